# Optimizing an MI355X kernel written in HIP

```python
import math
import jax, jax.numpy as jnp
from jax import lax
import numpy as np

D_MODEL = 1024
BATCH = 16
SEQ = 2048
DEPTH = 1

D_HY = D_MODEL
HY_ORDER = 2
HY_SHORT_CONV = 3
HY_EMB_DIM = 33
HY_FILTER_HIDDEN = 64
HY_FAST_DECAY_PCT = 0.3
HY_SLOW_DECAY_PCT = 1.5
HY_DECAY_TARGET = 1e-2
HY_FILTER_OUT_STD = 0.01
HY_COLS = (HY_ORDER + 1) * D_HY

SSD_EXPAND = 2
D_SSM = SSD_EXPAND * D_MODEL
SSD_HEADDIM = 64
SSD_HEADS = D_SSM // SSD_HEADDIM
SSD_GROUPS = 8
SSD_STATE = 128
SSD_CONV = 5
SSD_CHUNK = 128
SSD_CONV_DIM = D_SSM + 2 * SSD_GROUPS * SSD_STATE
SSD_DT_MIN = 1e-3
SSD_DT_MAX = 1e-1
SSD_COLS = D_SSM + SSD_CONV_DIM + 2 * SSD_HEADS

N_BRANCH = 2
GATE_COLS = N_BRANCH * D_MODEL
IN_COLS = HY_COLS + SSD_COLS + GATE_COLS

N_EXPERTS = 64
TOP_K = 8
N_EXPERT_GROUPS = 8
TOPK_GROUPS = 4
D_EXPERT = 256
D_SHARED = 256
ROUTED_SCALE = 2.5
MOE_BLOCK = 128

DN_ALPHA = (2.0 * DEPTH) ** 0.25
DN_BETA = (8.0 * DEPTH) ** -0.25
LN_EPS = 1e-5
RMS_EPS = 1e-5

kernel_name = "hyena_ssd_gated_moe_deepnorm_block"


def layer_norm(x, g, b):
    xf = x.astype(jnp.float32)
    mu = jnp.mean(xf, axis=-1, keepdims=True)
    var = jnp.mean(jnp.square(xf - mu), axis=-1, keepdims=True)
    return ((xf - mu) * lax.rsqrt(var + LN_EPS) * g + b).astype(x.dtype)


def centred_dwconv(x, w, b):
    k_w = w.shape[0]
    seq = x.shape[1]
    pad = k_w // 2
    xp = jnp.pad(x, ((0, 0), (pad, pad), (0, 0)))
    y = b
    for k in range(k_w):
        y = y + xp[:, k:k + seq] * w[k]
    return y


def hyena_pos_features(seq):
    t = jnp.linspace(0.0, 1.0, seq, dtype=jnp.float32)[:, None]
    bands = (HY_EMB_DIM - 1) // 2
    w = 2.0 * math.pi * jnp.arange(seq, dtype=jnp.float32)[:, None] / seq
    f = jnp.linspace(1e-4, bands - 1, bands, dtype=jnp.float32)[None, :]
    return jnp.concatenate([t, jnp.cos(f * w), -jnp.sin(f * w)], axis=-1)


def hyena_decay(seq):
    t = jnp.linspace(0.0, 1.0, seq, dtype=jnp.float32)[:, None]
    max_decay = math.log(HY_DECAY_TARGET) / HY_FAST_DECAY_PCT
    min_decay = math.log(HY_DECAY_TARGET) / HY_SLOW_DECAY_PCT
    deltas = jnp.linspace(min_decay, max_decay, D_HY, dtype=jnp.float32)[None, :]
    return jnp.exp(-t * jnp.abs(deltas))


def hyena_filters(seq, w1, b1, fr1, w2, b2, fr2, w3, b3, fr3, w4):
    f32 = jnp.float32
    z = hyena_pos_features(seq)
    h = jnp.sin(fr1.astype(f32) * (z @ w1.astype(f32) + b1.astype(f32)))
    h = jnp.sin(fr2.astype(f32) * (h @ w2.astype(f32) + b2.astype(f32)))
    h = jnp.sin(fr3.astype(f32) * (h @ w3.astype(f32) + b3.astype(f32)))
    k = (h @ w4.astype(f32)).reshape(seq, HY_ORDER, 2, D_HY) * hyena_decay(seq)[:, None, None, :]
    kf, kb = k[:, :, 0], k[:, :, 1]
    k_full = jnp.concatenate([kf[:1] + kb[:1], kf[1:], jnp.zeros_like(kf[:1]), kb[:0:-1]], axis=0)
    return jnp.fft.rfft(k_full, axis=0)


def fft_long_conv(u, k_spec, bias):
    seq = u.shape[1]
    uf32 = u.astype(jnp.float32)
    uf = jnp.fft.rfft(uf32, n=2 * seq, axis=1)
    y = jnp.fft.irfft(uf * k_spec[None], n=2 * seq, axis=1)[:, :seq]
    return (y + uf32 * bias.astype(jnp.float32)).astype(u.dtype)


def hyena_mixer(p_hy, conv_w, conv_b, k_spec, hy_bias):
    hy = centred_dwconv(p_hy, conv_w, conv_b)
    g1, g2, v = jnp.split(hy, HY_ORDER + 1, axis=-1)
    z = g1 * fft_long_conv(v, k_spec[:, 0], hy_bias[0])
    return g2 * fft_long_conv(z, k_spec[:, 1], hy_bias[1])


def ssd_chunked(xdt, a, bm, cm):
    b, l, h, p = xdt.shape
    g, n = bm.shape[-2:]
    r = h // g
    c = l // SSD_CHUNK
    q = SSD_CHUNK
    X = xdt.reshape(b, c, q, g, r, p)
    A_cs = jnp.cumsum(a.reshape(b, c, q, g, r), axis=2)
    Bc = bm.reshape(b, c, q, g, n)
    Cc = cm.reshape(b, c, q, g, n)
    seg = A_cs[:, :, :, None] - A_cs[:, :, None, :]
    tril = jnp.tril(jnp.ones((q, q), dtype=bool))[:, :, None, None]
    decay = jnp.exp(jnp.where(tril, seg, -jnp.inf))
    CB = jnp.einsum("bclgn,bcsgn->bclsg", Cc, Bc)
    y_diag = jnp.einsum("bclsg,bclsgr,bcsgrp->bclgrp", CB, decay, X)
    to_end = jnp.exp(A_cs[:, :, -1:] - A_cs)
    states = jnp.einsum("bcsgn,bcsgr,bcsgrp->bcgrpn", Bc, to_end, X)
    chunk_decay = jnp.exp(A_cs[:, :, -1])

    def step(carry, inp):
        st, dec = inp
        return carry * dec[..., None, None] + st, carry

    init = jnp.zeros((b, g, r, p, n), states.dtype)
    _, prev = lax.scan(step, init, (jnp.moveaxis(states, 1, 0), jnp.moveaxis(chunk_decay, 1, 0)))
    prev = jnp.moveaxis(prev, 0, 1)
    y_off = jnp.einsum("bclgn,bcgrpn,bclgr->bclgrp", Cc, prev, jnp.exp(A_cs))
    return (y_diag + y_off).reshape(b, l, h, p)


def ssd_mixer(p_z, p_xbc, p_dt, conv_w, conv_b, dt_bias, a_log, d_skip, norm_w):
    f32 = jnp.float32
    bsz, seq, _ = p_z.shape
    xbc = jax.nn.silu(centred_dwconv(p_xbc, conv_w, conv_b))
    xs, bm, cm = jnp.split(xbc, [D_SSM, D_SSM + SSD_GROUPS * SSD_STATE], axis=-1)
    xs = xs.reshape(bsz, seq, SSD_HEADS, SSD_HEADDIM)
    bm = bm.reshape(bsz, seq, SSD_GROUPS, SSD_STATE)
    cm = cm.reshape(bsz, seq, SSD_GROUPS, SSD_STATE)
    dt = jax.nn.softplus(p_dt.astype(f32).reshape(bsz, seq, 2, SSD_HEADS) + dt_bias.astype(f32))
    a = dt * -jnp.exp(a_log.astype(f32))
    flip = lambda t: jnp.flip(t, axis=1)
    y_fwd = ssd_chunked(xs * dt[:, :, 0, :, None], a[:, :, 0], bm, cm)
    y_bwd = flip(ssd_chunked(flip(xs * dt[:, :, 1, :, None]), flip(a[:, :, 1]), flip(bm), flip(cm)))
    y = y_fwd + y_bwd + xs * d_skip[:, None]
    y = y.reshape(bsz, seq, D_SSM) * jax.nn.silu(p_z)
    yg = y.astype(f32).reshape(bsz, seq, SSD_GROUPS, D_SSM // SSD_GROUPS)
    yg = yg * lax.rsqrt(jnp.mean(jnp.square(yg), axis=-1, keepdims=True) + RMS_EPS)
    return (yg.reshape(bsz, seq, D_SSM) * norm_w).astype(p_z.dtype)


def mixer_sublayer(u, w_in, b_in, hy_conv_w, hy_conv_b, hy_f_w1, hy_f_b1, hy_f_freq1,
                   hy_f_w2, hy_f_b2, hy_f_freq2, hy_f_w3, hy_f_b3, hy_f_freq3, hy_f_w4, hy_bias,
                   ssd_conv_w, ssd_conv_b, ssd_dt_bias, ssd_a_log, ssd_d, ssd_norm_w,
                   w_hy_branch, w_ssd_branch, w_out, b_out):
    proj = u @ w_in + b_in
    splits = np.cumsum([HY_COLS, D_SSM, SSD_CONV_DIM, 2 * SSD_HEADS]).tolist()
    p_hy, p_z, p_xbc, p_dt, p_gate = jnp.split(proj, splits, axis=-1)
    k_spec = hyena_filters(u.shape[1], hy_f_w1, hy_f_b1, hy_f_freq1, hy_f_w2, hy_f_b2, hy_f_freq2,
                           hy_f_w3, hy_f_b3, hy_f_freq3, hy_f_w4)
    y_hy = hyena_mixer(p_hy, hy_conv_w, hy_conv_b, k_spec, hy_bias) @ w_hy_branch
    y_ssd = ssd_mixer(p_z, p_xbc, p_dt, ssd_conv_w, ssd_conv_b, ssd_dt_bias, ssd_a_log,
                      ssd_d, ssd_norm_w) @ w_ssd_branch
    g_hy, g_ssd = jnp.split(jax.nn.sigmoid(p_gate), N_BRANCH, axis=-1)
    return (g_hy * y_hy + g_ssd * y_ssd) @ w_out + b_out


def route(h2d, router_w, router_bias):
    n_tok = h2d.shape[0]
    scores = jax.nn.sigmoid((h2d @ router_w).astype(jnp.float32))
    biased = scores + router_bias.astype(jnp.float32)
    per_group = N_EXPERTS // N_EXPERT_GROUPS
    grp_score = lax.top_k(biased.reshape(n_tok, N_EXPERT_GROUPS, per_group), 2)[0].sum(-1)
    _, top_grp = lax.top_k(grp_score, TOPK_GROUPS)
    grp_mask = jnp.any(top_grp[..., None] == jnp.arange(N_EXPERT_GROUPS), axis=-2)
    masked = jnp.where(jnp.repeat(grp_mask, per_group, axis=-1), biased, -jnp.inf)
    _, idx = lax.top_k(masked, TOP_K)
    w = jnp.take_along_axis(scores, idx, axis=-1)
    w = w / jnp.sum(w, axis=-1, keepdims=True) * ROUTED_SCALE
    return idx, w


def routed_experts(h2d, idx, w, w_gate, w_up, w_down):
    n_tok, d = h2d.shape
    n_assign = n_tok * TOP_K
    flat_e = idx.reshape(n_assign)
    flat_tok = jnp.repeat(jnp.arange(n_tok, dtype=jnp.int32), TOP_K)
    flat_w = w.reshape(n_assign)
    order = jnp.argsort(flat_e)
    e_sorted = flat_e[order]
    counts = jnp.bincount(flat_e, length=N_EXPERTS)
    padded = (counts + MOE_BLOCK - 1) // MOE_BLOCK * MOE_BLOCK
    pad_end = jnp.cumsum(padded)
    pad_start = pad_end - padded
    sorted_start = jnp.cumsum(counts) - counts
    dest = pad_start[e_sorted] + jnp.arange(n_assign) - sorted_start[e_sorted]
    n_blocks = -(-n_assign // MOE_BLOCK) + N_EXPERTS
    n_slots = n_blocks * MOE_BLOCK
    slot_tok = jnp.full((n_slots,), n_tok, jnp.int32).at[dest].set(flat_tok[order])
    slot_w = jnp.zeros((n_slots,), jnp.float32).at[dest].set(flat_w[order])
    block_e = jnp.minimum(jnp.searchsorted(pad_end, jnp.arange(n_blocks) * MOE_BLOCK, side="right"),
                          N_EXPERTS - 1)
    h_pad = jnp.concatenate([h2d, jnp.zeros((1, d), h2d.dtype)], axis=0)

    def step(acc, blk):
        tok, wt, e = blk
        xb = h_pad[tok]
        hb = jax.nn.silu(xb @ w_gate[e]) * (xb @ w_up[e])
        yb = (hb @ w_down[e]) * wt[:, None]
        return acc.at[tok].add(yb.astype(acc.dtype)), None

    acc, _ = lax.scan(step, jnp.zeros_like(h_pad),
                      (slot_tok.reshape(n_blocks, MOE_BLOCK), slot_w.reshape(n_blocks, MOE_BLOCK), block_e))
    return acc[:n_tok]


def moe_sublayer(h, router_w, router_bias, exp_w_gate, exp_w_up, exp_w_down,
                 sh_w_gate, sh_w_up, sh_w_down):
    bsz, seq, d = h.shape
    h2d = h.reshape(bsz * seq, d)
    idx, w = route(h2d, router_w, router_bias)
    routed = routed_experts(h2d, idx, w, exp_w_gate, exp_w_up, exp_w_down)
    shared = (jax.nn.silu(h2d @ sh_w_gate) * (h2d @ sh_w_up)) @ sh_w_down
    return (routed + shared).reshape(bsz, seq, d)


def setup_inputs(seed: int = 0) -> dict:
    key = jax.random.key(seed)
    ks = iter(jax.random.split(key, 64))
    f32 = jnp.float32
    Ld = DEPTH

    def nrm(shape, std):
        return std * jax.random.normal(next(ks), shape, f32)

    def xavier(fan_in, fan_out, shape, gain=1.0):
        return nrm(shape, gain * math.sqrt(2.0 / (fan_in + fan_out)))

    def ones_noise(shape):
        return 1.0 + nrm(shape, 0.01)

    u_dt = jax.random.uniform(next(ks), (Ld, 2, SSD_HEADS), f32)
    dt0 = jnp.exp(u_dt * (math.log(SSD_DT_MAX) - math.log(SSD_DT_MIN)) + math.log(SSD_DT_MIN))
    dt_bias = dt0 + jnp.log(-jnp.expm1(-dt0))
    a_log = jnp.log(jax.random.uniform(next(ks), (Ld, 2, SSD_HEADS), f32, 1.0, 16.0))
    FH = HY_FILTER_HIDDEN
    return {
        "x": nrm((BATCH, SEQ, D_MODEL), 1.0),
        "w_in": nrm((Ld, D_MODEL, IN_COLS), D_MODEL ** -0.5),
        "b_in": nrm((Ld, IN_COLS), 0.01),
        "hy_conv_w": nrm((Ld, HY_SHORT_CONV, HY_COLS), HY_SHORT_CONV ** -0.5),
        "hy_conv_b": nrm((Ld, HY_COLS), 0.01),
        "hy_f_w1": nrm((Ld, HY_EMB_DIM, FH), HY_EMB_DIM ** -0.5),
        "hy_f_b1": nrm((Ld, FH), 0.01),
        "hy_f_freq1": ones_noise((Ld, FH)),
        "hy_f_w2": nrm((Ld, FH, FH), FH ** -0.5),
        "hy_f_b2": nrm((Ld, FH), 0.01),
        "hy_f_freq2": ones_noise((Ld, FH)),
        "hy_f_w3": nrm((Ld, FH, FH), FH ** -0.5),
        "hy_f_b3": nrm((Ld, FH), 0.01),
        "hy_f_freq3": ones_noise((Ld, FH)),
        "hy_f_w4": nrm((Ld, FH, HY_ORDER * 2 * D_HY), HY_FILTER_OUT_STD),
        "hy_bias": nrm((Ld, HY_ORDER, D_HY), 0.1),
        "ssd_conv_w": nrm((Ld, SSD_CONV, SSD_CONV_DIM), SSD_CONV ** -0.5),
        "ssd_conv_b": nrm((Ld, SSD_CONV_DIM), 0.01),
        "ssd_dt_bias": dt_bias,
        "ssd_a_log": a_log,
        "ssd_d": ones_noise((Ld, SSD_HEADS)),
        "ssd_norm_w": ones_noise((Ld, D_SSM)),
        "w_hy_branch": xavier(D_HY, D_MODEL, (Ld, D_HY, D_MODEL), DN_BETA),
        "w_ssd_branch": xavier(D_SSM, D_MODEL, (Ld, D_SSM, D_MODEL), DN_BETA),
        "w_out": xavier(D_MODEL, D_MODEL, (Ld, D_MODEL, D_MODEL), DN_BETA),
        "b_out": nrm((Ld, D_MODEL), 0.01),
        "ln1_g": ones_noise((Ld, D_MODEL)),
        "ln1_b": nrm((Ld, D_MODEL), 0.01),
        "router_w": nrm((Ld, D_MODEL, N_EXPERTS), D_MODEL ** -0.5),
        "router_bias": nrm((Ld, N_EXPERTS), 0.01),
        "exp_w_gate": nrm((Ld, N_EXPERTS, D_MODEL, D_EXPERT), D_MODEL ** -0.5),
        "exp_w_up": nrm((Ld, N_EXPERTS, D_MODEL, D_EXPERT), D_MODEL ** -0.5),
        "exp_w_down": xavier(D_EXPERT, D_MODEL, (Ld, N_EXPERTS, D_EXPERT, D_MODEL), DN_BETA),
        "sh_w_gate": nrm((Ld, D_MODEL, D_SHARED), D_MODEL ** -0.5),
        "sh_w_up": nrm((Ld, D_MODEL, D_SHARED), D_MODEL ** -0.5),
        "sh_w_down": xavier(D_SHARED, D_MODEL, (Ld, D_SHARED, D_MODEL), DN_BETA),
        "ln2_g": ones_noise((Ld, D_MODEL)),
        "ln2_b": nrm((Ld, D_MODEL), 0.01),
    }


def reference(x, w_in, b_in, hy_conv_w, hy_conv_b, hy_f_w1, hy_f_b1, hy_f_freq1,
              hy_f_w2, hy_f_b2, hy_f_freq2, hy_f_w3, hy_f_b3, hy_f_freq3, hy_f_w4, hy_bias,
              ssd_conv_w, ssd_conv_b, ssd_dt_bias, ssd_a_log, ssd_d, ssd_norm_w,
              w_hy_branch, w_ssd_branch, w_out, b_out, ln1_g, ln1_b,
              router_w, router_bias, exp_w_gate, exp_w_up, exp_w_down,
              sh_w_gate, sh_w_up, sh_w_down, ln2_g, ln2_b):
    h = x
    for i in range(DEPTH):
        mix = mixer_sublayer(h, w_in[i], b_in[i], hy_conv_w[i], hy_conv_b[i],
                             hy_f_w1[i], hy_f_b1[i], hy_f_freq1[i], hy_f_w2[i], hy_f_b2[i], hy_f_freq2[i],
                             hy_f_w3[i], hy_f_b3[i], hy_f_freq3[i], hy_f_w4[i], hy_bias[i],
                             ssd_conv_w[i], ssd_conv_b[i], ssd_dt_bias[i], ssd_a_log[i], ssd_d[i],
                             ssd_norm_w[i], w_hy_branch[i], w_ssd_branch[i], w_out[i], b_out[i])
        h = layer_norm(DN_ALPHA * h + mix, ln1_g[i], ln1_b[i])
        ffn = moe_sublayer(h, router_w[i], router_bias[i], exp_w_gate[i], exp_w_up[i], exp_w_down[i],
                           sh_w_gate[i], sh_w_up[i], sh_w_down[i])
        h = layer_norm(DN_ALPHA * h + ffn, ln2_g[i], ln2_b[i])
    return h
```

```cpp
#define MK_N_LAUNCHES 1
#define REP_MASK ((1<<0)|(1<<3))
#include <hip/hip_runtime.h>
#include <cstdio>
#include <cstdint>

#define LAS __attribute__((address_space(3)))
#define GAS __attribute__((address_space(1)))
typedef unsigned short bf16;
typedef short bf16x8 __attribute__((ext_vector_type(8)));
typedef float f32x4 __attribute__((ext_vector_type(4)));
typedef float f32x2 __attribute__((ext_vector_type(2)));
typedef unsigned u32x4 __attribute__((ext_vector_type(4)));
typedef unsigned u32x2 __attribute__((ext_vector_type(2)));
typedef GAS unsigned gu32;

constexpr int BATCH = 16, SEQ = 2048, DM = 1024, MTOK = BATCH * SEQ;
constexpr int HYC = 3072, DSSM = 2048, CONVD = 4096, NHEAD = 32, NGRP = 8, NSTATE = 128, INC = 11328;
constexpr int NE = 64, TOPK = 8, DEXP = 256, NEX = NE + 1;
constexpr float DN_ALPHA = 1.189207115002721f;
constexpr float LN_EPS = 1e-5f, RMS_EPS = 1e-5f, ROUTED_SCALE = 2.5f;
constexpr int NWAVES = 8, NTHR = 512;
constexpr int WIN_ROWS = 11520;

constexpr size_t MiB = 1u << 20;
constexpr size_t WS_CTL = 0, CTL_ZERO_BYTES = 256 * 1024;
constexpr size_t WS_WHYB = 1 * MiB, WS_WSSDB = 3 * MiB, WS_WOUT = 7 * MiB;
constexpr size_t WS_XB = 9 * MiB;
constexpr size_t WS_WINT = 73 * MiB;
constexpr size_t WS_KERN = 96 * MiB;
constexpr size_t WS_PTHY = 112 * MiB;
constexpr size_t WS_YTHY = 304 * MiB;
constexpr size_t WS_YHY = 137 * MiB;
constexpr size_t WS_XBC = 201 * MiB;
constexpr size_t WS_DT = 457 * MiB;
constexpr size_t WS_HALO = 465 * MiB;
constexpr size_t WS_YSSD = 9 * MiB;
constexpr size_t WS_XB2 = 201 * MiB;
constexpr size_t WS_WING = 265 * MiB;
constexpr size_t WS_G = 269 * MiB;
constexpr size_t WS_MIX = 397 * MiB;
constexpr size_t WS_H1 = 177 * MiB;
constexpr size_t WS_EW1 = 9 * MiB;
constexpr size_t WS_EW2 = 477 * MiB;
constexpr size_t WS_YQ = 9 * MiB;
constexpr size_t WS_ASG = 510 * MiB;
constexpr size_t WS_H1B = 113 * MiB;
constexpr size_t WS_HID = 305 * MiB;
constexpr size_t WS_TOK = 461 * MiB;
constexpr size_t WS_WGT = 469 * MiB;
constexpr size_t WS_END = 511 * MiB;
constexpr int CW_BAR = 4096;
constexpr int CW_CNT = 16384;
constexpr int CW_DBG = 32768;

constexpr int LDS_BYTES = 163840;
constexpr int MISC_OFF = 163840 - 512;

#define RLX_AGENT __ATOMIC_RELAXED, __HIP_MEMORY_SCOPE_AGENT
#define LDS_WAIT() asm volatile("s_waitcnt lgkmcnt(0)" ::: "memory")
#define VM_WAIT() asm volatile("s_waitcnt vmcnt(0)" ::: "memory")
typedef __bf16 bf16x2_t __attribute__((ext_vector_type(2)));
__device__ __forceinline__ unsigned pk2(float lo, float hi) { const f32x2 v = {lo, hi}; return __builtin_bit_cast(unsigned, __builtin_convertvector(v, bf16x2_t)); }
__device__ __forceinline__ unsigned f2bf(float f) { return pk2(f, 0.f) & 0xffffu; }
__device__ __forceinline__ float bf2f(unsigned b) { return __builtin_bit_cast(float, b << 16); }
__device__ __forceinline__ float bflo(unsigned w) { return __builtin_bit_cast(float, w << 16); }
__device__ __forceinline__ float bfhi(unsigned w) { return __builtin_bit_cast(float, w & 0xffff0000u); }
__device__ __forceinline__ float sigmoidf_(float v) { return __builtin_amdgcn_rcpf(1.0f + __expf(-v)); }
__device__ __forceinline__ float siluf_(float v) { return v * __builtin_amdgcn_rcpf(1.0f + __expf(-v)); }
__device__ __forceinline__ float wave_sum(float v) {
#pragma unroll
    for (int o = 1; o < 64; o <<= 1) v += __shfl_xor(v, o);
    return v;
}
__device__ __forceinline__ float wave_max(float v) {
#pragma unroll
    for (int o = 1; o < 64; o <<= 1) v = fmaxf(v, __shfl_xor(v, o));
    return v;
}

namespace pg8 {
constexpr int BM = 256, BK = 64, HALF = 128, HTB = HALF * BK * 2, STAGE_BYTES = 8 * HTB, NXCD = 8, WGM = 8;
__host__ __device__ __forceinline__ int lds_byte(int r, int c) { const int st = (r >> 4) * 2 + (c >> 5), rr = r & 15, cc = c & 31, ob = rr * 64 + cc * 2; return st * 1024 + (ob ^ (((ob >> 9) & 1) << 5)); }
__host__ __device__ __forceinline__ void stage_rc(int b, int& R, int& C) { const int st = b / 1024, sb = b % 1024, swz = sb ^ (((sb >> 9) & 1) << 5); R = (st >> 1) * 16 + swz / 64; C = (st & 1) * 32 + (swz % 64) / 2; }
__host__ __device__ __forceinline__ int perm32(int rho) { const int n = rho >> 4, i = rho & 15; return 8 * (i >> 2) + 4 * n + (i & 3); }

struct Unit { int pm, pn; const char* A; const char* B; int e, cnt; };

struct StaticOrder {
    int nM, nN, nwg, G, c, K; const char* A; const char* B;
    __device__ void init(const bf16* A_, const bf16* B_, int M, int N, int K_, int G_, int c_) { A = (const char*)A_; B = (const char*)B_; nM = M / BM; nN = N / BM; nwg = nM * nN; G = G_; c = c_; K = K_; }
    __device__ __forceinline__ bool next(int i, Unit& u) const {
        const long L = (long)i * G + c; if (L >= nwg) return false;
        int wgid = (int)L; { const int q = nwg / NXCD, r = nwg % NXCD, xcd = wgid % NXCD, off = wgid / NXCD; wgid = (xcd < r ? xcd * (q + 1) : r * (q + 1) + (xcd - r) * q) + off; }
        const int nig = WGM * nN, gid = wgid / nig, fm = gid * WGM, gsz = (nM - fm) < WGM ? (nM - fm) : WGM;
        u.pm = fm + ((wgid % nig) % gsz); u.pn = (wgid % nig) / gsz;
        u.A = A + (size_t)u.pm * BM * K * 2; u.B = B + (size_t)u.pn * BM * K * 2; u.e = 0; u.cnt = 0; return true;
    }
    __device__ __forceinline__ unsigned row_off(const Unit&, int) const { return 0u; }
};

__device__ __forceinline__ unsigned cvt_pk_bf16(float lo, float hi) { unsigned r; asm volatile("v_cvt_pk_bf16_f32 %0, %1, %2" : "=v"(r) : "v"(lo), "v"(hi)); return r; }

template <class Epi, class Sched, bool GATHER>
__device__ __forceinline__ void gemm_phase(LAS unsigned char* lds, const int K, const Sched& S, const Epi& E) {
    constexpr bool TA = Epi::TA;
    const int tid = threadIdx.x, wid = __builtin_amdgcn_readfirstlane(tid >> 6), lane = tid & 63, wr = wid >> 2, wc = wid & 3, fr = lane & 15, fq = lane >> 4;
    const int nt = K / BK;
    unsigned voffA[2][2], voffB[2]; int RA[2], CA[2];
#pragma unroll
    for (int i = 0; i < 2; ++i) { int R, C; stage_rc(tid * 16 + i * 8192, R, C); const int Rb = Epi::PERM ? ((R & ~31) + perm32(R & 31)) : R;
        RA[i] = R; CA[i] = C; voffA[0][i] = (unsigned)(R * K + C) * 2u; voffA[1][i] = voffA[0][i]; voffB[i] = (unsigned)(Rb * K + C) * 2u; }
    const size_t kstep = (size_t)(BK * 2);
    const size_t hstep = (size_t)HALF * K * 2;
    const size_t hstepA = GATHER ? 0 : hstep;
    const unsigned ldsw = (unsigned)wid * 1024u;
    const int aoff = lds_byte(wr * 64 + fr, fq * 8), boff = lds_byte(wc * 32 + fr, fq * 8);
#define PG8_SA(b, h) (((b) * 2 + (h)) * HTB)
#define PG8_SB(b, h) ((4 + (b) * 2 + (h)) * HTB)
#define PG8_STAGE(bufoff, gbase, voff) do { _Pragma("unroll") for (int _i = 0; _i < 2; ++_i) \
        __builtin_amdgcn_global_load_lds((const unsigned*)((const char*)(gbase) + (voff)[_i]), (LAS unsigned*)(lds + (bufoff) + ldsw + _i * 8192), 16, 0, 0); } while (0)
#define PG8_STAGE_A(bufoff, gbase, h) PG8_STAGE(bufoff, (gbase) + (h) * hstepA, voffA[GATHER ? (h) : 0])
#define PG8_LDA(dst, b, h) do { _Pragma("unroll") for (int m = 0; m < 4; ++m) _Pragma("unroll") for (int k = 0; k < 2; ++k) dst[m][k] = *(const LAS bf16x8*)(lds + PG8_SA(b, h) + aoff + m * 2048 + k * 1024); } while (0)
#define PG8_LDB(dst, b, h) do { _Pragma("unroll") for (int n = 0; n < 2; ++n) _Pragma("unroll") for (int k = 0; k < 2; ++k) dst[n][k] = *(const LAS bf16x8*)(lds + PG8_SB(b, h) + boff + n * 2048 + k * 1024); } while (0)
#define PG8_MMA(ai, bj, At, Bt) do { __builtin_amdgcn_s_setprio(1); _Pragma("unroll") for (int m = 0; m < 4; ++m) _Pragma("unroll") for (int n = 0; n < 2; ++n) _Pragma("unroll") for (int k = 0; k < 2; ++k) \
        acc[ai][bj][m][n] = TA ? __builtin_amdgcn_mfma_f32_16x16x32_bf16(Bt[n][k], At[m][k], acc[ai][bj][m][n], 0, 0, 0) \
                               : __builtin_amdgcn_mfma_f32_16x16x32_bf16(At[m][k], Bt[n][k], acc[ai][bj][m][n], 0, 0, 0); __builtin_amdgcn_s_setprio(0); } while (0)
#define PG8_WAIT_V(n) asm volatile("s_waitcnt vmcnt(" #n ")" ::: "memory")
#define PG8_WAIT_L(n) asm volatile("s_waitcnt lgkmcnt(" #n ")" ::: "memory")
#define PG8_BAR __builtin_amdgcn_s_barrier()
#define PG8_SCHED __builtin_amdgcn_sched_barrier(0)
    Unit cur, nxt; int ui = 0;
    if (!S.next(0, cur)) return;
    if (GATHER) {
#pragma unroll
        for (int h = 0; h < 2; ++h)
#pragma unroll
            for (int i = 0; i < 2; ++i) voffA[h][i] = S.row_off(cur, h * HALF + RA[i]) + (unsigned)CA[i] * 2u;
    }
    f32x4 acc[2][2][4][2];
#pragma unroll
    for (int a = 0; a < 2; ++a)
#pragma unroll
        for (int b = 0; b < 2; ++b)
#pragma unroll
            for (int m = 0; m < 4; ++m)
#pragma unroll
                for (int n = 0; n < 2; ++n) acc[a][b][m][n] = (f32x4){0.f, 0.f, 0.f, 0.f};
    bf16x8 At[4][2], B0[2][2], B1[2][2];
    const char* cA = cur.A; const char* cB = cur.B;
    PG8_STAGE(PG8_SB(0, 0), cB, voffB); PG8_STAGE_A(PG8_SA(0, 0), cA, 0); PG8_STAGE(PG8_SB(0, 1), cB + hstep, voffB); PG8_STAGE_A(PG8_SA(0, 1), cA, 1);
    if (wr == 1) PG8_BAR;
    PG8_WAIT_V(4); PG8_BAR;
    PG8_STAGE(PG8_SB(1, 0), cB + kstep, voffB); PG8_STAGE_A(PG8_SA(1, 0), cA + kstep, 0); PG8_STAGE(PG8_SB(1, 1), cB + hstep + kstep, voffB);
    PG8_WAIT_V(6); PG8_BAR;
    for (;;) {
        const bool has_next = S.next(ui + 1, nxt);
        const char* nA = has_next ? nxt.A : cA; const char* nB = has_next ? nxt.B : cB;
        for (int t = 0; t < nt; t += 2) {
            const bool last = (t == nt - 2);
            const char* a1 = cA + (size_t)(t + 1) * kstep;
            const char* a2 = last ? nA : cA + (size_t)(t + 2) * kstep; const char* b2 = last ? nB : cB + (size_t)(t + 2) * kstep;
            const char* a3 = a2 + kstep; const char* b3 = b2 + kstep;
            PG8_LDB(B0, 0, 0); PG8_SCHED; PG8_LDA(At, 0, 0); PG8_STAGE_A(PG8_SA(1, 1), a1, 1);
            PG8_WAIT_L(8); PG8_BAR; PG8_WAIT_L(0); PG8_MMA(0, 0, At, B0); PG8_BAR; PG8_SCHED;
            if (GATHER) { if (last && has_next) {
#pragma unroll
                for (int h = 0; h < 2; ++h)
#pragma unroll
                    for (int i = 0; i < 2; ++i) voffA[h][i] = S.row_off(nxt, h * HALF + RA[i]) + (unsigned)CA[i] * 2u;
            } }
            PG8_LDB(B1, 0, 1); PG8_STAGE(PG8_SB(0, 0), b2, voffB);
            PG8_BAR; PG8_WAIT_L(0); PG8_MMA(0, 1, At, B1); PG8_BAR;
            PG8_LDA(At, 0, 1); PG8_STAGE_A(PG8_SA(0, 0), a2, 0);
            PG8_BAR; PG8_WAIT_L(0); PG8_MMA(1, 0, At, B0); PG8_BAR; PG8_SCHED;
            PG8_STAGE(PG8_SB(0, 1), b2 + hstep, voffB);
            PG8_WAIT_V(6); PG8_BAR; PG8_MMA(1, 1, At, B1); PG8_BAR;
            PG8_LDB(B0, 1, 0); PG8_SCHED; PG8_LDA(At, 1, 0); PG8_STAGE_A(PG8_SA(0, 1), a2, 1);
            PG8_WAIT_L(8); PG8_BAR; PG8_WAIT_L(0); PG8_MMA(0, 0, At, B0); PG8_BAR; PG8_SCHED;
            PG8_LDB(B1, 1, 1); PG8_STAGE(PG8_SB(1, 0), b3, voffB);
            PG8_BAR; PG8_WAIT_L(0); PG8_MMA(0, 1, At, B1); PG8_BAR;
            PG8_LDA(At, 1, 1); PG8_STAGE_A(PG8_SA(1, 0), a3, 0);
            PG8_BAR; PG8_WAIT_L(0); PG8_MMA(1, 0, At, B0); PG8_BAR; PG8_SCHED;
            PG8_STAGE(PG8_SB(1, 1), b3 + hstep, voffB);
            PG8_WAIT_V(6); PG8_BAR; PG8_MMA(1, 1, At, B1); PG8_BAR;
        }
        E(acc, cur, wr, wc, fr, fq);
        if (!has_next) break;
#pragma unroll
        for (int a = 0; a < 2; ++a)
#pragma unroll
            for (int b = 0; b < 2; ++b)
#pragma unroll
                for (int m = 0; m < 4; ++m)
#pragma unroll
                    for (int n = 0; n < 2; ++n) acc[a][b][m][n] = (f32x4){0.f, 0.f, 0.f, 0.f};
        cur = nxt; cA = nA; cB = nB; ++ui;
    }
    PG8_WAIT_V(0);
    if (wr == 0) PG8_BAR;
    PG8_BAR;
#undef PG8_SA
#undef PG8_SB
#undef PG8_STAGE
#undef PG8_STAGE_A
#undef PG8_LDA
#undef PG8_LDB
#undef PG8_MMA
#undef PG8_WAIT_V
#undef PG8_WAIT_L
#undef PG8_BAR
#undef PG8_SCHED
}
}

namespace pg8 {
struct EpiHyT {
    static constexpr bool TA = false, PERM = false;
    bf16* PT; const float* bias;
    __device__ __forceinline__ void operator()(const f32x4 (&acc)[2][2][4][2], const Unit& u, int wr, int wc, int fr, int fq) const {
#pragma unroll
        for (int bj = 0; bj < 2; ++bj)
#pragma unroll
            for (int n = 0; n < 2; ++n) {
                const int col = u.pn * BM + bj * HALF + wc * 32 + n * 16 + fr; const float bv = bias[col];
                bf16* colp = PT + (size_t)col * MTOK + u.pm * BM + wr * 64 + 4 * fq;
#pragma unroll
                for (int ai = 0; ai < 2; ++ai)
#pragma unroll
                    for (int m = 0; m < 4; ++m) { const f32x4 v = acc[ai][bj][m][n] + bv; u32x2 w; w.x = cvt_pk_bf16(v[0], v[1]); w.y = cvt_pk_bf16(v[2], v[3]);
                        *(u32x2*)(colp + ai * HALF + m * 16) = w; }
            }
    }
};
struct EpiZXD {
    static constexpr bool TA = true, PERM = true;
    bf16* Zb; bf16* XBC; float* DT; const float* b_in; bf16* HALO;
    __device__ __forceinline__ void operator()(const f32x4 (&acc)[2][2][4][2], const Unit& u, int wr, int wc, int fr, int fq) const {
        const int row0 = u.pm * BM + wr * 64 + fr;
        if (u.pn == 24) {
            if (wc < 2) {
                const int c0 = wc * 32 + 8 * fq;
#pragma unroll
                for (int n = 0; n < 2; ++n) { const f32x4 bv = *(const f32x4*)(b_in + 9216 + c0 + 4 * n);
#pragma unroll
                    for (int ai = 0; ai < 2; ++ai)
#pragma unroll
                        for (int m = 0; m < 4; ++m) *(f32x4*)(DT + (size_t)(row0 + ai * HALF + m * 16) * 64 + c0 + 4 * n) = acc[ai][0][m][n] + bv; }
            }
            return;
        }
        bf16* base; int ldc, colt, bcol;
        if (u.pn < 8) { base = Zb; ldc = DSSM; colt = u.pn * BM; bcol = 3072 + colt; } else { base = XBC; ldc = CONVD; colt = (u.pn - 8) * BM; bcol = 5120 + colt; }
        const int col0 = colt + wc * 32 + 8 * fq, bcol0 = bcol + wc * 32 + 8 * fq;
        f32x4 bv[2][2];
#pragma unroll
        for (int bj = 0; bj < 2; ++bj)
#pragma unroll
            for (int n = 0; n < 2; ++n) bv[bj][n] = *(const f32x4*)(b_in + bcol0 + bj * HALF + 4 * n);
#pragma unroll
        for (int ai = 0; ai < 2; ++ai)
#pragma unroll
            for (int m = 0; m < 4; ++m) { bf16* rowp = base + (size_t)(row0 + ai * HALF + m * 16) * ldc + col0;
#pragma unroll
                for (int bj = 0; bj < 2; ++bj) { const f32x4 v0 = acc[ai][bj][m][0] + bv[bj][0], v1 = acc[ai][bj][m][1] + bv[bj][1];
                    u32x4 w; w.x = cvt_pk_bf16(v0[0], v0[1]); w.y = cvt_pk_bf16(v0[2], v0[3]); w.z = cvt_pk_bf16(v1[0], v1[1]); w.w = cvt_pk_bf16(v1[2], v1[3]);
                    *(u32x4*)(rowp + bj * HALF) = w;
                    if (u.pn >= 8 && ((m == 3 && fr >= 14) || (m == 0 && fr < 2))) {
                        const int row = row0 + ai * HALF + m * 16, bb = row >> 11, t = row & 2047, tm = t & 63;
                        const int jb = (tm >= 62) ? (t >> 6) + 1 : (t >> 6), idx = (tm >= 62) ? tm - 62 : 2 + tm;
                        *(u32x4*)(HALO + ((size_t)(bb * 33 + jb) * 4 + idx) * CONVD + col0 + bj * HALF) = w; } } }
    }
};
template <int MODE> struct EpiBf {
    static constexpr bool TA = true, PERM = true;
    bf16* O; int ldc; const float* bias; const bf16* G1; int ldg; const bf16* P;
    __device__ __forceinline__ void operator()(const f32x4 (&acc)[2][2][4][2], const Unit& u, int wr, int wc, int fr, int fq) const {
        const int row0 = u.pm * BM + wr * 64 + fr, col0 = u.pn * BM + wc * 32 + 8 * fq;
#pragma unroll
        for (int ai = 0; ai < 2; ++ai)
#pragma unroll
            for (int m = 0; m < 4; ++m) { const size_t r = (size_t)(row0 + ai * HALF + m * 16);
#pragma unroll
                for (int bj = 0; bj < 2; ++bj) { f32x4 v0 = acc[ai][bj][m][0], v1 = acc[ai][bj][m][1]; const int c = col0 + bj * HALF;
                    if (MODE == 0) { const f32x4 b0 = *(const f32x4*)(bias + c), b1 = *(const f32x4*)(bias + c + 4); v0 = v0 + b0; v1 = v1 + b1;
#pragma unroll
                        for (int j = 0; j < 4; ++j) { v0[j] = sigmoidf_(v0[j]); v1[j] = sigmoidf_(v1[j]); } }
                    else { const u32x4 g = *(const u32x4*)(G1 + r * ldg + c);
                        v0[0] *= bflo(g.x); v0[1] *= bfhi(g.x); v0[2] *= bflo(g.y); v0[3] *= bfhi(g.y); v1[0] *= bflo(g.z); v1[1] *= bfhi(g.z); v1[2] *= bflo(g.w); v1[3] *= bfhi(g.w);
                        if (MODE == 2) { const u32x4 p = *(const u32x4*)(P + r * ldc + c);
                            v0[0] += bflo(p.x); v0[1] += bfhi(p.x); v0[2] += bflo(p.y); v0[3] += bfhi(p.y); v1[0] += bflo(p.z); v1[1] += bfhi(p.z); v1[2] += bflo(p.w); v1[3] += bfhi(p.w); } }
                    u32x4 w; w.x = cvt_pk_bf16(v0[0], v0[1]); w.y = cvt_pk_bf16(v0[2], v0[3]); w.z = cvt_pk_bf16(v1[0], v1[1]); w.w = cvt_pk_bf16(v1[2], v1[3]);
                    *(u32x4*)(O + r * ldc + c) = w; } }
    }
};
struct EpiRes {
    static constexpr bool TA = true, PERM = false;
    float* O; const float* bias; const float* X; float alpha;
    __device__ __forceinline__ void operator()(const f32x4 (&acc)[2][2][4][2], const Unit& u, int wr, int wc, int fr, int fq) const {
        const int row0 = u.pm * BM + wr * 64 + fr, col0 = u.pn * BM + wc * 32 + 4 * fq;
#pragma unroll
        for (int ai = 0; ai < 2; ++ai)
#pragma unroll
            for (int m = 0; m < 4; ++m) { const size_t off = (size_t)(row0 + ai * HALF + m * 16) * DM + col0;
#pragma unroll
                for (int bj = 0; bj < 2; ++bj)
#pragma unroll
                    for (int n = 0; n < 2; ++n) { const f32x4 xv = *(const f32x4*)(X + off + bj * HALF + n * 16), bv = *(const f32x4*)(bias + col0 + bj * HALF + n * 16);
                        *(f32x4*)(O + off + bj * HALF + n * 16) = acc[ai][bj][m][n] + bv + alpha * xv; } }
    }
};
struct EpiSwiGLU {
    static constexpr bool TA = true, PERM = true;
    bf16* HID;
    __device__ __forceinline__ void operator()(const f32x4 (&acc)[2][2][4][2], const Unit& u, int wr, int wc, int fr, int fq) const {
        const int row0 = u.pm * BM + wr * 64 + fr, col0 = u.pn * HALF + wc * 32 + 8 * fq;
#pragma unroll
        for (int ai = 0; ai < 2; ++ai)
#pragma unroll
            for (int m = 0; m < 4; ++m) { f32x4 v0, v1;
#pragma unroll
                for (int j = 0; j < 4; ++j) { v0[j] = siluf_(acc[ai][0][m][0][j]) * acc[ai][1][m][0][j]; v1[j] = siluf_(acc[ai][0][m][1][j]) * acc[ai][1][m][1][j]; }
                u32x4 w; w.x = cvt_pk_bf16(v0[0], v0[1]); w.y = cvt_pk_bf16(v0[2], v0[3]); w.z = cvt_pk_bf16(v1[0], v1[1]); w.w = cvt_pk_bf16(v1[2], v1[3]);
                *(u32x4*)(HID + (size_t)(row0 + ai * HALF + m * 16) * DEXP + col0) = w; }
    }
};
struct EpiScatter {
    static constexpr bool TA = false, PERM = false;
    float* ACC; const int* tok; const float* wgt; int j0_unused;
    __device__ __forceinline__ void operator()(const f32x4 (&acc)[2][2][4][2], const Unit& u, int wr, int wc, int fr, int fq) const {
        asm volatile("" : "+v"(fr), "+v"(fq));
        const int jt = u.pn >> 2, ct = u.pn & 3;
#pragma unroll
        for (int ai = 0; ai < 2; ++ai)
#pragma unroll
            for (int m = 0; m < 4; ++m)
#pragma unroll
                for (int j = 0; j < 4; ++j) { const int r = ai * HALF + wr * 64 + m * 16 + 4 * fq + j;
                    if (r < u.cnt) { int token; float w;
                        if (u.e == NE) { token = jt * BM + r; w = 1.0f; } else { const size_t li = (size_t)u.e * MTOK + (size_t)jt * BM + r; token = tok[li]; w = wgt[li]; }
                        float* rowp = ACC + (size_t)token * DM + ct * BM + wc * 32 + fr;
#pragma unroll
                        for (int bj = 0; bj < 2; ++bj)
#pragma unroll
                            for (int n = 0; n < 2; ++n) unsafeAtomicAdd(rowp + bj * HALF + n * 16, w * acc[ai][bj][m][n][j]);
                    }
                    asm volatile("" ::: "memory"); }
    }
};

struct EpiSlot {
    static constexpr bool TA = true, PERM = true;
    bf16* YQ;
    __device__ __forceinline__ void operator()(const f32x4 (&acc)[2][2][4][2], const Unit& u, int wr, int wc, int fr, int fq) const {
        const int row0 = u.pm * BM + wr * 64 + fr, col0 = wc * 32 + 8 * fq;
#pragma unroll
        for (int ai = 0; ai < 2; ++ai)
#pragma unroll
            for (int m = 0; m < 4; ++m) { bf16* rowp = YQ + (size_t)(row0 + ai * HALF + m * 16) * 256 + col0;
#pragma unroll
                for (int bj = 0; bj < 2; ++bj) { const f32x4 v0 = acc[ai][bj][m][0], v1 = acc[ai][bj][m][1];
                    u32x4 w; w.x = cvt_pk_bf16(v0[0], v0[1]); w.y = cvt_pk_bf16(v0[2], v0[3]); w.z = cvt_pk_bf16(v1[0], v1[1]); w.w = cvt_pk_bf16(v1[2], v1[3]);
                    *(u32x4*)(rowp + bj * HALF) = w; } }
    }
};
struct SlotOrder {
    const LAS int* tp; int G, c, total, q; const char* A; const char* W;
    __device__ __forceinline__ bool next(int i, Unit& u) const {
        const long L = (long)i * G + c; if (L >= (long)total) return false;
        const int tile = (int)L; int e = 0;
#pragma unroll 1
        for (int s = 64; s >= 1; s >>= 1) if (e + s <= NE && tp[e + s] <= tile) e += s;
        u.e = e; u.cnt = 0; u.pm = tile; u.pn = 0; u.A = A + (size_t)tile * BM * DEXP * 2; u.B = W + ((size_t)e * DM + (size_t)q * 256) * DEXP * 2;
        return true;
    }
    __device__ __forceinline__ unsigned row_off(const Unit&, int) const { return 0u; }
};
template <int NCT, bool FIRST> struct MoeOrder {
    const LAS int* tp; const LAS int* cnt; int G, c, total;
    const char* A; const char* W; const int* tok;
    __device__ __forceinline__ bool next(int i, Unit& u) const {
        const long L = (long)i * G + c; if (L >= (long)total * NCT) return false;
        const int tile = (int)(L / NCT), ct = (int)(L % NCT);
        int e = 0;
#pragma unroll 1
        for (int s = 64; s >= 1; s >>= 1) if (e + s <= NE && tp[e + s] <= tile) e += s;
        const int jt = tile - tp[e];
        u.e = e; const int left = cnt[e] - jt * BM; u.cnt = left < BM ? left : BM;
        if (FIRST) { u.pm = tile; u.pn = ct; u.A = A; u.B = W + ((size_t)e * 512 + (size_t)ct * 256) * DM * 2; }
        else { u.pm = tile; u.pn = jt * 4 + ct; u.A = A + (size_t)tile * BM * DEXP * 2; u.B = W + ((size_t)e * DM + (size_t)ct * 256) * DEXP * 2; }
        return true;
    }
    __device__ __forceinline__ unsigned row_off(const Unit& u, int r) const {
        const int jt = u.pm - tp[u.e]; int token;
        if (u.e == NE) token = jt * BM + r; else token = (r < u.cnt) ? tok[(size_t)u.e * MTOK + (size_t)jt * BM + r] : 0;
        return (unsigned)token * (unsigned)(DM * 2);
    }
};
}

#define XB_TMO      128
#define XB_XCNT(j)  (256  + 64 * (j))
#define XB_XSUB(j)  (1280 + 64 * (j))
#define XB_XGEN(j)  (2304 + 64 * (j))
#define XB_TOP      3328
#define XB_TOPGEN   3392
#define XCD_BAR_WORDS 3456
#define XB_SPIN_CAP (1u << 18)
__device__ __forceinline__ unsigned xb_ld(unsigned* p)              { return __hip_atomic_load(p, __ATOMIC_RELAXED, __HIP_MEMORY_SCOPE_AGENT); }
__device__ __forceinline__ unsigned xb_add(unsigned* p, unsigned v) { return __hip_atomic_fetch_add(p, v, __ATOMIC_RELAXED, __HIP_MEMORY_SCOPE_AGENT); }
__device__ __forceinline__ unsigned xb_xcc_id() { return (unsigned)__builtin_amdgcn_s_getreg((3 << 11) | 20) & 0xFu; }
#define XB_SPIN(cond, bar) do { unsigned _sp = 0; while (cond) { __builtin_amdgcn_s_sleep(1); \
    if ((++_sp & 255u) == 0u) { if (xb_ld(&(bar)[XB_TMO])) break; if (_sp > XB_SPIN_CAP) { atomicAdd(&(bar)[XB_TMO], 1u); break; } } } } while (0)
struct XcdBarrier { unsigned* bar; unsigned x; volatile LAS unsigned* st; };
__device__ __forceinline__ XcdBarrier xcd_barrier_post(unsigned* bar, volatile LAS unsigned* st) {
    XcdBarrier b; b.bar = bar; b.x = xb_xcc_id(); b.st = st;
    if (threadIdx.x == 0) (void)xb_add(&bar[XB_XCNT(b.x)], 1u);
    return b;
}
__device__ __forceinline__ void xcd_barrier_complete(unsigned* bar, unsigned x, unsigned& nloc, unsigned& nx) {
    const unsigned G = gridDim.x * gridDim.y * gridDim.z;
    unsigned sum, cnt, mine, sp = 0u;
    for (;;) {
        sum = 0u; cnt = 0u; mine = 0u;
#pragma unroll
        for (unsigned j = 0; j < 16; ++j) { const unsigned c = xb_ld(&bar[XB_XCNT(j)]); sum += c; cnt += (c > 0u) ? 1u : 0u; mine = (j == x) ? c : mine; }
        if (sum == G) break;
        __builtin_amdgcn_s_sleep(1);
        if ((++sp & 255u) == 0u) { if (xb_ld(&bar[XB_TMO])) break; if (sp > XB_SPIN_CAP) { atomicAdd(&bar[XB_TMO], 1u); break; } }
    }
    nloc = mine > 0u ? mine : 1u; nx = cnt > 0u ? cnt : 1u;
}
__device__ __forceinline__ void xcd_barrier(const XcdBarrier& b) {
    asm volatile("s_waitcnt vmcnt(0)" ::: "memory");
    __syncthreads();
    if (threadIdx.x == 0) {
        unsigned* bar = b.bar;
        __builtin_amdgcn_s_waitcnt(0);
        unsigned nloc = b.st[0], nx = b.st[1];
        if (nloc == 0u) { xcd_barrier_complete(bar, b.x, nloc, nx); b.st[0] = nloc; b.st[1] = nx; }
        const unsigned old = xb_add(&bar[XB_XSUB(b.x)], 1u);
        const unsigned gen = old / nloc;
        if (old + 1u == (gen + 1u) * nloc) {
            __builtin_amdgcn_fence(__ATOMIC_RELEASE, "agent");
            asm volatile("s_waitcnt vmcnt(0)" ::: "memory");
            const unsigned og = xb_add(&bar[XB_TOP], 1u);
            const unsigned tg = og / nx;
            if (og + 1u == (tg + 1u) * nx) xb_add(&bar[XB_TOPGEN], 1u);
            else XB_SPIN(xb_ld(&bar[XB_TOPGEN]) == tg, bar);
            __builtin_amdgcn_fence(__ATOMIC_ACQUIRE, "agent");
            xb_add(&bar[XB_XGEN(b.x)], 1u);
            asm volatile("s_waitcnt vmcnt(0)" ::: "memory");
        } else {
            XB_SPIN(xb_ld(&bar[XB_XGEN(b.x)]) == gen, bar);
            __builtin_amdgcn_fence(__ATOMIC_ACQUIRE, "agent");
            asm volatile("s_waitcnt vmcnt(0)" ::: "memory");
        }
    }
    __syncthreads();
}

struct Args {
    const float* in[38]; float* out; unsigned char* ws; int ph_lo, ph_hi, li, pad;
};
enum { I_X = 0, I_WIN, I_BIN, I_HCW, I_HCB, I_FW1, I_FB1, I_FF1, I_FW2, I_FB2, I_FF2, I_FW3, I_FB3, I_FF3, I_FW4, I_HBIAS,
       I_SCW, I_SCB, I_DTB, I_ALOG, I_SD, I_SNW, I_WHYB, I_WSSDB, I_WOUT, I_BOUT, I_LN1G, I_LN1B, I_RW, I_RB, I_EWG, I_EWU, I_EWD, I_SWG, I_SWU, I_SWD, I_LN2G, I_LN2B };
struct Frame {
    LAS unsigned char* lds; volatile LAS unsigned* MISC; gu32* ctl; unsigned char* ws;
    int tid, lane, wave, vcu, G;
    const float* const* in; float* out;
};

__device__ __forceinline__ void tr_item(const float* src, int ld_src, int k0, int c0, bf16* dst, int drow0, int ldd, LAS float* scr, int lane) {
#pragma unroll 8
    for (int i = 0; i < 32; ++i) { const int kk = 2 * i + (lane >> 5); scr[kk * 33 + (lane & 31)] = src[(size_t)(k0 + kk) * ld_src + c0 + (lane & 31)]; }
    LDS_WAIT(); asm volatile("" ::: "memory");
    const int c = lane & 7;
#pragma unroll
    for (int j = 0; j < 4; ++j) { const int n = (lane >> 3) + 8 * j; const LAS float* s = scr + (8 * c) * 33 + n;
        u32x4 o; o.x = pk2(s[0 * 33], s[1 * 33]); o.y = pk2(s[2 * 33], s[3 * 33]); o.z = pk2(s[4 * 33], s[5 * 33]); o.w = pk2(s[6 * 33], s[7 * 33]);
        *(u32x4*)(dst + (size_t)(drow0 + n) * ldd + k0 + 8 * c) = o; }
    LDS_WAIT(); asm volatile("" ::: "memory");
}
__device__ __forceinline__ void tr_matrix_item(const float* src, int ld_src, int K, int col_first, int ncols, bf16* dst, int drow_first, LAS float* scr, int it, int lane) {
    const int nblk = ncols / 32, kb = it / nblk, nb = it % nblk;
    tr_item(src, ld_src, kb * 64, col_first + nb * 32, dst, drow_first + nb * 32, K, scr, lane);
}
__device__ __forceinline__ void convert_x(Frame& F, const float* x, bf16* xb) {
    const size_t n8 = (size_t)MTOK * DM / 8; const size_t stride = (size_t)F.G * NTHR;
    for (size_t i = (size_t)F.vcu * NTHR + F.tid; i < n8; i += stride) {
        const f32x4 a = *(const f32x4*)(x + i * 8), b = *(const f32x4*)(x + i * 8 + 4);
        u32x4 o; o.x = pk2(a[0], a[1]); o.y = pk2(a[2], a[3]); o.z = pk2(b[0], b[1]); o.w = pk2(b[2], b[3]);
        *(u32x4*)(xb + i * 8) = o; }
}

__device__ __forceinline__ void hyena_filter(Frame& F) {
    const float* w1 = F.in[I_FW1]; const float* b1 = F.in[I_FB1]; const float* f1 = F.in[I_FF1];
    const float* w2 = F.in[I_FW2]; const float* b2 = F.in[I_FB2]; const float* f2 = F.in[I_FF2];
    const float* w3 = F.in[I_FW3]; const float* b3 = F.in[I_FB3]; const float* f3 = F.in[I_FF3];
    const float* w4 = F.in[I_FW4];
    bf16* KERN = (bf16*)(F.ws + WS_KERN);
    LAS float* hbuf = (LAS float*)(F.lds);
    const int lane = F.lane, wave = F.wave;
    for (int pg = F.vcu; pg < SEQ / 8; pg += F.G) {
        const int t = 8 * pg + wave;
        const float tn = (float)t / (float)(SEQ - 1), wv = 6.283185307179586f * (float)t / (float)SEQ;
        float zf = 0.f;
        if (lane == 0) zf = tn;
        else if (lane <= 16) { const float f = 1e-4f + (float)(lane - 1) * ((15.0f - 1e-4f) / 15.0f); zf = cosf(f * wv); }
        else if (lane <= 32) { const float f = 1e-4f + (float)(lane - 17) * ((15.0f - 1e-4f) / 15.0f); zf = -sinf(f * wv); }
        float s = b1[lane];
        for (int i = 0; i < 33; ++i) s += __shfl(zf, i) * w1[i * 64 + lane];
        float h = sinf(f1[lane] * s);
        s = b2[lane];
        for (int i = 0; i < 64; ++i) s += __shfl(h, i) * w2[i * 64 + lane];
        h = sinf(f2[lane] * s);
        s = b3[lane];
        for (int i = 0; i < 64; ++i) s += __shfl(h, i) * w3[i * 64 + lane];
        h = sinf(f3[lane] * s);
        hbuf[wave * 64 + lane] = h;
        __syncthreads();
        for (int q = 0; q < 8; ++q) {
            const int col = F.tid + 512 * q, c = col & 1023, dir = (col >> 10) & 1, o = col >> 11;
            float a[8];
#pragma unroll
            for (int p = 0; p < 8; ++p) a[p] = 0.f;
            float a0b = 0.f;
            for (int i = 0; i < 64; ++i) { const float w = w4[(size_t)i * 4096 + col];
#pragma unroll
                for (int p = 0; p < 8; ++p) a[p] += hbuf[p * 64 + i] * w;
                if (pg == 0 && dir == 0) a0b += hbuf[i] * w4[(size_t)i * 4096 + col + 1024]; }
            const float adel = 3.0701134573253945f + (float)c * ((15.350567286626973f - 3.0701134573253945f) / 1023.0f);
            bf16* kc = KERN + ((size_t)c * 2 + o) * 4096;
#pragma unroll
            for (int p = 0; p < 8; ++p) { const int tp = 8 * pg + p; const float v = a[p] * __expf(-((float)tp / (float)(SEQ - 1)) * adel);
                if (tp == 0) { if (dir == 0) { kc[2048] = (bf16)f2bf(v + a0b); kc[0] = 0; } }
                else kc[dir == 0 ? 2048 - tp : 2048 + tp] = (bf16)f2bf(v); }
        }
        __syncthreads();
    }
}

__device__ __forceinline__ void p0_prologue(Frame& F) {
    LAS float* scr = (LAS float*)(F.lds + 4096 + F.wave * 16384);
    const int gw = F.vcu * NWAVES + F.wave, NGW = F.G * NWAVES;
    hyena_filter(F);
    bf16* WINT = (bf16*)(F.ws + WS_WINT);
    constexpr int I_A = 16 * (9216 / 32), I_B = 16 * (64 / 32), I_C = 16 * (2048 / 32);
    constexpr int I_HY = 16 * 32, I_SS = 32 * 32, I_OUT = 16 * 32;
    constexpr int NITEMS = I_A + I_B + I_C + I_HY + I_SS + I_OUT;
    for (int it = gw; it < NITEMS; it += NGW) {
        int r = it;
        if (r < I_A) { tr_matrix_item(F.in[I_WIN], INC, DM, 0, 9216, WINT, 0, scr, r, F.lane); continue; } r -= I_A;
        if (r < I_B) { tr_matrix_item(F.in[I_WIN], INC, DM, 9216, 64, WINT, 9216, scr, r, F.lane); continue; } r -= I_B;
        if (r < I_C) { tr_matrix_item(F.in[I_WIN], INC, DM, 9280, 2048, WINT, 9472, scr, r, F.lane); continue; } r -= I_C;
        if (r < I_HY) { tr_matrix_item(F.in[I_WHYB], DM, DM, 0, DM, (bf16*)(F.ws + WS_WHYB), 0, scr, r, F.lane); continue; } r -= I_HY;
        if (r < I_SS) { tr_matrix_item(F.in[I_WSSDB], DM, DSSM, 0, DM, (bf16*)(F.ws + WS_WSSDB), 0, scr, r, F.lane); continue; } r -= I_SS;
        tr_matrix_item(F.in[I_WOUT], DM, DM, 0, DM, (bf16*)(F.ws + WS_WOUT), 0, scr, r, F.lane);
    }
    convert_x(F, F.in[I_X], (bf16*)(F.ws + WS_XB));
}
__device__ __forceinline__ void p6_reconvert(Frame& F) {
    LAS float* scr = (LAS float*)(F.lds + 4096 + F.wave * 16384);
    const int gw = F.vcu * NWAVES + F.wave, NGW = F.G * NWAVES;
    for (int it = gw; it < 16 * (2048 / 32); it += NGW) tr_matrix_item(F.in[I_WIN], INC, DM, 9280, 2048, (bf16*)(F.ws + WS_WING), 0, scr, it, F.lane);
    convert_x(F, F.in[I_X], (bf16*)(F.ws + WS_XB2));
}
__device__ __forceinline__ void p10_expert_weights(Frame& F) {
    LAS float* scr = (LAS float*)(F.lds + 4096 + F.wave * 16384);
    const int gw = F.vcu * NWAVES + F.wave, NGW = F.G * NWAVES;
    bf16* EW1 = (bf16*)(F.ws + WS_EW1); bf16* EW2 = (bf16*)(F.ws + WS_EW2);
    constexpr int PER1 = 16 * 4;
    constexpr int N1 = NEX * 2 * 2 * PER1, PER2 = 4 * 32, N2 = NEX * PER2;
    for (int it = gw; it < N1 + N2; it += NGW) {
        if (it < N1) { const int e = it / (4 * PER1), r0 = it % (4 * PER1), mat = r0 / (2 * PER1), r1 = r0 % (2 * PER1), ct = r1 / PER1, r2 = r1 % PER1;
            const float* src = (e < NE) ? F.in[mat ? I_EWU : I_EWG] + (size_t)e * DM * DEXP : F.in[mat ? I_SWU : I_SWG];
            tr_matrix_item(src, DEXP, DM, 128 * ct, 128, EW1 + (size_t)e * 512 * DM, 256 * ct + 128 * mat, scr, r2, F.lane); }
        else { const int r = it - N1, e = r / PER2, r2 = r % PER2;
            const float* src = (e < NE) ? F.in[I_EWD] + (size_t)e * DEXP * DM : F.in[I_SWD];
            tr_matrix_item(src, DM, DEXP, 0, DM, EW2 + (size_t)e * DM * DEXP, 0, scr, r2, F.lane); }
    }
}
__device__ __forceinline__ void p3_transpose(Frame& F) {
    const bf16* YT = (const bf16*)(F.ws + WS_YTHY); bf16* Y = (bf16*)(F.ws + WS_YHY);
    LAS bf16* scr = (LAS bf16*)(F.lds + F.wave * 9216);
    const int gw = F.vcu * NWAVES + F.wave, NGW = F.G * NWAVES, lane = F.lane;
    for (int tile = gw; tile < 16 * 512; tile += NGW) {
        const int c0 = (tile & 15) * 64, t0 = (tile >> 4) * 64;
#pragma unroll
        for (int p = 0; p < 8; ++p) { const int c = p * 8 + (lane >> 3), ch = lane & 7;
            const u32x4 g = *(const u32x4*)(YT + (size_t)(c0 + c) * MTOK + t0 + ch * 8);
            LAS bf16* d = scr + (ch * 8) * 72 + c;
            d[0 * 72] = (bf16)(g.x & 0xffff); d[1 * 72] = (bf16)(g.x >> 16); d[2 * 72] = (bf16)(g.y & 0xffff); d[3 * 72] = (bf16)(g.y >> 16);
            d[4 * 72] = (bf16)(g.z & 0xffff); d[5 * 72] = (bf16)(g.z >> 16); d[6 * 72] = (bf16)(g.w & 0xffff); d[7 * 72] = (bf16)(g.w >> 16); }
        LDS_WAIT(); asm volatile("" ::: "memory");
#pragma unroll
        for (int p = 0; p < 8; ++p) { const int tk = p * 8 + (lane >> 3), ch = lane & 7;
            const u32x4 v = *(const LAS u32x4*)(scr + tk * 72 + ch * 8);
            *(u32x4*)(Y + (size_t)(t0 + tk) * DM + c0 + ch * 8) = v; }
        LDS_WAIT(); asm volatile("" ::: "memory");
    }
}

constexpr int HY_LDU = 2064, HY_KCS = 4128, HY_U_BYTES = 16 * HY_LDU * 2, HY_KC_BYTES = 8 * HY_KCS * 2;

__device__ __forceinline__ void hy_build_kc(LAS bf16* KC, const bf16* kern, int tid) {
    const u32x4 g = *(const u32x4*)(kern + 8 * tid);
    const unsigned short e[8] = {(unsigned short)(g.x & 0xffff), (unsigned short)(g.x >> 16), (unsigned short)(g.y & 0xffff), (unsigned short)(g.y >> 16),
                                 (unsigned short)(g.z & 0xffff), (unsigned short)(g.z >> 16), (unsigned short)(g.w & 0xffff), (unsigned short)(g.w >> 16)};
#pragma unroll
    for (int fl = 0; fl < 8; ++fl)
#pragma unroll
        for (int j = 0; j < 8; ++j) KC[fl * HY_KCS + 8 * tid + j + fl] = e[j];
}
__device__ __forceinline__ f32x4 hy_short4(const bf16* prow, int t0, float w0, float w1, float w2, float cb) {
    const u32x2 g = *(const u32x2*)(prow + t0);
    const float p0 = bflo(g.x), p1 = bfhi(g.x), p2 = bflo(g.y), p3 = bfhi(g.y);
    const float pm = (t0 > 0) ? bf2f(prow[t0 - 1]) : 0.f, pp = (t0 + 4 < SEQ) ? bf2f(prow[t0 + 4]) : 0.f;
    f32x4 r; r[0] = cb + w0 * pm + w1 * p0 + w2 * p1; r[1] = cb + w0 * p0 + w1 * p1 + w2 * p2; r[2] = cb + w0 * p1 + w1 * p2 + w2 * p3; r[3] = cb + w0 * p2 + w1 * p3 + w2 * pp;
    return r;
}
__device__ __forceinline__ void hyena_phase(Frame& F) {
    LAS bf16* U = (LAS bf16*)(F.lds); LAS bf16* KC = (LAS bf16*)(F.lds + HY_U_BYTES);
    const bf16* PT = (const bf16*)(F.ws + WS_PTHY); const bf16* KERN = (const bf16*)(F.ws + WS_KERN); bf16* YT = (bf16*)(F.ws + WS_YTHY);
    const float* cw = F.in[I_HCW]; const float* cbv = F.in[I_HCB]; const float* hb = F.in[I_HBIAS];
    const int tid = F.tid, lane = F.lane, w = F.wave, fr = lane & 15, fq = lane >> 4;
    for (int c = F.vcu; c < DM; c += F.G) {
        hy_build_kc(KC, KERN + ((size_t)c * 2 + 0) * 4096, tid);
        { const int vc = 2048 + c; const float w0 = cw[0 * HYC + vc], w1 = cw[1 * HYC + vc], w2 = cw[2 * HYC + vc], cb = cbv[vc];
          const bf16* prow = PT + (size_t)vc * MTOK;
#pragma unroll 2
          for (int it = 0; it < 8; ++it) { const int idx = tid + 512 * it, b = idx >> 8, t8 = (idx & 255) * 8;
              const f32x4 lo = hy_short4(prow + (size_t)b * SEQ, t8, w0, w1, w2, cb), hi = hy_short4(prow + (size_t)b * SEQ, t8 + 4, w0, w1, w2, cb);
              u32x4 o; o.x = pk2(lo[0], lo[1]); o.y = pk2(lo[2], lo[3]); o.z = pk2(hi[0], hi[1]); o.w = pk2(hi[2], hi[3]);
              *(LAS u32x4*)(U + b * HY_LDU + t8) = o; } }
        __syncthreads();
#pragma unroll 1
        for (int o = 0; o < 2; ++o) {
            f32x4 acc[16];
#pragma unroll
            for (int i = 0; i < 16; ++i) acc[i] = (f32x4){0.f, 0.f, 0.f, 0.f};
            const LAS bf16* kbase = KC + (fr & 7) * HY_KCS + 2048 + 8 * fq - 8 * (fr >> 3) - 256 * w;
            const LAS bf16* ubase = U + fr * HY_LDU + 8 * fq;
            bf16x8 win[16];
#pragma unroll
            for (int i = 0; i < 16; ++i) win[i] = *(const LAS bf16x8*)(kbase - 16 * i);
#pragma unroll 1
            for (int sj8 = 0; sj8 < 64; sj8 += 8) {
#pragma unroll
                for (int u = 0; u < 8; ++u) { const int sj = sj8 + u;
                    const bf16x8 bfr = *(const LAS bf16x8*)(ubase + 32 * sj);
#pragma unroll
                    for (int tt = 0; tt < 16; ++tt) acc[tt] = __builtin_amdgcn_mfma_f32_16x16x32_bf16(win[(tt - 2 * u) & 15], bfr, acc[tt], 0, 0, 0);
                    win[(14 - 2 * u) & 15] = *(const LAS bf16x8*)(kbase + 16 * (2 * sj + 2));
                    win[(15 - 2 * u) & 15] = *(const LAS bf16x8*)(kbase + 16 * (2 * sj + 1));
                } }
            const float hbias = hb[o * DM + c];
            const int gc = (o == 0) ? c : 1024 + c;
            const float w0 = cw[0 * HYC + gc], w1 = cw[1 * HYC + gc], w2 = cw[2 * HYC + gc], cb = cbv[gc];
            const bf16* grow = PT + (size_t)gc * MTOK + (size_t)fr * SEQ;
            u32x2 zpk[16];
#pragma unroll
            for (int tt = 0; tt < 16; ++tt) { const int t0 = 256 * w + 16 * tt + 4 * fq;
                const u32x2 uu = *(const LAS u32x2*)(U + fr * HY_LDU + t0);
                const f32x4 g = hy_short4(grow, t0, w0, w1, w2, cb);
                f32x4 y = acc[tt]; y[0] = g[0] * (y[0] + bflo(uu.x) * hbias); y[1] = g[1] * (y[1] + bfhi(uu.x) * hbias); y[2] = g[2] * (y[2] + bflo(uu.y) * hbias); y[3] = g[3] * (y[3] + bfhi(uu.y) * hbias);
                zpk[tt].x = pk2(y[0], y[1]); zpk[tt].y = pk2(y[2], y[3]); }
            __syncthreads();
            if (o == 0) {
#pragma unroll
                for (int tt = 0; tt < 16; ++tt) *(LAS u32x2*)(U + fr * HY_LDU + 256 * w + 16 * tt + 4 * fq) = zpk[tt];
                hy_build_kc(KC, KERN + ((size_t)c * 2 + 1) * 4096, tid);
                __syncthreads();
            } else {
                bf16* yrow = YT + (size_t)c * MTOK + (size_t)fr * SEQ + 256 * w + 4 * fq;
#pragma unroll
                for (int tt = 0; tt < 16; ++tt) *(u32x2*)(yrow + 16 * tt) = zpk[tt];
            }
        }
    }
}

__device__ __forceinline__ void ssd_conv_phase(Frame& F) {
    bf16* XBC = (bf16*)(F.ws + WS_XBC); const bf16* HALO = (const bf16*)(F.ws + WS_HALO);
    const float* scw = F.in[I_SCW]; const float* scb = F.in[I_SCB];
    const int gw = F.vcu * NWAVES + F.wave, NGW = F.G * NWAVES, lane = F.lane;
    for (int item = gw; item < BATCH * 32 * 8; item += NGW) {
        const int cb8 = item & 7, seg = (item >> 3) & 31, b = item >> 8, col = cb8 * 512 + lane * 8;
        float wk[5][8], cbv[8];
#pragma unroll
        for (int k = 0; k < 5; ++k) { const f32x4 a = *(const f32x4*)(scw + k * CONVD + col), c = *(const f32x4*)(scw + k * CONVD + col + 4);
#pragma unroll
            for (int e = 0; e < 4; ++e) { wk[k][e] = a[e]; wk[k][4 + e] = c[e]; } }
        { const f32x4 a = *(const f32x4*)(scb + col), c = *(const f32x4*)(scb + col + 4);
#pragma unroll
          for (int e = 0; e < 4; ++e) { cbv[e] = a[e]; cbv[4 + e] = c[e]; } }
        bf16* xrow0 = XBC + ((size_t)b * SEQ + seg * 64) * CONVD + col;
        const bf16* hlo = HALO + ((size_t)(b * 33 + seg) * 4) * CONVD + col;
        const bf16* hhi = HALO + ((size_t)(b * 33 + seg + 1) * 4 + 2) * CONVD + col;
        const u32x4 zero4 = {0u, 0u, 0u, 0u};
        u32x4 W[12];
        W[0] = seg > 0 ? *(const u32x4*)(hlo) : zero4; W[1] = seg > 0 ? *(const u32x4*)(hlo + CONVD) : zero4;
        W[2] = *(const u32x4*)(xrow0); W[3] = *(const u32x4*)(xrow0 + CONVD);
#pragma unroll 1
        for (int blk = 0; blk < 8; ++blk) { const int r0 = 8 * blk;
#pragma unroll
            for (int i = 4; i < 12; ++i) { const int rr = r0 - 2 + i;
                if (rr < 64) W[i] = *(const u32x4*)(xrow0 + (size_t)rr * CONVD);
                else W[i] = (seg < 31) ? *(const u32x4*)(hhi + (size_t)(rr - 64) * CONVD) : zero4; }
#pragma unroll
            for (int o = 0; o < 8; ++o) { float v[8];
#pragma unroll
                for (int e = 0; e < 8; ++e) v[e] = cbv[e];
#pragma unroll
                for (int k = 0; k < 5; ++k) { const u32x4 p = W[o + k];
                    v[0] += wk[k][0] * bflo(p.x); v[1] += wk[k][1] * bfhi(p.x); v[2] += wk[k][2] * bflo(p.y); v[3] += wk[k][3] * bfhi(p.y);
                    v[4] += wk[k][4] * bflo(p.z); v[5] += wk[k][5] * bfhi(p.z); v[6] += wk[k][6] * bflo(p.w); v[7] += wk[k][7] * bfhi(p.w); }
#pragma unroll
                for (int e = 0; e < 8; ++e) v[e] = siluf_(v[e]);
                u32x4 ov; ov.x = pk2(v[0], v[1]); ov.y = pk2(v[2], v[3]); ov.z = pk2(v[4], v[5]); ov.w = pk2(v[6], v[7]);
                *(u32x4*)(xrow0 + (size_t)(r0 + o) * CONVD) = ov; }
#pragma unroll
            for (int i = 0; i < 4; ++i) W[i] = W[8 + i];
        }
    }
}

constexpr int SS_LDC = 144, SS_LDT = 80;
constexpr int SS_C = 0, SS_B = 18432, SS_BT = 36864, SS_M = 57344, SS_XD = 77824, SS_XE = 98304, SS_SB = 118784, SS_ACS = 155648, SS_DTV = 156672, SS_TOE = 157696, SS_END = 158720;
static_assert(SS_END <= MISC_OFF, "SSD LDS map");

template <int KS>
__device__ __forceinline__ f32x4 mma16(const LAS bf16* arow, const LAS bf16* brow, f32x4 acc) {
    bf16x8 a[KS], b[KS];
#pragma unroll
    for (int kk = 0; kk < KS; ++kk) { a[kk] = *(const LAS bf16x8*)(arow + 32 * kk); b[kk] = *(const LAS bf16x8*)(brow + 32 * kk); }
#pragma unroll
    for (int kk = 0; kk < KS; ++kk) acc = __builtin_amdgcn_mfma_f32_16x16x32_bf16(a[kk], b[kk], acc, 0, 0, 0);
    return acc;
}

__device__ __forceinline__ void ssd_phase(Frame& F) {
    LAS unsigned char* L = F.lds;
    LAS bf16* Cl = (LAS bf16*)(L + SS_C); LAS bf16* Bl = (LAS bf16*)(L + SS_B); LAS bf16* BT = (LAS bf16*)(L + SS_BT); LAS bf16* Ml = (LAS bf16*)(L + SS_M);
    LAS bf16* XD = (LAS bf16*)(L + SS_XD); LAS bf16* XE = (LAS bf16*)(L + SS_XE); LAS bf16* SB = (LAS bf16*)(L + SS_SB);
    LAS float* ACS = (LAS float*)(L + SS_ACS); LAS float* DTV = (LAS float*)(L + SS_DTV); LAS float* TOE = (LAS float*)(L + SS_TOE);
    const bf16* XBC = (const bf16*)(F.ws + WS_XBC); const float* DT = (const float*)(F.ws + WS_DT); const bf16* Zb = (const bf16*)F.out; bf16* YS = (bf16*)(F.ws + WS_YSSD);
    const float* dtb = F.in[I_DTB]; const float* alog = F.in[I_ALOG]; const float* sd = F.in[I_SD];
    const int tid = F.tid, lane = F.lane, w = F.wave, fr = lane & 15, fq = lane >> 4;
    for (int unit = F.vcu; unit < BATCH * NGRP * 2; unit += F.G) {
        const int b = unit >> 4, g = (unit >> 1) & 7, hp = unit & 1, h0 = 4 * g + 2 * hp;
#pragma unroll 1
        for (int dir = 0; dir < 2; ++dir) {
            const float dtbias = (w < 2) ? dtb[dir * 32 + h0 + w] : 0.f, aexp = (w < 2) ? __expf(alog[dir * 32 + h0 + w]) : 0.f;
            auto scan = [&](int buf, float raw) {
                raw += dtbias; const float dtv = raw > 20.f ? raw : log1pf(__expf(raw)); float a = -dtv * aexp;
#pragma unroll
                for (int o = 1; o < 64; o <<= 1) { const float v = __shfl_up(a, o); if (lane >= o) a += v; }
                const float tot = __shfl(a, 63); const int ix = (buf * 2 + w) * 64 + lane;
                ACS[ix] = a; DTV[ix] = dtv; TOE[ix] = __expf(tot - a); };
            auto dtload = [&](int ci) -> float { const int ch = dir ? 31 - ci : ci, r = dir ? 63 - lane : lane;
                return DT[((size_t)b * SEQ + 64 * ch + r) * 64 + dir * 32 + h0 + w]; };
            auto rowload = [&](int ci, int it, int tl) -> u32x4 { const int cg = (tl >> 6) + 8 * it, l = tl & 63, ch = dir ? 31 - ci : ci, r = dir ? 63 - l : l, lc0 = cg * 8;
                const int col = lc0 < 128 ? 64 * h0 + lc0 : (lc0 < 256 ? 2048 + 128 * g + (lc0 - 128) : 3072 + 128 * g + (lc0 - 256));
                return *(const u32x4*)(XBC + ((size_t)b * SEQ + 64 * ch + r) * CONVD + col); };
            f32x4 Sacc[8];
#pragma unroll
            for (int i = 0; i < 8; ++i) Sacc[i] = (f32x4){0.f, 0.f, 0.f, 0.f};
            const float dsk = sd[h0 + (w >> 2)];
            __syncthreads();
            for (int i = tid; i < 2 * 64 * SS_LDC / 2; i += NTHR) ((LAS unsigned*)SB)[i] = 0u;
            float dtn = 0.f;
            if (w < 2) { scan(0, dtload(0)); dtn = dtload(1); }
            u32x4 pf[6];
#pragma unroll
            for (int it = 0; it < 6; ++it) pf[it] = rowload(0, it, tid);
            __syncthreads();
#pragma unroll 1
            for (int ci = 0; ci < 32; ++ci) {
                const int ch = dir ? 31 - ci : ci, buf = ci & 1;
                const size_t tokbase = (size_t)b * SEQ + 64 * ch;
                int tl = tid; asm volatile("" : "+v"(tl));
                const LAS float* acs = ACS + buf * 128; const LAS float* dtv = DTV + buf * 128; const LAS float* toe = TOE + buf * 128;
#pragma unroll
                for (int it = 0; it < 6; ++it) { const int cg = (tl >> 6) + 8 * it, l = tl & 63; const u32x4 p = pf[it];
                    if (it < 2) { const int hh = cg >> 3, p0 = (cg & 7) * 8; const float d = dtv[hh * 64 + l], de = d * toe[hh * 64 + l];
                        const float v[8] = {bflo(p.x), bfhi(p.x), bflo(p.y), bfhi(p.y), bflo(p.z), bfhi(p.z), bflo(p.w), bfhi(p.w)};
#pragma unroll
                        for (int e = 0; e < 8; ++e) { XD[(hh * 64 + p0 + e) * SS_LDT + l] = (bf16)f2bf(v[e] * d); XE[(hh * 64 + p0 + e) * SS_LDT + l] = (bf16)f2bf(v[e] * de); } }
                    else if (it < 4) { const int n0 = (cg - 16) * 8; *(LAS u32x4*)(Bl + l * SS_LDC + n0) = p;
                        LAS bf16* d = BT + n0 * SS_LDT + l;
                        d[0 * SS_LDT] = (bf16)(p.x & 0xffff); d[1 * SS_LDT] = (bf16)(p.x >> 16); d[2 * SS_LDT] = (bf16)(p.y & 0xffff); d[3 * SS_LDT] = (bf16)(p.y >> 16);
                        d[4 * SS_LDT] = (bf16)(p.z & 0xffff); d[5 * SS_LDT] = (bf16)(p.z >> 16); d[6 * SS_LDT] = (bf16)(p.w & 0xffff); d[7 * SS_LDT] = (bf16)(p.w >> 16); }
                    else { const int n0 = (cg - 32) * 8; *(LAS u32x4*)(Cl + l * SS_LDC + n0) = p; } }
                if (ci + 1 < 32) {
#pragma unroll
                    for (int it = 0; it < 6; ++it) pf[it] = rowload(ci + 1, it, tl); }
                __syncthreads();
                const int hh = w >> 2, li = w & 3, lrow = 16 * li + fr;
                const int rloc = dir ? 63 - lrow : lrow; const size_t tok = tokbase + rloc;
                u32x2 pv[4], zv[4];
                if (dir) {
#pragma unroll
                    for (int pi = 0; pi < 4; ++pi) { const size_t o = tok * DSSM + 64 * (h0 + hh) + 16 * pi + 4 * fq; pv[pi] = *(const u32x2*)(YS + o); zv[pi] = *(const u32x2*)(Zb + o); } }
#pragma unroll
                for (int q = 0; q < 2; ++q) { const int id = 2 * w + q, si = id >> 2, lj = id & 3, l = 16 * lj + fr, s0 = 16 * si + 4 * fq;
                    u32x2 m0 = {0u, 0u}, m1 = {0u, 0u};
                    if (si <= lj) { f32x4 cb = (f32x4){0.f, 0.f, 0.f, 0.f};
                        cb = mma16<4>(Bl + (16 * si + fr) * SS_LDC + 8 * fq, Cl + (16 * lj + fr) * SS_LDC + 8 * fq, cb);
                        const float a0 = acs[l], a1 = acs[64 + l]; float x0[4], x1[4];
#pragma unroll
                        for (int j = 0; j < 4; ++j) { const int s = s0 + j; x0[j] = (s <= l) ? cb[j] * __expf(a0 - acs[s]) : 0.f; x1[j] = (s <= l) ? cb[j] * __expf(a1 - acs[64 + s]) : 0.f; }
                        m0.x = pk2(x0[0], x0[1]); m0.y = pk2(x0[2], x0[3]); m1.x = pk2(x1[0], x1[1]); m1.y = pk2(x1[2], x1[3]); }
                    *(LAS u32x2*)(Ml + (0 * 64 + l) * SS_LDT + s0) = m0; *(LAS u32x2*)(Ml + (1 * 64 + l) * SS_LDT + s0) = m1; }
                f32x4 Y[4];
                { bf16x8 cfr[4];
#pragma unroll
                  for (int kk = 0; kk < 4; ++kk) cfr[kk] = *(const LAS bf16x8*)(Cl + lrow * SS_LDC + 8 * fq + 32 * kk);
#pragma unroll
                  for (int pi = 0; pi < 4; ++pi) { Y[pi] = (f32x4){0.f, 0.f, 0.f, 0.f}; const LAS bf16* ar = SB + (hh * 64 + 16 * pi + fr) * SS_LDC + 8 * fq;
#pragma unroll
                      for (int kk = 0; kk < 4; ++kk) Y[pi] = __builtin_amdgcn_mfma_f32_16x16x32_bf16(*(const LAS bf16x8*)(ar + 32 * kk), cfr[kk], Y[pi], 0, 0, 0); } }
                __syncthreads();
                { const float el = __expf(acs[hh * 64 + lrow]);
                  const float dinv = __builtin_amdgcn_rcpf(dtv[hh * 64 + lrow]);
                  const bf16x8 mf0 = *(const LAS bf16x8*)(Ml + (hh * 64 + lrow) * SS_LDT + 8 * fq), mf1 = *(const LAS bf16x8*)(Ml + (hh * 64 + lrow) * SS_LDT + 8 * fq + 32);
#pragma unroll
                  for (int pi = 0; pi < 4; ++pi) { Y[pi] = Y[pi] * el; const LAS bf16* ar = XD + (hh * 64 + 16 * pi + fr) * SS_LDT + 8 * fq;
                      Y[pi] = __builtin_amdgcn_mfma_f32_16x16x32_bf16(*(const LAS bf16x8*)(ar), mf0, Y[pi], 0, 0, 0);
                      Y[pi] = __builtin_amdgcn_mfma_f32_16x16x32_bf16(*(const LAS bf16x8*)(ar + 32), mf1, Y[pi], 0, 0, 0);
                      const int p0 = 16 * pi + 4 * fq; bf16* yp = YS + tok * DSSM + 64 * (h0 + hh) + p0; f32x4 y = Y[pi];
                      if (dir == 0) {
#pragma unroll
                          for (int j = 0; j < 4; ++j) y[j] += dsk * dinv * bf2f(XD[(hh * 64 + p0 + j) * SS_LDT + lrow]);
                      } else { const u32x2 pvv = pv[pi], zvv = zv[pi];
                          y[0] = (y[0] + bflo(pvv.x)) * siluf_(bflo(zvv.x)); y[1] = (y[1] + bfhi(pvv.x)) * siluf_(bfhi(zvv.x)); y[2] = (y[2] + bflo(pvv.y)) * siluf_(bflo(zvv.y)); y[3] = (y[3] + bfhi(pvv.y)) * siluf_(bfhi(zvv.y)); }
                      u32x2 o; o.x = pk2(y[0], y[1]); o.y = pk2(y[2], y[3]); *(u32x2*)yp = o; } }
                { const int pi = w & 3; const float dec = __expf(acs[hh * 64 + 63]);
                  const bf16x8 xf0 = *(const LAS bf16x8*)(XE + (hh * 64 + 16 * pi + fr) * SS_LDT + 8 * fq), xf1 = *(const LAS bf16x8*)(XE + (hh * 64 + 16 * pi + fr) * SS_LDT + 8 * fq + 32);
#pragma unroll
                  for (int ni = 0; ni < 8; ++ni) { Sacc[ni] = Sacc[ni] * dec; const LAS bf16* ar = BT + (16 * ni + fr) * SS_LDT + 8 * fq;
                      Sacc[ni] = __builtin_amdgcn_mfma_f32_16x16x32_bf16(*(const LAS bf16x8*)(ar), xf0, Sacc[ni], 0, 0, 0);
                      Sacc[ni] = __builtin_amdgcn_mfma_f32_16x16x32_bf16(*(const LAS bf16x8*)(ar + 32), xf1, Sacc[ni], 0, 0, 0);
                      u32x2 o; o.x = pk2(Sacc[ni][0], Sacc[ni][1]); o.y = pk2(Sacc[ni][2], Sacc[ni][3]);
                      *(LAS u32x2*)(SB + (hh * 64 + 16 * pi + fr) * SS_LDC + 16 * ni + 4 * fq) = o; } }
                if (w < 2 && ci + 1 < 32) { scan(buf ^ 1, dtn); if (ci + 2 < 32) dtn = dtload(ci + 2); }
                __syncthreads();
            }
        }
    }
}

__device__ __forceinline__ void ssd_norm_phase(Frame& F) {
    bf16* YS = (bf16*)(F.ws + WS_YSSD); const float* nw = F.in[I_SNW];
    const int gw = F.vcu * NWAVES + F.wave, NGW = F.G * NWAVES, lane = F.lane;
    for (int m = gw; m < MTOK; m += NGW) { bf16* row = YS + (size_t)m * DSSM + lane * 32;
        u32x4 v[4]; float ss = 0.f;
#pragma unroll
        for (int j = 0; j < 4; ++j) { v[j] = *(const u32x4*)(row + 8 * j);
            const float a0 = bflo(v[j].x), a1 = bfhi(v[j].x), a2 = bflo(v[j].y), a3 = bfhi(v[j].y), a4 = bflo(v[j].z), a5 = bfhi(v[j].z), a6 = bflo(v[j].w), a7 = bfhi(v[j].w);
            ss += (a0 * a0 + a1 * a1) + (a2 * a2 + a3 * a3) + (a4 * a4 + a5 * a5) + (a6 * a6 + a7 * a7); }
        ss += __shfl_xor(ss, 1); ss += __shfl_xor(ss, 2); ss += __shfl_xor(ss, 4);
        const float rs = 1.0f / sqrtf(ss * (1.0f / 256.0f) + RMS_EPS);
#pragma unroll
        for (int j = 0; j < 4; ++j) { const f32x4 w0 = *(const f32x4*)(nw + lane * 32 + 8 * j), w1 = *(const f32x4*)(nw + lane * 32 + 8 * j + 4);
            u32x4 o; o.x = pk2(bflo(v[j].x) * rs * w0[0], bfhi(v[j].x) * rs * w0[1]); o.y = pk2(bflo(v[j].y) * rs * w0[2], bfhi(v[j].y) * rs * w0[3]);
            o.z = pk2(bflo(v[j].z) * rs * w1[0], bfhi(v[j].z) * rs * w1[1]); o.w = pk2(bflo(v[j].w) * rs * w1[2], bfhi(v[j].w) * rs * w1[3]);
            *(u32x4*)(row + 8 * j) = o; } }
}

constexpr int RT_WC = 131072;
__device__ __forceinline__ void ln1_router_phase(Frame& F) {
    float* H1 = (float*)(F.ws + WS_H1); bf16* H1B = (bf16*)(F.ws + WS_H1B);
    int* TOK = (int*)(F.ws + WS_TOK); float* WGT = (float*)(F.ws + WS_WGT); int* ASG = (int*)(F.ws + WS_ASG);
    const float* g1 = F.in[I_LN1G]; const float* b1 = F.in[I_LN1B]; const float* rw = F.in[I_RW]; const float* rb = F.in[I_RB];
    LAS float* hrow = (LAS float*)(F.lds + F.wave * 16384);
    LAS float* wc = (LAS float*)(F.lds + RT_WC);
    const int lane = F.lane, tid = F.tid;
    f32x4 gv[4], bv[4];
#pragma unroll
    for (int j = 0; j < 4; ++j) { gv[j] = *(const f32x4*)(g1 + 4 * lane + 256 * j); bv[j] = *(const f32x4*)(b1 + 4 * lane + 256 * j); }
    const float rbias = rb[lane];
    for (int step = F.vcu; step < MTOK / 32; step += F.G) {
        const int rg = step * 8 + F.wave;
        f32x4 nx0 = *(const f32x4*)(rw + tid * 4), nx1 = *(const f32x4*)(rw + 2048 + tid * 4);
#pragma unroll 1
        for (int r = 0; r < 4; ++r) { const size_t m = (size_t)rg * 4 + r; float* xr = H1 + m * DM;
            f32x4 v[4]; float s = 0.f;
#pragma unroll
            for (int j = 0; j < 4; ++j) { v[j] = *(const f32x4*)(xr + 4 * lane + 256 * j); s += (v[j][0] + v[j][1]) + (v[j][2] + v[j][3]); }
            const float mean = wave_sum(s) * (1.f / DM); float s2 = 0.f;
#pragma unroll
            for (int j = 0; j < 4; ++j) { v[j] = v[j] - mean; s2 += (v[j][0] * v[j][0] + v[j][1] * v[j][1]) + (v[j][2] * v[j][2] + v[j][3] * v[j][3]); }
            const float rstd = 1.f / sqrtf(wave_sum(s2) * (1.f / DM) + LN_EPS);
#pragma unroll
            for (int j = 0; j < 4; ++j) { const f32x4 h = v[j] * rstd * gv[j] + bv[j];
                *(f32x4*)(xr + 4 * lane + 256 * j) = h * DN_ALPHA;
                u32x2 o; o.x = pk2(h[0], h[1]); o.y = pk2(h[2], h[3]); *(u32x2*)(H1B + m * DM + 4 * lane + 256 * j) = o;
                *(LAS f32x4*)(hrow + r * 1024 + 4 * lane + 256 * j) = h; } }
        float lg[4] = {0.f, 0.f, 0.f, 0.f};
#pragma unroll 1
        for (int kc = 0; kc < 16; ++kc) {
            __syncthreads();
            *(LAS f32x4*)(wc + tid * 4) = nx0; *(LAS f32x4*)(wc + 2048 + tid * 4) = nx1;
            if (kc + 1 < 16) { nx0 = *(const f32x4*)(rw + (kc + 1) * 4096 + tid * 4); nx1 = *(const f32x4*)(rw + (kc + 1) * 4096 + 2048 + tid * 4); }
            __syncthreads();
#pragma unroll 4
            for (int kk = 0; kk < 64; kk += 4) {
                const float w0 = wc[(kk + 0) * 64 + lane], w1 = wc[(kk + 1) * 64 + lane], w2 = wc[(kk + 2) * 64 + lane], w3 = wc[(kk + 3) * 64 + lane];
#pragma unroll
                for (int r = 0; r < 4; ++r) { const f32x4 h = *(const LAS f32x4*)(hrow + r * 1024 + kc * 64 + kk); lg[r] += h[0] * w0 + h[1] * w1 + h[2] * w2 + h[3] * w3; } }
        }
#pragma unroll 1
        for (int r = 0; r < 4; ++r) { const int m = rg * 4 + r;
            const float score = 1.0f / (1.0f + expf(-lg[r])), biased = score + rbias;
            float m1 = biased; m1 = fmaxf(m1, __shfl_xor(m1, 1)); m1 = fmaxf(m1, __shfl_xor(m1, 2)); m1 = fmaxf(m1, __shfl_xor(m1, 4));
            const unsigned long long eq = __ballot(biased == m1); const int gbase = lane & ~7; const int first = gbase + __ffs((unsigned)((eq >> gbase) & 0xffull)) - 1;
            float v2 = (lane == first) ? -INFINITY : biased; v2 = fmaxf(v2, __shfl_xor(v2, 1)); v2 = fmaxf(v2, __shfl_xor(v2, 2)); v2 = fmaxf(v2, __shfl_xor(v2, 4));
            const float gs = m1 + v2; const int g = lane >> 3; int better = 0;
#pragma unroll
            for (int d = 1; d < 8; ++d) { const int g2 = (g + d) & 7; const float og = __shfl(gs, g2 * 8); better += (og > gs || (og == gs && g2 < g)) ? 1 : 0; }
            float masked = (better < 4) ? biased : -INFINITY; bool sel = false;
#pragma unroll 1
            for (int it = 0; it < TOPK; ++it) { const float mx = wave_max(masked); const unsigned long long bm = __ballot(masked == mx); const int win = __ffsll((long long)bm) - 1;
                if (lane == win) { sel = true; masked = -INFINITY; } }
            const float sw = wave_sum(sel ? score : 0.f);
            const unsigned long long selm = __ballot(sel);
            if (sel) { const unsigned pos = __hip_atomic_fetch_add((unsigned*)(F.ctl + CW_CNT + 64 * lane), 1u, __ATOMIC_RELAXED, __HIP_MEMORY_SCOPE_AGENT);
                TOK[(size_t)lane * MTOK + pos] = m; WGT[(size_t)lane * MTOK + pos] = score / sw * ROUTED_SCALE;
                ASG[(size_t)m * 8 + __popcll(selm & ((1ull << lane) - 1ull))] = lane * MTOK + (int)pos; } }
    }
}
constexpr int MOE_TP = 131072 + 1024, MOE_CNT = MOE_TP + 512;
__device__ __forceinline__ int moe_table(Frame& F) {
    LAS int* tp = (LAS int*)(F.lds + MOE_TP); LAS int* cnt = (LAS int*)(F.lds + MOE_CNT);
    __syncthreads();
    if (F.tid == 0) { int run = 0;
        for (int e = 0; e < NEX; ++e) { const int c = (e < NE) ? (int)__hip_atomic_load((unsigned*)(F.ctl + CW_CNT + 64 * e), __ATOMIC_RELAXED, __HIP_MEMORY_SCOPE_AGENT) : MTOK;
            cnt[e] = c; tp[e] = run; run += (c + 255) >> 8; }
        tp[NEX] = run; }
    __syncthreads();
    return tp[NEX];
}
template <bool LAST>
__device__ __forceinline__ void moe_combine_phase(Frame& F, int q) {
    float* H1 = (float*)(F.ws + WS_H1); const bf16* YQ = (const bf16*)(F.ws + WS_YQ); const int* ASG = (const int*)(F.ws + WS_ASG); const float* WGT = (const float*)(F.ws + WS_WGT);
    const LAS int* tp = (const LAS int*)(F.lds + MOE_TP);
    const float* g2 = F.in[I_LN2G]; const float* b2 = F.in[I_LN2B];
    const int gw = F.vcu * NWAVES + F.wave, NGW = F.G * NWAVES, lane = F.lane;
    const size_t shbase = (size_t)tp[NE] * 256;
    for (int m = gw; m < MTOK; m += NGW) {
        int li = 0; if (lane < 8) li = ASG[(size_t)m * 8 + lane];
        float wk = 0.f; if (lane < 8) wk = WGT[li];
        const int e = li >> 15, pos = li & 32767; const int slot = 256 * tp[e] + pos;
        float* hp = H1 + (size_t)m * DM + 256 * q + 4 * lane;
        f32x4 acc = *(const f32x4*)hp;
        { const u32x2 v = *(const u32x2*)(YQ + (shbase + m) * 256 + 4 * lane); acc[0] += bflo(v.x); acc[1] += bfhi(v.x); acc[2] += bflo(v.y); acc[3] += bfhi(v.y); }
#pragma unroll
        for (int k = 0; k < 8; ++k) { const int sk = __shfl(slot, k); const float w = __shfl(wk, k);
            const u32x2 v = *(const u32x2*)(YQ + (size_t)sk * 256 + 4 * lane); acc[0] += w * bflo(v.x); acc[1] += w * bfhi(v.x); acc[2] += w * bflo(v.y); acc[3] += w * bfhi(v.y); }
        if (!LAST) { *(f32x4*)hp = acc; }
        else { const float* xr = H1 + (size_t)m * DM; f32x4 v[4]; float s = 0.f;
#pragma unroll
            for (int j = 0; j < 3; ++j) v[j] = *(const f32x4*)(xr + 4 * lane + 256 * j);
            v[3] = acc;
#pragma unroll
            for (int j = 0; j < 4; ++j) s += (v[j][0] + v[j][1]) + (v[j][2] + v[j][3]);
            const float mean = wave_sum(s) * (1.f / DM); float s2 = 0.f;
#pragma unroll
            for (int j = 0; j < 4; ++j) { v[j] = v[j] - mean; s2 += (v[j][0] * v[j][0] + v[j][1] * v[j][1]) + (v[j][2] * v[j][2] + v[j][3] * v[j][3]); }
            const float rstd = 1.f / sqrtf(wave_sum(s2) * (1.f / DM) + LN_EPS);
#pragma unroll
            for (int j = 0; j < 4; ++j) { const f32x4 gv = *(const f32x4*)(g2 + 4 * lane + 256 * j), bv = *(const f32x4*)(b2 + 4 * lane + 256 * j);
                *(f32x4*)(F.out + (size_t)m * DM + 4 * lane + 256 * j) = v[j] * rstd * gv + bv; } }
    }
}
__device__ __forceinline__ void ln2_phase(Frame& F) {
    const float* H1 = (const float*)(F.ws + WS_H1); const float* g2 = F.in[I_LN2G]; const float* b2 = F.in[I_LN2B];
    const int gw = F.vcu * NWAVES + F.wave, NGW = F.G * NWAVES, lane = F.lane;
    f32x4 gv[4], bv[4];
#pragma unroll
    for (int j = 0; j < 4; ++j) { gv[j] = *(const f32x4*)(g2 + 4 * lane + 256 * j); bv[j] = *(const f32x4*)(b2 + 4 * lane + 256 * j); }
    for (int m = gw; m < MTOK; m += NGW) { const float* xr = H1 + (size_t)m * DM;
        f32x4 v[4]; float s = 0.f;
#pragma unroll
        for (int j = 0; j < 4; ++j) { v[j] = *(const f32x4*)(xr + 4 * lane + 256 * j); s += (v[j][0] + v[j][1]) + (v[j][2] + v[j][3]); }
        const float mean = wave_sum(s) * (1.f / DM); float s2 = 0.f;
#pragma unroll
        for (int j = 0; j < 4; ++j) { v[j] = v[j] - mean; s2 += (v[j][0] * v[j][0] + v[j][1] * v[j][1]) + (v[j][2] * v[j][2] + v[j][3] * v[j][3]); }
        const float rstd = 1.f / sqrtf(wave_sum(s2) * (1.f / DM) + LN_EPS);
#pragma unroll
        for (int j = 0; j < 4; ++j) *(f32x4*)(F.out + (size_t)m * DM + 4 * lane + 256 * j) = v[j] * rstd * gv[j] + bv[j]; }
}

#ifndef MK_N_LAUNCHES
#define MK_N_LAUNCHES 1
#endif
constexpr int NPH = 15;
constexpr int N_LAUNCHES = MK_N_LAUNCHES;

__global__ void __launch_bounds__(NTHR, 2) fwd_kernel(Args args) {
    extern __shared__ __attribute__((aligned(16))) unsigned char lds_raw[];
    Frame F;
    F.lds = (LAS unsigned char*)lds_raw;
    F.MISC = (volatile LAS unsigned*)(F.lds + MISC_OFF);
    F.tid = threadIdx.x; F.lane = F.tid & 63; F.wave = __builtin_amdgcn_readfirstlane(F.tid >> 6);
    F.G = gridDim.x; { const int bx = blockIdx.x; F.vcu = (F.G % 8 == 0) ? (bx % 8) * (F.G / 8) + bx / 8 : bx; }
    F.ws = args.ws; F.ctl = (gu32*)(args.ws + WS_CTL); F.in = args.in; F.out = args.out;
    for (int u = F.tid; u < (LDS_BYTES - MISC_OFF) / 4; u += NTHR) ((LAS unsigned*)(F.lds + MISC_OFF))[u] = 0u;
    __syncthreads();
    XcdBarrier bar; bar.bar = (unsigned*)(F.ctl + CW_BAR); bar.x = 0; bar.st = nullptr;
    if (N_LAUNCHES != NPH) bar = xcd_barrier_post((unsigned*)(F.ctl + CW_BAR), F.MISC + 8);
    const int lo = args.ph_lo, hi = args.ph_hi;
#ifndef PH_MASK
#define PH_MASK 0x7fff
#endif
#define IN(k) ((((PH_MASK) >> (k)) & 1) && lo <= (k) && (k) < hi)
#define SEAM(k) do { if (IN(k) && IN((k) + 1)) xcd_barrier(bar); } while (0)
#ifndef REP_MASK
#define REP_MASK 0
#endif
#define REPS(k) for (int rep_ = 0; rep_ < ((((REP_MASK) >> (k)) & 1) ? 2 : 1); ++rep_, ((((REP_MASK) >> (k)) & 1) && rep_ == 1 ? xcd_barrier(bar) : (void)0))
    const int G = F.G, bx = (int)blockIdx.x;

    if (IN(0)) REPS(0) { p0_prologue(F); } SEAM(0);
    if (IN(1)) REPS(1) {
        pg8::StaticOrder S; S.init((const bf16*)(F.ws + WS_XB), (const bf16*)(F.ws + WS_WINT), MTOK, HYC, DM, G, bx);
        pg8::EpiHyT E{(bf16*)(F.ws + WS_PTHY), F.in[I_BIN]};
        pg8::gemm_phase<pg8::EpiHyT, pg8::StaticOrder, false>(F.lds, DM, S, E);
    } SEAM(1);
    if (IN(2)) REPS(2) { hyena_phase(F); } SEAM(2);
    if (IN(3)) REPS(3) { p3_transpose(F); } SEAM(3);
    if (IN(4)) REPS(4) {
        pg8::StaticOrder S; S.init((const bf16*)(F.ws + WS_XB), (const bf16*)(F.ws + WS_WINT) + (size_t)3072 * DM, MTOK, 6400, DM, G, bx);
        pg8::EpiZXD E{(bf16*)F.out, (bf16*)(F.ws + WS_XBC), (float*)(F.ws + WS_DT), F.in[I_BIN], (bf16*)(F.ws + WS_HALO)};
        pg8::gemm_phase<pg8::EpiZXD, pg8::StaticOrder, false>(F.lds, DM, S, E);
    } SEAM(4);
    if (IN(5)) REPS(5) { ssd_conv_phase(F); } SEAM(5);
    if (IN(6)) REPS(6) { ssd_phase(F); } SEAM(6);
    if (IN(7)) REPS(7) { ssd_norm_phase(F); p6_reconvert(F); } SEAM(7);
    if (IN(8)) REPS(8) {
        pg8::StaticOrder S; S.init((const bf16*)(F.ws + WS_XB2), (const bf16*)(F.ws + WS_WING), MTOK, 2048, DM, G, bx);
        pg8::EpiBf<0> E{(bf16*)(F.ws + WS_G), 2048, F.in[I_BIN] + 9280, nullptr, 0, nullptr};
        pg8::gemm_phase<pg8::EpiBf<0>, pg8::StaticOrder, false>(F.lds, DM, S, E);
    } SEAM(8);
    if (IN(9)) REPS(9) {
        pg8::StaticOrder S; S.init((const bf16*)(F.ws + WS_YHY), (const bf16*)(F.ws + WS_WHYB), MTOK, DM, DM, G, bx);
        pg8::EpiBf<1> E{(bf16*)(F.ws + WS_MIX), DM, nullptr, (const bf16*)(F.ws + WS_G), 2048, nullptr};
        pg8::gemm_phase<pg8::EpiBf<1>, pg8::StaticOrder, false>(F.lds, DM, S, E);
    } SEAM(9);
    if (IN(10)) REPS(10) {
        pg8::StaticOrder S; S.init((const bf16*)(F.ws + WS_YSSD), (const bf16*)(F.ws + WS_WSSDB), MTOK, DM, DSSM, G, bx);
        pg8::EpiBf<2> E{(bf16*)(F.ws + WS_MIX), DM, nullptr, (const bf16*)(F.ws + WS_G) + 1024, 2048, (const bf16*)(F.ws + WS_MIX)};
        pg8::gemm_phase<pg8::EpiBf<2>, pg8::StaticOrder, false>(F.lds, DSSM, S, E);
    } SEAM(10);
    if (IN(11)) REPS(11) {
        pg8::StaticOrder S; S.init((const bf16*)(F.ws + WS_MIX), (const bf16*)(F.ws + WS_WOUT), MTOK, DM, DM, G, bx);
        pg8::EpiRes E{(float*)(F.ws + WS_H1), F.in[I_BOUT], F.in[I_X], DN_ALPHA};
        pg8::gemm_phase<pg8::EpiRes, pg8::StaticOrder, false>(F.lds, DM, S, E);
        p10_expert_weights(F);
    } SEAM(11);
    if (IN(12)) REPS(12) { ln1_router_phase(F); } SEAM(12);
    if (IN(13)) REPS(13) {
        const int total = moe_table(F);
        pg8::MoeOrder<2, true> S{(const LAS int*)(F.lds + MOE_TP), (const LAS int*)(F.lds + MOE_CNT), G, bx, total, (const char*)(F.ws + WS_H1B), (const char*)(F.ws + WS_EW1), (const int*)(F.ws + WS_TOK)};
        pg8::EpiSwiGLU E{(bf16*)(F.ws + WS_HID)};
        pg8::gemm_phase<pg8::EpiSwiGLU, pg8::MoeOrder<2, true>, true>(F.lds, DM, S, E);
    } SEAM(13);
    if (IN(14)) {
        const int total = moe_table(F);
#pragma unroll 1
        for (int q = 0; q < 4; ++q) {
            { pg8::SlotOrder S{(const LAS int*)(F.lds + MOE_TP), G, bx, total, q, (const char*)(F.ws + WS_HID), (const char*)(F.ws + WS_EW2)};
              pg8::EpiSlot E{(bf16*)(F.ws + WS_YQ)};
              int kd = DEXP; asm volatile("" : "+s"(kd));
              pg8::gemm_phase<pg8::EpiSlot, pg8::SlotOrder, false>(F.lds, kd, S, E); }
            xcd_barrier(bar);
            if (q < 3) { moe_combine_phase<false>(F, q); xcd_barrier(bar); }
            else moe_combine_phase<true>(F, q);
        }
    }
#ifdef EXTRA_BARS
    for (int xb_ = 0; xb_ < EXTRA_BARS; ++xb_) xcd_barrier(bar);
#endif
#undef IN
#undef SEAM
}

extern "C" void kernel_launch(void* const* d_in, const int* in_sizes, int n_in, void* d_out, int out_size, void* d_ws, size_t ws_size, hipStream_t stream) {
    static int grid = 0;
    if (grid == 0) {
        if (n_in != 38 || out_size != MTOK * DM || ws_size < WS_END) { fprintf(stderr, "kernel_launch: unexpected shapes (n_in %d out %d ws %zu)\n", n_in, out_size, ws_size); grid = -1; return; }
        int dev = 0, cus = 0, per_cu = 0;
        if (hipGetDevice(&dev) != hipSuccess || hipDeviceGetAttribute(&cus, hipDeviceAttributeMultiprocessorCount, dev) != hipSuccess) { grid = -1; return; }
        if (hipFuncSetAttribute((const void*)fwd_kernel, hipFuncAttributeMaxDynamicSharedMemorySize, LDS_BYTES) != hipSuccess) { fprintf(stderr, "kernel_launch: hipFuncSetAttribute failed\n"); grid = -1; return; }
        if (hipOccupancyMaxActiveBlocksPerMultiprocessor(&per_cu, (const void*)fwd_kernel, NTHR, LDS_BYTES) != hipSuccess || per_cu < 1) fprintf(stderr, "kernel_launch: occupancy query says %d\n", per_cu);
        (void)hipGetLastError();
        grid = cus;
    }
    if (grid < 0) return;
    (void)hipMemsetAsync((char*)d_ws + WS_CTL, 0, CTL_ZERO_BYTES, stream);
    Args a{};
    for (int i = 0; i < 38; ++i) a.in[i] = (const float*)d_in[i];
    a.out = (float*)d_out; a.ws = (unsigned char*)d_ws;
    for (int li = 0; li < N_LAUNCHES; ++li) {
        a.ph_lo = (N_LAUNCHES == NPH) ? li : 0; a.ph_hi = (N_LAUNCHES == NPH) ? li + 1 : NPH; a.li = li;
        hipLaunchKernelGGL(fwd_kernel, dim3(grid), dim3(NTHR), LDS_BYTES, stream, a);
    }
}
```

```cpp
#define MK_N_LAUNCHES 1
#include <hip/hip_runtime.h>
#include <cstdio>
#include <cstdint>

#define LAS __attribute__((address_space(3)))
#define GAS __attribute__((address_space(1)))
typedef unsigned short bf16;
typedef short bf16x8 __attribute__((ext_vector_type(8)));
typedef float f32x4 __attribute__((ext_vector_type(4)));
typedef float f32x2 __attribute__((ext_vector_type(2)));
typedef unsigned u32x4 __attribute__((ext_vector_type(4)));
typedef unsigned u32x2 __attribute__((ext_vector_type(2)));
typedef GAS unsigned gu32;

constexpr int BATCH = 16, SEQ = 2048, DM = 1024, MTOK = BATCH * SEQ;
constexpr int HYC = 3072, DSSM = 2048, CONVD = 4096, NHEAD = 32, NGRP = 8, NSTATE = 128, INC = 11328;
constexpr int NE = 64, TOPK = 8, DEXP = 256, NEX = NE + 1;
constexpr float DN_ALPHA = 1.189207115002721f;
constexpr float LN_EPS = 1e-5f, RMS_EPS = 1e-5f, ROUTED_SCALE = 2.5f;
constexpr int NWAVES = 8, NTHR = 512;
constexpr int WIN_ROWS = 11520;

constexpr size_t MiB = 1u << 20;
constexpr size_t WS_CTL = 0, CTL_ZERO_BYTES = 256 * 1024;
constexpr size_t WS_WHYB = 1 * MiB, WS_WSSDB = 3 * MiB, WS_WOUT = 7 * MiB;
constexpr size_t WS_XB = 9 * MiB;
constexpr size_t WS_WINT = 73 * MiB;
constexpr size_t WS_KERN = 96 * MiB;
constexpr size_t WS_PTHY = 112 * MiB;
constexpr size_t WS_YTHY = 304 * MiB;
constexpr size_t WS_YHY = 137 * MiB;
constexpr size_t WS_XBC = 201 * MiB;
constexpr size_t WS_DT = 457 * MiB;
constexpr size_t WS_HALO = 465 * MiB;
constexpr size_t WS_YSSD = 9 * MiB;
constexpr size_t WS_XB2 = 201 * MiB;
constexpr size_t WS_WING = 265 * MiB;
constexpr size_t WS_G = 269 * MiB;
constexpr size_t WS_MIX = 397 * MiB;
constexpr size_t WS_H1 = 177 * MiB;
constexpr size_t WS_EW1 = 9 * MiB;
constexpr size_t WS_EW2 = 477 * MiB;
constexpr size_t WS_YQ = 9 * MiB;
constexpr size_t WS_ASG = 510 * MiB;
constexpr size_t WS_H1B = 113 * MiB;
constexpr size_t WS_HID = 305 * MiB;
constexpr size_t WS_TOK = 461 * MiB;
constexpr size_t WS_WGT = 469 * MiB;
constexpr size_t WS_END = 511 * MiB;
constexpr int CW_BAR = 4096;
constexpr int CW_CNT = 16384;
constexpr int CW_DBG = 32768;

constexpr int LDS_BYTES = 163840;
constexpr int MISC_OFF = 163840 - 512;

#define RLX_AGENT __ATOMIC_RELAXED, __HIP_MEMORY_SCOPE_AGENT
#define LDS_WAIT() asm volatile("s_waitcnt lgkmcnt(0)" ::: "memory")
#define VM_WAIT() asm volatile("s_waitcnt vmcnt(0)" ::: "memory")
typedef __bf16 bf16x2_t __attribute__((ext_vector_type(2)));
__device__ __forceinline__ unsigned pk2(float lo, float hi) { const f32x2 v = {lo, hi}; return __builtin_bit_cast(unsigned, __builtin_convertvector(v, bf16x2_t)); }
__device__ __forceinline__ unsigned f2bf(float f) { return pk2(f, 0.f) & 0xffffu; }
__device__ __forceinline__ float bf2f(unsigned b) { return __builtin_bit_cast(float, b << 16); }
__device__ __forceinline__ float bflo(unsigned w) { return __builtin_bit_cast(float, w << 16); }
__device__ __forceinline__ float bfhi(unsigned w) { return __builtin_bit_cast(float, w & 0xffff0000u); }
__device__ __forceinline__ float sigmoidf_(float v) { return __builtin_amdgcn_rcpf(1.0f + __expf(-v)); }
__device__ __forceinline__ float siluf_(float v) { return v * __builtin_amdgcn_rcpf(1.0f + __expf(-v)); }
__device__ __forceinline__ float wave_sum(float v) {
#pragma unroll
    for (int o = 1; o < 64; o <<= 1) v += __shfl_xor(v, o);
    return v;
}
__device__ __forceinline__ float wave_max(float v) {
#pragma unroll
    for (int o = 1; o < 64; o <<= 1) v = fmaxf(v, __shfl_xor(v, o));
    return v;
}

namespace pg8 {
constexpr int BM = 256, BK = 64, HALF = 128, HTB = HALF * BK * 2, STAGE_BYTES = 8 * HTB, NXCD = 8, WGM = 8;
__host__ __device__ __forceinline__ int lds_byte(int r, int c) { const int st = (r >> 4) * 2 + (c >> 5), rr = r & 15, cc = c & 31, ob = rr * 64 + cc * 2; return st * 1024 + (ob ^ (((ob >> 9) & 1) << 5)); }
__host__ __device__ __forceinline__ void stage_rc(int b, int& R, int& C) { const int st = b / 1024, sb = b % 1024, swz = sb ^ (((sb >> 9) & 1) << 5); R = (st >> 1) * 16 + swz / 64; C = (st & 1) * 32 + (swz % 64) / 2; }
__host__ __device__ __forceinline__ int perm32(int rho) { const int n = rho >> 4, i = rho & 15; return 8 * (i >> 2) + 4 * n + (i & 3); }

struct Unit { int pm, pn; const char* A; const char* B; int e, cnt; };

struct StaticOrder {
    int nM, nN, nwg, G, c, K; const char* A; const char* B;
    __device__ void init(const bf16* A_, const bf16* B_, int M, int N, int K_, int G_, int c_) { A = (const char*)A_; B = (const char*)B_; nM = M / BM; nN = N / BM; nwg = nM * nN; G = G_; c = c_; K = K_; }
    __device__ __forceinline__ bool next(int i, Unit& u) const {
        const long L = (long)i * G + c; if (L >= nwg) return false;
        int wgid = (int)L; { const int q = nwg / NXCD, r = nwg % NXCD, xcd = wgid % NXCD, off = wgid / NXCD; wgid = (xcd < r ? xcd * (q + 1) : r * (q + 1) + (xcd - r) * q) + off; }
        const int nig = WGM * nN, gid = wgid / nig, fm = gid * WGM, gsz = (nM - fm) < WGM ? (nM - fm) : WGM;
        u.pm = fm + ((wgid % nig) % gsz); u.pn = (wgid % nig) / gsz;
        u.A = A + (size_t)u.pm * BM * K * 2; u.B = B + (size_t)u.pn * BM * K * 2; u.e = 0; u.cnt = 0; return true;
    }
    __device__ __forceinline__ unsigned row_off(const Unit&, int) const { return 0u; }
};

__device__ __forceinline__ unsigned cvt_pk_bf16(float lo, float hi) { unsigned r; asm volatile("v_cvt_pk_bf16_f32 %0, %1, %2" : "=v"(r) : "v"(lo), "v"(hi)); return r; }

template <class Epi, class Sched, bool GATHER>
__device__ __forceinline__ void gemm_phase(LAS unsigned char* lds, const int K, const Sched& S, const Epi& E) {
    constexpr bool TA = Epi::TA;
    const int tid = threadIdx.x, wid = __builtin_amdgcn_readfirstlane(tid >> 6), lane = tid & 63, wr = wid >> 2, wc = wid & 3, fr = lane & 15, fq = lane >> 4;
    const int nt = K / BK;
    unsigned voffA[2][2], voffB[2]; int RA[2], CA[2];
#pragma unroll
    for (int i = 0; i < 2; ++i) { int R, C; stage_rc(tid * 16 + i * 8192, R, C); const int Rb = Epi::PERM ? ((R & ~31) + perm32(R & 31)) : R;
        RA[i] = R; CA[i] = C; voffA[0][i] = (unsigned)(R * K + C) * 2u; voffA[1][i] = voffA[0][i]; voffB[i] = (unsigned)(Rb * K + C) * 2u; }
    const size_t kstep = (size_t)(BK * 2);
    const size_t hstep = (size_t)HALF * K * 2;
    const size_t hstepA = GATHER ? 0 : hstep;
    const unsigned ldsw = (unsigned)wid * 1024u;
    const int aoff = lds_byte(wr * 64 + fr, fq * 8), boff = lds_byte(wc * 32 + fr, fq * 8);
#define PG8_SA(b, h) (((b) * 2 + (h)) * HTB)
#define PG8_SB(b, h) ((4 + (b) * 2 + (h)) * HTB)
#define PG8_STAGE(bufoff, gbase, voff) do { _Pragma("unroll") for (int _i = 0; _i < 2; ++_i) \
        __builtin_amdgcn_global_load_lds((const unsigned*)((const char*)(gbase) + (voff)[_i]), (LAS unsigned*)(lds + (bufoff) + ldsw + _i * 8192), 16, 0, 0); } while (0)
#define PG8_STAGE_A(bufoff, gbase, h) PG8_STAGE(bufoff, (gbase) + (h) * hstepA, voffA[GATHER ? (h) : 0])
#define PG8_LDA(dst, b, h) do { _Pragma("unroll") for (int m = 0; m < 4; ++m) _Pragma("unroll") for (int k = 0; k < 2; ++k) dst[m][k] = *(const LAS bf16x8*)(lds + PG8_SA(b, h) + aoff + m * 2048 + k * 1024); } while (0)
#define PG8_LDB(dst, b, h) do { _Pragma("unroll") for (int n = 0; n < 2; ++n) _Pragma("unroll") for (int k = 0; k < 2; ++k) dst[n][k] = *(const LAS bf16x8*)(lds + PG8_SB(b, h) + boff + n * 2048 + k * 1024); } while (0)
#define PG8_MMA(ai, bj, At, Bt) do { __builtin_amdgcn_s_setprio(1); _Pragma("unroll") for (int m = 0; m < 4; ++m) _Pragma("unroll") for (int n = 0; n < 2; ++n) _Pragma("unroll") for (int k = 0; k < 2; ++k) \
        acc[ai][bj][m][n] = TA ? __builtin_amdgcn_mfma_f32_16x16x32_bf16(Bt[n][k], At[m][k], acc[ai][bj][m][n], 0, 0, 0) \
                               : __builtin_amdgcn_mfma_f32_16x16x32_bf16(At[m][k], Bt[n][k], acc[ai][bj][m][n], 0, 0, 0); __builtin_amdgcn_s_setprio(0); } while (0)
#define PG8_WAIT_V(n) asm volatile("s_waitcnt vmcnt(" #n ")" ::: "memory")
#define PG8_WAIT_L(n) asm volatile("s_waitcnt lgkmcnt(" #n ")" ::: "memory")
#define PG8_BAR __builtin_amdgcn_s_barrier()
#define PG8_SCHED __builtin_amdgcn_sched_barrier(0)
    Unit cur, nxt; int ui = 0;
    if (!S.next(0, cur)) return;
    if (GATHER) {
#pragma unroll
        for (int h = 0; h < 2; ++h)
#pragma unroll
            for (int i = 0; i < 2; ++i) voffA[h][i] = S.row_off(cur, h * HALF + RA[i]) + (unsigned)CA[i] * 2u;
    }
    f32x4 acc[2][2][4][2];
#pragma unroll
    for (int a = 0; a < 2; ++a)
#pragma unroll
        for (int b = 0; b < 2; ++b)
#pragma unroll
            for (int m = 0; m < 4; ++m)
#pragma unroll
                for (int n = 0; n < 2; ++n) acc[a][b][m][n] = (f32x4){0.f, 0.f, 0.f, 0.f};
    bf16x8 At[4][2], B0[2][2], B1[2][2];
    const char* cA = cur.A; const char* cB = cur.B;
    PG8_STAGE(PG8_SB(0, 0), cB, voffB); PG8_STAGE_A(PG8_SA(0, 0), cA, 0); PG8_STAGE(PG8_SB(0, 1), cB + hstep, voffB); PG8_STAGE_A(PG8_SA(0, 1), cA, 1);
    if (wr == 1) PG8_BAR;
    PG8_WAIT_V(4); PG8_BAR;
    PG8_STAGE(PG8_SB(1, 0), cB + kstep, voffB); PG8_STAGE_A(PG8_SA(1, 0), cA + kstep, 0); PG8_STAGE(PG8_SB(1, 1), cB + hstep + kstep, voffB);
    PG8_WAIT_V(6); PG8_BAR;
    for (;;) {
        const bool has_next = S.next(ui + 1, nxt);
        const char* nA = has_next ? nxt.A : cA; const char* nB = has_next ? nxt.B : cB;
        for (int t = 0; t < nt; t += 2) {
            const bool last = (t == nt - 2);
            const char* a1 = cA + (size_t)(t + 1) * kstep;
            const char* a2 = last ? nA : cA + (size_t)(t + 2) * kstep; const char* b2 = last ? nB : cB + (size_t)(t + 2) * kstep;
            const char* a3 = a2 + kstep; const char* b3 = b2 + kstep;
            PG8_LDB(B0, 0, 0); PG8_SCHED; PG8_LDA(At, 0, 0); PG8_STAGE_A(PG8_SA(1, 1), a1, 1);
            PG8_WAIT_L(8); PG8_BAR; PG8_WAIT_L(0); PG8_MMA(0, 0, At, B0); PG8_BAR; PG8_SCHED;
            if (GATHER) { if (last && has_next) {
#pragma unroll
                for (int h = 0; h < 2; ++h)
#pragma unroll
                    for (int i = 0; i < 2; ++i) voffA[h][i] = S.row_off(nxt, h * HALF + RA[i]) + (unsigned)CA[i] * 2u;
            } }
            PG8_LDB(B1, 0, 1); PG8_STAGE(PG8_SB(0, 0), b2, voffB);
            PG8_BAR; PG8_WAIT_L(0); PG8_MMA(0, 1, At, B1); PG8_BAR;
            PG8_LDA(At, 0, 1); PG8_STAGE_A(PG8_SA(0, 0), a2, 0);
            PG8_BAR; PG8_WAIT_L(0); PG8_MMA(1, 0, At, B0); PG8_BAR; PG8_SCHED;
            PG8_STAGE(PG8_SB(0, 1), b2 + hstep, voffB);
            PG8_WAIT_V(6); PG8_BAR; PG8_MMA(1, 1, At, B1); PG8_BAR;
            PG8_LDB(B0, 1, 0); PG8_SCHED; PG8_LDA(At, 1, 0); PG8_STAGE_A(PG8_SA(0, 1), a2, 1);
            PG8_WAIT_L(8); PG8_BAR; PG8_WAIT_L(0); PG8_MMA(0, 0, At, B0); PG8_BAR; PG8_SCHED;
            PG8_LDB(B1, 1, 1); PG8_STAGE(PG8_SB(1, 0), b3, voffB);
            PG8_BAR; PG8_WAIT_L(0); PG8_MMA(0, 1, At, B1); PG8_BAR;
            PG8_LDA(At, 1, 1); PG8_STAGE_A(PG8_SA(1, 0), a3, 0);
            PG8_BAR; PG8_WAIT_L(0); PG8_MMA(1, 0, At, B0); PG8_BAR; PG8_SCHED;
            PG8_STAGE(PG8_SB(1, 1), b3 + hstep, voffB);
            PG8_WAIT_V(6); PG8_BAR; PG8_MMA(1, 1, At, B1); PG8_BAR;
        }
        E(acc, cur, wr, wc, fr, fq);
        if (!has_next) break;
#pragma unroll
        for (int a = 0; a < 2; ++a)
#pragma unroll
            for (int b = 0; b < 2; ++b)
#pragma unroll
                for (int m = 0; m < 4; ++m)
#pragma unroll
                    for (int n = 0; n < 2; ++n) acc[a][b][m][n] = (f32x4){0.f, 0.f, 0.f, 0.f};
        cur = nxt; cA = nA; cB = nB; ++ui;
    }
    PG8_WAIT_V(0);
    if (wr == 0) PG8_BAR;
    PG8_BAR;
#undef PG8_SA
#undef PG8_SB
#undef PG8_STAGE
#undef PG8_STAGE_A
#undef PG8_LDA
#undef PG8_LDB
#undef PG8_MMA
#undef PG8_WAIT_V
#undef PG8_WAIT_L
#undef PG8_BAR
#undef PG8_SCHED
}
}

namespace pg8 {
struct EpiHyT {
    static constexpr bool TA = false, PERM = false;
    bf16* PT; const float* bias;
    __device__ __forceinline__ void operator()(const f32x4 (&acc)[2][2][4][2], const Unit& u, int wr, int wc, int fr, int fq) const {
#pragma unroll
        for (int bj = 0; bj < 2; ++bj)
#pragma unroll
            for (int n = 0; n < 2; ++n) {
                const int col = u.pn * BM + bj * HALF + wc * 32 + n * 16 + fr; const float bv = bias[col];
                bf16* colp = PT + (size_t)col * MTOK + u.pm * BM + wr * 64 + 4 * fq;
#pragma unroll
                for (int ai = 0; ai < 2; ++ai)
#pragma unroll
                    for (int m = 0; m < 4; ++m) { const f32x4 v = acc[ai][bj][m][n] + bv; u32x2 w; w.x = cvt_pk_bf16(v[0], v[1]); w.y = cvt_pk_bf16(v[2], v[3]);
                        *(u32x2*)(colp + ai * HALF + m * 16) = w; }
            }
    }
};
struct EpiZXD {
    static constexpr bool TA = true, PERM = true;
    bf16* Zb; bf16* XBC; float* DT; const float* b_in; bf16* HALO;
    __device__ __forceinline__ void operator()(const f32x4 (&acc)[2][2][4][2], const Unit& u, int wr, int wc, int fr, int fq) const {
        const int row0 = u.pm * BM + wr * 64 + fr;
        if (u.pn == 24) {
            if (wc < 2) {
                const int c0 = wc * 32 + 8 * fq;
#pragma unroll
                for (int n = 0; n < 2; ++n) { const f32x4 bv = *(const f32x4*)(b_in + 9216 + c0 + 4 * n);
#pragma unroll
                    for (int ai = 0; ai < 2; ++ai)
#pragma unroll
                        for (int m = 0; m < 4; ++m) *(f32x4*)(DT + (size_t)(row0 + ai * HALF + m * 16) * 64 + c0 + 4 * n) = acc[ai][0][m][n] + bv; }
            }
            return;
        }
        bf16* base; int ldc, colt, bcol;
        if (u.pn < 8) { base = Zb; ldc = DSSM; colt = u.pn * BM; bcol = 3072 + colt; } else { base = XBC; ldc = CONVD; colt = (u.pn - 8) * BM; bcol = 5120 + colt; }
        const int col0 = colt + wc * 32 + 8 * fq, bcol0 = bcol + wc * 32 + 8 * fq;
        f32x4 bv[2][2];
#pragma unroll
        for (int bj = 0; bj < 2; ++bj)
#pragma unroll
            for (int n = 0; n < 2; ++n) bv[bj][n] = *(const f32x4*)(b_in + bcol0 + bj * HALF + 4 * n);
#pragma unroll
        for (int ai = 0; ai < 2; ++ai)
#pragma unroll
            for (int m = 0; m < 4; ++m) { bf16* rowp = base + (size_t)(row0 + ai * HALF + m * 16) * ldc + col0;
#pragma unroll
                for (int bj = 0; bj < 2; ++bj) { const f32x4 v0 = acc[ai][bj][m][0] + bv[bj][0], v1 = acc[ai][bj][m][1] + bv[bj][1];
                    u32x4 w; w.x = cvt_pk_bf16(v0[0], v0[1]); w.y = cvt_pk_bf16(v0[2], v0[3]); w.z = cvt_pk_bf16(v1[0], v1[1]); w.w = cvt_pk_bf16(v1[2], v1[3]);
                    *(u32x4*)(rowp + bj * HALF) = w;
                    if (u.pn >= 8 && ((m == 3 && fr >= 14) || (m == 0 && fr < 2))) {
                        const int row = row0 + ai * HALF + m * 16, bb = row >> 11, t = row & 2047, tm = t & 63;
                        const int jb = (tm >= 62) ? (t >> 6) + 1 : (t >> 6), idx = (tm >= 62) ? tm - 62 : 2 + tm;
                        *(u32x4*)(HALO + ((size_t)(bb * 33 + jb) * 4 + idx) * CONVD + col0 + bj * HALF) = w; } } }
    }
};
template <int MODE> struct EpiBf {
    static constexpr bool TA = true, PERM = true;
    bf16* O; int ldc; const float* bias; const bf16* G1; int ldg; const bf16* P;
    __device__ __forceinline__ void operator()(const f32x4 (&acc)[2][2][4][2], const Unit& u, int wr, int wc, int fr, int fq) const {
        const int row0 = u.pm * BM + wr * 64 + fr, col0 = u.pn * BM + wc * 32 + 8 * fq;
#pragma unroll
        for (int ai = 0; ai < 2; ++ai)
#pragma unroll
            for (int m = 0; m < 4; ++m) { const size_t r = (size_t)(row0 + ai * HALF + m * 16);
#pragma unroll
                for (int bj = 0; bj < 2; ++bj) { f32x4 v0 = acc[ai][bj][m][0], v1 = acc[ai][bj][m][1]; const int c = col0 + bj * HALF;
                    if (MODE == 0) { const f32x4 b0 = *(const f32x4*)(bias + c), b1 = *(const f32x4*)(bias + c + 4); v0 = v0 + b0; v1 = v1 + b1;
#pragma unroll
                        for (int j = 0; j < 4; ++j) { v0[j] = sigmoidf_(v0[j]); v1[j] = sigmoidf_(v1[j]); } }
                    else { const u32x4 g = *(const u32x4*)(G1 + r * ldg + c);
                        v0[0] *= bflo(g.x); v0[1] *= bfhi(g.x); v0[2] *= bflo(g.y); v0[3] *= bfhi(g.y); v1[0] *= bflo(g.z); v1[1] *= bfhi(g.z); v1[2] *= bflo(g.w); v1[3] *= bfhi(g.w);
                        if (MODE == 2) { const u32x4 p = *(const u32x4*)(P + r * ldc + c);
                            v0[0] += bflo(p.x); v0[1] += bfhi(p.x); v0[2] += bflo(p.y); v0[3] += bfhi(p.y); v1[0] += bflo(p.z); v1[1] += bfhi(p.z); v1[2] += bflo(p.w); v1[3] += bfhi(p.w); } }
                    u32x4 w; w.x = cvt_pk_bf16(v0[0], v0[1]); w.y = cvt_pk_bf16(v0[2], v0[3]); w.z = cvt_pk_bf16(v1[0], v1[1]); w.w = cvt_pk_bf16(v1[2], v1[3]);
                    *(u32x4*)(O + r * ldc + c) = w; } }
    }
};
struct EpiRes {
    static constexpr bool TA = true, PERM = false;
    float* O; const float* bias; const float* X; float alpha;
    __device__ __forceinline__ void operator()(const f32x4 (&acc)[2][2][4][2], const Unit& u, int wr, int wc, int fr, int fq) const {
        const int row0 = u.pm * BM + wr * 64 + fr, col0 = u.pn * BM + wc * 32 + 4 * fq;
#pragma unroll
        for (int ai = 0; ai < 2; ++ai)
#pragma unroll
            for (int m = 0; m < 4; ++m) { const size_t off = (size_t)(row0 + ai * HALF + m * 16) * DM + col0;
#pragma unroll
                for (int bj = 0; bj < 2; ++bj)
#pragma unroll
                    for (int n = 0; n < 2; ++n) { const f32x4 xv = *(const f32x4*)(X + off + bj * HALF + n * 16), bv = *(const f32x4*)(bias + col0 + bj * HALF + n * 16);
                        *(f32x4*)(O + off + bj * HALF + n * 16) = acc[ai][bj][m][n] + bv + alpha * xv; } }
    }
};
struct EpiSwiGLU {
    static constexpr bool TA = true, PERM = true;
    bf16* HID;
    __device__ __forceinline__ void operator()(const f32x4 (&acc)[2][2][4][2], const Unit& u, int wr, int wc, int fr, int fq) const {
        const int row0 = u.pm * BM + wr * 64 + fr, col0 = u.pn * HALF + wc * 32 + 8 * fq;
#pragma unroll
        for (int ai = 0; ai < 2; ++ai)
#pragma unroll
            for (int m = 0; m < 4; ++m) { f32x4 v0, v1;
#pragma unroll
                for (int j = 0; j < 4; ++j) { v0[j] = siluf_(acc[ai][0][m][0][j]) * acc[ai][1][m][0][j]; v1[j] = siluf_(acc[ai][0][m][1][j]) * acc[ai][1][m][1][j]; }
                u32x4 w; w.x = cvt_pk_bf16(v0[0], v0[1]); w.y = cvt_pk_bf16(v0[2], v0[3]); w.z = cvt_pk_bf16(v1[0], v1[1]); w.w = cvt_pk_bf16(v1[2], v1[3]);
                *(u32x4*)(HID + (size_t)(row0 + ai * HALF + m * 16) * DEXP + col0) = w; }
    }
};
struct EpiScatter {
    static constexpr bool TA = false, PERM = false;
    float* ACC; const int* tok; const float* wgt; int j0_unused;
    __device__ __forceinline__ void operator()(const f32x4 (&acc)[2][2][4][2], const Unit& u, int wr, int wc, int fr, int fq) const {
        asm volatile("" : "+v"(fr), "+v"(fq));
        const int jt = u.pn >> 2, ct = u.pn & 3;
#pragma unroll
        for (int ai = 0; ai < 2; ++ai)
#pragma unroll
            for (int m = 0; m < 4; ++m)
#pragma unroll
                for (int j = 0; j < 4; ++j) { const int r = ai * HALF + wr * 64 + m * 16 + 4 * fq + j;
                    if (r < u.cnt) { int token; float w;
                        if (u.e == NE) { token = jt * BM + r; w = 1.0f; } else { const size_t li = (size_t)u.e * MTOK + (size_t)jt * BM + r; token = tok[li]; w = wgt[li]; }
                        float* rowp = ACC + (size_t)token * DM + ct * BM + wc * 32 + fr;
#pragma unroll
                        for (int bj = 0; bj < 2; ++bj)
#pragma unroll
                            for (int n = 0; n < 2; ++n) unsafeAtomicAdd(rowp + bj * HALF + n * 16, w * acc[ai][bj][m][n][j]);
                    }
                    asm volatile("" ::: "memory"); }
    }
};

struct EpiSlot8 {
    static constexpr bool TA = true, PERM = true;
    unsigned char* YQ;
    __device__ __forceinline__ void operator()(const f32x4 (&acc)[2][2][4][2], const Unit& u, int wr, int wc, int fr, int fq) const {
        const int row0 = u.pm * BM + wr * 64 + fr, col0 = (u.pn & 1) * 256 + wc * 32 + 8 * fq;
#pragma unroll
        for (int ai = 0; ai < 2; ++ai)
#pragma unroll
            for (int m = 0; m < 4; ++m) { unsigned char* rowp = YQ + (size_t)(row0 + ai * HALF + m * 16) * 512 + col0;
#pragma unroll
                for (int bj = 0; bj < 2; ++bj) { const f32x4 v0 = acc[ai][bj][m][0], v1 = acc[ai][bj][m][1];
                    int w0 = __builtin_amdgcn_cvt_pk_fp8_f32(v0[0], v0[1], 0, false); w0 = __builtin_amdgcn_cvt_pk_fp8_f32(v0[2], v0[3], w0, true);
                    int w1 = __builtin_amdgcn_cvt_pk_fp8_f32(v1[0], v1[1], 0, false); w1 = __builtin_amdgcn_cvt_pk_fp8_f32(v1[2], v1[3], w1, true);
                    u32x2 w; w.x = (unsigned)w0; w.y = (unsigned)w1; *(u32x2*)(rowp + bj * HALF) = w; } }
    }
};
struct SlotOrder2 {
    const LAS int* tp; int G, c, total, pass; const char* A; const char* W;
    __device__ __forceinline__ bool next(int i, Unit& u) const {
        const long L = (long)i * G + c; if (L >= 2l * total) return false;
        const int tile = (int)(L >> 1), q = 2 * pass + (int)(L & 1); int e = 0;
#pragma unroll 1
        for (int s = 64; s >= 1; s >>= 1) if (e + s <= NE && tp[e + s] <= tile) e += s;
        u.e = e; u.cnt = 0; u.pm = tile; u.pn = q; u.A = A + (size_t)tile * BM * DEXP * 2; u.B = W + ((size_t)e * DM + (size_t)q * 256) * DEXP * 2;
        return true;
    }
    __device__ __forceinline__ unsigned row_off(const Unit&, int) const { return 0u; }
};
template <int NCT, bool FIRST> struct MoeOrder {
    const LAS int* tp; const LAS int* cnt; int G, c, total;
    const char* A; const char* W; const int* tok;
    __device__ __forceinline__ bool next(int i, Unit& u) const {
        const long L = (long)i * G + c; if (L >= (long)total * NCT) return false;
        const int tile = (int)(L / NCT), ct = (int)(L % NCT);
        int e = 0;
#pragma unroll 1
        for (int s = 64; s >= 1; s >>= 1) if (e + s <= NE && tp[e + s] <= tile) e += s;
        const int jt = tile - tp[e];
        u.e = e; const int left = cnt[e] - jt * BM; u.cnt = left < BM ? left : BM;
        if (FIRST) { u.pm = tile; u.pn = ct; u.A = A; u.B = W + ((size_t)e * 512 + (size_t)ct * 256) * DM * 2; }
        else { u.pm = tile; u.pn = jt * 4 + ct; u.A = A + (size_t)tile * BM * DEXP * 2; u.B = W + ((size_t)e * DM + (size_t)ct * 256) * DEXP * 2; }
        return true;
    }
    __device__ __forceinline__ unsigned row_off(const Unit& u, int r) const {
        const int jt = u.pm - tp[u.e]; int token;
        if (u.e == NE) token = jt * BM + r; else token = (r < u.cnt) ? tok[(size_t)u.e * MTOK + (size_t)jt * BM + r] : 0;
        return (unsigned)token * (unsigned)(DM * 2);
    }
};
}

#define XB_TMO      128
#define XB_XCNT(j)  (256  + 64 * (j))
#define XB_XSUB(j)  (1280 + 64 * (j))
#define XB_XGEN(j)  (2304 + 64 * (j))
#define XB_TOP      3328
#define XB_TOPGEN   3392
#define XCD_BAR_WORDS 3456
#define XB_SPIN_CAP (1u << 18)
__device__ __forceinline__ unsigned xb_ld(unsigned* p)              { return __hip_atomic_load(p, __ATOMIC_RELAXED, __HIP_MEMORY_SCOPE_AGENT); }
__device__ __forceinline__ unsigned xb_add(unsigned* p, unsigned v) { return __hip_atomic_fetch_add(p, v, __ATOMIC_RELAXED, __HIP_MEMORY_SCOPE_AGENT); }
__device__ __forceinline__ unsigned xb_xcc_id() { return (unsigned)__builtin_amdgcn_s_getreg((3 << 11) | 20) & 0xFu; }
#define XB_SPIN(cond, bar) do { unsigned _sp = 0; while (cond) { __builtin_amdgcn_s_sleep(1); \
    if ((++_sp & 255u) == 0u) { if (xb_ld(&(bar)[XB_TMO])) break; if (_sp > XB_SPIN_CAP) { atomicAdd(&(bar)[XB_TMO], 1u); break; } } } } while (0)
struct XcdBarrier { unsigned* bar; unsigned x; volatile LAS unsigned* st; };
__device__ __forceinline__ XcdBarrier xcd_barrier_post(unsigned* bar, volatile LAS unsigned* st) {
    XcdBarrier b; b.bar = bar; b.x = xb_xcc_id(); b.st = st;
    if (threadIdx.x == 0) (void)xb_add(&bar[XB_XCNT(b.x)], 1u);
    return b;
}
__device__ __forceinline__ void xcd_barrier_complete(unsigned* bar, unsigned x, unsigned& nloc, unsigned& nx) {
    const unsigned G = gridDim.x * gridDim.y * gridDim.z;
    unsigned sum, cnt, mine, sp = 0u;
    for (;;) {
        sum = 0u; cnt = 0u; mine = 0u;
#pragma unroll
        for (unsigned j = 0; j < 16; ++j) { const unsigned c = xb_ld(&bar[XB_XCNT(j)]); sum += c; cnt += (c > 0u) ? 1u : 0u; mine = (j == x) ? c : mine; }
        if (sum == G) break;
        __builtin_amdgcn_s_sleep(1);
        if ((++sp & 255u) == 0u) { if (xb_ld(&bar[XB_TMO])) break; if (sp > XB_SPIN_CAP) { atomicAdd(&bar[XB_TMO], 1u); break; } }
    }
    nloc = mine > 0u ? mine : 1u; nx = cnt > 0u ? cnt : 1u;
}
__device__ __forceinline__ void xcd_barrier(const XcdBarrier& b) {
    asm volatile("s_waitcnt vmcnt(0)" ::: "memory");
    __syncthreads();
    if (threadIdx.x == 0) {
        unsigned* bar = b.bar;
        __builtin_amdgcn_s_waitcnt(0);
        unsigned nloc = b.st[0], nx = b.st[1];
        if (nloc == 0u) { xcd_barrier_complete(bar, b.x, nloc, nx); b.st[0] = nloc; b.st[1] = nx; }
        const unsigned old = xb_add(&bar[XB_XSUB(b.x)], 1u);
        const unsigned gen = old / nloc;
        if (old + 1u == (gen + 1u) * nloc) {
            __builtin_amdgcn_fence(__ATOMIC_RELEASE, "agent");
            asm volatile("s_waitcnt vmcnt(0)" ::: "memory");
            const unsigned og = xb_add(&bar[XB_TOP], 1u);
            const unsigned tg = og / nx;
            if (og + 1u == (tg + 1u) * nx) xb_add(&bar[XB_TOPGEN], 1u);
            else XB_SPIN(xb_ld(&bar[XB_TOPGEN]) == tg, bar);
            __builtin_amdgcn_fence(__ATOMIC_ACQUIRE, "agent");
            xb_add(&bar[XB_XGEN(b.x)], 1u);
            asm volatile("s_waitcnt vmcnt(0)" ::: "memory");
        } else {
            XB_SPIN(xb_ld(&bar[XB_XGEN(b.x)]) == gen, bar);
            __builtin_amdgcn_fence(__ATOMIC_ACQUIRE, "agent");
            asm volatile("s_waitcnt vmcnt(0)" ::: "memory");
        }
    }
    __syncthreads();
}

struct Args {
    const float* in[38]; float* out; unsigned char* ws; int ph_lo, ph_hi, li, pad;
};
enum { I_X = 0, I_WIN, I_BIN, I_HCW, I_HCB, I_FW1, I_FB1, I_FF1, I_FW2, I_FB2, I_FF2, I_FW3, I_FB3, I_FF3, I_FW4, I_HBIAS,
       I_SCW, I_SCB, I_DTB, I_ALOG, I_SD, I_SNW, I_WHYB, I_WSSDB, I_WOUT, I_BOUT, I_LN1G, I_LN1B, I_RW, I_RB, I_EWG, I_EWU, I_EWD, I_SWG, I_SWU, I_SWD, I_LN2G, I_LN2B };
struct Frame {
    LAS unsigned char* lds; volatile LAS unsigned* MISC; gu32* ctl; unsigned char* ws;
    int tid, lane, wave, vcu, G;
    const float* const* in; float* out;
};

__device__ __forceinline__ void tr_item(const float* src, int ld_src, int k0, int c0, bf16* dst, int drow0, int ldd, LAS float* scr, int lane) {
#pragma unroll 8
    for (int i = 0; i < 32; ++i) { const int kk = 2 * i + (lane >> 5); scr[kk * 33 + (lane & 31)] = src[(size_t)(k0 + kk) * ld_src + c0 + (lane & 31)]; }
    LDS_WAIT(); asm volatile("" ::: "memory");
    const int c = lane & 7;
#pragma unroll
    for (int j = 0; j < 4; ++j) { const int n = (lane >> 3) + 8 * j; const LAS float* s = scr + (8 * c) * 33 + n;
        u32x4 o; o.x = pk2(s[0 * 33], s[1 * 33]); o.y = pk2(s[2 * 33], s[3 * 33]); o.z = pk2(s[4 * 33], s[5 * 33]); o.w = pk2(s[6 * 33], s[7 * 33]);
        *(u32x4*)(dst + (size_t)(drow0 + n) * ldd + k0 + 8 * c) = o; }
    LDS_WAIT(); asm volatile("" ::: "memory");
}
__device__ __forceinline__ void tr_matrix_item(const float* src, int ld_src, int K, int col_first, int ncols, bf16* dst, int drow_first, LAS float* scr, int it, int lane) {
    const int nblk = ncols / 32, kb = it / nblk, nb = it % nblk;
    tr_item(src, ld_src, kb * 64, col_first + nb * 32, dst, drow_first + nb * 32, K, scr, lane);
}
__device__ __forceinline__ void convert_x(Frame& F, const float* x, bf16* xb) {
    const size_t n8 = (size_t)MTOK * DM / 8; const size_t stride = (size_t)F.G * NTHR;
    for (size_t i = (size_t)F.vcu * NTHR + F.tid; i < n8; i += stride) {
        const f32x4 a = *(const f32x4*)(x + i * 8), b = *(const f32x4*)(x + i * 8 + 4);
        u32x4 o; o.x = pk2(a[0], a[1]); o.y = pk2(a[2], a[3]); o.z = pk2(b[0], b[1]); o.w = pk2(b[2], b[3]);
        *(u32x4*)(xb + i * 8) = o; }
}

__device__ __forceinline__ void hyena_filter(Frame& F) {
    const float* w1 = F.in[I_FW1]; const float* b1 = F.in[I_FB1]; const float* f1 = F.in[I_FF1];
    const float* w2 = F.in[I_FW2]; const float* b2 = F.in[I_FB2]; const float* f2 = F.in[I_FF2];
    const float* w3 = F.in[I_FW3]; const float* b3 = F.in[I_FB3]; const float* f3 = F.in[I_FF3];
    const float* w4 = F.in[I_FW4];
    bf16* KERN = (bf16*)(F.ws + WS_KERN);
    LAS float* hbuf = (LAS float*)(F.lds);
    const int lane = F.lane, wave = F.wave;
    for (int pg = F.vcu; pg < SEQ / 8; pg += F.G) {
        const int t = 8 * pg + wave;
        const float tn = (float)t / (float)(SEQ - 1), wv = 6.283185307179586f * (float)t / (float)SEQ;
        float zf = 0.f;
        if (lane == 0) zf = tn;
        else if (lane <= 16) { const float f = 1e-4f + (float)(lane - 1) * ((15.0f - 1e-4f) / 15.0f); zf = cosf(f * wv); }
        else if (lane <= 32) { const float f = 1e-4f + (float)(lane - 17) * ((15.0f - 1e-4f) / 15.0f); zf = -sinf(f * wv); }
        float s = b1[lane];
        for (int i = 0; i < 33; ++i) s += __shfl(zf, i) * w1[i * 64 + lane];
        float h = sinf(f1[lane] * s);
        s = b2[lane];
        for (int i = 0; i < 64; ++i) s += __shfl(h, i) * w2[i * 64 + lane];
        h = sinf(f2[lane] * s);
        s = b3[lane];
        for (int i = 0; i < 64; ++i) s += __shfl(h, i) * w3[i * 64 + lane];
        h = sinf(f3[lane] * s);
        hbuf[wave * 64 + lane] = h;
        __syncthreads();
        for (int q = 0; q < 8; ++q) {
            const int col = F.tid + 512 * q, c = col & 1023, dir = (col >> 10) & 1, o = col >> 11;
            float a[8];
#pragma unroll
            for (int p = 0; p < 8; ++p) a[p] = 0.f;
            float a0b = 0.f;
            for (int i = 0; i < 64; ++i) { const float w = w4[(size_t)i * 4096 + col];
#pragma unroll
                for (int p = 0; p < 8; ++p) a[p] += hbuf[p * 64 + i] * w;
                if (pg == 0 && dir == 0) a0b += hbuf[i] * w4[(size_t)i * 4096 + col + 1024]; }
            const float adel = 3.0701134573253945f + (float)c * ((15.350567286626973f - 3.0701134573253945f) / 1023.0f);
            bf16* kc = KERN + ((size_t)c * 2 + o) * 4096;
#pragma unroll
            for (int p = 0; p < 8; ++p) { const int tp = 8 * pg + p; const float v = a[p] * __expf(-((float)tp / (float)(SEQ - 1)) * adel);
                if (tp == 0) { if (dir == 0) { kc[2048] = (bf16)f2bf(v + a0b); kc[0] = 0; } }
                else kc[dir == 0 ? 2048 - tp : 2048 + tp] = (bf16)f2bf(v); }
        }
        __syncthreads();
    }
}

__device__ __forceinline__ void p0_prologue(Frame& F) {
    LAS float* scr = (LAS float*)(F.lds + 4096 + F.wave * 16384);
    const int gw = F.vcu * NWAVES + F.wave, NGW = F.G * NWAVES;
    hyena_filter(F);
    bf16* WINT = (bf16*)(F.ws + WS_WINT);
    constexpr int I_A = 16 * (9216 / 32), I_B = 16 * (64 / 32), I_C = 16 * (2048 / 32);
    constexpr int I_HY = 16 * 32, I_SS = 32 * 32, I_OUT = 16 * 32;
    constexpr int NITEMS = I_A + I_B + I_C + I_HY + I_SS + I_OUT;
    for (int it = gw; it < NITEMS; it += NGW) {
        int r = it;
        if (r < I_A) { tr_matrix_item(F.in[I_WIN], INC, DM, 0, 9216, WINT, 0, scr, r, F.lane); continue; } r -= I_A;
        if (r < I_B) { tr_matrix_item(F.in[I_WIN], INC, DM, 9216, 64, WINT, 9216, scr, r, F.lane); continue; } r -= I_B;
        if (r < I_C) { tr_matrix_item(F.in[I_WIN], INC, DM, 9280, 2048, WINT, 9472, scr, r, F.lane); continue; } r -= I_C;
        if (r < I_HY) { tr_matrix_item(F.in[I_WHYB], DM, DM, 0, DM, (bf16*)(F.ws + WS_WHYB), 0, scr, r, F.lane); continue; } r -= I_HY;
        if (r < I_SS) { tr_matrix_item(F.in[I_WSSDB], DM, DSSM, 0, DM, (bf16*)(F.ws + WS_WSSDB), 0, scr, r, F.lane); continue; } r -= I_SS;
        tr_matrix_item(F.in[I_WOUT], DM, DM, 0, DM, (bf16*)(F.ws + WS_WOUT), 0, scr, r, F.lane);
    }
    convert_x(F, F.in[I_X], (bf16*)(F.ws + WS_XB));
}
__device__ __forceinline__ void p6_reconvert(Frame& F) {
    LAS float* scr = (LAS float*)(F.lds + 4096 + F.wave * 16384);
    const int gw = F.vcu * NWAVES + F.wave, NGW = F.G * NWAVES;
    for (int it = gw; it < 16 * (2048 / 32); it += NGW) tr_matrix_item(F.in[I_WIN], INC, DM, 9280, 2048, (bf16*)(F.ws + WS_WING), 0, scr, it, F.lane);
    convert_x(F, F.in[I_X], (bf16*)(F.ws + WS_XB2));
}
__device__ __forceinline__ void p10_expert_weights(Frame& F) {
    LAS float* scr = (LAS float*)(F.lds + 4096 + F.wave * 16384);
    const int gw = F.vcu * NWAVES + F.wave, NGW = F.G * NWAVES;
    bf16* EW1 = (bf16*)(F.ws + WS_EW1); bf16* EW2 = (bf16*)(F.ws + WS_EW2);
    constexpr int PER1 = 16 * 4;
    constexpr int N1 = NEX * 2 * 2 * PER1, PER2 = 4 * 32, N2 = NEX * PER2;
    for (int it = gw; it < N1 + N2; it += NGW) {
        if (it < N1) { const int e = it / (4 * PER1), r0 = it % (4 * PER1), mat = r0 / (2 * PER1), r1 = r0 % (2 * PER1), ct = r1 / PER1, r2 = r1 % PER1;
            const float* src = (e < NE) ? F.in[mat ? I_EWU : I_EWG] + (size_t)e * DM * DEXP : F.in[mat ? I_SWU : I_SWG];
            tr_matrix_item(src, DEXP, DM, 128 * ct, 128, EW1 + (size_t)e * 512 * DM, 256 * ct + 128 * mat, scr, r2, F.lane); }
        else { const int r = it - N1, e = r / PER2, r2 = r % PER2;
            const float* src = (e < NE) ? F.in[I_EWD] + (size_t)e * DEXP * DM : F.in[I_SWD];
            tr_matrix_item(src, DM, DEXP, 0, DM, EW2 + (size_t)e * DM * DEXP, 0, scr, r2, F.lane); }
    }
}
__device__ __forceinline__ void p3_transpose(Frame& F) {
    const bf16* YT = (const bf16*)(F.ws + WS_YTHY); bf16* Y = (bf16*)(F.ws + WS_YHY);
    LAS bf16* scr = (LAS bf16*)(F.lds + F.wave * 9216);
    const int gw = F.vcu * NWAVES + F.wave, NGW = F.G * NWAVES, lane = F.lane;
    for (int tile = gw; tile < 16 * 512; tile += NGW) {
        const int c0 = (tile & 15) * 64, t0 = (tile >> 4) * 64;
#pragma unroll
        for (int p = 0; p < 8; ++p) { const int c = p * 8 + (lane >> 3), ch = lane & 7;
            const u32x4 g = *(const u32x4*)(YT + (size_t)(c0 + c) * MTOK + t0 + ch * 8);
            LAS bf16* d = scr + (ch * 8) * 72 + c;
            d[0 * 72] = (bf16)(g.x & 0xffff); d[1 * 72] = (bf16)(g.x >> 16); d[2 * 72] = (bf16)(g.y & 0xffff); d[3 * 72] = (bf16)(g.y >> 16);
            d[4 * 72] = (bf16)(g.z & 0xffff); d[5 * 72] = (bf16)(g.z >> 16); d[6 * 72] = (bf16)(g.w & 0xffff); d[7 * 72] = (bf16)(g.w >> 16); }
        LDS_WAIT(); asm volatile("" ::: "memory");
#pragma unroll
        for (int p = 0; p < 8; ++p) { const int tk = p * 8 + (lane >> 3), ch = lane & 7;
            const u32x4 v = *(const LAS u32x4*)(scr + tk * 72 + ch * 8);
            *(u32x4*)(Y + (size_t)(t0 + tk) * DM + c0 + ch * 8) = v; }
        LDS_WAIT(); asm volatile("" ::: "memory");
    }
}

constexpr int HY_LDU = 2064, HY_KCS = 4128, HY_U_BYTES = 16 * HY_LDU * 2, HY_KC_BYTES = 8 * HY_KCS * 2;

__device__ __forceinline__ void hy_build_kc(LAS bf16* KC, const bf16* kern, int tid) {
    const u32x4 g = *(const u32x4*)(kern + 8 * tid);
    const unsigned short e[8] = {(unsigned short)(g.x & 0xffff), (unsigned short)(g.x >> 16), (unsigned short)(g.y & 0xffff), (unsigned short)(g.y >> 16),
                                 (unsigned short)(g.z & 0xffff), (unsigned short)(g.z >> 16), (unsigned short)(g.w & 0xffff), (unsigned short)(g.w >> 16)};
#pragma unroll
    for (int fl = 0; fl < 8; ++fl)
#pragma unroll
        for (int j = 0; j < 8; ++j) KC[fl * HY_KCS + 8 * tid + j + fl] = e[j];
}
__device__ __forceinline__ f32x4 hy_short4(const bf16* prow, int t0, float w0, float w1, float w2, float cb) {
    const u32x2 g = *(const u32x2*)(prow + t0);
    const float p0 = bflo(g.x), p1 = bfhi(g.x), p2 = bflo(g.y), p3 = bfhi(g.y);
    const float pm = (t0 > 0) ? bf2f(prow[t0 - 1]) : 0.f, pp = (t0 + 4 < SEQ) ? bf2f(prow[t0 + 4]) : 0.f;
    f32x4 r; r[0] = cb + w0 * pm + w1 * p0 + w2 * p1; r[1] = cb + w0 * p0 + w1 * p1 + w2 * p2; r[2] = cb + w0 * p1 + w1 * p2 + w2 * p3; r[3] = cb + w0 * p2 + w1 * p3 + w2 * pp;
    return r;
}
__device__ __forceinline__ void hyena_phase(Frame& F) {
    LAS bf16* U = (LAS bf16*)(F.lds); LAS bf16* KC = (LAS bf16*)(F.lds + HY_U_BYTES);
    const bf16* PT = (const bf16*)(F.ws + WS_PTHY); const bf16* KERN = (const bf16*)(F.ws + WS_KERN); bf16* YT = (bf16*)(F.ws + WS_YTHY);
    const float* cw = F.in[I_HCW]; const float* cbv = F.in[I_HCB]; const float* hb = F.in[I_HBIAS];
    const int tid = F.tid, lane = F.lane, w = F.wave, fr = lane & 15, fq = lane >> 4;
    for (int c = F.vcu; c < DM; c += F.G) {
        hy_build_kc(KC, KERN + ((size_t)c * 2 + 0) * 4096, tid);
        { const int vc = 2048 + c; const float w0 = cw[0 * HYC + vc], w1 = cw[1 * HYC + vc], w2 = cw[2 * HYC + vc], cb = cbv[vc];
          const bf16* prow = PT + (size_t)vc * MTOK;
#pragma unroll 2
          for (int it = 0; it < 8; ++it) { const int idx = tid + 512 * it, b = idx >> 8, t8 = (idx & 255) * 8;
              const f32x4 lo = hy_short4(prow + (size_t)b * SEQ, t8, w0, w1, w2, cb), hi = hy_short4(prow + (size_t)b * SEQ, t8 + 4, w0, w1, w2, cb);
              u32x4 o; o.x = pk2(lo[0], lo[1]); o.y = pk2(lo[2], lo[3]); o.z = pk2(hi[0], hi[1]); o.w = pk2(hi[2], hi[3]);
              *(LAS u32x4*)(U + b * HY_LDU + t8) = o; } }
        __syncthreads();
#pragma unroll 1
        for (int o = 0; o < 2; ++o) {
            f32x4 acc[16];
#pragma unroll
            for (int i = 0; i < 16; ++i) acc[i] = (f32x4){0.f, 0.f, 0.f, 0.f};
            const LAS bf16* kbase = KC + (fr & 7) * HY_KCS + 2048 + 8 * fq - 8 * (fr >> 3) - 256 * w;
            const LAS bf16* ubase = U + fr * HY_LDU + 8 * fq;
            bf16x8 win[16];
#pragma unroll
            for (int i = 0; i < 16; ++i) win[i] = *(const LAS bf16x8*)(kbase - 16 * i);
#pragma unroll 1
            for (int sj8 = 0; sj8 < 64; sj8 += 8) {
#pragma unroll
                for (int u = 0; u < 8; ++u) { const int sj = sj8 + u;
                    const bf16x8 bfr = *(const LAS bf16x8*)(ubase + 32 * sj);
#pragma unroll
                    for (int tt = 0; tt < 16; ++tt) acc[tt] = __builtin_amdgcn_mfma_f32_16x16x32_bf16(win[(tt - 2 * u) & 15], bfr, acc[tt], 0, 0, 0);
                    win[(14 - 2 * u) & 15] = *(const LAS bf16x8*)(kbase + 16 * (2 * sj + 2));
                    win[(15 - 2 * u) & 15] = *(const LAS bf16x8*)(kbase + 16 * (2 * sj + 1));
                } }
            const float hbias = hb[o * DM + c];
            const int gc = (o == 0) ? c : 1024 + c;
            const float w0 = cw[0 * HYC + gc], w1 = cw[1 * HYC + gc], w2 = cw[2 * HYC + gc], cb = cbv[gc];
            const bf16* grow = PT + (size_t)gc * MTOK + (size_t)fr * SEQ;
            u32x2 zpk[16];
#pragma unroll
            for (int tt = 0; tt < 16; ++tt) { const int t0 = 256 * w + 16 * tt + 4 * fq;
                const u32x2 uu = *(const LAS u32x2*)(U + fr * HY_LDU + t0);
                const f32x4 g = hy_short4(grow, t0, w0, w1, w2, cb);
                f32x4 y = acc[tt]; y[0] = g[0] * (y[0] + bflo(uu.x) * hbias); y[1] = g[1] * (y[1] + bfhi(uu.x) * hbias); y[2] = g[2] * (y[2] + bflo(uu.y) * hbias); y[3] = g[3] * (y[3] + bfhi(uu.y) * hbias);
                zpk[tt].x = pk2(y[0], y[1]); zpk[tt].y = pk2(y[2], y[3]); }
            __syncthreads();
            if (o == 0) {
#pragma unroll
                for (int tt = 0; tt < 16; ++tt) *(LAS u32x2*)(U + fr * HY_LDU + 256 * w + 16 * tt + 4 * fq) = zpk[tt];
                hy_build_kc(KC, KERN + ((size_t)c * 2 + 1) * 4096, tid);
                __syncthreads();
            } else {
                bf16* yrow = YT + (size_t)c * MTOK + (size_t)fr * SEQ + 256 * w + 4 * fq;
#pragma unroll
                for (int tt = 0; tt < 16; ++tt) *(u32x2*)(yrow + 16 * tt) = zpk[tt];
            }
        }
    }
}

__device__ __forceinline__ void ssd_conv_phase(Frame& F) {
    bf16* XBC = (bf16*)(F.ws + WS_XBC); const bf16* HALO = (const bf16*)(F.ws + WS_HALO);
    const float* scw = F.in[I_SCW]; const float* scb = F.in[I_SCB];
    const int gw = F.vcu * NWAVES + F.wave, NGW = F.G * NWAVES, lane = F.lane;
    for (int item = gw; item < BATCH * 32 * 8; item += NGW) {
        const int cb8 = item & 7, seg = (item >> 3) & 31, b = item >> 8, col = cb8 * 512 + lane * 8;
        float wk[5][8], cbv[8];
#pragma unroll
        for (int k = 0; k < 5; ++k) { const f32x4 a = *(const f32x4*)(scw + k * CONVD + col), c = *(const f32x4*)(scw + k * CONVD + col + 4);
#pragma unroll
            for (int e = 0; e < 4; ++e) { wk[k][e] = a[e]; wk[k][4 + e] = c[e]; } }
        { const f32x4 a = *(const f32x4*)(scb + col), c = *(const f32x4*)(scb + col + 4);
#pragma unroll
          for (int e = 0; e < 4; ++e) { cbv[e] = a[e]; cbv[4 + e] = c[e]; } }
        bf16* xrow0 = XBC + ((size_t)b * SEQ + seg * 64) * CONVD + col;
        const bf16* hlo = HALO + ((size_t)(b * 33 + seg) * 4) * CONVD + col;
        const bf16* hhi = HALO + ((size_t)(b * 33 + seg + 1) * 4 + 2) * CONVD + col;
        const u32x4 zero4 = {0u, 0u, 0u, 0u};
        u32x4 W[12];
        W[0] = seg > 0 ? *(const u32x4*)(hlo) : zero4; W[1] = seg > 0 ? *(const u32x4*)(hlo + CONVD) : zero4;
        W[2] = *(const u32x4*)(xrow0); W[3] = *(const u32x4*)(xrow0 + CONVD);
#pragma unroll 1
        for (int blk = 0; blk < 8; ++blk) { const int r0 = 8 * blk;
#pragma unroll
            for (int i = 4; i < 12; ++i) { const int rr = r0 - 2 + i;
                if (rr < 64) W[i] = *(const u32x4*)(xrow0 + (size_t)rr * CONVD);
                else W[i] = (seg < 31) ? *(const u32x4*)(hhi + (size_t)(rr - 64) * CONVD) : zero4; }
#pragma unroll
            for (int o = 0; o < 8; ++o) { float v[8];
#pragma unroll
                for (int e = 0; e < 8; ++e) v[e] = cbv[e];
#pragma unroll
                for (int k = 0; k < 5; ++k) { const u32x4 p = W[o + k];
                    v[0] += wk[k][0] * bflo(p.x); v[1] += wk[k][1] * bfhi(p.x); v[2] += wk[k][2] * bflo(p.y); v[3] += wk[k][3] * bfhi(p.y);
                    v[4] += wk[k][4] * bflo(p.z); v[5] += wk[k][5] * bfhi(p.z); v[6] += wk[k][6] * bflo(p.w); v[7] += wk[k][7] * bfhi(p.w); }
#pragma unroll
                for (int e = 0; e < 8; ++e) v[e] = siluf_(v[e]);
                u32x4 ov; ov.x = pk2(v[0], v[1]); ov.y = pk2(v[2], v[3]); ov.z = pk2(v[4], v[5]); ov.w = pk2(v[6], v[7]);
                *(u32x4*)(xrow0 + (size_t)(r0 + o) * CONVD) = ov; }
#pragma unroll
            for (int i = 0; i < 4; ++i) W[i] = W[8 + i];
        }
    }
}

constexpr int SS_LDC = 144, SS_LDT = 80;
constexpr int SS_C = 0, SS_B = 18432, SS_BT = 36864, SS_M = 57344, SS_XD = 77824, SS_XE = 98304, SS_SB = 118784, SS_ACS = 155648, SS_DTV = 156672, SS_TOE = 157696, SS_END = 158720;
static_assert(SS_END <= MISC_OFF, "SSD LDS map");

template <int KS>
__device__ __forceinline__ f32x4 mma16(const LAS bf16* arow, const LAS bf16* brow, f32x4 acc) {
    bf16x8 a[KS], b[KS];
#pragma unroll
    for (int kk = 0; kk < KS; ++kk) { a[kk] = *(const LAS bf16x8*)(arow + 32 * kk); b[kk] = *(const LAS bf16x8*)(brow + 32 * kk); }
#pragma unroll
    for (int kk = 0; kk < KS; ++kk) acc = __builtin_amdgcn_mfma_f32_16x16x32_bf16(a[kk], b[kk], acc, 0, 0, 0);
    return acc;
}

__device__ __forceinline__ void ssd_phase(Frame& F) {
    LAS unsigned char* L = F.lds;
    LAS bf16* Cl = (LAS bf16*)(L + SS_C); LAS bf16* Bl = (LAS bf16*)(L + SS_B); LAS bf16* BT = (LAS bf16*)(L + SS_BT); LAS bf16* Ml = (LAS bf16*)(L + SS_M);
    LAS bf16* XD = (LAS bf16*)(L + SS_XD); LAS bf16* XE = (LAS bf16*)(L + SS_XE); LAS bf16* SB = (LAS bf16*)(L + SS_SB);
    LAS float* ACS = (LAS float*)(L + SS_ACS); LAS float* DTV = (LAS float*)(L + SS_DTV); LAS float* TOE = (LAS float*)(L + SS_TOE);
    const bf16* XBC = (const bf16*)(F.ws + WS_XBC); const float* DT = (const float*)(F.ws + WS_DT); const bf16* Zb = (const bf16*)F.out; bf16* YS = (bf16*)(F.ws + WS_YSSD);
    const float* dtb = F.in[I_DTB]; const float* alog = F.in[I_ALOG]; const float* sd = F.in[I_SD];
    const int tid = F.tid, lane = F.lane, w = F.wave, fr = lane & 15, fq = lane >> 4;
    for (int unit = F.vcu; unit < BATCH * NGRP * 2; unit += F.G) {
        const int b = unit >> 4, g = (unit >> 1) & 7, hp = unit & 1, h0 = 4 * g + 2 * hp;
#pragma unroll 1
        for (int dir = 0; dir < 2; ++dir) {
            const float dtbias = (w < 2) ? dtb[dir * 32 + h0 + w] : 0.f, aexp = (w < 2) ? __expf(alog[dir * 32 + h0 + w]) : 0.f;
            auto scan = [&](int buf, float raw) {
                raw += dtbias; const float dtv = raw > 20.f ? raw : log1pf(__expf(raw)); float a = -dtv * aexp;
#pragma unroll
                for (int o = 1; o < 64; o <<= 1) { const float v = __shfl_up(a, o); if (lane >= o) a += v; }
                const float tot = __shfl(a, 63); const int ix = (buf * 2 + w) * 64 + lane;
                ACS[ix] = a; DTV[ix] = dtv; TOE[ix] = __expf(tot - a); };
            auto dtload = [&](int ci) -> float { const int ch = dir ? 31 - ci : ci, r = dir ? 63 - lane : lane;
                return DT[((size_t)b * SEQ + 64 * ch + r) * 64 + dir * 32 + h0 + w]; };
            auto rowload = [&](int ci, int it, int tl) -> u32x4 { const int cg = (tl >> 6) + 8 * it, l = tl & 63, ch = dir ? 31 - ci : ci, r = dir ? 63 - l : l, lc0 = cg * 8;
                const int col = lc0 < 128 ? 64 * h0 + lc0 : (lc0 < 256 ? 2048 + 128 * g + (lc0 - 128) : 3072 + 128 * g + (lc0 - 256));
                return *(const u32x4*)(XBC + ((size_t)b * SEQ + 64 * ch + r) * CONVD + col); };
            f32x4 Sacc[8];
#pragma unroll
            for (int i = 0; i < 8; ++i) Sacc[i] = (f32x4){0.f, 0.f, 0.f, 0.f};
            const float dsk = sd[h0 + (w >> 2)];
            __syncthreads();
            for (int i = tid; i < 2 * 64 * SS_LDC / 2; i += NTHR) ((LAS unsigned*)SB)[i] = 0u;
            float dtn = 0.f;
            if (w < 2) { scan(0, dtload(0)); dtn = dtload(1); }
            u32x4 pf[6];
#pragma unroll
            for (int it = 0; it < 6; ++it) pf[it] = rowload(0, it, tid);
            __syncthreads();
#pragma unroll 1
            for (int ci = 0; ci < 32; ++ci) {
                const int ch = dir ? 31 - ci : ci, buf = ci & 1;
                const size_t tokbase = (size_t)b * SEQ + 64 * ch;
                int tl = tid; asm volatile("" : "+v"(tl));
                const LAS float* acs = ACS + buf * 128; const LAS float* dtv = DTV + buf * 128; const LAS float* toe = TOE + buf * 128;
#pragma unroll
                for (int it = 0; it < 6; ++it) { const int cg = (tl >> 6) + 8 * it, l = tl & 63; const u32x4 p = pf[it];
                    if (it < 2) { const int hh = cg >> 3, p0 = (cg & 7) * 8; const float d = dtv[hh * 64 + l], de = d * toe[hh * 64 + l];
                        const float v[8] = {bflo(p.x), bfhi(p.x), bflo(p.y), bfhi(p.y), bflo(p.z), bfhi(p.z), bflo(p.w), bfhi(p.w)};
#pragma unroll
                        for (int e = 0; e < 8; ++e) { XD[(hh * 64 + p0 + e) * SS_LDT + l] = (bf16)f2bf(v[e] * d); XE[(hh * 64 + p0 + e) * SS_LDT + l] = (bf16)f2bf(v[e] * de); } }
                    else if (it < 4) { const int n0 = (cg - 16) * 8; *(LAS u32x4*)(Bl + l * SS_LDC + n0) = p;
                        LAS bf16* d = BT + n0 * SS_LDT + l;
                        d[0 * SS_LDT] = (bf16)(p.x & 0xffff); d[1 * SS_LDT] = (bf16)(p.x >> 16); d[2 * SS_LDT] = (bf16)(p.y & 0xffff); d[3 * SS_LDT] = (bf16)(p.y >> 16);
                        d[4 * SS_LDT] = (bf16)(p.z & 0xffff); d[5 * SS_LDT] = (bf16)(p.z >> 16); d[6 * SS_LDT] = (bf16)(p.w & 0xffff); d[7 * SS_LDT] = (bf16)(p.w >> 16); }
                    else { const int n0 = (cg - 32) * 8; *(LAS u32x4*)(Cl + l * SS_LDC + n0) = p; } }
                if (ci + 1 < 32) {
#pragma unroll
                    for (int it = 0; it < 6; ++it) pf[it] = rowload(ci + 1, it, tl); }
                __syncthreads();
                const int hh = w >> 2, li = w & 3, lrow = 16 * li + fr;
                const int rloc = dir ? 63 - lrow : lrow; const size_t tok = tokbase + rloc;
                u32x2 pv[4], zv[4];
                if (dir) {
#pragma unroll
                    for (int pi = 0; pi < 4; ++pi) { const size_t o = tok * DSSM + 64 * (h0 + hh) + 16 * pi + 4 * fq; pv[pi] = *(const u32x2*)(YS + o); zv[pi] = *(const u32x2*)(Zb + o); } }
#pragma unroll
                for (int q = 0; q < 2; ++q) { const int id = 2 * w + q, si = id >> 2, lj = id & 3, l = 16 * lj + fr, s0 = 16 * si + 4 * fq;
                    u32x2 m0 = {0u, 0u}, m1 = {0u, 0u};
                    if (si <= lj) { f32x4 cb = (f32x4){0.f, 0.f, 0.f, 0.f};
                        cb = mma16<4>(Bl + (16 * si + fr) * SS_LDC + 8 * fq, Cl + (16 * lj + fr) * SS_LDC + 8 * fq, cb);
                        const float a0 = acs[l], a1 = acs[64 + l]; float x0[4], x1[4];
#pragma unroll
                        for (int j = 0; j < 4; ++j) { const int s = s0 + j; x0[j] = (s <= l) ? cb[j] * __expf(a0 - acs[s]) : 0.f; x1[j] = (s <= l) ? cb[j] * __expf(a1 - acs[64 + s]) : 0.f; }
                        m0.x = pk2(x0[0], x0[1]); m0.y = pk2(x0[2], x0[3]); m1.x = pk2(x1[0], x1[1]); m1.y = pk2(x1[2], x1[3]); }
                    *(LAS u32x2*)(Ml + (0 * 64 + l) * SS_LDT + s0) = m0; *(LAS u32x2*)(Ml + (1 * 64 + l) * SS_LDT + s0) = m1; }
                f32x4 Y[4];
                { bf16x8 cfr[4];
#pragma unroll
                  for (int kk = 0; kk < 4; ++kk) cfr[kk] = *(const LAS bf16x8*)(Cl + lrow * SS_LDC + 8 * fq + 32 * kk);
#pragma unroll
                  for (int pi = 0; pi < 4; ++pi) { Y[pi] = (f32x4){0.f, 0.f, 0.f, 0.f}; const LAS bf16* ar = SB + (hh * 64 + 16 * pi + fr) * SS_LDC + 8 * fq;
#pragma unroll
                      for (int kk = 0; kk < 4; ++kk) Y[pi] = __builtin_amdgcn_mfma_f32_16x16x32_bf16(*(const LAS bf16x8*)(ar + 32 * kk), cfr[kk], Y[pi], 0, 0, 0); } }
                __syncthreads();
                { const float el = __expf(acs[hh * 64 + lrow]);
                  const float dinv = __builtin_amdgcn_rcpf(dtv[hh * 64 + lrow]);
                  const bf16x8 mf0 = *(const LAS bf16x8*)(Ml + (hh * 64 + lrow) * SS_LDT + 8 * fq), mf1 = *(const LAS bf16x8*)(Ml + (hh * 64 + lrow) * SS_LDT + 8 * fq + 32);
#pragma unroll
                  for (int pi = 0; pi < 4; ++pi) { Y[pi] = Y[pi] * el; const LAS bf16* ar = XD + (hh * 64 + 16 * pi + fr) * SS_LDT + 8 * fq;
                      Y[pi] = __builtin_amdgcn_mfma_f32_16x16x32_bf16(*(const LAS bf16x8*)(ar), mf0, Y[pi], 0, 0, 0);
                      Y[pi] = __builtin_amdgcn_mfma_f32_16x16x32_bf16(*(const LAS bf16x8*)(ar + 32), mf1, Y[pi], 0, 0, 0);
                      const int p0 = 16 * pi + 4 * fq; bf16* yp = YS + tok * DSSM + 64 * (h0 + hh) + p0; f32x4 y = Y[pi];
                      if (dir == 0) {
#pragma unroll
                          for (int j = 0; j < 4; ++j) y[j] += dsk * dinv * bf2f(XD[(hh * 64 + p0 + j) * SS_LDT + lrow]);
                      } else { const u32x2 pvv = pv[pi], zvv = zv[pi];
                          y[0] = (y[0] + bflo(pvv.x)) * siluf_(bflo(zvv.x)); y[1] = (y[1] + bfhi(pvv.x)) * siluf_(bfhi(zvv.x)); y[2] = (y[2] + bflo(pvv.y)) * siluf_(bflo(zvv.y)); y[3] = (y[3] + bfhi(pvv.y)) * siluf_(bfhi(zvv.y)); }
                      u32x2 o; o.x = pk2(y[0], y[1]); o.y = pk2(y[2], y[3]); *(u32x2*)yp = o; } }
                { const int pi = w & 3; const float dec = __expf(acs[hh * 64 + 63]);
                  const bf16x8 xf0 = *(const LAS bf16x8*)(XE + (hh * 64 + 16 * pi + fr) * SS_LDT + 8 * fq), xf1 = *(const LAS bf16x8*)(XE + (hh * 64 + 16 * pi + fr) * SS_LDT + 8 * fq + 32);
#pragma unroll
                  for (int ni = 0; ni < 8; ++ni) { Sacc[ni] = Sacc[ni] * dec; const LAS bf16* ar = BT + (16 * ni + fr) * SS_LDT + 8 * fq;
                      Sacc[ni] = __builtin_amdgcn_mfma_f32_16x16x32_bf16(*(const LAS bf16x8*)(ar), xf0, Sacc[ni], 0, 0, 0);
                      Sacc[ni] = __builtin_amdgcn_mfma_f32_16x16x32_bf16(*(const LAS bf16x8*)(ar + 32), xf1, Sacc[ni], 0, 0, 0);
                      u32x2 o; o.x = pk2(Sacc[ni][0], Sacc[ni][1]); o.y = pk2(Sacc[ni][2], Sacc[ni][3]);
                      *(LAS u32x2*)(SB + (hh * 64 + 16 * pi + fr) * SS_LDC + 16 * ni + 4 * fq) = o; } }
                if (w < 2 && ci + 1 < 32) { scan(buf ^ 1, dtn); if (ci + 2 < 32) dtn = dtload(ci + 2); }
                __syncthreads();
            }
        }
    }
}

__device__ __forceinline__ void ssd_norm_phase(Frame& F) {
    bf16* YS = (bf16*)(F.ws + WS_YSSD); const float* nw = F.in[I_SNW];
    const int gw = F.vcu * NWAVES + F.wave, NGW = F.G * NWAVES, lane = F.lane;
    for (int m = gw; m < MTOK; m += NGW) { bf16* row = YS + (size_t)m * DSSM + lane * 32;
        u32x4 v[4]; float ss = 0.f;
#pragma unroll
        for (int j = 0; j < 4; ++j) { v[j] = *(const u32x4*)(row + 8 * j);
            const float a0 = bflo(v[j].x), a1 = bfhi(v[j].x), a2 = bflo(v[j].y), a3 = bfhi(v[j].y), a4 = bflo(v[j].z), a5 = bfhi(v[j].z), a6 = bflo(v[j].w), a7 = bfhi(v[j].w);
            ss += (a0 * a0 + a1 * a1) + (a2 * a2 + a3 * a3) + (a4 * a4 + a5 * a5) + (a6 * a6 + a7 * a7); }
        ss += __shfl_xor(ss, 1); ss += __shfl_xor(ss, 2); ss += __shfl_xor(ss, 4);
        const float rs = 1.0f / sqrtf(ss * (1.0f / 256.0f) + RMS_EPS);
#pragma unroll
        for (int j = 0; j < 4; ++j) { const f32x4 w0 = *(const f32x4*)(nw + lane * 32 + 8 * j), w1 = *(const f32x4*)(nw + lane * 32 + 8 * j + 4);
            u32x4 o; o.x = pk2(bflo(v[j].x) * rs * w0[0], bfhi(v[j].x) * rs * w0[1]); o.y = pk2(bflo(v[j].y) * rs * w0[2], bfhi(v[j].y) * rs * w0[3]);
            o.z = pk2(bflo(v[j].z) * rs * w1[0], bfhi(v[j].z) * rs * w1[1]); o.w = pk2(bflo(v[j].w) * rs * w1[2], bfhi(v[j].w) * rs * w1[3]);
            *(u32x4*)(row + 8 * j) = o; } }
}

constexpr int RT_WC = 131072;
__device__ __forceinline__ void ln1_router_phase(Frame& F) {
    float* H1 = (float*)(F.ws + WS_H1); bf16* H1B = (bf16*)(F.ws + WS_H1B);
    int* TOK = (int*)(F.ws + WS_TOK); float* WGT = (float*)(F.ws + WS_WGT); int* ASG = (int*)(F.ws + WS_ASG);
    const float* g1 = F.in[I_LN1G]; const float* b1 = F.in[I_LN1B]; const float* rw = F.in[I_RW]; const float* rb = F.in[I_RB];
    LAS float* hrow = (LAS float*)(F.lds + F.wave * 16384);
    LAS float* wc = (LAS float*)(F.lds + RT_WC);
    const int lane = F.lane, tid = F.tid;
    f32x4 gv[4], bv[4];
#pragma unroll
    for (int j = 0; j < 4; ++j) { gv[j] = *(const f32x4*)(g1 + 4 * lane + 256 * j); bv[j] = *(const f32x4*)(b1 + 4 * lane + 256 * j); }
    const float rbias = rb[lane];
    for (int step = F.vcu; step < MTOK / 32; step += F.G) {
        const int rg = step * 8 + F.wave;
        f32x4 nx0 = *(const f32x4*)(rw + tid * 4), nx1 = *(const f32x4*)(rw + 2048 + tid * 4);
#pragma unroll 1
        for (int r = 0; r < 4; ++r) { const size_t m = (size_t)rg * 4 + r; float* xr = H1 + m * DM;
            f32x4 v[4]; float s = 0.f;
#pragma unroll
            for (int j = 0; j < 4; ++j) { v[j] = *(const f32x4*)(xr + 4 * lane + 256 * j); s += (v[j][0] + v[j][1]) + (v[j][2] + v[j][3]); }
            const float mean = wave_sum(s) * (1.f / DM); float s2 = 0.f;
#pragma unroll
            for (int j = 0; j < 4; ++j) { v[j] = v[j] - mean; s2 += (v[j][0] * v[j][0] + v[j][1] * v[j][1]) + (v[j][2] * v[j][2] + v[j][3] * v[j][3]); }
            const float rstd = 1.f / sqrtf(wave_sum(s2) * (1.f / DM) + LN_EPS);
#pragma unroll
            for (int j = 0; j < 4; ++j) { const f32x4 h = v[j] * rstd * gv[j] + bv[j];
                *(f32x4*)(xr + 4 * lane + 256 * j) = h * DN_ALPHA;
                u32x2 o; o.x = pk2(h[0], h[1]); o.y = pk2(h[2], h[3]); *(u32x2*)(H1B + m * DM + 4 * lane + 256 * j) = o;
                *(LAS f32x4*)(hrow + r * 1024 + 4 * lane + 256 * j) = h; } }
        float lg[4] = {0.f, 0.f, 0.f, 0.f};
#pragma unroll 1
        for (int kc = 0; kc < 16; ++kc) {
            __syncthreads();
            *(LAS f32x4*)(wc + tid * 4) = nx0; *(LAS f32x4*)(wc + 2048 + tid * 4) = nx1;
            if (kc + 1 < 16) { nx0 = *(const f32x4*)(rw + (kc + 1) * 4096 + tid * 4); nx1 = *(const f32x4*)(rw + (kc + 1) * 4096 + 2048 + tid * 4); }
            __syncthreads();
#pragma unroll 4
            for (int kk = 0; kk < 64; kk += 4) {
                const float w0 = wc[(kk + 0) * 64 + lane], w1 = wc[(kk + 1) * 64 + lane], w2 = wc[(kk + 2) * 64 + lane], w3 = wc[(kk + 3) * 64 + lane];
#pragma unroll
                for (int r = 0; r < 4; ++r) { const f32x4 h = *(const LAS f32x4*)(hrow + r * 1024 + kc * 64 + kk); lg[r] += h[0] * w0 + h[1] * w1 + h[2] * w2 + h[3] * w3; } }
        }
#pragma unroll 1
        for (int r = 0; r < 4; ++r) { const int m = rg * 4 + r;
            const float score = 1.0f / (1.0f + expf(-lg[r])), biased = score + rbias;
            float m1 = biased; m1 = fmaxf(m1, __shfl_xor(m1, 1)); m1 = fmaxf(m1, __shfl_xor(m1, 2)); m1 = fmaxf(m1, __shfl_xor(m1, 4));
            const unsigned long long eq = __ballot(biased == m1); const int gbase = lane & ~7; const int first = gbase + __ffs((unsigned)((eq >> gbase) & 0xffull)) - 1;
            float v2 = (lane == first) ? -INFINITY : biased; v2 = fmaxf(v2, __shfl_xor(v2, 1)); v2 = fmaxf(v2, __shfl_xor(v2, 2)); v2 = fmaxf(v2, __shfl_xor(v2, 4));
            const float gs = m1 + v2; const int g = lane >> 3; int better = 0;
#pragma unroll
            for (int d = 1; d < 8; ++d) { const int g2 = (g + d) & 7; const float og = __shfl(gs, g2 * 8); better += (og > gs || (og == gs && g2 < g)) ? 1 : 0; }
            float masked = (better < 4) ? biased : -INFINITY; bool sel = false;
#pragma unroll 1
            for (int it = 0; it < TOPK; ++it) { const float mx = wave_max(masked); const unsigned long long bm = __ballot(masked == mx); const int win = __ffsll((long long)bm) - 1;
                if (lane == win) { sel = true; masked = -INFINITY; } }
            const float sw = wave_sum(sel ? score : 0.f);
            const unsigned long long selm = __ballot(sel);
            if (sel) { const unsigned pos = __hip_atomic_fetch_add((unsigned*)(F.ctl + CW_CNT + 64 * lane), 1u, __ATOMIC_RELAXED, __HIP_MEMORY_SCOPE_AGENT);
                TOK[(size_t)lane * MTOK + pos] = m; WGT[(size_t)lane * MTOK + pos] = score / sw * ROUTED_SCALE;
                ASG[(size_t)m * 8 + __popcll(selm & ((1ull << lane) - 1ull))] = lane * MTOK + (int)pos; } }
    }
}
constexpr int MOE_TP = 131072 + 1024, MOE_CNT = MOE_TP + 512;
__device__ __forceinline__ int moe_table(Frame& F) {
    LAS int* tp = (LAS int*)(F.lds + MOE_TP); LAS int* cnt = (LAS int*)(F.lds + MOE_CNT);
    __syncthreads();
    if (F.tid == 0) { int run = 0;
        for (int e = 0; e < NEX; ++e) { const int c = (e < NE) ? (int)__hip_atomic_load((unsigned*)(F.ctl + CW_CNT + 64 * e), __ATOMIC_RELAXED, __HIP_MEMORY_SCOPE_AGENT) : MTOK;
            cnt[e] = c; tp[e] = run; run += (c + 255) >> 8; }
        tp[NEX] = run; }
    __syncthreads();
    return tp[NEX];
}
__device__ __forceinline__ void fp8x8_fma(f32x4& a0, f32x4& a1, const u32x2 v, const float w) {
    const f32x2 p0 = __builtin_amdgcn_cvt_pk_f32_fp8((int)v.x, false), p1 = __builtin_amdgcn_cvt_pk_f32_fp8((int)v.x, true);
    const f32x2 p2 = __builtin_amdgcn_cvt_pk_f32_fp8((int)v.y, false), p3 = __builtin_amdgcn_cvt_pk_f32_fp8((int)v.y, true);
    a0[0] += w * p0.x; a0[1] += w * p0.y; a0[2] += w * p1.x; a0[3] += w * p1.y; a1[0] += w * p2.x; a1[1] += w * p2.y; a1[2] += w * p3.x; a1[3] += w * p3.y;
}
template <bool LAST>
__device__ __forceinline__ void moe_combine_phase(Frame& F, int p) {
    float* H1 = (float*)(F.ws + WS_H1); const unsigned char* YQ = (const unsigned char*)(F.ws + WS_YQ); const int* ASG = (const int*)(F.ws + WS_ASG); const float* WGT = (const float*)(F.ws + WS_WGT);
    const LAS int* tp = (const LAS int*)(F.lds + MOE_TP);
    const float* g2 = F.in[I_LN2G]; const float* b2 = F.in[I_LN2B];
    const int gw = F.vcu * NWAVES + F.wave, NGW = F.G * NWAVES, lane = F.lane;
    const size_t shbase = (size_t)tp[NE] * 256;
    for (int m = gw; m < MTOK; m += NGW) {
        int li = 0; if (lane < 8) li = ASG[(size_t)m * 8 + lane];
        float wk = 0.f; if (lane < 8) wk = WGT[li];
        const int e = li >> 15, pos = li & 32767; const int slot = 256 * tp[e] + pos;
        float* hp = H1 + (size_t)m * DM + 512 * p + 8 * lane;
        f32x4 a0 = *(const f32x4*)hp, a1 = *(const f32x4*)(hp + 4);
        u32x2 vv[9];
        vv[8] = *(const u32x2*)(YQ + (shbase + m) * 512 + 8 * lane);
#pragma unroll
        for (int k = 0; k < 8; ++k) { const int sk = __shfl(slot, k); vv[k] = *(const u32x2*)(YQ + (size_t)sk * 512 + 8 * lane); }
        fp8x8_fma(a0, a1, vv[8], 1.0f);
#pragma unroll
        for (int k = 0; k < 8; ++k) fp8x8_fma(a0, a1, vv[k], __shfl(wk, k));
        if (!LAST) { *(f32x4*)hp = a0; *(f32x4*)(hp + 4) = a1; }
        else { const float* xr = H1 + (size_t)m * DM + 8 * lane; f32x4 v[4]; float s = 0.f;
            v[0] = *(const f32x4*)xr; v[1] = *(const f32x4*)(xr + 4); v[2] = a0; v[3] = a1;
#pragma unroll
            for (int j = 0; j < 4; ++j) s += (v[j][0] + v[j][1]) + (v[j][2] + v[j][3]);
            const float mean = wave_sum(s) * (1.f / DM); float s2 = 0.f;
#pragma unroll
            for (int j = 0; j < 4; ++j) { v[j] = v[j] - mean; s2 += (v[j][0] * v[j][0] + v[j][1] * v[j][1]) + (v[j][2] * v[j][2] + v[j][3] * v[j][3]); }
            const float rstd = 1.f / sqrtf(wave_sum(s2) * (1.f / DM) + LN_EPS);
#pragma unroll
            for (int j = 0; j < 4; ++j) { const int c = (j >> 1) * 512 + 8 * lane + 4 * (j & 1); const f32x4 gv = *(const f32x4*)(g2 + c), bv = *(const f32x4*)(b2 + c);
                *(f32x4*)(F.out + (size_t)m * DM + c) = v[j] * rstd * gv + bv; } }
    }
}
__device__ __forceinline__ void ln2_phase(Frame& F) {
    const float* H1 = (const float*)(F.ws + WS_H1); const float* g2 = F.in[I_LN2G]; const float* b2 = F.in[I_LN2B];
    const int gw = F.vcu * NWAVES + F.wave, NGW = F.G * NWAVES, lane = F.lane;
    f32x4 gv[4], bv[4];
#pragma unroll
    for (int j = 0; j < 4; ++j) { gv[j] = *(const f32x4*)(g2 + 4 * lane + 256 * j); bv[j] = *(const f32x4*)(b2 + 4 * lane + 256 * j); }
    for (int m = gw; m < MTOK; m += NGW) { const float* xr = H1 + (size_t)m * DM;
        f32x4 v[4]; float s = 0.f;
#pragma unroll
        for (int j = 0; j < 4; ++j) { v[j] = *(const f32x4*)(xr + 4 * lane + 256 * j); s += (v[j][0] + v[j][1]) + (v[j][2] + v[j][3]); }
        const float mean = wave_sum(s) * (1.f / DM); float s2 = 0.f;
#pragma unroll
        for (int j = 0; j < 4; ++j) { v[j] = v[j] - mean; s2 += (v[j][0] * v[j][0] + v[j][1] * v[j][1]) + (v[j][2] * v[j][2] + v[j][3] * v[j][3]); }
        const float rstd = 1.f / sqrtf(wave_sum(s2) * (1.f / DM) + LN_EPS);
#pragma unroll
        for (int j = 0; j < 4; ++j) *(f32x4*)(F.out + (size_t)m * DM + 4 * lane + 256 * j) = v[j] * rstd * gv[j] + bv[j]; }
}

#ifndef MK_N_LAUNCHES
#define MK_N_LAUNCHES 1
#endif
constexpr int NPH = 15;
constexpr int N_LAUNCHES = MK_N_LAUNCHES;

__global__ void __launch_bounds__(NTHR, 2) fwd_kernel(Args args) {
    extern __shared__ __attribute__((aligned(16))) unsigned char lds_raw[];
    Frame F;
    F.lds = (LAS unsigned char*)lds_raw;
    F.MISC = (volatile LAS unsigned*)(F.lds + MISC_OFF);
    F.tid = threadIdx.x; F.lane = F.tid & 63; F.wave = __builtin_amdgcn_readfirstlane(F.tid >> 6);
    F.G = gridDim.x; { const int bx = blockIdx.x; F.vcu = (F.G % 8 == 0) ? (bx % 8) * (F.G / 8) + bx / 8 : bx; }
    F.ws = args.ws; F.ctl = (gu32*)(args.ws + WS_CTL); F.in = args.in; F.out = args.out;
    for (int u = F.tid; u < (LDS_BYTES - MISC_OFF) / 4; u += NTHR) ((LAS unsigned*)(F.lds + MISC_OFF))[u] = 0u;
    __syncthreads();
    XcdBarrier bar; bar.bar = (unsigned*)(F.ctl + CW_BAR); bar.x = 0; bar.st = nullptr;
    if (N_LAUNCHES != NPH) bar = xcd_barrier_post((unsigned*)(F.ctl + CW_BAR), F.MISC + 8);
    const int lo = args.ph_lo, hi = args.ph_hi;
#ifndef PH_MASK
#define PH_MASK 0x7fff
#endif
#define IN(k) ((((PH_MASK) >> (k)) & 1) && lo <= (k) && (k) < hi)
#define SEAM(k) do { if (IN(k) && IN((k) + 1)) xcd_barrier(bar); } while (0)
#ifndef REP_MASK
#define REP_MASK 0
#endif
#define REPS(k) for (int rep_ = 0; rep_ < ((((REP_MASK) >> (k)) & 1) ? 2 : 1); ++rep_, ((((REP_MASK) >> (k)) & 1) && rep_ == 1 ? xcd_barrier(bar) : (void)0))
    const int G = F.G, bx = (int)blockIdx.x;

    if (IN(0)) REPS(0) { p0_prologue(F); } SEAM(0);
    if (IN(1)) REPS(1) {
        pg8::StaticOrder S; S.init((const bf16*)(F.ws + WS_XB), (const bf16*)(F.ws + WS_WINT), MTOK, HYC, DM, G, bx);
        pg8::EpiHyT E{(bf16*)(F.ws + WS_PTHY), F.in[I_BIN]};
        pg8::gemm_phase<pg8::EpiHyT, pg8::StaticOrder, false>(F.lds, DM, S, E);
    } SEAM(1);
    if (IN(2)) REPS(2) { hyena_phase(F); } SEAM(2);
    if (IN(3)) REPS(3) { p3_transpose(F); } SEAM(3);
    if (IN(4)) REPS(4) {
        pg8::StaticOrder S; S.init((const bf16*)(F.ws + WS_XB), (const bf16*)(F.ws + WS_WINT) + (size_t)3072 * DM, MTOK, 6400, DM, G, bx);
        pg8::EpiZXD E{(bf16*)F.out, (bf16*)(F.ws + WS_XBC), (float*)(F.ws + WS_DT), F.in[I_BIN], (bf16*)(F.ws + WS_HALO)};
        pg8::gemm_phase<pg8::EpiZXD, pg8::StaticOrder, false>(F.lds, DM, S, E);
    } SEAM(4);
    if (IN(5)) REPS(5) { ssd_conv_phase(F); } SEAM(5);
    if (IN(6)) REPS(6) { ssd_phase(F); } SEAM(6);
    if (IN(7)) REPS(7) { ssd_norm_phase(F); p6_reconvert(F); } SEAM(7);
    if (IN(8)) REPS(8) {
        pg8::StaticOrder S; S.init((const bf16*)(F.ws + WS_XB2), (const bf16*)(F.ws + WS_WING), MTOK, 2048, DM, G, bx);
        pg8::EpiBf<0> E{(bf16*)(F.ws + WS_G), 2048, F.in[I_BIN] + 9280, nullptr, 0, nullptr};
        pg8::gemm_phase<pg8::EpiBf<0>, pg8::StaticOrder, false>(F.lds, DM, S, E);
    } SEAM(8);
    if (IN(9)) REPS(9) {
        pg8::StaticOrder S; S.init((const bf16*)(F.ws + WS_YHY), (const bf16*)(F.ws + WS_WHYB), MTOK, DM, DM, G, bx);
        pg8::EpiBf<1> E{(bf16*)(F.ws + WS_MIX), DM, nullptr, (const bf16*)(F.ws + WS_G), 2048, nullptr};
        pg8::gemm_phase<pg8::EpiBf<1>, pg8::StaticOrder, false>(F.lds, DM, S, E);
    } SEAM(9);
    if (IN(10)) REPS(10) {
        pg8::StaticOrder S; S.init((const bf16*)(F.ws + WS_YSSD), (const bf16*)(F.ws + WS_WSSDB), MTOK, DM, DSSM, G, bx);
        pg8::EpiBf<2> E{(bf16*)(F.ws + WS_MIX), DM, nullptr, (const bf16*)(F.ws + WS_G) + 1024, 2048, (const bf16*)(F.ws + WS_MIX)};
        pg8::gemm_phase<pg8::EpiBf<2>, pg8::StaticOrder, false>(F.lds, DSSM, S, E);
    } SEAM(10);
    if (IN(11)) REPS(11) {
        pg8::StaticOrder S; S.init((const bf16*)(F.ws + WS_MIX), (const bf16*)(F.ws + WS_WOUT), MTOK, DM, DM, G, bx);
        pg8::EpiRes E{(float*)(F.ws + WS_H1), F.in[I_BOUT], F.in[I_X], DN_ALPHA};
        pg8::gemm_phase<pg8::EpiRes, pg8::StaticOrder, false>(F.lds, DM, S, E);
        p10_expert_weights(F);
    } SEAM(11);
    if (IN(12)) REPS(12) { ln1_router_phase(F); } SEAM(12);
    if (IN(13)) REPS(13) {
        const int total = moe_table(F);
        pg8::MoeOrder<2, true> S{(const LAS int*)(F.lds + MOE_TP), (const LAS int*)(F.lds + MOE_CNT), G, bx, total, (const char*)(F.ws + WS_H1B), (const char*)(F.ws + WS_EW1), (const int*)(F.ws + WS_TOK)};
        pg8::EpiSwiGLU E{(bf16*)(F.ws + WS_HID)};
        pg8::gemm_phase<pg8::EpiSwiGLU, pg8::MoeOrder<2, true>, true>(F.lds, DM, S, E);
    } SEAM(13);
    if (IN(14)) {
        const int total = moe_table(F);
#pragma unroll 1
        for (int p = 0; p < 2; ++p) {
            { pg8::SlotOrder2 S{(const LAS int*)(F.lds + MOE_TP), G, bx, total, p, (const char*)(F.ws + WS_HID), (const char*)(F.ws + WS_EW2)};
              pg8::EpiSlot8 E{(unsigned char*)(F.ws + WS_YQ)};
              int kd = DEXP; asm volatile("" : "+s"(kd));
              pg8::gemm_phase<pg8::EpiSlot8, pg8::SlotOrder2, false>(F.lds, kd, S, E); }
            xcd_barrier(bar);
            if (p == 0) { moe_combine_phase<false>(F, p); xcd_barrier(bar); }
            else moe_combine_phase<true>(F, p);
        }
    }
#ifdef EXTRA_BARS
    for (int xb_ = 0; xb_ < EXTRA_BARS; ++xb_) xcd_barrier(bar);
#endif
#undef IN
#undef SEAM
}

extern "C" void kernel_launch(void* const* d_in, const int* in_sizes, int n_in, void* d_out, int out_size, void* d_ws, size_t ws_size, hipStream_t stream) {
    static int grid = 0;
    if (grid == 0) {
        if (n_in != 38 || out_size != MTOK * DM || ws_size < WS_END) { fprintf(stderr, "kernel_launch: unexpected shapes (n_in %d out %d ws %zu)\n", n_in, out_size, ws_size); grid = -1; return; }
        int dev = 0, cus = 0, per_cu = 0;
        if (hipGetDevice(&dev) != hipSuccess || hipDeviceGetAttribute(&cus, hipDeviceAttributeMultiprocessorCount, dev) != hipSuccess) { grid = -1; return; }
        if (hipFuncSetAttribute((const void*)fwd_kernel, hipFuncAttributeMaxDynamicSharedMemorySize, LDS_BYTES) != hipSuccess) { fprintf(stderr, "kernel_launch: hipFuncSetAttribute failed\n"); grid = -1; return; }
        if (hipOccupancyMaxActiveBlocksPerMultiprocessor(&per_cu, (const void*)fwd_kernel, NTHR, LDS_BYTES) != hipSuccess || per_cu < 1) fprintf(stderr, "kernel_launch: occupancy query says %d\n", per_cu);
        (void)hipGetLastError();
        grid = cus;
    }
    if (grid < 0) return;
    (void)hipMemsetAsync((char*)d_ws + WS_CTL, 0, CTL_ZERO_BYTES, stream);
    Args a{};
    for (int i = 0; i < 38; ++i) a.in[i] = (const float*)d_in[i];
    a.out = (float*)d_out; a.ws = (unsigned char*)d_ws;
    for (int li = 0; li < N_LAUNCHES; ++li) {
        a.ph_lo = (N_LAUNCHES == NPH) ? li : 0; a.ph_hi = (N_LAUNCHES == NPH) ? li + 1 : NPH; a.li = li;
        hipLaunchKernelGGL(fwd_kernel, dim3(grid), dim3(NTHR), LDS_BYTES, stream, a);
    }
}
```

```cpp
#define MK_N_LAUNCHES 1
#include <hip/hip_runtime.h>
#include <cstdio>
#include <cstdint>

#define LAS __attribute__((address_space(3)))
#define GAS __attribute__((address_space(1)))
typedef unsigned short bf16;
typedef short bf16x8 __attribute__((ext_vector_type(8)));
typedef float f32x4 __attribute__((ext_vector_type(4)));
typedef float f32x2 __attribute__((ext_vector_type(2)));
typedef unsigned u32x4 __attribute__((ext_vector_type(4)));
typedef unsigned u32x2 __attribute__((ext_vector_type(2)));
typedef GAS unsigned gu32;

constexpr int BATCH = 16, SEQ = 2048, DM = 1024, MTOK = BATCH * SEQ;
constexpr int HYC = 3072, DSSM = 2048, CONVD = 4096, NHEAD = 32, NGRP = 8, NSTATE = 128, INC = 11328;
constexpr int NE = 64, TOPK = 8, DEXP = 256, NEX = NE + 1;
constexpr float DN_ALPHA = 1.189207115002721f;
constexpr float LN_EPS = 1e-5f, RMS_EPS = 1e-5f, ROUTED_SCALE = 2.5f;
constexpr int NWAVES = 8, NTHR = 512;
constexpr int WIN_ROWS = 11520;

constexpr size_t MiB = 1u << 20;
constexpr size_t WS_CTL = 0, CTL_ZERO_BYTES = 256 * 1024;
constexpr size_t WS_WHYB = 1 * MiB, WS_WSSDB = 3 * MiB, WS_WOUT = 7 * MiB;
constexpr size_t WS_XB = 9 * MiB;
constexpr size_t WS_WINT = 73 * MiB;
constexpr size_t WS_KERN = 96 * MiB;
constexpr size_t WS_PTHY = 112 * MiB;
constexpr size_t WS_YTHY = 304 * MiB;
constexpr size_t WS_YHY = 137 * MiB;
constexpr size_t WS_XBC = 201 * MiB;
constexpr size_t WS_DT = 457 * MiB;
constexpr size_t WS_HALO = 465 * MiB;
constexpr size_t WS_YSSD = 9 * MiB;
constexpr size_t WS_XB2 = 201 * MiB;
constexpr size_t WS_WING = 265 * MiB;
constexpr size_t WS_G = 269 * MiB;
constexpr size_t WS_MIX = 397 * MiB;
constexpr size_t WS_H1 = 177 * MiB;
constexpr size_t WS_EW1 = 9 * MiB;
constexpr size_t WS_EW2 = 477 * MiB;
constexpr size_t WS_YQ = 9 * MiB;
constexpr size_t WS_ASG = 510 * MiB;
constexpr size_t WS_H1B = 113 * MiB;
constexpr size_t WS_HID = 305 * MiB;
constexpr size_t WS_TOK = 461 * MiB;
constexpr size_t WS_WGT = 469 * MiB;
constexpr size_t WS_END = 511 * MiB;
constexpr int CW_BAR = 4096;
constexpr int CW_CNT = 16384;
constexpr int CW_DBG = 32768;

constexpr int LDS_BYTES = 163840;
constexpr int MISC_OFF = 163840 - 512;

#define RLX_AGENT __ATOMIC_RELAXED, __HIP_MEMORY_SCOPE_AGENT
#define LDS_WAIT() asm volatile("s_waitcnt lgkmcnt(0)" ::: "memory")
#define VM_WAIT() asm volatile("s_waitcnt vmcnt(0)" ::: "memory")
typedef __bf16 bf16x2_t __attribute__((ext_vector_type(2)));
__device__ __forceinline__ unsigned pk2(float lo, float hi) { const f32x2 v = {lo, hi}; return __builtin_bit_cast(unsigned, __builtin_convertvector(v, bf16x2_t)); }
__device__ __forceinline__ unsigned f2bf(float f) { return pk2(f, 0.f) & 0xffffu; }
__device__ __forceinline__ float bf2f(unsigned b) { return __builtin_bit_cast(float, b << 16); }
__device__ __forceinline__ float bflo(unsigned w) { return __builtin_bit_cast(float, w << 16); }
__device__ __forceinline__ float bfhi(unsigned w) { return __builtin_bit_cast(float, w & 0xffff0000u); }
__device__ __forceinline__ float sigmoidf_(float v) { return __builtin_amdgcn_rcpf(1.0f + __expf(-v)); }
__device__ __forceinline__ float siluf_(float v) { return v * __builtin_amdgcn_rcpf(1.0f + __expf(-v)); }
__device__ __forceinline__ float wave_sum(float v) {
#pragma unroll
    for (int o = 1; o < 64; o <<= 1) v += __shfl_xor(v, o);
    return v;
}
__device__ __forceinline__ float wave_max(float v) {
#pragma unroll
    for (int o = 1; o < 64; o <<= 1) v = fmaxf(v, __shfl_xor(v, o));
    return v;
}

namespace pg8 {
constexpr int BM = 256, BK = 64, HALF = 128, HTB = HALF * BK * 2, STAGE_BYTES = 8 * HTB, NXCD = 8, WGM = 8;
__host__ __device__ __forceinline__ int lds_byte(int r, int c) { const int st = (r >> 4) * 2 + (c >> 5), rr = r & 15, cc = c & 31, ob = rr * 64 + cc * 2; return st * 1024 + (ob ^ (((ob >> 9) & 1) << 5)); }
__host__ __device__ __forceinline__ void stage_rc(int b, int& R, int& C) { const int st = b / 1024, sb = b % 1024, swz = sb ^ (((sb >> 9) & 1) << 5); R = (st >> 1) * 16 + swz / 64; C = (st & 1) * 32 + (swz % 64) / 2; }
__host__ __device__ __forceinline__ int perm32(int rho) { const int n = rho >> 4, i = rho & 15; return 8 * (i >> 2) + 4 * n + (i & 3); }

struct Unit { int pm, pn; const char* A; const char* B; int e, cnt; };

struct StaticOrder {
    int nM, nN, nwg, G, c, K; const char* A; const char* B;
    __device__ void init(const bf16* A_, const bf16* B_, int M, int N, int K_, int G_, int c_) { A = (const char*)A_; B = (const char*)B_; nM = M / BM; nN = N / BM; nwg = nM * nN; G = G_; c = c_; K = K_; }
    __device__ __forceinline__ bool next(int i, Unit& u) const {
        const long L = (long)i * G + c; if (L >= nwg) return false;
        int wgid = (int)L; { const int q = nwg / NXCD, r = nwg % NXCD, xcd = wgid % NXCD, off = wgid / NXCD; wgid = (xcd < r ? xcd * (q + 1) : r * (q + 1) + (xcd - r) * q) + off; }
        const int nig = WGM * nN, gid = wgid / nig, fm = gid * WGM, gsz = (nM - fm) < WGM ? (nM - fm) : WGM;
        u.pm = fm + ((wgid % nig) % gsz); u.pn = (wgid % nig) / gsz;
        u.A = A + (size_t)u.pm * BM * K * 2; u.B = B + (size_t)u.pn * BM * K * 2; u.e = 0; u.cnt = 0; return true;
    }
    __device__ __forceinline__ unsigned row_off(const Unit&, int) const { return 0u; }
};

__device__ __forceinline__ unsigned cvt_pk_bf16(float lo, float hi) { unsigned r; asm volatile("v_cvt_pk_bf16_f32 %0, %1, %2" : "=v"(r) : "v"(lo), "v"(hi)); return r; }

template <class Epi, class Sched, bool GATHER>
__device__ __forceinline__ void gemm_phase(LAS unsigned char* lds, const int K, const Sched& S, const Epi& E) {
    constexpr bool TA = Epi::TA;
    const int tid = threadIdx.x, wid = __builtin_amdgcn_readfirstlane(tid >> 6), lane = tid & 63, wr = wid >> 2, wc = wid & 3, fr = lane & 15, fq = lane >> 4;
    const int nt = K / BK;
    unsigned voffA[2][2], voffB[2]; int RA[2], CA[2];
#pragma unroll
    for (int i = 0; i < 2; ++i) { int R, C; stage_rc(tid * 16 + i * 8192, R, C); const int Rb = Epi::PERM ? ((R & ~31) + perm32(R & 31)) : R;
        RA[i] = R; CA[i] = C; voffA[0][i] = (unsigned)(R * K + C) * 2u; voffA[1][i] = voffA[0][i]; voffB[i] = (unsigned)(Rb * K + C) * 2u; }
    const size_t kstep = (size_t)(BK * 2);
    const size_t hstep = (size_t)HALF * K * 2;
    const size_t hstepA = GATHER ? 0 : hstep;
    const unsigned ldsw = (unsigned)wid * 1024u;
    const int aoff = lds_byte(wr * 64 + fr, fq * 8), boff = lds_byte(wc * 32 + fr, fq * 8);
#define PG8_SA(b, h) (((b) * 2 + (h)) * HTB)
#define PG8_SB(b, h) ((4 + (b) * 2 + (h)) * HTB)
#define PG8_STAGE(bufoff, gbase, voff) do { _Pragma("unroll") for (int _i = 0; _i < 2; ++_i) \
        __builtin_amdgcn_global_load_lds((const unsigned*)((const char*)(gbase) + (voff)[_i]), (LAS unsigned*)(lds + (bufoff) + ldsw + _i * 8192), 16, 0, 0); } while (0)
#define PG8_STAGE_A(bufoff, gbase, h) PG8_STAGE(bufoff, (gbase) + (h) * hstepA, voffA[GATHER ? (h) : 0])
#define PG8_LDA(dst, b, h) do { _Pragma("unroll") for (int m = 0; m < 4; ++m) _Pragma("unroll") for (int k = 0; k < 2; ++k) dst[m][k] = *(const LAS bf16x8*)(lds + PG8_SA(b, h) + aoff + m * 2048 + k * 1024); } while (0)
#define PG8_LDB(dst, b, h) do { _Pragma("unroll") for (int n = 0; n < 2; ++n) _Pragma("unroll") for (int k = 0; k < 2; ++k) dst[n][k] = *(const LAS bf16x8*)(lds + PG8_SB(b, h) + boff + n * 2048 + k * 1024); } while (0)
#define PG8_MMA(ai, bj, At, Bt) do { __builtin_amdgcn_s_setprio(1); _Pragma("unroll") for (int m = 0; m < 4; ++m) _Pragma("unroll") for (int n = 0; n < 2; ++n) _Pragma("unroll") for (int k = 0; k < 2; ++k) \
        acc[ai][bj][m][n] = TA ? __builtin_amdgcn_mfma_f32_16x16x32_bf16(Bt[n][k], At[m][k], acc[ai][bj][m][n], 0, 0, 0) \
                               : __builtin_amdgcn_mfma_f32_16x16x32_bf16(At[m][k], Bt[n][k], acc[ai][bj][m][n], 0, 0, 0); __builtin_amdgcn_s_setprio(0); } while (0)
#define PG8_WAIT_V(n) asm volatile("s_waitcnt vmcnt(" #n ")" ::: "memory")
#define PG8_WAIT_L(n) asm volatile("s_waitcnt lgkmcnt(" #n ")" ::: "memory")
#define PG8_BAR __builtin_amdgcn_s_barrier()
#define PG8_SCHED __builtin_amdgcn_sched_barrier(0)
    Unit cur, nxt; int ui = 0;
    if (!S.next(0, cur)) return;
    if (GATHER) {
#pragma unroll
        for (int h = 0; h < 2; ++h)
#pragma unroll
            for (int i = 0; i < 2; ++i) voffA[h][i] = S.row_off(cur, h * HALF + RA[i]) + (unsigned)CA[i] * 2u;
    }
    f32x4 acc[2][2][4][2];
#pragma unroll
    for (int a = 0; a < 2; ++a)
#pragma unroll
        for (int b = 0; b < 2; ++b)
#pragma unroll
            for (int m = 0; m < 4; ++m)
#pragma unroll
                for (int n = 0; n < 2; ++n) acc[a][b][m][n] = (f32x4){0.f, 0.f, 0.f, 0.f};
    bf16x8 At[4][2], B0[2][2], B1[2][2];
    const char* cA = cur.A; const char* cB = cur.B;
    PG8_STAGE(PG8_SB(0, 0), cB, voffB); PG8_STAGE_A(PG8_SA(0, 0), cA, 0); PG8_STAGE(PG8_SB(0, 1), cB + hstep, voffB); PG8_STAGE_A(PG8_SA(0, 1), cA, 1);
    if (wr == 1) PG8_BAR;
    PG8_WAIT_V(4); PG8_BAR;
    PG8_STAGE(PG8_SB(1, 0), cB + kstep, voffB); PG8_STAGE_A(PG8_SA(1, 0), cA + kstep, 0); PG8_STAGE(PG8_SB(1, 1), cB + hstep + kstep, voffB);
    PG8_WAIT_V(6); PG8_BAR;
    for (;;) {
        const bool has_next = S.next(ui + 1, nxt);
        const char* nA = has_next ? nxt.A : cA; const char* nB = has_next ? nxt.B : cB;
        for (int t = 0; t < nt; t += 2) {
            const bool last = (t == nt - 2);
            const char* a1 = cA + (size_t)(t + 1) * kstep;
            const char* a2 = last ? nA : cA + (size_t)(t + 2) * kstep; const char* b2 = last ? nB : cB + (size_t)(t + 2) * kstep;
            const char* a3 = a2 + kstep; const char* b3 = b2 + kstep;
            PG8_LDB(B0, 0, 0); PG8_SCHED; PG8_LDA(At, 0, 0); PG8_STAGE_A(PG8_SA(1, 1), a1, 1);
            PG8_WAIT_L(8); PG8_BAR; PG8_WAIT_L(0); PG8_MMA(0, 0, At, B0); PG8_BAR; PG8_SCHED;
            if (GATHER) { if (last && has_next) {
#pragma unroll
                for (int h = 0; h < 2; ++h)
#pragma unroll
                    for (int i = 0; i < 2; ++i) voffA[h][i] = S.row_off(nxt, h * HALF + RA[i]) + (unsigned)CA[i] * 2u;
            } }
            PG8_LDB(B1, 0, 1); PG8_STAGE(PG8_SB(0, 0), b2, voffB);
            PG8_BAR; PG8_WAIT_L(0); PG8_MMA(0, 1, At, B1); PG8_BAR;
            PG8_LDA(At, 0, 1); PG8_STAGE_A(PG8_SA(0, 0), a2, 0);
            PG8_BAR; PG8_WAIT_L(0); PG8_MMA(1, 0, At, B0); PG8_BAR; PG8_SCHED;
            PG8_STAGE(PG8_SB(0, 1), b2 + hstep, voffB);
            PG8_WAIT_V(6); PG8_BAR; PG8_MMA(1, 1, At, B1); PG8_BAR;
            PG8_LDB(B0, 1, 0); PG8_SCHED; PG8_LDA(At, 1, 0); PG8_STAGE_A(PG8_SA(0, 1), a2, 1);
            PG8_WAIT_L(8); PG8_BAR; PG8_WAIT_L(0); PG8_MMA(0, 0, At, B0); PG8_BAR; PG8_SCHED;
            PG8_LDB(B1, 1, 1); PG8_STAGE(PG8_SB(1, 0), b3, voffB);
            PG8_BAR; PG8_WAIT_L(0); PG8_MMA(0, 1, At, B1); PG8_BAR;
            PG8_LDA(At, 1, 1); PG8_STAGE_A(PG8_SA(1, 0), a3, 0);
            PG8_BAR; PG8_WAIT_L(0); PG8_MMA(1, 0, At, B0); PG8_BAR; PG8_SCHED;
            PG8_STAGE(PG8_SB(1, 1), b3 + hstep, voffB);
            PG8_WAIT_V(6); PG8_BAR; PG8_MMA(1, 1, At, B1); PG8_BAR;
        }
        E(acc, cur, wr, wc, fr, fq);
        if (!has_next) break;
#pragma unroll
        for (int a = 0; a < 2; ++a)
#pragma unroll
            for (int b = 0; b < 2; ++b)
#pragma unroll
                for (int m = 0; m < 4; ++m)
#pragma unroll
                    for (int n = 0; n < 2; ++n) acc[a][b][m][n] = (f32x4){0.f, 0.f, 0.f, 0.f};
        cur = nxt; cA = nA; cB = nB; ++ui;
    }
    PG8_WAIT_V(0);
    if (wr == 0) PG8_BAR;
    PG8_BAR;
#undef PG8_SA
#undef PG8_SB
#undef PG8_STAGE
#undef PG8_STAGE_A
#undef PG8_LDA
#undef PG8_LDB
#undef PG8_MMA
#undef PG8_WAIT_V
#undef PG8_WAIT_L
#undef PG8_BAR
#undef PG8_SCHED
}
}

namespace pg8 {
struct EpiHyT {
    static constexpr bool TA = false, PERM = false;
    bf16* PT; const float* bias;
    __device__ __forceinline__ void operator()(const f32x4 (&acc)[2][2][4][2], const Unit& u, int wr, int wc, int fr, int fq) const {
#pragma unroll
        for (int bj = 0; bj < 2; ++bj)
#pragma unroll
            for (int n = 0; n < 2; ++n) {
                const int col = u.pn * BM + bj * HALF + wc * 32 + n * 16 + fr; const float bv = bias[col];
                bf16* colp = PT + (size_t)col * MTOK + u.pm * BM + wr * 64 + 4 * fq;
#pragma unroll
                for (int ai = 0; ai < 2; ++ai)
#pragma unroll
                    for (int m = 0; m < 4; ++m) { const f32x4 v = acc[ai][bj][m][n] + bv; u32x2 w; w.x = cvt_pk_bf16(v[0], v[1]); w.y = cvt_pk_bf16(v[2], v[3]);
                        *(u32x2*)(colp + ai * HALF + m * 16) = w; }
            }
    }
};
struct EpiZXD {
    static constexpr bool TA = true, PERM = true;
    bf16* Zb; bf16* XBC; float* DT; const float* b_in; bf16* HALO;
    __device__ __forceinline__ void operator()(const f32x4 (&acc)[2][2][4][2], const Unit& u, int wr, int wc, int fr, int fq) const {
        const int row0 = u.pm * BM + wr * 64 + fr;
        if (u.pn == 24) {
            if (wc < 2) {
                const int c0 = wc * 32 + 8 * fq;
#pragma unroll
                for (int n = 0; n < 2; ++n) { const f32x4 bv = *(const f32x4*)(b_in + 9216 + c0 + 4 * n);
#pragma unroll
                    for (int ai = 0; ai < 2; ++ai)
#pragma unroll
                        for (int m = 0; m < 4; ++m) *(f32x4*)(DT + (size_t)(row0 + ai * HALF + m * 16) * 64 + c0 + 4 * n) = acc[ai][0][m][n] + bv; }
            }
            return;
        }
        bf16* base; int ldc, colt, bcol;
        if (u.pn < 8) { base = Zb; ldc = DSSM; colt = u.pn * BM; bcol = 3072 + colt; } else { base = XBC; ldc = CONVD; colt = (u.pn - 8) * BM; bcol = 5120 + colt; }
        const int col0 = colt + wc * 32 + 8 * fq, bcol0 = bcol + wc * 32 + 8 * fq;
        f32x4 bv[2][2];
#pragma unroll
        for (int bj = 0; bj < 2; ++bj)
#pragma unroll
            for (int n = 0; n < 2; ++n) bv[bj][n] = *(const f32x4*)(b_in + bcol0 + bj * HALF + 4 * n);
#pragma unroll
        for (int ai = 0; ai < 2; ++ai)
#pragma unroll
            for (int m = 0; m < 4; ++m) { bf16* rowp = base + (size_t)(row0 + ai * HALF + m * 16) * ldc + col0;
#pragma unroll
                for (int bj = 0; bj < 2; ++bj) { const f32x4 v0 = acc[ai][bj][m][0] + bv[bj][0], v1 = acc[ai][bj][m][1] + bv[bj][1];
                    u32x4 w; w.x = cvt_pk_bf16(v0[0], v0[1]); w.y = cvt_pk_bf16(v0[2], v0[3]); w.z = cvt_pk_bf16(v1[0], v1[1]); w.w = cvt_pk_bf16(v1[2], v1[3]);
                    *(u32x4*)(rowp + bj * HALF) = w;
                    if (u.pn >= 8 && ((m == 3 && fr >= 14) || (m == 0 && fr < 2))) {
                        const int row = row0 + ai * HALF + m * 16, bb = row >> 11, t = row & 2047, tm = t & 63;
                        const int jb = (tm >= 62) ? (t >> 6) + 1 : (t >> 6), idx = (tm >= 62) ? tm - 62 : 2 + tm;
                        *(u32x4*)(HALO + ((size_t)(bb * 33 + jb) * 4 + idx) * CONVD + col0 + bj * HALF) = w; } } }
    }
};
template <int MODE> struct EpiBf {
    static constexpr bool TA = true, PERM = true;
    bf16* O; int ldc; const float* bias; const bf16* G1; int ldg; const bf16* P;
    __device__ __forceinline__ void operator()(const f32x4 (&acc)[2][2][4][2], const Unit& u, int wr, int wc, int fr, int fq) const {
        const int row0 = u.pm * BM + wr * 64 + fr, col0 = u.pn * BM + wc * 32 + 8 * fq;
#pragma unroll
        for (int ai = 0; ai < 2; ++ai)
#pragma unroll
            for (int m = 0; m < 4; ++m) { const size_t r = (size_t)(row0 + ai * HALF + m * 16);
#pragma unroll
                for (int bj = 0; bj < 2; ++bj) { f32x4 v0 = acc[ai][bj][m][0], v1 = acc[ai][bj][m][1]; const int c = col0 + bj * HALF;
                    if (MODE == 0) { const f32x4 b0 = *(const f32x4*)(bias + c), b1 = *(const f32x4*)(bias + c + 4); v0 = v0 + b0; v1 = v1 + b1;
#pragma unroll
                        for (int j = 0; j < 4; ++j) { v0[j] = sigmoidf_(v0[j]); v1[j] = sigmoidf_(v1[j]); } }
                    else { const u32x4 g = *(const u32x4*)(G1 + r * ldg + c);
                        v0[0] *= bflo(g.x); v0[1] *= bfhi(g.x); v0[2] *= bflo(g.y); v0[3] *= bfhi(g.y); v1[0] *= bflo(g.z); v1[1] *= bfhi(g.z); v1[2] *= bflo(g.w); v1[3] *= bfhi(g.w);
                        if (MODE == 2) { const u32x4 p = *(const u32x4*)(P + r * ldc + c);
                            v0[0] += bflo(p.x); v0[1] += bfhi(p.x); v0[2] += bflo(p.y); v0[3] += bfhi(p.y); v1[0] += bflo(p.z); v1[1] += bfhi(p.z); v1[2] += bflo(p.w); v1[3] += bfhi(p.w); } }
                    u32x4 w; w.x = cvt_pk_bf16(v0[0], v0[1]); w.y = cvt_pk_bf16(v0[2], v0[3]); w.z = cvt_pk_bf16(v1[0], v1[1]); w.w = cvt_pk_bf16(v1[2], v1[3]);
                    *(u32x4*)(O + r * ldc + c) = w; } }
    }
};
struct EpiRes {
    static constexpr bool TA = true, PERM = false;
    float* O; const float* bias; const float* X; float alpha;
    __device__ __forceinline__ void operator()(const f32x4 (&acc)[2][2][4][2], const Unit& u, int wr, int wc, int fr, int fq) const {
        const int row0 = u.pm * BM + wr * 64 + fr, col0 = u.pn * BM + wc * 32 + 4 * fq;
#pragma unroll
        for (int ai = 0; ai < 2; ++ai)
#pragma unroll
            for (int m = 0; m < 4; ++m) { const size_t off = (size_t)(row0 + ai * HALF + m * 16) * DM + col0;
#pragma unroll
                for (int bj = 0; bj < 2; ++bj)
#pragma unroll
                    for (int n = 0; n < 2; ++n) { const f32x4 xv = *(const f32x4*)(X + off + bj * HALF + n * 16), bv = *(const f32x4*)(bias + col0 + bj * HALF + n * 16);
                        *(f32x4*)(O + off + bj * HALF + n * 16) = acc[ai][bj][m][n] + bv + alpha * xv; } }
    }
};
struct EpiSwiGLU {
    static constexpr bool TA = true, PERM = true;
    bf16* HID;
    __device__ __forceinline__ void operator()(const f32x4 (&acc)[2][2][4][2], const Unit& u, int wr, int wc, int fr, int fq) const {
        const int row0 = u.pm * BM + wr * 64 + fr, col0 = u.pn * HALF + wc * 32 + 8 * fq;
#pragma unroll
        for (int ai = 0; ai < 2; ++ai)
#pragma unroll
            for (int m = 0; m < 4; ++m) { f32x4 v0, v1;
#pragma unroll
                for (int j = 0; j < 4; ++j) { v0[j] = siluf_(acc[ai][0][m][0][j]) * acc[ai][1][m][0][j]; v1[j] = siluf_(acc[ai][0][m][1][j]) * acc[ai][1][m][1][j]; }
                u32x4 w; w.x = cvt_pk_bf16(v0[0], v0[1]); w.y = cvt_pk_bf16(v0[2], v0[3]); w.z = cvt_pk_bf16(v1[0], v1[1]); w.w = cvt_pk_bf16(v1[2], v1[3]);
                *(u32x4*)(HID + (size_t)(row0 + ai * HALF + m * 16) * DEXP + col0) = w; }
    }
};
struct EpiScatter {
    static constexpr bool TA = false, PERM = false;
    float* ACC; const int* tok; const float* wgt; int j0_unused;
    __device__ __forceinline__ void operator()(const f32x4 (&acc)[2][2][4][2], const Unit& u, int wr, int wc, int fr, int fq) const {
        asm volatile("" : "+v"(fr), "+v"(fq));
        const int jt = u.pn >> 2, ct = u.pn & 3;
#pragma unroll
        for (int ai = 0; ai < 2; ++ai)
#pragma unroll
            for (int m = 0; m < 4; ++m)
#pragma unroll
                for (int j = 0; j < 4; ++j) { const int r = ai * HALF + wr * 64 + m * 16 + 4 * fq + j;
                    if (r < u.cnt) { int token; float w;
                        if (u.e == NE) { token = jt * BM + r; w = 1.0f; } else { const size_t li = (size_t)u.e * MTOK + (size_t)jt * BM + r; token = tok[li]; w = wgt[li]; }
                        float* rowp = ACC + (size_t)token * DM + ct * BM + wc * 32 + fr;
#pragma unroll
                        for (int bj = 0; bj < 2; ++bj)
#pragma unroll
                            for (int n = 0; n < 2; ++n) unsafeAtomicAdd(rowp + bj * HALF + n * 16, w * acc[ai][bj][m][n][j]);
                    }
                    asm volatile("" ::: "memory"); }
    }
};

struct EpiSlot8 {
    static constexpr bool TA = true, PERM = true;
    unsigned char* YQ;
    __device__ __forceinline__ void operator()(const f32x4 (&acc)[2][2][4][2], const Unit& u, int wr, int wc, int fr, int fq) const {
        const int row0 = u.pm * BM + wr * 64 + fr, col0 = (u.pn & 1) * 256 + wc * 32 + 8 * fq;
#pragma unroll
        for (int ai = 0; ai < 2; ++ai)
#pragma unroll
            for (int m = 0; m < 4; ++m) { unsigned char* rowp = YQ + (size_t)(row0 + ai * HALF + m * 16) * 512 + col0;
#pragma unroll
                for (int bj = 0; bj < 2; ++bj) { const f32x4 v0 = acc[ai][bj][m][0], v1 = acc[ai][bj][m][1];
                    int w0 = __builtin_amdgcn_cvt_pk_fp8_f32(v0[0], v0[1], 0, false); w0 = __builtin_amdgcn_cvt_pk_fp8_f32(v0[2], v0[3], w0, true);
                    int w1 = __builtin_amdgcn_cvt_pk_fp8_f32(v1[0], v1[1], 0, false); w1 = __builtin_amdgcn_cvt_pk_fp8_f32(v1[2], v1[3], w1, true);
                    u32x2 w; w.x = (unsigned)w0; w.y = (unsigned)w1; *(u32x2*)(rowp + bj * HALF) = w; } }
    }
};
struct SlotOrder2 {
    const LAS int* tp; int G, c, total, pass; const char* A; const char* W;
    __device__ __forceinline__ bool next(int i, Unit& u) const {
        const long L = (long)i * G + c; if (L >= 2l * total) return false;
        const int tile = (int)(L >> 1), q = 2 * pass + (int)(L & 1); int e = 0;
#pragma unroll 1
        for (int s = 64; s >= 1; s >>= 1) if (e + s <= NE && tp[e + s] <= tile) e += s;
        u.e = e; u.cnt = 0; u.pm = tile; u.pn = q; u.A = A + (size_t)tile * BM * DEXP * 2; u.B = W + ((size_t)e * DM + (size_t)q * 256) * DEXP * 2;
        return true;
    }
    __device__ __forceinline__ unsigned row_off(const Unit&, int) const { return 0u; }
};
template <int NCT, bool FIRST> struct MoeOrder {
    const LAS int* tp; const LAS int* cnt; int G, c, total;
    const char* A; const char* W; const int* tok;
    __device__ __forceinline__ bool next(int i, Unit& u) const {
        const long L = (long)i * G + c; if (L >= (long)total * NCT) return false;
        const int tile = (int)(L / NCT), ct = (int)(L % NCT);
        int e = 0;
#pragma unroll 1
        for (int s = 64; s >= 1; s >>= 1) if (e + s <= NE && tp[e + s] <= tile) e += s;
        const int jt = tile - tp[e];
        u.e = e; const int left = cnt[e] - jt * BM; u.cnt = left < BM ? left : BM;
        if (FIRST) { u.pm = tile; u.pn = ct; u.A = A; u.B = W + ((size_t)e * 512 + (size_t)ct * 256) * DM * 2; }
        else { u.pm = tile; u.pn = jt * 4 + ct; u.A = A + (size_t)tile * BM * DEXP * 2; u.B = W + ((size_t)e * DM + (size_t)ct * 256) * DEXP * 2; }
        return true;
    }
    __device__ __forceinline__ unsigned row_off(const Unit& u, int r) const {
        const int jt = u.pm - tp[u.e]; int token;
        if (u.e == NE) token = jt * BM + r; else token = (r < u.cnt) ? tok[(size_t)u.e * MTOK + (size_t)jt * BM + r] : 0;
        return (unsigned)token * (unsigned)(DM * 2);
    }
};
}

#define XB_TMO      128
#define XB_XCNT(j)  (256  + 64 * (j))
#define XB_XSUB(j)  (1280 + 64 * (j))
#define XB_XGEN(j)  (2304 + 64 * (j))
#define XB_TOP      3328
#define XB_TOPGEN   3392
#define XCD_BAR_WORDS 3456
#define XB_SPIN_CAP (1u << 18)
__device__ __forceinline__ unsigned xb_ld(unsigned* p)              { return __hip_atomic_load(p, __ATOMIC_RELAXED, __HIP_MEMORY_SCOPE_AGENT); }
__device__ __forceinline__ unsigned xb_add(unsigned* p, unsigned v) { return __hip_atomic_fetch_add(p, v, __ATOMIC_RELAXED, __HIP_MEMORY_SCOPE_AGENT); }
__device__ __forceinline__ unsigned xb_xcc_id() { return (unsigned)__builtin_amdgcn_s_getreg((3 << 11) | 20) & 0xFu; }
#define XB_SPIN(cond, bar) do { unsigned _sp = 0; while (cond) { __builtin_amdgcn_s_sleep(1); \
    if ((++_sp & 255u) == 0u) { if (xb_ld(&(bar)[XB_TMO])) break; if (_sp > XB_SPIN_CAP) { atomicAdd(&(bar)[XB_TMO], 1u); break; } } } } while (0)
struct XcdBarrier { unsigned* bar; unsigned x; volatile LAS unsigned* st; };
__device__ __forceinline__ XcdBarrier xcd_barrier_post(unsigned* bar, volatile LAS unsigned* st) {
    XcdBarrier b; b.bar = bar; b.x = xb_xcc_id(); b.st = st;
    if (threadIdx.x == 0) (void)xb_add(&bar[XB_XCNT(b.x)], 1u);
    return b;
}
__device__ __forceinline__ void xcd_barrier_complete(unsigned* bar, unsigned x, unsigned& nloc, unsigned& nx) {
    const unsigned G = gridDim.x * gridDim.y * gridDim.z;
    unsigned sum, cnt, mine, sp = 0u;
    for (;;) {
        sum = 0u; cnt = 0u; mine = 0u;
#pragma unroll
        for (unsigned j = 0; j < 16; ++j) { const unsigned c = xb_ld(&bar[XB_XCNT(j)]); sum += c; cnt += (c > 0u) ? 1u : 0u; mine = (j == x) ? c : mine; }
        if (sum == G) break;
        __builtin_amdgcn_s_sleep(1);
        if ((++sp & 255u) == 0u) { if (xb_ld(&bar[XB_TMO])) break; if (sp > XB_SPIN_CAP) { atomicAdd(&bar[XB_TMO], 1u); break; } }
    }
    nloc = mine > 0u ? mine : 1u; nx = cnt > 0u ? cnt : 1u;
}
__device__ __forceinline__ void xcd_barrier(const XcdBarrier& b) {
    asm volatile("s_waitcnt vmcnt(0)" ::: "memory");
    __syncthreads();
    if (threadIdx.x == 0) {
        unsigned* bar = b.bar;
        __builtin_amdgcn_s_waitcnt(0);
        unsigned nloc = b.st[0], nx = b.st[1];
        if (nloc == 0u) { xcd_barrier_complete(bar, b.x, nloc, nx); b.st[0] = nloc; b.st[1] = nx; }
        const unsigned old = xb_add(&bar[XB_XSUB(b.x)], 1u);
        const unsigned gen = old / nloc;
        if (old + 1u == (gen + 1u) * nloc) {
            __builtin_amdgcn_fence(__ATOMIC_RELEASE, "agent");
            asm volatile("s_waitcnt vmcnt(0)" ::: "memory");
            const unsigned og = xb_add(&bar[XB_TOP], 1u);
            const unsigned tg = og / nx;
            if (og + 1u == (tg + 1u) * nx) xb_add(&bar[XB_TOPGEN], 1u);
            else XB_SPIN(xb_ld(&bar[XB_TOPGEN]) == tg, bar);
            __builtin_amdgcn_fence(__ATOMIC_ACQUIRE, "agent");
            xb_add(&bar[XB_XGEN(b.x)], 1u);
            asm volatile("s_waitcnt vmcnt(0)" ::: "memory");
        } else {
            XB_SPIN(xb_ld(&bar[XB_XGEN(b.x)]) == gen, bar);
            __builtin_amdgcn_fence(__ATOMIC_ACQUIRE, "agent");
            asm volatile("s_waitcnt vmcnt(0)" ::: "memory");
        }
    }
    __syncthreads();
}

struct Args {
    const float* in[38]; float* out; unsigned char* ws; int ph_lo, ph_hi, li, pad;
};
enum { I_X = 0, I_WIN, I_BIN, I_HCW, I_HCB, I_FW1, I_FB1, I_FF1, I_FW2, I_FB2, I_FF2, I_FW3, I_FB3, I_FF3, I_FW4, I_HBIAS,
       I_SCW, I_SCB, I_DTB, I_ALOG, I_SD, I_SNW, I_WHYB, I_WSSDB, I_WOUT, I_BOUT, I_LN1G, I_LN1B, I_RW, I_RB, I_EWG, I_EWU, I_EWD, I_SWG, I_SWU, I_SWD, I_LN2G, I_LN2B };
struct Frame {
    LAS unsigned char* lds; volatile LAS unsigned* MISC; gu32* ctl; unsigned char* ws;
    int tid, lane, wave, vcu, G;
    const float* const* in; float* out;
};

__device__ __forceinline__ void tr_item(const float* src, int ld_src, int k0, int c0, bf16* dst, int drow0, int ldd, LAS float* scr, int lane) {
#pragma unroll 8
    for (int i = 0; i < 32; ++i) { const int kk = 2 * i + (lane >> 5); scr[kk * 33 + (lane & 31)] = src[(size_t)(k0 + kk) * ld_src + c0 + (lane & 31)]; }
    LDS_WAIT(); asm volatile("" ::: "memory");
    const int c = lane & 7;
#pragma unroll
    for (int j = 0; j < 4; ++j) { const int n = (lane >> 3) + 8 * j; const LAS float* s = scr + (8 * c) * 33 + n;
        u32x4 o; o.x = pk2(s[0 * 33], s[1 * 33]); o.y = pk2(s[2 * 33], s[3 * 33]); o.z = pk2(s[4 * 33], s[5 * 33]); o.w = pk2(s[6 * 33], s[7 * 33]);
        *(u32x4*)(dst + (size_t)(drow0 + n) * ldd + k0 + 8 * c) = o; }
    LDS_WAIT(); asm volatile("" ::: "memory");
}
__device__ __forceinline__ void tr_matrix_item(const float* src, int ld_src, int K, int col_first, int ncols, bf16* dst, int drow_first, LAS float* scr, int it, int lane) {
    const int nblk = ncols / 32, kb = it / nblk, nb = it % nblk;
    tr_item(src, ld_src, kb * 64, col_first + nb * 32, dst, drow_first + nb * 32, K, scr, lane);
}
__device__ __forceinline__ void convert_x(Frame& F, const float* x, bf16* xb) {
    const size_t n8 = (size_t)MTOK * DM / 8; const size_t stride = (size_t)F.G * NTHR;
    for (size_t i = (size_t)F.vcu * NTHR + F.tid; i < n8; i += stride) {
        const f32x4 a = *(const f32x4*)(x + i * 8), b = *(const f32x4*)(x + i * 8 + 4);
        u32x4 o; o.x = pk2(a[0], a[1]); o.y = pk2(a[2], a[3]); o.z = pk2(b[0], b[1]); o.w = pk2(b[2], b[3]);
        *(u32x4*)(xb + i * 8) = o; }
}

__device__ __forceinline__ void hyena_filter(Frame& F) {
    const float* w1 = F.in[I_FW1]; const float* b1 = F.in[I_FB1]; const float* f1 = F.in[I_FF1];
    const float* w2 = F.in[I_FW2]; const float* b2 = F.in[I_FB2]; const float* f2 = F.in[I_FF2];
    const float* w3 = F.in[I_FW3]; const float* b3 = F.in[I_FB3]; const float* f3 = F.in[I_FF3];
    const float* w4 = F.in[I_FW4];
    bf16* KERN = (bf16*)(F.ws + WS_KERN);
    LAS float* hbuf = (LAS float*)(F.lds);
    const int lane = F.lane, wave = F.wave;
    for (int pg = F.vcu; pg < SEQ / 8; pg += F.G) {
        const int t = 8 * pg + wave;
        const float tn = (float)t / (float)(SEQ - 1), wv = 6.283185307179586f * (float)t / (float)SEQ;
        float zf = 0.f;
        if (lane == 0) zf = tn;
        else if (lane <= 16) { const float f = 1e-4f + (float)(lane - 1) * ((15.0f - 1e-4f) / 15.0f); zf = cosf(f * wv); }
        else if (lane <= 32) { const float f = 1e-4f + (float)(lane - 17) * ((15.0f - 1e-4f) / 15.0f); zf = -sinf(f * wv); }
        float s = b1[lane];
        for (int i = 0; i < 33; ++i) s += __shfl(zf, i) * w1[i * 64 + lane];
        float h = sinf(f1[lane] * s);
        s = b2[lane];
        for (int i = 0; i < 64; ++i) s += __shfl(h, i) * w2[i * 64 + lane];
        h = sinf(f2[lane] * s);
        s = b3[lane];
        for (int i = 0; i < 64; ++i) s += __shfl(h, i) * w3[i * 64 + lane];
        h = sinf(f3[lane] * s);
        hbuf[wave * 64 + lane] = h;
        __syncthreads();
        for (int q = 0; q < 8; ++q) {
            const int col = F.tid + 512 * q, c = col & 1023, dir = (col >> 10) & 1, o = col >> 11;
            float a[8];
#pragma unroll
            for (int p = 0; p < 8; ++p) a[p] = 0.f;
            float a0b = 0.f;
            for (int i = 0; i < 64; ++i) { const float w = w4[(size_t)i * 4096 + col];
#pragma unroll
                for (int p = 0; p < 8; ++p) a[p] += hbuf[p * 64 + i] * w;
                if (pg == 0 && dir == 0) a0b += hbuf[i] * w4[(size_t)i * 4096 + col + 1024]; }
            const float adel = 3.0701134573253945f + (float)c * ((15.350567286626973f - 3.0701134573253945f) / 1023.0f);
            bf16* kc = KERN + ((size_t)c * 2 + o) * 4096;
#pragma unroll
            for (int p = 0; p < 8; ++p) { const int tp = 8 * pg + p; const float v = a[p] * __expf(-((float)tp / (float)(SEQ - 1)) * adel);
                if (tp == 0) { if (dir == 0) { kc[2048] = (bf16)f2bf(v + a0b); kc[0] = 0; } }
                else kc[dir == 0 ? 2048 - tp : 2048 + tp] = (bf16)f2bf(v); }
        }
        __syncthreads();
    }
}

__device__ __forceinline__ void p0_prologue(Frame& F) {
    LAS float* scr = (LAS float*)(F.lds + 4096 + F.wave * 16384);
    const int gw = F.vcu * NWAVES + F.wave, NGW = F.G * NWAVES;
    hyena_filter(F);
    bf16* WINT = (bf16*)(F.ws + WS_WINT);
    constexpr int I_A = 16 * (9216 / 32), I_B = 16 * (64 / 32), I_C = 16 * (2048 / 32);
    constexpr int I_HY = 16 * 32, I_SS = 32 * 32, I_OUT = 16 * 32;
    constexpr int NITEMS = I_A + I_B + I_C + I_HY + I_SS + I_OUT;
    for (int it = gw; it < NITEMS; it += NGW) {
        int r = it;
        if (r < I_A) { tr_matrix_item(F.in[I_WIN], INC, DM, 0, 9216, WINT, 0, scr, r, F.lane); continue; } r -= I_A;
        if (r < I_B) { tr_matrix_item(F.in[I_WIN], INC, DM, 9216, 64, WINT, 9216, scr, r, F.lane); continue; } r -= I_B;
        if (r < I_C) { tr_matrix_item(F.in[I_WIN], INC, DM, 9280, 2048, WINT, 9472, scr, r, F.lane); continue; } r -= I_C;
        if (r < I_HY) { tr_matrix_item(F.in[I_WHYB], DM, DM, 0, DM, (bf16*)(F.ws + WS_WHYB), 0, scr, r, F.lane); continue; } r -= I_HY;
        if (r < I_SS) { tr_matrix_item(F.in[I_WSSDB], DM, DSSM, 0, DM, (bf16*)(F.ws + WS_WSSDB), 0, scr, r, F.lane); continue; } r -= I_SS;
        tr_matrix_item(F.in[I_WOUT], DM, DM, 0, DM, (bf16*)(F.ws + WS_WOUT), 0, scr, r, F.lane);
    }
    convert_x(F, F.in[I_X], (bf16*)(F.ws + WS_XB));
}
__device__ __forceinline__ void p6_reconvert(Frame& F) {
    LAS float* scr = (LAS float*)(F.lds + 4096 + F.wave * 16384);
    const int gw = F.vcu * NWAVES + F.wave, NGW = F.G * NWAVES;
    for (int it = gw; it < 16 * (2048 / 32); it += NGW) tr_matrix_item(F.in[I_WIN], INC, DM, 9280, 2048, (bf16*)(F.ws + WS_WING), 0, scr, it, F.lane);
    convert_x(F, F.in[I_X], (bf16*)(F.ws + WS_XB2));
}
__device__ __forceinline__ void p10_expert_weights(Frame& F) {
    LAS float* scr = (LAS float*)(F.lds + 4096 + F.wave * 16384);
    const int gw = F.vcu * NWAVES + F.wave, NGW = F.G * NWAVES;
    bf16* EW1 = (bf16*)(F.ws + WS_EW1); bf16* EW2 = (bf16*)(F.ws + WS_EW2);
    constexpr int PER1 = 16 * 4;
    constexpr int N1 = NEX * 2 * 2 * PER1, PER2 = 4 * 32, N2 = NEX * PER2;
    for (int it = gw; it < N1 + N2; it += NGW) {
        if (it < N1) { const int e = it / (4 * PER1), r0 = it % (4 * PER1), mat = r0 / (2 * PER1), r1 = r0 % (2 * PER1), ct = r1 / PER1, r2 = r1 % PER1;
            const float* src = (e < NE) ? F.in[mat ? I_EWU : I_EWG] + (size_t)e * DM * DEXP : F.in[mat ? I_SWU : I_SWG];
            tr_matrix_item(src, DEXP, DM, 128 * ct, 128, EW1 + (size_t)e * 512 * DM, 256 * ct + 128 * mat, scr, r2, F.lane); }
        else { const int r = it - N1, e = r / PER2, r2 = r % PER2;
            const float* src = (e < NE) ? F.in[I_EWD] + (size_t)e * DEXP * DM : F.in[I_SWD];
            tr_matrix_item(src, DM, DEXP, 0, DM, EW2 + (size_t)e * DM * DEXP, 0, scr, r2, F.lane); }
    }
}
__device__ __forceinline__ void p3_transpose(Frame& F) {
    const bf16* YT = (const bf16*)(F.ws + WS_YTHY); bf16* Y = (bf16*)(F.ws + WS_YHY);
    LAS bf16* scr = (LAS bf16*)(F.lds + F.wave * 9216);
    const int gw = F.vcu * NWAVES + F.wave, NGW = F.G * NWAVES, lane = F.lane;
    for (int tile = gw; tile < 16 * 512; tile += NGW) {
        const int c0 = (tile & 15) * 64, t0 = (tile >> 4) * 64;
#pragma unroll
        for (int p = 0; p < 8; ++p) { const int c = p * 8 + (lane >> 3), ch = lane & 7;
            const u32x4 g = *(const u32x4*)(YT + (size_t)(c0 + c) * MTOK + t0 + ch * 8);
            LAS bf16* d = scr + (ch * 8) * 72 + c;
            d[0 * 72] = (bf16)(g.x & 0xffff); d[1 * 72] = (bf16)(g.x >> 16); d[2 * 72] = (bf16)(g.y & 0xffff); d[3 * 72] = (bf16)(g.y >> 16);
            d[4 * 72] = (bf16)(g.z & 0xffff); d[5 * 72] = (bf16)(g.z >> 16); d[6 * 72] = (bf16)(g.w & 0xffff); d[7 * 72] = (bf16)(g.w >> 16); }
        LDS_WAIT(); asm volatile("" ::: "memory");
#pragma unroll
        for (int p = 0; p < 8; ++p) { const int tk = p * 8 + (lane >> 3), ch = lane & 7;
            const u32x4 v = *(const LAS u32x4*)(scr + tk * 72 + ch * 8);
            *(u32x4*)(Y + (size_t)(t0 + tk) * DM + c0 + ch * 8) = v; }
        LDS_WAIT(); asm volatile("" ::: "memory");
    }
}

constexpr int HY_LDU = 2064, HY_KCS = 4128, HY_U_BYTES = 16 * HY_LDU * 2, HY_KC_BYTES = 8 * HY_KCS * 2;

__device__ __forceinline__ void hy_build_kc(LAS bf16* KC, const bf16* kern, int tid) {
    const u32x4 cur = *(const u32x4*)(kern + 8 * tid);
    u32x4 prv = {0u, 0u, 0u, 0u};
    if (tid > 0) prv = *(const u32x4*)(kern + 8 * tid - 8);
    const unsigned E[9] = {prv.x, prv.y, prv.z, prv.w, cur.x, cur.y, cur.z, cur.w, 0u};
#pragma unroll
    for (int fl = 0; fl < 8; ++fl) { const int sft = 8 - fl, k = sft >> 1;
        u32x4 o;
        if (sft & 1) { o.x = __builtin_amdgcn_alignbit(E[k + 1], E[k], 16); o.y = __builtin_amdgcn_alignbit(E[k + 2], E[k + 1], 16);
                       o.z = __builtin_amdgcn_alignbit(E[k + 3], E[k + 2], 16); o.w = __builtin_amdgcn_alignbit(E[k + 4], E[k + 3], 16); }
        else { o.x = E[k]; o.y = E[k + 1]; o.z = E[k + 2]; o.w = E[k + 3]; }
        *(LAS u32x4*)(KC + fl * HY_KCS + 8 * tid) = o; }
}
__device__ __forceinline__ f32x4 hy_short4(const bf16* prow, int t0, float w0, float w1, float w2, float cb) {
    const u32x2 g = *(const u32x2*)(prow + t0);
    const float p0 = bflo(g.x), p1 = bfhi(g.x), p2 = bflo(g.y), p3 = bfhi(g.y);
    const float pm = (t0 > 0) ? bf2f(prow[t0 - 1]) : 0.f, pp = (t0 + 4 < SEQ) ? bf2f(prow[t0 + 4]) : 0.f;
    f32x4 r; r[0] = cb + w0 * pm + w1 * p0 + w2 * p1; r[1] = cb + w0 * p0 + w1 * p1 + w2 * p2; r[2] = cb + w0 * p1 + w1 * p2 + w2 * p3; r[3] = cb + w0 * p2 + w1 * p3 + w2 * pp;
    return r;
}
__device__ __forceinline__ f32x4 hy_conv4(const u32x2 g, float pm, float pp, float w0, float w1, float w2, float cb) {
    const float p0 = bflo(g.x), p1 = bfhi(g.x), p2 = bflo(g.y), p3 = bfhi(g.y);
    f32x4 r; r[0] = cb + w0 * pm + w1 * p0 + w2 * p1; r[1] = cb + w0 * p0 + w1 * p1 + w2 * p2; r[2] = cb + w0 * p1 + w1 * p2 + w2 * p3; r[3] = cb + w0 * p2 + w1 * p3 + w2 * pp;
    return r;
}
__device__ __forceinline__ void hyena_phase(Frame& F) {
    LAS bf16* U = (LAS bf16*)(F.lds); LAS bf16* KC = (LAS bf16*)(F.lds + HY_U_BYTES);
    const bf16* PT = (const bf16*)(F.ws + WS_PTHY); const bf16* KERN = (const bf16*)(F.ws + WS_KERN); bf16* YT = (bf16*)(F.ws + WS_YTHY);
    const float* cw = F.in[I_HCW]; const float* cbv = F.in[I_HCB]; const float* hb = F.in[I_HBIAS];
    const int tid = F.tid, lane = F.lane, w = F.wave, fr = lane & 15, fq = lane >> 4;
    for (int c = F.vcu; c < DM; c += F.G) {
        hy_build_kc(KC, KERN + ((size_t)c * 2 + 0) * 4096, tid);
        { const int vc = 2048 + c; const float w0 = cw[0 * HYC + vc], w1 = cw[1 * HYC + vc], w2 = cw[2 * HYC + vc], cb = cbv[vc];
          const bf16* prow = PT + (size_t)vc * MTOK;
          u32x4 um[8]; unsigned short upm[8], upp[8];
#pragma unroll
          for (int it = 0; it < 8; ++it) { const int idx = tid + 512 * it, b = idx >> 8, t8 = (idx & 255) * 8; const bf16* pr = prow + (size_t)b * SEQ;
              um[it] = *(const u32x4*)(pr + t8); upm[it] = pr[t8 > 0 ? t8 - 1 : 0]; upp[it] = pr[t8 + 8 < SEQ ? t8 + 8 : SEQ - 1]; }
#pragma unroll
          for (int it = 0; it < 8; ++it) { const int idx = tid + 512 * it, b = idx >> 8, t8 = (idx & 255) * 8;
              const float pm = t8 > 0 ? bf2f(upm[it]) : 0.f, pp = t8 + 8 < SEQ ? bf2f(upp[it]) : 0.f;
              u32x2 g0; g0.x = um[it].x; g0.y = um[it].y; u32x2 g1v; g1v.x = um[it].z; g1v.y = um[it].w;
              const f32x4 lo = hy_conv4(g0, pm, bflo(um[it].z), w0, w1, w2, cb), hi = hy_conv4(g1v, bfhi(um[it].y), pp, w0, w1, w2, cb);
              u32x4 o; o.x = pk2(lo[0], lo[1]); o.y = pk2(lo[2], lo[3]); o.z = pk2(hi[0], hi[1]); o.w = pk2(hi[2], hi[3]);
              *(LAS u32x4*)(U + b * HY_LDU + t8) = o; } }
        __syncthreads();
#pragma unroll 1
        for (int o = 0; o < 2; ++o) {
            f32x4 acc[16];
#pragma unroll
            for (int i = 0; i < 16; ++i) acc[i] = (f32x4){0.f, 0.f, 0.f, 0.f};
            const LAS bf16* kbase = KC + (fr & 7) * HY_KCS + 2048 + 8 * fq - 8 * (fr >> 3) - 256 * w;
            const LAS bf16* ubase = U + fr * HY_LDU + 8 * fq;
            bf16x8 win[16];
#pragma unroll
            for (int i = 0; i < 16; ++i) win[i] = *(const LAS bf16x8*)(kbase - 16 * i);
            bf16x8 bnx = *(const LAS bf16x8*)(ubase);
#pragma unroll 1
            for (int sj8 = 0; sj8 < 64; sj8 += 8) {
#pragma unroll
                for (int u = 0; u < 8; ++u) { const int sj = sj8 + u;
                    const bf16x8 bfr = bnx;
                    bnx = *(const LAS bf16x8*)(ubase + 32 * ((sj + 1) & 63));
#pragma unroll
                    for (int t2 = 2; t2 < 18; ++t2) { const int tt = t2 & 15;
                        acc[tt] = __builtin_amdgcn_mfma_f32_16x16x32_bf16(win[(tt - 2 * u) & 15], bfr, acc[tt], 0, 0, 0); }
                    win[(14 - 2 * u) & 15] = *(const LAS bf16x8*)(kbase + 16 * (2 * sj + 2));
                    win[(15 - 2 * u) & 15] = *(const LAS bf16x8*)(kbase + 16 * (2 * sj + 1));
                } }
            const float hbias = hb[o * DM + c];
            const int gc = (o == 0) ? c : 1024 + c;
            const float w0 = cw[0 * HYC + gc], w1 = cw[1 * HYC + gc], w2 = cw[2 * HYC + gc], cb = cbv[gc];
            const bf16* grow = PT + (size_t)gc * MTOK + (size_t)fr * SEQ;
            u32x2 zpk[16], gm[16]; unsigned short gpm[16], gpp[16];
#pragma unroll
            for (int tt = 0; tt < 16; ++tt) { const int t0 = 256 * w + 16 * tt + 4 * fq;
                gm[tt] = *(const u32x2*)(grow + t0); gpm[tt] = grow[t0 > 0 ? t0 - 1 : 0]; gpp[tt] = grow[t0 + 4 < SEQ ? t0 + 4 : SEQ - 1]; }
#pragma unroll
            for (int tt = 0; tt < 16; ++tt) { const int t0 = 256 * w + 16 * tt + 4 * fq;
                const u32x2 uu = *(const LAS u32x2*)(U + fr * HY_LDU + t0);
                const f32x4 g = hy_conv4(gm[tt], t0 > 0 ? bf2f(gpm[tt]) : 0.f, t0 + 4 < SEQ ? bf2f(gpp[tt]) : 0.f, w0, w1, w2, cb);
                f32x4 y = acc[tt]; y[0] = g[0] * (y[0] + bflo(uu.x) * hbias); y[1] = g[1] * (y[1] + bfhi(uu.x) * hbias); y[2] = g[2] * (y[2] + bflo(uu.y) * hbias); y[3] = g[3] * (y[3] + bfhi(uu.y) * hbias);
                zpk[tt].x = pk2(y[0], y[1]); zpk[tt].y = pk2(y[2], y[3]); }
            __syncthreads();
            if (o == 0) {
#pragma unroll
                for (int tt = 0; tt < 16; ++tt) *(LAS u32x2*)(U + fr * HY_LDU + 256 * w + 16 * tt + 4 * fq) = zpk[tt];
                hy_build_kc(KC, KERN + ((size_t)c * 2 + 1) * 4096, tid);
                __syncthreads();
            } else {
                bf16* yrow = YT + (size_t)c * MTOK + (size_t)fr * SEQ + 256 * w + 4 * fq;
#pragma unroll
                for (int tt = 0; tt < 16; ++tt) *(u32x2*)(yrow + 16 * tt) = zpk[tt];
            }
        }
    }
}

__device__ __forceinline__ void ssd_conv_phase(Frame& F) {
    bf16* XBC = (bf16*)(F.ws + WS_XBC); const bf16* HALO = (const bf16*)(F.ws + WS_HALO);
    const float* scw = F.in[I_SCW]; const float* scb = F.in[I_SCB];
    const int gw = F.vcu * NWAVES + F.wave, NGW = F.G * NWAVES, lane = F.lane;
    for (int item = gw; item < BATCH * 32 * 8; item += NGW) {
        const int cb8 = item & 7, seg = (item >> 3) & 31, b = item >> 8, col = cb8 * 512 + lane * 8;
        float wk[5][8], cbv[8];
#pragma unroll
        for (int k = 0; k < 5; ++k) { const f32x4 a = *(const f32x4*)(scw + k * CONVD + col), c = *(const f32x4*)(scw + k * CONVD + col + 4);
#pragma unroll
            for (int e = 0; e < 4; ++e) { wk[k][e] = a[e]; wk[k][4 + e] = c[e]; } }
        { const f32x4 a = *(const f32x4*)(scb + col), c = *(const f32x4*)(scb + col + 4);
#pragma unroll
          for (int e = 0; e < 4; ++e) { cbv[e] = a[e]; cbv[4 + e] = c[e]; } }
        bf16* xrow0 = XBC + ((size_t)b * SEQ + seg * 64) * CONVD + col;
        const bf16* hlo = HALO + ((size_t)(b * 33 + seg) * 4) * CONVD + col;
        const bf16* hhi = HALO + ((size_t)(b * 33 + seg + 1) * 4 + 2) * CONVD + col;
        const u32x4 zero4 = {0u, 0u, 0u, 0u};
        u32x4 W[12];
        W[0] = seg > 0 ? *(const u32x4*)(hlo) : zero4; W[1] = seg > 0 ? *(const u32x4*)(hlo + CONVD) : zero4;
        W[2] = *(const u32x4*)(xrow0); W[3] = *(const u32x4*)(xrow0 + CONVD);
#pragma unroll 1
        for (int blk = 0; blk < 8; ++blk) { const int r0 = 8 * blk;
#pragma unroll
            for (int i = 4; i < 12; ++i) { const int rr = r0 - 2 + i;
                if (rr < 64) W[i] = *(const u32x4*)(xrow0 + (size_t)rr * CONVD);
                else W[i] = (seg < 31) ? *(const u32x4*)(hhi + (size_t)(rr - 64) * CONVD) : zero4; }
#pragma unroll
            for (int o = 0; o < 8; ++o) { float v[8];
#pragma unroll
                for (int e = 0; e < 8; ++e) v[e] = cbv[e];
#pragma unroll
                for (int k = 0; k < 5; ++k) { const u32x4 p = W[o + k];
                    v[0] += wk[k][0] * bflo(p.x); v[1] += wk[k][1] * bfhi(p.x); v[2] += wk[k][2] * bflo(p.y); v[3] += wk[k][3] * bfhi(p.y);
                    v[4] += wk[k][4] * bflo(p.z); v[5] += wk[k][5] * bfhi(p.z); v[6] += wk[k][6] * bflo(p.w); v[7] += wk[k][7] * bfhi(p.w); }
#pragma unroll
                for (int e = 0; e < 8; ++e) v[e] = siluf_(v[e]);
                u32x4 ov; ov.x = pk2(v[0], v[1]); ov.y = pk2(v[2], v[3]); ov.z = pk2(v[4], v[5]); ov.w = pk2(v[6], v[7]);
                *(u32x4*)(xrow0 + (size_t)(r0 + o) * CONVD) = ov; }
#pragma unroll
            for (int i = 0; i < 4; ++i) W[i] = W[8 + i];
        }
    }
}

constexpr int SS_LDC = 144, SS_LDT = 80;
constexpr int SS_C = 0, SS_B = 18432, SS_BT = 36864, SS_M = 57344, SS_XD = 77824, SS_XE = 98304, SS_SB = 118784, SS_ACS = 155648, SS_DTV = 156672, SS_TOE = 157696, SS_END = 158720;
static_assert(SS_END <= MISC_OFF, "SSD LDS map");

template <int KS>
__device__ __forceinline__ f32x4 mma16(const LAS bf16* arow, const LAS bf16* brow, f32x4 acc) {
    bf16x8 a[KS], b[KS];
#pragma unroll
    for (int kk = 0; kk < KS; ++kk) { a[kk] = *(const LAS bf16x8*)(arow + 32 * kk); b[kk] = *(const LAS bf16x8*)(brow + 32 * kk); }
#pragma unroll
    for (int kk = 0; kk < KS; ++kk) acc = __builtin_amdgcn_mfma_f32_16x16x32_bf16(a[kk], b[kk], acc, 0, 0, 0);
    return acc;
}

__device__ __forceinline__ void ssd_phase(Frame& F) {
    LAS unsigned char* L = F.lds;
    LAS bf16* Cl = (LAS bf16*)(L + SS_C); LAS bf16* Bl = (LAS bf16*)(L + SS_B); LAS bf16* BT = (LAS bf16*)(L + SS_BT); LAS bf16* Ml = (LAS bf16*)(L + SS_M);
    LAS bf16* XD = (LAS bf16*)(L + SS_XD); LAS bf16* XE = (LAS bf16*)(L + SS_XE); LAS bf16* SB = (LAS bf16*)(L + SS_SB);
    LAS float* ACS = (LAS float*)(L + SS_ACS); LAS float* DTV = (LAS float*)(L + SS_DTV); LAS float* TOE = (LAS float*)(L + SS_TOE);
    const bf16* XBC = (const bf16*)(F.ws + WS_XBC); const float* DT = (const float*)(F.ws + WS_DT); const bf16* Zb = (const bf16*)F.out; bf16* YS = (bf16*)(F.ws + WS_YSSD);
    const float* dtb = F.in[I_DTB]; const float* alog = F.in[I_ALOG]; const float* sd = F.in[I_SD];
    const int tid = F.tid, lane = F.lane, w = F.wave, fr = lane & 15, fq = lane >> 4;
    for (int unit = F.vcu; unit < BATCH * NGRP * 2; unit += F.G) {
        const int b = unit >> 4, g = (unit >> 1) & 7, hp = unit & 1, h0 = 4 * g + 2 * hp;
#pragma unroll 1
        for (int dir = 0; dir < 2; ++dir) {
            const float dtbias = (w < 2) ? dtb[dir * 32 + h0 + w] : 0.f, aexp = (w < 2) ? __expf(alog[dir * 32 + h0 + w]) : 0.f;
            auto scan = [&](int buf, float raw) {
                raw += dtbias; const float dtv = raw > 20.f ? raw : log1pf(__expf(raw)); float a = -dtv * aexp;
#pragma unroll
                for (int o = 1; o < 64; o <<= 1) { const float v = __shfl_up(a, o); if (lane >= o) a += v; }
                const float tot = __shfl(a, 63); const int ix = (buf * 2 + w) * 64 + lane;
                ACS[ix] = a; DTV[ix] = dtv; TOE[ix] = __expf(tot - a); };
            auto dtload = [&](int ci) -> float { const int ch = dir ? 31 - ci : ci, r = dir ? 63 - lane : lane;
                return DT[((size_t)b * SEQ + 64 * ch + r) * 64 + dir * 32 + h0 + w]; };
            auto rowload = [&](int ci, int it, int tl) -> u32x4 { const int cg = (tl >> 6) + 8 * it, l = tl & 63, ch = dir ? 31 - ci : ci, r = dir ? 63 - l : l, lc0 = cg * 8;
                const int col = lc0 < 128 ? 64 * h0 + lc0 : (lc0 < 256 ? 2048 + 128 * g + (lc0 - 128) : 3072 + 128 * g + (lc0 - 256));
                return *(const u32x4*)(XBC + ((size_t)b * SEQ + 64 * ch + r) * CONVD + col); };
            f32x4 Sacc[8];
#pragma unroll
            for (int i = 0; i < 8; ++i) Sacc[i] = (f32x4){0.f, 0.f, 0.f, 0.f};
            const float dsk = sd[h0 + (w >> 2)];
            __syncthreads();
            for (int i = tid; i < 2 * 64 * SS_LDC / 2; i += NTHR) ((LAS unsigned*)SB)[i] = 0u;
            float dtn = 0.f;
            if (w < 2) { scan(0, dtload(0)); dtn = dtload(1); }
            u32x4 pf[6];
#pragma unroll
            for (int it = 0; it < 6; ++it) pf[it] = rowload(0, it, tid);
            __syncthreads();
#pragma unroll 1
            for (int ci = 0; ci < 32; ++ci) {
                const int ch = dir ? 31 - ci : ci, buf = ci & 1;
                const size_t tokbase = (size_t)b * SEQ + 64 * ch;
                int tl = tid; asm volatile("" : "+v"(tl));
                const LAS float* acs = ACS + buf * 128; const LAS float* dtv = DTV + buf * 128; const LAS float* toe = TOE + buf * 128;
#pragma unroll
                for (int it = 0; it < 6; ++it) { const int cg = (tl >> 6) + 8 * it, l = tl & 63; const u32x4 p = pf[it];
                    if (it < 2) { const int hh = cg >> 3, p0 = (cg & 7) * 8; const float d = dtv[hh * 64 + l], de = d * toe[hh * 64 + l];
                        const float v[8] = {bflo(p.x), bfhi(p.x), bflo(p.y), bfhi(p.y), bflo(p.z), bfhi(p.z), bflo(p.w), bfhi(p.w)};
#pragma unroll
                        for (int e = 0; e < 8; ++e) { XD[(hh * 64 + p0 + e) * SS_LDT + l] = (bf16)f2bf(v[e] * d); XE[(hh * 64 + p0 + e) * SS_LDT + l] = (bf16)f2bf(v[e] * de); } }
                    else if (it < 4) { const int n0 = (cg - 16) * 8; *(LAS u32x4*)(Bl + l * SS_LDC + n0) = p;
                        LAS bf16* d = BT + n0 * SS_LDT + l;
                        d[0 * SS_LDT] = (bf16)(p.x & 0xffff); d[1 * SS_LDT] = (bf16)(p.x >> 16); d[2 * SS_LDT] = (bf16)(p.y & 0xffff); d[3 * SS_LDT] = (bf16)(p.y >> 16);
                        d[4 * SS_LDT] = (bf16)(p.z & 0xffff); d[5 * SS_LDT] = (bf16)(p.z >> 16); d[6 * SS_LDT] = (bf16)(p.w & 0xffff); d[7 * SS_LDT] = (bf16)(p.w >> 16); }
                    else { const int n0 = (cg - 32) * 8; *(LAS u32x4*)(Cl + l * SS_LDC + n0) = p; } }
                if (ci + 1 < 32) {
#pragma unroll
                    for (int it = 0; it < 6; ++it) pf[it] = rowload(ci + 1, it, tl); }
                __syncthreads();
                const int hh = w >> 2, li = w & 3, lrow = 16 * li + fr;
                const int rloc = dir ? 63 - lrow : lrow; const size_t tok = tokbase + rloc;
                u32x2 pv[4], zv[4];
                if (dir) {
#pragma unroll
                    for (int pi = 0; pi < 4; ++pi) { const size_t o = tok * DSSM + 64 * (h0 + hh) + 16 * pi + 4 * fq; pv[pi] = *(const u32x2*)(YS + o); zv[pi] = *(const u32x2*)(Zb + o); } }
#pragma unroll
                for (int q = 0; q < 2; ++q) { const int id = 2 * w + q, si = id >> 2, lj = id & 3, l = 16 * lj + fr, s0 = 16 * si + 4 * fq;
                    u32x2 m0 = {0u, 0u}, m1 = {0u, 0u};
                    if (si <= lj) { f32x4 cb = (f32x4){0.f, 0.f, 0.f, 0.f};
                        cb = mma16<4>(Bl + (16 * si + fr) * SS_LDC + 8 * fq, Cl + (16 * lj + fr) * SS_LDC + 8 * fq, cb);
                        const float a0 = acs[l], a1 = acs[64 + l]; float x0[4], x1[4];
#pragma unroll
                        for (int j = 0; j < 4; ++j) { const int s = s0 + j; x0[j] = (s <= l) ? cb[j] * __expf(a0 - acs[s]) : 0.f; x1[j] = (s <= l) ? cb[j] * __expf(a1 - acs[64 + s]) : 0.f; }
                        m0.x = pk2(x0[0], x0[1]); m0.y = pk2(x0[2], x0[3]); m1.x = pk2(x1[0], x1[1]); m1.y = pk2(x1[2], x1[3]); }
                    *(LAS u32x2*)(Ml + (0 * 64 + l) * SS_LDT + s0) = m0; *(LAS u32x2*)(Ml + (1 * 64 + l) * SS_LDT + s0) = m1; }
                f32x4 Y[4];
                { bf16x8 cfr[4];
#pragma unroll
                  for (int kk = 0; kk < 4; ++kk) cfr[kk] = *(const LAS bf16x8*)(Cl + lrow * SS_LDC + 8 * fq + 32 * kk);
#pragma unroll
                  for (int pi = 0; pi < 4; ++pi) { Y[pi] = (f32x4){0.f, 0.f, 0.f, 0.f}; const LAS bf16* ar = SB + (hh * 64 + 16 * pi + fr) * SS_LDC + 8 * fq;
#pragma unroll
                      for (int kk = 0; kk < 4; ++kk) Y[pi] = __builtin_amdgcn_mfma_f32_16x16x32_bf16(*(const LAS bf16x8*)(ar + 32 * kk), cfr[kk], Y[pi], 0, 0, 0); } }
                __syncthreads();
                { const float el = __expf(acs[hh * 64 + lrow]);
                  const float dinv = __builtin_amdgcn_rcpf(dtv[hh * 64 + lrow]);
                  const bf16x8 mf0 = *(const LAS bf16x8*)(Ml + (hh * 64 + lrow) * SS_LDT + 8 * fq), mf1 = *(const LAS bf16x8*)(Ml + (hh * 64 + lrow) * SS_LDT + 8 * fq + 32);
#pragma unroll
                  for (int pi = 0; pi < 4; ++pi) { Y[pi] = Y[pi] * el; const LAS bf16* ar = XD + (hh * 64 + 16 * pi + fr) * SS_LDT + 8 * fq;
                      Y[pi] = __builtin_amdgcn_mfma_f32_16x16x32_bf16(*(const LAS bf16x8*)(ar), mf0, Y[pi], 0, 0, 0);
                      Y[pi] = __builtin_amdgcn_mfma_f32_16x16x32_bf16(*(const LAS bf16x8*)(ar + 32), mf1, Y[pi], 0, 0, 0);
                      const int p0 = 16 * pi + 4 * fq; bf16* yp = YS + tok * DSSM + 64 * (h0 + hh) + p0; f32x4 y = Y[pi];
                      if (dir == 0) {
#pragma unroll
                          for (int j = 0; j < 4; ++j) y[j] += dsk * dinv * bf2f(XD[(hh * 64 + p0 + j) * SS_LDT + lrow]);
                      } else { const u32x2 pvv = pv[pi], zvv = zv[pi];
                          y[0] = (y[0] + bflo(pvv.x)) * siluf_(bflo(zvv.x)); y[1] = (y[1] + bfhi(pvv.x)) * siluf_(bfhi(zvv.x)); y[2] = (y[2] + bflo(pvv.y)) * siluf_(bflo(zvv.y)); y[3] = (y[3] + bfhi(pvv.y)) * siluf_(bfhi(zvv.y)); }
                      u32x2 o; o.x = pk2(y[0], y[1]); o.y = pk2(y[2], y[3]); *(u32x2*)yp = o; } }
                { const int pi = w & 3; const float dec = __expf(acs[hh * 64 + 63]);
                  const bf16x8 xf0 = *(const LAS bf16x8*)(XE + (hh * 64 + 16 * pi + fr) * SS_LDT + 8 * fq), xf1 = *(const LAS bf16x8*)(XE + (hh * 64 + 16 * pi + fr) * SS_LDT + 8 * fq + 32);
#pragma unroll
                  for (int ni = 0; ni < 8; ++ni) { Sacc[ni] = Sacc[ni] * dec; const LAS bf16* ar = BT + (16 * ni + fr) * SS_LDT + 8 * fq;
                      Sacc[ni] = __builtin_amdgcn_mfma_f32_16x16x32_bf16(*(const LAS bf16x8*)(ar), xf0, Sacc[ni], 0, 0, 0);
                      Sacc[ni] = __builtin_amdgcn_mfma_f32_16x16x32_bf16(*(const LAS bf16x8*)(ar + 32), xf1, Sacc[ni], 0, 0, 0);
                      u32x2 o; o.x = pk2(Sacc[ni][0], Sacc[ni][1]); o.y = pk2(Sacc[ni][2], Sacc[ni][3]);
                      *(LAS u32x2*)(SB + (hh * 64 + 16 * pi + fr) * SS_LDC + 16 * ni + 4 * fq) = o; } }
                if (w < 2 && ci + 1 < 32) { scan(buf ^ 1, dtn); if (ci + 2 < 32) dtn = dtload(ci + 2); }
                __syncthreads();
            }
        }
    }
}

__device__ __forceinline__ void ssd_norm_phase(Frame& F) {
    bf16* YS = (bf16*)(F.ws + WS_YSSD); const float* nw = F.in[I_SNW];
    const int gw = F.vcu * NWAVES + F.wave, NGW = F.G * NWAVES, lane = F.lane;
    for (int m = gw; m < MTOK; m += NGW) { bf16* row = YS + (size_t)m * DSSM + lane * 32;
        u32x4 v[4]; float ss = 0.f;
#pragma unroll
        for (int j = 0; j < 4; ++j) { v[j] = *(const u32x4*)(row + 8 * j);
            const float a0 = bflo(v[j].x), a1 = bfhi(v[j].x), a2 = bflo(v[j].y), a3 = bfhi(v[j].y), a4 = bflo(v[j].z), a5 = bfhi(v[j].z), a6 = bflo(v[j].w), a7 = bfhi(v[j].w);
            ss += (a0 * a0 + a1 * a1) + (a2 * a2 + a3 * a3) + (a4 * a4 + a5 * a5) + (a6 * a6 + a7 * a7); }
        ss += __shfl_xor(ss, 1); ss += __shfl_xor(ss, 2); ss += __shfl_xor(ss, 4);
        const float rs = 1.0f / sqrtf(ss * (1.0f / 256.0f) + RMS_EPS);
#pragma unroll
        for (int j = 0; j < 4; ++j) { const f32x4 w0 = *(const f32x4*)(nw + lane * 32 + 8 * j), w1 = *(const f32x4*)(nw + lane * 32 + 8 * j + 4);
            u32x4 o; o.x = pk2(bflo(v[j].x) * rs * w0[0], bfhi(v[j].x) * rs * w0[1]); o.y = pk2(bflo(v[j].y) * rs * w0[2], bfhi(v[j].y) * rs * w0[3]);
            o.z = pk2(bflo(v[j].z) * rs * w1[0], bfhi(v[j].z) * rs * w1[1]); o.w = pk2(bflo(v[j].w) * rs * w1[2], bfhi(v[j].w) * rs * w1[3]);
            *(u32x4*)(row + 8 * j) = o; } }
}

constexpr int RT_WC = 131072;
__device__ __forceinline__ void ln1_router_phase(Frame& F) {
    float* H1 = (float*)(F.ws + WS_H1); bf16* H1B = (bf16*)(F.ws + WS_H1B);
    int* TOK = (int*)(F.ws + WS_TOK); float* WGT = (float*)(F.ws + WS_WGT); int* ASG = (int*)(F.ws + WS_ASG);
    const float* g1 = F.in[I_LN1G]; const float* b1 = F.in[I_LN1B]; const float* rw = F.in[I_RW]; const float* rb = F.in[I_RB];
    LAS float* hrow = (LAS float*)(F.lds + F.wave * 16384);
    LAS float* wc = (LAS float*)(F.lds + RT_WC);
    const int lane = F.lane, tid = F.tid;
    f32x4 gv[4], bv[4];
#pragma unroll
    for (int j = 0; j < 4; ++j) { gv[j] = *(const f32x4*)(g1 + 4 * lane + 256 * j); bv[j] = *(const f32x4*)(b1 + 4 * lane + 256 * j); }
    const float rbias = rb[lane];
    for (int step = F.vcu; step < MTOK / 32; step += F.G) {
        const int rg = step * 8 + F.wave;
        f32x4 nx0 = *(const f32x4*)(rw + tid * 4), nx1 = *(const f32x4*)(rw + 2048 + tid * 4);
#pragma unroll 1
        for (int r = 0; r < 4; ++r) { const size_t m = (size_t)rg * 4 + r; float* xr = H1 + m * DM;
            f32x4 v[4]; float s = 0.f;
#pragma unroll
            for (int j = 0; j < 4; ++j) { v[j] = *(const f32x4*)(xr + 4 * lane + 256 * j); s += (v[j][0] + v[j][1]) + (v[j][2] + v[j][3]); }
            const float mean = wave_sum(s) * (1.f / DM); float s2 = 0.f;
#pragma unroll
            for (int j = 0; j < 4; ++j) { v[j] = v[j] - mean; s2 += (v[j][0] * v[j][0] + v[j][1] * v[j][1]) + (v[j][2] * v[j][2] + v[j][3] * v[j][3]); }
            const float rstd = 1.f / sqrtf(wave_sum(s2) * (1.f / DM) + LN_EPS);
#pragma unroll
            for (int j = 0; j < 4; ++j) { const f32x4 h = v[j] * rstd * gv[j] + bv[j];
                *(f32x4*)(xr + 4 * lane + 256 * j) = h * DN_ALPHA;
                u32x2 o; o.x = pk2(h[0], h[1]); o.y = pk2(h[2], h[3]); *(u32x2*)(H1B + m * DM + 4 * lane + 256 * j) = o;
                *(LAS f32x4*)(hrow + r * 1024 + 4 * lane + 256 * j) = h; } }
        float lg[4] = {0.f, 0.f, 0.f, 0.f};
#pragma unroll 1
        for (int kc = 0; kc < 16; ++kc) {
            __syncthreads();
            *(LAS f32x4*)(wc + tid * 4) = nx0; *(LAS f32x4*)(wc + 2048 + tid * 4) = nx1;
            if (kc + 1 < 16) { nx0 = *(const f32x4*)(rw + (kc + 1) * 4096 + tid * 4); nx1 = *(const f32x4*)(rw + (kc + 1) * 4096 + 2048 + tid * 4); }
            __syncthreads();
#pragma unroll 4
            for (int kk = 0; kk < 64; kk += 4) {
                const float w0 = wc[(kk + 0) * 64 + lane], w1 = wc[(kk + 1) * 64 + lane], w2 = wc[(kk + 2) * 64 + lane], w3 = wc[(kk + 3) * 64 + lane];
#pragma unroll
                for (int r = 0; r < 4; ++r) { const f32x4 h = *(const LAS f32x4*)(hrow + r * 1024 + kc * 64 + kk); lg[r] += h[0] * w0 + h[1] * w1 + h[2] * w2 + h[3] * w3; } }
        }
#pragma unroll 1
        for (int r = 0; r < 4; ++r) { const int m = rg * 4 + r;
            const float score = 1.0f / (1.0f + expf(-lg[r])), biased = score + rbias;
            float m1 = biased; m1 = fmaxf(m1, __shfl_xor(m1, 1)); m1 = fmaxf(m1, __shfl_xor(m1, 2)); m1 = fmaxf(m1, __shfl_xor(m1, 4));
            const unsigned long long eq = __ballot(biased == m1); const int gbase = lane & ~7; const int first = gbase + __ffs((unsigned)((eq >> gbase) & 0xffull)) - 1;
            float v2 = (lane == first) ? -INFINITY : biased; v2 = fmaxf(v2, __shfl_xor(v2, 1)); v2 = fmaxf(v2, __shfl_xor(v2, 2)); v2 = fmaxf(v2, __shfl_xor(v2, 4));
            const float gs = m1 + v2; const int g = lane >> 3; int better = 0;
#pragma unroll
            for (int d = 1; d < 8; ++d) { const int g2 = (g + d) & 7; const float og = __shfl(gs, g2 * 8); better += (og > gs || (og == gs && g2 < g)) ? 1 : 0; }
            float masked = (better < 4) ? biased : -INFINITY; bool sel = false;
#pragma unroll 1
            for (int it = 0; it < TOPK; ++it) { const float mx = wave_max(masked); const unsigned long long bm = __ballot(masked == mx); const int win = __ffsll((long long)bm) - 1;
                if (lane == win) { sel = true; masked = -INFINITY; } }
            const float sw = wave_sum(sel ? score : 0.f);
            const unsigned long long selm = __ballot(sel);
            if (sel) { const unsigned pos = __hip_atomic_fetch_add((unsigned*)(F.ctl + CW_CNT + 64 * lane), 1u, __ATOMIC_RELAXED, __HIP_MEMORY_SCOPE_AGENT);
                TOK[(size_t)lane * MTOK + pos] = m; WGT[(size_t)lane * MTOK + pos] = score / sw * ROUTED_SCALE;
                ASG[(size_t)m * 8 + __popcll(selm & ((1ull << lane) - 1ull))] = lane * MTOK + (int)pos; } }
    }
}
constexpr int MOE_TP = 131072 + 1024, MOE_CNT = MOE_TP + 512;
__device__ __forceinline__ int moe_table(Frame& F) {
    LAS int* tp = (LAS int*)(F.lds + MOE_TP); LAS int* cnt = (LAS int*)(F.lds + MOE_CNT);
    __syncthreads();
    if (F.tid == 0) { int run = 0;
        for (int e = 0; e < NEX; ++e) { const int c = (e < NE) ? (int)__hip_atomic_load((unsigned*)(F.ctl + CW_CNT + 64 * e), __ATOMIC_RELAXED, __HIP_MEMORY_SCOPE_AGENT) : MTOK;
            cnt[e] = c; tp[e] = run; run += (c + 255) >> 8; }
        tp[NEX] = run; }
    __syncthreads();
    return tp[NEX];
}
__device__ __forceinline__ void fp8x8_fma(f32x4& a0, f32x4& a1, const u32x2 v, const float w) {
    const f32x2 p0 = __builtin_amdgcn_cvt_pk_f32_fp8((int)v.x, false), p1 = __builtin_amdgcn_cvt_pk_f32_fp8((int)v.x, true);
    const f32x2 p2 = __builtin_amdgcn_cvt_pk_f32_fp8((int)v.y, false), p3 = __builtin_amdgcn_cvt_pk_f32_fp8((int)v.y, true);
    a0[0] += w * p0.x; a0[1] += w * p0.y; a0[2] += w * p1.x; a0[3] += w * p1.y; a1[0] += w * p2.x; a1[1] += w * p2.y; a1[2] += w * p3.x; a1[3] += w * p3.y;
}
template <bool LAST>
__device__ __forceinline__ void moe_combine_phase(Frame& F, int p) {
    float* H1 = (float*)(F.ws + WS_H1); const unsigned char* YQ = (const unsigned char*)(F.ws + WS_YQ); const int* ASG = (const int*)(F.ws + WS_ASG); const float* WGT = (const float*)(F.ws + WS_WGT);
    const LAS int* tp = (const LAS int*)(F.lds + MOE_TP);
    const float* g2 = F.in[I_LN2G]; const float* b2 = F.in[I_LN2B];
    const int gw = F.vcu * NWAVES + F.wave, NGW = F.G * NWAVES, lane = F.lane;
    const size_t shbase = (size_t)tp[NE] * 256;
    for (int m = gw; m < MTOK; m += NGW) {
        int li = 0; if (lane < 8) li = ASG[(size_t)m * 8 + lane];
        float wk = 0.f; if (lane < 8) wk = WGT[li];
        const int e = li >> 15, pos = li & 32767; const int slot = 256 * tp[e] + pos;
        float* hp = H1 + (size_t)m * DM + 512 * p + 8 * lane;
        f32x4 a0 = *(const f32x4*)hp, a1 = *(const f32x4*)(hp + 4);
        u32x2 vv[9];
        vv[8] = *(const u32x2*)(YQ + (shbase + m) * 512 + 8 * lane);
#pragma unroll
        for (int k = 0; k < 8; ++k) { const int sk = __shfl(slot, k); vv[k] = *(const u32x2*)(YQ + (size_t)sk * 512 + 8 * lane); }
        fp8x8_fma(a0, a1, vv[8], 1.0f);
#pragma unroll
        for (int k = 0; k < 8; ++k) fp8x8_fma(a0, a1, vv[k], __shfl(wk, k));
        if (!LAST) { *(f32x4*)hp = a0; *(f32x4*)(hp + 4) = a1; }
        else { const float* xr = H1 + (size_t)m * DM + 8 * lane; f32x4 v[4]; float s = 0.f;
            v[0] = *(const f32x4*)xr; v[1] = *(const f32x4*)(xr + 4); v[2] = a0; v[3] = a1;
#pragma unroll
            for (int j = 0; j < 4; ++j) s += (v[j][0] + v[j][1]) + (v[j][2] + v[j][3]);
            const float mean = wave_sum(s) * (1.f / DM); float s2 = 0.f;
#pragma unroll
            for (int j = 0; j < 4; ++j) { v[j] = v[j] - mean; s2 += (v[j][0] * v[j][0] + v[j][1] * v[j][1]) + (v[j][2] * v[j][2] + v[j][3] * v[j][3]); }
            const float rstd = 1.f / sqrtf(wave_sum(s2) * (1.f / DM) + LN_EPS);
#pragma unroll
            for (int j = 0; j < 4; ++j) { const int c = (j >> 1) * 512 + 8 * lane + 4 * (j & 1); const f32x4 gv = *(const f32x4*)(g2 + c), bv = *(const f32x4*)(b2 + c);
                *(f32x4*)(F.out + (size_t)m * DM + c) = v[j] * rstd * gv + bv; } }
    }
}
__device__ __forceinline__ void ln2_phase(Frame& F) {
    const float* H1 = (const float*)(F.ws + WS_H1); const float* g2 = F.in[I_LN2G]; const float* b2 = F.in[I_LN2B];
    const int gw = F.vcu * NWAVES + F.wave, NGW = F.G * NWAVES, lane = F.lane;
    f32x4 gv[4], bv[4];
#pragma unroll
    for (int j = 0; j < 4; ++j) { gv[j] = *(const f32x4*)(g2 + 4 * lane + 256 * j); bv[j] = *(const f32x4*)(b2 + 4 * lane + 256 * j); }
    for (int m = gw; m < MTOK; m += NGW) { const float* xr = H1 + (size_t)m * DM;
        f32x4 v[4]; float s = 0.f;
#pragma unroll
        for (int j = 0; j < 4; ++j) { v[j] = *(const f32x4*)(xr + 4 * lane + 256 * j); s += (v[j][0] + v[j][1]) + (v[j][2] + v[j][3]); }
        const float mean = wave_sum(s) * (1.f / DM); float s2 = 0.f;
#pragma unroll
        for (int j = 0; j < 4; ++j) { v[j] = v[j] - mean; s2 += (v[j][0] * v[j][0] + v[j][1] * v[j][1]) + (v[j][2] * v[j][2] + v[j][3] * v[j][3]); }
        const float rstd = 1.f / sqrtf(wave_sum(s2) * (1.f / DM) + LN_EPS);
#pragma unroll
        for (int j = 0; j < 4; ++j) *(f32x4*)(F.out + (size_t)m * DM + 4 * lane + 256 * j) = v[j] * rstd * gv[j] + bv[j]; }
}

#ifndef MK_N_LAUNCHES
#define MK_N_LAUNCHES 1
#endif
constexpr int NPH = 15;
constexpr int N_LAUNCHES = MK_N_LAUNCHES;

__global__ void __launch_bounds__(NTHR, 2) fwd_kernel(Args args) {
    extern __shared__ __attribute__((aligned(16))) unsigned char lds_raw[];
    Frame F;
    F.lds = (LAS unsigned char*)lds_raw;
    F.MISC = (volatile LAS unsigned*)(F.lds + MISC_OFF);
    F.tid = threadIdx.x; F.lane = F.tid & 63; F.wave = __builtin_amdgcn_readfirstlane(F.tid >> 6);
    F.G = gridDim.x; { const int bx = blockIdx.x; F.vcu = (F.G % 8 == 0) ? (bx % 8) * (F.G / 8) + bx / 8 : bx; }
    F.ws = args.ws; F.ctl = (gu32*)(args.ws + WS_CTL); F.in = args.in; F.out = args.out;
    for (int u = F.tid; u < (LDS_BYTES - MISC_OFF) / 4; u += NTHR) ((LAS unsigned*)(F.lds + MISC_OFF))[u] = 0u;
    __syncthreads();
    XcdBarrier bar; bar.bar = (unsigned*)(F.ctl + CW_BAR); bar.x = 0; bar.st = nullptr;
    if (N_LAUNCHES != NPH) bar = xcd_barrier_post((unsigned*)(F.ctl + CW_BAR), F.MISC + 8);
    const int lo = args.ph_lo, hi = args.ph_hi;
#ifndef PH_MASK
#define PH_MASK 0x7fff
#endif
#define IN(k) ((((PH_MASK) >> (k)) & 1) && lo <= (k) && (k) < hi)
#define SEAM(k) do { if (IN(k) && IN((k) + 1)) xcd_barrier(bar); } while (0)
#ifndef REP_MASK
#define REP_MASK 0
#endif
#define REPS(k) for (int rep_ = 0; rep_ < ((((REP_MASK) >> (k)) & 1) ? 2 : 1); ++rep_, ((((REP_MASK) >> (k)) & 1) && rep_ == 1 ? xcd_barrier(bar) : (void)0))
    const int G = F.G, bx = (int)blockIdx.x;

    if (IN(0)) REPS(0) { p0_prologue(F); } SEAM(0);
    if (IN(1)) REPS(1) {
        pg8::StaticOrder S; S.init((const bf16*)(F.ws + WS_XB), (const bf16*)(F.ws + WS_WINT), MTOK, HYC, DM, G, bx);
        pg8::EpiHyT E{(bf16*)(F.ws + WS_PTHY), F.in[I_BIN]};
        pg8::gemm_phase<pg8::EpiHyT, pg8::StaticOrder, false>(F.lds, DM, S, E);
    } SEAM(1);
    if (IN(2)) REPS(2) { hyena_phase(F); } SEAM(2);
    if (IN(3)) REPS(3) { p3_transpose(F); } SEAM(3);
    if (IN(4)) REPS(4) {
        pg8::StaticOrder S; S.init((const bf16*)(F.ws + WS_XB), (const bf16*)(F.ws + WS_WINT) + (size_t)3072 * DM, MTOK, 6400, DM, G, bx);
        pg8::EpiZXD E{(bf16*)F.out, (bf16*)(F.ws + WS_XBC), (float*)(F.ws + WS_DT), F.in[I_BIN], (bf16*)(F.ws + WS_HALO)};
        pg8::gemm_phase<pg8::EpiZXD, pg8::StaticOrder, false>(F.lds, DM, S, E);
    } SEAM(4);
    if (IN(5)) REPS(5) { ssd_conv_phase(F); } SEAM(5);
    if (IN(6)) REPS(6) { ssd_phase(F); } SEAM(6);
    if (IN(7)) REPS(7) { ssd_norm_phase(F); p6_reconvert(F); } SEAM(7);
    if (IN(8)) REPS(8) {
        pg8::StaticOrder S; S.init((const bf16*)(F.ws + WS_XB2), (const bf16*)(F.ws + WS_WING), MTOK, 2048, DM, G, bx);
        pg8::EpiBf<0> E{(bf16*)(F.ws + WS_G), 2048, F.in[I_BIN] + 9280, nullptr, 0, nullptr};
        pg8::gemm_phase<pg8::EpiBf<0>, pg8::StaticOrder, false>(F.lds, DM, S, E);
    } SEAM(8);
    if (IN(9)) REPS(9) {
        pg8::StaticOrder S; S.init((const bf16*)(F.ws + WS_YHY), (const bf16*)(F.ws + WS_WHYB), MTOK, DM, DM, G, bx);
        pg8::EpiBf<1> E{(bf16*)(F.ws + WS_MIX), DM, nullptr, (const bf16*)(F.ws + WS_G), 2048, nullptr};
        pg8::gemm_phase<pg8::EpiBf<1>, pg8::StaticOrder, false>(F.lds, DM, S, E);
    } SEAM(9);
    if (IN(10)) REPS(10) {
        pg8::StaticOrder S; S.init((const bf16*)(F.ws + WS_YSSD), (const bf16*)(F.ws + WS_WSSDB), MTOK, DM, DSSM, G, bx);
        pg8::EpiBf<2> E{(bf16*)(F.ws + WS_MIX), DM, nullptr, (const bf16*)(F.ws + WS_G) + 1024, 2048, (const bf16*)(F.ws + WS_MIX)};
        pg8::gemm_phase<pg8::EpiBf<2>, pg8::StaticOrder, false>(F.lds, DSSM, S, E);
    } SEAM(10);
    if (IN(11)) REPS(11) {
        pg8::StaticOrder S; S.init((const bf16*)(F.ws + WS_MIX), (const bf16*)(F.ws + WS_WOUT), MTOK, DM, DM, G, bx);
        pg8::EpiRes E{(float*)(F.ws + WS_H1), F.in[I_BOUT], F.in[I_X], DN_ALPHA};
        pg8::gemm_phase<pg8::EpiRes, pg8::StaticOrder, false>(F.lds, DM, S, E);
        p10_expert_weights(F);
    } SEAM(11);
    if (IN(12)) REPS(12) { ln1_router_phase(F); } SEAM(12);
    if (IN(13)) REPS(13) {
        const int total = moe_table(F);
        pg8::MoeOrder<2, true> S{(const LAS int*)(F.lds + MOE_TP), (const LAS int*)(F.lds + MOE_CNT), G, bx, total, (const char*)(F.ws + WS_H1B), (const char*)(F.ws + WS_EW1), (const int*)(F.ws + WS_TOK)};
        pg8::EpiSwiGLU E{(bf16*)(F.ws + WS_HID)};
        pg8::gemm_phase<pg8::EpiSwiGLU, pg8::MoeOrder<2, true>, true>(F.lds, DM, S, E);
    } SEAM(13);
    if (IN(14)) {
        const int total = moe_table(F);
#pragma unroll 1
        for (int p = 0; p < 2; ++p) {
            { pg8::SlotOrder2 S{(const LAS int*)(F.lds + MOE_TP), G, bx, total, p, (const char*)(F.ws + WS_HID), (const char*)(F.ws + WS_EW2)};
              pg8::EpiSlot8 E{(unsigned char*)(F.ws + WS_YQ)};
              int kd = DEXP; asm volatile("" : "+s"(kd));
              pg8::gemm_phase<pg8::EpiSlot8, pg8::SlotOrder2, false>(F.lds, kd, S, E); }
            xcd_barrier(bar);
            if (p == 0) { moe_combine_phase<false>(F, p); xcd_barrier(bar); }
            else moe_combine_phase<true>(F, p);
        }
    }
#ifdef EXTRA_BARS
    for (int xb_ = 0; xb_ < EXTRA_BARS; ++xb_) xcd_barrier(bar);
#endif
#undef IN
#undef SEAM
}

extern "C" void kernel_launch(void* const* d_in, const int* in_sizes, int n_in, void* d_out, int out_size, void* d_ws, size_t ws_size, hipStream_t stream) {
    static int grid = 0;
    if (grid == 0) {
        if (n_in != 38 || out_size != MTOK * DM || ws_size < WS_END) { fprintf(stderr, "kernel_launch: unexpected shapes (n_in %d out %d ws %zu)\n", n_in, out_size, ws_size); grid = -1; return; }
        int dev = 0, cus = 0, per_cu = 0;
        if (hipGetDevice(&dev) != hipSuccess || hipDeviceGetAttribute(&cus, hipDeviceAttributeMultiprocessorCount, dev) != hipSuccess) { grid = -1; return; }
        if (hipFuncSetAttribute((const void*)fwd_kernel, hipFuncAttributeMaxDynamicSharedMemorySize, LDS_BYTES) != hipSuccess) { fprintf(stderr, "kernel_launch: hipFuncSetAttribute failed\n"); grid = -1; return; }
        if (hipOccupancyMaxActiveBlocksPerMultiprocessor(&per_cu, (const void*)fwd_kernel, NTHR, LDS_BYTES) != hipSuccess || per_cu < 1) fprintf(stderr, "kernel_launch: occupancy query says %d\n", per_cu);
        (void)hipGetLastError();
        grid = cus;
    }
    if (grid < 0) return;
    (void)hipMemsetAsync((char*)d_ws + WS_CTL, 0, CTL_ZERO_BYTES, stream);
    Args a{};
    for (int i = 0; i < 38; ++i) a.in[i] = (const float*)d_in[i];
    a.out = (float*)d_out; a.ws = (unsigned char*)d_ws;
    for (int li = 0; li < N_LAUNCHES; ++li) {
        a.ph_lo = (N_LAUNCHES == NPH) ? li : 0; a.ph_hi = (N_LAUNCHES == NPH) ? li + 1 : NPH; a.li = li;
        hipLaunchKernelGGL(fwd_kernel, dim3(grid), dim3(NTHR), LDS_BYTES, stream, a);
    }
}
```

```cpp
#define MK_N_LAUNCHES 1
#include <hip/hip_runtime.h>
#include <cstdio>
#include <cstdint>

#define LAS __attribute__((address_space(3)))
#define GAS __attribute__((address_space(1)))
typedef unsigned short bf16;
typedef short bf16x8 __attribute__((ext_vector_type(8)));
typedef float f32x4 __attribute__((ext_vector_type(4)));
typedef float f32x2 __attribute__((ext_vector_type(2)));
typedef unsigned u32x4 __attribute__((ext_vector_type(4)));
typedef unsigned u32x2 __attribute__((ext_vector_type(2)));
typedef GAS unsigned gu32;

constexpr int BATCH = 16, SEQ = 2048, DM = 1024, MTOK = BATCH * SEQ;
constexpr int HYC = 3072, DSSM = 2048, CONVD = 4096, NHEAD = 32, NGRP = 8, NSTATE = 128, INC = 11328;
constexpr int NE = 64, TOPK = 8, DEXP = 256, NEX = NE + 1;
constexpr float DN_ALPHA = 1.189207115002721f;
constexpr float LN_EPS = 1e-5f, RMS_EPS = 1e-5f, ROUTED_SCALE = 2.5f;
constexpr int NWAVES = 8, NTHR = 512;
constexpr int WIN_ROWS = 11520;

constexpr size_t MiB = 1u << 20;
constexpr size_t WS_CTL = 0, CTL_ZERO_BYTES = 256 * 1024;
constexpr size_t WS_WHYB = 1 * MiB, WS_WSSDB = 3 * MiB, WS_WOUT = 7 * MiB;
constexpr size_t WS_XB = 9 * MiB;
constexpr size_t WS_WINT = 73 * MiB;
constexpr size_t WS_KERN = 96 * MiB;
constexpr size_t WS_PTHY = 112 * MiB;
constexpr size_t WS_YTHY = 304 * MiB;
constexpr size_t WS_YHY = 137 * MiB;
constexpr size_t WS_XBC = 201 * MiB;
constexpr size_t WS_DT = 457 * MiB;
constexpr size_t WS_HALO = 465 * MiB;
constexpr size_t WS_YSSD = 9 * MiB;
constexpr size_t WS_XB2 = 201 * MiB;
constexpr size_t WS_WING = 265 * MiB;
constexpr size_t WS_G = 269 * MiB;
constexpr size_t WS_MIX = 397 * MiB;
constexpr size_t WS_H1 = 177 * MiB;
constexpr size_t WS_EW1 = 9 * MiB;
constexpr size_t WS_EW2 = 477 * MiB;
constexpr size_t WS_YQ = 9 * MiB;
constexpr size_t WS_ASG = 510 * MiB;
constexpr size_t WS_H1B = 113 * MiB;
constexpr size_t WS_HID = 305 * MiB;
constexpr size_t WS_TOK = 461 * MiB;
constexpr size_t WS_WGT = 469 * MiB;
constexpr size_t WS_END = 511 * MiB;
constexpr int CW_BAR = 4096;
constexpr int CW_CNT = 16384;
constexpr int CW_DBG = 32768;

constexpr int LDS_BYTES = 163840;
constexpr int MISC_OFF = 163840 - 512;

#define RLX_AGENT __ATOMIC_RELAXED, __HIP_MEMORY_SCOPE_AGENT
#define LDS_WAIT() asm volatile("s_waitcnt lgkmcnt(0)" ::: "memory")
#define VM_WAIT() asm volatile("s_waitcnt vmcnt(0)" ::: "memory")
typedef __bf16 bf16x2_t __attribute__((ext_vector_type(2)));
__device__ __forceinline__ unsigned pk2(float lo, float hi) { const f32x2 v = {lo, hi}; return __builtin_bit_cast(unsigned, __builtin_convertvector(v, bf16x2_t)); }
__device__ __forceinline__ unsigned f2bf(float f) { return pk2(f, 0.f) & 0xffffu; }
__device__ __forceinline__ float bf2f(unsigned b) { return __builtin_bit_cast(float, b << 16); }
__device__ __forceinline__ float bflo(unsigned w) { return __builtin_bit_cast(float, w << 16); }
__device__ __forceinline__ float bfhi(unsigned w) { return __builtin_bit_cast(float, w & 0xffff0000u); }
__device__ __forceinline__ float sigmoidf_(float v) { return __builtin_amdgcn_rcpf(1.0f + __expf(-v)); }
__device__ __forceinline__ float siluf_(float v) { return v * __builtin_amdgcn_rcpf(1.0f + __expf(-v)); }
__device__ __forceinline__ float wave_sum(float v) {
#pragma unroll
    for (int o = 1; o < 64; o <<= 1) v += __shfl_xor(v, o);
    return v;
}
__device__ __forceinline__ float wave_max(float v) {
#pragma unroll
    for (int o = 1; o < 64; o <<= 1) v = fmaxf(v, __shfl_xor(v, o));
    return v;
}

namespace pg8 {
constexpr int BM = 256, BK = 64, HALF = 128, HTB = HALF * BK * 2, STAGE_BYTES = 8 * HTB, NXCD = 8, WGM = 8;
__host__ __device__ __forceinline__ int lds_byte(int r, int c) { const int st = (r >> 4) * 2 + (c >> 5), rr = r & 15, cc = c & 31, ob = rr * 64 + cc * 2; return st * 1024 + (ob ^ (((ob >> 9) & 1) << 5)); }
__host__ __device__ __forceinline__ void stage_rc(int b, int& R, int& C) { const int st = b / 1024, sb = b % 1024, swz = sb ^ (((sb >> 9) & 1) << 5); R = (st >> 1) * 16 + swz / 64; C = (st & 1) * 32 + (swz % 64) / 2; }
__host__ __device__ __forceinline__ int perm32(int rho) { const int n = rho >> 4, i = rho & 15; return 8 * (i >> 2) + 4 * n + (i & 3); }

struct Unit { int pm, pn; const char* A; const char* B; int e, cnt; };

struct StaticOrder {
    int nM, nN, nwg, G, c, K; const char* A; const char* B;
    __device__ void init(const bf16* A_, const bf16* B_, int M, int N, int K_, int G_, int c_) { A = (const char*)A_; B = (const char*)B_; nM = M / BM; nN = N / BM; nwg = nM * nN; G = G_; c = c_; K = K_; }
    __device__ __forceinline__ bool next(int i, Unit& u) const {
        const long L = (long)i * G + c; if (L >= nwg) return false;
        int wgid = (int)L; { const int q = nwg / NXCD, r = nwg % NXCD, xcd = wgid % NXCD, off = wgid / NXCD; wgid = (xcd < r ? xcd * (q + 1) : r * (q + 1) + (xcd - r) * q) + off; }
        const int nig = WGM * nN, gid = wgid / nig, fm = gid * WGM, gsz = (nM - fm) < WGM ? (nM - fm) : WGM;
        u.pm = fm + ((wgid % nig) % gsz); u.pn = (wgid % nig) / gsz;
        u.A = A + (size_t)u.pm * BM * K * 2; u.B = B + (size_t)u.pn * BM * K * 2; u.e = 0; u.cnt = 0; return true;
    }
    __device__ __forceinline__ unsigned row_off(const Unit&, int) const { return 0u; }
};

__device__ __forceinline__ unsigned cvt_pk_bf16(float lo, float hi) { unsigned r; asm volatile("v_cvt_pk_bf16_f32 %0, %1, %2" : "=v"(r) : "v"(lo), "v"(hi)); return r; }

#ifndef PG8_SP2
#define PG8_SP2 true
#endif
template <class Epi, class Sched, bool GATHER, bool SP2 = PG8_SP2>
__device__ __forceinline__ void gemm_phase(LAS unsigned char* lds, const int K, const Sched& S, const Epi& E) {
    constexpr bool TA = Epi::TA;
    const int tid = threadIdx.x, wid = __builtin_amdgcn_readfirstlane(tid >> 6), lane = tid & 63, wr = wid >> 2, wc = wid & 3, fr = lane & 15, fq = lane >> 4;
    const int nt = K / BK;
    unsigned voffA[2][2], voffB[2]; int RA[2], CA[2];
#pragma unroll
    for (int i = 0; i < 2; ++i) { int R, C; stage_rc(tid * 16 + i * 8192, R, C); const int Rb = Epi::PERM ? ((R & ~31) + perm32(R & 31)) : R;
        RA[i] = R; CA[i] = C; voffA[0][i] = (unsigned)(R * K + C) * 2u; voffA[1][i] = voffA[0][i]; voffB[i] = (unsigned)(Rb * K + C) * 2u; }
    const size_t kstep = (size_t)(BK * 2);
    const size_t hstep = (size_t)HALF * K * 2;
    const size_t hstepA = GATHER ? 0 : hstep;
    const unsigned ldsw = (unsigned)wid * 1024u;
    const int aoff = lds_byte(wr * 64 + fr, fq * 8), boff = lds_byte(wc * 32 + fr, fq * 8);
#define PG8_SA(b, h) (((b) * 2 + (h)) * HTB)
#define PG8_SB(b, h) ((4 + (b) * 2 + (h)) * HTB)
#define PG8_STAGE(bufoff, gbase, voff) do { _Pragma("unroll") for (int _i = 0; _i < 2; ++_i) \
        __builtin_amdgcn_global_load_lds((const unsigned*)((const char*)(gbase) + (voff)[_i]), (LAS unsigned*)(lds + (bufoff) + ldsw + _i * 8192), 16, 0, 0); } while (0)
#define PG8_STAGE_A(bufoff, gbase, h) PG8_STAGE(bufoff, (gbase) + (h) * hstepA, voffA[GATHER ? (h) : 0])
#define PG8_LDA(dst, b, h) do { _Pragma("unroll") for (int m = 0; m < 4; ++m) _Pragma("unroll") for (int k = 0; k < 2; ++k) dst[m][k] = *(const LAS bf16x8*)(lds + PG8_SA(b, h) + aoff + m * 2048 + k * 1024); } while (0)
#define PG8_LDB(dst, b, h) do { _Pragma("unroll") for (int n = 0; n < 2; ++n) _Pragma("unroll") for (int k = 0; k < 2; ++k) dst[n][k] = *(const LAS bf16x8*)(lds + PG8_SB(b, h) + boff + n * 2048 + k * 1024); } while (0)
#define PG8_MMA(ai, bj, At, Bt) do { __builtin_amdgcn_s_setprio(1); _Pragma("unroll") for (int m = 0; m < 4; ++m) _Pragma("unroll") for (int n = 0; n < 2; ++n) _Pragma("unroll") for (int k = 0; k < 2; ++k) \
        acc[ai][bj][m][n] = TA ? __builtin_amdgcn_mfma_f32_16x16x32_bf16(Bt[n][k], At[m][k], acc[ai][bj][m][n], 0, 0, 0) \
                               : __builtin_amdgcn_mfma_f32_16x16x32_bf16(At[m][k], Bt[n][k], acc[ai][bj][m][n], 0, 0, 0); __builtin_amdgcn_s_setprio(0); } while (0)
#define PG8_WAIT_V(n) asm volatile("s_waitcnt vmcnt(" #n ")" ::: "memory")
#define PG8_WAIT_L(n) asm volatile("s_waitcnt lgkmcnt(" #n ")" ::: "memory")
#define PG8_BAR __builtin_amdgcn_s_barrier()
#define PG8_SCHED __builtin_amdgcn_sched_barrier(0)
    Unit cur, nxt; int ui = 0;
    if (!S.next(0, cur)) return;
    if (GATHER) {
#pragma unroll
        for (int h = 0; h < 2; ++h)
#pragma unroll
            for (int i = 0; i < 2; ++i) voffA[h][i] = S.row_off(cur, h * HALF + RA[i]) + (unsigned)CA[i] * 2u;
    }
    f32x4 acc[2][2][4][2];
#pragma unroll
    for (int a = 0; a < 2; ++a)
#pragma unroll
        for (int b = 0; b < 2; ++b)
#pragma unroll
            for (int m = 0; m < 4; ++m)
#pragma unroll
                for (int n = 0; n < 2; ++n) acc[a][b][m][n] = (f32x4){0.f, 0.f, 0.f, 0.f};
    bf16x8 At[4][2], B0[2][2], B1[2][2];
    const char* cA = cur.A; const char* cB = cur.B;
    if constexpr (SP2) {
        PG8_STAGE(PG8_SB(0, 0), cB, voffB); PG8_STAGE(PG8_SB(0, 1), cB + hstep, voffB); PG8_STAGE_A(PG8_SA(0, 0), cA, 0); PG8_STAGE_A(PG8_SA(0, 1), cA, 1);
        if (wr == 1) PG8_BAR;
        PG8_WAIT_V(2); PG8_BAR;
        PG8_STAGE(PG8_SB(1, 0), cB + kstep, voffB); PG8_STAGE_A(PG8_SA(1, 0), cA + kstep, 0); PG8_STAGE(PG8_SB(1, 1), cB + hstep + kstep, voffB);
        PG8_WAIT_V(6); PG8_BAR;
    } else {
    PG8_STAGE(PG8_SB(0, 0), cB, voffB); PG8_STAGE_A(PG8_SA(0, 0), cA, 0); PG8_STAGE(PG8_SB(0, 1), cB + hstep, voffB); PG8_STAGE_A(PG8_SA(0, 1), cA, 1);
    if (wr == 1) PG8_BAR;
    PG8_WAIT_V(4); PG8_BAR;
    PG8_STAGE(PG8_SB(1, 0), cB + kstep, voffB); PG8_STAGE_A(PG8_SA(1, 0), cA + kstep, 0); PG8_STAGE(PG8_SB(1, 1), cB + hstep + kstep, voffB);
    PG8_WAIT_V(6); PG8_BAR;
    }
    for (;;) {
        const bool has_next = S.next(ui + 1, nxt);
        const char* nA = has_next ? nxt.A : cA; const char* nB = has_next ? nxt.B : cB;
        for (int t = 0; t < nt; t += 2) {
            const bool last = (t == nt - 2);
            const char* a1 = cA + (size_t)(t + 1) * kstep;
            const char* a2 = last ? nA : cA + (size_t)(t + 2) * kstep; const char* b2 = last ? nB : cB + (size_t)(t + 2) * kstep;
            const char* a3 = a2 + kstep; const char* b3 = b2 + kstep;
            if constexpr (SP2) {
            PG8_LDB(B0, 0, 0); PG8_LDB(B1, 0, 1); PG8_SCHED; PG8_LDA(At, 0, 0); PG8_STAGE_A(PG8_SA(1, 1), a1, 1);
            PG8_WAIT_V(8); PG8_WAIT_L(0); PG8_BAR; PG8_MMA(0, 0, At, B0); PG8_MMA(0, 1, At, B1); PG8_BAR; PG8_SCHED;
            if (GATHER) { if (last && has_next) {
#pragma unroll
                for (int h = 0; h < 2; ++h)
#pragma unroll
                    for (int i = 0; i < 2; ++i) voffA[h][i] = S.row_off(nxt, h * HALF + RA[i]) + (unsigned)CA[i] * 2u;
            } }
            PG8_LDA(At, 0, 1); PG8_STAGE(PG8_SB(0, 0), b2, voffB); PG8_STAGE(PG8_SB(0, 1), b2 + hstep, voffB); PG8_STAGE_A(PG8_SA(0, 0), a2, 0);
            PG8_WAIT_V(8); PG8_WAIT_L(0); PG8_BAR; PG8_MMA(1, 0, At, B0); PG8_MMA(1, 1, At, B1); PG8_BAR; PG8_SCHED;
            PG8_LDB(B0, 1, 0); PG8_LDB(B1, 1, 1); PG8_SCHED; PG8_LDA(At, 1, 0); PG8_STAGE_A(PG8_SA(0, 1), a2, 1);
            PG8_WAIT_V(8); PG8_WAIT_L(0); PG8_BAR; PG8_MMA(0, 0, At, B0); PG8_MMA(0, 1, At, B1); PG8_BAR; PG8_SCHED;
            PG8_LDA(At, 1, 1); PG8_STAGE(PG8_SB(1, 0), b3, voffB); PG8_STAGE(PG8_SB(1, 1), b3 + hstep, voffB); PG8_STAGE_A(PG8_SA(1, 0), a3, 0);
            PG8_WAIT_V(8); PG8_WAIT_L(0); PG8_BAR; PG8_MMA(1, 0, At, B0); PG8_MMA(1, 1, At, B1); PG8_BAR; PG8_SCHED;
            } else {
            PG8_LDB(B0, 0, 0); PG8_SCHED; PG8_LDA(At, 0, 0); PG8_STAGE_A(PG8_SA(1, 1), a1, 1);
            PG8_WAIT_L(8); PG8_BAR; PG8_WAIT_L(0); PG8_MMA(0, 0, At, B0); PG8_BAR; PG8_SCHED;
            if (GATHER) { if (last && has_next) {
#pragma unroll
                for (int h = 0; h < 2; ++h)
#pragma unroll
                    for (int i = 0; i < 2; ++i) voffA[h][i] = S.row_off(nxt, h * HALF + RA[i]) + (unsigned)CA[i] * 2u;
            } }
            PG8_LDB(B1, 0, 1); PG8_STAGE(PG8_SB(0, 0), b2, voffB);
            PG8_BAR; PG8_WAIT_L(0); PG8_MMA(0, 1, At, B1); PG8_BAR;
            PG8_LDA(At, 0, 1); PG8_STAGE_A(PG8_SA(0, 0), a2, 0);
            PG8_BAR; PG8_WAIT_L(0); PG8_MMA(1, 0, At, B0); PG8_BAR; PG8_SCHED;
            PG8_STAGE(PG8_SB(0, 1), b2 + hstep, voffB);
            PG8_WAIT_V(6); PG8_BAR; PG8_MMA(1, 1, At, B1); PG8_BAR;
            PG8_LDB(B0, 1, 0); PG8_SCHED; PG8_LDA(At, 1, 0); PG8_STAGE_A(PG8_SA(0, 1), a2, 1);
            PG8_WAIT_L(8); PG8_BAR; PG8_WAIT_L(0); PG8_MMA(0, 0, At, B0); PG8_BAR; PG8_SCHED;
            PG8_LDB(B1, 1, 1); PG8_STAGE(PG8_SB(1, 0), b3, voffB);
            PG8_BAR; PG8_WAIT_L(0); PG8_MMA(0, 1, At, B1); PG8_BAR;
            PG8_LDA(At, 1, 1); PG8_STAGE_A(PG8_SA(1, 0), a3, 0);
            PG8_BAR; PG8_WAIT_L(0); PG8_MMA(1, 0, At, B0); PG8_BAR; PG8_SCHED;
            PG8_STAGE(PG8_SB(1, 1), b3 + hstep, voffB);
            PG8_WAIT_V(6); PG8_BAR; PG8_MMA(1, 1, At, B1); PG8_BAR;
                    }
        }
        E(acc, cur, wr, wc, fr, fq);
        if (!has_next) break;
#pragma unroll
        for (int a = 0; a < 2; ++a)
#pragma unroll
            for (int b = 0; b < 2; ++b)
#pragma unroll
                for (int m = 0; m < 4; ++m)
#pragma unroll
                    for (int n = 0; n < 2; ++n) acc[a][b][m][n] = (f32x4){0.f, 0.f, 0.f, 0.f};
        cur = nxt; cA = nA; cB = nB; ++ui;
    }
    PG8_WAIT_V(0);
    if (wr == 0) PG8_BAR;
    PG8_BAR;
#undef PG8_SA
#undef PG8_SB
#undef PG8_STAGE
#undef PG8_STAGE_A
#undef PG8_LDA
#undef PG8_LDB
#undef PG8_MMA
#undef PG8_WAIT_V
#undef PG8_WAIT_L
#undef PG8_BAR
#undef PG8_SCHED
}
}

namespace pg8 {
struct EpiHyT {
    static constexpr bool TA = false, PERM = false;
    bf16* PT; const float* bias;
    __device__ __forceinline__ void operator()(const f32x4 (&acc)[2][2][4][2], const Unit& u, int wr, int wc, int fr, int fq) const {
#pragma unroll
        for (int bj = 0; bj < 2; ++bj)
#pragma unroll
            for (int n = 0; n < 2; ++n) {
                const int col = u.pn * BM + bj * HALF + wc * 32 + n * 16 + fr; const float bv = bias[col];
                bf16* colp = PT + (size_t)col * MTOK + u.pm * BM + wr * 64 + 4 * fq;
#pragma unroll
                for (int ai = 0; ai < 2; ++ai)
#pragma unroll
                    for (int m = 0; m < 4; ++m) { const f32x4 v = acc[ai][bj][m][n] + bv; u32x2 w; w.x = cvt_pk_bf16(v[0], v[1]); w.y = cvt_pk_bf16(v[2], v[3]);
                        *(u32x2*)(colp + ai * HALF + m * 16) = w; }
            }
    }
};
struct EpiZXD {
    static constexpr bool TA = true, PERM = true;
    bf16* Zb; bf16* XBC; float* DT; const float* b_in; bf16* HALO;
    __device__ __forceinline__ void operator()(const f32x4 (&acc)[2][2][4][2], const Unit& u, int wr, int wc, int fr, int fq) const {
        const int row0 = u.pm * BM + wr * 64 + fr;
        if (u.pn == 24) {
            if (wc < 2) {
                const int c0 = wc * 32 + 8 * fq;
#pragma unroll
                for (int n = 0; n < 2; ++n) { const f32x4 bv = *(const f32x4*)(b_in + 9216 + c0 + 4 * n);
#pragma unroll
                    for (int ai = 0; ai < 2; ++ai)
#pragma unroll
                        for (int m = 0; m < 4; ++m) *(f32x4*)(DT + (size_t)(row0 + ai * HALF + m * 16) * 64 + c0 + 4 * n) = acc[ai][0][m][n] + bv; }
            }
            return;
        }
        bf16* base; int ldc, colt, bcol;
        if (u.pn < 8) { base = Zb; ldc = DSSM; colt = u.pn * BM; bcol = 3072 + colt; } else { base = XBC; ldc = CONVD; colt = (u.pn - 8) * BM; bcol = 5120 + colt; }
        const int col0 = colt + wc * 32 + 8 * fq, bcol0 = bcol + wc * 32 + 8 * fq;
        f32x4 bv[2][2];
#pragma unroll
        for (int bj = 0; bj < 2; ++bj)
#pragma unroll
            for (int n = 0; n < 2; ++n) bv[bj][n] = *(const f32x4*)(b_in + bcol0 + bj * HALF + 4 * n);
#pragma unroll
        for (int ai = 0; ai < 2; ++ai)
#pragma unroll
            for (int m = 0; m < 4; ++m) { bf16* rowp = base + (size_t)(row0 + ai * HALF + m * 16) * ldc + col0;
#pragma unroll
                for (int bj = 0; bj < 2; ++bj) { const f32x4 v0 = acc[ai][bj][m][0] + bv[bj][0], v1 = acc[ai][bj][m][1] + bv[bj][1];
                    u32x4 w; w.x = cvt_pk_bf16(v0[0], v0[1]); w.y = cvt_pk_bf16(v0[2], v0[3]); w.z = cvt_pk_bf16(v1[0], v1[1]); w.w = cvt_pk_bf16(v1[2], v1[3]);
                    *(u32x4*)(rowp + bj * HALF) = w;
                    if (u.pn >= 8 && ((m == 3 && fr >= 14) || (m == 0 && fr < 2))) {
                        const int row = row0 + ai * HALF + m * 16, bb = row >> 11, t = row & 2047, tm = t & 63;
                        const int jb = (tm >= 62) ? (t >> 6) + 1 : (t >> 6), idx = (tm >= 62) ? tm - 62 : 2 + tm;
                        *(u32x4*)(HALO + ((size_t)(bb * 33 + jb) * 4 + idx) * CONVD + col0 + bj * HALF) = w; } } }
    }
};
template <int MODE> struct EpiBf {
    static constexpr bool TA = true, PERM = true;
    bf16* O; int ldc; const float* bias; const bf16* G1; int ldg; const bf16* P;
    __device__ __forceinline__ void operator()(const f32x4 (&acc)[2][2][4][2], const Unit& u, int wr, int wc, int fr, int fq) const {
        const int row0 = u.pm * BM + wr * 64 + fr, col0 = u.pn * BM + wc * 32 + 8 * fq;
#pragma unroll
        for (int ai = 0; ai < 2; ++ai)
#pragma unroll
            for (int m = 0; m < 4; ++m) { const size_t r = (size_t)(row0 + ai * HALF + m * 16);
#pragma unroll
                for (int bj = 0; bj < 2; ++bj) { f32x4 v0 = acc[ai][bj][m][0], v1 = acc[ai][bj][m][1]; const int c = col0 + bj * HALF;
                    if (MODE == 0) { const f32x4 b0 = *(const f32x4*)(bias + c), b1 = *(const f32x4*)(bias + c + 4); v0 = v0 + b0; v1 = v1 + b1;
#pragma unroll
                        for (int j = 0; j < 4; ++j) { v0[j] = sigmoidf_(v0[j]); v1[j] = sigmoidf_(v1[j]); } }
                    else { const u32x4 g = *(const u32x4*)(G1 + r * ldg + c);
                        v0[0] *= bflo(g.x); v0[1] *= bfhi(g.x); v0[2] *= bflo(g.y); v0[3] *= bfhi(g.y); v1[0] *= bflo(g.z); v1[1] *= bfhi(g.z); v1[2] *= bflo(g.w); v1[3] *= bfhi(g.w);
                        if (MODE == 2) { const u32x4 p = *(const u32x4*)(P + r * ldc + c);
                            v0[0] += bflo(p.x); v0[1] += bfhi(p.x); v0[2] += bflo(p.y); v0[3] += bfhi(p.y); v1[0] += bflo(p.z); v1[1] += bfhi(p.z); v1[2] += bflo(p.w); v1[3] += bfhi(p.w); } }
                    u32x4 w; w.x = cvt_pk_bf16(v0[0], v0[1]); w.y = cvt_pk_bf16(v0[2], v0[3]); w.z = cvt_pk_bf16(v1[0], v1[1]); w.w = cvt_pk_bf16(v1[2], v1[3]);
                    *(u32x4*)(O + r * ldc + c) = w; } }
    }
};
struct EpiRes {
    static constexpr bool TA = true, PERM = false;
    float* O; const float* bias; const float* X; float alpha;
    __device__ __forceinline__ void operator()(const f32x4 (&acc)[2][2][4][2], const Unit& u, int wr, int wc, int fr, int fq) const {
        const int row0 = u.pm * BM + wr * 64 + fr, col0 = u.pn * BM + wc * 32 + 4 * fq;
#pragma unroll
        for (int ai = 0; ai < 2; ++ai)
#pragma unroll
            for (int m = 0; m < 4; ++m) { const size_t off = (size_t)(row0 + ai * HALF + m * 16) * DM + col0;
#pragma unroll
                for (int bj = 0; bj < 2; ++bj)
#pragma unroll
                    for (int n = 0; n < 2; ++n) { const f32x4 xv = *(const f32x4*)(X + off + bj * HALF + n * 16), bv = *(const f32x4*)(bias + col0 + bj * HALF + n * 16);
                        *(f32x4*)(O + off + bj * HALF + n * 16) = acc[ai][bj][m][n] + bv + alpha * xv; } }
    }
};
struct EpiSwiGLU {
    static constexpr bool TA = true, PERM = true;
    bf16* HID;
    __device__ __forceinline__ void operator()(const f32x4 (&acc)[2][2][4][2], const Unit& u, int wr, int wc, int fr, int fq) const {
        const int row0 = u.pm * BM + wr * 64 + fr, col0 = u.pn * HALF + wc * 32 + 8 * fq;
#pragma unroll
        for (int ai = 0; ai < 2; ++ai)
#pragma unroll
            for (int m = 0; m < 4; ++m) { f32x4 v0, v1;
#pragma unroll
                for (int j = 0; j < 4; ++j) { v0[j] = siluf_(acc[ai][0][m][0][j]) * acc[ai][1][m][0][j]; v1[j] = siluf_(acc[ai][0][m][1][j]) * acc[ai][1][m][1][j]; }
                u32x4 w; w.x = cvt_pk_bf16(v0[0], v0[1]); w.y = cvt_pk_bf16(v0[2], v0[3]); w.z = cvt_pk_bf16(v1[0], v1[1]); w.w = cvt_pk_bf16(v1[2], v1[3]);
                *(u32x4*)(HID + (size_t)(row0 + ai * HALF + m * 16) * DEXP + col0) = w; }
    }
};
struct EpiScatter {
    static constexpr bool TA = false, PERM = false;
    float* ACC; const int* tok; const float* wgt; int j0_unused;
    __device__ __forceinline__ void operator()(const f32x4 (&acc)[2][2][4][2], const Unit& u, int wr, int wc, int fr, int fq) const {
        asm volatile("" : "+v"(fr), "+v"(fq));
        const int jt = u.pn >> 2, ct = u.pn & 3;
#pragma unroll
        for (int ai = 0; ai < 2; ++ai)
#pragma unroll
            for (int m = 0; m < 4; ++m)
#pragma unroll
                for (int j = 0; j < 4; ++j) { const int r = ai * HALF + wr * 64 + m * 16 + 4 * fq + j;
                    if (r < u.cnt) { int token; float w;
                        if (u.e == NE) { token = jt * BM + r; w = 1.0f; } else { const size_t li = (size_t)u.e * MTOK + (size_t)jt * BM + r; token = tok[li]; w = wgt[li]; }
                        float* rowp = ACC + (size_t)token * DM + ct * BM + wc * 32 + fr;
#pragma unroll
                        for (int bj = 0; bj < 2; ++bj)
#pragma unroll
                            for (int n = 0; n < 2; ++n) unsafeAtomicAdd(rowp + bj * HALF + n * 16, w * acc[ai][bj][m][n][j]);
                    }
                    asm volatile("" ::: "memory"); }
    }
};

struct EpiSlot8 {
    static constexpr bool TA = true, PERM = true;
    unsigned char* YQ;
    __device__ __forceinline__ void operator()(const f32x4 (&acc)[2][2][4][2], const Unit& u, int wr, int wc, int fr, int fq) const {
        const int row0 = u.pm * BM + wr * 64 + fr, col0 = (u.pn & 1) * 256 + wc * 32 + 8 * fq;
#pragma unroll
        for (int ai = 0; ai < 2; ++ai)
#pragma unroll
            for (int m = 0; m < 4; ++m) { unsigned char* rowp = YQ + (size_t)(row0 + ai * HALF + m * 16) * 512 + col0;
#pragma unroll
                for (int bj = 0; bj < 2; ++bj) { const f32x4 v0 = acc[ai][bj][m][0], v1 = acc[ai][bj][m][1];
                    int w0 = __builtin_amdgcn_cvt_pk_fp8_f32(v0[0], v0[1], 0, false); w0 = __builtin_amdgcn_cvt_pk_fp8_f32(v0[2], v0[3], w0, true);
                    int w1 = __builtin_amdgcn_cvt_pk_fp8_f32(v1[0], v1[1], 0, false); w1 = __builtin_amdgcn_cvt_pk_fp8_f32(v1[2], v1[3], w1, true);
                    u32x2 w; w.x = (unsigned)w0; w.y = (unsigned)w1; *(u32x2*)(rowp + bj * HALF) = w; } }
    }
};
struct SlotOrder2 {
    const LAS int* tp; int G, c, total, pass; const char* A; const char* W;
    __device__ __forceinline__ bool next(int i, Unit& u) const {
        const long L = (long)i * G + c; if (L >= 2l * total) return false;
        const int tile = (int)(L >> 1), q = 2 * pass + (int)(L & 1); int e = 0;
#pragma unroll 1
        for (int s = 64; s >= 1; s >>= 1) if (e + s <= NE && tp[e + s] <= tile) e += s;
        u.e = e; u.cnt = 0; u.pm = tile; u.pn = q; u.A = A + (size_t)tile * BM * DEXP * 2; u.B = W + ((size_t)e * DM + (size_t)q * 256) * DEXP * 2;
        return true;
    }
    __device__ __forceinline__ unsigned row_off(const Unit&, int) const { return 0u; }
};
template <int NCT, bool FIRST> struct MoeOrder {
    const LAS int* tp; const LAS int* cnt; int G, c, total;
    const char* A; const char* W; const int* tok;
    __device__ __forceinline__ bool next(int i, Unit& u) const {
        const long L = (long)i * G + c; if (L >= (long)total * NCT) return false;
        const int tile = (int)(L / NCT), ct = (int)(L % NCT);
        int e = 0;
#pragma unroll 1
        for (int s = 64; s >= 1; s >>= 1) if (e + s <= NE && tp[e + s] <= tile) e += s;
        const int jt = tile - tp[e];
        u.e = e; const int left = cnt[e] - jt * BM; u.cnt = left < BM ? left : BM;
        if (FIRST) { u.pm = tile; u.pn = ct; u.A = A; u.B = W + ((size_t)e * 512 + (size_t)ct * 256) * DM * 2; }
        else { u.pm = tile; u.pn = jt * 4 + ct; u.A = A + (size_t)tile * BM * DEXP * 2; u.B = W + ((size_t)e * DM + (size_t)ct * 256) * DEXP * 2; }
        return true;
    }
    __device__ __forceinline__ unsigned row_off(const Unit& u, int r) const {
        const int jt = u.pm - tp[u.e]; int token;
        if (u.e == NE) token = jt * BM + r; else token = (r < u.cnt) ? tok[(size_t)u.e * MTOK + (size_t)jt * BM + r] : 0;
        return (unsigned)token * (unsigned)(DM * 2);
    }
};
}

#define XB_TMO      128
#define XB_XCNT(j)  (256  + 64 * (j))
#define XB_XSUB(j)  (1280 + 64 * (j))
#define XB_XGEN(j)  (2304 + 64 * (j))
#define XB_TOP      3328
#define XB_TOPGEN   3392
#define XCD_BAR_WORDS 3456
#define XB_SPIN_CAP (1u << 18)
__device__ __forceinline__ unsigned xb_ld(unsigned* p)              { return __hip_atomic_load(p, __ATOMIC_RELAXED, __HIP_MEMORY_SCOPE_AGENT); }
__device__ __forceinline__ unsigned xb_add(unsigned* p, unsigned v) { return __hip_atomic_fetch_add(p, v, __ATOMIC_RELAXED, __HIP_MEMORY_SCOPE_AGENT); }
__device__ __forceinline__ unsigned xb_xcc_id() { return (unsigned)__builtin_amdgcn_s_getreg((3 << 11) | 20) & 0xFu; }
#define XB_SPIN(cond, bar) do { unsigned _sp = 0; while (cond) { __builtin_amdgcn_s_sleep(1); \
    if ((++_sp & 255u) == 0u) { if (xb_ld(&(bar)[XB_TMO])) break; if (_sp > XB_SPIN_CAP) { atomicAdd(&(bar)[XB_TMO], 1u); break; } } } } while (0)
struct XcdBarrier { unsigned* bar; unsigned x; volatile LAS unsigned* st; };
__device__ __forceinline__ XcdBarrier xcd_barrier_post(unsigned* bar, volatile LAS unsigned* st) {
    XcdBarrier b; b.bar = bar; b.x = xb_xcc_id(); b.st = st;
    if (threadIdx.x == 0) (void)xb_add(&bar[XB_XCNT(b.x)], 1u);
    return b;
}
__device__ __forceinline__ void xcd_barrier_complete(unsigned* bar, unsigned x, unsigned& nloc, unsigned& nx) {
    const unsigned G = gridDim.x * gridDim.y * gridDim.z;
    unsigned sum, cnt, mine, sp = 0u;
    for (;;) {
        sum = 0u; cnt = 0u; mine = 0u;
#pragma unroll
        for (unsigned j = 0; j < 16; ++j) { const unsigned c = xb_ld(&bar[XB_XCNT(j)]); sum += c; cnt += (c > 0u) ? 1u : 0u; mine = (j == x) ? c : mine; }
        if (sum == G) break;
        __builtin_amdgcn_s_sleep(1);
        if ((++sp & 255u) == 0u) { if (xb_ld(&bar[XB_TMO])) break; if (sp > XB_SPIN_CAP) { atomicAdd(&bar[XB_TMO], 1u); break; } }
    }
    nloc = mine > 0u ? mine : 1u; nx = cnt > 0u ? cnt : 1u;
}
__device__ __forceinline__ void xcd_barrier(const XcdBarrier& b) {
    asm volatile("s_waitcnt vmcnt(0)" ::: "memory");
    __syncthreads();
    if (threadIdx.x == 0) {
        unsigned* bar = b.bar;
        __builtin_amdgcn_s_waitcnt(0);
        unsigned nloc = b.st[0], nx = b.st[1];
        if (nloc == 0u) { xcd_barrier_complete(bar, b.x, nloc, nx); b.st[0] = nloc; b.st[1] = nx; }
        const unsigned old = xb_add(&bar[XB_XSUB(b.x)], 1u);
        const unsigned gen = old / nloc;
        if (old + 1u == (gen + 1u) * nloc) {
            __builtin_amdgcn_fence(__ATOMIC_RELEASE, "agent");
            asm volatile("s_waitcnt vmcnt(0)" ::: "memory");
            const unsigned og = xb_add(&bar[XB_TOP], 1u);
            const unsigned tg = og / nx;
            if (og + 1u == (tg + 1u) * nx) xb_add(&bar[XB_TOPGEN], 1u);
            else XB_SPIN(xb_ld(&bar[XB_TOPGEN]) == tg, bar);
            __builtin_amdgcn_fence(__ATOMIC_ACQUIRE, "agent");
            xb_add(&bar[XB_XGEN(b.x)], 1u);
            asm volatile("s_waitcnt vmcnt(0)" ::: "memory");
        } else {
            XB_SPIN(xb_ld(&bar[XB_XGEN(b.x)]) == gen, bar);
            __builtin_amdgcn_fence(__ATOMIC_ACQUIRE, "agent");
            asm volatile("s_waitcnt vmcnt(0)" ::: "memory");
        }
    }
    __syncthreads();
}

struct Args {
    const float* in[38]; float* out; unsigned char* ws; int ph_lo, ph_hi, li, pad;
};
enum { I_X = 0, I_WIN, I_BIN, I_HCW, I_HCB, I_FW1, I_FB1, I_FF1, I_FW2, I_FB2, I_FF2, I_FW3, I_FB3, I_FF3, I_FW4, I_HBIAS,
       I_SCW, I_SCB, I_DTB, I_ALOG, I_SD, I_SNW, I_WHYB, I_WSSDB, I_WOUT, I_BOUT, I_LN1G, I_LN1B, I_RW, I_RB, I_EWG, I_EWU, I_EWD, I_SWG, I_SWU, I_SWD, I_LN2G, I_LN2B };
struct Frame {
    LAS unsigned char* lds; volatile LAS unsigned* MISC; gu32* ctl; unsigned char* ws;
    int tid, lane, wave, vcu, G;
    const float* const* in; float* out;
};

__device__ __forceinline__ void tr_item(const float* src, int ld_src, int k0, int c0, bf16* dst, int drow0, int ldd, LAS float* scr, int lane) {
#pragma unroll 8
    for (int i = 0; i < 32; ++i) { const int kk = 2 * i + (lane >> 5); scr[kk * 33 + (lane & 31)] = src[(size_t)(k0 + kk) * ld_src + c0 + (lane & 31)]; }
    LDS_WAIT(); asm volatile("" ::: "memory");
    const int c = lane & 7;
#pragma unroll
    for (int j = 0; j < 4; ++j) { const int n = (lane >> 3) + 8 * j; const LAS float* s = scr + (8 * c) * 33 + n;
        u32x4 o; o.x = pk2(s[0 * 33], s[1 * 33]); o.y = pk2(s[2 * 33], s[3 * 33]); o.z = pk2(s[4 * 33], s[5 * 33]); o.w = pk2(s[6 * 33], s[7 * 33]);
        *(u32x4*)(dst + (size_t)(drow0 + n) * ldd + k0 + 8 * c) = o; }
    LDS_WAIT(); asm volatile("" ::: "memory");
}
__device__ __forceinline__ void tr_matrix_item(const float* src, int ld_src, int K, int col_first, int ncols, bf16* dst, int drow_first, LAS float* scr, int it, int lane) {
    const int nblk = ncols / 32, kb = it / nblk, nb = it % nblk;
    tr_item(src, ld_src, kb * 64, col_first + nb * 32, dst, drow_first + nb * 32, K, scr, lane);
}
__device__ __forceinline__ void convert_x(Frame& F, const float* x, bf16* xb) {
    const size_t n8 = (size_t)MTOK * DM / 8; const size_t stride = (size_t)F.G * NTHR;
    for (size_t i = (size_t)F.vcu * NTHR + F.tid; i < n8; i += stride) {
        const f32x4 a = *(const f32x4*)(x + i * 8), b = *(const f32x4*)(x + i * 8 + 4);
        u32x4 o; o.x = pk2(a[0], a[1]); o.y = pk2(a[2], a[3]); o.z = pk2(b[0], b[1]); o.w = pk2(b[2], b[3]);
        *(u32x4*)(xb + i * 8) = o; }
}

__device__ __forceinline__ void hyena_filter(Frame& F) {
    const float* w1 = F.in[I_FW1]; const float* b1 = F.in[I_FB1]; const float* f1 = F.in[I_FF1];
    const float* w2 = F.in[I_FW2]; const float* b2 = F.in[I_FB2]; const float* f2 = F.in[I_FF2];
    const float* w3 = F.in[I_FW3]; const float* b3 = F.in[I_FB3]; const float* f3 = F.in[I_FF3];
    const float* w4 = F.in[I_FW4];
    bf16* KERN = (bf16*)(F.ws + WS_KERN);
    LAS float* hbuf = (LAS float*)(F.lds);
    const int lane = F.lane, wave = F.wave;
    for (int pg = F.vcu; pg < SEQ / 8; pg += F.G) {
        const int t = 8 * pg + wave;
        const float tn = (float)t / (float)(SEQ - 1), wv = 6.283185307179586f * (float)t / (float)SEQ;
        float zf = 0.f;
        if (lane == 0) zf = tn;
        else if (lane <= 16) { const float f = 1e-4f + (float)(lane - 1) * ((15.0f - 1e-4f) / 15.0f); zf = cosf(f * wv); }
        else if (lane <= 32) { const float f = 1e-4f + (float)(lane - 17) * ((15.0f - 1e-4f) / 15.0f); zf = -sinf(f * wv); }
        float s = b1[lane];
        for (int i = 0; i < 33; ++i) s += __shfl(zf, i) * w1[i * 64 + lane];
        float h = sinf(f1[lane] * s);
        s = b2[lane];
        for (int i = 0; i < 64; ++i) s += __shfl(h, i) * w2[i * 64 + lane];
        h = sinf(f2[lane] * s);
        s = b3[lane];
        for (int i = 0; i < 64; ++i) s += __shfl(h, i) * w3[i * 64 + lane];
        h = sinf(f3[lane] * s);
        hbuf[wave * 64 + lane] = h;
        __syncthreads();
        for (int q = 0; q < 8; ++q) {
            const int col = F.tid + 512 * q, c = col & 1023, dir = (col >> 10) & 1, o = col >> 11;
            float a[8];
#pragma unroll
            for (int p = 0; p < 8; ++p) a[p] = 0.f;
            float a0b = 0.f;
            for (int i = 0; i < 64; ++i) { const float w = w4[(size_t)i * 4096 + col];
#pragma unroll
                for (int p = 0; p < 8; ++p) a[p] += hbuf[p * 64 + i] * w;
                if (pg == 0 && dir == 0) a0b += hbuf[i] * w4[(size_t)i * 4096 + col + 1024]; }
            const float adel = 3.0701134573253945f + (float)c * ((15.350567286626973f - 3.0701134573253945f) / 1023.0f);
            bf16* kc = KERN + ((size_t)c * 2 + o) * 4096;
#pragma unroll
            for (int p = 0; p < 8; ++p) { const int tp = 8 * pg + p; const float v = a[p] * __expf(-((float)tp / (float)(SEQ - 1)) * adel);
                if (tp == 0) { if (dir == 0) { kc[2048] = (bf16)f2bf(v + a0b); kc[0] = 0; } }
                else kc[dir == 0 ? 2048 - tp : 2048 + tp] = (bf16)f2bf(v); }
        }
        __syncthreads();
    }
}

__device__ __forceinline__ void p0_prologue(Frame& F) {
    LAS float* scr = (LAS float*)(F.lds + 4096 + F.wave * 16384);
    const int gw = F.vcu * NWAVES + F.wave, NGW = F.G * NWAVES;
    hyena_filter(F);
    bf16* WINT = (bf16*)(F.ws + WS_WINT);
    constexpr int I_A = 16 * (9216 / 32), I_B = 16 * (64 / 32), I_C = 16 * (2048 / 32);
    constexpr int I_HY = 16 * 32, I_SS = 32 * 32, I_OUT = 16 * 32;
    constexpr int NITEMS = I_A + I_B + I_C + I_HY + I_SS + I_OUT;
    for (int it = gw; it < NITEMS; it += NGW) {
        int r = it;
        if (r < I_A) { tr_matrix_item(F.in[I_WIN], INC, DM, 0, 9216, WINT, 0, scr, r, F.lane); continue; } r -= I_A;
        if (r < I_B) { tr_matrix_item(F.in[I_WIN], INC, DM, 9216, 64, WINT, 9216, scr, r, F.lane); continue; } r -= I_B;
        if (r < I_C) { tr_matrix_item(F.in[I_WIN], INC, DM, 9280, 2048, WINT, 9472, scr, r, F.lane); continue; } r -= I_C;
        if (r < I_HY) { tr_matrix_item(F.in[I_WHYB], DM, DM, 0, DM, (bf16*)(F.ws + WS_WHYB), 0, scr, r, F.lane); continue; } r -= I_HY;
        if (r < I_SS) { tr_matrix_item(F.in[I_WSSDB], DM, DSSM, 0, DM, (bf16*)(F.ws + WS_WSSDB), 0, scr, r, F.lane); continue; } r -= I_SS;
        tr_matrix_item(F.in[I_WOUT], DM, DM, 0, DM, (bf16*)(F.ws + WS_WOUT), 0, scr, r, F.lane);
    }
    convert_x(F, F.in[I_X], (bf16*)(F.ws + WS_XB));
}
__device__ __forceinline__ void p6_reconvert(Frame& F) {
    LAS float* scr = (LAS float*)(F.lds + 4096 + F.wave * 16384);
    const int gw = F.vcu * NWAVES + F.wave, NGW = F.G * NWAVES;
    for (int it = gw; it < 16 * (2048 / 32); it += NGW) tr_matrix_item(F.in[I_WIN], INC, DM, 9280, 2048, (bf16*)(F.ws + WS_WING), 0, scr, it, F.lane);
    convert_x(F, F.in[I_X], (bf16*)(F.ws + WS_XB2));
}
__device__ __forceinline__ void p10_expert_weights(Frame& F) {
    LAS float* scr = (LAS float*)(F.lds + 4096 + F.wave * 16384);
    const int gw = F.vcu * NWAVES + F.wave, NGW = F.G * NWAVES;
    bf16* EW1 = (bf16*)(F.ws + WS_EW1); bf16* EW2 = (bf16*)(F.ws + WS_EW2);
    constexpr int PER1 = 16 * 4;
    constexpr int N1 = NEX * 2 * 2 * PER1, PER2 = 4 * 32, N2 = NEX * PER2;
    for (int it = gw; it < N1 + N2; it += NGW) {
        if (it < N1) { const int e = it / (4 * PER1), r0 = it % (4 * PER1), mat = r0 / (2 * PER1), r1 = r0 % (2 * PER1), ct = r1 / PER1, r2 = r1 % PER1;
            const float* src = (e < NE) ? F.in[mat ? I_EWU : I_EWG] + (size_t)e * DM * DEXP : F.in[mat ? I_SWU : I_SWG];
            tr_matrix_item(src, DEXP, DM, 128 * ct, 128, EW1 + (size_t)e * 512 * DM, 256 * ct + 128 * mat, scr, r2, F.lane); }
        else { const int r = it - N1, e = r / PER2, r2 = r % PER2;
            const float* src = (e < NE) ? F.in[I_EWD] + (size_t)e * DEXP * DM : F.in[I_SWD];
            tr_matrix_item(src, DM, DEXP, 0, DM, EW2 + (size_t)e * DM * DEXP, 0, scr, r2, F.lane); }
    }
}
__device__ __forceinline__ void p3_transpose(Frame& F) {
    const bf16* YT = (const bf16*)(F.ws + WS_YTHY); bf16* Y = (bf16*)(F.ws + WS_YHY);
    LAS bf16* scr = (LAS bf16*)(F.lds + F.wave * 9216);
    const int gw = F.vcu * NWAVES + F.wave, NGW = F.G * NWAVES, lane = F.lane;
    for (int tile = gw; tile < 16 * 512; tile += NGW) {
        const int c0 = (tile & 15) * 64, t0 = (tile >> 4) * 64;
#pragma unroll
        for (int p = 0; p < 8; ++p) { const int c = p * 8 + (lane >> 3), ch = lane & 7;
            const u32x4 g = *(const u32x4*)(YT + (size_t)(c0 + c) * MTOK + t0 + ch * 8);
            LAS bf16* d = scr + (ch * 8) * 72 + c;
            d[0 * 72] = (bf16)(g.x & 0xffff); d[1 * 72] = (bf16)(g.x >> 16); d[2 * 72] = (bf16)(g.y & 0xffff); d[3 * 72] = (bf16)(g.y >> 16);
            d[4 * 72] = (bf16)(g.z & 0xffff); d[5 * 72] = (bf16)(g.z >> 16); d[6 * 72] = (bf16)(g.w & 0xffff); d[7 * 72] = (bf16)(g.w >> 16); }
        LDS_WAIT(); asm volatile("" ::: "memory");
#pragma unroll
        for (int p = 0; p < 8; ++p) { const int tk = p * 8 + (lane >> 3), ch = lane & 7;
            const u32x4 v = *(const LAS u32x4*)(scr + tk * 72 + ch * 8);
            *(u32x4*)(Y + (size_t)(t0 + tk) * DM + c0 + ch * 8) = v; }
        LDS_WAIT(); asm volatile("" ::: "memory");
    }
}

constexpr int HY_LDU = 2064, HY_KCS = 4128, HY_U_BYTES = 16 * HY_LDU * 2, HY_KC_BYTES = 8 * HY_KCS * 2;

__device__ __forceinline__ void hy_build_kc(LAS bf16* KC, const bf16* kern, int tid) {
    const u32x4 cur = *(const u32x4*)(kern + 8 * tid);
    u32x4 prv = {0u, 0u, 0u, 0u};
    if (tid > 0) prv = *(const u32x4*)(kern + 8 * tid - 8);
    const unsigned E[9] = {prv.x, prv.y, prv.z, prv.w, cur.x, cur.y, cur.z, cur.w, 0u};
#pragma unroll
    for (int fl = 0; fl < 8; ++fl) { const int sft = 8 - fl, k = sft >> 1;
        u32x4 o;
        if (sft & 1) { o.x = __builtin_amdgcn_alignbit(E[k + 1], E[k], 16); o.y = __builtin_amdgcn_alignbit(E[k + 2], E[k + 1], 16);
                       o.z = __builtin_amdgcn_alignbit(E[k + 3], E[k + 2], 16); o.w = __builtin_amdgcn_alignbit(E[k + 4], E[k + 3], 16); }
        else { o.x = E[k]; o.y = E[k + 1]; o.z = E[k + 2]; o.w = E[k + 3]; }
        *(LAS u32x4*)(KC + fl * HY_KCS + 8 * tid) = o; }
}
__device__ __forceinline__ f32x4 hy_short4(const bf16* prow, int t0, float w0, float w1, float w2, float cb) {
    const u32x2 g = *(const u32x2*)(prow + t0);
    const float p0 = bflo(g.x), p1 = bfhi(g.x), p2 = bflo(g.y), p3 = bfhi(g.y);
    const float pm = (t0 > 0) ? bf2f(prow[t0 - 1]) : 0.f, pp = (t0 + 4 < SEQ) ? bf2f(prow[t0 + 4]) : 0.f;
    f32x4 r; r[0] = cb + w0 * pm + w1 * p0 + w2 * p1; r[1] = cb + w0 * p0 + w1 * p1 + w2 * p2; r[2] = cb + w0 * p1 + w1 * p2 + w2 * p3; r[3] = cb + w0 * p2 + w1 * p3 + w2 * pp;
    return r;
}
__device__ __forceinline__ f32x4 hy_conv4(const u32x2 g, float pm, float pp, float w0, float w1, float w2, float cb) {
    const float p0 = bflo(g.x), p1 = bfhi(g.x), p2 = bflo(g.y), p3 = bfhi(g.y);
    f32x4 r; r[0] = cb + w0 * pm + w1 * p0 + w2 * p1; r[1] = cb + w0 * p0 + w1 * p1 + w2 * p2; r[2] = cb + w0 * p1 + w1 * p2 + w2 * p3; r[3] = cb + w0 * p2 + w1 * p3 + w2 * pp;
    return r;
}
__device__ __forceinline__ void hyena_phase(Frame& F) {
    LAS bf16* U = (LAS bf16*)(F.lds); LAS bf16* KC = (LAS bf16*)(F.lds + HY_U_BYTES);
    const bf16* PT = (const bf16*)(F.ws + WS_PTHY); const bf16* KERN = (const bf16*)(F.ws + WS_KERN); bf16* YT = (bf16*)(F.ws + WS_YTHY);
    const float* cw = F.in[I_HCW]; const float* cbv = F.in[I_HCB]; const float* hb = F.in[I_HBIAS];
    const int tid = F.tid, lane = F.lane, w = F.wave, fr = lane & 15, fq = lane >> 4;
    for (int c = F.vcu; c < DM; c += F.G) {
        hy_build_kc(KC, KERN + ((size_t)c * 2 + 0) * 4096, tid);
        { const int vc = 2048 + c; const float w0 = cw[0 * HYC + vc], w1 = cw[1 * HYC + vc], w2 = cw[2 * HYC + vc], cb = cbv[vc];
          const bf16* prow = PT + (size_t)vc * MTOK;
          u32x4 um[8]; unsigned short upm[8], upp[8];
#pragma unroll
          for (int it = 0; it < 8; ++it) { const int idx = tid + 512 * it, b = idx >> 8, t8 = (idx & 255) * 8; const bf16* pr = prow + (size_t)b * SEQ;
              um[it] = *(const u32x4*)(pr + t8); upm[it] = pr[t8 > 0 ? t8 - 1 : 0]; upp[it] = pr[t8 + 8 < SEQ ? t8 + 8 : SEQ - 1]; }
#pragma unroll
          for (int it = 0; it < 8; ++it) { const int idx = tid + 512 * it, b = idx >> 8, t8 = (idx & 255) * 8;
              const float pm = t8 > 0 ? bf2f(upm[it]) : 0.f, pp = t8 + 8 < SEQ ? bf2f(upp[it]) : 0.f;
              u32x2 g0; g0.x = um[it].x; g0.y = um[it].y; u32x2 g1v; g1v.x = um[it].z; g1v.y = um[it].w;
              const f32x4 lo = hy_conv4(g0, pm, bflo(um[it].z), w0, w1, w2, cb), hi = hy_conv4(g1v, bfhi(um[it].y), pp, w0, w1, w2, cb);
              u32x4 o; o.x = pk2(lo[0], lo[1]); o.y = pk2(lo[2], lo[3]); o.z = pk2(hi[0], hi[1]); o.w = pk2(hi[2], hi[3]);
              *(LAS u32x4*)(U + b * HY_LDU + t8) = o; } }
        __syncthreads();
#pragma unroll 1
        for (int o = 0; o < 2; ++o) {
            f32x4 acc[16];
#pragma unroll
            for (int i = 0; i < 16; ++i) acc[i] = (f32x4){0.f, 0.f, 0.f, 0.f};
            const LAS bf16* kbase = KC + (fr & 7) * HY_KCS + 2048 + 8 * fq - 8 * (fr >> 3) - 256 * w;
            const LAS bf16* ubase = U + fr * HY_LDU + 8 * fq;
            bf16x8 win[16];
#pragma unroll
            for (int i = 0; i < 16; ++i) win[i] = *(const LAS bf16x8*)(kbase - 16 * i);
            bf16x8 bnx = *(const LAS bf16x8*)(ubase);
#pragma unroll 1
            for (int sj8 = 0; sj8 < 64; sj8 += 8) {
#pragma unroll
                for (int u = 0; u < 8; ++u) { const int sj = sj8 + u;
                    const bf16x8 bfr = bnx;
                    bnx = *(const LAS bf16x8*)(ubase + 32 * ((sj + 1) & 63));
#pragma unroll
                    for (int t2 = 2; t2 < 18; ++t2) { const int tt = t2 & 15;
                        acc[tt] = __builtin_amdgcn_mfma_f32_16x16x32_bf16(win[(tt - 2 * u) & 15], bfr, acc[tt], 0, 0, 0); }
                    win[(14 - 2 * u) & 15] = *(const LAS bf16x8*)(kbase + 16 * (2 * sj + 2));
                    win[(15 - 2 * u) & 15] = *(const LAS bf16x8*)(kbase + 16 * (2 * sj + 1));
                } }
            const float hbias = hb[o * DM + c];
            const int gc = (o == 0) ? c : 1024 + c;
            const float w0 = cw[0 * HYC + gc], w1 = cw[1 * HYC + gc], w2 = cw[2 * HYC + gc], cb = cbv[gc];
            const bf16* grow = PT + (size_t)gc * MTOK + (size_t)fr * SEQ;
            u32x2 zpk[16], gm[16]; unsigned short gpm[16], gpp[16];
#pragma unroll
            for (int tt = 0; tt < 16; ++tt) { const int t0 = 256 * w + 16 * tt + 4 * fq;
                gm[tt] = *(const u32x2*)(grow + t0); gpm[tt] = grow[t0 > 0 ? t0 - 1 : 0]; gpp[tt] = grow[t0 + 4 < SEQ ? t0 + 4 : SEQ - 1]; }
#pragma unroll
            for (int tt = 0; tt < 16; ++tt) { const int t0 = 256 * w + 16 * tt + 4 * fq;
                const u32x2 uu = *(const LAS u32x2*)(U + fr * HY_LDU + t0);
                const f32x4 g = hy_conv4(gm[tt], t0 > 0 ? bf2f(gpm[tt]) : 0.f, t0 + 4 < SEQ ? bf2f(gpp[tt]) : 0.f, w0, w1, w2, cb);
                f32x4 y = acc[tt]; y[0] = g[0] * (y[0] + bflo(uu.x) * hbias); y[1] = g[1] * (y[1] + bfhi(uu.x) * hbias); y[2] = g[2] * (y[2] + bflo(uu.y) * hbias); y[3] = g[3] * (y[3] + bfhi(uu.y) * hbias);
                zpk[tt].x = pk2(y[0], y[1]); zpk[tt].y = pk2(y[2], y[3]); }
            __syncthreads();
            if (o == 0) {
#pragma unroll
                for (int tt = 0; tt < 16; ++tt) *(LAS u32x2*)(U + fr * HY_LDU + 256 * w + 16 * tt + 4 * fq) = zpk[tt];
                hy_build_kc(KC, KERN + ((size_t)c * 2 + 1) * 4096, tid);
                __syncthreads();
            } else {
                bf16* yrow = YT + (size_t)c * MTOK + (size_t)fr * SEQ + 256 * w + 4 * fq;
#pragma unroll
                for (int tt = 0; tt < 16; ++tt) *(u32x2*)(yrow + 16 * tt) = zpk[tt];
            }
        }
    }
}

__device__ __forceinline__ void ssd_conv_phase(Frame& F) {
    bf16* XBC = (bf16*)(F.ws + WS_XBC); const bf16* HALO = (const bf16*)(F.ws + WS_HALO);
    const float* scw = F.in[I_SCW]; const float* scb = F.in[I_SCB];
    const int gw = F.vcu * NWAVES + F.wave, NGW = F.G * NWAVES, lane = F.lane;
    for (int item = gw; item < BATCH * 32 * 8; item += NGW) {
        const int cb8 = item & 7, seg = (item >> 3) & 31, b = item >> 8, col = cb8 * 512 + lane * 8;
        float wk[5][8], cbv[8];
#pragma unroll
        for (int k = 0; k < 5; ++k) { const f32x4 a = *(const f32x4*)(scw + k * CONVD + col), c = *(const f32x4*)(scw + k * CONVD + col + 4);
#pragma unroll
            for (int e = 0; e < 4; ++e) { wk[k][e] = a[e]; wk[k][4 + e] = c[e]; } }
        { const f32x4 a = *(const f32x4*)(scb + col), c = *(const f32x4*)(scb + col + 4);
#pragma unroll
          for (int e = 0; e < 4; ++e) { cbv[e] = a[e]; cbv[4 + e] = c[e]; } }
        bf16* xrow0 = XBC + ((size_t)b * SEQ + seg * 64) * CONVD + col;
        const bf16* hlo = HALO + ((size_t)(b * 33 + seg) * 4) * CONVD + col;
        const bf16* hhi = HALO + ((size_t)(b * 33 + seg + 1) * 4 + 2) * CONVD + col;
        const u32x4 zero4 = {0u, 0u, 0u, 0u};
        u32x4 W[12];
        W[0] = seg > 0 ? *(const u32x4*)(hlo) : zero4; W[1] = seg > 0 ? *(const u32x4*)(hlo + CONVD) : zero4;
        W[2] = *(const u32x4*)(xrow0); W[3] = *(const u32x4*)(xrow0 + CONVD);
#pragma unroll 1
        for (int blk = 0; blk < 8; ++blk) { const int r0 = 8 * blk;
#pragma unroll
            for (int i = 4; i < 12; ++i) { const int rr = r0 - 2 + i;
                if (rr < 64) W[i] = *(const u32x4*)(xrow0 + (size_t)rr * CONVD);
                else W[i] = (seg < 31) ? *(const u32x4*)(hhi + (size_t)(rr - 64) * CONVD) : zero4; }
#pragma unroll
            for (int o = 0; o < 8; ++o) { float v[8];
#pragma unroll
                for (int e = 0; e < 8; ++e) v[e] = cbv[e];
#pragma unroll
                for (int k = 0; k < 5; ++k) { const u32x4 p = W[o + k];
                    v[0] += wk[k][0] * bflo(p.x); v[1] += wk[k][1] * bfhi(p.x); v[2] += wk[k][2] * bflo(p.y); v[3] += wk[k][3] * bfhi(p.y);
                    v[4] += wk[k][4] * bflo(p.z); v[5] += wk[k][5] * bfhi(p.z); v[6] += wk[k][6] * bflo(p.w); v[7] += wk[k][7] * bfhi(p.w); }
#pragma unroll
                for (int e = 0; e < 8; ++e) v[e] = siluf_(v[e]);
                u32x4 ov; ov.x = pk2(v[0], v[1]); ov.y = pk2(v[2], v[3]); ov.z = pk2(v[4], v[5]); ov.w = pk2(v[6], v[7]);
                *(u32x4*)(xrow0 + (size_t)(r0 + o) * CONVD) = ov; }
#pragma unroll
            for (int i = 0; i < 4; ++i) W[i] = W[8 + i];
        }
    }
}

constexpr int SS_LDC = 144, SS_LDT = 80;
constexpr int SS_C = 0, SS_B = 18432, SS_BT = 36864, SS_M = 57344, SS_XD = 77824, SS_XE = 98304, SS_SB = 118784, SS_ACS = 155648, SS_DTV = 156672, SS_TOE = 157696, SS_END = 158720;
static_assert(SS_END <= MISC_OFF, "SSD LDS map");

template <int KS>
__device__ __forceinline__ f32x4 mma16(const LAS bf16* arow, const LAS bf16* brow, f32x4 acc) {
    bf16x8 a[KS], b[KS];
#pragma unroll
    for (int kk = 0; kk < KS; ++kk) { a[kk] = *(const LAS bf16x8*)(arow + 32 * kk); b[kk] = *(const LAS bf16x8*)(brow + 32 * kk); }
#pragma unroll
    for (int kk = 0; kk < KS; ++kk) acc = __builtin_amdgcn_mfma_f32_16x16x32_bf16(a[kk], b[kk], acc, 0, 0, 0);
    return acc;
}

__device__ __forceinline__ void ssd_phase(Frame& F) {
    LAS unsigned char* L = F.lds;
    LAS bf16* Cl = (LAS bf16*)(L + SS_C); LAS bf16* Bl = (LAS bf16*)(L + SS_B); LAS bf16* BT = (LAS bf16*)(L + SS_BT); LAS bf16* Ml = (LAS bf16*)(L + SS_M);
    LAS bf16* XD = (LAS bf16*)(L + SS_XD); LAS bf16* XE = (LAS bf16*)(L + SS_XE); LAS bf16* SB = (LAS bf16*)(L + SS_SB);
    LAS float* ACS = (LAS float*)(L + SS_ACS); LAS float* DTV = (LAS float*)(L + SS_DTV); LAS float* TOE = (LAS float*)(L + SS_TOE);
    const bf16* XBC = (const bf16*)(F.ws + WS_XBC); const float* DT = (const float*)(F.ws + WS_DT); const bf16* Zb = (const bf16*)F.out; bf16* YS = (bf16*)(F.ws + WS_YSSD);
    const float* dtb = F.in[I_DTB]; const float* alog = F.in[I_ALOG]; const float* sd = F.in[I_SD];
    const int tid = F.tid, lane = F.lane, w = F.wave, fr = lane & 15, fq = lane >> 4;
    for (int unit = F.vcu; unit < BATCH * NGRP * 2; unit += F.G) {
        const int b = unit >> 4, g = (unit >> 1) & 7, hp = unit & 1, h0 = 4 * g + 2 * hp;
#pragma unroll 1
        for (int dir = 0; dir < 2; ++dir) {
            const float dtbias = (w < 2) ? dtb[dir * 32 + h0 + w] : 0.f, aexp = (w < 2) ? __expf(alog[dir * 32 + h0 + w]) : 0.f;
            auto scan = [&](int buf, float raw) {
                raw += dtbias; const float dtv = raw > 20.f ? raw : log1pf(__expf(raw)); float a = -dtv * aexp;
#pragma unroll
                for (int o = 1; o < 64; o <<= 1) { const float v = __shfl_up(a, o); if (lane >= o) a += v; }
                const float tot = __shfl(a, 63); const int ix = (buf * 2 + w) * 64 + lane;
                ACS[ix] = a; DTV[ix] = dtv; TOE[ix] = __expf(tot - a); };
            auto dtload = [&](int ci) -> float { const int ch = dir ? 31 - ci : ci, r = dir ? 63 - lane : lane;
                return DT[((size_t)b * SEQ + 64 * ch + r) * 64 + dir * 32 + h0 + w]; };
            auto rowload = [&](int ci, int it, int tl) -> u32x4 { const int cg = (tl >> 6) + 8 * it, l = tl & 63, ch = dir ? 31 - ci : ci, r = dir ? 63 - l : l, lc0 = cg * 8;
                const int col = lc0 < 128 ? 64 * h0 + lc0 : (lc0 < 256 ? 2048 + 128 * g + (lc0 - 128) : 3072 + 128 * g + (lc0 - 256));
                return *(const u32x4*)(XBC + ((size_t)b * SEQ + 64 * ch + r) * CONVD + col); };
            f32x4 Sacc[8];
#pragma unroll
            for (int i = 0; i < 8; ++i) Sacc[i] = (f32x4){0.f, 0.f, 0.f, 0.f};
            const float dsk = sd[h0 + (w >> 2)];
            __syncthreads();
            for (int i = tid; i < 2 * 64 * SS_LDC / 2; i += NTHR) ((LAS unsigned*)SB)[i] = 0u;
            float dtn = 0.f;
            if (w < 2) { scan(0, dtload(0)); dtn = dtload(1); }
            u32x4 pf[6];
#pragma unroll
            for (int it = 0; it < 6; ++it) pf[it] = rowload(0, it, tid);
            __syncthreads();
#pragma unroll 1
            for (int ci = 0; ci < 32; ++ci) {
                const int ch = dir ? 31 - ci : ci, buf = ci & 1;
                const size_t tokbase = (size_t)b * SEQ + 64 * ch;
                int tl = tid; asm volatile("" : "+v"(tl));
                const LAS float* acs = ACS + buf * 128; const LAS float* dtv = DTV + buf * 128; const LAS float* toe = TOE + buf * 128;
#pragma unroll
                for (int it = 0; it < 6; ++it) { const int cg = (tl >> 6) + 8 * it, l = tl & 63; const u32x4 p = pf[it];
                    if (it < 2) { const int hh = cg >> 3, p0 = (cg & 7) * 8; const float d = dtv[hh * 64 + l], de = d * toe[hh * 64 + l];
                        const float v[8] = {bflo(p.x), bfhi(p.x), bflo(p.y), bfhi(p.y), bflo(p.z), bfhi(p.z), bflo(p.w), bfhi(p.w)};
#pragma unroll
                        for (int e = 0; e < 8; ++e) { XD[(hh * 64 + p0 + e) * SS_LDT + l] = (bf16)f2bf(v[e] * d); XE[(hh * 64 + p0 + e) * SS_LDT + l] = (bf16)f2bf(v[e] * de); } }
                    else if (it < 4) { const int n0 = (cg - 16) * 8; *(LAS u32x4*)(Bl + l * SS_LDC + n0) = p;
                        LAS bf16* d = BT + n0 * SS_LDT + l;
                        d[0 * SS_LDT] = (bf16)(p.x & 0xffff); d[1 * SS_LDT] = (bf16)(p.x >> 16); d[2 * SS_LDT] = (bf16)(p.y & 0xffff); d[3 * SS_LDT] = (bf16)(p.y >> 16);
                        d[4 * SS_LDT] = (bf16)(p.z & 0xffff); d[5 * SS_LDT] = (bf16)(p.z >> 16); d[6 * SS_LDT] = (bf16)(p.w & 0xffff); d[7 * SS_LDT] = (bf16)(p.w >> 16); }
                    else { const int n0 = (cg - 32) * 8; *(LAS u32x4*)(Cl + l * SS_LDC + n0) = p; } }
                if (ci + 1 < 32) {
#pragma unroll
                    for (int it = 0; it < 6; ++it) pf[it] = rowload(ci + 1, it, tl); }
                __syncthreads();
                const int hh = w >> 2, li = w & 3, lrow = 16 * li + fr;
                const int rloc = dir ? 63 - lrow : lrow; const size_t tok = tokbase + rloc;
                u32x2 pv[4], zv[4];
                if (dir) {
#pragma unroll
                    for (int pi = 0; pi < 4; ++pi) { const size_t o = tok * DSSM + 64 * (h0 + hh) + 16 * pi + 4 * fq; pv[pi] = *(const u32x2*)(YS + o); zv[pi] = *(const u32x2*)(Zb + o); } }
#pragma unroll
                for (int q = 0; q < 2; ++q) { const int id = 2 * w + q, si = id >> 2, lj = id & 3, l = 16 * lj + fr, s0 = 16 * si + 4 * fq;
                    u32x2 m0 = {0u, 0u}, m1 = {0u, 0u};
                    if (si <= lj) { f32x4 cb = (f32x4){0.f, 0.f, 0.f, 0.f};
                        cb = mma16<4>(Bl + (16 * si + fr) * SS_LDC + 8 * fq, Cl + (16 * lj + fr) * SS_LDC + 8 * fq, cb);
                        const float a0 = acs[l], a1 = acs[64 + l]; float x0[4], x1[4];
#pragma unroll
                        for (int j = 0; j < 4; ++j) { const int s = s0 + j; x0[j] = (s <= l) ? cb[j] * __expf(a0 - acs[s]) : 0.f; x1[j] = (s <= l) ? cb[j] * __expf(a1 - acs[64 + s]) : 0.f; }
                        m0.x = pk2(x0[0], x0[1]); m0.y = pk2(x0[2], x0[3]); m1.x = pk2(x1[0], x1[1]); m1.y = pk2(x1[2], x1[3]); }
                    *(LAS u32x2*)(Ml + (0 * 64 + l) * SS_LDT + s0) = m0; *(LAS u32x2*)(Ml + (1 * 64 + l) * SS_LDT + s0) = m1; }
                f32x4 Y[4];
                { bf16x8 cfr[4];
#pragma unroll
                  for (int kk = 0; kk < 4; ++kk) cfr[kk] = *(const LAS bf16x8*)(Cl + lrow * SS_LDC + 8 * fq + 32 * kk);
#pragma unroll
                  for (int pi = 0; pi < 4; ++pi) { Y[pi] = (f32x4){0.f, 0.f, 0.f, 0.f}; const LAS bf16* ar = SB + (hh * 64 + 16 * pi + fr) * SS_LDC + 8 * fq;
#pragma unroll
                      for (int kk = 0; kk < 4; ++kk) Y[pi] = __builtin_amdgcn_mfma_f32_16x16x32_bf16(*(const LAS bf16x8*)(ar + 32 * kk), cfr[kk], Y[pi], 0, 0, 0); } }
                __syncthreads();
                { const float el = __expf(acs[hh * 64 + lrow]);
                  const float dinv = __builtin_amdgcn_rcpf(dtv[hh * 64 + lrow]);
                  const bf16x8 mf0 = *(const LAS bf16x8*)(Ml + (hh * 64 + lrow) * SS_LDT + 8 * fq), mf1 = *(const LAS bf16x8*)(Ml + (hh * 64 + lrow) * SS_LDT + 8 * fq + 32);
#pragma unroll
                  for (int pi = 0; pi < 4; ++pi) { Y[pi] = Y[pi] * el; const LAS bf16* ar = XD + (hh * 64 + 16 * pi + fr) * SS_LDT + 8 * fq;
                      Y[pi] = __builtin_amdgcn_mfma_f32_16x16x32_bf16(*(const LAS bf16x8*)(ar), mf0, Y[pi], 0, 0, 0);
                      Y[pi] = __builtin_amdgcn_mfma_f32_16x16x32_bf16(*(const LAS bf16x8*)(ar + 32), mf1, Y[pi], 0, 0, 0);
                      const int p0 = 16 * pi + 4 * fq; bf16* yp = YS + tok * DSSM + 64 * (h0 + hh) + p0; f32x4 y = Y[pi];
                      if (dir == 0) {
#pragma unroll
                          for (int j = 0; j < 4; ++j) y[j] += dsk * dinv * bf2f(XD[(hh * 64 + p0 + j) * SS_LDT + lrow]);
                      } else { const u32x2 pvv = pv[pi], zvv = zv[pi];
                          y[0] = (y[0] + bflo(pvv.x)) * siluf_(bflo(zvv.x)); y[1] = (y[1] + bfhi(pvv.x)) * siluf_(bfhi(zvv.x)); y[2] = (y[2] + bflo(pvv.y)) * siluf_(bflo(zvv.y)); y[3] = (y[3] + bfhi(pvv.y)) * siluf_(bfhi(zvv.y)); }
                      u32x2 o; o.x = pk2(y[0], y[1]); o.y = pk2(y[2], y[3]); *(u32x2*)yp = o; } }
                { const int pi = w & 3; const float dec = __expf(acs[hh * 64 + 63]);
                  const bf16x8 xf0 = *(const LAS bf16x8*)(XE + (hh * 64 + 16 * pi + fr) * SS_LDT + 8 * fq), xf1 = *(const LAS bf16x8*)(XE + (hh * 64 + 16 * pi + fr) * SS_LDT + 8 * fq + 32);
#pragma unroll
                  for (int ni = 0; ni < 8; ++ni) { Sacc[ni] = Sacc[ni] * dec; const LAS bf16* ar = BT + (16 * ni + fr) * SS_LDT + 8 * fq;
                      Sacc[ni] = __builtin_amdgcn_mfma_f32_16x16x32_bf16(*(const LAS bf16x8*)(ar), xf0, Sacc[ni], 0, 0, 0);
                      Sacc[ni] = __builtin_amdgcn_mfma_f32_16x16x32_bf16(*(const LAS bf16x8*)(ar + 32), xf1, Sacc[ni], 0, 0, 0);
                      u32x2 o; o.x = pk2(Sacc[ni][0], Sacc[ni][1]); o.y = pk2(Sacc[ni][2], Sacc[ni][3]);
                      *(LAS u32x2*)(SB + (hh * 64 + 16 * pi + fr) * SS_LDC + 16 * ni + 4 * fq) = o; } }
                if (w < 2 && ci + 1 < 32) { scan(buf ^ 1, dtn); if (ci + 2 < 32) dtn = dtload(ci + 2); }
                __syncthreads();
            }
        }
    }
}

__device__ __forceinline__ void ssd_norm_phase(Frame& F) {
    bf16* YS = (bf16*)(F.ws + WS_YSSD); const float* nw = F.in[I_SNW];
    const int gw = F.vcu * NWAVES + F.wave, NGW = F.G * NWAVES, lane = F.lane;
    for (int m = gw; m < MTOK; m += NGW) { bf16* row = YS + (size_t)m * DSSM + lane * 32;
        u32x4 v[4]; float ss = 0.f;
#pragma unroll
        for (int j = 0; j < 4; ++j) { v[j] = *(const u32x4*)(row + 8 * j);
            const float a0 = bflo(v[j].x), a1 = bfhi(v[j].x), a2 = bflo(v[j].y), a3 = bfhi(v[j].y), a4 = bflo(v[j].z), a5 = bfhi(v[j].z), a6 = bflo(v[j].w), a7 = bfhi(v[j].w);
            ss += (a0 * a0 + a1 * a1) + (a2 * a2 + a3 * a3) + (a4 * a4 + a5 * a5) + (a6 * a6 + a7 * a7); }
        ss += __shfl_xor(ss, 1); ss += __shfl_xor(ss, 2); ss += __shfl_xor(ss, 4);
        const float rs = 1.0f / sqrtf(ss * (1.0f / 256.0f) + RMS_EPS);
#pragma unroll
        for (int j = 0; j < 4; ++j) { const f32x4 w0 = *(const f32x4*)(nw + lane * 32 + 8 * j), w1 = *(const f32x4*)(nw + lane * 32 + 8 * j + 4);
            u32x4 o; o.x = pk2(bflo(v[j].x) * rs * w0[0], bfhi(v[j].x) * rs * w0[1]); o.y = pk2(bflo(v[j].y) * rs * w0[2], bfhi(v[j].y) * rs * w0[3]);
            o.z = pk2(bflo(v[j].z) * rs * w1[0], bfhi(v[j].z) * rs * w1[1]); o.w = pk2(bflo(v[j].w) * rs * w1[2], bfhi(v[j].w) * rs * w1[3]);
            *(u32x4*)(row + 8 * j) = o; } }
}

constexpr int RT_WC = 131072;
__device__ __forceinline__ void ln1_router_phase(Frame& F) {
    float* H1 = (float*)(F.ws + WS_H1); bf16* H1B = (bf16*)(F.ws + WS_H1B);
    int* TOK = (int*)(F.ws + WS_TOK); float* WGT = (float*)(F.ws + WS_WGT); int* ASG = (int*)(F.ws + WS_ASG);
    const float* g1 = F.in[I_LN1G]; const float* b1 = F.in[I_LN1B]; const float* rw = F.in[I_RW]; const float* rb = F.in[I_RB];
    LAS float* hrow = (LAS float*)(F.lds + F.wave * 16384);
    LAS float* wc = (LAS float*)(F.lds + RT_WC);
    const int lane = F.lane, tid = F.tid;
    f32x4 gv[4], bv[4];
#pragma unroll
    for (int j = 0; j < 4; ++j) { gv[j] = *(const f32x4*)(g1 + 4 * lane + 256 * j); bv[j] = *(const f32x4*)(b1 + 4 * lane + 256 * j); }
    const float rbias = rb[lane];
    for (int step = F.vcu; step < MTOK / 32; step += F.G) {
        const int rg = step * 8 + F.wave;
        f32x4 nx0 = *(const f32x4*)(rw + tid * 4), nx1 = *(const f32x4*)(rw + 2048 + tid * 4);
#pragma unroll 1
        for (int r = 0; r < 4; ++r) { const size_t m = (size_t)rg * 4 + r; float* xr = H1 + m * DM;
            f32x4 v[4]; float s = 0.f;
#pragma unroll
            for (int j = 0; j < 4; ++j) { v[j] = *(const f32x4*)(xr + 4 * lane + 256 * j); s += (v[j][0] + v[j][1]) + (v[j][2] + v[j][3]); }
            const float mean = wave_sum(s) * (1.f / DM); float s2 = 0.f;
#pragma unroll
            for (int j = 0; j < 4; ++j) { v[j] = v[j] - mean; s2 += (v[j][0] * v[j][0] + v[j][1] * v[j][1]) + (v[j][2] * v[j][2] + v[j][3] * v[j][3]); }
            const float rstd = 1.f / sqrtf(wave_sum(s2) * (1.f / DM) + LN_EPS);
#pragma unroll
            for (int j = 0; j < 4; ++j) { const f32x4 h = v[j] * rstd * gv[j] + bv[j];
                *(f32x4*)(xr + 4 * lane + 256 * j) = h * DN_ALPHA;
                u32x2 o; o.x = pk2(h[0], h[1]); o.y = pk2(h[2], h[3]); *(u32x2*)(H1B + m * DM + 4 * lane + 256 * j) = o;
                *(LAS f32x4*)(hrow + r * 1024 + 4 * lane + 256 * j) = h; } }
        float lg[4] = {0.f, 0.f, 0.f, 0.f};
#pragma unroll 1
        for (int kc = 0; kc < 16; ++kc) {
            __syncthreads();
            *(LAS f32x4*)(wc + tid * 4) = nx0; *(LAS f32x4*)(wc + 2048 + tid * 4) = nx1;
            if (kc + 1 < 16) { nx0 = *(const f32x4*)(rw + (kc + 1) * 4096 + tid * 4); nx1 = *(const f32x4*)(rw + (kc + 1) * 4096 + 2048 + tid * 4); }
            __syncthreads();
#pragma unroll 4
            for (int kk = 0; kk < 64; kk += 4) {
                const float w0 = wc[(kk + 0) * 64 + lane], w1 = wc[(kk + 1) * 64 + lane], w2 = wc[(kk + 2) * 64 + lane], w3 = wc[(kk + 3) * 64 + lane];
#pragma unroll
                for (int r = 0; r < 4; ++r) { const f32x4 h = *(const LAS f32x4*)(hrow + r * 1024 + kc * 64 + kk); lg[r] += h[0] * w0 + h[1] * w1 + h[2] * w2 + h[3] * w3; } }
        }
#pragma unroll 1
        for (int r = 0; r < 4; ++r) { const int m = rg * 4 + r;
            const float score = 1.0f / (1.0f + expf(-lg[r])), biased = score + rbias;
            float m1 = biased; m1 = fmaxf(m1, __shfl_xor(m1, 1)); m1 = fmaxf(m1, __shfl_xor(m1, 2)); m1 = fmaxf(m1, __shfl_xor(m1, 4));
            const unsigned long long eq = __ballot(biased == m1); const int gbase = lane & ~7; const int first = gbase + __ffs((unsigned)((eq >> gbase) & 0xffull)) - 1;
            float v2 = (lane == first) ? -INFINITY : biased; v2 = fmaxf(v2, __shfl_xor(v2, 1)); v2 = fmaxf(v2, __shfl_xor(v2, 2)); v2 = fmaxf(v2, __shfl_xor(v2, 4));
            const float gs = m1 + v2; const int g = lane >> 3; int better = 0;
#pragma unroll
            for (int d = 1; d < 8; ++d) { const int g2 = (g + d) & 7; const float og = __shfl(gs, g2 * 8); better += (og > gs || (og == gs && g2 < g)) ? 1 : 0; }
            float masked = (better < 4) ? biased : -INFINITY; bool sel = false;
#pragma unroll 1
            for (int it = 0; it < TOPK; ++it) { const float mx = wave_max(masked); const unsigned long long bm = __ballot(masked == mx); const int win = __ffsll((long long)bm) - 1;
                if (lane == win) { sel = true; masked = -INFINITY; } }
            const float sw = wave_sum(sel ? score : 0.f);
            const unsigned long long selm = __ballot(sel);
            if (sel) { const unsigned pos = __hip_atomic_fetch_add((unsigned*)(F.ctl + CW_CNT + 64 * lane), 1u, __ATOMIC_RELAXED, __HIP_MEMORY_SCOPE_AGENT);
                TOK[(size_t)lane * MTOK + pos] = m; WGT[(size_t)lane * MTOK + pos] = score / sw * ROUTED_SCALE;
                ASG[(size_t)m * 8 + __popcll(selm & ((1ull << lane) - 1ull))] = lane * MTOK + (int)pos; } }
    }
}
constexpr int MOE_TP = 131072 + 1024, MOE_CNT = MOE_TP + 512;
__device__ __forceinline__ int moe_table(Frame& F) {
    LAS int* tp = (LAS int*)(F.lds + MOE_TP); LAS int* cnt = (LAS int*)(F.lds + MOE_CNT);
    __syncthreads();
    if (F.tid == 0) { int run = 0;
        for (int e = 0; e < NEX; ++e) { const int c = (e < NE) ? (int)__hip_atomic_load((unsigned*)(F.ctl + CW_CNT + 64 * e), __ATOMIC_RELAXED, __HIP_MEMORY_SCOPE_AGENT) : MTOK;
            cnt[e] = c; tp[e] = run; run += (c + 255) >> 8; }
        tp[NEX] = run; }
    __syncthreads();
    return tp[NEX];
}
__device__ __forceinline__ void fp8x8_fma(f32x4& a0, f32x4& a1, const u32x2 v, const float w) {
    const f32x2 p0 = __builtin_amdgcn_cvt_pk_f32_fp8((int)v.x, false), p1 = __builtin_amdgcn_cvt_pk_f32_fp8((int)v.x, true);
    const f32x2 p2 = __builtin_amdgcn_cvt_pk_f32_fp8((int)v.y, false), p3 = __builtin_amdgcn_cvt_pk_f32_fp8((int)v.y, true);
    a0[0] += w * p0.x; a0[1] += w * p0.y; a0[2] += w * p1.x; a0[3] += w * p1.y; a1[0] += w * p2.x; a1[1] += w * p2.y; a1[2] += w * p3.x; a1[3] += w * p3.y;
}
template <bool LAST>
__device__ __forceinline__ void moe_combine_phase(Frame& F, int p) {
    float* H1 = (float*)(F.ws + WS_H1); const unsigned char* YQ = (const unsigned char*)(F.ws + WS_YQ); const int* ASG = (const int*)(F.ws + WS_ASG); const float* WGT = (const float*)(F.ws + WS_WGT);
    const LAS int* tp = (const LAS int*)(F.lds + MOE_TP);
    const float* g2 = F.in[I_LN2G]; const float* b2 = F.in[I_LN2B];
    const int gw = F.vcu * NWAVES + F.wave, NGW = F.G * NWAVES, lane = F.lane;
    const size_t shbase = (size_t)tp[NE] * 256;
    for (int m = gw; m < MTOK; m += NGW) {
        int li = 0; if (lane < 8) li = ASG[(size_t)m * 8 + lane];
        float wk = 0.f; if (lane < 8) wk = WGT[li];
        const int e = li >> 15, pos = li & 32767; const int slot = 256 * tp[e] + pos;
        float* hp = H1 + (size_t)m * DM + 512 * p + 8 * lane;
        f32x4 a0 = *(const f32x4*)hp, a1 = *(const f32x4*)(hp + 4);
        u32x2 vv[9];
        vv[8] = *(const u32x2*)(YQ + (shbase + m) * 512 + 8 * lane);
#pragma unroll
        for (int k = 0; k < 8; ++k) { const int sk = __shfl(slot, k); vv[k] = *(const u32x2*)(YQ + (size_t)sk * 512 + 8 * lane); }
        fp8x8_fma(a0, a1, vv[8], 1.0f);
#pragma unroll
        for (int k = 0; k < 8; ++k) fp8x8_fma(a0, a1, vv[k], __shfl(wk, k));
        if (!LAST) { *(f32x4*)hp = a0; *(f32x4*)(hp + 4) = a1; }
        else { const float* xr = H1 + (size_t)m * DM + 8 * lane; f32x4 v[4]; float s = 0.f;
            v[0] = *(const f32x4*)xr; v[1] = *(const f32x4*)(xr + 4); v[2] = a0; v[3] = a1;
#pragma unroll
            for (int j = 0; j < 4; ++j) s += (v[j][0] + v[j][1]) + (v[j][2] + v[j][3]);
            const float mean = wave_sum(s) * (1.f / DM); float s2 = 0.f;
#pragma unroll
            for (int j = 0; j < 4; ++j) { v[j] = v[j] - mean; s2 += (v[j][0] * v[j][0] + v[j][1] * v[j][1]) + (v[j][2] * v[j][2] + v[j][3] * v[j][3]); }
            const float rstd = 1.f / sqrtf(wave_sum(s2) * (1.f / DM) + LN_EPS);
#pragma unroll
            for (int j = 0; j < 4; ++j) { const int c = (j >> 1) * 512 + 8 * lane + 4 * (j & 1); const f32x4 gv = *(const f32x4*)(g2 + c), bv = *(const f32x4*)(b2 + c);
                *(f32x4*)(F.out + (size_t)m * DM + c) = v[j] * rstd * gv + bv; } }
    }
}
__device__ __forceinline__ void ln2_phase(Frame& F) {
    const float* H1 = (const float*)(F.ws + WS_H1); const float* g2 = F.in[I_LN2G]; const float* b2 = F.in[I_LN2B];
    const int gw = F.vcu * NWAVES + F.wave, NGW = F.G * NWAVES, lane = F.lane;
    f32x4 gv[4], bv[4];
#pragma unroll
    for (int j = 0; j < 4; ++j) { gv[j] = *(const f32x4*)(g2 + 4 * lane + 256 * j); bv[j] = *(const f32x4*)(b2 + 4 * lane + 256 * j); }
    for (int m = gw; m < MTOK; m += NGW) { const float* xr = H1 + (size_t)m * DM;
        f32x4 v[4]; float s = 0.f;
#pragma unroll
        for (int j = 0; j < 4; ++j) { v[j] = *(const f32x4*)(xr + 4 * lane + 256 * j); s += (v[j][0] + v[j][1]) + (v[j][2] + v[j][3]); }
        const float mean = wave_sum(s) * (1.f / DM); float s2 = 0.f;
#pragma unroll
        for (int j = 0; j < 4; ++j) { v[j] = v[j] - mean; s2 += (v[j][0] * v[j][0] + v[j][1] * v[j][1]) + (v[j][2] * v[j][2] + v[j][3] * v[j][3]); }
        const float rstd = 1.f / sqrtf(wave_sum(s2) * (1.f / DM) + LN_EPS);
#pragma unroll
        for (int j = 0; j < 4; ++j) *(f32x4*)(F.out + (size_t)m * DM + 4 * lane + 256 * j) = v[j] * rstd * gv[j] + bv[j]; }
}

#ifndef MK_N_LAUNCHES
#define MK_N_LAUNCHES 1
#endif
constexpr int NPH = 15;
constexpr int N_LAUNCHES = MK_N_LAUNCHES;

__global__ void __launch_bounds__(NTHR, 2) fwd_kernel(Args args) {
    extern __shared__ __attribute__((aligned(16))) unsigned char lds_raw[];
    Frame F;
    F.lds = (LAS unsigned char*)lds_raw;
    F.MISC = (volatile LAS unsigned*)(F.lds + MISC_OFF);
    F.tid = threadIdx.x; F.lane = F.tid & 63; F.wave = __builtin_amdgcn_readfirstlane(F.tid >> 6);
    F.G = gridDim.x; { const int bx = blockIdx.x; F.vcu = (F.G % 8 == 0) ? (bx % 8) * (F.G / 8) + bx / 8 : bx; }
    F.ws = args.ws; F.ctl = (gu32*)(args.ws + WS_CTL); F.in = args.in; F.out = args.out;
    for (int u = F.tid; u < (LDS_BYTES - MISC_OFF) / 4; u += NTHR) ((LAS unsigned*)(F.lds + MISC_OFF))[u] = 0u;
    __syncthreads();
    XcdBarrier bar; bar.bar = (unsigned*)(F.ctl + CW_BAR); bar.x = 0; bar.st = nullptr;
    if (N_LAUNCHES != NPH) bar = xcd_barrier_post((unsigned*)(F.ctl + CW_BAR), F.MISC + 8);
    const int lo = args.ph_lo, hi = args.ph_hi;
#ifndef PH_MASK
#define PH_MASK 0x7fff
#endif
#define IN(k) ((((PH_MASK) >> (k)) & 1) && lo <= (k) && (k) < hi)
#define SEAM(k) do { if (IN(k) && IN((k) + 1)) xcd_barrier(bar); } while (0)
#ifndef REP_MASK
#define REP_MASK 0
#endif
#define REPS(k) for (int rep_ = 0; rep_ < ((((REP_MASK) >> (k)) & 1) ? 2 : 1); ++rep_, ((((REP_MASK) >> (k)) & 1) && rep_ == 1 ? xcd_barrier(bar) : (void)0))
    const int G = F.G, bx = (int)blockIdx.x;

    if (IN(0)) REPS(0) { p0_prologue(F); } SEAM(0);
    if (IN(1)) REPS(1) {
        pg8::StaticOrder S; S.init((const bf16*)(F.ws + WS_XB), (const bf16*)(F.ws + WS_WINT), MTOK, HYC, DM, G, bx);
        pg8::EpiHyT E{(bf16*)(F.ws + WS_PTHY), F.in[I_BIN]};
        pg8::gemm_phase<pg8::EpiHyT, pg8::StaticOrder, false>(F.lds, DM, S, E);
    } SEAM(1);
    if (IN(2)) REPS(2) { hyena_phase(F); } SEAM(2);
    if (IN(3)) REPS(3) { p3_transpose(F); } SEAM(3);
    if (IN(4)) REPS(4) {
        pg8::StaticOrder S; S.init((const bf16*)(F.ws + WS_XB), (const bf16*)(F.ws + WS_WINT) + (size_t)3072 * DM, MTOK, 6400, DM, G, bx);
        pg8::EpiZXD E{(bf16*)F.out, (bf16*)(F.ws + WS_XBC), (float*)(F.ws + WS_DT), F.in[I_BIN], (bf16*)(F.ws + WS_HALO)};
        pg8::gemm_phase<pg8::EpiZXD, pg8::StaticOrder, false>(F.lds, DM, S, E);
    } SEAM(4);
    if (IN(5)) REPS(5) { ssd_conv_phase(F); } SEAM(5);
    if (IN(6)) REPS(6) { ssd_phase(F); } SEAM(6);
    if (IN(7)) REPS(7) { ssd_norm_phase(F); p6_reconvert(F); } SEAM(7);
    if (IN(8)) REPS(8) {
        pg8::StaticOrder S; S.init((const bf16*)(F.ws + WS_XB2), (const bf16*)(F.ws + WS_WING), MTOK, 2048, DM, G, bx);
        pg8::EpiBf<0> E{(bf16*)(F.ws + WS_G), 2048, F.in[I_BIN] + 9280, nullptr, 0, nullptr};
        pg8::gemm_phase<pg8::EpiBf<0>, pg8::StaticOrder, false>(F.lds, DM, S, E);
    } SEAM(8);
    if (IN(9)) REPS(9) {
        pg8::StaticOrder S; S.init((const bf16*)(F.ws + WS_YHY), (const bf16*)(F.ws + WS_WHYB), MTOK, DM, DM, G, bx);
        pg8::EpiBf<1> E{(bf16*)(F.ws + WS_MIX), DM, nullptr, (const bf16*)(F.ws + WS_G), 2048, nullptr};
        pg8::gemm_phase<pg8::EpiBf<1>, pg8::StaticOrder, false>(F.lds, DM, S, E);
    } SEAM(9);
    if (IN(10)) REPS(10) {
        pg8::StaticOrder S; S.init((const bf16*)(F.ws + WS_YSSD), (const bf16*)(F.ws + WS_WSSDB), MTOK, DM, DSSM, G, bx);
        pg8::EpiBf<2> E{(bf16*)(F.ws + WS_MIX), DM, nullptr, (const bf16*)(F.ws + WS_G) + 1024, 2048, (const bf16*)(F.ws + WS_MIX)};
        pg8::gemm_phase<pg8::EpiBf<2>, pg8::StaticOrder, false>(F.lds, DSSM, S, E);
    } SEAM(10);
    if (IN(11)) REPS(11) {
        pg8::StaticOrder S; S.init((const bf16*)(F.ws + WS_MIX), (const bf16*)(F.ws + WS_WOUT), MTOK, DM, DM, G, bx);
        pg8::EpiRes E{(float*)(F.ws + WS_H1), F.in[I_BOUT], F.in[I_X], DN_ALPHA};
        pg8::gemm_phase<pg8::EpiRes, pg8::StaticOrder, false>(F.lds, DM, S, E);
        p10_expert_weights(F);
    } SEAM(11);
    if (IN(12)) REPS(12) { ln1_router_phase(F); } SEAM(12);
    if (IN(13)) REPS(13) {
        const int total = moe_table(F);
        pg8::MoeOrder<2, true> S{(const LAS int*)(F.lds + MOE_TP), (const LAS int*)(F.lds + MOE_CNT), G, bx, total, (const char*)(F.ws + WS_H1B), (const char*)(F.ws + WS_EW1), (const int*)(F.ws + WS_TOK)};
        pg8::EpiSwiGLU E{(bf16*)(F.ws + WS_HID)};
        pg8::gemm_phase<pg8::EpiSwiGLU, pg8::MoeOrder<2, true>, true>(F.lds, DM, S, E);
    } SEAM(13);
    if (IN(14)) {
        const int total = moe_table(F);
#pragma unroll 1
        for (int p = 0; p < 2; ++p) {
            { pg8::SlotOrder2 S{(const LAS int*)(F.lds + MOE_TP), G, bx, total, p, (const char*)(F.ws + WS_HID), (const char*)(F.ws + WS_EW2)};
              pg8::EpiSlot8 E{(unsigned char*)(F.ws + WS_YQ)};
              int kd = DEXP; asm volatile("" : "+s"(kd));
              pg8::gemm_phase<pg8::EpiSlot8, pg8::SlotOrder2, false>(F.lds, kd, S, E); }
            xcd_barrier(bar);
            if (p == 0) { moe_combine_phase<false>(F, p); xcd_barrier(bar); }
            else moe_combine_phase<true>(F, p);
        }
    }
#ifdef EXTRA_BARS
    for (int xb_ = 0; xb_ < EXTRA_BARS; ++xb_) xcd_barrier(bar);
#endif
#undef IN
#undef SEAM
}

extern "C" void kernel_launch(void* const* d_in, const int* in_sizes, int n_in, void* d_out, int out_size, void* d_ws, size_t ws_size, hipStream_t stream) {
    static int grid = 0;
    if (grid == 0) {
        if (n_in != 38 || out_size != MTOK * DM || ws_size < WS_END) { fprintf(stderr, "kernel_launch: unexpected shapes (n_in %d out %d ws %zu)\n", n_in, out_size, ws_size); grid = -1; return; }
        int dev = 0, cus = 0, per_cu = 0;
        if (hipGetDevice(&dev) != hipSuccess || hipDeviceGetAttribute(&cus, hipDeviceAttributeMultiprocessorCount, dev) != hipSuccess) { grid = -1; return; }
        if (hipFuncSetAttribute((const void*)fwd_kernel, hipFuncAttributeMaxDynamicSharedMemorySize, LDS_BYTES) != hipSuccess) { fprintf(stderr, "kernel_launch: hipFuncSetAttribute failed\n"); grid = -1; return; }
        if (hipOccupancyMaxActiveBlocksPerMultiprocessor(&per_cu, (const void*)fwd_kernel, NTHR, LDS_BYTES) != hipSuccess || per_cu < 1) fprintf(stderr, "kernel_launch: occupancy query says %d\n", per_cu);
        (void)hipGetLastError();
        grid = cus;
    }
    if (grid < 0) return;
    (void)hipMemsetAsync((char*)d_ws + WS_CTL, 0, CTL_ZERO_BYTES, stream);
    Args a{};
    for (int i = 0; i < 38; ++i) a.in[i] = (const float*)d_in[i];
    a.out = (float*)d_out; a.ws = (unsigned char*)d_ws;
    for (int li = 0; li < N_LAUNCHES; ++li) {
        a.ph_lo = (N_LAUNCHES == NPH) ? li : 0; a.ph_hi = (N_LAUNCHES == NPH) ? li + 1 : NPH; a.li = li;
        hipLaunchKernelGGL(fwd_kernel, dim3(grid), dim3(NTHR), LDS_BYTES, stream, a);
    }
}
```

```cpp
#define MK_N_LAUNCHES 1
#include <hip/hip_runtime.h>
#include <cstdio>
#include <cstdint>

#define LAS __attribute__((address_space(3)))
#define GAS __attribute__((address_space(1)))
typedef unsigned short bf16;
typedef short bf16x8 __attribute__((ext_vector_type(8)));
typedef float f32x4 __attribute__((ext_vector_type(4)));
typedef float f32x2 __attribute__((ext_vector_type(2)));
typedef unsigned u32x4 __attribute__((ext_vector_type(4)));
typedef unsigned u32x2 __attribute__((ext_vector_type(2)));
typedef GAS unsigned gu32;

constexpr int BATCH = 16, SEQ = 2048, DM = 1024, MTOK = BATCH * SEQ;
constexpr int HYC = 3072, DSSM = 2048, CONVD = 4096, NHEAD = 32, NGRP = 8, NSTATE = 128, INC = 11328;
constexpr int NE = 64, TOPK = 8, DEXP = 256, NEX = NE + 1;
constexpr float DN_ALPHA = 1.189207115002721f;
constexpr float LN_EPS = 1e-5f, RMS_EPS = 1e-5f, ROUTED_SCALE = 2.5f;
constexpr int NWAVES = 8, NTHR = 512;
constexpr int WIN_ROWS = 11520;

constexpr size_t MiB = 1u << 20;
constexpr size_t WS_CTL = 0, CTL_ZERO_BYTES = 256 * 1024;
constexpr size_t WS_WHYB = 1 * MiB, WS_WSSDB = 3 * MiB, WS_WOUT = 7 * MiB;
constexpr size_t WS_XB = 9 * MiB;
constexpr size_t WS_WINT = 73 * MiB;
constexpr size_t WS_KERN = 96 * MiB;
constexpr size_t WS_PTHY = 112 * MiB;
constexpr size_t WS_YTHY = 304 * MiB;
constexpr size_t WS_YHY = 137 * MiB;
constexpr size_t WS_XBC = 201 * MiB;
constexpr size_t WS_DT = 457 * MiB;
constexpr size_t WS_HALO = 465 * MiB;
constexpr size_t WS_YSSD = 9 * MiB;
constexpr size_t WS_XB2 = 201 * MiB;
constexpr size_t WS_WING = 265 * MiB;
constexpr size_t WS_G = 269 * MiB;
constexpr size_t WS_MIX = 397 * MiB;
constexpr size_t WS_H1 = 177 * MiB;
constexpr size_t WS_EW1 = 9 * MiB;
constexpr size_t WS_EW2 = 477 * MiB;
constexpr size_t WS_YQ = 9 * MiB;
constexpr size_t WS_ASG = 510 * MiB;
constexpr size_t WS_H1B = 113 * MiB;
constexpr size_t WS_HID = 305 * MiB;
constexpr size_t WS_TOK = 461 * MiB;
constexpr size_t WS_WGT = 469 * MiB;
constexpr size_t WS_END = 511 * MiB;
constexpr int CW_BAR = 4096;
constexpr int CW_CNT = 16384;
constexpr int CW_DBG = 32768;

constexpr int LDS_BYTES = 163840;
constexpr int MISC_OFF = 163840 - 512;

#define RLX_AGENT __ATOMIC_RELAXED, __HIP_MEMORY_SCOPE_AGENT
#define LDS_WAIT() asm volatile("s_waitcnt lgkmcnt(0)" ::: "memory")
#define VM_WAIT() asm volatile("s_waitcnt vmcnt(0)" ::: "memory")
typedef __bf16 bf16x2_t __attribute__((ext_vector_type(2)));
__device__ __forceinline__ unsigned pk2(float lo, float hi) { const f32x2 v = {lo, hi}; return __builtin_bit_cast(unsigned, __builtin_convertvector(v, bf16x2_t)); }
__device__ __forceinline__ unsigned f2bf(float f) { return pk2(f, 0.f) & 0xffffu; }
__device__ __forceinline__ float bf2f(unsigned b) { return __builtin_bit_cast(float, b << 16); }
__device__ __forceinline__ float bflo(unsigned w) { return __builtin_bit_cast(float, w << 16); }
__device__ __forceinline__ float bfhi(unsigned w) { return __builtin_bit_cast(float, w & 0xffff0000u); }
__device__ __forceinline__ float sigmoidf_(float v) { return __builtin_amdgcn_rcpf(1.0f + __expf(-v)); }
__device__ __forceinline__ float siluf_(float v) { return v * __builtin_amdgcn_rcpf(1.0f + __expf(-v)); }
__device__ __forceinline__ float wave_sum(float v) {
#pragma unroll
    for (int o = 1; o < 64; o <<= 1) v += __shfl_xor(v, o);
    return v;
}
__device__ __forceinline__ float wave_max(float v) {
#pragma unroll
    for (int o = 1; o < 64; o <<= 1) v = fmaxf(v, __shfl_xor(v, o));
    return v;
}

namespace pg8 {
constexpr int BM = 256, BK = 64, HALF = 128, HTB = HALF * BK * 2, STAGE_BYTES = 8 * HTB, NXCD = 8, WGM = 8;
__host__ __device__ __forceinline__ int lds_byte(int r, int c) { const int st = (r >> 4) * 2 + (c >> 5), rr = r & 15, cc = c & 31, ob = rr * 64 + cc * 2; return st * 1024 + (ob ^ (((ob >> 9) & 1) << 5)); }
__host__ __device__ __forceinline__ void stage_rc(int b, int& R, int& C) { const int st = b / 1024, sb = b % 1024, swz = sb ^ (((sb >> 9) & 1) << 5); R = (st >> 1) * 16 + swz / 64; C = (st & 1) * 32 + (swz % 64) / 2; }
__host__ __device__ __forceinline__ int perm32(int rho) { const int n = rho >> 4, i = rho & 15; return 8 * (i >> 2) + 4 * n + (i & 3); }

struct Unit { int pm, pn; const char* A; const char* B; int e, cnt; };

struct StaticOrder {
    int nM, nN, nwg, G, c, K; const char* A; const char* B;
    __device__ void init(const bf16* A_, const bf16* B_, int M, int N, int K_, int G_, int c_) { A = (const char*)A_; B = (const char*)B_; nM = M / BM; nN = N / BM; nwg = nM * nN; G = G_; c = c_; K = K_; }
    __device__ __forceinline__ bool next(int i, Unit& u) const {
        const long L = (long)i * G + c; if (L >= nwg) return false;
        int wgid = (int)L; { const int q = nwg / NXCD, r = nwg % NXCD, xcd = wgid % NXCD, off = wgid / NXCD; wgid = (xcd < r ? xcd * (q + 1) : r * (q + 1) + (xcd - r) * q) + off; }
        const int nig = WGM * nN, gid = wgid / nig, fm = gid * WGM, gsz = (nM - fm) < WGM ? (nM - fm) : WGM;
        u.pm = fm + ((wgid % nig) % gsz); u.pn = (wgid % nig) / gsz;
        u.A = A + (size_t)u.pm * BM * K * 2; u.B = B + (size_t)u.pn * BM * K * 2; u.e = 0; u.cnt = 0; return true;
    }
    __device__ __forceinline__ unsigned row_off(const Unit&, int) const { return 0u; }
};

__device__ __forceinline__ unsigned cvt_pk_bf16(float lo, float hi) { unsigned r; asm volatile("v_cvt_pk_bf16_f32 %0, %1, %2" : "=v"(r) : "v"(lo), "v"(hi)); return r; }

#ifndef PG8_SP2
#define PG8_SP2 true
#endif
template <class Epi, class Sched, bool GATHER, bool SP2 = PG8_SP2>
__device__ __forceinline__ void gemm_phase(LAS unsigned char* lds, const int K, const Sched& S, const Epi& E) {
    constexpr bool TA = Epi::TA;
    const int tid = threadIdx.x, wid = __builtin_amdgcn_readfirstlane(tid >> 6), lane = tid & 63, wr = wid >> 2, wc = wid & 3, fr = lane & 15, fq = lane >> 4;
    const int nt = K / BK;
    unsigned voffA[2][2], voffB[2]; int RA[2], CA[2];
#pragma unroll
    for (int i = 0; i < 2; ++i) { int R, C; stage_rc(tid * 16 + i * 8192, R, C); const int Rb = Epi::PERM ? ((R & ~31) + perm32(R & 31)) : R;
        RA[i] = R; CA[i] = C; voffA[0][i] = (unsigned)(R * K + C) * 2u; voffA[1][i] = voffA[0][i]; voffB[i] = (unsigned)(Rb * K + C) * 2u; }
    const size_t kstep = (size_t)(BK * 2);
    const size_t hstep = (size_t)HALF * K * 2;
    const size_t hstepA = GATHER ? 0 : hstep;
    const unsigned ldsw = (unsigned)wid * 1024u;
    const int aoff = lds_byte(wr * 64 + fr, fq * 8), boff = lds_byte(wc * 32 + fr, fq * 8);
#define PG8_SA(b, h) (((b) * 2 + (h)) * HTB)
#define PG8_SB(b, h) ((4 + (b) * 2 + (h)) * HTB)
#define PG8_STAGE(bufoff, gbase, voff) do { _Pragma("unroll") for (int _i = 0; _i < 2; ++_i) \
        __builtin_amdgcn_global_load_lds((const unsigned*)((const char*)(gbase) + (voff)[_i]), (LAS unsigned*)(lds + (bufoff) + ldsw + _i * 8192), 16, 0, 0); } while (0)
#define PG8_STAGE_A(bufoff, gbase, h) PG8_STAGE(bufoff, (gbase) + (h) * hstepA, voffA[GATHER ? (h) : 0])
#define PG8_LDA(dst, b, h) do { _Pragma("unroll") for (int m = 0; m < 4; ++m) _Pragma("unroll") for (int k = 0; k < 2; ++k) dst[m][k] = *(const LAS bf16x8*)(lds + PG8_SA(b, h) + aoff + m * 2048 + k * 1024); } while (0)
#define PG8_LDB(dst, b, h) do { _Pragma("unroll") for (int n = 0; n < 2; ++n) _Pragma("unroll") for (int k = 0; k < 2; ++k) dst[n][k] = *(const LAS bf16x8*)(lds + PG8_SB(b, h) + boff + n * 2048 + k * 1024); } while (0)
#define PG8_MMA(ai, bj, At, Bt) do { __builtin_amdgcn_s_setprio(1); _Pragma("unroll") for (int m = 0; m < 4; ++m) _Pragma("unroll") for (int n = 0; n < 2; ++n) _Pragma("unroll") for (int k = 0; k < 2; ++k) \
        acc[ai][bj][m][n] = TA ? __builtin_amdgcn_mfma_f32_16x16x32_bf16(Bt[n][k], At[m][k], acc[ai][bj][m][n], 0, 0, 0) \
                               : __builtin_amdgcn_mfma_f32_16x16x32_bf16(At[m][k], Bt[n][k], acc[ai][bj][m][n], 0, 0, 0); __builtin_amdgcn_s_setprio(0); } while (0)
#define PG8_WAIT_V(n) asm volatile("s_waitcnt vmcnt(" #n ")" ::: "memory")
#define PG8_WAIT_L(n) asm volatile("s_waitcnt lgkmcnt(" #n ")" ::: "memory")
#define PG8_BAR __builtin_amdgcn_s_barrier()
#define PG8_SCHED __builtin_amdgcn_sched_barrier(0)
    Unit cur, nxt; int ui = 0;
    if (!S.next(0, cur)) return;
    if (GATHER) {
#pragma unroll
        for (int h = 0; h < 2; ++h)
#pragma unroll
            for (int i = 0; i < 2; ++i) voffA[h][i] = S.row_off(cur, h * HALF + RA[i]) + (unsigned)CA[i] * 2u;
    }
    f32x4 acc[2][2][4][2];
#pragma unroll
    for (int a = 0; a < 2; ++a)
#pragma unroll
        for (int b = 0; b < 2; ++b)
#pragma unroll
            for (int m = 0; m < 4; ++m)
#pragma unroll
                for (int n = 0; n < 2; ++n) acc[a][b][m][n] = (f32x4){0.f, 0.f, 0.f, 0.f};
    bf16x8 At[4][2], B0[2][2], B1[2][2];
    const char* cA = cur.A; const char* cB = cur.B;
    if constexpr (SP2) {
        PG8_STAGE(PG8_SB(0, 0), cB, voffB); PG8_STAGE(PG8_SB(0, 1), cB + hstep, voffB); PG8_STAGE_A(PG8_SA(0, 0), cA, 0); PG8_STAGE_A(PG8_SA(0, 1), cA, 1);
        if (wr == 1) PG8_BAR;
        PG8_WAIT_V(2); PG8_BAR;
        PG8_STAGE(PG8_SB(1, 0), cB + kstep, voffB); PG8_STAGE_A(PG8_SA(1, 0), cA + kstep, 0); PG8_STAGE(PG8_SB(1, 1), cB + hstep + kstep, voffB);
        PG8_WAIT_V(6); PG8_BAR;
    } else {
    PG8_STAGE(PG8_SB(0, 0), cB, voffB); PG8_STAGE_A(PG8_SA(0, 0), cA, 0); PG8_STAGE(PG8_SB(0, 1), cB + hstep, voffB); PG8_STAGE_A(PG8_SA(0, 1), cA, 1);
    if (wr == 1) PG8_BAR;
    PG8_WAIT_V(4); PG8_BAR;
    PG8_STAGE(PG8_SB(1, 0), cB + kstep, voffB); PG8_STAGE_A(PG8_SA(1, 0), cA + kstep, 0); PG8_STAGE(PG8_SB(1, 1), cB + hstep + kstep, voffB);
    PG8_WAIT_V(6); PG8_BAR;
    }
    for (;;) {
        const bool has_next = S.next(ui + 1, nxt);
        const char* nA = has_next ? nxt.A : cA; const char* nB = has_next ? nxt.B : cB;
        for (int t = 0; t < nt; t += 2) {
            const bool last = (t == nt - 2);
            const char* a1 = cA + (size_t)(t + 1) * kstep;
            const char* a2 = last ? nA : cA + (size_t)(t + 2) * kstep; const char* b2 = last ? nB : cB + (size_t)(t + 2) * kstep;
            const char* a3 = a2 + kstep; const char* b3 = b2 + kstep;
            if constexpr (SP2) {
            PG8_LDB(B0, 0, 0); PG8_LDB(B1, 0, 1); PG8_SCHED; PG8_LDA(At, 0, 0); PG8_STAGE_A(PG8_SA(1, 1), a1, 1);
            PG8_WAIT_V(8); PG8_WAIT_L(0); PG8_BAR; PG8_MMA(0, 0, At, B0); PG8_MMA(0, 1, At, B1); PG8_BAR; PG8_SCHED;
            if (GATHER) { if (last && has_next) {
#pragma unroll
                for (int h = 0; h < 2; ++h)
#pragma unroll
                    for (int i = 0; i < 2; ++i) voffA[h][i] = S.row_off(nxt, h * HALF + RA[i]) + (unsigned)CA[i] * 2u;
            } }
            PG8_LDA(At, 0, 1); PG8_STAGE(PG8_SB(0, 0), b2, voffB); PG8_STAGE(PG8_SB(0, 1), b2 + hstep, voffB); PG8_STAGE_A(PG8_SA(0, 0), a2, 0);
            PG8_WAIT_V(8); PG8_WAIT_L(0); PG8_BAR; PG8_MMA(1, 0, At, B0); PG8_MMA(1, 1, At, B1); PG8_BAR; PG8_SCHED;
            PG8_LDB(B0, 1, 0); PG8_LDB(B1, 1, 1); PG8_SCHED; PG8_LDA(At, 1, 0); PG8_STAGE_A(PG8_SA(0, 1), a2, 1);
            PG8_WAIT_V(8); PG8_WAIT_L(0); PG8_BAR; PG8_MMA(0, 0, At, B0); PG8_MMA(0, 1, At, B1); PG8_BAR; PG8_SCHED;
            PG8_LDA(At, 1, 1); PG8_STAGE(PG8_SB(1, 0), b3, voffB); PG8_STAGE(PG8_SB(1, 1), b3 + hstep, voffB); PG8_STAGE_A(PG8_SA(1, 0), a3, 0);
            PG8_WAIT_V(8); PG8_WAIT_L(0); PG8_BAR; PG8_MMA(1, 0, At, B0); PG8_MMA(1, 1, At, B1); PG8_BAR; PG8_SCHED;
            } else {
            PG8_LDB(B0, 0, 0); PG8_SCHED; PG8_LDA(At, 0, 0); PG8_STAGE_A(PG8_SA(1, 1), a1, 1);
            PG8_WAIT_L(8); PG8_BAR; PG8_WAIT_L(0); PG8_MMA(0, 0, At, B0); PG8_BAR; PG8_SCHED;
            if (GATHER) { if (last && has_next) {
#pragma unroll
                for (int h = 0; h < 2; ++h)
#pragma unroll
                    for (int i = 0; i < 2; ++i) voffA[h][i] = S.row_off(nxt, h * HALF + RA[i]) + (unsigned)CA[i] * 2u;
            } }
            PG8_LDB(B1, 0, 1); PG8_STAGE(PG8_SB(0, 0), b2, voffB);
            PG8_BAR; PG8_WAIT_L(0); PG8_MMA(0, 1, At, B1); PG8_BAR;
            PG8_LDA(At, 0, 1); PG8_STAGE_A(PG8_SA(0, 0), a2, 0);
            PG8_BAR; PG8_WAIT_L(0); PG8_MMA(1, 0, At, B0); PG8_BAR; PG8_SCHED;
            PG8_STAGE(PG8_SB(0, 1), b2 + hstep, voffB);
            PG8_WAIT_V(6); PG8_BAR; PG8_MMA(1, 1, At, B1); PG8_BAR;
            PG8_LDB(B0, 1, 0); PG8_SCHED; PG8_LDA(At, 1, 0); PG8_STAGE_A(PG8_SA(0, 1), a2, 1);
            PG8_WAIT_L(8); PG8_BAR; PG8_WAIT_L(0); PG8_MMA(0, 0, At, B0); PG8_BAR; PG8_SCHED;
            PG8_LDB(B1, 1, 1); PG8_STAGE(PG8_SB(1, 0), b3, voffB);
            PG8_BAR; PG8_WAIT_L(0); PG8_MMA(0, 1, At, B1); PG8_BAR;
            PG8_LDA(At, 1, 1); PG8_STAGE_A(PG8_SA(1, 0), a3, 0);
            PG8_BAR; PG8_WAIT_L(0); PG8_MMA(1, 0, At, B0); PG8_BAR; PG8_SCHED;
            PG8_STAGE(PG8_SB(1, 1), b3 + hstep, voffB);
            PG8_WAIT_V(6); PG8_BAR; PG8_MMA(1, 1, At, B1); PG8_BAR;
                    }
        }
        E(acc, cur, wr, wc, fr, fq);
        if (!has_next) break;
#pragma unroll
        for (int a = 0; a < 2; ++a)
#pragma unroll
            for (int b = 0; b < 2; ++b)
#pragma unroll
                for (int m = 0; m < 4; ++m)
#pragma unroll
                    for (int n = 0; n < 2; ++n) acc[a][b][m][n] = (f32x4){0.f, 0.f, 0.f, 0.f};
        cur = nxt; cA = nA; cB = nB; ++ui;
    }
    PG8_WAIT_V(0);
    if (wr == 0) PG8_BAR;
    PG8_BAR;
#undef PG8_SA
#undef PG8_SB
#undef PG8_STAGE
#undef PG8_STAGE_A
#undef PG8_LDA
#undef PG8_LDB
#undef PG8_MMA
#undef PG8_WAIT_V
#undef PG8_WAIT_L
#undef PG8_BAR
#undef PG8_SCHED
}
}

namespace pg8 {
struct EpiHyT {
    static constexpr bool TA = false, PERM = false;
    bf16* PT; const float* bias;
    __device__ __forceinline__ void operator()(const f32x4 (&acc)[2][2][4][2], const Unit& u, int wr, int wc, int fr, int fq) const {
#pragma unroll
        for (int bj = 0; bj < 2; ++bj)
#pragma unroll
            for (int n = 0; n < 2; ++n) {
                const int col = u.pn * BM + bj * HALF + wc * 32 + n * 16 + fr; const float bv = bias[col];
                bf16* colp = PT + (size_t)col * MTOK + u.pm * BM + wr * 64 + 4 * fq;
#pragma unroll
                for (int ai = 0; ai < 2; ++ai)
#pragma unroll
                    for (int m = 0; m < 4; ++m) { const f32x4 v = acc[ai][bj][m][n] + bv; u32x2 w; w.x = cvt_pk_bf16(v[0], v[1]); w.y = cvt_pk_bf16(v[2], v[3]);
                        *(u32x2*)(colp + ai * HALF + m * 16) = w; }
            }
    }
};
struct EpiZXD {
    static constexpr bool TA = true, PERM = true;
    bf16* Zb; bf16* XBC; float* DT; const float* b_in; bf16* HALO;
    __device__ __forceinline__ void operator()(const f32x4 (&acc)[2][2][4][2], const Unit& u, int wr, int wc, int fr, int fq) const {
        const int row0 = u.pm * BM + wr * 64 + fr;
        if (u.pn == 24) {
            if (wc < 2) {
                const int c0 = wc * 32 + 8 * fq;
#pragma unroll
                for (int n = 0; n < 2; ++n) { const f32x4 bv = *(const f32x4*)(b_in + 9216 + c0 + 4 * n);
#pragma unroll
                    for (int ai = 0; ai < 2; ++ai)
#pragma unroll
                        for (int m = 0; m < 4; ++m) *(f32x4*)(DT + (size_t)(row0 + ai * HALF + m * 16) * 64 + c0 + 4 * n) = acc[ai][0][m][n] + bv; }
            }
            return;
        }
        bf16* base; int ldc, colt, bcol;
        if (u.pn < 8) { base = Zb; ldc = DSSM; colt = u.pn * BM; bcol = 3072 + colt; } else { base = XBC; ldc = CONVD; colt = (u.pn - 8) * BM; bcol = 5120 + colt; }
        const int col0 = colt + wc * 32 + 8 * fq, bcol0 = bcol + wc * 32 + 8 * fq;
        f32x4 bv[2][2];
#pragma unroll
        for (int bj = 0; bj < 2; ++bj)
#pragma unroll
            for (int n = 0; n < 2; ++n) bv[bj][n] = *(const f32x4*)(b_in + bcol0 + bj * HALF + 4 * n);
#pragma unroll
        for (int ai = 0; ai < 2; ++ai)
#pragma unroll
            for (int m = 0; m < 4; ++m) { bf16* rowp = base + (size_t)(row0 + ai * HALF + m * 16) * ldc + col0;
#pragma unroll
                for (int bj = 0; bj < 2; ++bj) { const f32x4 v0 = acc[ai][bj][m][0] + bv[bj][0], v1 = acc[ai][bj][m][1] + bv[bj][1];
                    u32x4 w; w.x = cvt_pk_bf16(v0[0], v0[1]); w.y = cvt_pk_bf16(v0[2], v0[3]); w.z = cvt_pk_bf16(v1[0], v1[1]); w.w = cvt_pk_bf16(v1[2], v1[3]);
                    *(u32x4*)(rowp + bj * HALF) = w;
                    if (u.pn >= 8 && ((m == 3 && fr >= 14) || (m == 0 && fr < 2))) {
                        const int row = row0 + ai * HALF + m * 16, bb = row >> 11, t = row & 2047, tm = t & 63;
                        const int jb = (tm >= 62) ? (t >> 6) + 1 : (t >> 6), idx = (tm >= 62) ? tm - 62 : 2 + tm;
                        *(u32x4*)(HALO + ((size_t)(bb * 33 + jb) * 4 + idx) * CONVD + col0 + bj * HALF) = w; } } }
    }
};
template <int MODE> struct EpiBf {
    static constexpr bool TA = true, PERM = true;
    bf16* O; int ldc; const float* bias; const bf16* G1; int ldg; const bf16* P;
    __device__ __forceinline__ void operator()(const f32x4 (&acc)[2][2][4][2], const Unit& u, int wr, int wc, int fr, int fq) const {
        const int row0 = u.pm * BM + wr * 64 + fr, col0 = u.pn * BM + wc * 32 + 8 * fq;
#pragma unroll
        for (int ai = 0; ai < 2; ++ai)
#pragma unroll
            for (int m = 0; m < 4; ++m) { const size_t r = (size_t)(row0 + ai * HALF + m * 16);
#pragma unroll
                for (int bj = 0; bj < 2; ++bj) { f32x4 v0 = acc[ai][bj][m][0], v1 = acc[ai][bj][m][1]; const int c = col0 + bj * HALF;
                    if (MODE == 0) { const f32x4 b0 = *(const f32x4*)(bias + c), b1 = *(const f32x4*)(bias + c + 4); v0 = v0 + b0; v1 = v1 + b1;
#pragma unroll
                        for (int j = 0; j < 4; ++j) { v0[j] = sigmoidf_(v0[j]); v1[j] = sigmoidf_(v1[j]); } }
                    else { const u32x4 g = *(const u32x4*)(G1 + r * ldg + c);
                        v0[0] *= bflo(g.x); v0[1] *= bfhi(g.x); v0[2] *= bflo(g.y); v0[3] *= bfhi(g.y); v1[0] *= bflo(g.z); v1[1] *= bfhi(g.z); v1[2] *= bflo(g.w); v1[3] *= bfhi(g.w);
                        if (MODE == 2) { const u32x4 p = *(const u32x4*)(P + r * ldc + c);
                            v0[0] += bflo(p.x); v0[1] += bfhi(p.x); v0[2] += bflo(p.y); v0[3] += bfhi(p.y); v1[0] += bflo(p.z); v1[1] += bfhi(p.z); v1[2] += bflo(p.w); v1[3] += bfhi(p.w); } }
                    u32x4 w; w.x = cvt_pk_bf16(v0[0], v0[1]); w.y = cvt_pk_bf16(v0[2], v0[3]); w.z = cvt_pk_bf16(v1[0], v1[1]); w.w = cvt_pk_bf16(v1[2], v1[3]);
                    *(u32x4*)(O + r * ldc + c) = w; } }
    }
};
struct EpiRes {
    static constexpr bool TA = true, PERM = false;
    float* O; const float* bias; const float* X; float alpha;
    __device__ __forceinline__ void operator()(const f32x4 (&acc)[2][2][4][2], const Unit& u, int wr, int wc, int fr, int fq) const {
        const int row0 = u.pm * BM + wr * 64 + fr, col0 = u.pn * BM + wc * 32 + 4 * fq;
#pragma unroll
        for (int ai = 0; ai < 2; ++ai)
#pragma unroll
            for (int m = 0; m < 4; ++m) { const size_t off = (size_t)(row0 + ai * HALF + m * 16) * DM + col0;
#pragma unroll
                for (int bj = 0; bj < 2; ++bj)
#pragma unroll
                    for (int n = 0; n < 2; ++n) { const f32x4 xv = *(const f32x4*)(X + off + bj * HALF + n * 16), bv = *(const f32x4*)(bias + col0 + bj * HALF + n * 16);
                        *(f32x4*)(O + off + bj * HALF + n * 16) = acc[ai][bj][m][n] + bv + alpha * xv; } }
    }
};
struct EpiSwiGLU {
    static constexpr bool TA = true, PERM = true;
    bf16* HID;
    __device__ __forceinline__ void operator()(const f32x4 (&acc)[2][2][4][2], const Unit& u, int wr, int wc, int fr, int fq) const {
        const int row0 = u.pm * BM + wr * 64 + fr, col0 = u.pn * HALF + wc * 32 + 8 * fq;
#pragma unroll
        for (int ai = 0; ai < 2; ++ai)
#pragma unroll
            for (int m = 0; m < 4; ++m) { f32x4 v0, v1;
#pragma unroll
                for (int j = 0; j < 4; ++j) { v0[j] = siluf_(acc[ai][0][m][0][j]) * acc[ai][1][m][0][j]; v1[j] = siluf_(acc[ai][0][m][1][j]) * acc[ai][1][m][1][j]; }
                u32x4 w; w.x = cvt_pk_bf16(v0[0], v0[1]); w.y = cvt_pk_bf16(v0[2], v0[3]); w.z = cvt_pk_bf16(v1[0], v1[1]); w.w = cvt_pk_bf16(v1[2], v1[3]);
                *(u32x4*)(HID + (size_t)(row0 + ai * HALF + m * 16) * DEXP + col0) = w; }
    }
};
struct EpiScatter {
    static constexpr bool TA = false, PERM = false;
    float* ACC; const int* tok; const float* wgt; int j0_unused;
    __device__ __forceinline__ void operator()(const f32x4 (&acc)[2][2][4][2], const Unit& u, int wr, int wc, int fr, int fq) const {
        asm volatile("" : "+v"(fr), "+v"(fq));
        const int jt = u.pn >> 2, ct = u.pn & 3;
#pragma unroll
        for (int ai = 0; ai < 2; ++ai)
#pragma unroll
            for (int m = 0; m < 4; ++m)
#pragma unroll
                for (int j = 0; j < 4; ++j) { const int r = ai * HALF + wr * 64 + m * 16 + 4 * fq + j;
                    if (r < u.cnt) { int token; float w;
                        if (u.e == NE) { token = jt * BM + r; w = 1.0f; } else { const size_t li = (size_t)u.e * MTOK + (size_t)jt * BM + r; token = tok[li]; w = wgt[li]; }
                        float* rowp = ACC + (size_t)token * DM + ct * BM + wc * 32 + fr;
#pragma unroll
                        for (int bj = 0; bj < 2; ++bj)
#pragma unroll
                            for (int n = 0; n < 2; ++n) unsafeAtomicAdd(rowp + bj * HALF + n * 16, w * acc[ai][bj][m][n][j]);
                    }
                    asm volatile("" ::: "memory"); }
    }
};

struct EpiSlot8 {
    static constexpr bool TA = true, PERM = true;
    unsigned char* YQ;
    __device__ __forceinline__ void operator()(const f32x4 (&acc)[2][2][4][2], const Unit& u, int wr, int wc, int fr, int fq) const {
        const int row0 = u.pm * BM + wr * 64 + fr, col0 = (u.pn & 1) * 256 + wc * 32 + 8 * fq;
#pragma unroll
        for (int ai = 0; ai < 2; ++ai)
#pragma unroll
            for (int m = 0; m < 4; ++m) { unsigned char* rowp = YQ + (size_t)(row0 + ai * HALF + m * 16) * 512 + col0;
#pragma unroll
                for (int bj = 0; bj < 2; ++bj) { const f32x4 v0 = acc[ai][bj][m][0], v1 = acc[ai][bj][m][1];
                    int w0 = __builtin_amdgcn_cvt_pk_fp8_f32(v0[0], v0[1], 0, false); w0 = __builtin_amdgcn_cvt_pk_fp8_f32(v0[2], v0[3], w0, true);
                    int w1 = __builtin_amdgcn_cvt_pk_fp8_f32(v1[0], v1[1], 0, false); w1 = __builtin_amdgcn_cvt_pk_fp8_f32(v1[2], v1[3], w1, true);
                    u32x2 w; w.x = (unsigned)w0; w.y = (unsigned)w1; *(u32x2*)(rowp + bj * HALF) = w; } }
    }
};
struct SlotOrder2 {
    const LAS int* tp; int G, c, total, pass; const char* A; const char* W;
    __device__ __forceinline__ bool next(int i, Unit& u) const {
        const long L = (long)i * G + c; if (L >= 2l * total) return false;
        const int tile = (int)(L >> 1), q = 2 * pass + (int)(L & 1); int e = 0;
#pragma unroll 1
        for (int s = 64; s >= 1; s >>= 1) if (e + s <= NE && tp[e + s] <= tile) e += s;
        u.e = e; u.cnt = 0; u.pm = tile; u.pn = q; u.A = A + (size_t)tile * BM * DEXP * 2; u.B = W + ((size_t)e * DM + (size_t)q * 256) * DEXP * 2;
        return true;
    }
    __device__ __forceinline__ unsigned row_off(const Unit&, int) const { return 0u; }
};
template <int NCT, bool FIRST> struct MoeOrder {
    const LAS int* tp; const LAS int* cnt; int G, c, total;
    const char* A; const char* W; const int* tok;
    __device__ __forceinline__ bool next(int i, Unit& u) const {
        const long L = (long)i * G + c; if (L >= (long)total * NCT) return false;
        const int tile = (int)(L / NCT), ct = (int)(L % NCT);
        int e = 0;
#pragma unroll 1
        for (int s = 64; s >= 1; s >>= 1) if (e + s <= NE && tp[e + s] <= tile) e += s;
        const int jt = tile - tp[e];
        u.e = e; const int left = cnt[e] - jt * BM; u.cnt = left < BM ? left : BM;
        if (FIRST) { u.pm = tile; u.pn = ct; u.A = A; u.B = W + ((size_t)e * 512 + (size_t)ct * 256) * DM * 2; }
        else { u.pm = tile; u.pn = jt * 4 + ct; u.A = A + (size_t)tile * BM * DEXP * 2; u.B = W + ((size_t)e * DM + (size_t)ct * 256) * DEXP * 2; }
        return true;
    }
    __device__ __forceinline__ unsigned row_off(const Unit& u, int r) const {
        const int jt = u.pm - tp[u.e]; int token;
        if (u.e == NE) token = jt * BM + r; else token = (r < u.cnt) ? tok[(size_t)u.e * MTOK + (size_t)jt * BM + r] : 0;
        return (unsigned)token * (unsigned)(DM * 2);
    }
};
}

#define XB_TMO      128
#define XB_XCNT(j)  (256  + 64 * (j))
#define XB_XSUB(j)  (1280 + 64 * (j))
#define XB_XGEN(j)  (2304 + 64 * (j))
#define XB_TOP      3328
#define XB_TOPGEN   3392
#define XCD_BAR_WORDS 3456
#define XB_SPIN_CAP (1u << 18)
__device__ __forceinline__ unsigned xb_ld(unsigned* p)              { return __hip_atomic_load(p, __ATOMIC_RELAXED, __HIP_MEMORY_SCOPE_AGENT); }
__device__ __forceinline__ unsigned xb_add(unsigned* p, unsigned v) { return __hip_atomic_fetch_add(p, v, __ATOMIC_RELAXED, __HIP_MEMORY_SCOPE_AGENT); }
__device__ __forceinline__ unsigned xb_xcc_id() { return (unsigned)__builtin_amdgcn_s_getreg((3 << 11) | 20) & 0xFu; }
#define XB_SPIN(cond, bar) do { unsigned _sp = 0; while (cond) { __builtin_amdgcn_s_sleep(1); \
    if ((++_sp & 255u) == 0u) { if (xb_ld(&(bar)[XB_TMO])) break; if (_sp > XB_SPIN_CAP) { atomicAdd(&(bar)[XB_TMO], 1u); break; } } } } while (0)
struct XcdBarrier { unsigned* bar; unsigned x; volatile LAS unsigned* st; };
__device__ __forceinline__ XcdBarrier xcd_barrier_post(unsigned* bar, volatile LAS unsigned* st) {
    XcdBarrier b; b.bar = bar; b.x = xb_xcc_id(); b.st = st;
    if (threadIdx.x == 0) (void)xb_add(&bar[XB_XCNT(b.x)], 1u);
    return b;
}
__device__ __forceinline__ void xcd_barrier_complete(unsigned* bar, unsigned x, unsigned& nloc, unsigned& nx) {
    const unsigned G = gridDim.x * gridDim.y * gridDim.z;
    unsigned sum, cnt, mine, sp = 0u;
    for (;;) {
        sum = 0u; cnt = 0u; mine = 0u;
#pragma unroll
        for (unsigned j = 0; j < 16; ++j) { const unsigned c = xb_ld(&bar[XB_XCNT(j)]); sum += c; cnt += (c > 0u) ? 1u : 0u; mine = (j == x) ? c : mine; }
        if (sum == G) break;
        __builtin_amdgcn_s_sleep(1);
        if ((++sp & 255u) == 0u) { if (xb_ld(&bar[XB_TMO])) break; if (sp > XB_SPIN_CAP) { atomicAdd(&bar[XB_TMO], 1u); break; } }
    }
    nloc = mine > 0u ? mine : 1u; nx = cnt > 0u ? cnt : 1u;
}
__device__ __forceinline__ void xcd_barrier(const XcdBarrier& b) {
    asm volatile("s_waitcnt vmcnt(0)" ::: "memory");
    __syncthreads();
    if (threadIdx.x == 0) {
        unsigned* bar = b.bar;
        __builtin_amdgcn_s_waitcnt(0);
        unsigned nloc = b.st[0], nx = b.st[1];
        if (nloc == 0u) { xcd_barrier_complete(bar, b.x, nloc, nx); b.st[0] = nloc; b.st[1] = nx; }
        const unsigned old = xb_add(&bar[XB_XSUB(b.x)], 1u);
        const unsigned gen = old / nloc;
        if (old + 1u == (gen + 1u) * nloc) {
            __builtin_amdgcn_fence(__ATOMIC_RELEASE, "agent");
            asm volatile("s_waitcnt vmcnt(0)" ::: "memory");
            const unsigned og = xb_add(&bar[XB_TOP], 1u);
            const unsigned tg = og / nx;
            if (og + 1u == (tg + 1u) * nx) xb_add(&bar[XB_TOPGEN], 1u);
            else XB_SPIN(xb_ld(&bar[XB_TOPGEN]) == tg, bar);
            __builtin_amdgcn_fence(__ATOMIC_ACQUIRE, "agent");
            xb_add(&bar[XB_XGEN(b.x)], 1u);
            asm volatile("s_waitcnt vmcnt(0)" ::: "memory");
        } else {
            XB_SPIN(xb_ld(&bar[XB_XGEN(b.x)]) == gen, bar);
            __builtin_amdgcn_fence(__ATOMIC_ACQUIRE, "agent");
            asm volatile("s_waitcnt vmcnt(0)" ::: "memory");
        }
    }
    __syncthreads();
}

struct Args {
    const float* in[38]; float* out; unsigned char* ws; int ph_lo, ph_hi, li, pad;
};
enum { I_X = 0, I_WIN, I_BIN, I_HCW, I_HCB, I_FW1, I_FB1, I_FF1, I_FW2, I_FB2, I_FF2, I_FW3, I_FB3, I_FF3, I_FW4, I_HBIAS,
       I_SCW, I_SCB, I_DTB, I_ALOG, I_SD, I_SNW, I_WHYB, I_WSSDB, I_WOUT, I_BOUT, I_LN1G, I_LN1B, I_RW, I_RB, I_EWG, I_EWU, I_EWD, I_SWG, I_SWU, I_SWD, I_LN2G, I_LN2B };
struct Frame {
    LAS unsigned char* lds; volatile LAS unsigned* MISC; gu32* ctl; unsigned char* ws;
    int tid, lane, wave, vcu, G;
    const float* const* in; float* out;
};

__device__ __forceinline__ void tr_item(const float* src, int ld_src, int k0, int c0, bf16* dst, int drow0, int ldd, LAS float* scr, int lane) {
    f32x4 ld[8];
#pragma unroll
    for (int i = 0; i < 8; ++i) ld[i] = *(const f32x4*)(src + (size_t)(k0 + 8 * i + (lane >> 3)) * ld_src + c0 + 4 * (lane & 7));
#pragma unroll
    for (int i = 0; i < 8; ++i) { LAS float* d = scr + (8 * i + (lane >> 3)) * 33 + 4 * (lane & 7); d[0] = ld[i][0]; d[1] = ld[i][1]; d[2] = ld[i][2]; d[3] = ld[i][3]; }
    LDS_WAIT(); asm volatile("" ::: "memory");
    const int c = lane & 7;
#pragma unroll
    for (int j = 0; j < 4; ++j) { const int n = (lane >> 3) + 8 * j; const LAS float* s = scr + (8 * c) * 33 + n;
        u32x4 o; o.x = pk2(s[0 * 33], s[1 * 33]); o.y = pk2(s[2 * 33], s[3 * 33]); o.z = pk2(s[4 * 33], s[5 * 33]); o.w = pk2(s[6 * 33], s[7 * 33]);
        *(u32x4*)(dst + (size_t)(drow0 + n) * ldd + k0 + 8 * c) = o; }
    LDS_WAIT(); asm volatile("" ::: "memory");
}
__device__ __forceinline__ void tr_matrix_item(const float* src, int ld_src, int K, int col_first, int ncols, bf16* dst, int drow_first, LAS float* scr, int it, int lane) {
    const int nblk = ncols / 32, kb = it / nblk, nb = it % nblk;
    tr_item(src, ld_src, kb * 64, col_first + nb * 32, dst, drow_first + nb * 32, K, scr, lane);
}
__device__ __forceinline__ void convert_x(Frame& F, const float* x, bf16* xb) {
    const size_t n8 = (size_t)MTOK * DM / 8; const size_t stride = (size_t)F.G * NTHR;
    for (size_t i = (size_t)F.vcu * NTHR + F.tid; i < n8; i += stride) {
        const f32x4 a = *(const f32x4*)(x + i * 8), b = *(const f32x4*)(x + i * 8 + 4);
        u32x4 o; o.x = pk2(a[0], a[1]); o.y = pk2(a[2], a[3]); o.z = pk2(b[0], b[1]); o.w = pk2(b[2], b[3]);
        *(u32x4*)(xb + i * 8) = o; }
}

__device__ __forceinline__ void hyena_filter(Frame& F) {
    const float* w1 = F.in[I_FW1]; const float* b1 = F.in[I_FB1]; const float* f1 = F.in[I_FF1];
    const float* w2 = F.in[I_FW2]; const float* b2 = F.in[I_FB2]; const float* f2 = F.in[I_FF2];
    const float* w3 = F.in[I_FW3]; const float* b3 = F.in[I_FB3]; const float* f3 = F.in[I_FF3];
    const float* w4 = F.in[I_FW4];
    bf16* KERN = (bf16*)(F.ws + WS_KERN);
    LAS float* hbuf = (LAS float*)(F.lds);
    const int lane = F.lane, wave = F.wave;
    for (int pg = F.vcu; pg < SEQ / 8; pg += F.G) {
        const int t = 8 * pg + wave;
        const float tn = (float)t / (float)(SEQ - 1), wv = 6.283185307179586f * (float)t / (float)SEQ;
        float zf = 0.f;
        if (lane == 0) zf = tn;
        else if (lane <= 16) { const float f = 1e-4f + (float)(lane - 1) * ((15.0f - 1e-4f) / 15.0f); zf = cosf(f * wv); }
        else if (lane <= 32) { const float f = 1e-4f + (float)(lane - 17) * ((15.0f - 1e-4f) / 15.0f); zf = -sinf(f * wv); }
        float s = b1[lane];
        for (int i = 0; i < 33; ++i) s += __shfl(zf, i) * w1[i * 64 + lane];
        float h = sinf(f1[lane] * s);
        s = b2[lane];
        for (int i = 0; i < 64; ++i) s += __shfl(h, i) * w2[i * 64 + lane];
        h = sinf(f2[lane] * s);
        s = b3[lane];
        for (int i = 0; i < 64; ++i) s += __shfl(h, i) * w3[i * 64 + lane];
        h = sinf(f3[lane] * s);
        hbuf[wave * 64 + lane] = h;
        __syncthreads();
        { float a[8][8];
#pragma unroll
          for (int q = 0; q < 8; ++q)
#pragma unroll
              for (int p = 0; p < 8; ++p) a[q][p] = 0.f;
          float a0b[4] = {0.f, 0.f, 0.f, 0.f};
#pragma unroll 2
          for (int i = 0; i < 64; ++i) { float wv[8], hv[8];
#pragma unroll
              for (int q = 0; q < 8; ++q) wv[q] = w4[(size_t)i * 4096 + F.tid + 512 * q];
#pragma unroll
              for (int p = 0; p < 8; ++p) hv[p] = hbuf[p * 64 + i];
#pragma unroll
              for (int q = 0; q < 8; ++q)
#pragma unroll
                  for (int p = 0; p < 8; ++p) a[q][p] += hv[p] * wv[q];
              if (pg == 0) { a0b[0] += hv[0] * wv[2]; a0b[1] += hv[0] * wv[3]; a0b[2] += hv[0] * wv[6]; a0b[3] += hv[0] * wv[7]; } }
#pragma unroll
          for (int q = 0; q < 8; ++q) { const int col = F.tid + 512 * q, c = col & 1023, dir = (q >> 1) & 1, o = q >> 2;
              const float adel = 3.0701134573253945f + (float)c * ((15.350567286626973f - 3.0701134573253945f) / 1023.0f);
              bf16* kc = KERN + ((size_t)c * 2 + o) * 4096;
#pragma unroll
              for (int p = 0; p < 8; ++p) { const int tp = 8 * pg + p; const float v = a[q][p] * __expf(-((float)tp / (float)(SEQ - 1)) * adel);
                  if (tp == 0) { if (dir == 0) { kc[2048] = (bf16)f2bf(v + a0b[(q & 1) + 2 * o]); kc[0] = 0; } }
                  else kc[dir == 0 ? 2048 - tp : 2048 + tp] = (bf16)f2bf(v); } } }
        __syncthreads();
    }
}

__device__ __forceinline__ void p0_prologue(Frame& F) {
    LAS float* scr = (LAS float*)(F.lds + 4096 + F.wave * 16384);
    const int gw = F.vcu * NWAVES + F.wave, NGW = F.G * NWAVES;
    hyena_filter(F);
    bf16* WINT = (bf16*)(F.ws + WS_WINT);
    constexpr int I_A = 16 * (9216 / 32), I_B = 16 * (64 / 32), I_C = 16 * (2048 / 32);
    constexpr int I_HY = 16 * 32, I_SS = 32 * 32, I_OUT = 16 * 32;
    constexpr int NITEMS = I_A + I_B + I_C + I_HY + I_SS + I_OUT;
    for (int it = gw; it < NITEMS; it += NGW) {
        int r = it;
        if (r < I_A) { tr_matrix_item(F.in[I_WIN], INC, DM, 0, 9216, WINT, 0, scr, r, F.lane); continue; } r -= I_A;
        if (r < I_B) { tr_matrix_item(F.in[I_WIN], INC, DM, 9216, 64, WINT, 9216, scr, r, F.lane); continue; } r -= I_B;
        if (r < I_C) { tr_matrix_item(F.in[I_WIN], INC, DM, 9280, 2048, WINT, 9472, scr, r, F.lane); continue; } r -= I_C;
        if (r < I_HY) { tr_matrix_item(F.in[I_WHYB], DM, DM, 0, DM, (bf16*)(F.ws + WS_WHYB), 0, scr, r, F.lane); continue; } r -= I_HY;
        if (r < I_SS) { tr_matrix_item(F.in[I_WSSDB], DM, DSSM, 0, DM, (bf16*)(F.ws + WS_WSSDB), 0, scr, r, F.lane); continue; } r -= I_SS;
        tr_matrix_item(F.in[I_WOUT], DM, DM, 0, DM, (bf16*)(F.ws + WS_WOUT), 0, scr, r, F.lane);
    }
    convert_x(F, F.in[I_X], (bf16*)(F.ws + WS_XB));
}
__device__ __forceinline__ void p6_reconvert(Frame& F) {
    LAS float* scr = (LAS float*)(F.lds + 4096 + F.wave * 16384);
    const int gw = F.vcu * NWAVES + F.wave, NGW = F.G * NWAVES;
    for (int it = gw; it < 16 * (2048 / 32); it += NGW) tr_matrix_item(F.in[I_WIN], INC, DM, 9280, 2048, (bf16*)(F.ws + WS_WING), 0, scr, it, F.lane);
    convert_x(F, F.in[I_X], (bf16*)(F.ws + WS_XB2));
}
__device__ __forceinline__ void p10_expert_weights(Frame& F) {
    LAS float* scr = (LAS float*)(F.lds + 4096 + F.wave * 16384);
    const int gw = F.vcu * NWAVES + F.wave, NGW = F.G * NWAVES;
    bf16* EW1 = (bf16*)(F.ws + WS_EW1); bf16* EW2 = (bf16*)(F.ws + WS_EW2);
    constexpr int PER1 = 16 * 4;
    constexpr int N1 = NEX * 2 * 2 * PER1, PER2 = 4 * 32, N2 = NEX * PER2;
    for (int it = gw; it < N1 + N2; it += NGW) {
        if (it < N1) { const int e = it / (4 * PER1), r0 = it % (4 * PER1), mat = r0 / (2 * PER1), r1 = r0 % (2 * PER1), ct = r1 / PER1, r2 = r1 % PER1;
            const float* src = (e < NE) ? F.in[mat ? I_EWU : I_EWG] + (size_t)e * DM * DEXP : F.in[mat ? I_SWU : I_SWG];
            tr_matrix_item(src, DEXP, DM, 128 * ct, 128, EW1 + (size_t)e * 512 * DM, 256 * ct + 128 * mat, scr, r2, F.lane); }
        else { const int r = it - N1, e = r / PER2, r2 = r % PER2;
            const float* src = (e < NE) ? F.in[I_EWD] + (size_t)e * DEXP * DM : F.in[I_SWD];
            tr_matrix_item(src, DM, DEXP, 0, DM, EW2 + (size_t)e * DM * DEXP, 0, scr, r2, F.lane); }
    }
}
__device__ __forceinline__ void p3_transpose(Frame& F) {
    const bf16* YT = (const bf16*)(F.ws + WS_YTHY); bf16* Y = (bf16*)(F.ws + WS_YHY);
    LAS bf16* scr = (LAS bf16*)(F.lds + F.wave * 9216);
    const int gw = F.vcu * NWAVES + F.wave, NGW = F.G * NWAVES, lane = F.lane;
    for (int tile = gw; tile < 16 * 512; tile += NGW) {
        const int c0 = (tile & 15) * 64, t0 = (tile >> 4) * 64;
#pragma unroll
        for (int p = 0; p < 8; ++p) { const int c = p * 8 + (lane >> 3), ch = lane & 7;
            const u32x4 g = *(const u32x4*)(YT + (size_t)(c0 + c) * MTOK + t0 + ch * 8);
            LAS bf16* d = scr + (ch * 8) * 72 + (c ^ (ch << 3));
            d[0 * 72] = (bf16)(g.x & 0xffff); d[1 * 72] = (bf16)(g.x >> 16); d[2 * 72] = (bf16)(g.y & 0xffff); d[3 * 72] = (bf16)(g.y >> 16);
            d[4 * 72] = (bf16)(g.z & 0xffff); d[5 * 72] = (bf16)(g.z >> 16); d[6 * 72] = (bf16)(g.w & 0xffff); d[7 * 72] = (bf16)(g.w >> 16); }
        LDS_WAIT(); asm volatile("" ::: "memory");
#pragma unroll
        for (int p = 0; p < 8; ++p) { const int tk = p * 8 + (lane >> 3), ch = lane & 7;
            const u32x4 v = *(const LAS u32x4*)(scr + tk * 72 + ((ch ^ ((tk >> 3) & 7)) << 3));
            *(u32x4*)(Y + (size_t)(t0 + tk) * DM + c0 + ch * 8) = v; }
        LDS_WAIT(); asm volatile("" ::: "memory");
    }
}

constexpr int HY_LDU = 2064, HY_KCS = 4128, HY_U_BYTES = 16 * HY_LDU * 2, HY_KC_BYTES = 8 * HY_KCS * 2;

__device__ __forceinline__ void hy_build_kc(LAS bf16* KC, const bf16* kern, int tid) {
    const u32x4 cur = *(const u32x4*)(kern + 8 * tid);
    u32x4 prv = {0u, 0u, 0u, 0u};
    if (tid > 0) prv = *(const u32x4*)(kern + 8 * tid - 8);
    const unsigned E[9] = {prv.x, prv.y, prv.z, prv.w, cur.x, cur.y, cur.z, cur.w, 0u};
#pragma unroll
    for (int fl = 0; fl < 8; ++fl) { const int sft = 8 - fl, k = sft >> 1;
        u32x4 o;
        if (sft & 1) { o.x = __builtin_amdgcn_alignbit(E[k + 1], E[k], 16); o.y = __builtin_amdgcn_alignbit(E[k + 2], E[k + 1], 16);
                       o.z = __builtin_amdgcn_alignbit(E[k + 3], E[k + 2], 16); o.w = __builtin_amdgcn_alignbit(E[k + 4], E[k + 3], 16); }
        else { o.x = E[k]; o.y = E[k + 1]; o.z = E[k + 2]; o.w = E[k + 3]; }
        *(LAS u32x4*)(KC + fl * HY_KCS + 8 * tid) = o; }
}
__device__ __forceinline__ f32x4 hy_short4(const bf16* prow, int t0, float w0, float w1, float w2, float cb) {
    const u32x2 g = *(const u32x2*)(prow + t0);
    const float p0 = bflo(g.x), p1 = bfhi(g.x), p2 = bflo(g.y), p3 = bfhi(g.y);
    const float pm = (t0 > 0) ? bf2f(prow[t0 - 1]) : 0.f, pp = (t0 + 4 < SEQ) ? bf2f(prow[t0 + 4]) : 0.f;
    f32x4 r; r[0] = cb + w0 * pm + w1 * p0 + w2 * p1; r[1] = cb + w0 * p0 + w1 * p1 + w2 * p2; r[2] = cb + w0 * p1 + w1 * p2 + w2 * p3; r[3] = cb + w0 * p2 + w1 * p3 + w2 * pp;
    return r;
}
__device__ __forceinline__ f32x4 hy_conv4(const u32x2 g, float pm, float pp, float w0, float w1, float w2, float cb) {
    const float p0 = bflo(g.x), p1 = bfhi(g.x), p2 = bflo(g.y), p3 = bfhi(g.y);
    f32x4 r; r[0] = cb + w0 * pm + w1 * p0 + w2 * p1; r[1] = cb + w0 * p0 + w1 * p1 + w2 * p2; r[2] = cb + w0 * p1 + w1 * p2 + w2 * p3; r[3] = cb + w0 * p2 + w1 * p3 + w2 * pp;
    return r;
}
__device__ __forceinline__ void hyena_phase(Frame& F) {
    LAS bf16* U = (LAS bf16*)(F.lds); LAS bf16* KC = (LAS bf16*)(F.lds + HY_U_BYTES);
    const bf16* PT = (const bf16*)(F.ws + WS_PTHY); const bf16* KERN = (const bf16*)(F.ws + WS_KERN); bf16* YT = (bf16*)(F.ws + WS_YTHY);
    const float* cw = F.in[I_HCW]; const float* cbv = F.in[I_HCB]; const float* hb = F.in[I_HBIAS];
    const int tid = F.tid, lane = F.lane, w = F.wave, fr = lane & 15, fq = lane >> 4;
    for (int c = F.vcu; c < DM; c += F.G) {
        hy_build_kc(KC, KERN + ((size_t)c * 2 + 0) * 4096, tid);
        { const int vc = 2048 + c; const float w0 = cw[0 * HYC + vc], w1 = cw[1 * HYC + vc], w2 = cw[2 * HYC + vc], cb = cbv[vc];
          const bf16* prow = PT + (size_t)vc * MTOK;
          u32x4 um[8]; unsigned short upm[8], upp[8];
#pragma unroll
          for (int it = 0; it < 8; ++it) { const int idx = tid + 512 * it, b = idx >> 8, t8 = (idx & 255) * 8; const bf16* pr = prow + (size_t)b * SEQ;
              um[it] = *(const u32x4*)(pr + t8); upm[it] = pr[t8 > 0 ? t8 - 1 : 0]; upp[it] = pr[t8 + 8 < SEQ ? t8 + 8 : SEQ - 1]; }
#pragma unroll
          for (int it = 0; it < 8; ++it) { const int idx = tid + 512 * it, b = idx >> 8, t8 = (idx & 255) * 8;
              const float pm = t8 > 0 ? bf2f(upm[it]) : 0.f, pp = t8 + 8 < SEQ ? bf2f(upp[it]) : 0.f;
              u32x2 g0; g0.x = um[it].x; g0.y = um[it].y; u32x2 g1v; g1v.x = um[it].z; g1v.y = um[it].w;
              const f32x4 lo = hy_conv4(g0, pm, bflo(um[it].z), w0, w1, w2, cb), hi = hy_conv4(g1v, bfhi(um[it].y), pp, w0, w1, w2, cb);
              u32x4 o; o.x = pk2(lo[0], lo[1]); o.y = pk2(lo[2], lo[3]); o.z = pk2(hi[0], hi[1]); o.w = pk2(hi[2], hi[3]);
              *(LAS u32x4*)(U + b * HY_LDU + t8) = o; } }
        __syncthreads();
#pragma unroll 1
        for (int o = 0; o < 2; ++o) {
            f32x4 acc[16];
#pragma unroll
            for (int i = 0; i < 16; ++i) acc[i] = (f32x4){0.f, 0.f, 0.f, 0.f};
            const LAS bf16* kbase = KC + (fr & 7) * HY_KCS + 2048 + 8 * fq - 8 * (fr >> 3) - 256 * w;
            const LAS bf16* ubase = U + fr * HY_LDU + 8 * fq;
            bf16x8 win[16];
#pragma unroll
            for (int i = 0; i < 16; ++i) win[i] = *(const LAS bf16x8*)(kbase - 16 * i);
            bf16x8 bnx = *(const LAS bf16x8*)(ubase);
#pragma unroll 1
            for (int sj8 = 0; sj8 < 64; sj8 += 8) {
#pragma unroll
                for (int u = 0; u < 8; ++u) { const int sj = sj8 + u;
                    const bf16x8 bfr = bnx;
                    bnx = *(const LAS bf16x8*)(ubase + 32 * ((sj + 1) & 63));
#pragma unroll
                    for (int t2 = 2; t2 < 18; ++t2) { const int tt = t2 & 15;
                        acc[tt] = __builtin_amdgcn_mfma_f32_16x16x32_bf16(win[(tt - 2 * u) & 15], bfr, acc[tt], 0, 0, 0); }
                    win[(14 - 2 * u) & 15] = *(const LAS bf16x8*)(kbase + 16 * (2 * sj + 2));
                    win[(15 - 2 * u) & 15] = *(const LAS bf16x8*)(kbase + 16 * (2 * sj + 1));
                } }
            const float hbias = hb[o * DM + c];
            const int gc = (o == 0) ? c : 1024 + c;
            const float w0 = cw[0 * HYC + gc], w1 = cw[1 * HYC + gc], w2 = cw[2 * HYC + gc], cb = cbv[gc];
            const bf16* grow = PT + (size_t)gc * MTOK + (size_t)fr * SEQ;
            u32x2 zpk[16], gm[16]; unsigned short gpm[16], gpp[16];
#pragma unroll
            for (int tt = 0; tt < 16; ++tt) { const int t0 = 256 * w + 16 * tt + 4 * fq;
                gm[tt] = *(const u32x2*)(grow + t0); gpm[tt] = grow[t0 > 0 ? t0 - 1 : 0]; gpp[tt] = grow[t0 + 4 < SEQ ? t0 + 4 : SEQ - 1]; }
#pragma unroll
            for (int tt = 0; tt < 16; ++tt) { const int t0 = 256 * w + 16 * tt + 4 * fq;
                const u32x2 uu = *(const LAS u32x2*)(U + fr * HY_LDU + t0);
                const f32x4 g = hy_conv4(gm[tt], t0 > 0 ? bf2f(gpm[tt]) : 0.f, t0 + 4 < SEQ ? bf2f(gpp[tt]) : 0.f, w0, w1, w2, cb);
                f32x4 y = acc[tt]; y[0] = g[0] * (y[0] + bflo(uu.x) * hbias); y[1] = g[1] * (y[1] + bfhi(uu.x) * hbias); y[2] = g[2] * (y[2] + bflo(uu.y) * hbias); y[3] = g[3] * (y[3] + bfhi(uu.y) * hbias);
                zpk[tt].x = pk2(y[0], y[1]); zpk[tt].y = pk2(y[2], y[3]); }
            __syncthreads();
            if (o == 0) {
#pragma unroll
                for (int tt = 0; tt < 16; ++tt) *(LAS u32x2*)(U + fr * HY_LDU + 256 * w + 16 * tt + 4 * fq) = zpk[tt];
                hy_build_kc(KC, KERN + ((size_t)c * 2 + 1) * 4096, tid);
                __syncthreads();
            } else {
                bf16* yrow = YT + (size_t)c * MTOK + (size_t)fr * SEQ + 256 * w + 4 * fq;
#pragma unroll
                for (int tt = 0; tt < 16; ++tt) *(u32x2*)(yrow + 16 * tt) = zpk[tt];
            }
        }
    }
}

__device__ __forceinline__ void ssd_conv_phase(Frame& F) {
    bf16* XBC = (bf16*)(F.ws + WS_XBC); const bf16* HALO = (const bf16*)(F.ws + WS_HALO);
    const float* scw = F.in[I_SCW]; const float* scb = F.in[I_SCB];
    const int gw = F.vcu * NWAVES + F.wave, NGW = F.G * NWAVES, lane = F.lane;
    for (int item = gw; item < BATCH * 32 * 8; item += NGW) {
        const int cb8 = item & 7, seg = (item >> 3) & 31, b = item >> 8, col = cb8 * 512 + lane * 8;
        float wk[5][8], cbv[8];
#pragma unroll
        for (int k = 0; k < 5; ++k) { const f32x4 a = *(const f32x4*)(scw + k * CONVD + col), c = *(const f32x4*)(scw + k * CONVD + col + 4);
#pragma unroll
            for (int e = 0; e < 4; ++e) { wk[k][e] = a[e]; wk[k][4 + e] = c[e]; } }
        { const f32x4 a = *(const f32x4*)(scb + col), c = *(const f32x4*)(scb + col + 4);
#pragma unroll
          for (int e = 0; e < 4; ++e) { cbv[e] = a[e]; cbv[4 + e] = c[e]; } }
        bf16* xrow0 = XBC + ((size_t)b * SEQ + seg * 64) * CONVD + col;
        const bf16* hlo = HALO + ((size_t)(b * 33 + seg) * 4) * CONVD + col;
        const bf16* hhi = HALO + ((size_t)(b * 33 + seg + 1) * 4 + 2) * CONVD + col;
        const u32x4 zero4 = {0u, 0u, 0u, 0u};
        u32x4 W[12];
        W[0] = seg > 0 ? *(const u32x4*)(hlo) : zero4; W[1] = seg > 0 ? *(const u32x4*)(hlo + CONVD) : zero4;
        W[2] = *(const u32x4*)(xrow0); W[3] = *(const u32x4*)(xrow0 + CONVD);
#pragma unroll 1
        for (int blk = 0; blk < 8; ++blk) { const int r0 = 8 * blk;
#pragma unroll
            for (int i = 4; i < 12; ++i) { const int rr = r0 - 2 + i;
                if (rr < 64) W[i] = *(const u32x4*)(xrow0 + (size_t)rr * CONVD);
                else W[i] = (seg < 31) ? *(const u32x4*)(hhi + (size_t)(rr - 64) * CONVD) : zero4; }
#pragma unroll
            for (int o = 0; o < 8; ++o) { float v[8];
#pragma unroll
                for (int e = 0; e < 8; ++e) v[e] = cbv[e];
#pragma unroll
                for (int k = 0; k < 5; ++k) { const u32x4 p = W[o + k];
                    v[0] += wk[k][0] * bflo(p.x); v[1] += wk[k][1] * bfhi(p.x); v[2] += wk[k][2] * bflo(p.y); v[3] += wk[k][3] * bfhi(p.y);
                    v[4] += wk[k][4] * bflo(p.z); v[5] += wk[k][5] * bfhi(p.z); v[6] += wk[k][6] * bflo(p.w); v[7] += wk[k][7] * bfhi(p.w); }
#pragma unroll
                for (int e = 0; e < 8; ++e) v[e] = siluf_(v[e]);
                u32x4 ov; ov.x = pk2(v[0], v[1]); ov.y = pk2(v[2], v[3]); ov.z = pk2(v[4], v[5]); ov.w = pk2(v[6], v[7]);
                *(u32x4*)(xrow0 + (size_t)(r0 + o) * CONVD) = ov; }
#pragma unroll
            for (int i = 0; i < 4; ++i) W[i] = W[8 + i];
        }
    }
}

constexpr int SS_LDC = 144, SS_LDT = 80;
constexpr int SS_C = 0, SS_B = 18432, SS_BT = 36864, SS_M = 57344, SS_XD = 77824, SS_XE = 98304, SS_SB = 118784, SS_ACS = 155648, SS_DTV = 156672, SS_TOE = 157696, SS_END = 158720;
static_assert(SS_END <= MISC_OFF, "SSD LDS map");

template <int KS>
__device__ __forceinline__ f32x4 mma16(const LAS bf16* arow, const LAS bf16* brow, f32x4 acc) {
    bf16x8 a[KS], b[KS];
#pragma unroll
    for (int kk = 0; kk < KS; ++kk) { a[kk] = *(const LAS bf16x8*)(arow + 32 * kk); b[kk] = *(const LAS bf16x8*)(brow + 32 * kk); }
#pragma unroll
    for (int kk = 0; kk < KS; ++kk) acc = __builtin_amdgcn_mfma_f32_16x16x32_bf16(a[kk], b[kk], acc, 0, 0, 0);
    return acc;
}

__device__ __forceinline__ void ssd_phase(Frame& F) {
    LAS unsigned char* L = F.lds;
    LAS bf16* Cl = (LAS bf16*)(L + SS_C); LAS bf16* Bl = (LAS bf16*)(L + SS_B); LAS bf16* BT = (LAS bf16*)(L + SS_BT); LAS bf16* Ml = (LAS bf16*)(L + SS_M);
    LAS bf16* XD = (LAS bf16*)(L + SS_XD); LAS bf16* XE = (LAS bf16*)(L + SS_XE); LAS bf16* SB = (LAS bf16*)(L + SS_SB);
    LAS float* ACS = (LAS float*)(L + SS_ACS); LAS float* DTV = (LAS float*)(L + SS_DTV); LAS float* TOE = (LAS float*)(L + SS_TOE);
    const bf16* XBC = (const bf16*)(F.ws + WS_XBC); const float* DT = (const float*)(F.ws + WS_DT); const bf16* Zb = (const bf16*)F.out; bf16* YS = (bf16*)(F.ws + WS_YSSD);
    const float* dtb = F.in[I_DTB]; const float* alog = F.in[I_ALOG]; const float* sd = F.in[I_SD];
    const int tid = F.tid, lane = F.lane, w = F.wave, fr = lane & 15, fq = lane >> 4;
    for (int unit = F.vcu; unit < BATCH * NGRP * 2; unit += F.G) {
        const int b = unit >> 4, g = (unit >> 1) & 7, hp = unit & 1, h0 = 4 * g + 2 * hp;
#pragma unroll 1
        for (int dir = 0; dir < 2; ++dir) {
            const float dtbias = (w < 2) ? dtb[dir * 32 + h0 + w] : 0.f, aexp = (w < 2) ? __expf(alog[dir * 32 + h0 + w]) : 0.f;
            auto scan = [&](int buf, float raw) {
                raw += dtbias; const float dtv = raw > 20.f ? raw : log1pf(__expf(raw)); float a = -dtv * aexp;
#pragma unroll
                for (int o = 1; o < 64; o <<= 1) { const float v = __shfl_up(a, o); if (lane >= o) a += v; }
                const float tot = __shfl(a, 63); const int ix = (buf * 2 + w) * 64 + lane;
                ACS[ix] = a; DTV[ix] = dtv; TOE[ix] = __expf(tot - a); };
            auto dtload = [&](int ci) -> float { const int ch = dir ? 31 - ci : ci, r = dir ? 63 - lane : lane;
                return DT[((size_t)b * SEQ + 64 * ch + r) * 64 + dir * 32 + h0 + w]; };
            auto rowload = [&](int ci, int it, int tl) -> u32x4 { const int cg = (tl >> 6) + 8 * it, l = tl & 63, ch = dir ? 31 - ci : ci, r = dir ? 63 - l : l, lc0 = cg * 8;
                const int col = lc0 < 128 ? 64 * h0 + lc0 : (lc0 < 256 ? 2048 + 128 * g + (lc0 - 128) : 3072 + 128 * g + (lc0 - 256));
                return *(const u32x4*)(XBC + ((size_t)b * SEQ + 64 * ch + r) * CONVD + col); };
            f32x4 Sacc[8];
#pragma unroll
            for (int i = 0; i < 8; ++i) Sacc[i] = (f32x4){0.f, 0.f, 0.f, 0.f};
            const float dsk = sd[h0 + (w >> 2)];
            __syncthreads();
            for (int i = tid; i < 2 * 64 * SS_LDC / 2; i += NTHR) ((LAS unsigned*)SB)[i] = 0u;
            float dtn = 0.f;
            if (w < 2) { scan(0, dtload(0)); dtn = dtload(1); }
            u32x4 pf[6];
#pragma unroll
            for (int it = 0; it < 6; ++it) pf[it] = rowload(0, it, tid);
            __syncthreads();
#pragma unroll 1
            for (int ci = 0; ci < 32; ++ci) {
                const int ch = dir ? 31 - ci : ci, buf = ci & 1;
                const size_t tokbase = (size_t)b * SEQ + 64 * ch;
                int tl = tid; asm volatile("" : "+v"(tl));
                const LAS float* acs = ACS + buf * 128; const LAS float* dtv = DTV + buf * 128; const LAS float* toe = TOE + buf * 128;
#pragma unroll
                for (int it = 0; it < 6; ++it) { const int cg = (tl >> 6) + 8 * it, l = tl & 63; const u32x4 p = pf[it];
                    if (it < 2) { const int hh = cg >> 3, p0 = (cg & 7) * 8; const float d = dtv[hh * 64 + l], de = d * toe[hh * 64 + l];
                        const float v[8] = {bflo(p.x), bfhi(p.x), bflo(p.y), bfhi(p.y), bflo(p.z), bfhi(p.z), bflo(p.w), bfhi(p.w)};
#pragma unroll
                        for (int e = 0; e < 8; ++e) { XD[(hh * 64 + p0 + e) * SS_LDT + l] = (bf16)f2bf(v[e] * d); XE[(hh * 64 + p0 + e) * SS_LDT + l] = (bf16)f2bf(v[e] * de); } }
                    else if (it < 4) { const int n0 = (cg - 16) * 8; *(LAS u32x4*)(Bl + l * SS_LDC + n0) = p;
                        LAS bf16* d = BT + n0 * SS_LDT + l;
                        d[0 * SS_LDT] = (bf16)(p.x & 0xffff); d[1 * SS_LDT] = (bf16)(p.x >> 16); d[2 * SS_LDT] = (bf16)(p.y & 0xffff); d[3 * SS_LDT] = (bf16)(p.y >> 16);
                        d[4 * SS_LDT] = (bf16)(p.z & 0xffff); d[5 * SS_LDT] = (bf16)(p.z >> 16); d[6 * SS_LDT] = (bf16)(p.w & 0xffff); d[7 * SS_LDT] = (bf16)(p.w >> 16); }
                    else { const int n0 = (cg - 32) * 8; *(LAS u32x4*)(Cl + l * SS_LDC + n0) = p; } }
                if (ci + 1 < 32) {
#pragma unroll
                    for (int it = 0; it < 6; ++it) pf[it] = rowload(ci + 1, it, tl); }
                __syncthreads();
                const int hh = w >> 2, li = w & 3, lrow = 16 * li + fr;
                const int rloc = dir ? 63 - lrow : lrow; const size_t tok = tokbase + rloc;
                u32x2 pv[4], zv[4];
                if (dir) {
#pragma unroll
                    for (int pi = 0; pi < 4; ++pi) { const size_t o = tok * DSSM + 64 * (h0 + hh) + 16 * pi + 4 * fq; pv[pi] = *(const u32x2*)(YS + o); zv[pi] = *(const u32x2*)(Zb + o); } }
#pragma unroll
                for (int q = 0; q < 2; ++q) { const int id = 2 * w + q, si = id >> 2, lj = id & 3, l = 16 * lj + fr, s0 = 16 * si + 4 * fq;
                    u32x2 m0 = {0u, 0u}, m1 = {0u, 0u};
                    if (si <= lj) { f32x4 cb = (f32x4){0.f, 0.f, 0.f, 0.f};
                        cb = mma16<4>(Bl + (16 * si + fr) * SS_LDC + 8 * fq, Cl + (16 * lj + fr) * SS_LDC + 8 * fq, cb);
                        const float a0 = acs[l], a1 = acs[64 + l]; float x0[4], x1[4];
#pragma unroll
                        for (int j = 0; j < 4; ++j) { const int s = s0 + j; x0[j] = (s <= l) ? cb[j] * __expf(a0 - acs[s]) : 0.f; x1[j] = (s <= l) ? cb[j] * __expf(a1 - acs[64 + s]) : 0.f; }
                        m0.x = pk2(x0[0], x0[1]); m0.y = pk2(x0[2], x0[3]); m1.x = pk2(x1[0], x1[1]); m1.y = pk2(x1[2], x1[3]); }
                    *(LAS u32x2*)(Ml + (0 * 64 + l) * SS_LDT + s0) = m0; *(LAS u32x2*)(Ml + (1 * 64 + l) * SS_LDT + s0) = m1; }
                f32x4 Y[4];
                { bf16x8 cfr[4];
#pragma unroll
                  for (int kk = 0; kk < 4; ++kk) cfr[kk] = *(const LAS bf16x8*)(Cl + lrow * SS_LDC + 8 * fq + 32 * kk);
#pragma unroll
                  for (int pi = 0; pi < 4; ++pi) { Y[pi] = (f32x4){0.f, 0.f, 0.f, 0.f}; const LAS bf16* ar = SB + (hh * 64 + 16 * pi + fr) * SS_LDC + 8 * fq;
#pragma unroll
                      for (int kk = 0; kk < 4; ++kk) Y[pi] = __builtin_amdgcn_mfma_f32_16x16x32_bf16(*(const LAS bf16x8*)(ar + 32 * kk), cfr[kk], Y[pi], 0, 0, 0); } }
                __syncthreads();
                { const float el = __expf(acs[hh * 64 + lrow]);
                  const float dinv = __builtin_amdgcn_rcpf(dtv[hh * 64 + lrow]);
                  const bf16x8 mf0 = *(const LAS bf16x8*)(Ml + (hh * 64 + lrow) * SS_LDT + 8 * fq), mf1 = *(const LAS bf16x8*)(Ml + (hh * 64 + lrow) * SS_LDT + 8 * fq + 32);
#pragma unroll
                  for (int pi = 0; pi < 4; ++pi) { Y[pi] = Y[pi] * el; const LAS bf16* ar = XD + (hh * 64 + 16 * pi + fr) * SS_LDT + 8 * fq;
                      Y[pi] = __builtin_amdgcn_mfma_f32_16x16x32_bf16(*(const LAS bf16x8*)(ar), mf0, Y[pi], 0, 0, 0);
                      Y[pi] = __builtin_amdgcn_mfma_f32_16x16x32_bf16(*(const LAS bf16x8*)(ar + 32), mf1, Y[pi], 0, 0, 0);
                      const int p0 = 16 * pi + 4 * fq; bf16* yp = YS + tok * DSSM + 64 * (h0 + hh) + p0; f32x4 y = Y[pi];
                      if (dir == 0) {
#pragma unroll
                          for (int j = 0; j < 4; ++j) y[j] += dsk * dinv * bf2f(XD[(hh * 64 + p0 + j) * SS_LDT + lrow]);
                      } else { const u32x2 pvv = pv[pi], zvv = zv[pi];
                          y[0] = (y[0] + bflo(pvv.x)) * siluf_(bflo(zvv.x)); y[1] = (y[1] + bfhi(pvv.x)) * siluf_(bfhi(zvv.x)); y[2] = (y[2] + bflo(pvv.y)) * siluf_(bflo(zvv.y)); y[3] = (y[3] + bfhi(pvv.y)) * siluf_(bfhi(zvv.y)); }
                      u32x2 o; o.x = pk2(y[0], y[1]); o.y = pk2(y[2], y[3]); *(u32x2*)yp = o; } }
                { const int pi = w & 3; const float dec = __expf(acs[hh * 64 + 63]);
                  const bf16x8 xf0 = *(const LAS bf16x8*)(XE + (hh * 64 + 16 * pi + fr) * SS_LDT + 8 * fq), xf1 = *(const LAS bf16x8*)(XE + (hh * 64 + 16 * pi + fr) * SS_LDT + 8 * fq + 32);
#pragma unroll
                  for (int ni = 0; ni < 8; ++ni) { Sacc[ni] = Sacc[ni] * dec; const LAS bf16* ar = BT + (16 * ni + fr) * SS_LDT + 8 * fq;
                      Sacc[ni] = __builtin_amdgcn_mfma_f32_16x16x32_bf16(*(const LAS bf16x8*)(ar), xf0, Sacc[ni], 0, 0, 0);
                      Sacc[ni] = __builtin_amdgcn_mfma_f32_16x16x32_bf16(*(const LAS bf16x8*)(ar + 32), xf1, Sacc[ni], 0, 0, 0);
                      u32x2 o; o.x = pk2(Sacc[ni][0], Sacc[ni][1]); o.y = pk2(Sacc[ni][2], Sacc[ni][3]);
                      *(LAS u32x2*)(SB + (hh * 64 + 16 * pi + fr) * SS_LDC + 16 * ni + 4 * fq) = o; } }
                if (w < 2 && ci + 1 < 32) { scan(buf ^ 1, dtn); if (ci + 2 < 32) dtn = dtload(ci + 2); }
                __syncthreads();
            }
        }
    }
}

__device__ __forceinline__ void ssd_norm_phase(Frame& F) {
    bf16* YS = (bf16*)(F.ws + WS_YSSD); const float* nw = F.in[I_SNW];
    const int gw = F.vcu * NWAVES + F.wave, NGW = F.G * NWAVES, lane = F.lane;
    for (int m = gw; m < MTOK; m += NGW) { bf16* row = YS + (size_t)m * DSSM + lane * 32;
        u32x4 v[4]; float ss = 0.f;
#pragma unroll
        for (int j = 0; j < 4; ++j) { v[j] = *(const u32x4*)(row + 8 * j);
            const float a0 = bflo(v[j].x), a1 = bfhi(v[j].x), a2 = bflo(v[j].y), a3 = bfhi(v[j].y), a4 = bflo(v[j].z), a5 = bfhi(v[j].z), a6 = bflo(v[j].w), a7 = bfhi(v[j].w);
            ss += (a0 * a0 + a1 * a1) + (a2 * a2 + a3 * a3) + (a4 * a4 + a5 * a5) + (a6 * a6 + a7 * a7); }
        ss += __shfl_xor(ss, 1); ss += __shfl_xor(ss, 2); ss += __shfl_xor(ss, 4);
        const float rs = 1.0f / sqrtf(ss * (1.0f / 256.0f) + RMS_EPS);
#pragma unroll
        for (int j = 0; j < 4; ++j) { const f32x4 w0 = *(const f32x4*)(nw + lane * 32 + 8 * j), w1 = *(const f32x4*)(nw + lane * 32 + 8 * j + 4);
            u32x4 o; o.x = pk2(bflo(v[j].x) * rs * w0[0], bfhi(v[j].x) * rs * w0[1]); o.y = pk2(bflo(v[j].y) * rs * w0[2], bfhi(v[j].y) * rs * w0[3]);
            o.z = pk2(bflo(v[j].z) * rs * w1[0], bfhi(v[j].z) * rs * w1[1]); o.w = pk2(bflo(v[j].w) * rs * w1[2], bfhi(v[j].w) * rs * w1[3]);
            *(u32x4*)(row + 8 * j) = o; } }
}

constexpr int RT_WC = 131072;
__device__ __forceinline__ void ln1_router_phase(Frame& F) {
    float* H1 = (float*)(F.ws + WS_H1); bf16* H1B = (bf16*)(F.ws + WS_H1B);
    int* TOK = (int*)(F.ws + WS_TOK); float* WGT = (float*)(F.ws + WS_WGT); int* ASG = (int*)(F.ws + WS_ASG);
    const float* g1 = F.in[I_LN1G]; const float* b1 = F.in[I_LN1B]; const float* rw = F.in[I_RW]; const float* rb = F.in[I_RB];
    LAS float* hrow = (LAS float*)(F.lds + F.wave * 16384);
    LAS float* wc = (LAS float*)(F.lds + RT_WC);
    const int lane = F.lane, tid = F.tid;
    f32x4 gv[4], bv[4];
#pragma unroll
    for (int j = 0; j < 4; ++j) { gv[j] = *(const f32x4*)(g1 + 4 * lane + 256 * j); bv[j] = *(const f32x4*)(b1 + 4 * lane + 256 * j); }
    const float rbias = rb[lane];
    for (int step = F.vcu; step < MTOK / 32; step += F.G) {
        const int rg = step * 8 + F.wave;
        f32x4 nx0 = *(const f32x4*)(rw + tid * 4), nx1 = *(const f32x4*)(rw + 2048 + tid * 4);
#pragma unroll 1
        for (int r = 0; r < 4; ++r) { const size_t m = (size_t)rg * 4 + r; float* xr = H1 + m * DM;
            f32x4 v[4]; float s = 0.f;
#pragma unroll
            for (int j = 0; j < 4; ++j) { v[j] = *(const f32x4*)(xr + 4 * lane + 256 * j); s += (v[j][0] + v[j][1]) + (v[j][2] + v[j][3]); }
            const float mean = wave_sum(s) * (1.f / DM); float s2 = 0.f;
#pragma unroll
            for (int j = 0; j < 4; ++j) { v[j] = v[j] - mean; s2 += (v[j][0] * v[j][0] + v[j][1] * v[j][1]) + (v[j][2] * v[j][2] + v[j][3] * v[j][3]); }
            const float rstd = 1.f / sqrtf(wave_sum(s2) * (1.f / DM) + LN_EPS);
#pragma unroll
            for (int j = 0; j < 4; ++j) { const f32x4 h = v[j] * rstd * gv[j] + bv[j];
                *(f32x4*)(xr + 4 * lane + 256 * j) = h * DN_ALPHA;
                u32x2 o; o.x = pk2(h[0], h[1]); o.y = pk2(h[2], h[3]); *(u32x2*)(H1B + m * DM + 4 * lane + 256 * j) = o;
                *(LAS f32x4*)(hrow + r * 1024 + 4 * lane + 256 * j) = h; } }
        float lg[4] = {0.f, 0.f, 0.f, 0.f};
#pragma unroll 1
        for (int kc = 0; kc < 16; ++kc) {
            __syncthreads();
            *(LAS f32x4*)(wc + tid * 4) = nx0; *(LAS f32x4*)(wc + 2048 + tid * 4) = nx1;
            if (kc + 1 < 16) { nx0 = *(const f32x4*)(rw + (kc + 1) * 4096 + tid * 4); nx1 = *(const f32x4*)(rw + (kc + 1) * 4096 + 2048 + tid * 4); }
            __syncthreads();
#pragma unroll 4
            for (int kk = 0; kk < 64; kk += 4) {
                const float w0 = wc[(kk + 0) * 64 + lane], w1 = wc[(kk + 1) * 64 + lane], w2 = wc[(kk + 2) * 64 + lane], w3 = wc[(kk + 3) * 64 + lane];
#pragma unroll
                for (int r = 0; r < 4; ++r) { const f32x4 h = *(const LAS f32x4*)(hrow + r * 1024 + kc * 64 + kk); lg[r] += h[0] * w0 + h[1] * w1 + h[2] * w2 + h[3] * w3; } }
        }
#pragma unroll 1
        for (int r = 0; r < 4; ++r) { const int m = rg * 4 + r;
            const float score = 1.0f / (1.0f + expf(-lg[r])), biased = score + rbias;
            float m1 = biased; m1 = fmaxf(m1, __shfl_xor(m1, 1)); m1 = fmaxf(m1, __shfl_xor(m1, 2)); m1 = fmaxf(m1, __shfl_xor(m1, 4));
            const unsigned long long eq = __ballot(biased == m1); const int gbase = lane & ~7; const int first = gbase + __ffs((unsigned)((eq >> gbase) & 0xffull)) - 1;
            float v2 = (lane == first) ? -INFINITY : biased; v2 = fmaxf(v2, __shfl_xor(v2, 1)); v2 = fmaxf(v2, __shfl_xor(v2, 2)); v2 = fmaxf(v2, __shfl_xor(v2, 4));
            const float gs = m1 + v2; const int g = lane >> 3; int better = 0;
#pragma unroll
            for (int d = 1; d < 8; ++d) { const int g2 = (g + d) & 7; const float og = __shfl(gs, g2 * 8); better += (og > gs || (og == gs && g2 < g)) ? 1 : 0; }
            float masked = (better < 4) ? biased : -INFINITY; bool sel = false;
#pragma unroll 1
            for (int it = 0; it < TOPK; ++it) { const float mx = wave_max(masked); const unsigned long long bm = __ballot(masked == mx); const int win = __ffsll((long long)bm) - 1;
                if (lane == win) { sel = true; masked = -INFINITY; } }
            const float sw = wave_sum(sel ? score : 0.f);
            const unsigned long long selm = __ballot(sel);
            if (sel) { const unsigned pos = __hip_atomic_fetch_add((unsigned*)(F.ctl + CW_CNT + 64 * lane), 1u, __ATOMIC_RELAXED, __HIP_MEMORY_SCOPE_AGENT);
                TOK[(size_t)lane * MTOK + pos] = m; WGT[(size_t)lane * MTOK + pos] = score / sw * ROUTED_SCALE;
                ASG[(size_t)m * 8 + __popcll(selm & ((1ull << lane) - 1ull))] = lane * MTOK + (int)pos; } }
    }
}
constexpr int MOE_TP = 131072 + 1024, MOE_CNT = MOE_TP + 512;
__device__ __forceinline__ int moe_table(Frame& F) {
    LAS int* tp = (LAS int*)(F.lds + MOE_TP); LAS int* cnt = (LAS int*)(F.lds + MOE_CNT);
    __syncthreads();
    if (F.tid == 0) { int run = 0;
        for (int e = 0; e < NEX; ++e) { const int c = (e < NE) ? (int)__hip_atomic_load((unsigned*)(F.ctl + CW_CNT + 64 * e), __ATOMIC_RELAXED, __HIP_MEMORY_SCOPE_AGENT) : MTOK;
            cnt[e] = c; tp[e] = run; run += (c + 255) >> 8; }
        tp[NEX] = run; }
    __syncthreads();
    return tp[NEX];
}
__device__ __forceinline__ void fp8x8_fma(f32x4& a0, f32x4& a1, const u32x2 v, const float w) {
    const f32x2 p0 = __builtin_amdgcn_cvt_pk_f32_fp8((int)v.x, false), p1 = __builtin_amdgcn_cvt_pk_f32_fp8((int)v.x, true);
    const f32x2 p2 = __builtin_amdgcn_cvt_pk_f32_fp8((int)v.y, false), p3 = __builtin_amdgcn_cvt_pk_f32_fp8((int)v.y, true);
    a0[0] += w * p0.x; a0[1] += w * p0.y; a0[2] += w * p1.x; a0[3] += w * p1.y; a1[0] += w * p2.x; a1[1] += w * p2.y; a1[2] += w * p3.x; a1[3] += w * p3.y;
}
template <bool LAST>
__device__ __forceinline__ void moe_combine_phase(Frame& F, int p) {
    float* H1 = (float*)(F.ws + WS_H1); const unsigned char* YQ = (const unsigned char*)(F.ws + WS_YQ); const int* ASG = (const int*)(F.ws + WS_ASG); const float* WGT = (const float*)(F.ws + WS_WGT);
    const LAS int* tp = (const LAS int*)(F.lds + MOE_TP);
    const float* g2 = F.in[I_LN2G]; const float* b2 = F.in[I_LN2B];
    const int gw = F.vcu * NWAVES + F.wave, NGW = F.G * NWAVES, lane = F.lane;
    const size_t shbase = (size_t)tp[NE] * 256;
    for (int m = gw; m < MTOK; m += NGW) {
        int li = 0; if (lane < 8) li = ASG[(size_t)m * 8 + lane];
        float wk = 0.f; if (lane < 8) wk = WGT[li];
        const int e = li >> 15, pos = li & 32767; const int slot = 256 * tp[e] + pos;
        float* hp = H1 + (size_t)m * DM + 512 * p + 8 * lane;
        f32x4 a0 = *(const f32x4*)hp, a1 = *(const f32x4*)(hp + 4);
        u32x2 vv[9];
        vv[8] = *(const u32x2*)(YQ + (shbase + m) * 512 + 8 * lane);
#pragma unroll
        for (int k = 0; k < 8; ++k) { const int sk = __shfl(slot, k); vv[k] = *(const u32x2*)(YQ + (size_t)sk * 512 + 8 * lane); }
        fp8x8_fma(a0, a1, vv[8], 1.0f);
#pragma unroll
        for (int k = 0; k < 8; ++k) fp8x8_fma(a0, a1, vv[k], __shfl(wk, k));
        if (!LAST) { *(f32x4*)hp = a0; *(f32x4*)(hp + 4) = a1; }
        else { const float* xr = H1 + (size_t)m * DM + 8 * lane; f32x4 v[4]; float s = 0.f;
            v[0] = *(const f32x4*)xr; v[1] = *(const f32x4*)(xr + 4); v[2] = a0; v[3] = a1;
#pragma unroll
            for (int j = 0; j < 4; ++j) s += (v[j][0] + v[j][1]) + (v[j][2] + v[j][3]);
            const float mean = wave_sum(s) * (1.f / DM); float s2 = 0.f;
#pragma unroll
            for (int j = 0; j < 4; ++j) { v[j] = v[j] - mean; s2 += (v[j][0] * v[j][0] + v[j][1] * v[j][1]) + (v[j][2] * v[j][2] + v[j][3] * v[j][3]); }
            const float rstd = 1.f / sqrtf(wave_sum(s2) * (1.f / DM) + LN_EPS);
#pragma unroll
            for (int j = 0; j < 4; ++j) { const int c = (j >> 1) * 512 + 8 * lane + 4 * (j & 1); const f32x4 gv = *(const f32x4*)(g2 + c), bv = *(const f32x4*)(b2 + c);
                *(f32x4*)(F.out + (size_t)m * DM + c) = v[j] * rstd * gv + bv; } }
    }
}
__device__ __forceinline__ void ln2_phase(Frame& F) {
    const float* H1 = (const float*)(F.ws + WS_H1); const float* g2 = F.in[I_LN2G]; const float* b2 = F.in[I_LN2B];
    const int gw = F.vcu * NWAVES + F.wave, NGW = F.G * NWAVES, lane = F.lane;
    f32x4 gv[4], bv[4];
#pragma unroll
    for (int j = 0; j < 4; ++j) { gv[j] = *(const f32x4*)(g2 + 4 * lane + 256 * j); bv[j] = *(const f32x4*)(b2 + 4 * lane + 256 * j); }
    for (int m = gw; m < MTOK; m += NGW) { const float* xr = H1 + (size_t)m * DM;
        f32x4 v[4]; float s = 0.f;
#pragma unroll
        for (int j = 0; j < 4; ++j) { v[j] = *(const f32x4*)(xr + 4 * lane + 256 * j); s += (v[j][0] + v[j][1]) + (v[j][2] + v[j][3]); }
        const float mean = wave_sum(s) * (1.f / DM); float s2 = 0.f;
#pragma unroll
        for (int j = 0; j < 4; ++j) { v[j] = v[j] - mean; s2 += (v[j][0] * v[j][0] + v[j][1] * v[j][1]) + (v[j][2] * v[j][2] + v[j][3] * v[j][3]); }
        const float rstd = 1.f / sqrtf(wave_sum(s2) * (1.f / DM) + LN_EPS);
#pragma unroll
        for (int j = 0; j < 4; ++j) *(f32x4*)(F.out + (size_t)m * DM + 4 * lane + 256 * j) = v[j] * rstd * gv[j] + bv[j]; }
}

#ifndef MK_N_LAUNCHES
#define MK_N_LAUNCHES 1
#endif
constexpr int NPH = 15;
constexpr int N_LAUNCHES = MK_N_LAUNCHES;

__global__ void __launch_bounds__(NTHR, 2) fwd_kernel(Args args) {
    extern __shared__ __attribute__((aligned(16))) unsigned char lds_raw[];
    Frame F;
    F.lds = (LAS unsigned char*)lds_raw;
    F.MISC = (volatile LAS unsigned*)(F.lds + MISC_OFF);
    F.tid = threadIdx.x; F.lane = F.tid & 63; F.wave = __builtin_amdgcn_readfirstlane(F.tid >> 6);
    F.G = gridDim.x; { const int bx = blockIdx.x; F.vcu = (F.G % 8 == 0) ? (bx % 8) * (F.G / 8) + bx / 8 : bx; }
    F.ws = args.ws; F.ctl = (gu32*)(args.ws + WS_CTL); F.in = args.in; F.out = args.out;
    for (int u = F.tid; u < (LDS_BYTES - MISC_OFF) / 4; u += NTHR) ((LAS unsigned*)(F.lds + MISC_OFF))[u] = 0u;
    __syncthreads();
    XcdBarrier bar; bar.bar = (unsigned*)(F.ctl + CW_BAR); bar.x = 0; bar.st = nullptr;
    if (N_LAUNCHES != NPH) bar = xcd_barrier_post((unsigned*)(F.ctl + CW_BAR), F.MISC + 8);
    const int lo = args.ph_lo, hi = args.ph_hi;
#ifndef PH_MASK
#define PH_MASK 0x7fff
#endif
#define IN(k) ((((PH_MASK) >> (k)) & 1) && lo <= (k) && (k) < hi)
#define SEAM(k) do { if (IN(k) && IN((k) + 1)) xcd_barrier(bar); } while (0)
#ifndef REP_MASK
#define REP_MASK 0
#endif
#define REPS(k) for (int rep_ = 0; rep_ < ((((REP_MASK) >> (k)) & 1) ? 2 : 1); ++rep_, ((((REP_MASK) >> (k)) & 1) && rep_ == 1 ? xcd_barrier(bar) : (void)0))
    const int G = F.G, bx = (int)blockIdx.x;

    if (IN(0)) REPS(0) { p0_prologue(F); } SEAM(0);
    if (IN(1)) REPS(1) {
        pg8::StaticOrder S; S.init((const bf16*)(F.ws + WS_XB), (const bf16*)(F.ws + WS_WINT), MTOK, HYC, DM, G, bx);
        pg8::EpiHyT E{(bf16*)(F.ws + WS_PTHY), F.in[I_BIN]};
        pg8::gemm_phase<pg8::EpiHyT, pg8::StaticOrder, false>(F.lds, DM, S, E);
    } SEAM(1);
    if (IN(2)) REPS(2) { hyena_phase(F); } SEAM(2);
    if (IN(3)) REPS(3) { p3_transpose(F); } SEAM(3);
    if (IN(4)) REPS(4) {
        pg8::StaticOrder S; S.init((const bf16*)(F.ws + WS_XB), (const bf16*)(F.ws + WS_WINT) + (size_t)3072 * DM, MTOK, 6400, DM, G, bx);
        pg8::EpiZXD E{(bf16*)F.out, (bf16*)(F.ws + WS_XBC), (float*)(F.ws + WS_DT), F.in[I_BIN], (bf16*)(F.ws + WS_HALO)};
        pg8::gemm_phase<pg8::EpiZXD, pg8::StaticOrder, false>(F.lds, DM, S, E);
    } SEAM(4);
    if (IN(5)) REPS(5) { ssd_conv_phase(F); } SEAM(5);
    if (IN(6)) REPS(6) { ssd_phase(F); } SEAM(6);
    if (IN(7)) REPS(7) { ssd_norm_phase(F); p6_reconvert(F); } SEAM(7);
    if (IN(8)) REPS(8) {
        pg8::StaticOrder S; S.init((const bf16*)(F.ws + WS_XB2), (const bf16*)(F.ws + WS_WING), MTOK, 2048, DM, G, bx);
        pg8::EpiBf<0> E{(bf16*)(F.ws + WS_G), 2048, F.in[I_BIN] + 9280, nullptr, 0, nullptr};
        pg8::gemm_phase<pg8::EpiBf<0>, pg8::StaticOrder, false>(F.lds, DM, S, E);
    } SEAM(8);
    if (IN(9)) REPS(9) {
        pg8::StaticOrder S; S.init((const bf16*)(F.ws + WS_YHY), (const bf16*)(F.ws + WS_WHYB), MTOK, DM, DM, G, bx);
        pg8::EpiBf<1> E{(bf16*)(F.ws + WS_MIX), DM, nullptr, (const bf16*)(F.ws + WS_G), 2048, nullptr};
        pg8::gemm_phase<pg8::EpiBf<1>, pg8::StaticOrder, false>(F.lds, DM, S, E);
    } SEAM(9);
    if (IN(10)) REPS(10) {
        pg8::StaticOrder S; S.init((const bf16*)(F.ws + WS_YSSD), (const bf16*)(F.ws + WS_WSSDB), MTOK, DM, DSSM, G, bx);
        pg8::EpiBf<2> E{(bf16*)(F.ws + WS_MIX), DM, nullptr, (const bf16*)(F.ws + WS_G) + 1024, 2048, (const bf16*)(F.ws + WS_MIX)};
        pg8::gemm_phase<pg8::EpiBf<2>, pg8::StaticOrder, false>(F.lds, DSSM, S, E);
    } SEAM(10);
    if (IN(11)) REPS(11) {
        pg8::StaticOrder S; S.init((const bf16*)(F.ws + WS_MIX), (const bf16*)(F.ws + WS_WOUT), MTOK, DM, DM, G, bx);
        pg8::EpiRes E{(float*)(F.ws + WS_H1), F.in[I_BOUT], F.in[I_X], DN_ALPHA};
        pg8::gemm_phase<pg8::EpiRes, pg8::StaticOrder, false>(F.lds, DM, S, E);
        p10_expert_weights(F);
    } SEAM(11);
    if (IN(12)) REPS(12) { ln1_router_phase(F); } SEAM(12);
    if (IN(13)) REPS(13) {
        const int total = moe_table(F);
        pg8::MoeOrder<2, true> S{(const LAS int*)(F.lds + MOE_TP), (const LAS int*)(F.lds + MOE_CNT), G, bx, total, (const char*)(F.ws + WS_H1B), (const char*)(F.ws + WS_EW1), (const int*)(F.ws + WS_TOK)};
        pg8::EpiSwiGLU E{(bf16*)(F.ws + WS_HID)};
        pg8::gemm_phase<pg8::EpiSwiGLU, pg8::MoeOrder<2, true>, true>(F.lds, DM, S, E);
    } SEAM(13);
    if (IN(14)) {
        const int total = moe_table(F);
#pragma unroll 1
        for (int p = 0; p < 2; ++p) {
            { pg8::SlotOrder2 S{(const LAS int*)(F.lds + MOE_TP), G, bx, total, p, (const char*)(F.ws + WS_HID), (const char*)(F.ws + WS_EW2)};
              pg8::EpiSlot8 E{(unsigned char*)(F.ws + WS_YQ)};
              int kd = DEXP; asm volatile("" : "+s"(kd));
              pg8::gemm_phase<pg8::EpiSlot8, pg8::SlotOrder2, false>(F.lds, kd, S, E); }
            xcd_barrier(bar);
            if (p == 0) { moe_combine_phase<false>(F, p); xcd_barrier(bar); }
            else moe_combine_phase<true>(F, p);
        }
    }
#ifdef EXTRA_BARS
    for (int xb_ = 0; xb_ < EXTRA_BARS; ++xb_) xcd_barrier(bar);
#endif
#undef IN
#undef SEAM
}

extern "C" void kernel_launch(void* const* d_in, const int* in_sizes, int n_in, void* d_out, int out_size, void* d_ws, size_t ws_size, hipStream_t stream) {
    static int grid = 0;
    if (grid == 0) {
        if (n_in != 38 || out_size != MTOK * DM || ws_size < WS_END) { fprintf(stderr, "kernel_launch: unexpected shapes (n_in %d out %d ws %zu)\n", n_in, out_size, ws_size); grid = -1; return; }
        int dev = 0, cus = 0, per_cu = 0;
        if (hipGetDevice(&dev) != hipSuccess || hipDeviceGetAttribute(&cus, hipDeviceAttributeMultiprocessorCount, dev) != hipSuccess) { grid = -1; return; }
        if (hipFuncSetAttribute((const void*)fwd_kernel, hipFuncAttributeMaxDynamicSharedMemorySize, LDS_BYTES) != hipSuccess) { fprintf(stderr, "kernel_launch: hipFuncSetAttribute failed\n"); grid = -1; return; }
        if (hipOccupancyMaxActiveBlocksPerMultiprocessor(&per_cu, (const void*)fwd_kernel, NTHR, LDS_BYTES) != hipSuccess || per_cu < 1) fprintf(stderr, "kernel_launch: occupancy query says %d\n", per_cu);
        (void)hipGetLastError();
        grid = cus;
    }
    if (grid < 0) return;
    (void)hipMemsetAsync((char*)d_ws + WS_CTL, 0, CTL_ZERO_BYTES, stream);
    Args a{};
    for (int i = 0; i < 38; ++i) a.in[i] = (const float*)d_in[i];
    a.out = (float*)d_out; a.ws = (unsigned char*)d_ws;
    for (int li = 0; li < N_LAUNCHES; ++li) {
        a.ph_lo = (N_LAUNCHES == NPH) ? li : 0; a.ph_hi = (N_LAUNCHES == NPH) ? li + 1 : NPH; a.li = li;
        hipLaunchKernelGGL(fwd_kernel, dim3(grid), dim3(NTHR), LDS_BYTES, stream, a);
    }
}
```

```cpp
#define MK_N_LAUNCHES 1
#include <hip/hip_runtime.h>
#include <cstdio>
#include <cstdint>

#define LAS __attribute__((address_space(3)))
#define GAS __attribute__((address_space(1)))
typedef unsigned short bf16;
typedef short bf16x8 __attribute__((ext_vector_type(8)));
typedef float f32x4 __attribute__((ext_vector_type(4)));
typedef float f32x2 __attribute__((ext_vector_type(2)));
typedef unsigned u32x4 __attribute__((ext_vector_type(4)));
typedef unsigned u32x2 __attribute__((ext_vector_type(2)));
typedef GAS unsigned gu32;

constexpr int BATCH = 16, SEQ = 2048, DM = 1024, MTOK = BATCH * SEQ;
constexpr int HYC = 3072, DSSM = 2048, CONVD = 4096, NHEAD = 32, NGRP = 8, NSTATE = 128, INC = 11328;
constexpr int NE = 64, TOPK = 8, DEXP = 256, NEX = NE + 1;
constexpr float DN_ALPHA = 1.189207115002721f;
constexpr float LN_EPS = 1e-5f, RMS_EPS = 1e-5f, ROUTED_SCALE = 2.5f;
constexpr int NWAVES = 8, NTHR = 512;
constexpr int WIN_ROWS = 11520;

constexpr size_t MiB = 1u << 20;
constexpr size_t WS_CTL = 0, CTL_ZERO_BYTES = 256 * 1024;
constexpr size_t WS_WHYB = 1 * MiB, WS_WSSDB = 3 * MiB, WS_WOUT = 7 * MiB;
constexpr size_t WS_XB = 9 * MiB;
constexpr size_t WS_WINT = 73 * MiB;
constexpr size_t WS_KERN = 96 * MiB;
constexpr size_t WS_PTHY = 112 * MiB;
constexpr size_t WS_YTHY = 304 * MiB;
constexpr size_t WS_YHY = 137 * MiB;
constexpr size_t WS_XBC = 201 * MiB;
constexpr size_t WS_DT = 457 * MiB;
constexpr size_t WS_HALO = 465 * MiB;
constexpr size_t WS_YSSD = 9 * MiB;
constexpr size_t WS_XB2 = 201 * MiB;
constexpr size_t WS_WING = 505 * MiB;
constexpr size_t WS_G = 269 * MiB;
constexpr size_t WS_MIX = 397 * MiB;
constexpr int H1B_PITCH = 2048;
constexpr size_t WS_EW1 = 9 * MiB;
constexpr size_t WS_EW2 = 477 * MiB;
constexpr size_t WS_YQ = 1 * MiB;
constexpr size_t WS_ASG = 510 * MiB;
constexpr size_t WS_H1P = 177 * MiB;
constexpr size_t WS_HID = 305 * MiB;
constexpr size_t WS_TOK = 461 * MiB;
constexpr size_t WS_WGT = 469 * MiB;
constexpr size_t WS_END = 511 * MiB;
constexpr size_t OUT_XB = 64 * MiB;
constexpr int CW_BAR = 4096;
constexpr int CW_CNT = 16384;
constexpr int CW_DBG = 32768;

constexpr int LDS_BYTES = 163840;
constexpr int MISC_OFF = 163840 - 512;

#define RLX_AGENT __ATOMIC_RELAXED, __HIP_MEMORY_SCOPE_AGENT
#define LDS_WAIT() asm volatile("s_waitcnt lgkmcnt(0)" ::: "memory")
#define VM_WAIT() asm volatile("s_waitcnt vmcnt(0)" ::: "memory")
typedef __bf16 bf16x2_t __attribute__((ext_vector_type(2)));
__device__ __forceinline__ unsigned pk2(float lo, float hi) { const f32x2 v = {lo, hi}; return __builtin_bit_cast(unsigned, __builtin_convertvector(v, bf16x2_t)); }
__device__ __forceinline__ unsigned f2bf(float f) { return pk2(f, 0.f) & 0xffffu; }
__device__ __forceinline__ float bf2f(unsigned b) { return __builtin_bit_cast(float, b << 16); }
__device__ __forceinline__ float bflo(unsigned w) { return __builtin_bit_cast(float, w << 16); }
__device__ __forceinline__ float bfhi(unsigned w) { return __builtin_bit_cast(float, w & 0xffff0000u); }
__device__ __forceinline__ float sigmoidf_(float v) { return __builtin_amdgcn_rcpf(1.0f + __expf(-v)); }
__device__ __forceinline__ float siluf_(float v) { return v * __builtin_amdgcn_rcpf(1.0f + __expf(-v)); }
__device__ __forceinline__ float wave_sum(float v) {
#pragma unroll
    for (int o = 1; o < 64; o <<= 1) v += __shfl_xor(v, o);
    return v;
}
__device__ __forceinline__ float wave_max(float v) {
#pragma unroll
    for (int o = 1; o < 64; o <<= 1) v = fmaxf(v, __shfl_xor(v, o));
    return v;
}

#ifndef PG8_WGM
#define PG8_WGM 8
#endif
namespace pg8 {
constexpr int BM = 256, BK = 64, HALF = 128, HTB = HALF * BK * 2, STAGE_BYTES = 8 * HTB, NXCD = 8, WGM = PG8_WGM;
__host__ __device__ __forceinline__ int lds_byte(int r, int c) { const int st = (r >> 4) * 2 + (c >> 5), rr = r & 15, cc = c & 31, ob = rr * 64 + cc * 2; return st * 1024 + (ob ^ (((ob >> 9) & 1) << 5)); }
__host__ __device__ __forceinline__ void stage_rc(int b, int& R, int& C) { const int st = b / 1024, sb = b % 1024, swz = sb ^ (((sb >> 9) & 1) << 5); R = (st >> 1) * 16 + swz / 64; C = (st & 1) * 32 + (swz % 64) / 2; }
__host__ __device__ __forceinline__ int perm32(int rho) { const int n = rho >> 4, i = rho & 15; return 8 * (i >> 2) + 4 * n + (i & 3); }

struct Unit { int pm, pn; const char* A; const char* B; int e, cnt; };

struct StaticOrder {
    int nM, nN, nwg, G, c, K; const char* A; const char* B;
    __device__ void init(const bf16* A_, const bf16* B_, int M, int N, int K_, int G_, int c_) { A = (const char*)A_; B = (const char*)B_; nM = M / BM; nN = N / BM; nwg = nM * nN; G = G_; c = c_; K = K_; }
    __device__ __forceinline__ bool next(int i, Unit& u) const {
        const long L = (long)i * G + c; if (L >= nwg) return false;
        int wgid = (int)L; { const int q = nwg / NXCD, r = nwg % NXCD, xcd = wgid % NXCD, off = wgid / NXCD; wgid = (xcd < r ? xcd * (q + 1) : r * (q + 1) + (xcd - r) * q) + off; }
        const int nig = WGM * nN, gid = wgid / nig, fm = gid * WGM, gsz = (nM - fm) < WGM ? (nM - fm) : WGM;
        u.pm = fm + ((wgid % nig) % gsz); u.pn = (wgid % nig) / gsz;
        u.A = A + (size_t)u.pm * BM * K * 2; u.B = B + (size_t)u.pn * BM * K * 2; u.e = 0; u.cnt = 0; return true;
    }
    __device__ __forceinline__ unsigned row_off(const Unit&, int) const { return 0u; }
};

__device__ __forceinline__ unsigned cvt_pk_bf16(float lo, float hi) { unsigned r; asm volatile("v_cvt_pk_bf16_f32 %0, %1, %2" : "=v"(r) : "v"(lo), "v"(hi)); return r; }

#ifndef PG8_SP2
#define PG8_SP2 true
#endif
#ifndef PG8_ALIGN
#define PG8_ALIGN true
#endif
template <class Epi, class Sched, bool GATHER, bool SP2 = PG8_SP2, bool ALIGN_EPI = PG8_ALIGN>
__device__ __forceinline__ void gemm_phase(LAS unsigned char* lds, const int K, const Sched& S, const Epi& E) {
    constexpr bool TA = Epi::TA;
    const int tid = threadIdx.x, wid = __builtin_amdgcn_readfirstlane(tid >> 6), lane = tid & 63, wr = wid >> 2, wc = wid & 3, fr = lane & 15, fq = lane >> 4;
    const int nt = K / BK;
    unsigned voffA[2][2], voffB[2]; int RA[2], CA[2];
#pragma unroll
    for (int i = 0; i < 2; ++i) { int R, C; stage_rc(tid * 16 + i * 8192, R, C); const int Rb = Epi::PERM ? ((R & ~31) + perm32(R & 31)) : R;
        RA[i] = R; CA[i] = C; voffA[0][i] = (unsigned)(R * K + C) * 2u; voffA[1][i] = voffA[0][i]; voffB[i] = (unsigned)(Rb * K + C) * 2u; }
    const size_t kstep = (size_t)(BK * 2);
    const size_t hstep = (size_t)HALF * K * 2;
    const size_t hstepA = GATHER ? 0 : hstep;
    const unsigned ldsw = (unsigned)wid * 1024u;
    const int aoff = lds_byte(wr * 64 + fr, fq * 8), boff = lds_byte(wc * 32 + fr, fq * 8);
#define PG8_SA(b, h) (((b) * 2 + (h)) * HTB)
#define PG8_SB(b, h) ((4 + (b) * 2 + (h)) * HTB)
#define PG8_STAGE(bufoff, gbase, voff) do { _Pragma("unroll") for (int _i = 0; _i < 2; ++_i) \
        __builtin_amdgcn_global_load_lds((const unsigned*)((const char*)(gbase) + (voff)[_i]), (LAS unsigned*)(lds + (bufoff) + ldsw + _i * 8192), 16, 0, 0); } while (0)
#define PG8_STAGE_A(bufoff, gbase, h) PG8_STAGE(bufoff, (gbase) + (h) * hstepA, voffA[GATHER ? (h) : 0])
#define PG8_LDA(dst, b, h) do { _Pragma("unroll") for (int m = 0; m < 4; ++m) _Pragma("unroll") for (int k = 0; k < 2; ++k) dst[m][k] = *(const LAS bf16x8*)(lds + PG8_SA(b, h) + aoff + m * 2048 + k * 1024); } while (0)
#define PG8_LDB(dst, b, h) do { _Pragma("unroll") for (int n = 0; n < 2; ++n) _Pragma("unroll") for (int k = 0; k < 2; ++k) dst[n][k] = *(const LAS bf16x8*)(lds + PG8_SB(b, h) + boff + n * 2048 + k * 1024); } while (0)
#define PG8_MMA(ai, bj, At, Bt) do { __builtin_amdgcn_s_setprio(1); _Pragma("unroll") for (int m = 0; m < 4; ++m) _Pragma("unroll") for (int n = 0; n < 2; ++n) _Pragma("unroll") for (int k = 0; k < 2; ++k) \
        acc[ai][bj][m][n] = TA ? __builtin_amdgcn_mfma_f32_16x16x32_bf16(Bt[n][k], At[m][k], acc[ai][bj][m][n], 0, 0, 0) \
                               : __builtin_amdgcn_mfma_f32_16x16x32_bf16(At[m][k], Bt[n][k], acc[ai][bj][m][n], 0, 0, 0); __builtin_amdgcn_s_setprio(0); } while (0)
#define PG8_WAIT_V(n) asm volatile("s_waitcnt vmcnt(" #n ")" ::: "memory")
#define PG8_WAIT_L(n) asm volatile("s_waitcnt lgkmcnt(" #n ")" ::: "memory")
#define PG8_BAR __builtin_amdgcn_s_barrier()
#define PG8_SCHED __builtin_amdgcn_sched_barrier(0)
    Unit cur, nxt; int ui = 0;
    if (!S.next(0, cur)) return;
    if (GATHER) {
#pragma unroll
        for (int h = 0; h < 2; ++h)
#pragma unroll
            for (int i = 0; i < 2; ++i) voffA[h][i] = S.row_off(cur, h * HALF + RA[i]) + (unsigned)CA[i] * 2u;
    }
    f32x4 acc[2][2][4][2];
#pragma unroll
    for (int a = 0; a < 2; ++a)
#pragma unroll
        for (int b = 0; b < 2; ++b)
#pragma unroll
            for (int m = 0; m < 4; ++m)
#pragma unroll
                for (int n = 0; n < 2; ++n) acc[a][b][m][n] = (f32x4){0.f, 0.f, 0.f, 0.f};
    bf16x8 At[4][2], B0[2][2], B1[2][2];
    const char* cA = cur.A; const char* cB = cur.B;
    if constexpr (SP2) {
        PG8_STAGE(PG8_SB(0, 0), cB, voffB); PG8_STAGE(PG8_SB(0, 1), cB + hstep, voffB); PG8_STAGE_A(PG8_SA(0, 0), cA, 0); PG8_STAGE_A(PG8_SA(0, 1), cA, 1);
        if (wr == 1) PG8_BAR;
        PG8_WAIT_V(2); PG8_BAR;
        PG8_STAGE(PG8_SB(1, 0), cB + kstep, voffB); PG8_STAGE_A(PG8_SA(1, 0), cA + kstep, 0); PG8_STAGE(PG8_SB(1, 1), cB + hstep + kstep, voffB);
        PG8_WAIT_V(6); PG8_BAR;
    } else {
    PG8_STAGE(PG8_SB(0, 0), cB, voffB); PG8_STAGE_A(PG8_SA(0, 0), cA, 0); PG8_STAGE(PG8_SB(0, 1), cB + hstep, voffB); PG8_STAGE_A(PG8_SA(0, 1), cA, 1);
    if (wr == 1) PG8_BAR;
    PG8_WAIT_V(4); PG8_BAR;
    PG8_STAGE(PG8_SB(1, 0), cB + kstep, voffB); PG8_STAGE_A(PG8_SA(1, 0), cA + kstep, 0); PG8_STAGE(PG8_SB(1, 1), cB + hstep + kstep, voffB);
    PG8_WAIT_V(6); PG8_BAR;
    }
    for (;;) {
        const bool has_next = S.next(ui + 1, nxt);
        const char* nA = has_next ? nxt.A : cA; const char* nB = has_next ? nxt.B : cB;
        for (int t = 0; t < nt; t += 2) {
            const bool last = (t == nt - 2);
            const char* a1 = cA + (size_t)(t + 1) * kstep;
            const char* a2 = last ? nA : cA + (size_t)(t + 2) * kstep; const char* b2 = last ? nB : cB + (size_t)(t + 2) * kstep;
            const char* a3 = a2 + kstep; const char* b3 = b2 + kstep;
            if constexpr (SP2) {
            PG8_LDB(B0, 0, 0); PG8_LDB(B1, 0, 1); PG8_SCHED; PG8_LDA(At, 0, 0); PG8_STAGE_A(PG8_SA(1, 1), a1, 1);
            PG8_WAIT_V(8); PG8_WAIT_L(0); PG8_BAR; PG8_MMA(0, 0, At, B0); PG8_MMA(0, 1, At, B1); PG8_BAR; PG8_SCHED;
            if (GATHER) { if (last && has_next) {
#pragma unroll
                for (int h = 0; h < 2; ++h)
#pragma unroll
                    for (int i = 0; i < 2; ++i) voffA[h][i] = S.row_off(nxt, h * HALF + RA[i]) + (unsigned)CA[i] * 2u;
            } }
            PG8_LDA(At, 0, 1); PG8_STAGE(PG8_SB(0, 0), b2, voffB); PG8_STAGE(PG8_SB(0, 1), b2 + hstep, voffB); PG8_STAGE_A(PG8_SA(0, 0), a2, 0);
            PG8_WAIT_V(8); PG8_WAIT_L(0); PG8_BAR; PG8_MMA(1, 0, At, B0); PG8_MMA(1, 1, At, B1); PG8_BAR; PG8_SCHED;
            PG8_LDB(B0, 1, 0); PG8_LDB(B1, 1, 1); PG8_SCHED; PG8_LDA(At, 1, 0); PG8_STAGE_A(PG8_SA(0, 1), a2, 1);
            PG8_WAIT_V(8); PG8_WAIT_L(0); PG8_BAR; PG8_MMA(0, 0, At, B0); PG8_MMA(0, 1, At, B1); PG8_BAR; PG8_SCHED;
            PG8_LDA(At, 1, 1); PG8_STAGE(PG8_SB(1, 0), b3, voffB); PG8_STAGE(PG8_SB(1, 1), b3 + hstep, voffB); PG8_STAGE_A(PG8_SA(1, 0), a3, 0);
            PG8_WAIT_V(8); PG8_WAIT_L(0); PG8_BAR; PG8_MMA(1, 0, At, B0); PG8_MMA(1, 1, At, B1); PG8_BAR; PG8_SCHED;
            } else {
            PG8_LDB(B0, 0, 0); PG8_SCHED; PG8_LDA(At, 0, 0); PG8_STAGE_A(PG8_SA(1, 1), a1, 1);
            PG8_WAIT_L(8); PG8_BAR; PG8_WAIT_L(0); PG8_MMA(0, 0, At, B0); PG8_BAR; PG8_SCHED;
            if (GATHER) { if (last && has_next) {
#pragma unroll
                for (int h = 0; h < 2; ++h)
#pragma unroll
                    for (int i = 0; i < 2; ++i) voffA[h][i] = S.row_off(nxt, h * HALF + RA[i]) + (unsigned)CA[i] * 2u;
            } }
            PG8_LDB(B1, 0, 1); PG8_STAGE(PG8_SB(0, 0), b2, voffB);
            PG8_BAR; PG8_WAIT_L(0); PG8_MMA(0, 1, At, B1); PG8_BAR;
            PG8_LDA(At, 0, 1); PG8_STAGE_A(PG8_SA(0, 0), a2, 0);
            PG8_BAR; PG8_WAIT_L(0); PG8_MMA(1, 0, At, B0); PG8_BAR; PG8_SCHED;
            PG8_STAGE(PG8_SB(0, 1), b2 + hstep, voffB);
            PG8_WAIT_V(6); PG8_BAR; PG8_MMA(1, 1, At, B1); PG8_BAR;
            PG8_LDB(B0, 1, 0); PG8_SCHED; PG8_LDA(At, 1, 0); PG8_STAGE_A(PG8_SA(0, 1), a2, 1);
            PG8_WAIT_L(8); PG8_BAR; PG8_WAIT_L(0); PG8_MMA(0, 0, At, B0); PG8_BAR; PG8_SCHED;
            PG8_LDB(B1, 1, 1); PG8_STAGE(PG8_SB(1, 0), b3, voffB);
            PG8_BAR; PG8_WAIT_L(0); PG8_MMA(0, 1, At, B1); PG8_BAR;
            PG8_LDA(At, 1, 1); PG8_STAGE_A(PG8_SA(1, 0), a3, 0);
            PG8_BAR; PG8_WAIT_L(0); PG8_MMA(1, 0, At, B0); PG8_BAR; PG8_SCHED;
            PG8_STAGE(PG8_SB(1, 1), b3 + hstep, voffB);
            PG8_WAIT_V(6); PG8_BAR; PG8_MMA(1, 1, At, B1); PG8_BAR;
                    }
        }
        if constexpr (ALIGN_EPI) { if (wr == 0) PG8_BAR; }
        E(acc, cur, wr, wc, fr, fq);
        if (!has_next) break;
#pragma unroll
        for (int a = 0; a < 2; ++a)
#pragma unroll
            for (int b = 0; b < 2; ++b)
#pragma unroll
                for (int m = 0; m < 4; ++m)
#pragma unroll
                    for (int n = 0; n < 2; ++n) acc[a][b][m][n] = (f32x4){0.f, 0.f, 0.f, 0.f};
        cur = nxt; cA = nA; cB = nB; ++ui;
        if constexpr (ALIGN_EPI) { if (wr == 1) PG8_BAR; }
    }
    PG8_WAIT_V(0);
    if constexpr (!ALIGN_EPI) { if (wr == 0) PG8_BAR; }
    PG8_BAR;
#undef PG8_SA
#undef PG8_SB
#undef PG8_STAGE
#undef PG8_STAGE_A
#undef PG8_LDA
#undef PG8_LDB
#undef PG8_MMA
#undef PG8_WAIT_V
#undef PG8_WAIT_L
#undef PG8_BAR
#undef PG8_SCHED
}
}

namespace pg8 {
struct EpiHyT {
    static constexpr bool TA = false, PERM = false;
    bf16* PT; const float* bias; LAS unsigned char* scr;
    __device__ __forceinline__ void operator()(const f32x4 (&acc)[2][2][4][2], const Unit& u, int wr, int wc, int fr, int fq) const {
        const int lane = fq * 16 + fr, lc = lane >> 3, lp = lane & 7;
        LAS unsigned char* s = scr + (wr * 4 + wc) * 2304;
        LAS unsigned char* wp = s + fr * 144 + 8 * fq;
        const LAS unsigned char* rp = s + lc * 144 + 16 * lp;
#pragma unroll
        for (int bj = 0; bj < 2; ++bj)
#pragma unroll
            for (int n = 0; n < 2; ++n) {
                const int col0 = u.pn * BM + bj * HALF + wc * 32 + n * 16; const float bv = bias[col0 + fr];
                bf16* gp = PT + (size_t)(col0 + lc) * MTOK + u.pm * BM + wr * 64 + 8 * lp;
#pragma unroll
                for (int ai = 0; ai < 2; ++ai) {
#pragma unroll
                    for (int m = 0; m < 4; ++m) { const f32x4 v = acc[ai][bj][m][n] + bv; u32x2 w; w.x = cvt_pk_bf16(v[0], v[1]); w.y = cvt_pk_bf16(v[2], v[3]);
                        *(LAS u32x2*)(wp + 32 * m) = w; }
                    const u32x4 r0 = *(const LAS u32x4*)rp, r1 = *(const LAS u32x4*)(rp + 8 * 144);
                    *(u32x4*)(gp + ai * HALF) = r0; *(u32x4*)(gp + ai * HALF + (size_t)8 * MTOK) = r1; }
            }
    }
};
struct EpiZXD {
    static constexpr bool TA = true, PERM = true;
    unsigned char* Z8; bf16* XBC; float* DT; const float* b_in; bf16* HALO;
    __device__ __forceinline__ void operator()(const f32x4 (&acc)[2][2][4][2], const Unit& u, int wr, int wc, int fr, int fq) const {
        const int row0 = u.pm * BM + wr * 64 + fr;
        if (u.pn == 24) {
            if (wc < 2) {
                const int c0 = wc * 32 + 8 * fq;
#pragma unroll
                for (int n = 0; n < 2; ++n) { const f32x4 bv = *(const f32x4*)(b_in + 9216 + c0 + 4 * n);
#pragma unroll
                    for (int ai = 0; ai < 2; ++ai)
#pragma unroll
                        for (int m = 0; m < 4; ++m) *(f32x4*)(DT + (size_t)(row0 + ai * HALF + m * 16) * 64 + c0 + 4 * n) = acc[ai][0][m][n] + bv; }
            }
            return;
        }
        if (u.pn < 8) {
            const int col0z = u.pn * BM + wc * 32 + 8 * fq;
#pragma unroll
            for (int bj = 0; bj < 2; ++bj) { const f32x4 b0 = *(const f32x4*)(b_in + 3072 + col0z + bj * HALF), b1 = *(const f32x4*)(b_in + 3072 + col0z + bj * HALF + 4);
#pragma unroll
                for (int ai = 0; ai < 2; ++ai)
#pragma unroll
                    for (int m = 0; m < 4; ++m) { const f32x4 v0 = acc[ai][bj][m][0] + b0, v1 = acc[ai][bj][m][1] + b1;
                        int w0 = __builtin_amdgcn_cvt_pk_fp8_f32(v0[0], v0[1], 0, false); w0 = __builtin_amdgcn_cvt_pk_fp8_f32(v0[2], v0[3], w0, true);
                        int w1 = __builtin_amdgcn_cvt_pk_fp8_f32(v1[0], v1[1], 0, false); w1 = __builtin_amdgcn_cvt_pk_fp8_f32(v1[2], v1[3], w1, true);
                        u32x2 w; w.x = (unsigned)w0; w.y = (unsigned)w1;
                        *(u32x2*)(Z8 + (size_t)(row0 + ai * HALF + m * 16) * DSSM + col0z + bj * HALF) = w; } }
            return;
        }
        bf16* base = XBC; const int ldc = CONVD, colt = (u.pn - 8) * BM, bcol = 5120 + colt;
        const int col0 = colt + wc * 32 + 8 * fq, bcol0 = bcol + wc * 32 + 8 * fq;
        f32x4 bv[2][2];
#pragma unroll
        for (int bj = 0; bj < 2; ++bj)
#pragma unroll
            for (int n = 0; n < 2; ++n) bv[bj][n] = *(const f32x4*)(b_in + bcol0 + bj * HALF + 4 * n);
#pragma unroll
        for (int ai = 0; ai < 2; ++ai)
#pragma unroll
            for (int m = 0; m < 4; ++m) { bf16* rowp = base + (size_t)(row0 + ai * HALF + m * 16) * ldc + col0;
#pragma unroll
                for (int bj = 0; bj < 2; ++bj) { const f32x4 v0 = acc[ai][bj][m][0] + bv[bj][0], v1 = acc[ai][bj][m][1] + bv[bj][1];
                    u32x4 w; w.x = cvt_pk_bf16(v0[0], v0[1]); w.y = cvt_pk_bf16(v0[2], v0[3]); w.z = cvt_pk_bf16(v1[0], v1[1]); w.w = cvt_pk_bf16(v1[2], v1[3]);
                    *(u32x4*)(rowp + bj * HALF) = w;
                    if ((m == 3 && fr >= 14) || (m == 0 && fr < 2)) {
                        const int row = row0 + ai * HALF + m * 16, bb = row >> 11, t = row & 2047, tm = t & 63;
                        const int jb = (tm >= 62) ? (t >> 6) + 1 : (t >> 6), idx = (tm >= 62) ? tm - 62 : 2 + tm;
                        *(u32x4*)(HALO + ((size_t)(bb * 33 + jb) * 4 + idx) * CONVD + col0 + bj * HALF) = w; } } }
    }
};
template <int MODE> struct EpiBf {
    static constexpr bool TA = true, PERM = true;
    bf16* O; int ldc; const float* bias; const bf16* G1; int ldg; const bf16* P;
    __device__ __forceinline__ void operator()(const f32x4 (&acc)[2][2][4][2], const Unit& u, int wr, int wc, int fr, int fq) const {
        const int row0 = u.pm * BM + wr * 64 + fr, col0 = u.pn * BM + wc * 32 + 8 * fq;
        if (MODE == 0) {
#pragma unroll
            for (int ai = 0; ai < 2; ++ai)
#pragma unroll
                for (int m = 0; m < 4; ++m) { const size_t r = (size_t)(row0 + ai * HALF + m * 16);
#pragma unroll
                    for (int bj = 0; bj < 2; ++bj) { f32x4 v0 = acc[ai][bj][m][0], v1 = acc[ai][bj][m][1]; const int c = col0 + bj * HALF;
                        const f32x4 b0 = *(const f32x4*)(bias + c), b1 = *(const f32x4*)(bias + c + 4); v0 = v0 + b0; v1 = v1 + b1;
#pragma unroll
                        for (int j = 0; j < 4; ++j) { v0[j] = sigmoidf_(v0[j]); v1[j] = sigmoidf_(v1[j]); }
                        u32x4 w; w.x = cvt_pk_bf16(v0[0], v0[1]); w.y = cvt_pk_bf16(v0[2], v0[3]); w.z = cvt_pk_bf16(v1[0], v1[1]); w.w = cvt_pk_bf16(v1[2], v1[3]);
                        *(u32x4*)(O + r * ldc + c) = w; } }
            return;
        }
        u32x4 gb[2][4], pb[2][4];
        auto fetch = [&](int grp, int slot) {
#pragma unroll
            for (int kk = 0; kk < 4; ++kk) { const int ai = grp >> 1, m = 2 * (grp & 1) + (kk >> 1), bj = kk & 1; const size_t r = (size_t)(row0 + ai * HALF + m * 16); const int c = col0 + bj * HALF;
                gb[slot][kk] = *(const u32x4*)(G1 + r * ldg + c); if (MODE == 2) pb[slot][kk] = *(const u32x4*)(P + r * ldc + c); } };
        fetch(0, 0);
#pragma unroll
        for (int grp = 0; grp < 4; ++grp) {
            if (grp + 1 < 4) fetch(grp + 1, (grp + 1) & 1);
            __builtin_amdgcn_sched_barrier(0);
#pragma unroll
            for (int kk = 0; kk < 4; ++kk) { const int ai = grp >> 1, m = 2 * (grp & 1) + (kk >> 1), bj = kk & 1; const size_t r = (size_t)(row0 + ai * HALF + m * 16); const int c = col0 + bj * HALF;
                f32x4 v0 = acc[ai][bj][m][0], v1 = acc[ai][bj][m][1]; const u32x4 g = gb[grp & 1][kk];
                v0[0] *= bflo(g.x); v0[1] *= bfhi(g.x); v0[2] *= bflo(g.y); v0[3] *= bfhi(g.y); v1[0] *= bflo(g.z); v1[1] *= bfhi(g.z); v1[2] *= bflo(g.w); v1[3] *= bfhi(g.w);
                if (MODE == 2) { const u32x4 p = pb[grp & 1][kk];
                    v0[0] += bflo(p.x); v0[1] += bfhi(p.x); v0[2] += bflo(p.y); v0[3] += bfhi(p.y); v1[0] += bflo(p.z); v1[1] += bfhi(p.z); v1[2] += bflo(p.w); v1[3] += bfhi(p.w); }
                u32x4 w; w.x = cvt_pk_bf16(v0[0], v0[1]); w.y = cvt_pk_bf16(v0[2], v0[3]); w.z = cvt_pk_bf16(v1[0], v1[1]); w.w = cvt_pk_bf16(v1[2], v1[3]);
                *(u32x4*)(O + r * ldc + c) = w; }
            __builtin_amdgcn_sched_barrier(0);
        }
    }
};
struct EpiRes {
    static constexpr bool TA = true, PERM = true;
    bf16* O; const float* bias; const bf16* X; float alpha;
    __device__ __forceinline__ void operator()(const f32x4 (&acc)[2][2][4][2], const Unit& u, int wr, int wc, int fr, int fq) const {
        const int row0 = u.pm * BM + wr * 64 + fr, col0 = u.pn * BM + wc * 32 + 8 * fq;
        f32x4 bb[2][2];
#pragma unroll
        for (int bj = 0; bj < 2; ++bj) { bb[bj][0] = *(const f32x4*)(bias + col0 + bj * HALF); bb[bj][1] = *(const f32x4*)(bias + col0 + bj * HALF + 4); }
        u32x4 xb[2][4];
        auto fetch = [&](int grp, int slot) {
#pragma unroll
            for (int kk = 0; kk < 4; ++kk) { const int ai = grp >> 1, m = 2 * (grp & 1) + (kk >> 1), bj = kk & 1; xb[slot][kk] = *(const u32x4*)(X + (size_t)(row0 + ai * HALF + m * 16) * DM + col0 + bj * HALF); } };
        fetch(0, 0);
#pragma unroll
        for (int grp = 0; grp < 4; ++grp) {
            if (grp + 1 < 4) fetch(grp + 1, (grp + 1) & 1);
            __builtin_amdgcn_sched_barrier(0);
#pragma unroll
            for (int kk = 0; kk < 4; ++kk) { const int ai = grp >> 1, m = 2 * (grp & 1) + (kk >> 1), bj = kk & 1; const size_t off = (size_t)(row0 + ai * HALF + m * 16) * DM + col0 + bj * HALF;
                const u32x4 xv = xb[grp & 1][kk]; f32x4 v0 = acc[ai][bj][m][0] + bb[bj][0], v1 = acc[ai][bj][m][1] + bb[bj][1];
                v0[0] += alpha * bflo(xv.x); v0[1] += alpha * bfhi(xv.x); v0[2] += alpha * bflo(xv.y); v0[3] += alpha * bfhi(xv.y);
                v1[0] += alpha * bflo(xv.z); v1[1] += alpha * bfhi(xv.z); v1[2] += alpha * bflo(xv.w); v1[3] += alpha * bfhi(xv.w);
                u32x4 w; w.x = cvt_pk_bf16(v0[0], v0[1]); w.y = cvt_pk_bf16(v0[2], v0[3]); w.z = cvt_pk_bf16(v1[0], v1[1]); w.w = cvt_pk_bf16(v1[2], v1[3]);
                *(u32x4*)(O + off) = w; }
            __builtin_amdgcn_sched_barrier(0);
        }
    }
};
struct EpiSwiGLU {
    static constexpr bool TA = true, PERM = true;
    bf16* HID;
    __device__ __forceinline__ void operator()(const f32x4 (&acc)[2][2][4][2], const Unit& u, int wr, int wc, int fr, int fq) const {
        const int row0 = u.pm * BM + wr * 64 + fr, col0 = u.pn * HALF + wc * 32 + 8 * fq;
#pragma unroll
        for (int ai = 0; ai < 2; ++ai)
#pragma unroll
            for (int m = 0; m < 4; ++m) { f32x4 v0, v1;
#pragma unroll
                for (int j = 0; j < 4; ++j) { v0[j] = siluf_(acc[ai][0][m][0][j]) * acc[ai][1][m][0][j]; v1[j] = siluf_(acc[ai][0][m][1][j]) * acc[ai][1][m][1][j]; }
                u32x4 w; w.x = cvt_pk_bf16(v0[0], v0[1]); w.y = cvt_pk_bf16(v0[2], v0[3]); w.z = cvt_pk_bf16(v1[0], v1[1]); w.w = cvt_pk_bf16(v1[2], v1[3]);
                *(u32x4*)(HID + (size_t)(row0 + ai * HALF + m * 16) * DEXP + col0) = w; }
    }
};
struct EpiScatter {
    static constexpr bool TA = false, PERM = false;
    float* ACC; const int* tok; const float* wgt; int j0_unused;
    __device__ __forceinline__ void operator()(const f32x4 (&acc)[2][2][4][2], const Unit& u, int wr, int wc, int fr, int fq) const {
        asm volatile("" : "+v"(fr), "+v"(fq));
        const int jt = u.pn >> 2, ct = u.pn & 3;
#pragma unroll
        for (int ai = 0; ai < 2; ++ai)
#pragma unroll
            for (int m = 0; m < 4; ++m)
#pragma unroll
                for (int j = 0; j < 4; ++j) { const int r = ai * HALF + wr * 64 + m * 16 + 4 * fq + j;
                    if (r < u.cnt) { int token; float w;
                        if (u.e == NE) { token = jt * BM + r; w = 1.0f; } else { const size_t li = (size_t)u.e * MTOK + (size_t)jt * BM + r; token = tok[li]; w = wgt[li]; }
                        float* rowp = ACC + (size_t)token * DM + ct * BM + wc * 32 + fr;
#pragma unroll
                        for (int bj = 0; bj < 2; ++bj)
#pragma unroll
                            for (int n = 0; n < 2; ++n) unsafeAtomicAdd(rowp + bj * HALF + n * 16, w * acc[ai][bj][m][n][j]);
                    }
                    asm volatile("" ::: "memory"); }
    }
};

struct EpiSlot8 {
    static constexpr bool TA = true, PERM = true;
    unsigned char* YQ;
    __device__ __forceinline__ void operator()(const f32x4 (&acc)[2][2][4][2], const Unit& u, int wr, int wc, int fr, int fq) const {
        asm volatile("" : "+v"(fr), "+v"(fq));
        const int row0 = u.pm * BM + wr * 64 + fr, col0 = u.pn * 256 + wc * 32 + 8 * fq;
#pragma unroll
        for (int ai = 0; ai < 2; ++ai)
#pragma unroll
            for (int m = 0; m < 4; ++m) { unsigned char* rowp = YQ + (size_t)(row0 + ai * HALF + m * 16) * 1024 + col0;
#pragma unroll
                for (int bj = 0; bj < 2; ++bj) { const f32x4 v0 = acc[ai][bj][m][0], v1 = acc[ai][bj][m][1];
                    int w0 = __builtin_amdgcn_cvt_pk_fp8_f32(v0[0], v0[1], 0, false); w0 = __builtin_amdgcn_cvt_pk_fp8_f32(v0[2], v0[3], w0, true);
                    int w1 = __builtin_amdgcn_cvt_pk_fp8_f32(v1[0], v1[1], 0, false); w1 = __builtin_amdgcn_cvt_pk_fp8_f32(v1[2], v1[3], w1, true);
                    u32x2 w; w.x = (unsigned)w0; w.y = (unsigned)w1; *(u32x2*)(rowp + bj * HALF) = w; } }
    }
};
struct SlotOrder4 {
    const LAS int* tp; const LAS int* te; int G, c, total; const char* A; const char* W;
    __device__ __forceinline__ bool next(int i, Unit& u) const {
        int tile, q;
        if (G == 256) { const int cx = c & 7, cj = c >> 3; q = cj & 3; tile = i * 64 + (cj >> 2) * 8 + cx; }
        else { const long L = (long)i * G + c; tile = (int)(L >> 2); q = (int)(L & 3); }
        if (tile >= total) return false;
        const int e = te[tile];
        u.e = e; u.cnt = 0; u.pm = tile; u.pn = q; u.A = A + (size_t)tile * BM * DEXP * 2; u.B = W + ((size_t)e * DM + (size_t)q * 256) * DEXP * 2;
        return true;
    }
    __device__ __forceinline__ unsigned row_off(const Unit&, int) const { return 0u; }
};
template <int NCT, bool FIRST> struct MoeOrder {
    const LAS int* tp; const LAS int* cnt; const LAS int* te; int G, c, total;
    const char* A; const char* W; const int* tok;
    __device__ __forceinline__ bool next(int i, Unit& u) const {
        const long L = (long)i * G + c; if (L >= (long)total * NCT) return false;
        const int tile = (int)(L / NCT), ct = (int)(L % NCT);
        const int e = te[tile];
        const int jt = tile - tp[e];
        u.e = e; const int left = cnt[e] - jt * BM; u.cnt = left < BM ? left : BM;
        if (FIRST) { u.pm = tile; u.pn = ct; u.A = A; u.B = W + ((size_t)e * 512 + (size_t)ct * 256) * DM * 2; }
        else { u.pm = tile; u.pn = jt * 4 + ct; u.A = A + (size_t)tile * BM * DEXP * 2; u.B = W + ((size_t)e * DM + (size_t)ct * 256) * DEXP * 2; }
        return true;
    }
    __device__ __forceinline__ unsigned row_off(const Unit& u, int r) const {
        const int jt = u.pm - tp[u.e]; int token;
        if (u.e == NE) token = jt * BM + r; else token = (r < u.cnt) ? tok[(size_t)u.e * MTOK + (size_t)jt * BM + r] : 0;
        return (unsigned)token * (unsigned)(H1B_PITCH * 2);
    }
};
}

#define XB_TMO      128
#define XB_XCNT(j)  (256  + 64 * (j))
#define XB_XSUB(j)  (1280 + 64 * (j))
#define XB_XGEN(j)  (2304 + 64 * (j))
#define XB_TOP      3328
#define XB_TOPGEN   3392
#define XCD_BAR_WORDS 3456
#define XB_SPIN_CAP (1u << 18)
__device__ __forceinline__ unsigned xb_ld(unsigned* p)              { return __hip_atomic_load(p, __ATOMIC_RELAXED, __HIP_MEMORY_SCOPE_AGENT); }
__device__ __forceinline__ unsigned xb_add(unsigned* p, unsigned v) { return __hip_atomic_fetch_add(p, v, __ATOMIC_RELAXED, __HIP_MEMORY_SCOPE_AGENT); }
__device__ __forceinline__ unsigned xb_xcc_id() { return (unsigned)__builtin_amdgcn_s_getreg((3 << 11) | 20) & 0xFu; }
#define XB_SPIN(cond, bar) do { unsigned _sp = 0; while (cond) { __builtin_amdgcn_s_sleep(1); \
    if ((++_sp & 255u) == 0u) { if (xb_ld(&(bar)[XB_TMO])) break; if (_sp > XB_SPIN_CAP) { atomicAdd(&(bar)[XB_TMO], 1u); break; } } } } while (0)
struct XcdBarrier { unsigned* bar; unsigned x; volatile LAS unsigned* st; };
__device__ __forceinline__ XcdBarrier xcd_barrier_post(unsigned* bar, volatile LAS unsigned* st) {
    XcdBarrier b; b.bar = bar; b.x = xb_xcc_id(); b.st = st;
    if (threadIdx.x == 0) (void)xb_add(&bar[XB_XCNT(b.x)], 1u);
    return b;
}
__device__ __forceinline__ void xcd_barrier_complete(unsigned* bar, unsigned x, unsigned& nloc, unsigned& nx) {
    const unsigned G = gridDim.x * gridDim.y * gridDim.z;
    unsigned sum, cnt, mine, sp = 0u;
    for (;;) {
        sum = 0u; cnt = 0u; mine = 0u;
#pragma unroll
        for (unsigned j = 0; j < 16; ++j) { const unsigned c = xb_ld(&bar[XB_XCNT(j)]); sum += c; cnt += (c > 0u) ? 1u : 0u; mine = (j == x) ? c : mine; }
        if (sum == G) break;
        __builtin_amdgcn_s_sleep(1);
        if ((++sp & 255u) == 0u) { if (xb_ld(&bar[XB_TMO])) break; if (sp > XB_SPIN_CAP) { atomicAdd(&bar[XB_TMO], 1u); break; } }
    }
    nloc = mine > 0u ? mine : 1u; nx = cnt > 0u ? cnt : 1u;
}
__device__ __forceinline__ void xcd_barrier(const XcdBarrier& b) {
    asm volatile("s_waitcnt vmcnt(0)" ::: "memory");
    __syncthreads();
    if (threadIdx.x == 0) {
        unsigned* bar = b.bar;
        __builtin_amdgcn_s_waitcnt(0);
        unsigned nloc = b.st[0], nx = b.st[1];
        if (nloc == 0u) { xcd_barrier_complete(bar, b.x, nloc, nx); b.st[0] = nloc; b.st[1] = nx; }
        const unsigned old = xb_add(&bar[XB_XSUB(b.x)], 1u);
        const unsigned gen = old / nloc;
        if (old + 1u == (gen + 1u) * nloc) {
            __builtin_amdgcn_fence(__ATOMIC_RELEASE, "agent");
            asm volatile("s_waitcnt vmcnt(0)" ::: "memory");
            const unsigned og = xb_add(&bar[XB_TOP], 1u);
            const unsigned tg = og / nx;
            if (og + 1u == (tg + 1u) * nx) xb_add(&bar[XB_TOPGEN], 1u);
            else XB_SPIN(xb_ld(&bar[XB_TOPGEN]) == tg, bar);
            __builtin_amdgcn_fence(__ATOMIC_ACQUIRE, "agent");
            xb_add(&bar[XB_XGEN(b.x)], 1u);
            asm volatile("s_waitcnt vmcnt(0)" ::: "memory");
        } else {
            XB_SPIN(xb_ld(&bar[XB_XGEN(b.x)]) == gen, bar);
            __builtin_amdgcn_fence(__ATOMIC_ACQUIRE, "agent");
            asm volatile("s_waitcnt vmcnt(0)" ::: "memory");
        }
    }
    __syncthreads();
}

struct Args {
    const float* in[38]; float* out; unsigned char* ws; int ph_lo, ph_hi, li, pad;
};
enum { I_X = 0, I_WIN, I_BIN, I_HCW, I_HCB, I_FW1, I_FB1, I_FF1, I_FW2, I_FB2, I_FF2, I_FW3, I_FB3, I_FF3, I_FW4, I_HBIAS,
       I_SCW, I_SCB, I_DTB, I_ALOG, I_SD, I_SNW, I_WHYB, I_WSSDB, I_WOUT, I_BOUT, I_LN1G, I_LN1B, I_RW, I_RB, I_EWG, I_EWU, I_EWD, I_SWG, I_SWU, I_SWD, I_LN2G, I_LN2B };
struct Frame {
    LAS unsigned char* lds; volatile LAS unsigned* MISC; gu32* ctl; unsigned char* ws;
    int tid, lane, wave, vcu, G;
    const float* const* in; float* out;
};

__device__ __forceinline__ void tr_item(const float* src, int ld_src, int k0, int c0, bf16* dst, int drow0, int ldd, LAS float* scr, int lane) {
    f32x4 ld[8];
#pragma unroll
    for (int i = 0; i < 8; ++i) ld[i] = *(const f32x4*)(src + (size_t)(k0 + 8 * i + (lane >> 3)) * ld_src + c0 + 4 * (lane & 7));
#pragma unroll
    for (int i = 0; i < 8; ++i) { LAS float* d = scr + (8 * i + (lane >> 3)) * 33 + 4 * (lane & 7); d[0] = ld[i][0]; d[1] = ld[i][1]; d[2] = ld[i][2]; d[3] = ld[i][3]; }
    LDS_WAIT(); asm volatile("" ::: "memory");
    const int c = lane & 7;
#pragma unroll
    for (int j = 0; j < 4; ++j) { const int n = (lane >> 3) + 8 * j; const LAS float* s = scr + (8 * c) * 33 + n;
        u32x4 o; o.x = pk2(s[0 * 33], s[1 * 33]); o.y = pk2(s[2 * 33], s[3 * 33]); o.z = pk2(s[4 * 33], s[5 * 33]); o.w = pk2(s[6 * 33], s[7 * 33]);
        *(u32x4*)(dst + (size_t)(drow0 + n) * ldd + k0 + 8 * c) = o; }
    LDS_WAIT(); asm volatile("" ::: "memory");
}
__device__ __forceinline__ void tr_matrix_item(const float* src, int ld_src, int K, int col_first, int ncols, bf16* dst, int drow_first, LAS float* scr, int it, int lane) {
    const int nblk = ncols / 32, kb = it / nblk, nb = it % nblk;
    tr_item(src, ld_src, kb * 64, col_first + nb * 32, dst, drow_first + nb * 32, K, scr, lane);
}
__device__ __forceinline__ void convert_x(Frame& F, const float* x, bf16* xb) {
    const size_t n8 = (size_t)MTOK * DM / 8; const size_t stride = (size_t)F.G * NTHR;
    for (size_t i = (size_t)F.vcu * NTHR + F.tid; i < n8; i += 4 * stride) {
        f32x4 a[4], b[4];
#pragma unroll
        for (int u = 0; u < 4; ++u) { const size_t k = (i + u * stride < n8) ? i + u * stride : i; a[u] = *(const f32x4*)(x + k * 8); b[u] = *(const f32x4*)(x + k * 8 + 4); }
#pragma unroll
        for (int u = 0; u < 4; ++u) { u32x4 o; o.x = pk2(a[u][0], a[u][1]); o.y = pk2(a[u][2], a[u][3]); o.z = pk2(b[u][0], b[u][1]); o.w = pk2(b[u][2], b[u][3]);
            if (i + u * stride < n8) *(u32x4*)(xb + (i + u * stride) * 8) = o; } }
}

__device__ __forceinline__ void hyena_filter(Frame& F) {
    const float* w1 = F.in[I_FW1]; const float* b1 = F.in[I_FB1]; const float* f1 = F.in[I_FF1];
    const float* w2 = F.in[I_FW2]; const float* b2 = F.in[I_FB2]; const float* f2 = F.in[I_FF2];
    const float* w3 = F.in[I_FW3]; const float* b3 = F.in[I_FB3]; const float* f3 = F.in[I_FF3];
    const float* w4 = F.in[I_FW4];
    bf16* KERN = (bf16*)(F.ws + WS_KERN);
    LAS float* hbuf = (LAS float*)(F.lds);
    const int lane = F.lane, wave = F.wave;
    for (int pg = F.vcu; pg < SEQ / 8; pg += F.G) {
        const int t = 8 * pg + wave;
        const float tn = (float)t / (float)(SEQ - 1), wv = 6.283185307179586f * (float)t / (float)SEQ;
        float zf = 0.f;
        if (lane == 0) zf = tn;
        else if (lane <= 16) { const float f = 1e-4f + (float)(lane - 1) * ((15.0f - 1e-4f) / 15.0f); zf = cosf(f * wv); }
        else if (lane <= 32) { const float f = 1e-4f + (float)(lane - 17) * ((15.0f - 1e-4f) / 15.0f); zf = -sinf(f * wv); }
        float s = b1[lane];
        for (int i = 0; i < 33; ++i) s += __shfl(zf, i) * w1[i * 64 + lane];
        float h = sinf(f1[lane] * s);
        s = b2[lane];
        for (int i = 0; i < 64; ++i) s += __shfl(h, i) * w2[i * 64 + lane];
        h = sinf(f2[lane] * s);
        s = b3[lane];
        for (int i = 0; i < 64; ++i) s += __shfl(h, i) * w3[i * 64 + lane];
        h = sinf(f3[lane] * s);
        hbuf[wave * 64 + lane] = h;
        __syncthreads();
        { float a[8][8];
#pragma unroll
          for (int q = 0; q < 8; ++q)
#pragma unroll
              for (int p = 0; p < 8; ++p) a[q][p] = 0.f;
          float a0b[4] = {0.f, 0.f, 0.f, 0.f};
#pragma unroll 2
          for (int i = 0; i < 64; ++i) { float wv[8], hv[8];
#pragma unroll
              for (int q = 0; q < 8; ++q) wv[q] = w4[(size_t)i * 4096 + F.tid + 512 * q];
#pragma unroll
              for (int p = 0; p < 8; ++p) hv[p] = hbuf[p * 64 + i];
#pragma unroll
              for (int q = 0; q < 8; ++q)
#pragma unroll
                  for (int p = 0; p < 8; ++p) a[q][p] += hv[p] * wv[q];
              if (pg == 0) { a0b[0] += hv[0] * wv[2]; a0b[1] += hv[0] * wv[3]; a0b[2] += hv[0] * wv[6]; a0b[3] += hv[0] * wv[7]; } }
#pragma unroll
          for (int q = 0; q < 8; ++q) { const int col = F.tid + 512 * q, c = col & 1023, dir = (q >> 1) & 1, o = q >> 2;
              const float adel = 3.0701134573253945f + (float)c * ((15.350567286626973f - 3.0701134573253945f) / 1023.0f);
              bf16* kc = KERN + ((size_t)c * 2 + o) * 4096;
#pragma unroll
              for (int p = 0; p < 8; ++p) { const int tp = 8 * pg + p; const float v = a[q][p] * __expf(-((float)tp / (float)(SEQ - 1)) * adel);
                  if (tp == 0) { if (dir == 0) { kc[2048] = (bf16)f2bf(v + a0b[(q & 1) + 2 * o]); kc[0] = 0; } }
                  else kc[dir == 0 ? 2048 - tp : 2048 + tp] = (bf16)f2bf(v); } } }
        __syncthreads();
    }
}

__device__ __forceinline__ void p0_prologue(Frame& F) {
    LAS float* scr = (LAS float*)(F.lds + 4096 + F.wave * 16384);
    const int gw = F.vcu * NWAVES + F.wave, NGW = F.G * NWAVES;
    const bool late_filter = (blockIdx.x & 1);
    bf16* WINT = (bf16*)(F.ws + WS_WINT);
    constexpr int I_A = 16 * (9216 / 32), I_B = 16 * (64 / 32), I_C = 16 * (2048 / 32);
    constexpr int I_HY = 16 * 32, I_SS = 32 * 32, I_OUT = 16 * 32;
    constexpr int NITEMS = I_A + I_B + I_C + I_HY + I_SS + I_OUT;
#pragma unroll 1
    for (int s_ = 0; s_ < 2; ++s_) {
    if ((s_ == 1) == late_filter) { hyena_filter(F); continue; }
    for (int it = gw; it < NITEMS; it += NGW) {
        int r = it;
        if (r < I_A) { tr_matrix_item(F.in[I_WIN], INC, DM, 0, 9216, WINT, 0, scr, r, F.lane); continue; } r -= I_A;
        if (r < I_B) { tr_matrix_item(F.in[I_WIN], INC, DM, 9216, 64, WINT, 9216, scr, r, F.lane); continue; } r -= I_B;
        if (r < I_C) { tr_matrix_item(F.in[I_WIN], INC, DM, 9280, 2048, (bf16*)(F.ws + WS_WING), 0, scr, r, F.lane); continue; } r -= I_C;
        if (r < I_HY) { tr_matrix_item(F.in[I_WHYB], DM, DM, 0, DM, (bf16*)(F.ws + WS_WHYB), 0, scr, r, F.lane); continue; } r -= I_HY;
        if (r < I_SS) { tr_matrix_item(F.in[I_WSSDB], DM, DSSM, 0, DM, (bf16*)(F.ws + WS_WSSDB), 0, scr, r, F.lane); continue; } r -= I_SS;
        tr_matrix_item(F.in[I_WOUT], DM, DM, 0, DM, (bf16*)(F.ws + WS_WOUT), 0, scr, r, F.lane);
    }
    convert_x(F, F.in[I_X], (bf16*)((unsigned char*)F.out + OUT_XB));
    __syncthreads();
    }
}
__device__ __forceinline__ void p6_reconvert(Frame& F) {
    LAS float* scr = (LAS float*)(F.lds + 4096 + F.wave * 16384);
    const int gw = F.vcu * NWAVES + F.wave, NGW = F.G * NWAVES;
    for (int it = gw; it < 16 * (2048 / 32); it += NGW) tr_matrix_item(F.in[I_WIN], INC, DM, 9280, 2048, (bf16*)(F.ws + WS_WING), 0, scr, it, F.lane);
    convert_x(F, F.in[I_X], (bf16*)(F.ws + WS_XB2));
}
__device__ __forceinline__ void p10_expert_weights(Frame& F) {
    LAS float* scr = (LAS float*)(F.lds + 4096 + F.wave * 16384);
    const int gw = F.vcu * NWAVES + F.wave, NGW = F.G * NWAVES;
    bf16* EW1 = (bf16*)(F.ws + WS_EW1); bf16* EW2 = (bf16*)(F.ws + WS_EW2);
    constexpr int PER1 = 16 * 4;
    constexpr int N1 = NEX * 2 * 2 * PER1, PER2 = 4 * 32, N2 = NEX * PER2;
    for (int it = gw; it < N1 + N2; it += NGW) {
        if (it < N1) { const int e = it / (4 * PER1), r0 = it % (4 * PER1), mat = r0 / (2 * PER1), r1 = r0 % (2 * PER1), ct = r1 / PER1, r2 = r1 % PER1;
            const float* src = (e < NE) ? F.in[mat ? I_EWU : I_EWG] + (size_t)e * DM * DEXP : F.in[mat ? I_SWU : I_SWG];
            tr_matrix_item(src, DEXP, DM, 128 * ct, 128, EW1 + (size_t)e * 512 * DM, 256 * ct + 128 * mat, scr, r2, F.lane); }
        else { const int r = it - N1, e = r / PER2, r2 = r % PER2;
            const float* src = (e < NE) ? F.in[I_EWD] + (size_t)e * DEXP * DM : F.in[I_SWD];
            tr_matrix_item(src, DM, DEXP, 0, DM, EW2 + (size_t)e * DM * DEXP, 0, scr, r2, F.lane); }
    }
}
__device__ __forceinline__ void p3_transpose(Frame& F) {
    const bf16* YT = (const bf16*)(F.ws + WS_YTHY); bf16* Y = (bf16*)(F.ws + WS_YHY);
    LAS bf16* scr = (LAS bf16*)(F.lds + F.wave * 9216);
    const int gw = F.vcu * NWAVES + F.wave, NGW = F.G * NWAVES, lane = F.lane;
    for (int tile = gw; tile < 16 * 512; tile += NGW) {
        const int c0 = (tile & 15) * 64, t0 = (tile >> 4) * 64;
#pragma unroll
        for (int p = 0; p < 8; ++p) { const int c = p * 8 + (lane >> 3), ch = lane & 7;
            const u32x4 g = *(const u32x4*)(YT + (size_t)(c0 + c) * MTOK + t0 + ch * 8);
            LAS bf16* d = scr + (ch * 8) * 72 + (c ^ (ch << 3));
            d[0 * 72] = (bf16)(g.x & 0xffff); d[1 * 72] = (bf16)(g.x >> 16); d[2 * 72] = (bf16)(g.y & 0xffff); d[3 * 72] = (bf16)(g.y >> 16);
            d[4 * 72] = (bf16)(g.z & 0xffff); d[5 * 72] = (bf16)(g.z >> 16); d[6 * 72] = (bf16)(g.w & 0xffff); d[7 * 72] = (bf16)(g.w >> 16); }
        LDS_WAIT(); asm volatile("" ::: "memory");
#pragma unroll
        for (int p = 0; p < 8; ++p) { const int tk = p * 8 + (lane >> 3), ch = lane & 7;
            const u32x4 v = *(const LAS u32x4*)(scr + tk * 72 + ((ch ^ ((tk >> 3) & 7)) << 3));
            *(u32x4*)(Y + (size_t)(t0 + tk) * DM + c0 + ch * 8) = v; }
        LDS_WAIT(); asm volatile("" ::: "memory");
    }
}

constexpr int HY_LDU = 2064, HY_KCS = 4128, HY_U_BYTES = 16 * HY_LDU * 2, HY_KC_BYTES = 8 * HY_KCS * 2;

struct HyKRow { u32x4 cur, prv; };
__device__ __forceinline__ void hy_load_kern(HyKRow& r, const bf16* kern, int tid) {
    r.cur = *(const u32x4*)(kern + 8 * tid);
    r.prv = (u32x4){0u, 0u, 0u, 0u};
    if (tid > 0) r.prv = *(const u32x4*)(kern + 8 * tid - 8);
}
__device__ __forceinline__ void hy_store_kc(LAS bf16* KC, const HyKRow& r, int tid) {
    const unsigned E[9] = {r.prv.x, r.prv.y, r.prv.z, r.prv.w, r.cur.x, r.cur.y, r.cur.z, r.cur.w, 0u};
#pragma unroll
    for (int fl = 0; fl < 8; ++fl) { const int sft = 8 - fl, k = sft >> 1;
        u32x4 o;
        if (sft & 1) { o.x = __builtin_amdgcn_alignbit(E[k + 1], E[k], 16); o.y = __builtin_amdgcn_alignbit(E[k + 2], E[k + 1], 16);
                       o.z = __builtin_amdgcn_alignbit(E[k + 3], E[k + 2], 16); o.w = __builtin_amdgcn_alignbit(E[k + 4], E[k + 3], 16); }
        else { o.x = E[k]; o.y = E[k + 1]; o.z = E[k + 2]; o.w = E[k + 3]; }
        *(LAS u32x4*)(KC + fl * HY_KCS + 8 * tid) = o; }
}
__device__ __forceinline__ f32x4 hy_short4(const bf16* prow, int t0, float w0, float w1, float w2, float cb) {
    const u32x2 g = *(const u32x2*)(prow + t0);
    const float p0 = bflo(g.x), p1 = bfhi(g.x), p2 = bflo(g.y), p3 = bfhi(g.y);
    const float pm = (t0 > 0) ? bf2f(prow[t0 - 1]) : 0.f, pp = (t0 + 4 < SEQ) ? bf2f(prow[t0 + 4]) : 0.f;
    f32x4 r; r[0] = cb + w0 * pm + w1 * p0 + w2 * p1; r[1] = cb + w0 * p0 + w1 * p1 + w2 * p2; r[2] = cb + w0 * p1 + w1 * p2 + w2 * p3; r[3] = cb + w0 * p2 + w1 * p3 + w2 * pp;
    return r;
}
__device__ __forceinline__ f32x4 hy_conv4(const u32x2 g, float pm, float pp, float w0, float w1, float w2, float cb) {
    const float p0 = bflo(g.x), p1 = bfhi(g.x), p2 = bflo(g.y), p3 = bfhi(g.y);
    f32x4 r; r[0] = cb + w0 * pm + w1 * p0 + w2 * p1; r[1] = cb + w0 * p0 + w1 * p1 + w2 * p2; r[2] = cb + w0 * p1 + w1 * p2 + w2 * p3; r[3] = cb + w0 * p2 + w1 * p3 + w2 * pp;
    return r;
}
__device__ __forceinline__ void hyena_phase(Frame& F) {
    LAS bf16* U = (LAS bf16*)(F.lds); LAS bf16* KC = (LAS bf16*)(F.lds + HY_U_BYTES);
    const bf16* PT = (const bf16*)(F.ws + WS_PTHY); const bf16* KERN = (const bf16*)(F.ws + WS_KERN); bf16* YT = (bf16*)(F.ws + WS_YTHY);
    const float* cw = F.in[I_HCW]; const float* cbv = F.in[I_HCB]; const float* hb = F.in[I_HBIAS];
    const int tid = F.tid, lane = F.lane, w = F.wave, fr = lane & 15, fq = lane >> 4;
    u32x4 um[8]; unsigned ee[8]; HyKRow kr;
    auto load_v = [&](int c) { int tl = tid; asm volatile("" : "+v"(tl));
        const bf16* prow = PT + (size_t)(2048 + c) * MTOK + (size_t)(tl >> 8) * SEQ + (tl & 255) * 8;
#pragma unroll
        for (int it = 0; it < 8; ++it) { um[it] = *(const u32x4*)(prow + (size_t)(2 * it) * SEQ); ee[it] = 0u; }
        if (lane == 0 || lane == 63) {
#pragma unroll
            for (int it = 0; it < 8; ++it) { const int t8 = (tl & 255) * 8; const bf16* pr = prow + (size_t)(2 * it) * SEQ - t8;
                if (lane == 0) { if (t8 > 0) ee[it] = pr[t8 - 1]; } else { if (t8 + 8 < SEQ) ee[it] = pr[t8 + 8]; } } } };
    if (F.vcu < DM) { hy_load_kern(kr, KERN + ((size_t)F.vcu * 2 + 0) * 4096, tid); load_v(F.vcu); }
    for (int c = F.vcu; c < DM; c += F.G) {
        const bool has_next = (c + F.G < DM);
        hy_store_kc(KC, kr, tid);
        { const int vc = 2048 + c; const float w0 = cw[0 * HYC + vc], w1 = cw[1 * HYC + vc], w2 = cw[2 * HYC + vc], cb = cbv[vc];
#pragma unroll
          for (int it = 0; it < 8; ++it) { const int idx = tid + 512 * it, b = idx >> 8, t8 = (idx & 255) * 8;
              const unsigned up = __shfl_up(um[it].w >> 16, 1), dn = __shfl_down(um[it].x & 0xffffu, 1);
              const float pm = bf2f(lane == 0 ? ee[it] : up), pp = bf2f(lane == 63 ? ee[it] : dn);
              u32x2 g0; g0.x = um[it].x; g0.y = um[it].y; u32x2 g1v; g1v.x = um[it].z; g1v.y = um[it].w;
              const f32x4 lo = hy_conv4(g0, pm, bflo(um[it].z), w0, w1, w2, cb), hi = hy_conv4(g1v, bfhi(um[it].y), pp, w0, w1, w2, cb);
              u32x4 o; o.x = pk2(lo[0], lo[1]); o.y = pk2(lo[2], lo[3]); o.z = pk2(hi[0], hi[1]); o.w = pk2(hi[2], hi[3]);
              *(LAS u32x4*)(U + b * HY_LDU + t8) = o; } }
        __syncthreads();
#pragma unroll
        for (int o = 0; o < 2; ++o) {
            const int gc = (o == 0) ? c : 1024 + c;
            int lz = lane; asm volatile("" : "+v"(lz));
            const bf16* grow = PT + (size_t)gc * MTOK + (size_t)(lz & 15) * SEQ;
            u32x2 gm[16];
#pragma unroll
            for (int tt = 0; tt < 16; ++tt) gm[tt] = *(const u32x2*)(grow + 256 * w + 16 * tt + 4 * fq);
            const unsigned edge_lo = (w > 0) ? (unsigned)grow[256 * w - 1] : 0u, edge_hi = (w < 7) ? (unsigned)grow[256 * w + 256] : 0u;
            if (o == 0) hy_load_kern(kr, KERN + ((size_t)c * 2 + 1) * 4096, tid);
            else if (has_next) hy_load_kern(kr, KERN + ((size_t)(c + F.G) * 2 + 0) * 4096, tid);
            f32x4 acc[16];
#pragma unroll
            for (int i = 0; i < 16; ++i) acc[i] = (f32x4){0.f, 0.f, 0.f, 0.f};
            const LAS bf16* kbase = KC + (fr & 7) * HY_KCS + 2048 + 8 * fq - 8 * (fr >> 3) - 256 * w;
            const LAS bf16* ubase = U + fr * HY_LDU + 8 * fq;
            bf16x8 win[16];
#pragma unroll
            for (int i = 0; i < 16; ++i) win[i] = *(const LAS bf16x8*)(kbase - 16 * i);
            bf16x8 bnx = *(const LAS bf16x8*)(ubase);
#pragma unroll 1
            for (int sj8 = 0; sj8 < 64; sj8 += 8) {
#pragma unroll
                for (int u = 0; u < 8; ++u) { const int sj = sj8 + u;
                    const bf16x8 bfr = bnx;
                    bnx = *(const LAS bf16x8*)(ubase + 32 * ((sj + 1) & 63));
#pragma unroll
                    for (int t2 = 2; t2 < 18; ++t2) { const int tt = t2 & 15;
                        acc[tt] = __builtin_amdgcn_mfma_f32_16x16x32_bf16(win[(tt - 2 * u) & 15], bfr, acc[tt], 0, 0, 0); }
                    win[(14 - 2 * u) & 15] = *(const LAS bf16x8*)(kbase + 16 * (2 * sj + 2));
                    win[(15 - 2 * u) & 15] = *(const LAS bf16x8*)(kbase + 16 * (2 * sj + 1));
                } }
            if (o == 1 && has_next) load_v(c + F.G);
            const float hbias = hb[o * DM + c];
            const float w0 = cw[0 * HYC + gc], w1 = cw[1 * HYC + gc], w2 = cw[2 * HYC + gc], cb = cbv[gc];
            u32x2 zpk[16];
            unsigned pa[16], nb[16];
#pragma unroll
            for (int tt = 0; tt < 16; ++tt) { pa[tt] = __shfl(gm[tt].y >> 16, (lane + 48) & 63); nb[tt] = __shfl(gm[tt].x & 0xffffu, (lane + 16) & 63); }
#pragma unroll
            for (int tt = 0; tt < 16; ++tt) { const int t0 = 256 * w + 16 * tt + 4 * fq;
                const unsigned pmv = (fq > 0) ? pa[tt] : (tt > 0 ? pa[tt > 0 ? tt - 1 : 0] : edge_lo), ppv = (fq < 3) ? nb[tt] : (tt < 15 ? nb[tt < 15 ? tt + 1 : 15] : edge_hi);
                const u32x2 uu = *(const LAS u32x2*)(U + fr * HY_LDU + t0);
                const f32x4 g = hy_conv4(gm[tt], bf2f(pmv), bf2f(ppv), w0, w1, w2, cb);
                f32x4 y = acc[tt]; y[0] = g[0] * (y[0] + bflo(uu.x) * hbias); y[1] = g[1] * (y[1] + bfhi(uu.x) * hbias); y[2] = g[2] * (y[2] + bflo(uu.y) * hbias); y[3] = g[3] * (y[3] + bfhi(uu.y) * hbias);
                zpk[tt].x = pk2(y[0], y[1]); zpk[tt].y = pk2(y[2], y[3]); }
            __syncthreads();
            if (o == 0) {
#pragma unroll
                for (int tt = 0; tt < 16; ++tt) *(LAS u32x2*)(U + fr * HY_LDU + 256 * w + 16 * tt + 4 * fq) = zpk[tt];
                hy_store_kc(KC, kr, tid);
                __syncthreads();
            } else {
                int ly = lane; asm volatile("" : "+v"(ly));
                bf16* yrow = YT + (size_t)c * MTOK + (size_t)(ly & 15) * SEQ + 256 * w + 4 * (ly >> 4);
#pragma unroll
                for (int tt = 0; tt < 16; ++tt) *(u32x2*)(yrow + 16 * tt) = zpk[tt];
            }
        }
    }
}

__device__ __forceinline__ void ssd_conv_phase(Frame& F) {
    bf16* XBC = (bf16*)(F.ws + WS_XBC); const bf16* HALO = (const bf16*)(F.ws + WS_HALO);
    const float* scw = F.in[I_SCW]; const float* scb = F.in[I_SCB];
    const int gw = F.vcu * NWAVES + F.wave, NGW = F.G * NWAVES, lane = F.lane;
    for (int item = gw; item < BATCH * 32 * 8; item += NGW) {
        const int cb8 = item & 7, seg = (item >> 3) & 31, b = item >> 8, col = cb8 * 512 + lane * 8;
        float wk[5][8], cbv[8];
#pragma unroll
        for (int k = 0; k < 5; ++k) { const f32x4 a = *(const f32x4*)(scw + k * CONVD + col), c = *(const f32x4*)(scw + k * CONVD + col + 4);
#pragma unroll
            for (int e = 0; e < 4; ++e) { wk[k][e] = a[e]; wk[k][4 + e] = c[e]; } }
        { const f32x4 a = *(const f32x4*)(scb + col), c = *(const f32x4*)(scb + col + 4);
#pragma unroll
          for (int e = 0; e < 4; ++e) { cbv[e] = a[e]; cbv[4 + e] = c[e]; } }
        bf16* xrow0 = XBC + ((size_t)b * SEQ + seg * 64) * CONVD + col;
        const bf16* hlo = HALO + ((size_t)(b * 33 + seg) * 4) * CONVD + col;
        const bf16* hhi = HALO + ((size_t)(b * 33 + seg + 1) * 4 + 2) * CONVD + col;
        const u32x4 zero4 = {0u, 0u, 0u, 0u};
        u32x4 W[12];
        W[0] = seg > 0 ? *(const u32x4*)(hlo) : zero4; W[1] = seg > 0 ? *(const u32x4*)(hlo + CONVD) : zero4;
        W[2] = *(const u32x4*)(xrow0); W[3] = *(const u32x4*)(xrow0 + CONVD);
#pragma unroll 1
        for (int blk = 0; blk < 8; ++blk) { const int r0 = 8 * blk;
#pragma unroll
            for (int i = 4; i < 12; ++i) { const int rr = r0 - 2 + i;
                if (rr < 64) W[i] = *(const u32x4*)(xrow0 + (size_t)rr * CONVD);
                else W[i] = (seg < 31) ? *(const u32x4*)(hhi + (size_t)(rr - 64) * CONVD) : zero4; }
#pragma unroll
            for (int o = 0; o < 8; ++o) { float v[8];
#pragma unroll
                for (int e = 0; e < 8; ++e) v[e] = cbv[e];
#pragma unroll
                for (int k = 0; k < 5; ++k) { const u32x4 p = W[o + k];
                    v[0] += wk[k][0] * bflo(p.x); v[1] += wk[k][1] * bfhi(p.x); v[2] += wk[k][2] * bflo(p.y); v[3] += wk[k][3] * bfhi(p.y);
                    v[4] += wk[k][4] * bflo(p.z); v[5] += wk[k][5] * bfhi(p.z); v[6] += wk[k][6] * bflo(p.w); v[7] += wk[k][7] * bfhi(p.w); }
#pragma unroll
                for (int e = 0; e < 8; ++e) v[e] = siluf_(v[e]);
                u32x4 ov; ov.x = pk2(v[0], v[1]); ov.y = pk2(v[2], v[3]); ov.z = pk2(v[4], v[5]); ov.w = pk2(v[6], v[7]);
                *(u32x4*)(xrow0 + (size_t)(r0 + o) * CONVD) = ov; }
#pragma unroll
            for (int i = 0; i < 4; ++i) W[i] = W[8 + i];
        }
    }
}

constexpr int SS_LDC = 144, SS_LDM = 136;
constexpr int SS_C = 0, SS_B = 18432, SS_X = 36864, SS_XE = 55296, SS_M = 73728, SS_SB = 108544, SS_ACS = 145408, SS_DTV = 146432, SS_TOE = 147456, SS_END = 148480;
static_assert(SS_END <= MISC_OFF, "SSD LDS map");
typedef short s16x4 __attribute__((ext_vector_type(4)));
__device__ __forceinline__ bf16x8 ssd_trfrag(const LAS bf16* p) {
    const s16x4 a = __builtin_amdgcn_ds_read_tr16_b64_v4i16((LAS s16x4*)p), b = __builtin_amdgcn_ds_read_tr16_b64_v4i16((LAS s16x4*)(p + 16 * SS_LDC));
    return __builtin_shufflevector(a, b, 0, 1, 2, 3, 4, 5, 6, 7);
}

__device__ __forceinline__ void ssd_phase(Frame& F) {
    LAS unsigned char* L = F.lds;
    LAS bf16* Cl = (LAS bf16*)(L + SS_C); LAS bf16* Bl = (LAS bf16*)(L + SS_B); LAS bf16* Xr = (LAS bf16*)(L + SS_X); LAS bf16* XEr = (LAS bf16*)(L + SS_XE);
    LAS bf16* Ml = (LAS bf16*)(L + SS_M); LAS bf16* SB = (LAS bf16*)(L + SS_SB);
    LAS float* ACS = (LAS float*)(L + SS_ACS); LAS float* DTV = (LAS float*)(L + SS_DTV); LAS float* TOE = (LAS float*)(L + SS_TOE);
    const bf16* XBC = (const bf16*)(F.ws + WS_XBC); const float* DT = (const float*)(F.ws + WS_DT); const unsigned char* Z8 = (const unsigned char*)F.out; bf16* YS = (bf16*)(F.ws + WS_YSSD);
    const float* dtb = F.in[I_DTB]; const float* alog = F.in[I_ALOG]; const float* sd = F.in[I_SD];
    const int tid = F.tid, lane = F.lane, w = F.wave, fr = lane & 15, fq = lane >> 4;
    for (int unit = F.vcu; unit < BATCH * NGRP * 2; unit += F.G) {
        const int b = unit >> 4, g = (unit >> 1) & 7, hp = unit & 1, h0 = 4 * g + 2 * hp;
#pragma unroll 1
        for (int dir = 0; dir < 2; ++dir) {
            const float dtbias = (w < 2) ? dtb[dir * 32 + h0 + w] : 0.f, aexp = (w < 2) ? __expf(alog[dir * 32 + h0 + w]) : 0.f;
            auto scan = [&](int buf, float raw) {
                raw += dtbias; const float dtv = raw > 20.f ? raw : log1pf(__expf(raw)); float a = -dtv * aexp;
#pragma unroll
                for (int o = 1; o < 64; o <<= 1) { const float v = __shfl_up(a, o); if (lane >= o) a += v; }
                const float tot = __shfl(a, 63); const int ix = (buf * 2 + w) * 64 + lane;
                ACS[ix] = a; DTV[ix] = dtv; TOE[ix] = __expf(tot - a); };
            auto dtload = [&](int ci) -> float { const int ch = dir ? 31 - ci : ci, r = dir ? 63 - lane : lane;
                return DT[((size_t)b * SEQ + 64 * ch + r) * 64 + dir * 32 + h0 + w]; };
            auto rowload = [&](int ci, int it, int tl) -> u32x4 {
                const int l = (tl >> 4) + 32 * (it & 1), j = tl & 15, ch = dir ? 31 - ci : ci, r = dir ? 63 - l : l;
                const int col = (it < 2 ? 64 * h0 : (it < 4 ? 2048 + 128 * g : 3072 + 128 * g)) + 8 * j;
                return *(const u32x4*)(XBC + ((size_t)b * SEQ + 64 * ch + r) * CONVD + col); };
            f32x4 Sacc[8];
#pragma unroll
            for (int i = 0; i < 8; ++i) Sacc[i] = (f32x4){0.f, 0.f, 0.f, 0.f};
            const float dsk = sd[h0 + (w >> 2)];
            __syncthreads();
            for (int i = tid; i < 2 * 64 * SS_LDC / 2; i += NTHR) ((LAS unsigned*)SB)[i] = 0u;
            float dtn = 0.f;
            if (w < 2) { scan(0, dtload(0)); dtn = dtload(1); }
            u32x4 pf[6];
#pragma unroll
            for (int it = 0; it < 6; ++it) pf[it] = rowload(0, it, tid);
            __syncthreads();
#pragma unroll 1
            for (int ci = 0; ci < 32; ++ci) {
                const int ch = dir ? 31 - ci : ci, buf = ci & 1;
                const size_t tokbase = (size_t)b * SEQ + 64 * ch;
                int tl = tid; asm volatile("" : "+v"(tl));
                int frl = fr, fql = fq; asm volatile("" : "+v"(frl), "+v"(fql));
                const LAS float* acs = ACS + buf * 128; const LAS float* dtv = DTV + buf * 128; const LAS float* toe = TOE + buf * 128;
#pragma unroll
                for (int it = 0; it < 6; ++it) { const int l = (tl >> 4) + 32 * (it & 1), j = tl & 15; const u32x4 p = pf[it];
                    if (it < 2) { const int hh = j >> 3; const float de = dtv[hh * 64 + l] * toe[hh * 64 + l];
                        *(LAS u32x4*)(Xr + l * SS_LDC + j * 8) = p;
                        u32x4 q; q.x = pk2(bflo(p.x) * de, bfhi(p.x) * de); q.y = pk2(bflo(p.y) * de, bfhi(p.y) * de); q.z = pk2(bflo(p.z) * de, bfhi(p.z) * de); q.w = pk2(bflo(p.w) * de, bfhi(p.w) * de);
                        *(LAS u32x4*)(XEr + l * SS_LDC + j * 8) = q; }
                    else if (it < 4) { *(LAS u32x4*)(Bl + l * SS_LDC + j * 8) = p; }
                    else { *(LAS u32x4*)(Cl + l * SS_LDC + j * 8) = p; } }
                if (ci + 1 < 32) {
#pragma unroll
                    for (int it = 0; it < 6; ++it) pf[it] = rowload(ci + 1, it, tl); }
                __syncthreads();
                const int hh = w >> 2, li = w & 3, lrow = 16 * li + frl;
                const int rloc = dir ? 63 - lrow : lrow; const size_t tok = tokbase + rloc;
                u32x2 pv[4]; unsigned zv[4];
                if (dir) {
#pragma unroll
                    for (int pi = 0; pi < 4; ++pi) { const size_t o = tok * DSSM + 64 * (h0 + hh) + 16 * pi + 4 * fql; pv[pi] = *(const u32x2*)(YS + o); zv[pi] = *(const unsigned*)(Z8 + o); } }
#define SSD_FENCE() asm volatile("s_waitcnt lgkmcnt(0)" ::: "memory")
#define SSD_TIE8(a) asm volatile("s_waitcnt lgkmcnt(0)" : "+v"(a[0][0]), "+v"(a[0][1]), "+v"(a[1][0]), "+v"(a[1][1]), "+v"(a[2][0]), "+v"(a[2][1]), "+v"(a[3][0]), "+v"(a[3][1]) :: "memory")
#define SSD_TIE8K(a) asm volatile("s_waitcnt lgkmcnt(0)" : "+v"(a[0][0]), "+v"(a[0][1]), "+v"(a[0][2]), "+v"(a[0][3]), "+v"(a[1][0]), "+v"(a[1][1]), "+v"(a[1][2]), "+v"(a[1][3]) :: "memory")
                f32x4 Y[4];
                { bf16x8 cfr[4];
#pragma unroll
                  for (int kk = 0; kk < 4; ++kk) cfr[kk] = *(const LAS bf16x8*)(Cl + lrow * SS_LDC + 8 * fql + 32 * kk);
#pragma unroll
                  for (int ph = 0; ph < 2; ++ph) { bf16x8 sfr[2][4];
#pragma unroll
                      for (int pp = 0; pp < 2; ++pp)
#pragma unroll
                          for (int kk = 0; kk < 4; ++kk) sfr[pp][kk] = *(const LAS bf16x8*)(SB + (hh * 64 + 16 * (2 * ph + pp) + frl) * SS_LDC + 8 * fql + 32 * kk);
                      SSD_TIE8K(sfr);
#pragma unroll
                      for (int pp = 0; pp < 2; ++pp) { Y[2 * ph + pp] = (f32x4){0.f, 0.f, 0.f, 0.f};
#pragma unroll
                          for (int kk = 0; kk < 4; ++kk) Y[2 * ph + pp] = __builtin_amdgcn_mfma_f32_16x16x32_bf16(sfr[pp][kk], cfr[kk], Y[2 * ph + pp], 0, 0, 0); }
                      __builtin_amdgcn_sched_barrier(0); } }
                { bf16x8 cbA[2][4], cbB[2][4]; f32x4 tas[2], tdd[2]; float tal[2];
#pragma unroll
                  for (int q = 0; q < 2; ++q) { const int id = 2 * w + q, si = id >> 2, lj = id & 3;
                      if (si <= lj) {
#pragma unroll
                          for (int kk = 0; kk < 4; ++kk) { cbA[q][kk] = *(const LAS bf16x8*)(Bl + (16 * si + frl) * SS_LDC + 8 * fql + 32 * kk); cbB[q][kk] = *(const LAS bf16x8*)(Cl + (16 * lj + frl) * SS_LDC + 8 * fql + 32 * kk); } } }
                  auto tab_load = [&](int q) { const int id = 2 * w + q, si = id >> 2, lj = id & 3, l = 16 * lj + frl, s0 = 16 * si + 4 * fql;
#pragma unroll
                      for (int h = 0; h < 2; ++h) { tas[h] = *(const LAS f32x4*)(acs + 64 * h + s0); tdd[h] = *(const LAS f32x4*)(dtv + 64 * h + s0); tal[h] = acs[64 * h + l]; } };
                  tab_load(0);
                  SSD_FENCE();
#pragma unroll
                  for (int q = 0; q < 2; ++q) { const int id = 2 * w + q, si = id >> 2, lj = id & 3, l = 16 * lj + frl, s0 = 16 * si + 4 * fql;
                      u32x2 m0 = {0u, 0u}, m1 = {0u, 0u};
                      if (si <= lj) { f32x4 cb = (f32x4){0.f, 0.f, 0.f, 0.f};
#pragma unroll
                          for (int kk = 0; kk < 4; ++kk) cb = __builtin_amdgcn_mfma_f32_16x16x32_bf16(cbA[q][kk], cbB[q][kk], cb, 0, 0, 0);
                          float x0[4], x1[4];
#pragma unroll
                          for (int j = 0; j < 4; ++j) { const bool keep = (s0 + j <= l);
                              const float e0 = __expf(fminf(tal[0] - tas[0][j], 0.f)) * tdd[0][j], e1 = __expf(fminf(tal[1] - tas[1][j], 0.f)) * tdd[1][j];
                              const float c = keep ? cb[j] : 0.f; x0[j] = c * e0; x1[j] = c * e1; }
                          m0.x = pk2(x0[0], x0[1]); m0.y = pk2(x0[2], x0[3]); m1.x = pk2(x1[0], x1[1]); m1.y = pk2(x1[2], x1[3]); }
                      if (q == 0) tab_load(1);
                      *(LAS u32x2*)(Ml + (0 * 64 + l) * SS_LDM + s0) = m0; *(LAS u32x2*)(Ml + (1 * 64 + l) * SS_LDM + s0) = m1; } }
                __syncthreads();
                const int trb = (4 * fql + (frl >> 2)) * SS_LDC + 4 * (frl & 3);
                { bf16x8 mf[2], xdf[4][2];
#pragma unroll
                  for (int kk = 0; kk < 2; ++kk) { const LAS bf16* mp = Ml + (hh * 64 + lrow) * SS_LDM + 32 * kk + 4 * fql;
                      const s16x4 a = *(const LAS s16x4*)mp, b2 = *(const LAS s16x4*)(mp + 16); mf[kk] = __builtin_shufflevector(a, b2, 0, 1, 2, 3, 4, 5, 6, 7); }
#pragma unroll
                  for (int pi = 0; pi < 4; ++pi)
#pragma unroll
                      for (int kk = 0; kk < 2; ++kk) xdf[pi][kk] = ssd_trfrag(Xr + trb + 32 * kk * SS_LDC + hh * 64 + 16 * pi);
                  const float el = __expf(acs[hh * 64 + lrow]);
                  SSD_TIE8(xdf);
#pragma unroll
                  for (int pi = 0; pi < 4; ++pi) { Y[pi] = Y[pi] * el;
                      Y[pi] = __builtin_amdgcn_mfma_f32_16x16x32_bf16(xdf[pi][0], mf[0], Y[pi], 0, 0, 0);
                      Y[pi] = __builtin_amdgcn_mfma_f32_16x16x32_bf16(xdf[pi][1], mf[1], Y[pi], 0, 0, 0); }
                  __builtin_amdgcn_sched_barrier(0);
#pragma unroll
                  for (int pi = 0; pi < 4; ++pi) { const int p0 = 16 * pi + 4 * fql; bf16* yp = YS + tok * DSSM + 64 * (h0 + hh) + p0; f32x4 y = Y[pi];
                      if (dir == 0) { const u32x2 xv = *(const LAS u32x2*)(Xr + lrow * SS_LDC + hh * 64 + p0);
                          y[0] += dsk * bflo(xv.x); y[1] += dsk * bfhi(xv.x); y[2] += dsk * bflo(xv.y); y[3] += dsk * bfhi(xv.y);
                      } else { const u32x2 pvv = pv[pi]; const f32x2 z01 = __builtin_amdgcn_cvt_pk_f32_fp8((int)zv[pi], false), z23 = __builtin_amdgcn_cvt_pk_f32_fp8((int)zv[pi], true);
                          y[0] = (y[0] + bflo(pvv.x)) * siluf_(z01.x); y[1] = (y[1] + bfhi(pvv.x)) * siluf_(z01.y); y[2] = (y[2] + bflo(pvv.y)) * siluf_(z23.x); y[3] = (y[3] + bfhi(pvv.y)) * siluf_(z23.y); }
                      u32x2 o; o.x = pk2(y[0], y[1]); o.y = pk2(y[2], y[3]); *(u32x2*)yp = o; }
                  __builtin_amdgcn_sched_barrier(0); }
                { const int pi5 = w & 3; const float dec = __expf(acs[hh * 64 + 63]);
                  bf16x8 xef[2];
#pragma unroll
                  for (int kk = 0; kk < 2; ++kk) xef[kk] = ssd_trfrag(XEr + trb + 32 * kk * SS_LDC + hh * 64 + 16 * pi5);
#pragma unroll
                  for (int nh = 0; nh < 2; ++nh) { bf16x8 btf[4][2];
#pragma unroll
                      for (int nn = 0; nn < 4; ++nn)
#pragma unroll
                          for (int kk = 0; kk < 2; ++kk) btf[nn][kk] = ssd_trfrag(Bl + trb + 32 * kk * SS_LDC + 16 * (4 * nh + nn));
                      SSD_TIE8(btf);
#pragma unroll
                      for (int nn = 0; nn < 4; ++nn) { const int ni = 4 * nh + nn; Sacc[ni] = Sacc[ni] * dec;
                          Sacc[ni] = __builtin_amdgcn_mfma_f32_16x16x32_bf16(btf[nn][0], xef[0], Sacc[ni], 0, 0, 0);
                          Sacc[ni] = __builtin_amdgcn_mfma_f32_16x16x32_bf16(btf[nn][1], xef[1], Sacc[ni], 0, 0, 0); }
                      __builtin_amdgcn_sched_barrier(0); }
#pragma unroll
                  for (int ni = 0; ni < 8; ++ni) { u32x2 o; o.x = pk2(Sacc[ni][0], Sacc[ni][1]); o.y = pk2(Sacc[ni][2], Sacc[ni][3]);
                      *(LAS u32x2*)(SB + (hh * 64 + 16 * pi5 + frl) * SS_LDC + 16 * ni + 4 * fql) = o; } }
                if (w < 2 && ci + 1 < 32) { scan(buf ^ 1, dtn); if (ci + 2 < 32) dtn = dtload(ci + 2); }
                __syncthreads();
            }
        }
    }
}

__device__ __forceinline__ void ssd_norm_phase(Frame& F) {
    bf16* YS = (bf16*)(F.ws + WS_YSSD); const float* nw = F.in[I_SNW];
    const int gw = F.vcu * NWAVES + F.wave, NGW = F.G * NWAVES, lane = F.lane;
    f32x4 wv[8];
#pragma unroll
    for (int j = 0; j < 8; ++j) wv[j] = *(const f32x4*)(nw + lane * 32 + 4 * j);
    for (int m = gw; m < MTOK; m += 2 * NGW) {
        u32x4 v[2][4];
#pragma unroll
        for (int u = 0; u < 2; ++u)
#pragma unroll
            for (int j = 0; j < 4; ++j) v[u][j] = *(const u32x4*)(YS + (size_t)((m + u * NGW < MTOK) ? m + u * NGW : m) * DSSM + lane * 32 + 8 * j);
#pragma unroll
        for (int u = 0; u < 2; ++u) { if (m + u * NGW >= MTOK) break; bf16* row = YS + (size_t)(m + u * NGW) * DSSM + lane * 32; float ss = 0.f;
#pragma unroll
            for (int j = 0; j < 4; ++j) { const u32x4 q = v[u][j];
                const float a0 = bflo(q.x), a1 = bfhi(q.x), a2 = bflo(q.y), a3 = bfhi(q.y), a4 = bflo(q.z), a5 = bfhi(q.z), a6 = bflo(q.w), a7 = bfhi(q.w);
                ss += (a0 * a0 + a1 * a1) + (a2 * a2 + a3 * a3) + (a4 * a4 + a5 * a5) + (a6 * a6 + a7 * a7); }
            ss += __shfl_xor(ss, 1); ss += __shfl_xor(ss, 2); ss += __shfl_xor(ss, 4);
            const float rs = 1.0f / sqrtf(ss * (1.0f / 256.0f) + RMS_EPS);
#pragma unroll
            for (int j = 0; j < 4; ++j) { const u32x4 q = v[u][j]; const f32x4 w0 = wv[2 * j], w1 = wv[2 * j + 1];
                u32x4 o; o.x = pk2(bflo(q.x) * rs * w0[0], bfhi(q.x) * rs * w0[1]); o.y = pk2(bflo(q.y) * rs * w0[2], bfhi(q.y) * rs * w0[3]);
                o.z = pk2(bflo(q.z) * rs * w1[0], bfhi(q.z) * rs * w1[1]); o.w = pk2(bflo(q.w) * rs * w1[2], bfhi(q.w) * rs * w1[3]);
                *(u32x4*)(row + 8 * j) = o; } } }
}

constexpr int RT_WC = 131072;
__device__ __forceinline__ void ln1_router_phase(Frame& F) {
    const bf16* H1P = (const bf16*)(F.ws + WS_H1P); bf16* H1B = (bf16*)F.out;
    int* TOK = (int*)(F.ws + WS_TOK); float* WGT = (float*)(F.ws + WS_WGT); int* ASG = (int*)(F.ws + WS_ASG);
    const float* g1 = F.in[I_LN1G]; const float* b1 = F.in[I_LN1B]; const float* rw = F.in[I_RW]; const float* rb = F.in[I_RB];
    LAS float* hrow = (LAS float*)(F.lds + F.wave * 16384);
    LAS float* wc = (LAS float*)(F.lds + RT_WC);
    LAS unsigned* cl = (LAS unsigned*)(F.lds + RT_WC + 16384);
    if (F.tid < 64) cl[F.tid] = 0u;
    __syncthreads();
    const int lane = F.lane, tid = F.tid;
    f32x4 gv[4], bv[4];
#pragma unroll
    for (int j = 0; j < 4; ++j) { gv[j] = *(const f32x4*)(g1 + 4 * lane + 256 * j); bv[j] = *(const f32x4*)(b1 + 4 * lane + 256 * j); }
    const float rbias = rb[lane];
    for (int step = F.vcu; step < MTOK / 32; step += F.G) {
        const int rg = step * 8 + F.wave;
        f32x4 nx0 = *(const f32x4*)(rw + tid * 4), nx1 = *(const f32x4*)(rw + 2048 + tid * 4);
#pragma unroll 1
        for (int r = 0; r < 4; ++r) { const size_t m = (size_t)rg * 4 + r; const bf16* xr = H1P + m * DM;
            f32x4 v[4]; float s = 0.f;
#pragma unroll
            for (int j = 0; j < 4; ++j) { const u32x2 q = *(const u32x2*)(xr + 4 * lane + 256 * j); v[j][0] = bflo(q.x); v[j][1] = bfhi(q.x); v[j][2] = bflo(q.y); v[j][3] = bfhi(q.y); s += (v[j][0] + v[j][1]) + (v[j][2] + v[j][3]); }
            const float mean = wave_sum(s) * (1.f / DM); float s2 = 0.f;
#pragma unroll
            for (int j = 0; j < 4; ++j) { v[j] = v[j] - mean; s2 += (v[j][0] * v[j][0] + v[j][1] * v[j][1]) + (v[j][2] * v[j][2] + v[j][3] * v[j][3]); }
            const float rstd = 1.f / sqrtf(wave_sum(s2) * (1.f / DM) + LN_EPS);
#pragma unroll
            for (int j = 0; j < 4; ++j) { const f32x4 h = v[j] * rstd * gv[j] + bv[j];
                u32x2 o; o.x = pk2(h[0], h[1]); o.y = pk2(h[2], h[3]); *(u32x2*)(H1B + m * H1B_PITCH + 4 * lane + 256 * j) = o;
                *(LAS f32x4*)(hrow + r * 1024 + 4 * lane + 256 * j) = h; } }
        float lg[4] = {0.f, 0.f, 0.f, 0.f};
#pragma unroll 1
        for (int kc = 0; kc < 16; ++kc) {
            __syncthreads();
            *(LAS f32x4*)(wc + tid * 4) = nx0; *(LAS f32x4*)(wc + 2048 + tid * 4) = nx1;
            if (kc + 1 < 16) { nx0 = *(const f32x4*)(rw + (kc + 1) * 4096 + tid * 4); nx1 = *(const f32x4*)(rw + (kc + 1) * 4096 + 2048 + tid * 4); }
            __syncthreads();
#pragma unroll 4
            for (int kk = 0; kk < 64; kk += 4) {
                const float w0 = wc[(kk + 0) * 64 + lane], w1 = wc[(kk + 1) * 64 + lane], w2 = wc[(kk + 2) * 64 + lane], w3 = wc[(kk + 3) * 64 + lane];
#pragma unroll
                for (int r = 0; r < 4; ++r) { const f32x4 h = *(const LAS f32x4*)(hrow + r * 1024 + kc * 64 + kk); lg[r] += h[0] * w0 + h[1] * w1 + h[2] * w2 + h[3] * w3; } }
        }
        bool selr[4]; float wgr[4]; int rkr[4];
#pragma unroll
        for (int r = 0; r < 4; ++r) {
            const float score = 1.0f / (1.0f + expf(-lg[r])), biased = score + rbias;
            float m1 = biased; m1 = fmaxf(m1, __shfl_xor(m1, 1)); m1 = fmaxf(m1, __shfl_xor(m1, 2)); m1 = fmaxf(m1, __shfl_xor(m1, 4));
            const unsigned long long eq = __ballot(biased == m1); const int gbase = lane & ~7; const int first = gbase + __ffs((unsigned)((eq >> gbase) & 0xffull)) - 1;
            float v2 = (lane == first) ? -INFINITY : biased; v2 = fmaxf(v2, __shfl_xor(v2, 1)); v2 = fmaxf(v2, __shfl_xor(v2, 2)); v2 = fmaxf(v2, __shfl_xor(v2, 4));
            const float gs = m1 + v2; const int g = lane >> 3; int better = 0;
#pragma unroll
            for (int d = 1; d < 8; ++d) { const int g2 = (g + d) & 7; const float og = __shfl(gs, g2 * 8); better += (og > gs || (og == gs && g2 < g)) ? 1 : 0; }
            float masked = (better < 4) ? biased : -INFINITY; bool sel = false;
#pragma unroll 1
            for (int it = 0; it < TOPK; ++it) { const float mx = wave_max(masked); const unsigned long long bm = __ballot(masked == mx); const int win = __ffsll((long long)bm) - 1;
                if (lane == win) { sel = true; masked = -INFINITY; } }
            const float sw = wave_sum(sel ? score : 0.f);
            const unsigned long long selm = __ballot(sel);
            selr[r] = sel; wgr[r] = score / sw * ROUTED_SCALE; rkr[r] = __popcll(selm & ((1ull << lane) - 1ull)); }
        unsigned lp[4];
#pragma unroll
        for (int r = 0; r < 4; ++r) lp[r] = selr[r] ? atomicAdd((unsigned*)(cl + lane), 1u) : 0u;
        __syncthreads();
        if (F.wave == 0) { const unsigned n = cl[lane]; unsigned bs = 0u;
            if (n) bs = __hip_atomic_fetch_add((unsigned*)(F.ctl + CW_CNT + 64 * lane), n, __ATOMIC_RELAXED, __HIP_MEMORY_SCOPE_AGENT);
            cl[64 + lane] = bs; cl[lane] = 0u; }
        __syncthreads();
        const unsigned bse = cl[64 + lane];
#pragma unroll
        for (int r = 0; r < 4; ++r) if (selr[r]) { const int m = rg * 4 + r; const unsigned pos = bse + lp[r];
            TOK[(size_t)lane * MTOK + pos] = m; WGT[(size_t)lane * MTOK + pos] = wgr[r]; ASG[(size_t)m * 8 + rkr[r]] = lane * MTOK + (int)pos; }
    }
}
constexpr int MOE_TP = 131072 + 1024, MOE_CNT = MOE_TP + 512, MOE_TE = 131072 + 4096;
__device__ __forceinline__ int moe_table(Frame& F) {
    LAS int* tp = (LAS int*)(F.lds + MOE_TP); LAS int* cnt = (LAS int*)(F.lds + MOE_CNT);
    __syncthreads();
    if (F.tid == 0) { int run = 0;
        for (int e = 0; e < NEX; ++e) { const int c = (e < NE) ? (int)__hip_atomic_load((unsigned*)(F.ctl + CW_CNT + 64 * e), __ATOMIC_RELAXED, __HIP_MEMORY_SCOPE_AGENT) : MTOK;
            cnt[e] = c; tp[e] = run; run += (c + 255) >> 8; }
        tp[NEX] = run; }
    __syncthreads();
    { LAS int* te = (LAS int*)(F.lds + MOE_TE); const int total = tp[NEX];
      for (int t = F.tid; t < total; t += NTHR) { int e = 0;
#pragma unroll 1
          for (int s = 64; s >= 1; s >>= 1) if (e + s <= NE && tp[e + s] <= t) e += s;
          te[t] = e; } }
    __syncthreads();
    return tp[NEX];
}
__device__ __forceinline__ void fp8x4_fma(f32x4& a, const unsigned v, const float w) {
    const f32x2 p0 = __builtin_amdgcn_cvt_pk_f32_fp8((int)v, false), p1 = __builtin_amdgcn_cvt_pk_f32_fp8((int)v, true);
    a[0] += w * p0.x; a[1] += w * p0.y; a[2] += w * p1.x; a[3] += w * p1.y;
}
__device__ __forceinline__ void moe_combine_phase(Frame& F) {
    const bf16* H1B = (const bf16*)F.out; const unsigned char* YQ = (const unsigned char*)(F.ws + WS_YQ); const int* ASG = (const int*)(F.ws + WS_ASG); const float* WGT = (const float*)(F.ws + WS_WGT);
    const LAS int* tp = (const LAS int*)(F.lds + MOE_TP);
    const float* g2 = F.in[I_LN2G]; const float* b2 = F.in[I_LN2B];
    const int gw = F.vcu * NWAVES + F.wave, NGW = F.G * NWAVES, lane = F.lane;
    const size_t shbase = (size_t)tp[NE] * 256;
    f32x4 gv[4], bv[4];
#pragma unroll
    for (int j = 0; j < 4; ++j) { gv[j] = *(const f32x4*)(g2 + 4 * lane + 256 * j); bv[j] = *(const f32x4*)(b2 + 4 * lane + 256 * j); }
    const int l8 = lane & 7;
    int li = ASG[(size_t)gw * 8 + l8];
    float wk = WGT[li];
    int li_n = (gw + NGW < MTOK) ? ASG[(size_t)(gw + NGW) * 8 + l8] : 0;
    for (int m = gw; m < MTOK; m += NGW) {
        const int e = li >> 15, pos = li & 32767; const int slot = 256 * tp[e] + pos; const float wcur = wk;
        unsigned vv[9][4]; f32x4 v[4];
        { const unsigned char* sp = YQ + (shbase + m) * 1024 + 4 * lane;
#pragma unroll
          for (int j = 0; j < 4; ++j) vv[8][j] = *(const unsigned*)(sp + 256 * j); }
#pragma unroll
        for (int k = 0; k < 8; ++k) { const int sk = __shfl(slot, k); const unsigned char* sp = YQ + (size_t)sk * 1024 + 4 * lane;
#pragma unroll
            for (int j = 0; j < 4; ++j) vv[k][j] = *(const unsigned*)(sp + 256 * j); }
        float* xr = F.out + (size_t)m * DM + 4 * lane; const bf16* hr = H1B + (size_t)m * H1B_PITCH + 4 * lane; u32x2 hq[4];
#pragma unroll
        for (int j = 0; j < 4; ++j) hq[j] = *(const u32x2*)(hr + 256 * j);
        li = li_n; wk = WGT[li];
        li_n = (m + 2 * NGW < MTOK) ? ASG[(size_t)(m + 2 * NGW) * 8 + l8] : 0;
#pragma unroll
        for (int j = 0; j < 4; ++j) { v[j][0] = DN_ALPHA * bflo(hq[j].x); v[j][1] = DN_ALPHA * bfhi(hq[j].x); v[j][2] = DN_ALPHA * bflo(hq[j].y); v[j][3] = DN_ALPHA * bfhi(hq[j].y); fp8x4_fma(v[j], vv[8][j], 1.0f); }
#pragma unroll
        for (int k = 0; k < 8; ++k) { const float w = __shfl(wcur, k);
#pragma unroll
            for (int j = 0; j < 4; ++j) fp8x4_fma(v[j], vv[k][j], w); }
        float s = 0.f;
#pragma unroll
        for (int j = 0; j < 4; ++j) s += (v[j][0] + v[j][1]) + (v[j][2] + v[j][3]);
        const float mean = wave_sum(s) * (1.f / DM); float s2 = 0.f;
#pragma unroll
        for (int j = 0; j < 4; ++j) { v[j] = v[j] - mean; s2 += (v[j][0] * v[j][0] + v[j][1] * v[j][1]) + (v[j][2] * v[j][2] + v[j][3] * v[j][3]); }
        const float rstd = 1.f / sqrtf(wave_sum(s2) * (1.f / DM) + LN_EPS);
#pragma unroll
        for (int j = 0; j < 4; ++j) *(f32x4*)(xr + 256 * j) = v[j] * rstd * gv[j] + bv[j];
    }
}

#ifndef MK_N_LAUNCHES
#define MK_N_LAUNCHES 1
#endif
constexpr int NPH = 15;
constexpr int N_LAUNCHES = MK_N_LAUNCHES;

__global__ void __launch_bounds__(NTHR, 2) fwd_kernel(Args args) {
    extern __shared__ __attribute__((aligned(16))) unsigned char lds_raw[];
    Frame F;
    F.lds = (LAS unsigned char*)lds_raw;
    F.MISC = (volatile LAS unsigned*)(F.lds + MISC_OFF);
    F.tid = threadIdx.x; F.lane = F.tid & 63; F.wave = __builtin_amdgcn_readfirstlane(F.tid >> 6);
    F.G = gridDim.x; { const int bx = blockIdx.x; F.vcu = (F.G % 8 == 0) ? (bx % 8) * (F.G / 8) + bx / 8 : bx; }
    F.ws = args.ws; F.ctl = (gu32*)(args.ws + WS_CTL); F.in = args.in; F.out = args.out;
    for (int u = F.tid; u < (LDS_BYTES - MISC_OFF) / 4; u += NTHR) ((LAS unsigned*)(F.lds + MISC_OFF))[u] = 0u;
    __syncthreads();
    XcdBarrier bar; bar.bar = (unsigned*)(F.ctl + CW_BAR); bar.x = 0; bar.st = nullptr;
    if (N_LAUNCHES != NPH) bar = xcd_barrier_post((unsigned*)(F.ctl + CW_BAR), F.MISC + 8);
    const int lo = args.ph_lo, hi = args.ph_hi;
#ifndef PH_MASK
#define PH_MASK 0x7fff
#endif
#define IN(k) ((((PH_MASK) >> (k)) & 1) && lo <= (k) && (k) < hi)
#ifdef STRESS_US
#define SKEW() do { if ((blockIdx.x * 2654435761u >> 28) & 1) { const unsigned long long t0_ = __builtin_amdgcn_s_memrealtime(); while (__builtin_amdgcn_s_memrealtime() - t0_ < (unsigned long long)(STRESS_US) * 100ull) __builtin_amdgcn_s_sleep(8); } __syncthreads(); } while (0)
#else
#define SKEW() do { } while (0)
#endif
#define SEAM(k) do { if (IN(k) && IN((k) + 1)) { xcd_barrier(bar); SKEW(); } } while (0)
#ifndef REP_MASK
#define REP_MASK 0
#endif
#define REPS(k) for (int rep_ = 0; rep_ < ((((REP_MASK) >> (k)) & 1) ? 2 : 1); ++rep_, ((((REP_MASK) >> (k)) & 1) && rep_ == 1 ? xcd_barrier(bar) : (void)0))
    const int G = F.G, bx = (int)blockIdx.x;

#ifdef START_BARS
    for (int xb_ = 0; xb_ < START_BARS; ++xb_) xcd_barrier(bar);
#endif
    if (IN(0)) REPS(0) { p0_prologue(F); } SEAM(0);
    if (IN(1)) REPS(1) {
        pg8::StaticOrder S; S.init((const bf16*)((unsigned char*)F.out + OUT_XB), (const bf16*)(F.ws + WS_WINT), MTOK, HYC, DM, G, bx);
        pg8::EpiHyT E{(bf16*)(F.ws + WS_PTHY), F.in[I_BIN], F.lds + pg8::STAGE_BYTES};
        pg8::gemm_phase<pg8::EpiHyT, pg8::StaticOrder, false>(F.lds, DM, S, E);
    } SEAM(1);
    if (IN(2)) REPS(2) { hyena_phase(F); } SEAM(2);
    if (IN(3)) REPS(3) { p3_transpose(F); } SEAM(3);
    if (IN(4)) REPS(4) {
        pg8::StaticOrder S; S.init((const bf16*)((unsigned char*)F.out + OUT_XB), (const bf16*)(F.ws + WS_WINT) + (size_t)3072 * DM, MTOK, 6400, DM, G, bx);
        pg8::EpiZXD E{(unsigned char*)F.out, (bf16*)(F.ws + WS_XBC), (float*)(F.ws + WS_DT), F.in[I_BIN], (bf16*)(F.ws + WS_HALO)};
        pg8::gemm_phase<pg8::EpiZXD, pg8::StaticOrder, false>(F.lds, DM, S, E);
    } SEAM(4);
    if (IN(5)) REPS(5) { ssd_conv_phase(F); } SEAM(5);
    if (IN(6)) REPS(6) { ssd_phase(F); } SEAM(6);
    if (IN(7)) REPS(7) { ssd_norm_phase(F); }
    if (IN(8)) REPS(8) {
        pg8::StaticOrder S; S.init((const bf16*)((unsigned char*)F.out + OUT_XB), (const bf16*)(F.ws + WS_WING), MTOK, 2048, DM, G, bx);
        pg8::EpiBf<0> E{(bf16*)(F.ws + WS_G), 2048, F.in[I_BIN] + 9280, nullptr, 0, nullptr};
        pg8::gemm_phase<pg8::EpiBf<0>, pg8::StaticOrder, false>(F.lds, DM, S, E);
    } SEAM(8);
    if (IN(9)) REPS(9) {
        pg8::StaticOrder S; S.init((const bf16*)(F.ws + WS_YHY), (const bf16*)(F.ws + WS_WHYB), MTOK, DM, DM, G, bx);
        pg8::EpiBf<1> E{(bf16*)(F.ws + WS_MIX), DM, nullptr, (const bf16*)(F.ws + WS_G), 2048, nullptr};
        pg8::gemm_phase<pg8::EpiBf<1>, pg8::StaticOrder, false>(F.lds, DM, S, E);
    }
    if (IN(10)) REPS(10) {
        pg8::StaticOrder S; S.init((const bf16*)(F.ws + WS_YSSD), (const bf16*)(F.ws + WS_WSSDB), MTOK, DM, DSSM, G, bx);
        pg8::EpiBf<2> E{(bf16*)(F.ws + WS_MIX), DM, nullptr, (const bf16*)(F.ws + WS_G) + 1024, 2048, (const bf16*)(F.ws + WS_MIX)};
        pg8::gemm_phase<pg8::EpiBf<2>, pg8::StaticOrder, false>(F.lds, DSSM, S, E);
    } SEAM(10);
    if (IN(11)) REPS(11) {
        pg8::StaticOrder S; S.init((const bf16*)(F.ws + WS_MIX), (const bf16*)(F.ws + WS_WOUT), MTOK, DM, DM, G, bx);
        pg8::EpiRes E{(bf16*)(F.ws + WS_H1P), F.in[I_BOUT], (const bf16*)((unsigned char*)F.out + OUT_XB), DN_ALPHA};
        pg8::gemm_phase<pg8::EpiRes, pg8::StaticOrder, false>(F.lds, DM, S, E);
        p10_expert_weights(F);
    } SEAM(11);
    if (IN(12)) REPS(12) { ln1_router_phase(F); } SEAM(12);
    if (IN(13)) REPS(13) {
        const int total = moe_table(F);
        pg8::MoeOrder<2, true> S{(const LAS int*)(F.lds + MOE_TP), (const LAS int*)(F.lds + MOE_CNT), (const LAS int*)(F.lds + MOE_TE), G, bx, total, (const char*)F.out, (const char*)(F.ws + WS_EW1), (const int*)(F.ws + WS_TOK)};
        pg8::EpiSwiGLU E{(bf16*)(F.ws + WS_HID)};
        pg8::gemm_phase<pg8::EpiSwiGLU, pg8::MoeOrder<2, true>, true>(F.lds, DM, S, E);
    } SEAM(13);
    if (IN(14)) {
        const int total = moe_table(F);
        { pg8::SlotOrder4 S{(const LAS int*)(F.lds + MOE_TP), (const LAS int*)(F.lds + MOE_TE), G, bx, total, (const char*)(F.ws + WS_HID), (const char*)(F.ws + WS_EW2)};
          pg8::EpiSlot8 E{(unsigned char*)(F.ws + WS_YQ)}; int kd = DEXP; asm volatile("" : "+s"(kd));
          pg8::gemm_phase<pg8::EpiSlot8, pg8::SlotOrder4, false>(F.lds, kd, S, E); }
        xcd_barrier(bar);
        moe_combine_phase(F);
    }
#ifdef EXTRA_BARS
    for (int xb_ = 0; xb_ < EXTRA_BARS; ++xb_) xcd_barrier(bar);
#endif
#undef IN
#undef SEAM
}

extern "C" void kernel_launch(void* const* d_in, const int* in_sizes, int n_in, void* d_out, int out_size, void* d_ws, size_t ws_size, hipStream_t stream) {
    static int grid = 0;
    if (grid == 0) {
        if (n_in != 38 || out_size != MTOK * DM || ws_size < WS_END) { fprintf(stderr, "kernel_launch: unexpected shapes (n_in %d out %d ws %zu)\n", n_in, out_size, ws_size); grid = -1; return; }
        int dev = 0, cus = 0, per_cu = 0;
        if (hipGetDevice(&dev) != hipSuccess || hipDeviceGetAttribute(&cus, hipDeviceAttributeMultiprocessorCount, dev) != hipSuccess) { grid = -1; return; }
        if (hipFuncSetAttribute((const void*)fwd_kernel, hipFuncAttributeMaxDynamicSharedMemorySize, LDS_BYTES) != hipSuccess) { fprintf(stderr, "kernel_launch: hipFuncSetAttribute failed\n"); grid = -1; return; }
        if (hipOccupancyMaxActiveBlocksPerMultiprocessor(&per_cu, (const void*)fwd_kernel, NTHR, LDS_BYTES) != hipSuccess || per_cu < 1) fprintf(stderr, "kernel_launch: occupancy query says %d\n", per_cu);
        (void)hipGetLastError();
        grid = cus;
    }
    if (grid < 0) return;
#ifdef EXTRA_PHASE
    {
        (void)hipMemsetAsync((char*)d_ws + WS_CTL, 0, CTL_ZERO_BYTES, stream);
        Args x{}; for (int i = 0; i < 38; ++i) x.in[i] = (const float*)d_in[i];
        x.out = (float*)d_out; x.ws = (unsigned char*)d_ws; x.ph_lo = EXTRA_PHASE; x.ph_hi = EXTRA_PHASE + 1; x.li = 0;
        hipLaunchKernelGGL(fwd_kernel, dim3(grid), dim3(NTHR), LDS_BYTES, stream, x);
    }
#endif
    (void)hipMemsetAsync((char*)d_ws + WS_CTL, 0, CTL_ZERO_BYTES, stream);
    Args a{};
    for (int i = 0; i < 38; ++i) a.in[i] = (const float*)d_in[i];
    a.out = (float*)d_out; a.ws = (unsigned char*)d_ws;
    for (int li = 0; li < N_LAUNCHES; ++li) {
        a.ph_lo = (N_LAUNCHES == NPH) ? li : 0; a.ph_hi = (N_LAUNCHES == NPH) ? li + 1 : NPH; a.li = li;
        hipLaunchKernelGGL(fwd_kernel, dim3(grid), dim3(NTHR), LDS_BYTES, stream, a);
    }
}
```

```cpp
#define MK_N_LAUNCHES 1
#include <hip/hip_runtime.h>
#include <cstdio>
#include <cstdint>

#define LAS __attribute__((address_space(3)))
#define GAS __attribute__((address_space(1)))
typedef unsigned short bf16;
typedef short bf16x8 __attribute__((ext_vector_type(8)));
typedef float f32x4 __attribute__((ext_vector_type(4)));
typedef float f32x2 __attribute__((ext_vector_type(2)));
typedef unsigned u32x4 __attribute__((ext_vector_type(4)));
typedef unsigned u32x2 __attribute__((ext_vector_type(2)));
typedef GAS unsigned gu32;

constexpr int BATCH = 16, SEQ = 2048, DM = 1024, MTOK = BATCH * SEQ;
constexpr int HYC = 3072, DSSM = 2048, CONVD = 4096, NHEAD = 32, NGRP = 8, NSTATE = 128, INC = 11328;
constexpr int NE = 64, TOPK = 8, DEXP = 256, NEX = NE + 1;
constexpr float DN_ALPHA = 1.189207115002721f;
constexpr float LN_EPS = 1e-5f, RMS_EPS = 1e-5f, ROUTED_SCALE = 2.5f;
constexpr int NWAVES = 8, NTHR = 512;
constexpr int WIN_ROWS = 11520;

constexpr size_t MiB = 1u << 20;
constexpr size_t WS_CTL = 0, CTL_ZERO_BYTES = 256 * 1024;
constexpr size_t WS_WHYB = 1 * MiB, WS_WSSDB = 3 * MiB, WS_WOUT = 7 * MiB;
constexpr size_t WS_XB = 9 * MiB;
constexpr size_t WS_WINT = 73 * MiB;
constexpr size_t WS_KERN = 96 * MiB;
constexpr size_t WS_PTHY = 112 * MiB;
constexpr size_t WS_YTHY = 304 * MiB;
constexpr size_t WS_YHY = 137 * MiB;
constexpr size_t WS_XBC = 201 * MiB;
constexpr size_t WS_DT = 457 * MiB;
constexpr size_t WS_HALO = 465 * MiB;
constexpr size_t WS_YSSD = 9 * MiB;
constexpr size_t WS_XB2 = 201 * MiB;
constexpr size_t WS_WING = 505 * MiB;
constexpr size_t WS_G = 269 * MiB;
constexpr size_t WS_MIX = 397 * MiB;
constexpr int H1B_PITCH = 2048;
constexpr size_t WS_EW1 = 9 * MiB;
constexpr size_t WS_EW2 = 477 * MiB;
constexpr size_t WS_YQ = 1 * MiB;
constexpr size_t WS_ASG = 510 * MiB;
constexpr size_t WS_H1P = 177 * MiB;
constexpr size_t WS_HID = 305 * MiB;
constexpr size_t WS_TOK = 461 * MiB;
constexpr size_t WS_WGT = 469 * MiB;
constexpr size_t WS_END = 511 * MiB;
constexpr size_t OUT_XB = 64 * MiB;
constexpr int CW_BAR = 4096;
constexpr int CW_CNT = 16384;
constexpr int CW_DBG = 32768;

constexpr int LDS_BYTES = 163840;
constexpr int MISC_OFF = 163840 - 512;

#define RLX_AGENT __ATOMIC_RELAXED, __HIP_MEMORY_SCOPE_AGENT
#define LDS_WAIT() asm volatile("s_waitcnt lgkmcnt(0)" ::: "memory")
#define VM_WAIT() asm volatile("s_waitcnt vmcnt(0)" ::: "memory")
typedef __bf16 bf16x2_t __attribute__((ext_vector_type(2)));
__device__ __forceinline__ unsigned pk2(float lo, float hi) { const f32x2 v = {lo, hi}; return __builtin_bit_cast(unsigned, __builtin_convertvector(v, bf16x2_t)); }
__device__ __forceinline__ unsigned f2bf(float f) { return pk2(f, 0.f) & 0xffffu; }
__device__ __forceinline__ float bf2f(unsigned b) { return __builtin_bit_cast(float, b << 16); }
__device__ __forceinline__ float bflo(unsigned w) { return __builtin_bit_cast(float, w << 16); }
__device__ __forceinline__ float bfhi(unsigned w) { return __builtin_bit_cast(float, w & 0xffff0000u); }
__device__ __forceinline__ float sigmoidf_(float v) { return __builtin_amdgcn_rcpf(1.0f + __expf(-v)); }
__device__ __forceinline__ float siluf_(float v) { return v * __builtin_amdgcn_rcpf(1.0f + __expf(-v)); }
__device__ __forceinline__ float wave_sum(float v) {
#pragma unroll
    for (int o = 1; o < 64; o <<= 1) v += __shfl_xor(v, o);
    return v;
}
__device__ __forceinline__ float wave_max(float v) {
#pragma unroll
    for (int o = 1; o < 64; o <<= 1) v = fmaxf(v, __shfl_xor(v, o));
    return v;
}

#ifndef PG8_WGM
#define PG8_WGM 8
#endif
namespace pg8 {
constexpr int BM = 256, BK = 64, HALF = 128, HTB = HALF * BK * 2, STAGE_BYTES = 8 * HTB, NXCD = 8, WGM = PG8_WGM;
__host__ __device__ __forceinline__ int lds_byte(int r, int c) { const int st = (r >> 4) * 2 + (c >> 5), rr = r & 15, cc = c & 31, ob = rr * 64 + cc * 2; return st * 1024 + (ob ^ (((ob >> 9) & 1) << 5)); }
__host__ __device__ __forceinline__ void stage_rc(int b, int& R, int& C) { const int st = b / 1024, sb = b % 1024, swz = sb ^ (((sb >> 9) & 1) << 5); R = (st >> 1) * 16 + swz / 64; C = (st & 1) * 32 + (swz % 64) / 2; }
__host__ __device__ __forceinline__ int perm32(int rho) { const int n = rho >> 4, i = rho & 15; return 8 * (i >> 2) + 4 * n + (i & 3); }

struct Unit { int pm, pn; const char* A; const char* B; int e, cnt; };

struct StaticOrder {
    int nM, nN, nwg, G, c, K; const char* A; const char* B;
    __device__ void init(const bf16* A_, const bf16* B_, int M, int N, int K_, int G_, int c_) { A = (const char*)A_; B = (const char*)B_; nM = M / BM; nN = N / BM; nwg = nM * nN; G = G_; c = c_; K = K_; }
    __device__ __forceinline__ bool next(int i, Unit& u) const {
        const long L = (long)i * G + c; if (L >= nwg) return false;
        int wgid = (int)L; { const int q = nwg / NXCD, r = nwg % NXCD, xcd = wgid % NXCD, off = wgid / NXCD; wgid = (xcd < r ? xcd * (q + 1) : r * (q + 1) + (xcd - r) * q) + off; }
        const int nig = WGM * nN, gid = wgid / nig, fm = gid * WGM, gsz = (nM - fm) < WGM ? (nM - fm) : WGM;
        u.pm = fm + ((wgid % nig) % gsz); u.pn = (wgid % nig) / gsz;
        u.A = A + (size_t)u.pm * BM * K * 2; u.B = B + (size_t)u.pn * BM * K * 2; u.e = 0; u.cnt = 0; return true;
    }
    __device__ __forceinline__ unsigned row_off(const Unit&, int) const { return 0u; }
};

__device__ __forceinline__ unsigned cvt_pk_bf16(float lo, float hi) { unsigned r; asm volatile("v_cvt_pk_bf16_f32 %0, %1, %2" : "=v"(r) : "v"(lo), "v"(hi)); return r; }

#ifndef PG8_SP2
#define PG8_SP2 true
#endif
#ifndef PG8_ALIGN
#define PG8_ALIGN true
#endif
template <class Epi, class Sched, bool GATHER, bool SP2 = PG8_SP2, bool ALIGN_EPI = PG8_ALIGN>
__device__ __forceinline__ void gemm_phase(LAS unsigned char* lds, const int K, const Sched& S, const Epi& E) {
    constexpr bool TA = Epi::TA;
    const int tid = threadIdx.x, wid = __builtin_amdgcn_readfirstlane(tid >> 6), lane = tid & 63, wr = wid >> 2, wc = wid & 3, fr = lane & 15, fq = lane >> 4;
    const int nt = K / BK;
    unsigned voffA[2][2], voffB[2]; int RA[2], CA[2];
#pragma unroll
    for (int i = 0; i < 2; ++i) { int R, C; stage_rc(tid * 16 + i * 8192, R, C); const int Rb = Epi::PERM ? ((R & ~31) + perm32(R & 31)) : R;
        RA[i] = R; CA[i] = C; voffA[0][i] = (unsigned)(R * K + C) * 2u; voffA[1][i] = voffA[0][i]; voffB[i] = (unsigned)(Rb * K + C) * 2u; }
    const size_t kstep = (size_t)(BK * 2);
    const size_t hstep = (size_t)HALF * K * 2;
    const size_t hstepA = GATHER ? 0 : hstep;
    const unsigned ldsw = (unsigned)wid * 1024u;
    const int aoff = lds_byte(wr * 64 + fr, fq * 8), boff = lds_byte(wc * 32 + fr, fq * 8);
#define PG8_SA(b, h) (((b) * 2 + (h)) * HTB)
#define PG8_SB(b, h) ((4 + (b) * 2 + (h)) * HTB)
#define PG8_STAGE(bufoff, gbase, voff) do { _Pragma("unroll") for (int _i = 0; _i < 2; ++_i) \
        __builtin_amdgcn_global_load_lds((const unsigned*)((const char*)(gbase) + (voff)[_i]), (LAS unsigned*)(lds + (bufoff) + ldsw + _i * 8192), 16, 0, 0); } while (0)
#define PG8_STAGE_A(bufoff, gbase, h) PG8_STAGE(bufoff, (gbase) + (h) * hstepA, voffA[GATHER ? (h) : 0])
#define PG8_LDA(dst, b, h) do { _Pragma("unroll") for (int m = 0; m < 4; ++m) _Pragma("unroll") for (int k = 0; k < 2; ++k) dst[m][k] = *(const LAS bf16x8*)(lds + PG8_SA(b, h) + aoff + m * 2048 + k * 1024); } while (0)
#define PG8_LDB(dst, b, h) do { _Pragma("unroll") for (int n = 0; n < 2; ++n) _Pragma("unroll") for (int k = 0; k < 2; ++k) dst[n][k] = *(const LAS bf16x8*)(lds + PG8_SB(b, h) + boff + n * 2048 + k * 1024); } while (0)
#define PG8_MMA(ai, bj, At, Bt) do { __builtin_amdgcn_s_setprio(1); _Pragma("unroll") for (int m = 0; m < 4; ++m) _Pragma("unroll") for (int n = 0; n < 2; ++n) _Pragma("unroll") for (int k = 0; k < 2; ++k) \
        acc[ai][bj][m][n] = TA ? __builtin_amdgcn_mfma_f32_16x16x32_bf16(Bt[n][k], At[m][k], acc[ai][bj][m][n], 0, 0, 0) \
                               : __builtin_amdgcn_mfma_f32_16x16x32_bf16(At[m][k], Bt[n][k], acc[ai][bj][m][n], 0, 0, 0); __builtin_amdgcn_s_setprio(0); } while (0)
#define PG8_WAIT_V(n) asm volatile("s_waitcnt vmcnt(" #n ")" ::: "memory")
#define PG8_WAIT_L(n) asm volatile("s_waitcnt lgkmcnt(" #n ")" ::: "memory")
#define PG8_BAR __builtin_amdgcn_s_barrier()
#define PG8_SCHED __builtin_amdgcn_sched_barrier(0)
    Unit cur, nxt; int ui = 0;
    if (!S.next(0, cur)) return;
    if (GATHER) {
#pragma unroll
        for (int h = 0; h < 2; ++h)
#pragma unroll
            for (int i = 0; i < 2; ++i) voffA[h][i] = S.row_off(cur, h * HALF + RA[i]) + (unsigned)CA[i] * 2u;
    }
    f32x4 acc[2][2][4][2];
#pragma unroll
    for (int a = 0; a < 2; ++a)
#pragma unroll
        for (int b = 0; b < 2; ++b)
#pragma unroll
            for (int m = 0; m < 4; ++m)
#pragma unroll
                for (int n = 0; n < 2; ++n) acc[a][b][m][n] = (f32x4){0.f, 0.f, 0.f, 0.f};
    bf16x8 At[4][2], B0[2][2], B1[2][2];
    const char* cA = cur.A; const char* cB = cur.B;
    if constexpr (SP2) {
        PG8_STAGE(PG8_SB(0, 0), cB, voffB); PG8_STAGE(PG8_SB(0, 1), cB + hstep, voffB); PG8_STAGE_A(PG8_SA(0, 0), cA, 0); PG8_STAGE_A(PG8_SA(0, 1), cA, 1);
        if (wr == 1) PG8_BAR;
        PG8_WAIT_V(2); PG8_BAR;
        PG8_STAGE(PG8_SB(1, 0), cB + kstep, voffB); PG8_STAGE_A(PG8_SA(1, 0), cA + kstep, 0); PG8_STAGE(PG8_SB(1, 1), cB + hstep + kstep, voffB);
        PG8_WAIT_V(6); PG8_BAR;
    } else {
    PG8_STAGE(PG8_SB(0, 0), cB, voffB); PG8_STAGE_A(PG8_SA(0, 0), cA, 0); PG8_STAGE(PG8_SB(0, 1), cB + hstep, voffB); PG8_STAGE_A(PG8_SA(0, 1), cA, 1);
    if (wr == 1) PG8_BAR;
    PG8_WAIT_V(4); PG8_BAR;
    PG8_STAGE(PG8_SB(1, 0), cB + kstep, voffB); PG8_STAGE_A(PG8_SA(1, 0), cA + kstep, 0); PG8_STAGE(PG8_SB(1, 1), cB + hstep + kstep, voffB);
    PG8_WAIT_V(6); PG8_BAR;
    }
    for (;;) {
        const bool has_next = S.next(ui + 1, nxt);
        const char* nA = has_next ? nxt.A : cA; const char* nB = has_next ? nxt.B : cB;
        for (int t = 0; t < nt; t += 2) {
            const bool last = (t == nt - 2);
            const char* a1 = cA + (size_t)(t + 1) * kstep;
            const char* a2 = last ? nA : cA + (size_t)(t + 2) * kstep; const char* b2 = last ? nB : cB + (size_t)(t + 2) * kstep;
            const char* a3 = a2 + kstep; const char* b3 = b2 + kstep;
            if constexpr (SP2) {
            PG8_LDB(B0, 0, 0); PG8_LDB(B1, 0, 1); PG8_SCHED; PG8_LDA(At, 0, 0); PG8_STAGE_A(PG8_SA(1, 1), a1, 1);
            PG8_WAIT_V(8); PG8_WAIT_L(0); PG8_BAR; PG8_MMA(0, 0, At, B0); PG8_MMA(0, 1, At, B1); PG8_BAR; PG8_SCHED;
            if (GATHER) { if (last && has_next) {
#pragma unroll
                for (int h = 0; h < 2; ++h)
#pragma unroll
                    for (int i = 0; i < 2; ++i) voffA[h][i] = S.row_off(nxt, h * HALF + RA[i]) + (unsigned)CA[i] * 2u;
            } }
            PG8_LDA(At, 0, 1); PG8_STAGE(PG8_SB(0, 0), b2, voffB); PG8_STAGE(PG8_SB(0, 1), b2 + hstep, voffB); PG8_STAGE_A(PG8_SA(0, 0), a2, 0);
            PG8_WAIT_V(8); PG8_WAIT_L(0); PG8_BAR; PG8_MMA(1, 0, At, B0); PG8_MMA(1, 1, At, B1); PG8_BAR; PG8_SCHED;
            PG8_LDB(B0, 1, 0); PG8_LDB(B1, 1, 1); PG8_SCHED; PG8_LDA(At, 1, 0); PG8_STAGE_A(PG8_SA(0, 1), a2, 1);
            PG8_WAIT_V(8); PG8_WAIT_L(0); PG8_BAR; PG8_MMA(0, 0, At, B0); PG8_MMA(0, 1, At, B1); PG8_BAR; PG8_SCHED;
            PG8_LDA(At, 1, 1); PG8_STAGE(PG8_SB(1, 0), b3, voffB); PG8_STAGE(PG8_SB(1, 1), b3 + hstep, voffB); PG8_STAGE_A(PG8_SA(1, 0), a3, 0);
            PG8_WAIT_V(8); PG8_WAIT_L(0); PG8_BAR; PG8_MMA(1, 0, At, B0); PG8_MMA(1, 1, At, B1); PG8_BAR; PG8_SCHED;
            } else {
            PG8_LDB(B0, 0, 0); PG8_SCHED; PG8_LDA(At, 0, 0); PG8_STAGE_A(PG8_SA(1, 1), a1, 1);
            PG8_WAIT_L(8); PG8_BAR; PG8_WAIT_L(0); PG8_MMA(0, 0, At, B0); PG8_BAR; PG8_SCHED;
            if (GATHER) { if (last && has_next) {
#pragma unroll
                for (int h = 0; h < 2; ++h)
#pragma unroll
                    for (int i = 0; i < 2; ++i) voffA[h][i] = S.row_off(nxt, h * HALF + RA[i]) + (unsigned)CA[i] * 2u;
            } }
            PG8_LDB(B1, 0, 1); PG8_STAGE(PG8_SB(0, 0), b2, voffB);
            PG8_BAR; PG8_WAIT_L(0); PG8_MMA(0, 1, At, B1); PG8_BAR;
            PG8_LDA(At, 0, 1); PG8_STAGE_A(PG8_SA(0, 0), a2, 0);
            PG8_BAR; PG8_WAIT_L(0); PG8_MMA(1, 0, At, B0); PG8_BAR; PG8_SCHED;
            PG8_STAGE(PG8_SB(0, 1), b2 + hstep, voffB);
            PG8_WAIT_V(6); PG8_BAR; PG8_MMA(1, 1, At, B1); PG8_BAR;
            PG8_LDB(B0, 1, 0); PG8_SCHED; PG8_LDA(At, 1, 0); PG8_STAGE_A(PG8_SA(0, 1), a2, 1);
            PG8_WAIT_L(8); PG8_BAR; PG8_WAIT_L(0); PG8_MMA(0, 0, At, B0); PG8_BAR; PG8_SCHED;
            PG8_LDB(B1, 1, 1); PG8_STAGE(PG8_SB(1, 0), b3, voffB);
            PG8_BAR; PG8_WAIT_L(0); PG8_MMA(0, 1, At, B1); PG8_BAR;
            PG8_LDA(At, 1, 1); PG8_STAGE_A(PG8_SA(1, 0), a3, 0);
            PG8_BAR; PG8_WAIT_L(0); PG8_MMA(1, 0, At, B0); PG8_BAR; PG8_SCHED;
            PG8_STAGE(PG8_SB(1, 1), b3 + hstep, voffB);
            PG8_WAIT_V(6); PG8_BAR; PG8_MMA(1, 1, At, B1); PG8_BAR;
                    }
        }
        if constexpr (ALIGN_EPI) { if (wr == 0) PG8_BAR; }
        E(acc, cur, wr, wc, fr, fq);
        if (!has_next) break;
#pragma unroll
        for (int a = 0; a < 2; ++a)
#pragma unroll
            for (int b = 0; b < 2; ++b)
#pragma unroll
                for (int m = 0; m < 4; ++m)
#pragma unroll
                    for (int n = 0; n < 2; ++n) acc[a][b][m][n] = (f32x4){0.f, 0.f, 0.f, 0.f};
        cur = nxt; cA = nA; cB = nB; ++ui;
        if constexpr (ALIGN_EPI) { if (wr == 1) PG8_BAR; }
    }
    PG8_WAIT_V(0);
    if constexpr (!ALIGN_EPI) { if (wr == 0) PG8_BAR; }
    PG8_BAR;
#undef PG8_SA
#undef PG8_SB
#undef PG8_STAGE
#undef PG8_STAGE_A
#undef PG8_LDA
#undef PG8_LDB
#undef PG8_MMA
#undef PG8_WAIT_V
#undef PG8_WAIT_L
#undef PG8_BAR
#undef PG8_SCHED
}
}

namespace pg8 {
struct EpiHyT {
    static constexpr bool TA = false, PERM = false;
    bf16* PT; const float* bias; LAS unsigned char* scr;
    __device__ __forceinline__ void operator()(const f32x4 (&acc)[2][2][4][2], const Unit& u, int wr, int wc, int fr, int fq) const {
        const int lane = fq * 16 + fr, lc = lane >> 3, lp = lane & 7;
        LAS unsigned char* s = scr + (wr * 4 + wc) * 2304;
        LAS unsigned char* wp = s + fr * 144 + 8 * fq;
        const LAS unsigned char* rp = s + lc * 144 + 16 * lp;
#pragma unroll
        for (int bj = 0; bj < 2; ++bj)
#pragma unroll
            for (int n = 0; n < 2; ++n) {
                const int col0 = u.pn * BM + bj * HALF + wc * 32 + n * 16; const float bv = bias[col0 + fr];
                bf16* gp = PT + (size_t)(col0 + lc) * MTOK + u.pm * BM + wr * 64 + 8 * lp;
#pragma unroll
                for (int ai = 0; ai < 2; ++ai) {
#pragma unroll
                    for (int m = 0; m < 4; ++m) { const f32x4 v = acc[ai][bj][m][n] + bv; u32x2 w; w.x = cvt_pk_bf16(v[0], v[1]); w.y = cvt_pk_bf16(v[2], v[3]);
                        *(LAS u32x2*)(wp + 32 * m) = w; }
                    const u32x4 r0 = *(const LAS u32x4*)rp, r1 = *(const LAS u32x4*)(rp + 8 * 144);
                    *(u32x4*)(gp + ai * HALF) = r0; *(u32x4*)(gp + ai * HALF + (size_t)8 * MTOK) = r1; }
            }
    }
};
struct EpiZXD {
    static constexpr bool TA = true, PERM = true;
    unsigned char* Z8; bf16* XBC; float* DT; const float* b_in; bf16* HALO;
    __device__ __forceinline__ void operator()(const f32x4 (&acc)[2][2][4][2], const Unit& u, int wr, int wc, int fr, int fq) const {
        const int row0 = u.pm * BM + wr * 64 + fr;
        if (u.pn == 24) {
            if (wc < 2) {
                const int c0 = wc * 32 + 8 * fq;
#pragma unroll
                for (int n = 0; n < 2; ++n) { const f32x4 bv = *(const f32x4*)(b_in + 9216 + c0 + 4 * n);
#pragma unroll
                    for (int ai = 0; ai < 2; ++ai)
#pragma unroll
                        for (int m = 0; m < 4; ++m) *(f32x4*)(DT + (size_t)(row0 + ai * HALF + m * 16) * 64 + c0 + 4 * n) = acc[ai][0][m][n] + bv; }
            }
            return;
        }
        if (u.pn < 8) {
            const int col0z = u.pn * BM + wc * 32 + 8 * fq;
#pragma unroll
            for (int bj = 0; bj < 2; ++bj) { const f32x4 b0 = *(const f32x4*)(b_in + 3072 + col0z + bj * HALF), b1 = *(const f32x4*)(b_in + 3072 + col0z + bj * HALF + 4);
#pragma unroll
                for (int ai = 0; ai < 2; ++ai)
#pragma unroll
                    for (int m = 0; m < 4; ++m) { const f32x4 v0 = acc[ai][bj][m][0] + b0, v1 = acc[ai][bj][m][1] + b1;
                        int w0 = __builtin_amdgcn_cvt_pk_fp8_f32(v0[0], v0[1], 0, false); w0 = __builtin_amdgcn_cvt_pk_fp8_f32(v0[2], v0[3], w0, true);
                        int w1 = __builtin_amdgcn_cvt_pk_fp8_f32(v1[0], v1[1], 0, false); w1 = __builtin_amdgcn_cvt_pk_fp8_f32(v1[2], v1[3], w1, true);
                        u32x2 w; w.x = (unsigned)w0; w.y = (unsigned)w1;
                        *(u32x2*)(Z8 + (size_t)(row0 + ai * HALF + m * 16) * DSSM + col0z + bj * HALF) = w; } }
            return;
        }
        bf16* base = XBC; const int ldc = CONVD, colt = (u.pn - 8) * BM, bcol = 5120 + colt;
        const int col0 = colt + wc * 32 + 8 * fq, bcol0 = bcol + wc * 32 + 8 * fq;
        f32x4 bv[2][2];
#pragma unroll
        for (int bj = 0; bj < 2; ++bj)
#pragma unroll
            for (int n = 0; n < 2; ++n) bv[bj][n] = *(const f32x4*)(b_in + bcol0 + bj * HALF + 4 * n);
#pragma unroll
        for (int ai = 0; ai < 2; ++ai)
#pragma unroll
            for (int m = 0; m < 4; ++m) { bf16* rowp = base + (size_t)(row0 + ai * HALF + m * 16) * ldc + col0;
#pragma unroll
                for (int bj = 0; bj < 2; ++bj) { const f32x4 v0 = acc[ai][bj][m][0] + bv[bj][0], v1 = acc[ai][bj][m][1] + bv[bj][1];
                    u32x4 w; w.x = cvt_pk_bf16(v0[0], v0[1]); w.y = cvt_pk_bf16(v0[2], v0[3]); w.z = cvt_pk_bf16(v1[0], v1[1]); w.w = cvt_pk_bf16(v1[2], v1[3]);
                    *(u32x4*)(rowp + bj * HALF) = w;
                    if ((m == 3 && fr >= 14) || (m == 0 && fr < 2)) {
                        const int row = row0 + ai * HALF + m * 16, bb = row >> 11, t = row & 2047, tm = t & 63;
                        const int jb = (tm >= 62) ? (t >> 6) + 1 : (t >> 6), idx = (tm >= 62) ? tm - 62 : 2 + tm;
                        *(u32x4*)(HALO + ((size_t)(bb * 33 + jb) * 4 + idx) * CONVD + col0 + bj * HALF) = w; } } }
    }
};
template <int MODE> struct EpiBf {
    static constexpr bool TA = true, PERM = true;
    bf16* O; int ldc; const float* bias; const bf16* G1; int ldg; const bf16* P;
    __device__ __forceinline__ void operator()(const f32x4 (&acc)[2][2][4][2], const Unit& u, int wr, int wc, int fr, int fq) const {
        const int row0 = u.pm * BM + wr * 64 + fr, col0 = u.pn * BM + wc * 32 + 8 * fq;
#pragma unroll
        for (int ai = 0; ai < 2; ++ai)
#pragma unroll
            for (int m = 0; m < 4; ++m) { const size_t r = (size_t)(row0 + ai * HALF + m * 16);
#pragma unroll
                for (int bj = 0; bj < 2; ++bj) { f32x4 v0 = acc[ai][bj][m][0], v1 = acc[ai][bj][m][1]; const int c = col0 + bj * HALF;
                    if (MODE == 0) { const f32x4 b0 = *(const f32x4*)(bias + c), b1 = *(const f32x4*)(bias + c + 4); v0 = v0 + b0; v1 = v1 + b1;
#pragma unroll
                        for (int j = 0; j < 4; ++j) { v0[j] = sigmoidf_(v0[j]); v1[j] = sigmoidf_(v1[j]); } }
                    else { const u32x4 g = *(const u32x4*)(G1 + r * ldg + c);
                        v0[0] *= bflo(g.x); v0[1] *= bfhi(g.x); v0[2] *= bflo(g.y); v0[3] *= bfhi(g.y); v1[0] *= bflo(g.z); v1[1] *= bfhi(g.z); v1[2] *= bflo(g.w); v1[3] *= bfhi(g.w);
                        if (MODE == 2) { const u32x4 p = *(const u32x4*)(P + r * ldc + c);
                            v0[0] += bflo(p.x); v0[1] += bfhi(p.x); v0[2] += bflo(p.y); v0[3] += bfhi(p.y); v1[0] += bflo(p.z); v1[1] += bfhi(p.z); v1[2] += bflo(p.w); v1[3] += bfhi(p.w); } }
                    u32x4 w; w.x = cvt_pk_bf16(v0[0], v0[1]); w.y = cvt_pk_bf16(v0[2], v0[3]); w.z = cvt_pk_bf16(v1[0], v1[1]); w.w = cvt_pk_bf16(v1[2], v1[3]);
                    *(u32x4*)(O + r * ldc + c) = w; } }
    }
};
struct EpiRes {
    static constexpr bool TA = true, PERM = true;
    bf16* O; const float* bias; const bf16* X; float alpha;
    __device__ __forceinline__ void operator()(const f32x4 (&acc)[2][2][4][2], const Unit& u, int wr, int wc, int fr, int fq) const {
        const int row0 = u.pm * BM + wr * 64 + fr, col0 = u.pn * BM + wc * 32 + 8 * fq;
#pragma unroll
        for (int ai = 0; ai < 2; ++ai)
#pragma unroll
            for (int m = 0; m < 4; ++m) { const size_t off = (size_t)(row0 + ai * HALF + m * 16) * DM + col0;
#pragma unroll
                for (int bj = 0; bj < 2; ++bj) { const u32x4 xv = *(const u32x4*)(X + off + bj * HALF); const f32x4 b0 = *(const f32x4*)(bias + col0 + bj * HALF), b1 = *(const f32x4*)(bias + col0 + bj * HALF + 4);
                    f32x4 v0 = acc[ai][bj][m][0] + b0, v1 = acc[ai][bj][m][1] + b1;
                    v0[0] += alpha * bflo(xv.x); v0[1] += alpha * bfhi(xv.x); v0[2] += alpha * bflo(xv.y); v0[3] += alpha * bfhi(xv.y);
                    v1[0] += alpha * bflo(xv.z); v1[1] += alpha * bfhi(xv.z); v1[2] += alpha * bflo(xv.w); v1[3] += alpha * bfhi(xv.w);
                    u32x4 w; w.x = cvt_pk_bf16(v0[0], v0[1]); w.y = cvt_pk_bf16(v0[2], v0[3]); w.z = cvt_pk_bf16(v1[0], v1[1]); w.w = cvt_pk_bf16(v1[2], v1[3]);
                    *(u32x4*)(O + off + bj * HALF) = w; } }
    }
};
struct EpiSwiGLU {
    static constexpr bool TA = true, PERM = true;
    bf16* HID;
    __device__ __forceinline__ void operator()(const f32x4 (&acc)[2][2][4][2], const Unit& u, int wr, int wc, int fr, int fq) const {
        const int row0 = u.pm * BM + wr * 64 + fr, col0 = u.pn * HALF + wc * 32 + 8 * fq;
#pragma unroll
        for (int ai = 0; ai < 2; ++ai)
#pragma unroll
            for (int m = 0; m < 4; ++m) { f32x4 v0, v1;
#pragma unroll
                for (int j = 0; j < 4; ++j) { v0[j] = siluf_(acc[ai][0][m][0][j]) * acc[ai][1][m][0][j]; v1[j] = siluf_(acc[ai][0][m][1][j]) * acc[ai][1][m][1][j]; }
                u32x4 w; w.x = cvt_pk_bf16(v0[0], v0[1]); w.y = cvt_pk_bf16(v0[2], v0[3]); w.z = cvt_pk_bf16(v1[0], v1[1]); w.w = cvt_pk_bf16(v1[2], v1[3]);
                *(u32x4*)(HID + (size_t)(row0 + ai * HALF + m * 16) * DEXP + col0) = w; }
    }
};
struct EpiScatter {
    static constexpr bool TA = false, PERM = false;
    float* ACC; const int* tok; const float* wgt; int j0_unused;
    __device__ __forceinline__ void operator()(const f32x4 (&acc)[2][2][4][2], const Unit& u, int wr, int wc, int fr, int fq) const {
        asm volatile("" : "+v"(fr), "+v"(fq));
        const int jt = u.pn >> 2, ct = u.pn & 3;
#pragma unroll
        for (int ai = 0; ai < 2; ++ai)
#pragma unroll
            for (int m = 0; m < 4; ++m)
#pragma unroll
                for (int j = 0; j < 4; ++j) { const int r = ai * HALF + wr * 64 + m * 16 + 4 * fq + j;
                    if (r < u.cnt) { int token; float w;
                        if (u.e == NE) { token = jt * BM + r; w = 1.0f; } else { const size_t li = (size_t)u.e * MTOK + (size_t)jt * BM + r; token = tok[li]; w = wgt[li]; }
                        float* rowp = ACC + (size_t)token * DM + ct * BM + wc * 32 + fr;
#pragma unroll
                        for (int bj = 0; bj < 2; ++bj)
#pragma unroll
                            for (int n = 0; n < 2; ++n) unsafeAtomicAdd(rowp + bj * HALF + n * 16, w * acc[ai][bj][m][n][j]);
                    }
                    asm volatile("" ::: "memory"); }
    }
};

struct EpiSlot8 {
    static constexpr bool TA = true, PERM = true;
    unsigned char* YQ;
    __device__ __forceinline__ void operator()(const f32x4 (&acc)[2][2][4][2], const Unit& u, int wr, int wc, int fr, int fq) const {
        asm volatile("" : "+v"(fr), "+v"(fq));
        const int row0 = u.pm * BM + wr * 64 + fr, col0 = u.pn * 256 + wc * 32 + 8 * fq;
#pragma unroll
        for (int ai = 0; ai < 2; ++ai)
#pragma unroll
            for (int m = 0; m < 4; ++m) { unsigned char* rowp = YQ + (size_t)(row0 + ai * HALF + m * 16) * 1024 + col0;
#pragma unroll
                for (int bj = 0; bj < 2; ++bj) { const f32x4 v0 = acc[ai][bj][m][0], v1 = acc[ai][bj][m][1];
                    int w0 = __builtin_amdgcn_cvt_pk_fp8_f32(v0[0], v0[1], 0, false); w0 = __builtin_amdgcn_cvt_pk_fp8_f32(v0[2], v0[3], w0, true);
                    int w1 = __builtin_amdgcn_cvt_pk_fp8_f32(v1[0], v1[1], 0, false); w1 = __builtin_amdgcn_cvt_pk_fp8_f32(v1[2], v1[3], w1, true);
                    u32x2 w; w.x = (unsigned)w0; w.y = (unsigned)w1; *(u32x2*)(rowp + bj * HALF) = w; } }
    }
};
struct SlotOrder4 {
    const LAS int* tp; const LAS int* te; int G, c, total; const char* A; const char* W;
    __device__ __forceinline__ bool next(int i, Unit& u) const {
        int tile, q;
        if (G == 256) { const int cx = c & 7, cj = c >> 3; q = cj & 3; tile = i * 64 + (cj >> 2) * 8 + cx; }
        else { const long L = (long)i * G + c; tile = (int)(L >> 2); q = (int)(L & 3); }
        if (tile >= total) return false;
        const int e = te[tile];
        u.e = e; u.cnt = 0; u.pm = tile; u.pn = q; u.A = A + (size_t)tile * BM * DEXP * 2; u.B = W + ((size_t)e * DM + (size_t)q * 256) * DEXP * 2;
        return true;
    }
    __device__ __forceinline__ unsigned row_off(const Unit&, int) const { return 0u; }
};
template <int NCT, bool FIRST> struct MoeOrder {
    const LAS int* tp; const LAS int* cnt; const LAS int* te; int G, c, total;
    const char* A; const char* W; const int* tok;
    __device__ __forceinline__ bool next(int i, Unit& u) const {
        const long L = (long)i * G + c; if (L >= (long)total * NCT) return false;
        const int tile = (int)(L / NCT), ct = (int)(L % NCT);
        const int e = te[tile];
        const int jt = tile - tp[e];
        u.e = e; const int left = cnt[e] - jt * BM; u.cnt = left < BM ? left : BM;
        if (FIRST) { u.pm = tile; u.pn = ct; u.A = A; u.B = W + ((size_t)e * 512 + (size_t)ct * 256) * DM * 2; }
        else { u.pm = tile; u.pn = jt * 4 + ct; u.A = A + (size_t)tile * BM * DEXP * 2; u.B = W + ((size_t)e * DM + (size_t)ct * 256) * DEXP * 2; }
        return true;
    }
    __device__ __forceinline__ unsigned row_off(const Unit& u, int r) const {
        const int jt = u.pm - tp[u.e]; int token;
        if (u.e == NE) token = jt * BM + r; else token = (r < u.cnt) ? tok[(size_t)u.e * MTOK + (size_t)jt * BM + r] : 0;
        return (unsigned)token * (unsigned)(H1B_PITCH * 2);
    }
};
}

#define XB_TMO      128
#define XB_XCNT(j)  (256  + 64 * (j))
#define XB_XSUB(j)  (1280 + 64 * (j))
#define XB_XGEN(j)  (2304 + 64 * (j))
#define XB_TOP      3328
#define XB_TOPGEN   3392
#define XCD_BAR_WORDS 3456
#define XB_SPIN_CAP (1u << 18)
__device__ __forceinline__ unsigned xb_ld(unsigned* p)              { return __hip_atomic_load(p, __ATOMIC_RELAXED, __HIP_MEMORY_SCOPE_AGENT); }
__device__ __forceinline__ unsigned xb_add(unsigned* p, unsigned v) { return __hip_atomic_fetch_add(p, v, __ATOMIC_RELAXED, __HIP_MEMORY_SCOPE_AGENT); }
__device__ __forceinline__ unsigned xb_xcc_id() { return (unsigned)__builtin_amdgcn_s_getreg((3 << 11) | 20) & 0xFu; }
#define XB_SPIN(cond, bar) do { unsigned _sp = 0; while (cond) { __builtin_amdgcn_s_sleep(1); \
    if ((++_sp & 255u) == 0u) { if (xb_ld(&(bar)[XB_TMO])) break; if (_sp > XB_SPIN_CAP) { atomicAdd(&(bar)[XB_TMO], 1u); break; } } } } while (0)
struct XcdBarrier { unsigned* bar; unsigned x; volatile LAS unsigned* st; };
__device__ __forceinline__ XcdBarrier xcd_barrier_post(unsigned* bar, volatile LAS unsigned* st) {
    XcdBarrier b; b.bar = bar; b.x = xb_xcc_id(); b.st = st;
    if (threadIdx.x == 0) (void)xb_add(&bar[XB_XCNT(b.x)], 1u);
    return b;
}
__device__ __forceinline__ void xcd_barrier_complete(unsigned* bar, unsigned x, unsigned& nloc, unsigned& nx) {
    const unsigned G = gridDim.x * gridDim.y * gridDim.z;
    unsigned sum, cnt, mine, sp = 0u;
    for (;;) {
        sum = 0u; cnt = 0u; mine = 0u;
#pragma unroll
        for (unsigned j = 0; j < 16; ++j) { const unsigned c = xb_ld(&bar[XB_XCNT(j)]); sum += c; cnt += (c > 0u) ? 1u : 0u; mine = (j == x) ? c : mine; }
        if (sum == G) break;
        __builtin_amdgcn_s_sleep(1);
        if ((++sp & 255u) == 0u) { if (xb_ld(&bar[XB_TMO])) break; if (sp > XB_SPIN_CAP) { atomicAdd(&bar[XB_TMO], 1u); break; } }
    }
    nloc = mine > 0u ? mine : 1u; nx = cnt > 0u ? cnt : 1u;
}
__device__ __forceinline__ void xcd_barrier(const XcdBarrier& b) {
    asm volatile("s_waitcnt vmcnt(0)" ::: "memory");
    __syncthreads();
    if (threadIdx.x == 0) {
        unsigned* bar = b.bar;
        __builtin_amdgcn_s_waitcnt(0);
        unsigned nloc = b.st[0], nx = b.st[1];
        if (nloc == 0u) { xcd_barrier_complete(bar, b.x, nloc, nx); b.st[0] = nloc; b.st[1] = nx; }
        const unsigned old = xb_add(&bar[XB_XSUB(b.x)], 1u);
        const unsigned gen = old / nloc;
        if (old + 1u == (gen + 1u) * nloc) {
            __builtin_amdgcn_fence(__ATOMIC_RELEASE, "agent");
            asm volatile("s_waitcnt vmcnt(0)" ::: "memory");
            const unsigned og = xb_add(&bar[XB_TOP], 1u);
            const unsigned tg = og / nx;
            if (og + 1u == (tg + 1u) * nx) xb_add(&bar[XB_TOPGEN], 1u);
            else XB_SPIN(xb_ld(&bar[XB_TOPGEN]) == tg, bar);
            __builtin_amdgcn_fence(__ATOMIC_ACQUIRE, "agent");
            xb_add(&bar[XB_XGEN(b.x)], 1u);
            asm volatile("s_waitcnt vmcnt(0)" ::: "memory");
        } else {
            XB_SPIN(xb_ld(&bar[XB_XGEN(b.x)]) == gen, bar);
            __builtin_amdgcn_fence(__ATOMIC_ACQUIRE, "agent");
            asm volatile("s_waitcnt vmcnt(0)" ::: "memory");
        }
    }
    __syncthreads();
}

struct Args {
    const float* in[38]; float* out; unsigned char* ws; int ph_lo, ph_hi, li, pad;
};
enum { I_X = 0, I_WIN, I_BIN, I_HCW, I_HCB, I_FW1, I_FB1, I_FF1, I_FW2, I_FB2, I_FF2, I_FW3, I_FB3, I_FF3, I_FW4, I_HBIAS,
       I_SCW, I_SCB, I_DTB, I_ALOG, I_SD, I_SNW, I_WHYB, I_WSSDB, I_WOUT, I_BOUT, I_LN1G, I_LN1B, I_RW, I_RB, I_EWG, I_EWU, I_EWD, I_SWG, I_SWU, I_SWD, I_LN2G, I_LN2B };
struct Frame {
    LAS unsigned char* lds; volatile LAS unsigned* MISC; gu32* ctl; unsigned char* ws;
    int tid, lane, wave, vcu, G;
    const float* const* in; float* out;
};

__device__ __forceinline__ void tr_item(const float* src, int ld_src, int k0, int c0, bf16* dst, int drow0, int ldd, LAS float* scr, int lane) {
    f32x4 ld[8];
#pragma unroll
    for (int i = 0; i < 8; ++i) ld[i] = *(const f32x4*)(src + (size_t)(k0 + 8 * i + (lane >> 3)) * ld_src + c0 + 4 * (lane & 7));
#pragma unroll
    for (int i = 0; i < 8; ++i) { LAS float* d = scr + (8 * i + (lane >> 3)) * 33 + 4 * (lane & 7); d[0] = ld[i][0]; d[1] = ld[i][1]; d[2] = ld[i][2]; d[3] = ld[i][3]; }
    LDS_WAIT(); asm volatile("" ::: "memory");
    const int c = lane & 7;
#pragma unroll
    for (int j = 0; j < 4; ++j) { const int n = (lane >> 3) + 8 * j; const LAS float* s = scr + (8 * c) * 33 + n;
        u32x4 o; o.x = pk2(s[0 * 33], s[1 * 33]); o.y = pk2(s[2 * 33], s[3 * 33]); o.z = pk2(s[4 * 33], s[5 * 33]); o.w = pk2(s[6 * 33], s[7 * 33]);
        *(u32x4*)(dst + (size_t)(drow0 + n) * ldd + k0 + 8 * c) = o; }
    LDS_WAIT(); asm volatile("" ::: "memory");
}
__device__ __forceinline__ void tr_matrix_item(const float* src, int ld_src, int K, int col_first, int ncols, bf16* dst, int drow_first, LAS float* scr, int it, int lane) {
    const int nblk = ncols / 32, kb = it / nblk, nb = it % nblk;
    tr_item(src, ld_src, kb * 64, col_first + nb * 32, dst, drow_first + nb * 32, K, scr, lane);
}
__device__ __forceinline__ void convert_x(Frame& F, const float* x, bf16* xb) {
    const size_t n8 = (size_t)MTOK * DM / 8; const size_t stride = (size_t)F.G * NTHR;
    for (size_t i = (size_t)F.vcu * NTHR + F.tid; i < n8; i += 4 * stride) {
        f32x4 a[4], b[4];
#pragma unroll
        for (int u = 0; u < 4; ++u) { const size_t k = (i + u * stride < n8) ? i + u * stride : i; a[u] = *(const f32x4*)(x + k * 8); b[u] = *(const f32x4*)(x + k * 8 + 4); }
#pragma unroll
        for (int u = 0; u < 4; ++u) { u32x4 o; o.x = pk2(a[u][0], a[u][1]); o.y = pk2(a[u][2], a[u][3]); o.z = pk2(b[u][0], b[u][1]); o.w = pk2(b[u][2], b[u][3]);
            if (i + u * stride < n8) *(u32x4*)(xb + (i + u * stride) * 8) = o; } }
}

__device__ __forceinline__ void hyena_filter(Frame& F) {
    const float* w1 = F.in[I_FW1]; const float* b1 = F.in[I_FB1]; const float* f1 = F.in[I_FF1];
    const float* w2 = F.in[I_FW2]; const float* b2 = F.in[I_FB2]; const float* f2 = F.in[I_FF2];
    const float* w3 = F.in[I_FW3]; const float* b3 = F.in[I_FB3]; const float* f3 = F.in[I_FF3];
    const float* w4 = F.in[I_FW4];
    bf16* KERN = (bf16*)(F.ws + WS_KERN);
    LAS float* hbuf = (LAS float*)(F.lds);
    const int lane = F.lane, wave = F.wave;
    for (int pg = F.vcu; pg < SEQ / 8; pg += F.G) {
        const int t = 8 * pg + wave;
        const float tn = (float)t / (float)(SEQ - 1), wv = 6.283185307179586f * (float)t / (float)SEQ;
        float zf = 0.f;
        if (lane == 0) zf = tn;
        else if (lane <= 16) { const float f = 1e-4f + (float)(lane - 1) * ((15.0f - 1e-4f) / 15.0f); zf = cosf(f * wv); }
        else if (lane <= 32) { const float f = 1e-4f + (float)(lane - 17) * ((15.0f - 1e-4f) / 15.0f); zf = -sinf(f * wv); }
        float s = b1[lane];
        for (int i = 0; i < 33; ++i) s += __shfl(zf, i) * w1[i * 64 + lane];
        float h = sinf(f1[lane] * s);
        s = b2[lane];
        for (int i = 0; i < 64; ++i) s += __shfl(h, i) * w2[i * 64 + lane];
        h = sinf(f2[lane] * s);
        s = b3[lane];
        for (int i = 0; i < 64; ++i) s += __shfl(h, i) * w3[i * 64 + lane];
        h = sinf(f3[lane] * s);
        hbuf[wave * 64 + lane] = h;
        __syncthreads();
        { float a[8][8];
#pragma unroll
          for (int q = 0; q < 8; ++q)
#pragma unroll
              for (int p = 0; p < 8; ++p) a[q][p] = 0.f;
          float a0b[4] = {0.f, 0.f, 0.f, 0.f};
#pragma unroll 2
          for (int i = 0; i < 64; ++i) { float wv[8], hv[8];
#pragma unroll
              for (int q = 0; q < 8; ++q) wv[q] = w4[(size_t)i * 4096 + F.tid + 512 * q];
#pragma unroll
              for (int p = 0; p < 8; ++p) hv[p] = hbuf[p * 64 + i];
#pragma unroll
              for (int q = 0; q < 8; ++q)
#pragma unroll
                  for (int p = 0; p < 8; ++p) a[q][p] += hv[p] * wv[q];
              if (pg == 0) { a0b[0] += hv[0] * wv[2]; a0b[1] += hv[0] * wv[3]; a0b[2] += hv[0] * wv[6]; a0b[3] += hv[0] * wv[7]; } }
#pragma unroll
          for (int q = 0; q < 8; ++q) { const int col = F.tid + 512 * q, c = col & 1023, dir = (q >> 1) & 1, o = q >> 2;
              const float adel = 3.0701134573253945f + (float)c * ((15.350567286626973f - 3.0701134573253945f) / 1023.0f);
              bf16* kc = KERN + ((size_t)c * 2 + o) * 4096;
#pragma unroll
              for (int p = 0; p < 8; ++p) { const int tp = 8 * pg + p; const float v = a[q][p] * __expf(-((float)tp / (float)(SEQ - 1)) * adel);
                  if (tp == 0) { if (dir == 0) { kc[2048] = (bf16)f2bf(v + a0b[(q & 1) + 2 * o]); kc[0] = 0; } }
                  else kc[dir == 0 ? 2048 - tp : 2048 + tp] = (bf16)f2bf(v); } } }
        __syncthreads();
    }
}

__device__ __forceinline__ void p0_prologue(Frame& F) {
    LAS float* scr = (LAS float*)(F.lds + 4096 + F.wave * 16384);
    const int gw = F.vcu * NWAVES + F.wave, NGW = F.G * NWAVES;
    const bool late_filter = (blockIdx.x & 1);
    bf16* WINT = (bf16*)(F.ws + WS_WINT);
    constexpr int I_A = 16 * (9216 / 32), I_B = 16 * (64 / 32), I_C = 16 * (2048 / 32);
    constexpr int I_HY = 16 * 32, I_SS = 32 * 32, I_OUT = 16 * 32;
    constexpr int NITEMS = I_A + I_B + I_C + I_HY + I_SS + I_OUT;
#pragma unroll 1
    for (int s_ = 0; s_ < 2; ++s_) {
    if ((s_ == 1) == late_filter) { hyena_filter(F); continue; }
    for (int it = gw; it < NITEMS; it += NGW) {
        int r = it;
        if (r < I_A) { tr_matrix_item(F.in[I_WIN], INC, DM, 0, 9216, WINT, 0, scr, r, F.lane); continue; } r -= I_A;
        if (r < I_B) { tr_matrix_item(F.in[I_WIN], INC, DM, 9216, 64, WINT, 9216, scr, r, F.lane); continue; } r -= I_B;
        if (r < I_C) { tr_matrix_item(F.in[I_WIN], INC, DM, 9280, 2048, (bf16*)(F.ws + WS_WING), 0, scr, r, F.lane); continue; } r -= I_C;
        if (r < I_HY) { tr_matrix_item(F.in[I_WHYB], DM, DM, 0, DM, (bf16*)(F.ws + WS_WHYB), 0, scr, r, F.lane); continue; } r -= I_HY;
        if (r < I_SS) { tr_matrix_item(F.in[I_WSSDB], DM, DSSM, 0, DM, (bf16*)(F.ws + WS_WSSDB), 0, scr, r, F.lane); continue; } r -= I_SS;
        tr_matrix_item(F.in[I_WOUT], DM, DM, 0, DM, (bf16*)(F.ws + WS_WOUT), 0, scr, r, F.lane);
    }
    convert_x(F, F.in[I_X], (bf16*)((unsigned char*)F.out + OUT_XB));
    __syncthreads();
    }
}
__device__ __forceinline__ void p6_reconvert(Frame& F) {
    LAS float* scr = (LAS float*)(F.lds + 4096 + F.wave * 16384);
    const int gw = F.vcu * NWAVES + F.wave, NGW = F.G * NWAVES;
    for (int it = gw; it < 16 * (2048 / 32); it += NGW) tr_matrix_item(F.in[I_WIN], INC, DM, 9280, 2048, (bf16*)(F.ws + WS_WING), 0, scr, it, F.lane);
    convert_x(F, F.in[I_X], (bf16*)(F.ws + WS_XB2));
}
__device__ __forceinline__ void p10_expert_weights(Frame& F) {
    LAS float* scr = (LAS float*)(F.lds + 4096 + F.wave * 16384);
    const int gw = F.vcu * NWAVES + F.wave, NGW = F.G * NWAVES;
    bf16* EW1 = (bf16*)(F.ws + WS_EW1); bf16* EW2 = (bf16*)(F.ws + WS_EW2);
    constexpr int PER1 = 16 * 4;
    constexpr int N1 = NEX * 2 * 2 * PER1, PER2 = 4 * 32, N2 = NEX * PER2;
    for (int it = gw; it < N1 + N2; it += NGW) {
        if (it < N1) { const int e = it / (4 * PER1), r0 = it % (4 * PER1), mat = r0 / (2 * PER1), r1 = r0 % (2 * PER1), ct = r1 / PER1, r2 = r1 % PER1;
            const float* src = (e < NE) ? F.in[mat ? I_EWU : I_EWG] + (size_t)e * DM * DEXP : F.in[mat ? I_SWU : I_SWG];
            tr_matrix_item(src, DEXP, DM, 128 * ct, 128, EW1 + (size_t)e * 512 * DM, 256 * ct + 128 * mat, scr, r2, F.lane); }
        else { const int r = it - N1, e = r / PER2, r2 = r % PER2;
            const float* src = (e < NE) ? F.in[I_EWD] + (size_t)e * DEXP * DM : F.in[I_SWD];
            tr_matrix_item(src, DM, DEXP, 0, DM, EW2 + (size_t)e * DM * DEXP, 0, scr, r2, F.lane); }
    }
}
__device__ __forceinline__ void p3_transpose(Frame& F) {
    const bf16* YT = (const bf16*)(F.ws + WS_YTHY); bf16* Y = (bf16*)(F.ws + WS_YHY);
    LAS bf16* scr = (LAS bf16*)(F.lds + F.wave * 9216);
    const int gw = F.vcu * NWAVES + F.wave, NGW = F.G * NWAVES, lane = F.lane;
    for (int tile = gw; tile < 16 * 512; tile += NGW) {
        const int c0 = (tile & 15) * 64, t0 = (tile >> 4) * 64;
#pragma unroll
        for (int p = 0; p < 8; ++p) { const int c = p * 8 + (lane >> 3), ch = lane & 7;
            const u32x4 g = *(const u32x4*)(YT + (size_t)(c0 + c) * MTOK + t0 + ch * 8);
            LAS bf16* d = scr + (ch * 8) * 72 + (c ^ (ch << 3));
            d[0 * 72] = (bf16)(g.x & 0xffff); d[1 * 72] = (bf16)(g.x >> 16); d[2 * 72] = (bf16)(g.y & 0xffff); d[3 * 72] = (bf16)(g.y >> 16);
            d[4 * 72] = (bf16)(g.z & 0xffff); d[5 * 72] = (bf16)(g.z >> 16); d[6 * 72] = (bf16)(g.w & 0xffff); d[7 * 72] = (bf16)(g.w >> 16); }
        LDS_WAIT(); asm volatile("" ::: "memory");
#pragma unroll
        for (int p = 0; p < 8; ++p) { const int tk = p * 8 + (lane >> 3), ch = lane & 7;
            const u32x4 v = *(const LAS u32x4*)(scr + tk * 72 + ((ch ^ ((tk >> 3) & 7)) << 3));
            *(u32x4*)(Y + (size_t)(t0 + tk) * DM + c0 + ch * 8) = v; }
        LDS_WAIT(); asm volatile("" ::: "memory");
    }
}

constexpr int HY_LDU = 2064, HY_KCS = 4128, HY_U_BYTES = 16 * HY_LDU * 2, HY_KC_BYTES = 8 * HY_KCS * 2;

struct HyKRow { u32x4 cur, prv; };
__device__ __forceinline__ void hy_load_kern(HyKRow& r, const bf16* kern, int tid) {
    r.cur = *(const u32x4*)(kern + 8 * tid);
    r.prv = (u32x4){0u, 0u, 0u, 0u};
    if (tid > 0) r.prv = *(const u32x4*)(kern + 8 * tid - 8);
}
__device__ __forceinline__ void hy_store_kc(LAS bf16* KC, const HyKRow& r, int tid) {
    const unsigned E[9] = {r.prv.x, r.prv.y, r.prv.z, r.prv.w, r.cur.x, r.cur.y, r.cur.z, r.cur.w, 0u};
#pragma unroll
    for (int fl = 0; fl < 8; ++fl) { const int sft = 8 - fl, k = sft >> 1;
        u32x4 o;
        if (sft & 1) { o.x = __builtin_amdgcn_alignbit(E[k + 1], E[k], 16); o.y = __builtin_amdgcn_alignbit(E[k + 2], E[k + 1], 16);
                       o.z = __builtin_amdgcn_alignbit(E[k + 3], E[k + 2], 16); o.w = __builtin_amdgcn_alignbit(E[k + 4], E[k + 3], 16); }
        else { o.x = E[k]; o.y = E[k + 1]; o.z = E[k + 2]; o.w = E[k + 3]; }
        *(LAS u32x4*)(KC + fl * HY_KCS + 8 * tid) = o; }
}
__device__ __forceinline__ f32x4 hy_short4(const bf16* prow, int t0, float w0, float w1, float w2, float cb) {
    const u32x2 g = *(const u32x2*)(prow + t0);
    const float p0 = bflo(g.x), p1 = bfhi(g.x), p2 = bflo(g.y), p3 = bfhi(g.y);
    const float pm = (t0 > 0) ? bf2f(prow[t0 - 1]) : 0.f, pp = (t0 + 4 < SEQ) ? bf2f(prow[t0 + 4]) : 0.f;
    f32x4 r; r[0] = cb + w0 * pm + w1 * p0 + w2 * p1; r[1] = cb + w0 * p0 + w1 * p1 + w2 * p2; r[2] = cb + w0 * p1 + w1 * p2 + w2 * p3; r[3] = cb + w0 * p2 + w1 * p3 + w2 * pp;
    return r;
}
__device__ __forceinline__ f32x4 hy_conv4(const u32x2 g, float pm, float pp, float w0, float w1, float w2, float cb) {
    const float p0 = bflo(g.x), p1 = bfhi(g.x), p2 = bflo(g.y), p3 = bfhi(g.y);
    f32x4 r; r[0] = cb + w0 * pm + w1 * p0 + w2 * p1; r[1] = cb + w0 * p0 + w1 * p1 + w2 * p2; r[2] = cb + w0 * p1 + w1 * p2 + w2 * p3; r[3] = cb + w0 * p2 + w1 * p3 + w2 * pp;
    return r;
}
__device__ __forceinline__ void hyena_phase(Frame& F) {
    LAS bf16* U = (LAS bf16*)(F.lds); LAS bf16* KC = (LAS bf16*)(F.lds + HY_U_BYTES);
    const bf16* PT = (const bf16*)(F.ws + WS_PTHY); const bf16* KERN = (const bf16*)(F.ws + WS_KERN); bf16* YT = (bf16*)(F.ws + WS_YTHY);
    const float* cw = F.in[I_HCW]; const float* cbv = F.in[I_HCB]; const float* hb = F.in[I_HBIAS];
    const int tid = F.tid, lane = F.lane, w = F.wave, fr = lane & 15, fq = lane >> 4;
    u32x4 um[8]; unsigned ee[8]; HyKRow kr;
    auto load_v = [&](int c) { int tl = tid; asm volatile("" : "+v"(tl));
        const bf16* prow = PT + (size_t)(2048 + c) * MTOK + (size_t)(tl >> 8) * SEQ + (tl & 255) * 8;
#pragma unroll
        for (int it = 0; it < 8; ++it) { um[it] = *(const u32x4*)(prow + (size_t)(2 * it) * SEQ); ee[it] = 0u; }
        if (lane == 0 || lane == 63) {
#pragma unroll
            for (int it = 0; it < 8; ++it) { const int t8 = (tl & 255) * 8; const bf16* pr = prow + (size_t)(2 * it) * SEQ - t8;
                if (lane == 0) { if (t8 > 0) ee[it] = pr[t8 - 1]; } else { if (t8 + 8 < SEQ) ee[it] = pr[t8 + 8]; } } } };
    if (F.vcu < DM) { hy_load_kern(kr, KERN + ((size_t)F.vcu * 2 + 0) * 4096, tid); load_v(F.vcu); }
    for (int c = F.vcu; c < DM; c += F.G) {
        const bool has_next = (c + F.G < DM);
        hy_store_kc(KC, kr, tid);
        { const int vc = 2048 + c; const float w0 = cw[0 * HYC + vc], w1 = cw[1 * HYC + vc], w2 = cw[2 * HYC + vc], cb = cbv[vc];
#pragma unroll
          for (int it = 0; it < 8; ++it) { const int idx = tid + 512 * it, b = idx >> 8, t8 = (idx & 255) * 8;
              const unsigned up = __shfl_up(um[it].w >> 16, 1), dn = __shfl_down(um[it].x & 0xffffu, 1);
              const float pm = bf2f(lane == 0 ? ee[it] : up), pp = bf2f(lane == 63 ? ee[it] : dn);
              u32x2 g0; g0.x = um[it].x; g0.y = um[it].y; u32x2 g1v; g1v.x = um[it].z; g1v.y = um[it].w;
              const f32x4 lo = hy_conv4(g0, pm, bflo(um[it].z), w0, w1, w2, cb), hi = hy_conv4(g1v, bfhi(um[it].y), pp, w0, w1, w2, cb);
              u32x4 o; o.x = pk2(lo[0], lo[1]); o.y = pk2(lo[2], lo[3]); o.z = pk2(hi[0], hi[1]); o.w = pk2(hi[2], hi[3]);
              *(LAS u32x4*)(U + b * HY_LDU + t8) = o; } }
        __syncthreads();
#pragma unroll
        for (int o = 0; o < 2; ++o) {
            const int gc = (o == 0) ? c : 1024 + c;
            int lz = lane; asm volatile("" : "+v"(lz));
            const bf16* grow = PT + (size_t)gc * MTOK + (size_t)(lz & 15) * SEQ;
            u32x2 gm[16];
#pragma unroll
            for (int tt = 0; tt < 16; ++tt) gm[tt] = *(const u32x2*)(grow + 256 * w + 16 * tt + 4 * fq);
            const unsigned edge_lo = (w > 0) ? (unsigned)grow[256 * w - 1] : 0u, edge_hi = (w < 7) ? (unsigned)grow[256 * w + 256] : 0u;
            if (o == 0) hy_load_kern(kr, KERN + ((size_t)c * 2 + 1) * 4096, tid);
            else if (has_next) hy_load_kern(kr, KERN + ((size_t)(c + F.G) * 2 + 0) * 4096, tid);
            f32x4 acc[16];
#pragma unroll
            for (int i = 0; i < 16; ++i) acc[i] = (f32x4){0.f, 0.f, 0.f, 0.f};
            const LAS bf16* kbase = KC + (fr & 7) * HY_KCS + 2048 + 8 * fq - 8 * (fr >> 3) - 256 * w;
            const LAS bf16* ubase = U + fr * HY_LDU + 8 * fq;
            bf16x8 win[16];
#pragma unroll
            for (int i = 0; i < 16; ++i) win[i] = *(const LAS bf16x8*)(kbase - 16 * i);
            bf16x8 bnx = *(const LAS bf16x8*)(ubase);
#define HY_TIE(a, b, c) asm volatile("s_waitcnt lgkmcnt(0)" : "+v"(a), "+v"(b), "+v"(c) :: "memory")
#pragma unroll 1
            for (int sj8 = 0; sj8 < 64; sj8 += 8) {
#pragma unroll
                for (int u = 0; u < 8; ++u) { const int sj = sj8 + u;
                    HY_TIE(bnx, win[(16 - 2 * u) & 15], win[(17 - 2 * u) & 15]);
                    const bf16x8 bfr = bnx;
#pragma unroll
                    for (int tt = 14; tt < 16; ++tt) acc[tt] = __builtin_amdgcn_mfma_f32_16x16x32_bf16(win[(tt - 2 * u) & 15], bfr, acc[tt], 0, 0, 0);
                    __builtin_amdgcn_sched_barrier(0);
                    bnx = *(const LAS bf16x8*)(ubase + 32 * ((sj + 1) & 63));
                    win[(14 - 2 * u) & 15] = *(const LAS bf16x8*)(kbase + 16 * (2 * sj + 2));
                    win[(15 - 2 * u) & 15] = *(const LAS bf16x8*)(kbase + 16 * (2 * sj + 1));
                    __builtin_amdgcn_sched_barrier(0);
#pragma unroll
                    for (int tt = 2; tt < 14; ++tt) acc[tt] = __builtin_amdgcn_mfma_f32_16x16x32_bf16(win[(tt - 2 * u) & 15], bfr, acc[tt], 0, 0, 0);
#pragma unroll
                    for (int tt = 0; tt < 2; ++tt) acc[tt] = __builtin_amdgcn_mfma_f32_16x16x32_bf16(win[(tt - 2 * u) & 15], bfr, acc[tt], 0, 0, 0);
                    __builtin_amdgcn_sched_barrier(0);
                } }
#undef HY_TIE
            if (o == 1 && has_next) load_v(c + F.G);
            const float hbias = hb[o * DM + c];
            const float w0 = cw[0 * HYC + gc], w1 = cw[1 * HYC + gc], w2 = cw[2 * HYC + gc], cb = cbv[gc];
            u32x2 zpk[16];
            unsigned pa[16], nb[16];
#pragma unroll
            for (int tt = 0; tt < 16; ++tt) { pa[tt] = __shfl(gm[tt].y >> 16, (lane + 48) & 63); nb[tt] = __shfl(gm[tt].x & 0xffffu, (lane + 16) & 63); }
#pragma unroll
            for (int tt = 0; tt < 16; ++tt) { const int t0 = 256 * w + 16 * tt + 4 * fq;
                const unsigned pmv = (fq > 0) ? pa[tt] : (tt > 0 ? pa[tt > 0 ? tt - 1 : 0] : edge_lo), ppv = (fq < 3) ? nb[tt] : (tt < 15 ? nb[tt < 15 ? tt + 1 : 15] : edge_hi);
                const u32x2 uu = *(const LAS u32x2*)(U + fr * HY_LDU + t0);
                const f32x4 g = hy_conv4(gm[tt], bf2f(pmv), bf2f(ppv), w0, w1, w2, cb);
                f32x4 y = acc[tt]; y[0] = g[0] * (y[0] + bflo(uu.x) * hbias); y[1] = g[1] * (y[1] + bfhi(uu.x) * hbias); y[2] = g[2] * (y[2] + bflo(uu.y) * hbias); y[3] = g[3] * (y[3] + bfhi(uu.y) * hbias);
                zpk[tt].x = pk2(y[0], y[1]); zpk[tt].y = pk2(y[2], y[3]); }
            __syncthreads();
            if (o == 0) {
#pragma unroll
                for (int tt = 0; tt < 16; ++tt) *(LAS u32x2*)(U + fr * HY_LDU + 256 * w + 16 * tt + 4 * fq) = zpk[tt];
                hy_store_kc(KC, kr, tid);
                __syncthreads();
            } else {
                int ly = lane; asm volatile("" : "+v"(ly));
                bf16* yrow = YT + (size_t)c * MTOK + (size_t)(ly & 15) * SEQ + 256 * w + 4 * (ly >> 4);
#pragma unroll
                for (int tt = 0; tt < 16; ++tt) *(u32x2*)(yrow + 16 * tt) = zpk[tt];
            }
        }
    }
}

__device__ __forceinline__ void ssd_conv_phase(Frame& F) {
    bf16* XBC = (bf16*)(F.ws + WS_XBC); const bf16* HALO = (const bf16*)(F.ws + WS_HALO);
    const float* scw = F.in[I_SCW]; const float* scb = F.in[I_SCB];
    const int gw = F.vcu * NWAVES + F.wave, NGW = F.G * NWAVES, lane = F.lane;
    for (int item = gw; item < BATCH * 32 * 8; item += NGW) {
        const int cb8 = item & 7, seg = (item >> 3) & 31, b = item >> 8, col = cb8 * 512 + lane * 8;
        float wk[5][8], cbv[8];
#pragma unroll
        for (int k = 0; k < 5; ++k) { const f32x4 a = *(const f32x4*)(scw + k * CONVD + col), c = *(const f32x4*)(scw + k * CONVD + col + 4);
#pragma unroll
            for (int e = 0; e < 4; ++e) { wk[k][e] = a[e]; wk[k][4 + e] = c[e]; } }
        { const f32x4 a = *(const f32x4*)(scb + col), c = *(const f32x4*)(scb + col + 4);
#pragma unroll
          for (int e = 0; e < 4; ++e) { cbv[e] = a[e]; cbv[4 + e] = c[e]; } }
        bf16* xrow0 = XBC + ((size_t)b * SEQ + seg * 64) * CONVD + col;
        const bf16* hlo = HALO + ((size_t)(b * 33 + seg) * 4) * CONVD + col;
        const bf16* hhi = HALO + ((size_t)(b * 33 + seg + 1) * 4 + 2) * CONVD + col;
        const u32x4 zero4 = {0u, 0u, 0u, 0u};
        u32x4 W[12];
        W[0] = seg > 0 ? *(const u32x4*)(hlo) : zero4; W[1] = seg > 0 ? *(const u32x4*)(hlo + CONVD) : zero4;
        W[2] = *(const u32x4*)(xrow0); W[3] = *(const u32x4*)(xrow0 + CONVD);
#pragma unroll 1
        for (int blk = 0; blk < 8; ++blk) { const int r0 = 8 * blk;
#pragma unroll
            for (int i = 4; i < 12; ++i) { const int rr = r0 - 2 + i;
                if (rr < 64) W[i] = *(const u32x4*)(xrow0 + (size_t)rr * CONVD);
                else W[i] = (seg < 31) ? *(const u32x4*)(hhi + (size_t)(rr - 64) * CONVD) : zero4; }
#pragma unroll
            for (int o = 0; o < 8; ++o) { float v[8];
#pragma unroll
                for (int e = 0; e < 8; ++e) v[e] = cbv[e];
#pragma unroll
                for (int k = 0; k < 5; ++k) { const u32x4 p = W[o + k];
                    v[0] += wk[k][0] * bflo(p.x); v[1] += wk[k][1] * bfhi(p.x); v[2] += wk[k][2] * bflo(p.y); v[3] += wk[k][3] * bfhi(p.y);
                    v[4] += wk[k][4] * bflo(p.z); v[5] += wk[k][5] * bfhi(p.z); v[6] += wk[k][6] * bflo(p.w); v[7] += wk[k][7] * bfhi(p.w); }
#pragma unroll
                for (int e = 0; e < 8; ++e) v[e] = siluf_(v[e]);
                u32x4 ov; ov.x = pk2(v[0], v[1]); ov.y = pk2(v[2], v[3]); ov.z = pk2(v[4], v[5]); ov.w = pk2(v[6], v[7]);
                *(u32x4*)(xrow0 + (size_t)(r0 + o) * CONVD) = ov; }
#pragma unroll
            for (int i = 0; i < 4; ++i) W[i] = W[8 + i];
        }
    }
}

constexpr int SS_LDC = 144, SS_LDM = 136;
constexpr int SS_C = 0, SS_B = 18432, SS_X = 36864, SS_XE = 55296, SS_M = 73728, SS_SB = 108544, SS_ACS = 145408, SS_DTV = 146432, SS_TOE = 147456, SS_END = 148480;
static_assert(SS_END <= MISC_OFF, "SSD LDS map");
typedef short s16x4 __attribute__((ext_vector_type(4)));
__device__ __forceinline__ bf16x8 ssd_trfrag(const LAS bf16* p) {
    const s16x4 a = __builtin_amdgcn_ds_read_tr16_b64_v4i16((LAS s16x4*)p), b = __builtin_amdgcn_ds_read_tr16_b64_v4i16((LAS s16x4*)(p + 16 * SS_LDC));
    return __builtin_shufflevector(a, b, 0, 1, 2, 3, 4, 5, 6, 7);
}

__device__ __forceinline__ void ssd_phase(Frame& F) {
    LAS unsigned char* L = F.lds;
    LAS bf16* Cl = (LAS bf16*)(L + SS_C); LAS bf16* Bl = (LAS bf16*)(L + SS_B); LAS bf16* Xr = (LAS bf16*)(L + SS_X); LAS bf16* XEr = (LAS bf16*)(L + SS_XE);
    LAS bf16* Ml = (LAS bf16*)(L + SS_M); LAS bf16* SB = (LAS bf16*)(L + SS_SB);
    LAS float* ACS = (LAS float*)(L + SS_ACS); LAS float* DTV = (LAS float*)(L + SS_DTV); LAS float* TOE = (LAS float*)(L + SS_TOE);
    const bf16* XBC = (const bf16*)(F.ws + WS_XBC); const float* DT = (const float*)(F.ws + WS_DT); const unsigned char* Z8 = (const unsigned char*)F.out; bf16* YS = (bf16*)(F.ws + WS_YSSD);
    const float* dtb = F.in[I_DTB]; const float* alog = F.in[I_ALOG]; const float* sd = F.in[I_SD];
    const int tid = F.tid, lane = F.lane, w = F.wave, fr = lane & 15, fq = lane >> 4;
    for (int unit = F.vcu; unit < BATCH * NGRP * 2; unit += F.G) {
        const int b = unit >> 4, g = (unit >> 1) & 7, hp = unit & 1, h0 = 4 * g + 2 * hp;
#pragma unroll 1
        for (int dir = 0; dir < 2; ++dir) {
            const float dtbias = (w < 2) ? dtb[dir * 32 + h0 + w] : 0.f, aexp = (w < 2) ? __expf(alog[dir * 32 + h0 + w]) : 0.f;
            auto scan = [&](int buf, float raw) {
                raw += dtbias; const float dtv = raw > 20.f ? raw : log1pf(__expf(raw)); float a = -dtv * aexp;
#pragma unroll
                for (int o = 1; o < 64; o <<= 1) { const float v = __shfl_up(a, o); if (lane >= o) a += v; }
                const float tot = __shfl(a, 63); const int ix = (buf * 2 + w) * 64 + lane;
                ACS[ix] = a; DTV[ix] = dtv; TOE[ix] = __expf(tot - a); };
            auto dtload = [&](int ci) -> float { const int ch = dir ? 31 - ci : ci, r = dir ? 63 - lane : lane;
                return DT[((size_t)b * SEQ + 64 * ch + r) * 64 + dir * 32 + h0 + w]; };
            auto rowload = [&](int ci, int it, int tl) -> u32x4 {
                const int l = (tl >> 4) + 32 * (it & 1), j = tl & 15, ch = dir ? 31 - ci : ci, r = dir ? 63 - l : l;
                const int col = (it < 2 ? 64 * h0 : (it < 4 ? 2048 + 128 * g : 3072 + 128 * g)) + 8 * j;
                return *(const u32x4*)(XBC + ((size_t)b * SEQ + 64 * ch + r) * CONVD + col); };
            f32x4 Sacc[8];
#pragma unroll
            for (int i = 0; i < 8; ++i) Sacc[i] = (f32x4){0.f, 0.f, 0.f, 0.f};
            const float dsk = sd[h0 + (w >> 2)];
            __syncthreads();
            for (int i = tid; i < 2 * 64 * SS_LDC / 2; i += NTHR) ((LAS unsigned*)SB)[i] = 0u;
            float dtn = 0.f;
            if (w < 2) { scan(0, dtload(0)); dtn = dtload(1); }
            u32x4 pf[6];
#pragma unroll
            for (int it = 0; it < 6; ++it) pf[it] = rowload(0, it, tid);
            __syncthreads();
#pragma unroll 1
            for (int ci = 0; ci < 32; ++ci) {
                const int ch = dir ? 31 - ci : ci, buf = ci & 1;
                const size_t tokbase = (size_t)b * SEQ + 64 * ch;
                int tl = tid; asm volatile("" : "+v"(tl));
                int frl = fr, fql = fq; asm volatile("" : "+v"(frl), "+v"(fql));
                const LAS float* acs = ACS + buf * 128; const LAS float* dtv = DTV + buf * 128; const LAS float* toe = TOE + buf * 128;
#pragma unroll
                for (int it = 0; it < 6; ++it) { const int l = (tl >> 4) + 32 * (it & 1), j = tl & 15; const u32x4 p = pf[it];
                    if (it < 2) { const int hh = j >> 3; const float de = dtv[hh * 64 + l] * toe[hh * 64 + l];
                        *(LAS u32x4*)(Xr + l * SS_LDC + j * 8) = p;
                        u32x4 q; q.x = pk2(bflo(p.x) * de, bfhi(p.x) * de); q.y = pk2(bflo(p.y) * de, bfhi(p.y) * de); q.z = pk2(bflo(p.z) * de, bfhi(p.z) * de); q.w = pk2(bflo(p.w) * de, bfhi(p.w) * de);
                        *(LAS u32x4*)(XEr + l * SS_LDC + j * 8) = q; }
                    else if (it < 4) { *(LAS u32x4*)(Bl + l * SS_LDC + j * 8) = p; }
                    else { *(LAS u32x4*)(Cl + l * SS_LDC + j * 8) = p; } }
                if (ci + 1 < 32) {
#pragma unroll
                    for (int it = 0; it < 6; ++it) pf[it] = rowload(ci + 1, it, tl); }
                __syncthreads();
                const int hh = w >> 2, li = w & 3, lrow = 16 * li + frl;
                const int rloc = dir ? 63 - lrow : lrow; const size_t tok = tokbase + rloc;
                u32x2 pv[4]; unsigned zv[4];
                if (dir) {
#pragma unroll
                    for (int pi = 0; pi < 4; ++pi) { const size_t o = tok * DSSM + 64 * (h0 + hh) + 16 * pi + 4 * fql; pv[pi] = *(const u32x2*)(YS + o); zv[pi] = *(const unsigned*)(Z8 + o); } }
#define SSD_FENCE() asm volatile("s_waitcnt lgkmcnt(0)" ::: "memory")
#define SSD_TIE8(a) asm volatile("s_waitcnt lgkmcnt(0)" : "+v"(a[0][0]), "+v"(a[0][1]), "+v"(a[1][0]), "+v"(a[1][1]), "+v"(a[2][0]), "+v"(a[2][1]), "+v"(a[3][0]), "+v"(a[3][1]) :: "memory")
#define SSD_TIE8K(a) asm volatile("s_waitcnt lgkmcnt(0)" : "+v"(a[0][0]), "+v"(a[0][1]), "+v"(a[0][2]), "+v"(a[0][3]), "+v"(a[1][0]), "+v"(a[1][1]), "+v"(a[1][2]), "+v"(a[1][3]) :: "memory")
                f32x4 Y[4];
                { bf16x8 cfr[4];
#pragma unroll
                  for (int kk = 0; kk < 4; ++kk) cfr[kk] = *(const LAS bf16x8*)(Cl + lrow * SS_LDC + 8 * fql + 32 * kk);
#pragma unroll
                  for (int ph = 0; ph < 2; ++ph) { bf16x8 sfr[2][4];
#pragma unroll
                      for (int pp = 0; pp < 2; ++pp)
#pragma unroll
                          for (int kk = 0; kk < 4; ++kk) sfr[pp][kk] = *(const LAS bf16x8*)(SB + (hh * 64 + 16 * (2 * ph + pp) + frl) * SS_LDC + 8 * fql + 32 * kk);
                      SSD_TIE8K(sfr);
#pragma unroll
                      for (int pp = 0; pp < 2; ++pp) { Y[2 * ph + pp] = (f32x4){0.f, 0.f, 0.f, 0.f};
#pragma unroll
                          for (int kk = 0; kk < 4; ++kk) Y[2 * ph + pp] = __builtin_amdgcn_mfma_f32_16x16x32_bf16(sfr[pp][kk], cfr[kk], Y[2 * ph + pp], 0, 0, 0); }
                      __builtin_amdgcn_sched_barrier(0); } }
                { bf16x8 cbA[2][4], cbB[2][4]; f32x4 tas[2], tdd[2]; float tal[2];
#pragma unroll
                  for (int q = 0; q < 2; ++q) { const int id = 2 * w + q, si = id >> 2, lj = id & 3;
                      if (si <= lj) {
#pragma unroll
                          for (int kk = 0; kk < 4; ++kk) { cbA[q][kk] = *(const LAS bf16x8*)(Bl + (16 * si + frl) * SS_LDC + 8 * fql + 32 * kk); cbB[q][kk] = *(const LAS bf16x8*)(Cl + (16 * lj + frl) * SS_LDC + 8 * fql + 32 * kk); } } }
                  auto tab_load = [&](int q) { const int id = 2 * w + q, si = id >> 2, lj = id & 3, l = 16 * lj + frl, s0 = 16 * si + 4 * fql;
#pragma unroll
                      for (int h = 0; h < 2; ++h) { tas[h] = *(const LAS f32x4*)(acs + 64 * h + s0); tdd[h] = *(const LAS f32x4*)(dtv + 64 * h + s0); tal[h] = acs[64 * h + l]; } };
                  tab_load(0);
                  SSD_FENCE();
#pragma unroll
                  for (int q = 0; q < 2; ++q) { const int id = 2 * w + q, si = id >> 2, lj = id & 3, l = 16 * lj + frl, s0 = 16 * si + 4 * fql;
                      u32x2 m0 = {0u, 0u}, m1 = {0u, 0u};
                      if (si <= lj) { f32x4 cb = (f32x4){0.f, 0.f, 0.f, 0.f};
#pragma unroll
                          for (int kk = 0; kk < 4; ++kk) cb = __builtin_amdgcn_mfma_f32_16x16x32_bf16(cbA[q][kk], cbB[q][kk], cb, 0, 0, 0);
                          float x0[4], x1[4];
#pragma unroll
                          for (int j = 0; j < 4; ++j) { const bool keep = (s0 + j <= l);
                              const float e0 = __expf(fminf(tal[0] - tas[0][j], 0.f)) * tdd[0][j], e1 = __expf(fminf(tal[1] - tas[1][j], 0.f)) * tdd[1][j];
                              const float c = keep ? cb[j] : 0.f; x0[j] = c * e0; x1[j] = c * e1; }
                          m0.x = pk2(x0[0], x0[1]); m0.y = pk2(x0[2], x0[3]); m1.x = pk2(x1[0], x1[1]); m1.y = pk2(x1[2], x1[3]); }
                      if (q == 0) tab_load(1);
                      *(LAS u32x2*)(Ml + (0 * 64 + l) * SS_LDM + s0) = m0; *(LAS u32x2*)(Ml + (1 * 64 + l) * SS_LDM + s0) = m1; } }
                __syncthreads();
                const int trb = (4 * fql + (frl >> 2)) * SS_LDC + 4 * (frl & 3);
                { bf16x8 mf[2], xdf[4][2];
#pragma unroll
                  for (int kk = 0; kk < 2; ++kk) { const LAS bf16* mp = Ml + (hh * 64 + lrow) * SS_LDM + 32 * kk + 4 * fql;
                      const s16x4 a = *(const LAS s16x4*)mp, b2 = *(const LAS s16x4*)(mp + 16); mf[kk] = __builtin_shufflevector(a, b2, 0, 1, 2, 3, 4, 5, 6, 7); }
#pragma unroll
                  for (int pi = 0; pi < 4; ++pi)
#pragma unroll
                      for (int kk = 0; kk < 2; ++kk) xdf[pi][kk] = ssd_trfrag(Xr + trb + 32 * kk * SS_LDC + hh * 64 + 16 * pi);
                  const float el = __expf(acs[hh * 64 + lrow]);
                  SSD_TIE8(xdf);
#pragma unroll
                  for (int pi = 0; pi < 4; ++pi) { Y[pi] = Y[pi] * el;
                      Y[pi] = __builtin_amdgcn_mfma_f32_16x16x32_bf16(xdf[pi][0], mf[0], Y[pi], 0, 0, 0);
                      Y[pi] = __builtin_amdgcn_mfma_f32_16x16x32_bf16(xdf[pi][1], mf[1], Y[pi], 0, 0, 0); }
                  __builtin_amdgcn_sched_barrier(0);
#pragma unroll
                  for (int pi = 0; pi < 4; ++pi) { const int p0 = 16 * pi + 4 * fql; bf16* yp = YS + tok * DSSM + 64 * (h0 + hh) + p0; f32x4 y = Y[pi];
                      if (dir == 0) { const u32x2 xv = *(const LAS u32x2*)(Xr + lrow * SS_LDC + hh * 64 + p0);
                          y[0] += dsk * bflo(xv.x); y[1] += dsk * bfhi(xv.x); y[2] += dsk * bflo(xv.y); y[3] += dsk * bfhi(xv.y);
                      } else { const u32x2 pvv = pv[pi]; const f32x2 z01 = __builtin_amdgcn_cvt_pk_f32_fp8((int)zv[pi], false), z23 = __builtin_amdgcn_cvt_pk_f32_fp8((int)zv[pi], true);
                          y[0] = (y[0] + bflo(pvv.x)) * siluf_(z01.x); y[1] = (y[1] + bfhi(pvv.x)) * siluf_(z01.y); y[2] = (y[2] + bflo(pvv.y)) * siluf_(z23.x); y[3] = (y[3] + bfhi(pvv.y)) * siluf_(z23.y); }
                      u32x2 o; o.x = pk2(y[0], y[1]); o.y = pk2(y[2], y[3]); *(u32x2*)yp = o; }
                  __builtin_amdgcn_sched_barrier(0); }
                { const int pi5 = w & 3; const float dec = __expf(acs[hh * 64 + 63]);
                  bf16x8 xef[2];
#pragma unroll
                  for (int kk = 0; kk < 2; ++kk) xef[kk] = ssd_trfrag(XEr + trb + 32 * kk * SS_LDC + hh * 64 + 16 * pi5);
#pragma unroll
                  for (int nh = 0; nh < 2; ++nh) { bf16x8 btf[4][2];
#pragma unroll
                      for (int nn = 0; nn < 4; ++nn)
#pragma unroll
                          for (int kk = 0; kk < 2; ++kk) btf[nn][kk] = ssd_trfrag(Bl + trb + 32 * kk * SS_LDC + 16 * (4 * nh + nn));
                      SSD_TIE8(btf);
#pragma unroll
                      for (int nn = 0; nn < 4; ++nn) { const int ni = 4 * nh + nn; Sacc[ni] = Sacc[ni] * dec;
                          Sacc[ni] = __builtin_amdgcn_mfma_f32_16x16x32_bf16(btf[nn][0], xef[0], Sacc[ni], 0, 0, 0);
                          Sacc[ni] = __builtin_amdgcn_mfma_f32_16x16x32_bf16(btf[nn][1], xef[1], Sacc[ni], 0, 0, 0); }
                      __builtin_amdgcn_sched_barrier(0); }
#pragma unroll
                  for (int ni = 0; ni < 8; ++ni) { u32x2 o; o.x = pk2(Sacc[ni][0], Sacc[ni][1]); o.y = pk2(Sacc[ni][2], Sacc[ni][3]);
                      *(LAS u32x2*)(SB + (hh * 64 + 16 * pi5 + frl) * SS_LDC + 16 * ni + 4 * fql) = o; } }
                if (w < 2 && ci + 1 < 32) { scan(buf ^ 1, dtn); if (ci + 2 < 32) dtn = dtload(ci + 2); }
                __syncthreads();
            }
        }
    }
}

__device__ __forceinline__ void ssd_norm_phase(Frame& F) {
    bf16* YS = (bf16*)(F.ws + WS_YSSD); const float* nw = F.in[I_SNW];
    const int gw = F.vcu * NWAVES + F.wave, NGW = F.G * NWAVES, lane = F.lane;
    f32x4 wv[8];
#pragma unroll
    for (int j = 0; j < 8; ++j) wv[j] = *(const f32x4*)(nw + lane * 32 + 4 * j);
    for (int m = gw; m < MTOK; m += 2 * NGW) {
        u32x4 v[2][4];
#pragma unroll
        for (int u = 0; u < 2; ++u)
#pragma unroll
            for (int j = 0; j < 4; ++j) v[u][j] = *(const u32x4*)(YS + (size_t)((m + u * NGW < MTOK) ? m + u * NGW : m) * DSSM + lane * 32 + 8 * j);
#pragma unroll
        for (int u = 0; u < 2; ++u) { if (m + u * NGW >= MTOK) break; bf16* row = YS + (size_t)(m + u * NGW) * DSSM + lane * 32; float ss = 0.f;
#pragma unroll
            for (int j = 0; j < 4; ++j) { const u32x4 q = v[u][j];
                const float a0 = bflo(q.x), a1 = bfhi(q.x), a2 = bflo(q.y), a3 = bfhi(q.y), a4 = bflo(q.z), a5 = bfhi(q.z), a6 = bflo(q.w), a7 = bfhi(q.w);
                ss += (a0 * a0 + a1 * a1) + (a2 * a2 + a3 * a3) + (a4 * a4 + a5 * a5) + (a6 * a6 + a7 * a7); }
            ss += __shfl_xor(ss, 1); ss += __shfl_xor(ss, 2); ss += __shfl_xor(ss, 4);
            const float rs = 1.0f / sqrtf(ss * (1.0f / 256.0f) + RMS_EPS);
#pragma unroll
            for (int j = 0; j < 4; ++j) { const u32x4 q = v[u][j]; const f32x4 w0 = wv[2 * j], w1 = wv[2 * j + 1];
                u32x4 o; o.x = pk2(bflo(q.x) * rs * w0[0], bfhi(q.x) * rs * w0[1]); o.y = pk2(bflo(q.y) * rs * w0[2], bfhi(q.y) * rs * w0[3]);
                o.z = pk2(bflo(q.z) * rs * w1[0], bfhi(q.z) * rs * w1[1]); o.w = pk2(bflo(q.w) * rs * w1[2], bfhi(q.w) * rs * w1[3]);
                *(u32x4*)(row + 8 * j) = o; } } }
}

constexpr int RT_WC = 131072;
__device__ __forceinline__ void ln1_router_phase(Frame& F) {
    const bf16* H1P = (const bf16*)(F.ws + WS_H1P); bf16* H1B = (bf16*)F.out;
    int* TOK = (int*)(F.ws + WS_TOK); float* WGT = (float*)(F.ws + WS_WGT); int* ASG = (int*)(F.ws + WS_ASG);
    const float* g1 = F.in[I_LN1G]; const float* b1 = F.in[I_LN1B]; const float* rw = F.in[I_RW]; const float* rb = F.in[I_RB];
    LAS float* hrow = (LAS float*)(F.lds + F.wave * 16384);
    LAS float* wc = (LAS float*)(F.lds + RT_WC);
    LAS unsigned* cl = (LAS unsigned*)(F.lds + RT_WC + 16384);
    if (F.tid < 64) cl[F.tid] = 0u;
    __syncthreads();
    const int lane = F.lane, tid = F.tid;
    f32x4 gv[4], bv[4];
#pragma unroll
    for (int j = 0; j < 4; ++j) { gv[j] = *(const f32x4*)(g1 + 4 * lane + 256 * j); bv[j] = *(const f32x4*)(b1 + 4 * lane + 256 * j); }
    const float rbias = rb[lane];
    for (int step = F.vcu; step < MTOK / 32; step += F.G) {
        const int rg = step * 8 + F.wave;
        f32x4 nx0 = *(const f32x4*)(rw + tid * 4), nx1 = *(const f32x4*)(rw + 2048 + tid * 4);
#pragma unroll 1
        for (int r = 0; r < 4; ++r) { const size_t m = (size_t)rg * 4 + r; const bf16* xr = H1P + m * DM;
            f32x4 v[4]; float s = 0.f;
#pragma unroll
            for (int j = 0; j < 4; ++j) { const u32x2 q = *(const u32x2*)(xr + 4 * lane + 256 * j); v[j][0] = bflo(q.x); v[j][1] = bfhi(q.x); v[j][2] = bflo(q.y); v[j][3] = bfhi(q.y); s += (v[j][0] + v[j][1]) + (v[j][2] + v[j][3]); }
            const float mean = wave_sum(s) * (1.f / DM); float s2 = 0.f;
#pragma unroll
            for (int j = 0; j < 4; ++j) { v[j] = v[j] - mean; s2 += (v[j][0] * v[j][0] + v[j][1] * v[j][1]) + (v[j][2] * v[j][2] + v[j][3] * v[j][3]); }
            const float rstd = 1.f / sqrtf(wave_sum(s2) * (1.f / DM) + LN_EPS);
#pragma unroll
            for (int j = 0; j < 4; ++j) { const f32x4 h = v[j] * rstd * gv[j] + bv[j];
                u32x2 o; o.x = pk2(h[0], h[1]); o.y = pk2(h[2], h[3]); *(u32x2*)(H1B + m * H1B_PITCH + 4 * lane + 256 * j) = o;
                *(LAS f32x4*)(hrow + r * 1024 + 4 * lane + 256 * j) = h; } }
        float lg[4] = {0.f, 0.f, 0.f, 0.f};
#pragma unroll 1
        for (int kc = 0; kc < 16; ++kc) {
            __syncthreads();
            *(LAS f32x4*)(wc + tid * 4) = nx0; *(LAS f32x4*)(wc + 2048 + tid * 4) = nx1;
            if (kc + 1 < 16) { nx0 = *(const f32x4*)(rw + (kc + 1) * 4096 + tid * 4); nx1 = *(const f32x4*)(rw + (kc + 1) * 4096 + 2048 + tid * 4); }
            __syncthreads();
#pragma unroll 4
            for (int kk = 0; kk < 64; kk += 4) {
                const float w0 = wc[(kk + 0) * 64 + lane], w1 = wc[(kk + 1) * 64 + lane], w2 = wc[(kk + 2) * 64 + lane], w3 = wc[(kk + 3) * 64 + lane];
#pragma unroll
                for (int r = 0; r < 4; ++r) { const f32x4 h = *(const LAS f32x4*)(hrow + r * 1024 + kc * 64 + kk); lg[r] += h[0] * w0 + h[1] * w1 + h[2] * w2 + h[3] * w3; } }
        }
        bool selr[4]; float wgr[4]; int rkr[4];
#pragma unroll
        for (int r = 0; r < 4; ++r) {
            const float score = 1.0f / (1.0f + expf(-lg[r])), biased = score + rbias;
            float m1 = biased; m1 = fmaxf(m1, __shfl_xor(m1, 1)); m1 = fmaxf(m1, __shfl_xor(m1, 2)); m1 = fmaxf(m1, __shfl_xor(m1, 4));
            const unsigned long long eq = __ballot(biased == m1); const int gbase = lane & ~7; const int first = gbase + __ffs((unsigned)((eq >> gbase) & 0xffull)) - 1;
            float v2 = (lane == first) ? -INFINITY : biased; v2 = fmaxf(v2, __shfl_xor(v2, 1)); v2 = fmaxf(v2, __shfl_xor(v2, 2)); v2 = fmaxf(v2, __shfl_xor(v2, 4));
            const float gs = m1 + v2; const int g = lane >> 3; int better = 0;
#pragma unroll
            for (int d = 1; d < 8; ++d) { const int g2 = (g + d) & 7; const float og = __shfl(gs, g2 * 8); better += (og > gs || (og == gs && g2 < g)) ? 1 : 0; }
            float masked = (better < 4) ? biased : -INFINITY; bool sel = false;
#pragma unroll 1
            for (int it = 0; it < TOPK; ++it) { const float mx = wave_max(masked); const unsigned long long bm = __ballot(masked == mx); const int win = __ffsll((long long)bm) - 1;
                if (lane == win) { sel = true; masked = -INFINITY; } }
            const float sw = wave_sum(sel ? score : 0.f);
            const unsigned long long selm = __ballot(sel);
            selr[r] = sel; wgr[r] = score / sw * ROUTED_SCALE; rkr[r] = __popcll(selm & ((1ull << lane) - 1ull)); }
        unsigned lp[4];
#pragma unroll
        for (int r = 0; r < 4; ++r) lp[r] = selr[r] ? atomicAdd((unsigned*)(cl + lane), 1u) : 0u;
        __syncthreads();
        if (F.wave == 0) { const unsigned n = cl[lane]; unsigned bs = 0u;
            if (n) bs = __hip_atomic_fetch_add((unsigned*)(F.ctl + CW_CNT + 64 * lane), n, __ATOMIC_RELAXED, __HIP_MEMORY_SCOPE_AGENT);
            cl[64 + lane] = bs; cl[lane] = 0u; }
        __syncthreads();
        const unsigned bse = cl[64 + lane];
#pragma unroll
        for (int r = 0; r < 4; ++r) if (selr[r]) { const int m = rg * 4 + r; const unsigned pos = bse + lp[r];
            TOK[(size_t)lane * MTOK + pos] = m; WGT[(size_t)lane * MTOK + pos] = wgr[r]; ASG[(size_t)m * 8 + rkr[r]] = lane * MTOK + (int)pos; }
    }
}
constexpr int MOE_TP = 131072 + 1024, MOE_CNT = MOE_TP + 512, MOE_TE = 131072 + 4096;
__device__ __forceinline__ int moe_table(Frame& F) {
    LAS int* tp = (LAS int*)(F.lds + MOE_TP); LAS int* cnt = (LAS int*)(F.lds + MOE_CNT);
    __syncthreads();
    if (F.tid == 0) { int run = 0;
        for (int e = 0; e < NEX; ++e) { const int c = (e < NE) ? (int)__hip_atomic_load((unsigned*)(F.ctl + CW_CNT + 64 * e), __ATOMIC_RELAXED, __HIP_MEMORY_SCOPE_AGENT) : MTOK;
            cnt[e] = c; tp[e] = run; run += (c + 255) >> 8; }
        tp[NEX] = run; }
    __syncthreads();
    { LAS int* te = (LAS int*)(F.lds + MOE_TE); const int total = tp[NEX];
      for (int t = F.tid; t < total; t += NTHR) { int e = 0;
#pragma unroll 1
          for (int s = 64; s >= 1; s >>= 1) if (e + s <= NE && tp[e + s] <= t) e += s;
          te[t] = e; } }
    __syncthreads();
    return tp[NEX];
}
__device__ __forceinline__ void fp8x4_fma(f32x4& a, const unsigned v, const float w) {
    const f32x2 p0 = __builtin_amdgcn_cvt_pk_f32_fp8((int)v, false), p1 = __builtin_amdgcn_cvt_pk_f32_fp8((int)v, true);
    a[0] += w * p0.x; a[1] += w * p0.y; a[2] += w * p1.x; a[3] += w * p1.y;
}
__device__ __forceinline__ void moe_combine_phase(Frame& F) {
    const bf16* H1B = (const bf16*)F.out; const unsigned char* YQ = (const unsigned char*)(F.ws + WS_YQ); const int* ASG = (const int*)(F.ws + WS_ASG); const float* WGT = (const float*)(F.ws + WS_WGT);
    const LAS int* tp = (const LAS int*)(F.lds + MOE_TP);
    const float* g2 = F.in[I_LN2G]; const float* b2 = F.in[I_LN2B];
    const int gw = F.vcu * NWAVES + F.wave, NGW = F.G * NWAVES, lane = F.lane;
    const size_t shbase = (size_t)tp[NE] * 256;
    f32x4 gv[4], bv[4];
#pragma unroll
    for (int j = 0; j < 4; ++j) { gv[j] = *(const f32x4*)(g2 + 4 * lane + 256 * j); bv[j] = *(const f32x4*)(b2 + 4 * lane + 256 * j); }
    const int l8 = lane & 7;
    int li = ASG[(size_t)gw * 8 + l8];
    float wk = WGT[li];
    int li_n = (gw + NGW < MTOK) ? ASG[(size_t)(gw + NGW) * 8 + l8] : 0;
    for (int m = gw; m < MTOK; m += NGW) {
        const int e = li >> 15, pos = li & 32767; const int slot = 256 * tp[e] + pos; const float wcur = wk;
        unsigned vv[9][4]; f32x4 v[4];
        { const unsigned char* sp = YQ + (shbase + m) * 1024 + 4 * lane;
#pragma unroll
          for (int j = 0; j < 4; ++j) vv[8][j] = *(const unsigned*)(sp + 256 * j); }
#pragma unroll
        for (int k = 0; k < 8; ++k) { const int sk = __shfl(slot, k); const unsigned char* sp = YQ + (size_t)sk * 1024 + 4 * lane;
#pragma unroll
            for (int j = 0; j < 4; ++j) vv[k][j] = *(const unsigned*)(sp + 256 * j); }
        float* xr = F.out + (size_t)m * DM + 4 * lane; const bf16* hr = H1B + (size_t)m * H1B_PITCH + 4 * lane; u32x2 hq[4];
#pragma unroll
        for (int j = 0; j < 4; ++j) hq[j] = *(const u32x2*)(hr + 256 * j);
        li = li_n; wk = WGT[li];
        li_n = (m + 2 * NGW < MTOK) ? ASG[(size_t)(m + 2 * NGW) * 8 + l8] : 0;
#pragma unroll
        for (int j = 0; j < 4; ++j) { v[j][0] = DN_ALPHA * bflo(hq[j].x); v[j][1] = DN_ALPHA * bfhi(hq[j].x); v[j][2] = DN_ALPHA * bflo(hq[j].y); v[j][3] = DN_ALPHA * bfhi(hq[j].y); fp8x4_fma(v[j], vv[8][j], 1.0f); }
#pragma unroll
        for (int k = 0; k < 8; ++k) { const float w = __shfl(wcur, k);
#pragma unroll
            for (int j = 0; j < 4; ++j) fp8x4_fma(v[j], vv[k][j], w); }
        float s = 0.f;
#pragma unroll
        for (int j = 0; j < 4; ++j) s += (v[j][0] + v[j][1]) + (v[j][2] + v[j][3]);
        const float mean = wave_sum(s) * (1.f / DM); float s2 = 0.f;
#pragma unroll
        for (int j = 0; j < 4; ++j) { v[j] = v[j] - mean; s2 += (v[j][0] * v[j][0] + v[j][1] * v[j][1]) + (v[j][2] * v[j][2] + v[j][3] * v[j][3]); }
        const float rstd = 1.f / sqrtf(wave_sum(s2) * (1.f / DM) + LN_EPS);
#pragma unroll
        for (int j = 0; j < 4; ++j) *(f32x4*)(xr + 256 * j) = v[j] * rstd * gv[j] + bv[j];
    }
}

#ifndef MK_N_LAUNCHES
#define MK_N_LAUNCHES 1
#endif
constexpr int NPH = 15;
constexpr int N_LAUNCHES = MK_N_LAUNCHES;

__global__ void __launch_bounds__(NTHR, 2) fwd_kernel(Args args) {
    extern __shared__ __attribute__((aligned(16))) unsigned char lds_raw[];
    Frame F;
    F.lds = (LAS unsigned char*)lds_raw;
    F.MISC = (volatile LAS unsigned*)(F.lds + MISC_OFF);
    F.tid = threadIdx.x; F.lane = F.tid & 63; F.wave = __builtin_amdgcn_readfirstlane(F.tid >> 6);
    F.G = gridDim.x; { const int bx = blockIdx.x; F.vcu = (F.G % 8 == 0) ? (bx % 8) * (F.G / 8) + bx / 8 : bx; }
    F.ws = args.ws; F.ctl = (gu32*)(args.ws + WS_CTL); F.in = args.in; F.out = args.out;
    for (int u = F.tid; u < (LDS_BYTES - MISC_OFF) / 4; u += NTHR) ((LAS unsigned*)(F.lds + MISC_OFF))[u] = 0u;
    __syncthreads();
    XcdBarrier bar; bar.bar = (unsigned*)(F.ctl + CW_BAR); bar.x = 0; bar.st = nullptr;
    if (N_LAUNCHES != NPH) bar = xcd_barrier_post((unsigned*)(F.ctl + CW_BAR), F.MISC + 8);
    const int lo = args.ph_lo, hi = args.ph_hi;
#ifndef PH_MASK
#define PH_MASK 0x7fff
#endif
#define IN(k) ((((PH_MASK) >> (k)) & 1) && lo <= (k) && (k) < hi)
#ifdef STRESS_US
#define SKEW() do { if ((blockIdx.x * 2654435761u >> 28) & 1) { const unsigned long long t0_ = __builtin_amdgcn_s_memrealtime(); while (__builtin_amdgcn_s_memrealtime() - t0_ < (unsigned long long)(STRESS_US) * 100ull) __builtin_amdgcn_s_sleep(8); } __syncthreads(); } while (0)
#else
#define SKEW() do { } while (0)
#endif
#define SEAM(k) do { if (IN(k) && IN((k) + 1)) { xcd_barrier(bar); SKEW(); } } while (0)
#ifndef REP_MASK
#define REP_MASK 0
#endif
#define REPS(k) for (int rep_ = 0; rep_ < ((((REP_MASK) >> (k)) & 1) ? 2 : 1); ++rep_, ((((REP_MASK) >> (k)) & 1) && rep_ == 1 ? xcd_barrier(bar) : (void)0))
    const int G = F.G, bx = (int)blockIdx.x;

#ifdef START_BARS
    for (int xb_ = 0; xb_ < START_BARS; ++xb_) xcd_barrier(bar);
#endif
    if (IN(0)) REPS(0) { p0_prologue(F); } SEAM(0);
    if (IN(1)) REPS(1) {
        pg8::StaticOrder S; S.init((const bf16*)((unsigned char*)F.out + OUT_XB), (const bf16*)(F.ws + WS_WINT), MTOK, HYC, DM, G, bx);
        pg8::EpiHyT E{(bf16*)(F.ws + WS_PTHY), F.in[I_BIN], F.lds + pg8::STAGE_BYTES};
        pg8::gemm_phase<pg8::EpiHyT, pg8::StaticOrder, false>(F.lds, DM, S, E);
    } SEAM(1);
    if (IN(2)) REPS(2) { hyena_phase(F); } SEAM(2);
    if (IN(3)) REPS(3) { p3_transpose(F); } SEAM(3);
    if (IN(4)) REPS(4) {
        pg8::StaticOrder S; S.init((const bf16*)((unsigned char*)F.out + OUT_XB), (const bf16*)(F.ws + WS_WINT) + (size_t)3072 * DM, MTOK, 6400, DM, G, bx);
        pg8::EpiZXD E{(unsigned char*)F.out, (bf16*)(F.ws + WS_XBC), (float*)(F.ws + WS_DT), F.in[I_BIN], (bf16*)(F.ws + WS_HALO)};
        pg8::gemm_phase<pg8::EpiZXD, pg8::StaticOrder, false>(F.lds, DM, S, E);
    } SEAM(4);
    if (IN(5)) REPS(5) { ssd_conv_phase(F); } SEAM(5);
    if (IN(6)) REPS(6) { ssd_phase(F); } SEAM(6);
    if (IN(7)) REPS(7) { ssd_norm_phase(F); }
    if (IN(8)) REPS(8) {
        pg8::StaticOrder S; S.init((const bf16*)((unsigned char*)F.out + OUT_XB), (const bf16*)(F.ws + WS_WING), MTOK, 2048, DM, G, bx);
        pg8::EpiBf<0> E{(bf16*)(F.ws + WS_G), 2048, F.in[I_BIN] + 9280, nullptr, 0, nullptr};
        pg8::gemm_phase<pg8::EpiBf<0>, pg8::StaticOrder, false>(F.lds, DM, S, E);
    } SEAM(8);
    if (IN(9)) REPS(9) {
        pg8::StaticOrder S; S.init((const bf16*)(F.ws + WS_YHY), (const bf16*)(F.ws + WS_WHYB), MTOK, DM, DM, G, bx);
        pg8::EpiBf<1> E{(bf16*)(F.ws + WS_MIX), DM, nullptr, (const bf16*)(F.ws + WS_G), 2048, nullptr};
        pg8::gemm_phase<pg8::EpiBf<1>, pg8::StaticOrder, false>(F.lds, DM, S, E);
    }
    if (IN(10)) REPS(10) {
        pg8::StaticOrder S; S.init((const bf16*)(F.ws + WS_YSSD), (const bf16*)(F.ws + WS_WSSDB), MTOK, DM, DSSM, G, bx);
        pg8::EpiBf<2> E{(bf16*)(F.ws + WS_MIX), DM, nullptr, (const bf16*)(F.ws + WS_G) + 1024, 2048, (const bf16*)(F.ws + WS_MIX)};
        pg8::gemm_phase<pg8::EpiBf<2>, pg8::StaticOrder, false>(F.lds, DSSM, S, E);
    } SEAM(10);
    if (IN(11)) REPS(11) {
        pg8::StaticOrder S; S.init((const bf16*)(F.ws + WS_MIX), (const bf16*)(F.ws + WS_WOUT), MTOK, DM, DM, G, bx);
        pg8::EpiRes E{(bf16*)(F.ws + WS_H1P), F.in[I_BOUT], (const bf16*)((unsigned char*)F.out + OUT_XB), DN_ALPHA};
        pg8::gemm_phase<pg8::EpiRes, pg8::StaticOrder, false>(F.lds, DM, S, E);
        p10_expert_weights(F);
    } SEAM(11);
    if (IN(12)) REPS(12) { ln1_router_phase(F); } SEAM(12);
    if (IN(13)) REPS(13) {
        const int total = moe_table(F);
        pg8::MoeOrder<2, true> S{(const LAS int*)(F.lds + MOE_TP), (const LAS int*)(F.lds + MOE_CNT), (const LAS int*)(F.lds + MOE_TE), G, bx, total, (const char*)F.out, (const char*)(F.ws + WS_EW1), (const int*)(F.ws + WS_TOK)};
        pg8::EpiSwiGLU E{(bf16*)(F.ws + WS_HID)};
        pg8::gemm_phase<pg8::EpiSwiGLU, pg8::MoeOrder<2, true>, true>(F.lds, DM, S, E);
    } SEAM(13);
    if (IN(14)) {
        const int total = moe_table(F);
        { pg8::SlotOrder4 S{(const LAS int*)(F.lds + MOE_TP), (const LAS int*)(F.lds + MOE_TE), G, bx, total, (const char*)(F.ws + WS_HID), (const char*)(F.ws + WS_EW2)};
          pg8::EpiSlot8 E{(unsigned char*)(F.ws + WS_YQ)}; int kd = DEXP; asm volatile("" : "+s"(kd));
          pg8::gemm_phase<pg8::EpiSlot8, pg8::SlotOrder4, false>(F.lds, kd, S, E); }
        xcd_barrier(bar);
        moe_combine_phase(F);
    }
#ifdef EXTRA_BARS
    for (int xb_ = 0; xb_ < EXTRA_BARS; ++xb_) xcd_barrier(bar);
#endif
#undef IN
#undef SEAM
}

extern "C" void kernel_launch(void* const* d_in, const int* in_sizes, int n_in, void* d_out, int out_size, void* d_ws, size_t ws_size, hipStream_t stream) {
    static int grid = 0;
    if (grid == 0) {
        if (n_in != 38 || out_size != MTOK * DM || ws_size < WS_END) { fprintf(stderr, "kernel_launch: unexpected shapes (n_in %d out %d ws %zu)\n", n_in, out_size, ws_size); grid = -1; return; }
        int dev = 0, cus = 0, per_cu = 0;
        if (hipGetDevice(&dev) != hipSuccess || hipDeviceGetAttribute(&cus, hipDeviceAttributeMultiprocessorCount, dev) != hipSuccess) { grid = -1; return; }
        if (hipFuncSetAttribute((const void*)fwd_kernel, hipFuncAttributeMaxDynamicSharedMemorySize, LDS_BYTES) != hipSuccess) { fprintf(stderr, "kernel_launch: hipFuncSetAttribute failed\n"); grid = -1; return; }
        if (hipOccupancyMaxActiveBlocksPerMultiprocessor(&per_cu, (const void*)fwd_kernel, NTHR, LDS_BYTES) != hipSuccess || per_cu < 1) fprintf(stderr, "kernel_launch: occupancy query says %d\n", per_cu);
        (void)hipGetLastError();
        grid = cus;
    }
    if (grid < 0) return;
#ifdef EXTRA_PHASE
    {
        (void)hipMemsetAsync((char*)d_ws + WS_CTL, 0, CTL_ZERO_BYTES, stream);
        Args x{}; for (int i = 0; i < 38; ++i) x.in[i] = (const float*)d_in[i];
        x.out = (float*)d_out; x.ws = (unsigned char*)d_ws; x.ph_lo = EXTRA_PHASE; x.ph_hi = EXTRA_PHASE + 1; x.li = 0;
        hipLaunchKernelGGL(fwd_kernel, dim3(grid), dim3(NTHR), LDS_BYTES, stream, x);
    }
#endif
    (void)hipMemsetAsync((char*)d_ws + WS_CTL, 0, CTL_ZERO_BYTES, stream);
    Args a{};
    for (int i = 0; i < 38; ++i) a.in[i] = (const float*)d_in[i];
    a.out = (float*)d_out; a.ws = (unsigned char*)d_ws;
    for (int li = 0; li < N_LAUNCHES; ++li) {
        a.ph_lo = (N_LAUNCHES == NPH) ? li : 0; a.ph_hi = (N_LAUNCHES == NPH) ? li + 1 : NPH; a.li = li;
        hipLaunchKernelGGL(fwd_kernel, dim3(grid), dim3(NTHR), LDS_BYTES, stream, a);
    }
}
```

```cpp
#define MK_N_LAUNCHES 1
#include <hip/hip_runtime.h>
#include <cstdio>
#include <cstdint>

#define LAS __attribute__((address_space(3)))
#define GAS __attribute__((address_space(1)))
typedef unsigned short bf16;
typedef short bf16x8 __attribute__((ext_vector_type(8)));
typedef float f32x4 __attribute__((ext_vector_type(4)));
typedef float f32x2 __attribute__((ext_vector_type(2)));
typedef unsigned u32x4 __attribute__((ext_vector_type(4)));
typedef unsigned u32x2 __attribute__((ext_vector_type(2)));
typedef GAS unsigned gu32;

constexpr int BATCH = 16, SEQ = 2048, DM = 1024, MTOK = BATCH * SEQ;
constexpr int HYC = 3072, DSSM = 2048, CONVD = 4096, NHEAD = 32, NGRP = 8, NSTATE = 128, INC = 11328;
constexpr int NE = 64, TOPK = 8, DEXP = 256, NEX = NE + 1;
constexpr float DN_ALPHA = 1.189207115002721f;
constexpr float LN_EPS = 1e-5f, RMS_EPS = 1e-5f, ROUTED_SCALE = 2.5f;
constexpr int NWAVES = 8, NTHR = 512;
constexpr int WIN_ROWS = 11520;

constexpr size_t MiB = 1u << 20;
constexpr size_t WS_CTL = 0, CTL_ZERO_BYTES = 256 * 1024;
constexpr size_t WS_WHYB = 1 * MiB, WS_WSSDB = 3 * MiB, WS_WOUT = 7 * MiB;
constexpr size_t WS_XB = 9 * MiB;
constexpr size_t WS_WINT = 73 * MiB;
constexpr size_t WS_KERN = 96 * MiB;
constexpr size_t WS_PTHY = 112 * MiB;
constexpr size_t WS_YTHY = 304 * MiB;
constexpr size_t WS_YHY = 137 * MiB;
constexpr size_t WS_XBC = 201 * MiB;
constexpr size_t WS_DT = 457 * MiB;
constexpr size_t WS_HALO = 465 * MiB;
constexpr size_t WS_YSSD = 9 * MiB;
constexpr size_t WS_XB2 = 201 * MiB;
constexpr size_t WS_WING = 505 * MiB;
constexpr size_t WS_G = 269 * MiB;
constexpr size_t WS_MIX = 397 * MiB;
constexpr int H1B_PITCH = 2048;
constexpr size_t WS_EW1 = 9 * MiB;
constexpr size_t WS_EW2 = 477 * MiB;
constexpr size_t WS_YQ = 1 * MiB;
constexpr size_t WS_ASG = 510 * MiB;
constexpr size_t WS_H1P = 177 * MiB;
constexpr size_t WS_HID = 305 * MiB;
constexpr size_t WS_TOK = 461 * MiB;
constexpr size_t WS_WGT = 469 * MiB;
constexpr size_t WS_END = 511 * MiB;
constexpr size_t OUT_XB = 64 * MiB;
constexpr int CW_BAR = 4096;
constexpr int CW_CNT = 16384;
constexpr int CW_DBG = 32768;

constexpr int LDS_BYTES = 163840;
constexpr int MISC_OFF = 163840 - 512;

#define RLX_AGENT __ATOMIC_RELAXED, __HIP_MEMORY_SCOPE_AGENT
#define LDS_WAIT() asm volatile("s_waitcnt lgkmcnt(0)" ::: "memory")
#define VM_WAIT() asm volatile("s_waitcnt vmcnt(0)" ::: "memory")
typedef __bf16 bf16x2_t __attribute__((ext_vector_type(2)));
__device__ __forceinline__ unsigned pk2(float lo, float hi) { const f32x2 v = {lo, hi}; return __builtin_bit_cast(unsigned, __builtin_convertvector(v, bf16x2_t)); }
__device__ __forceinline__ unsigned f2bf(float f) { return pk2(f, 0.f) & 0xffffu; }
__device__ __forceinline__ float bf2f(unsigned b) { return __builtin_bit_cast(float, b << 16); }
__device__ __forceinline__ float bflo(unsigned w) { return __builtin_bit_cast(float, w << 16); }
__device__ __forceinline__ float bfhi(unsigned w) { return __builtin_bit_cast(float, w & 0xffff0000u); }
__device__ __forceinline__ float sigmoidf_(float v) { return __builtin_amdgcn_rcpf(1.0f + __expf(-v)); }
__device__ __forceinline__ float siluf_(float v) { return v * __builtin_amdgcn_rcpf(1.0f + __expf(-v)); }
__device__ __forceinline__ float wave_sum(float v) {
#pragma unroll
    for (int o = 1; o < 64; o <<= 1) v += __shfl_xor(v, o);
    return v;
}
__device__ __forceinline__ float wave_max(float v) {
#pragma unroll
    for (int o = 1; o < 64; o <<= 1) v = fmaxf(v, __shfl_xor(v, o));
    return v;
}

#ifndef PG8_WGM
#define PG8_WGM 8
#endif
namespace pg8 {
constexpr int BM = 256, BK = 64, HALF = 128, HTB = HALF * BK * 2, STAGE_BYTES = 8 * HTB, NXCD = 8, WGM = PG8_WGM;
__host__ __device__ __forceinline__ int lds_byte(int r, int c) { const int st = (r >> 4) * 2 + (c >> 5), rr = r & 15, cc = c & 31, ob = rr * 64 + cc * 2; return st * 1024 + (ob ^ (((ob >> 9) & 1) << 5)); }
__host__ __device__ __forceinline__ void stage_rc(int b, int& R, int& C) { const int st = b / 1024, sb = b % 1024, swz = sb ^ (((sb >> 9) & 1) << 5); R = (st >> 1) * 16 + swz / 64; C = (st & 1) * 32 + (swz % 64) / 2; }
__host__ __device__ __forceinline__ int perm32(int rho) { const int n = rho >> 4, i = rho & 15; return 8 * (i >> 2) + 4 * n + (i & 3); }

struct Unit { int pm, pn; const char* A; const char* B; int e, cnt; };

struct StaticOrder {
    int nM, nN, nwg, G, c, K; const char* A; const char* B;
    __device__ void init(const bf16* A_, const bf16* B_, int M, int N, int K_, int G_, int c_) { A = (const char*)A_; B = (const char*)B_; nM = M / BM; nN = N / BM; nwg = nM * nN; G = G_; c = c_; K = K_; }
    __device__ __forceinline__ bool next(int i, Unit& u) const {
        const long L = (long)i * G + c; if (L >= nwg) return false;
        int wgid = (int)L; { const int q = nwg / NXCD, r = nwg % NXCD, xcd = wgid % NXCD, off = wgid / NXCD; wgid = (xcd < r ? xcd * (q + 1) : r * (q + 1) + (xcd - r) * q) + off; }
        const int nig = WGM * nN, gid = wgid / nig, fm = gid * WGM, gsz = (nM - fm) < WGM ? (nM - fm) : WGM;
        u.pm = fm + ((wgid % nig) % gsz); u.pn = (wgid % nig) / gsz;
        u.A = A + (size_t)u.pm * BM * K * 2; u.B = B + (size_t)u.pn * BM * K * 2; u.e = 0; u.cnt = 0; return true;
    }
    __device__ __forceinline__ unsigned row_off(const Unit&, int) const { return 0u; }
};

__device__ __forceinline__ unsigned cvt_pk_bf16(float lo, float hi) { unsigned r; asm volatile("v_cvt_pk_bf16_f32 %0, %1, %2" : "=v"(r) : "v"(lo), "v"(hi)); return r; }

#ifndef PG8_SP2
#define PG8_SP2 true
#endif
#ifndef PG8_ALIGN
#define PG8_ALIGN true
#endif
template <class Epi, class Sched, bool GATHER, bool SP2 = PG8_SP2, bool ALIGN_EPI = PG8_ALIGN>
__device__ __forceinline__ void gemm_phase(LAS unsigned char* lds, const int K, const Sched& S, const Epi& E) {
    constexpr bool TA = Epi::TA;
    const int tid = threadIdx.x, wid = __builtin_amdgcn_readfirstlane(tid >> 6), lane = tid & 63, wr = wid >> 2, wc = wid & 3, fr = lane & 15, fq = lane >> 4;
    const int nt = K / BK;
    unsigned voffA[2][2], voffB[2]; int RA[2], CA[2];
#pragma unroll
    for (int i = 0; i < 2; ++i) { int R, C; stage_rc(tid * 16 + i * 8192, R, C); const int Rb = Epi::PERM ? ((R & ~31) + perm32(R & 31)) : R;
        RA[i] = R; CA[i] = C; voffA[0][i] = (unsigned)(R * K + C) * 2u; voffA[1][i] = voffA[0][i]; voffB[i] = (unsigned)(Rb * K + C) * 2u; }
    const size_t kstep = (size_t)(BK * 2);
    const size_t hstep = (size_t)HALF * K * 2;
    const size_t hstepA = GATHER ? 0 : hstep;
    const unsigned ldsw = (unsigned)wid * 1024u;
    const int aoff = lds_byte(wr * 64 + fr, fq * 8), boff = lds_byte(wc * 32 + fr, fq * 8);
#define PG8_SA(b, h) (((b) * 2 + (h)) * HTB)
#define PG8_SB(b, h) ((4 + (b) * 2 + (h)) * HTB)
#define PG8_STAGE(bufoff, gbase, voff) do { _Pragma("unroll") for (int _i = 0; _i < 2; ++_i) \
        __builtin_amdgcn_global_load_lds((const unsigned*)((const char*)(gbase) + (voff)[_i]), (LAS unsigned*)(lds + (bufoff) + ldsw + _i * 8192), 16, 0, 0); } while (0)
#define PG8_STAGE_A(bufoff, gbase, h) PG8_STAGE(bufoff, (gbase) + (h) * hstepA, voffA[GATHER ? (h) : 0])
#define PG8_LDA(dst, b, h) do { _Pragma("unroll") for (int m = 0; m < 4; ++m) _Pragma("unroll") for (int k = 0; k < 2; ++k) dst[m][k] = *(const LAS bf16x8*)(lds + PG8_SA(b, h) + aoff + m * 2048 + k * 1024); } while (0)
#define PG8_LDB(dst, b, h) do { _Pragma("unroll") for (int n = 0; n < 2; ++n) _Pragma("unroll") for (int k = 0; k < 2; ++k) dst[n][k] = *(const LAS bf16x8*)(lds + PG8_SB(b, h) + boff + n * 2048 + k * 1024); } while (0)
#define PG8_MMA(ai, bj, At, Bt) do { __builtin_amdgcn_s_setprio(1); _Pragma("unroll") for (int m = 0; m < 4; ++m) _Pragma("unroll") for (int n = 0; n < 2; ++n) _Pragma("unroll") for (int k = 0; k < 2; ++k) \
        acc[ai][bj][m][n] = TA ? __builtin_amdgcn_mfma_f32_16x16x32_bf16(Bt[n][k], At[m][k], acc[ai][bj][m][n], 0, 0, 0) \
                               : __builtin_amdgcn_mfma_f32_16x16x32_bf16(At[m][k], Bt[n][k], acc[ai][bj][m][n], 0, 0, 0); __builtin_amdgcn_s_setprio(0); } while (0)
#define PG8_WAIT_V(n) asm volatile("s_waitcnt vmcnt(" #n ")" ::: "memory")
#define PG8_WAIT_L(n) asm volatile("s_waitcnt lgkmcnt(" #n ")" ::: "memory")
#define PG8_BAR __builtin_amdgcn_s_barrier()
#define PG8_SCHED __builtin_amdgcn_sched_barrier(0)
    Unit cur, nxt; int ui = 0;
    if (!S.next(0, cur)) return;
    if (GATHER) {
#pragma unroll
        for (int h = 0; h < 2; ++h)
#pragma unroll
            for (int i = 0; i < 2; ++i) voffA[h][i] = S.row_off(cur, h * HALF + RA[i]) + (unsigned)CA[i] * 2u;
    }
    f32x4 acc[2][2][4][2];
#pragma unroll
    for (int a = 0; a < 2; ++a)
#pragma unroll
        for (int b = 0; b < 2; ++b)
#pragma unroll
            for (int m = 0; m < 4; ++m)
#pragma unroll
                for (int n = 0; n < 2; ++n) acc[a][b][m][n] = (f32x4){0.f, 0.f, 0.f, 0.f};
    bf16x8 At[4][2], B0[2][2], B1[2][2];
    const char* cA = cur.A; const char* cB = cur.B;
    if constexpr (SP2) {
        PG8_STAGE(PG8_SB(0, 0), cB, voffB); PG8_STAGE(PG8_SB(0, 1), cB + hstep, voffB); PG8_STAGE_A(PG8_SA(0, 0), cA, 0); PG8_STAGE_A(PG8_SA(0, 1), cA, 1);
        if (wr == 1) PG8_BAR;
        PG8_WAIT_V(2); PG8_BAR;
        PG8_STAGE(PG8_SB(1, 0), cB + kstep, voffB); PG8_STAGE_A(PG8_SA(1, 0), cA + kstep, 0); PG8_STAGE(PG8_SB(1, 1), cB + hstep + kstep, voffB);
        PG8_WAIT_V(6); PG8_BAR;
    } else {
    PG8_STAGE(PG8_SB(0, 0), cB, voffB); PG8_STAGE_A(PG8_SA(0, 0), cA, 0); PG8_STAGE(PG8_SB(0, 1), cB + hstep, voffB); PG8_STAGE_A(PG8_SA(0, 1), cA, 1);
    if (wr == 1) PG8_BAR;
    PG8_WAIT_V(4); PG8_BAR;
    PG8_STAGE(PG8_SB(1, 0), cB + kstep, voffB); PG8_STAGE_A(PG8_SA(1, 0), cA + kstep, 0); PG8_STAGE(PG8_SB(1, 1), cB + hstep + kstep, voffB);
    PG8_WAIT_V(6); PG8_BAR;
    }
    for (;;) {
        const bool has_next = S.next(ui + 1, nxt);
        const char* nA = has_next ? nxt.A : cA; const char* nB = has_next ? nxt.B : cB;
        for (int t = 0; t < nt; t += 2) {
            const bool last = (t == nt - 2);
            const char* a1 = cA + (size_t)(t + 1) * kstep;
            const char* a2 = last ? nA : cA + (size_t)(t + 2) * kstep; const char* b2 = last ? nB : cB + (size_t)(t + 2) * kstep;
            const char* a3 = a2 + kstep; const char* b3 = b2 + kstep;
            if constexpr (SP2) {
            PG8_LDB(B0, 0, 0); PG8_LDB(B1, 0, 1); PG8_SCHED; PG8_LDA(At, 0, 0); PG8_STAGE_A(PG8_SA(1, 1), a1, 1);
            PG8_WAIT_V(8); PG8_WAIT_L(0); PG8_BAR; PG8_MMA(0, 0, At, B0); PG8_MMA(0, 1, At, B1); PG8_BAR; PG8_SCHED;
            if (GATHER) { if (last && has_next) {
#pragma unroll
                for (int h = 0; h < 2; ++h)
#pragma unroll
                    for (int i = 0; i < 2; ++i) voffA[h][i] = S.row_off(nxt, h * HALF + RA[i]) + (unsigned)CA[i] * 2u;
            } }
            PG8_LDA(At, 0, 1); PG8_STAGE(PG8_SB(0, 0), b2, voffB); PG8_STAGE(PG8_SB(0, 1), b2 + hstep, voffB); PG8_STAGE_A(PG8_SA(0, 0), a2, 0);
            PG8_WAIT_V(8); PG8_WAIT_L(0); PG8_BAR; PG8_MMA(1, 0, At, B0); PG8_MMA(1, 1, At, B1); PG8_BAR; PG8_SCHED;
            PG8_LDB(B0, 1, 0); PG8_LDB(B1, 1, 1); PG8_SCHED; PG8_LDA(At, 1, 0); PG8_STAGE_A(PG8_SA(0, 1), a2, 1);
            PG8_WAIT_V(8); PG8_WAIT_L(0); PG8_BAR; PG8_MMA(0, 0, At, B0); PG8_MMA(0, 1, At, B1); PG8_BAR; PG8_SCHED;
            PG8_LDA(At, 1, 1); PG8_STAGE(PG8_SB(1, 0), b3, voffB); PG8_STAGE(PG8_SB(1, 1), b3 + hstep, voffB); PG8_STAGE_A(PG8_SA(1, 0), a3, 0);
            PG8_WAIT_V(8); PG8_WAIT_L(0); PG8_BAR; PG8_MMA(1, 0, At, B0); PG8_MMA(1, 1, At, B1); PG8_BAR; PG8_SCHED;
            } else {
            PG8_LDB(B0, 0, 0); PG8_SCHED; PG8_LDA(At, 0, 0); PG8_STAGE_A(PG8_SA(1, 1), a1, 1);
            PG8_WAIT_L(8); PG8_BAR; PG8_WAIT_L(0); PG8_MMA(0, 0, At, B0); PG8_BAR; PG8_SCHED;
            if (GATHER) { if (last && has_next) {
#pragma unroll
                for (int h = 0; h < 2; ++h)
#pragma unroll
                    for (int i = 0; i < 2; ++i) voffA[h][i] = S.row_off(nxt, h * HALF + RA[i]) + (unsigned)CA[i] * 2u;
            } }
            PG8_LDB(B1, 0, 1); PG8_STAGE(PG8_SB(0, 0), b2, voffB);
            PG8_BAR; PG8_WAIT_L(0); PG8_MMA(0, 1, At, B1); PG8_BAR;
            PG8_LDA(At, 0, 1); PG8_STAGE_A(PG8_SA(0, 0), a2, 0);
            PG8_BAR; PG8_WAIT_L(0); PG8_MMA(1, 0, At, B0); PG8_BAR; PG8_SCHED;
            PG8_STAGE(PG8_SB(0, 1), b2 + hstep, voffB);
            PG8_WAIT_V(6); PG8_BAR; PG8_MMA(1, 1, At, B1); PG8_BAR;
            PG8_LDB(B0, 1, 0); PG8_SCHED; PG8_LDA(At, 1, 0); PG8_STAGE_A(PG8_SA(0, 1), a2, 1);
            PG8_WAIT_L(8); PG8_BAR; PG8_WAIT_L(0); PG8_MMA(0, 0, At, B0); PG8_BAR; PG8_SCHED;
            PG8_LDB(B1, 1, 1); PG8_STAGE(PG8_SB(1, 0), b3, voffB);
            PG8_BAR; PG8_WAIT_L(0); PG8_MMA(0, 1, At, B1); PG8_BAR;
            PG8_LDA(At, 1, 1); PG8_STAGE_A(PG8_SA(1, 0), a3, 0);
            PG8_BAR; PG8_WAIT_L(0); PG8_MMA(1, 0, At, B0); PG8_BAR; PG8_SCHED;
            PG8_STAGE(PG8_SB(1, 1), b3 + hstep, voffB);
            PG8_WAIT_V(6); PG8_BAR; PG8_MMA(1, 1, At, B1); PG8_BAR;
                    }
        }
        if constexpr (ALIGN_EPI) { if (wr == 0) PG8_BAR; }
        E(acc, cur, wr, wc, fr, fq);
        if (!has_next) break;
#pragma unroll
        for (int a = 0; a < 2; ++a)
#pragma unroll
            for (int b = 0; b < 2; ++b)
#pragma unroll
                for (int m = 0; m < 4; ++m)
#pragma unroll
                    for (int n = 0; n < 2; ++n) acc[a][b][m][n] = (f32x4){0.f, 0.f, 0.f, 0.f};
        cur = nxt; cA = nA; cB = nB; ++ui;
        if constexpr (ALIGN_EPI) { if (wr == 1) PG8_BAR; }
    }
    PG8_WAIT_V(0);
    if constexpr (!ALIGN_EPI) { if (wr == 0) PG8_BAR; }
    PG8_BAR;
#undef PG8_SA
#undef PG8_SB
#undef PG8_STAGE
#undef PG8_STAGE_A
#undef PG8_LDA
#undef PG8_LDB
#undef PG8_MMA
#undef PG8_WAIT_V
#undef PG8_WAIT_L
#undef PG8_BAR
#undef PG8_SCHED
}
}

namespace pg8 {
struct EpiHyT {
    static constexpr bool TA = false, PERM = false;
    bf16* PT; const float* bias; LAS unsigned char* scr;
    __device__ __forceinline__ void operator()(const f32x4 (&acc)[2][2][4][2], const Unit& u, int wr, int wc, int fr, int fq) const {
        const int lane = fq * 16 + fr, lc = lane >> 3, lp = lane & 7;
        LAS unsigned char* s = scr + (wr * 4 + wc) * 2304;
        LAS unsigned char* wp = s + fr * 144 + 8 * fq;
        const LAS unsigned char* rp = s + lc * 144 + 16 * lp;
#pragma unroll
        for (int bj = 0; bj < 2; ++bj)
#pragma unroll
            for (int n = 0; n < 2; ++n) {
                const int col0 = u.pn * BM + bj * HALF + wc * 32 + n * 16; const float bv = bias[col0 + fr];
                bf16* gp = PT + (size_t)(col0 + lc) * MTOK + u.pm * BM + wr * 64 + 8 * lp;
#pragma unroll
                for (int ai = 0; ai < 2; ++ai) {
#pragma unroll
                    for (int m = 0; m < 4; ++m) { const f32x4 v = acc[ai][bj][m][n] + bv; u32x2 w; w.x = cvt_pk_bf16(v[0], v[1]); w.y = cvt_pk_bf16(v[2], v[3]);
                        *(LAS u32x2*)(wp + 32 * m) = w; }
                    const u32x4 r0 = *(const LAS u32x4*)rp, r1 = *(const LAS u32x4*)(rp + 8 * 144);
                    *(u32x4*)(gp + ai * HALF) = r0; *(u32x4*)(gp + ai * HALF + (size_t)8 * MTOK) = r1; }
            }
    }
};
struct EpiZXD {
    static constexpr bool TA = true, PERM = true;
    unsigned char* Z8; bf16* XBC; float* DT; const float* b_in; bf16* HALO;
    __device__ __forceinline__ void operator()(const f32x4 (&acc)[2][2][4][2], const Unit& u, int wr, int wc, int fr, int fq) const {
        const int row0 = u.pm * BM + wr * 64 + fr;
        if (u.pn == 24) {
            if (wc < 2) {
                const int c0 = wc * 32 + 8 * fq;
#pragma unroll
                for (int n = 0; n < 2; ++n) { const f32x4 bv = *(const f32x4*)(b_in + 9216 + c0 + 4 * n);
#pragma unroll
                    for (int ai = 0; ai < 2; ++ai)
#pragma unroll
                        for (int m = 0; m < 4; ++m) *(f32x4*)(DT + (size_t)(row0 + ai * HALF + m * 16) * 64 + c0 + 4 * n) = acc[ai][0][m][n] + bv; }
            }
            return;
        }
        if (u.pn < 8) {
            const int col0z = u.pn * BM + wc * 32 + 8 * fq;
#pragma unroll
            for (int bj = 0; bj < 2; ++bj) { const f32x4 b0 = *(const f32x4*)(b_in + 3072 + col0z + bj * HALF), b1 = *(const f32x4*)(b_in + 3072 + col0z + bj * HALF + 4);
#pragma unroll
                for (int ai = 0; ai < 2; ++ai)
#pragma unroll
                    for (int m = 0; m < 4; ++m) { const f32x4 v0 = acc[ai][bj][m][0] + b0, v1 = acc[ai][bj][m][1] + b1;
                        int w0 = __builtin_amdgcn_cvt_pk_fp8_f32(v0[0], v0[1], 0, false); w0 = __builtin_amdgcn_cvt_pk_fp8_f32(v0[2], v0[3], w0, true);
                        int w1 = __builtin_amdgcn_cvt_pk_fp8_f32(v1[0], v1[1], 0, false); w1 = __builtin_amdgcn_cvt_pk_fp8_f32(v1[2], v1[3], w1, true);
                        u32x2 w; w.x = (unsigned)w0; w.y = (unsigned)w1;
                        *(u32x2*)(Z8 + (size_t)(row0 + ai * HALF + m * 16) * DSSM + col0z + bj * HALF) = w; } }
            return;
        }
        bf16* base = XBC; const int ldc = CONVD, colt = (u.pn - 8) * BM, bcol = 5120 + colt;
        const int col0 = colt + wc * 32 + 8 * fq, bcol0 = bcol + wc * 32 + 8 * fq;
        f32x4 bv[2][2];
#pragma unroll
        for (int bj = 0; bj < 2; ++bj)
#pragma unroll
            for (int n = 0; n < 2; ++n) bv[bj][n] = *(const f32x4*)(b_in + bcol0 + bj * HALF + 4 * n);
#pragma unroll
        for (int ai = 0; ai < 2; ++ai)
#pragma unroll
            for (int m = 0; m < 4; ++m) { bf16* rowp = base + (size_t)(row0 + ai * HALF + m * 16) * ldc + col0;
#pragma unroll
                for (int bj = 0; bj < 2; ++bj) { const f32x4 v0 = acc[ai][bj][m][0] + bv[bj][0], v1 = acc[ai][bj][m][1] + bv[bj][1];
                    u32x4 w; w.x = cvt_pk_bf16(v0[0], v0[1]); w.y = cvt_pk_bf16(v0[2], v0[3]); w.z = cvt_pk_bf16(v1[0], v1[1]); w.w = cvt_pk_bf16(v1[2], v1[3]);
                    *(u32x4*)(rowp + bj * HALF) = w;
                    if ((m == 3 && fr >= 14) || (m == 0 && fr < 2)) {
                        const int row = row0 + ai * HALF + m * 16, bb = row >> 11, t = row & 2047, tm = t & 63;
                        const int jb = (tm >= 62) ? (t >> 6) + 1 : (t >> 6), idx = (tm >= 62) ? tm - 62 : 2 + tm;
                        *(u32x4*)(HALO + ((size_t)(bb * 33 + jb) * 4 + idx) * CONVD + col0 + bj * HALF) = w; } } }
    }
};
template <int MODE> struct EpiBf {
    static constexpr bool TA = true, PERM = true;
    bf16* O; int ldc; const float* bias; const bf16* G1; int ldg; const bf16* P;
    __device__ __forceinline__ void operator()(const f32x4 (&acc)[2][2][4][2], const Unit& u, int wr, int wc, int fr, int fq) const {
        const int row0 = u.pm * BM + wr * 64 + fr, col0 = u.pn * BM + wc * 32 + 8 * fq;
#pragma unroll
        for (int ai = 0; ai < 2; ++ai)
#pragma unroll
            for (int m = 0; m < 4; ++m) { const size_t r = (size_t)(row0 + ai * HALF + m * 16);
#pragma unroll
                for (int bj = 0; bj < 2; ++bj) { f32x4 v0 = acc[ai][bj][m][0], v1 = acc[ai][bj][m][1]; const int c = col0 + bj * HALF;
                    if (MODE == 0) { const f32x4 b0 = *(const f32x4*)(bias + c), b1 = *(const f32x4*)(bias + c + 4); v0 = v0 + b0; v1 = v1 + b1;
#pragma unroll
                        for (int j = 0; j < 4; ++j) { v0[j] = sigmoidf_(v0[j]); v1[j] = sigmoidf_(v1[j]); } }
                    else { const u32x4 g = *(const u32x4*)(G1 + r * ldg + c);
                        v0[0] *= bflo(g.x); v0[1] *= bfhi(g.x); v0[2] *= bflo(g.y); v0[3] *= bfhi(g.y); v1[0] *= bflo(g.z); v1[1] *= bfhi(g.z); v1[2] *= bflo(g.w); v1[3] *= bfhi(g.w);
                        if (MODE == 2) { const u32x4 p = *(const u32x4*)(P + r * ldc + c);
                            v0[0] += bflo(p.x); v0[1] += bfhi(p.x); v0[2] += bflo(p.y); v0[3] += bfhi(p.y); v1[0] += bflo(p.z); v1[1] += bfhi(p.z); v1[2] += bflo(p.w); v1[3] += bfhi(p.w); } }
                    u32x4 w; w.x = cvt_pk_bf16(v0[0], v0[1]); w.y = cvt_pk_bf16(v0[2], v0[3]); w.z = cvt_pk_bf16(v1[0], v1[1]); w.w = cvt_pk_bf16(v1[2], v1[3]);
                    *(u32x4*)(O + r * ldc + c) = w; } }
    }
};
struct EpiRes {
    static constexpr bool TA = true, PERM = true;
    bf16* O; const float* bias; const bf16* X; float alpha;
    __device__ __forceinline__ void operator()(const f32x4 (&acc)[2][2][4][2], const Unit& u, int wr, int wc, int fr, int fq) const {
        const int row0 = u.pm * BM + wr * 64 + fr, col0 = u.pn * BM + wc * 32 + 8 * fq;
#pragma unroll
        for (int ai = 0; ai < 2; ++ai)
#pragma unroll
            for (int m = 0; m < 4; ++m) { const size_t off = (size_t)(row0 + ai * HALF + m * 16) * DM + col0;
#pragma unroll
                for (int bj = 0; bj < 2; ++bj) { const u32x4 xv = *(const u32x4*)(X + off + bj * HALF); const f32x4 b0 = *(const f32x4*)(bias + col0 + bj * HALF), b1 = *(const f32x4*)(bias + col0 + bj * HALF + 4);
                    f32x4 v0 = acc[ai][bj][m][0] + b0, v1 = acc[ai][bj][m][1] + b1;
                    v0[0] += alpha * bflo(xv.x); v0[1] += alpha * bfhi(xv.x); v0[2] += alpha * bflo(xv.y); v0[3] += alpha * bfhi(xv.y);
                    v1[0] += alpha * bflo(xv.z); v1[1] += alpha * bfhi(xv.z); v1[2] += alpha * bflo(xv.w); v1[3] += alpha * bfhi(xv.w);
                    u32x4 w; w.x = cvt_pk_bf16(v0[0], v0[1]); w.y = cvt_pk_bf16(v0[2], v0[3]); w.z = cvt_pk_bf16(v1[0], v1[1]); w.w = cvt_pk_bf16(v1[2], v1[3]);
                    *(u32x4*)(O + off + bj * HALF) = w; } }
    }
};
struct EpiSwiGLU {
    static constexpr bool TA = true, PERM = true;
    bf16* HID;
    __device__ __forceinline__ void operator()(const f32x4 (&acc)[2][2][4][2], const Unit& u, int wr, int wc, int fr, int fq) const {
        const int row0 = u.pm * BM + wr * 64 + fr, col0 = u.pn * HALF + wc * 32 + 8 * fq;
#pragma unroll
        for (int ai = 0; ai < 2; ++ai)
#pragma unroll
            for (int m = 0; m < 4; ++m) { f32x4 v0, v1;
#pragma unroll
                for (int j = 0; j < 4; ++j) { v0[j] = siluf_(acc[ai][0][m][0][j]) * acc[ai][1][m][0][j]; v1[j] = siluf_(acc[ai][0][m][1][j]) * acc[ai][1][m][1][j]; }
                u32x4 w; w.x = cvt_pk_bf16(v0[0], v0[1]); w.y = cvt_pk_bf16(v0[2], v0[3]); w.z = cvt_pk_bf16(v1[0], v1[1]); w.w = cvt_pk_bf16(v1[2], v1[3]);
                *(u32x4*)(HID + (size_t)(row0 + ai * HALF + m * 16) * DEXP + col0) = w; }
    }
};
struct EpiScatter {
    static constexpr bool TA = false, PERM = false;
    float* ACC; const int* tok; const float* wgt; int j0_unused;
    __device__ __forceinline__ void operator()(const f32x4 (&acc)[2][2][4][2], const Unit& u, int wr, int wc, int fr, int fq) const {
        asm volatile("" : "+v"(fr), "+v"(fq));
        const int jt = u.pn >> 2, ct = u.pn & 3;
#pragma unroll
        for (int ai = 0; ai < 2; ++ai)
#pragma unroll
            for (int m = 0; m < 4; ++m)
#pragma unroll
                for (int j = 0; j < 4; ++j) { const int r = ai * HALF + wr * 64 + m * 16 + 4 * fq + j;
                    if (r < u.cnt) { int token; float w;
                        if (u.e == NE) { token = jt * BM + r; w = 1.0f; } else { const size_t li = (size_t)u.e * MTOK + (size_t)jt * BM + r; token = tok[li]; w = wgt[li]; }
                        float* rowp = ACC + (size_t)token * DM + ct * BM + wc * 32 + fr;
#pragma unroll
                        for (int bj = 0; bj < 2; ++bj)
#pragma unroll
                            for (int n = 0; n < 2; ++n) unsafeAtomicAdd(rowp + bj * HALF + n * 16, w * acc[ai][bj][m][n][j]);
                    }
                    asm volatile("" ::: "memory"); }
    }
};

struct EpiSlot8 {
    static constexpr bool TA = true, PERM = true;
    unsigned char* YQ;
    __device__ __forceinline__ void operator()(const f32x4 (&acc)[2][2][4][2], const Unit& u, int wr, int wc, int fr, int fq) const {
        asm volatile("" : "+v"(fr), "+v"(fq));
        const int row0 = u.pm * BM + wr * 64 + fr, col0 = u.pn * 256 + wc * 32 + 8 * fq;
#pragma unroll
        for (int ai = 0; ai < 2; ++ai)
#pragma unroll
            for (int m = 0; m < 4; ++m) { unsigned char* rowp = YQ + (size_t)(row0 + ai * HALF + m * 16) * 1024 + col0;
#pragma unroll
                for (int bj = 0; bj < 2; ++bj) { const f32x4 v0 = acc[ai][bj][m][0], v1 = acc[ai][bj][m][1];
                    int w0 = __builtin_amdgcn_cvt_pk_fp8_f32(v0[0], v0[1], 0, false); w0 = __builtin_amdgcn_cvt_pk_fp8_f32(v0[2], v0[3], w0, true);
                    int w1 = __builtin_amdgcn_cvt_pk_fp8_f32(v1[0], v1[1], 0, false); w1 = __builtin_amdgcn_cvt_pk_fp8_f32(v1[2], v1[3], w1, true);
                    u32x2 w; w.x = (unsigned)w0; w.y = (unsigned)w1; *(u32x2*)(rowp + bj * HALF) = w; } }
    }
};
struct SlotOrder4 {
    const LAS int* tp; const LAS int* te; int G, c, total; const char* A; const char* W;
    __device__ __forceinline__ bool next(int i, Unit& u) const {
        int tile, q;
        if (G == 256) { const int cx = c & 7, cj = c >> 3; q = cj & 3; tile = i * 64 + (cj >> 2) * 8 + cx; }
        else { const long L = (long)i * G + c; tile = (int)(L >> 2); q = (int)(L & 3); }
        if (tile >= total) return false;
        const int e = te[tile];
        u.e = e; u.cnt = 0; u.pm = tile; u.pn = q; u.A = A + (size_t)tile * BM * DEXP * 2; u.B = W + ((size_t)e * DM + (size_t)q * 256) * DEXP * 2;
        return true;
    }
    __device__ __forceinline__ unsigned row_off(const Unit&, int) const { return 0u; }
};
template <int NCT, bool FIRST> struct MoeOrder {
    const LAS int* tp; const LAS int* cnt; const LAS int* te; int G, c, total;
    const char* A; const char* W; const int* tok;
    __device__ __forceinline__ bool next(int i, Unit& u) const {
        const long L = (long)i * G + c; if (L >= (long)total * NCT) return false;
        const int tile = (int)(L / NCT), ct = (int)(L % NCT);
        const int e = te[tile];
        const int jt = tile - tp[e];
        u.e = e; const int left = cnt[e] - jt * BM; u.cnt = left < BM ? left : BM;
        if (FIRST) { u.pm = tile; u.pn = ct; u.A = A; u.B = W + ((size_t)e * 512 + (size_t)ct * 256) * DM * 2; }
        else { u.pm = tile; u.pn = jt * 4 + ct; u.A = A + (size_t)tile * BM * DEXP * 2; u.B = W + ((size_t)e * DM + (size_t)ct * 256) * DEXP * 2; }
        return true;
    }
    __device__ __forceinline__ unsigned row_off(const Unit& u, int r) const {
        const int jt = u.pm - tp[u.e]; int token;
        if (u.e == NE) token = jt * BM + r; else token = (r < u.cnt) ? tok[(size_t)u.e * MTOK + (size_t)jt * BM + r] : 0;
        return (unsigned)token * (unsigned)(H1B_PITCH * 2);
    }
};
}

#define XB_TMO      128
#define XB_XCNT(j)  (256  + 64 * (j))
#define XB_XSUB(j)  (1280 + 64 * (j))
#define XB_XGEN(j)  (2304 + 64 * (j))
#define XB_TOP      3328
#define XB_TOPGEN   3392
#define XCD_BAR_WORDS 3456
#define XB_SPIN_CAP (1u << 18)
__device__ __forceinline__ unsigned xb_ld(unsigned* p)              { return __hip_atomic_load(p, __ATOMIC_RELAXED, __HIP_MEMORY_SCOPE_AGENT); }
__device__ __forceinline__ unsigned xb_add(unsigned* p, unsigned v) { return __hip_atomic_fetch_add(p, v, __ATOMIC_RELAXED, __HIP_MEMORY_SCOPE_AGENT); }
__device__ __forceinline__ unsigned xb_xcc_id() { return (unsigned)__builtin_amdgcn_s_getreg((3 << 11) | 20) & 0xFu; }
#define XB_SPIN(cond, bar) do { unsigned _sp = 0; while (cond) { __builtin_amdgcn_s_sleep(1); \
    if ((++_sp & 255u) == 0u) { if (xb_ld(&(bar)[XB_TMO])) break; if (_sp > XB_SPIN_CAP) { atomicAdd(&(bar)[XB_TMO], 1u); break; } } } } while (0)
struct XcdBarrier { unsigned* bar; unsigned x; volatile LAS unsigned* st; };
__device__ __forceinline__ XcdBarrier xcd_barrier_post(unsigned* bar, volatile LAS unsigned* st) {
    XcdBarrier b; b.bar = bar; b.x = xb_xcc_id(); b.st = st;
    if (threadIdx.x == 0) (void)xb_add(&bar[XB_XCNT(b.x)], 1u);
    return b;
}
__device__ __forceinline__ void xcd_barrier_complete(unsigned* bar, unsigned x, unsigned& nloc, unsigned& nx) {
    const unsigned G = gridDim.x * gridDim.y * gridDim.z;
    unsigned sum, cnt, mine, sp = 0u;
    for (;;) {
        sum = 0u; cnt = 0u; mine = 0u;
#pragma unroll
        for (unsigned j = 0; j < 16; ++j) { const unsigned c = xb_ld(&bar[XB_XCNT(j)]); sum += c; cnt += (c > 0u) ? 1u : 0u; mine = (j == x) ? c : mine; }
        if (sum == G) break;
        __builtin_amdgcn_s_sleep(1);
        if ((++sp & 255u) == 0u) { if (xb_ld(&bar[XB_TMO])) break; if (sp > XB_SPIN_CAP) { atomicAdd(&bar[XB_TMO], 1u); break; } }
    }
    nloc = mine > 0u ? mine : 1u; nx = cnt > 0u ? cnt : 1u;
}
__device__ __forceinline__ void xcd_barrier(const XcdBarrier& b) {
    asm volatile("s_waitcnt vmcnt(0)" ::: "memory");
    __syncthreads();
    if (threadIdx.x == 0) {
        unsigned* bar = b.bar;
        __builtin_amdgcn_s_waitcnt(0);
        unsigned nloc = b.st[0], nx = b.st[1];
        if (nloc == 0u) { xcd_barrier_complete(bar, b.x, nloc, nx); b.st[0] = nloc; b.st[1] = nx; }
        const unsigned old = xb_add(&bar[XB_XSUB(b.x)], 1u);
        const unsigned gen = old / nloc;
        if (old + 1u == (gen + 1u) * nloc) {
            __builtin_amdgcn_fence(__ATOMIC_RELEASE, "agent");
            asm volatile("s_waitcnt vmcnt(0)" ::: "memory");
            const unsigned og = xb_add(&bar[XB_TOP], 1u);
            const unsigned tg = og / nx;
            if (og + 1u == (tg + 1u) * nx) xb_add(&bar[XB_TOPGEN], 1u);
            else XB_SPIN(xb_ld(&bar[XB_TOPGEN]) == tg, bar);
            __builtin_amdgcn_fence(__ATOMIC_ACQUIRE, "agent");
            xb_add(&bar[XB_XGEN(b.x)], 1u);
            asm volatile("s_waitcnt vmcnt(0)" ::: "memory");
        } else {
            XB_SPIN(xb_ld(&bar[XB_XGEN(b.x)]) == gen, bar);
            __builtin_amdgcn_fence(__ATOMIC_ACQUIRE, "agent");
            asm volatile("s_waitcnt vmcnt(0)" ::: "memory");
        }
    }
    __syncthreads();
}

struct Args {
    const float* in[38]; float* out; unsigned char* ws; int ph_lo, ph_hi, li, pad;
};
enum { I_X = 0, I_WIN, I_BIN, I_HCW, I_HCB, I_FW1, I_FB1, I_FF1, I_FW2, I_FB2, I_FF2, I_FW3, I_FB3, I_FF3, I_FW4, I_HBIAS,
       I_SCW, I_SCB, I_DTB, I_ALOG, I_SD, I_SNW, I_WHYB, I_WSSDB, I_WOUT, I_BOUT, I_LN1G, I_LN1B, I_RW, I_RB, I_EWG, I_EWU, I_EWD, I_SWG, I_SWU, I_SWD, I_LN2G, I_LN2B };
struct Frame {
    LAS unsigned char* lds; volatile LAS unsigned* MISC; gu32* ctl; unsigned char* ws;
    int tid, lane, wave, vcu, G;
    const float* const* in; float* out;
};

__device__ __forceinline__ void tr_item(const float* src, int ld_src, int k0, int c0, bf16* dst, int drow0, int ldd, LAS float* scr, int lane) {
    f32x4 ld[8];
#pragma unroll
    for (int i = 0; i < 8; ++i) ld[i] = *(const f32x4*)(src + (size_t)(k0 + 8 * i + (lane >> 3)) * ld_src + c0 + 4 * (lane & 7));
#pragma unroll
    for (int i = 0; i < 8; ++i) { LAS float* d = scr + (8 * i + (lane >> 3)) * 33 + 4 * (lane & 7); d[0] = ld[i][0]; d[1] = ld[i][1]; d[2] = ld[i][2]; d[3] = ld[i][3]; }
    LDS_WAIT(); asm volatile("" ::: "memory");
    const int c = lane & 7;
#pragma unroll
    for (int j = 0; j < 4; ++j) { const int n = (lane >> 3) + 8 * j; const LAS float* s = scr + (8 * c) * 33 + n;
        u32x4 o; o.x = pk2(s[0 * 33], s[1 * 33]); o.y = pk2(s[2 * 33], s[3 * 33]); o.z = pk2(s[4 * 33], s[5 * 33]); o.w = pk2(s[6 * 33], s[7 * 33]);
        *(u32x4*)(dst + (size_t)(drow0 + n) * ldd + k0 + 8 * c) = o; }
    LDS_WAIT(); asm volatile("" ::: "memory");
}
__device__ __forceinline__ void tr_matrix_item(const float* src, int ld_src, int K, int col_first, int ncols, bf16* dst, int drow_first, LAS float* scr, int it, int lane) {
    const int nblk = ncols / 32, kb = it / nblk, nb = it % nblk;
    tr_item(src, ld_src, kb * 64, col_first + nb * 32, dst, drow_first + nb * 32, K, scr, lane);
}
__device__ __forceinline__ void convert_x(Frame& F, const float* x, bf16* xb) {
    const size_t n8 = (size_t)MTOK * DM / 8; const size_t stride = (size_t)F.G * NTHR;
    for (size_t i = (size_t)F.vcu * NTHR + F.tid; i < n8; i += 4 * stride) {
        f32x4 a[4], b[4];
#pragma unroll
        for (int u = 0; u < 4; ++u) { const size_t k = (i + u * stride < n8) ? i + u * stride : i; a[u] = *(const f32x4*)(x + k * 8); b[u] = *(const f32x4*)(x + k * 8 + 4); }
#pragma unroll
        for (int u = 0; u < 4; ++u) { u32x4 o; o.x = pk2(a[u][0], a[u][1]); o.y = pk2(a[u][2], a[u][3]); o.z = pk2(b[u][0], b[u][1]); o.w = pk2(b[u][2], b[u][3]);
            if (i + u * stride < n8) *(u32x4*)(xb + (i + u * stride) * 8) = o; } }
}

__device__ __forceinline__ void hyena_filter(Frame& F) {
    const float* w1 = F.in[I_FW1]; const float* b1 = F.in[I_FB1]; const float* f1 = F.in[I_FF1];
    const float* w2 = F.in[I_FW2]; const float* b2 = F.in[I_FB2]; const float* f2 = F.in[I_FF2];
    const float* w3 = F.in[I_FW3]; const float* b3 = F.in[I_FB3]; const float* f3 = F.in[I_FF3];
    const float* w4 = F.in[I_FW4];
    bf16* KERN = (bf16*)(F.ws + WS_KERN);
    LAS float* hbuf = (LAS float*)(F.lds);
    const int lane = F.lane, wave = F.wave;
    for (int pg = F.vcu; pg < SEQ / 8; pg += F.G) {
        const int t = 8 * pg + wave;
        const float tn = (float)t / (float)(SEQ - 1), wv = 6.283185307179586f * (float)t / (float)SEQ;
        float zf = 0.f;
        if (lane == 0) zf = tn;
        else if (lane <= 16) { const float f = 1e-4f + (float)(lane - 1) * ((15.0f - 1e-4f) / 15.0f); zf = cosf(f * wv); }
        else if (lane <= 32) { const float f = 1e-4f + (float)(lane - 17) * ((15.0f - 1e-4f) / 15.0f); zf = -sinf(f * wv); }
        float s = b1[lane];
        for (int i = 0; i < 33; ++i) s += __shfl(zf, i) * w1[i * 64 + lane];
        float h = sinf(f1[lane] * s);
        s = b2[lane];
        for (int i = 0; i < 64; ++i) s += __shfl(h, i) * w2[i * 64 + lane];
        h = sinf(f2[lane] * s);
        s = b3[lane];
        for (int i = 0; i < 64; ++i) s += __shfl(h, i) * w3[i * 64 + lane];
        h = sinf(f3[lane] * s);
        hbuf[wave * 64 + lane] = h;
        __syncthreads();
        { float a[8][8];
#pragma unroll
          for (int q = 0; q < 8; ++q)
#pragma unroll
              for (int p = 0; p < 8; ++p) a[q][p] = 0.f;
          float a0b[4] = {0.f, 0.f, 0.f, 0.f};
#pragma unroll 2
          for (int i = 0; i < 64; ++i) { float wv[8], hv[8];
#pragma unroll
              for (int q = 0; q < 8; ++q) wv[q] = w4[(size_t)i * 4096 + F.tid + 512 * q];
#pragma unroll
              for (int p = 0; p < 8; ++p) hv[p] = hbuf[p * 64 + i];
#pragma unroll
              for (int q = 0; q < 8; ++q)
#pragma unroll
                  for (int p = 0; p < 8; ++p) a[q][p] += hv[p] * wv[q];
              if (pg == 0) { a0b[0] += hv[0] * wv[2]; a0b[1] += hv[0] * wv[3]; a0b[2] += hv[0] * wv[6]; a0b[3] += hv[0] * wv[7]; } }
#pragma unroll
          for (int q = 0; q < 8; ++q) { const int col = F.tid + 512 * q, c = col & 1023, dir = (q >> 1) & 1, o = q >> 2;
              const float adel = 3.0701134573253945f + (float)c * ((15.350567286626973f - 3.0701134573253945f) / 1023.0f);
              bf16* kc = KERN + ((size_t)c * 2 + o) * 4096;
#pragma unroll
              for (int p = 0; p < 8; ++p) { const int tp = 8 * pg + p; const float v = a[q][p] * __expf(-((float)tp / (float)(SEQ - 1)) * adel);
                  if (tp == 0) { if (dir == 0) { kc[2048] = (bf16)f2bf(v + a0b[(q & 1) + 2 * o]); kc[0] = 0; } }
                  else kc[dir == 0 ? 2048 - tp : 2048 + tp] = (bf16)f2bf(v); } } }
        __syncthreads();
    }
}

__device__ __forceinline__ void p0_prologue(Frame& F) {
    LAS float* scr = (LAS float*)(F.lds + 4096 + F.wave * 16384);
    const int gw = F.vcu * NWAVES + F.wave, NGW = F.G * NWAVES;
    const bool late_filter = (blockIdx.x & 1);
    bf16* WINT = (bf16*)(F.ws + WS_WINT);
    constexpr int I_A = 16 * (9216 / 32), I_B = 16 * (64 / 32), I_C = 16 * (2048 / 32);
    constexpr int I_HY = 16 * 32, I_SS = 32 * 32, I_OUT = 16 * 32;
    constexpr int NITEMS = I_A + I_B + I_C + I_HY + I_SS + I_OUT;
#pragma unroll 1
    for (int s_ = 0; s_ < 2; ++s_) {
    if ((s_ == 1) == late_filter) { hyena_filter(F); continue; }
    for (int it = gw; it < NITEMS; it += NGW) {
        int r = it;
        if (r < I_A) { tr_matrix_item(F.in[I_WIN], INC, DM, 0, 9216, WINT, 0, scr, r, F.lane); continue; } r -= I_A;
        if (r < I_B) { tr_matrix_item(F.in[I_WIN], INC, DM, 9216, 64, WINT, 9216, scr, r, F.lane); continue; } r -= I_B;
        if (r < I_C) { tr_matrix_item(F.in[I_WIN], INC, DM, 9280, 2048, (bf16*)(F.ws + WS_WING), 0, scr, r, F.lane); continue; } r -= I_C;
        if (r < I_HY) { tr_matrix_item(F.in[I_WHYB], DM, DM, 0, DM, (bf16*)(F.ws + WS_WHYB), 0, scr, r, F.lane); continue; } r -= I_HY;
        if (r < I_SS) { tr_matrix_item(F.in[I_WSSDB], DM, DSSM, 0, DM, (bf16*)(F.ws + WS_WSSDB), 0, scr, r, F.lane); continue; } r -= I_SS;
        tr_matrix_item(F.in[I_WOUT], DM, DM, 0, DM, (bf16*)(F.ws + WS_WOUT), 0, scr, r, F.lane);
    }
    convert_x(F, F.in[I_X], (bf16*)((unsigned char*)F.out + OUT_XB));
    __syncthreads();
    }
}
__device__ __forceinline__ void p6_reconvert(Frame& F) {
    LAS float* scr = (LAS float*)(F.lds + 4096 + F.wave * 16384);
    const int gw = F.vcu * NWAVES + F.wave, NGW = F.G * NWAVES;
    for (int it = gw; it < 16 * (2048 / 32); it += NGW) tr_matrix_item(F.in[I_WIN], INC, DM, 9280, 2048, (bf16*)(F.ws + WS_WING), 0, scr, it, F.lane);
    convert_x(F, F.in[I_X], (bf16*)(F.ws + WS_XB2));
}
__device__ __forceinline__ void p10_expert_weights(Frame& F) {
    LAS float* scr = (LAS float*)(F.lds + 4096 + F.wave * 16384);
    const int gw = F.vcu * NWAVES + F.wave, NGW = F.G * NWAVES;
    bf16* EW1 = (bf16*)(F.ws + WS_EW1); bf16* EW2 = (bf16*)(F.ws + WS_EW2);
    constexpr int PER1 = 16 * 4;
    constexpr int N1 = NEX * 2 * 2 * PER1, PER2 = 4 * 32, N2 = NEX * PER2;
    for (int it = gw; it < N1 + N2; it += NGW) {
        if (it < N1) { const int e = it / (4 * PER1), r0 = it % (4 * PER1), mat = r0 / (2 * PER1), r1 = r0 % (2 * PER1), ct = r1 / PER1, r2 = r1 % PER1;
            const float* src = (e < NE) ? F.in[mat ? I_EWU : I_EWG] + (size_t)e * DM * DEXP : F.in[mat ? I_SWU : I_SWG];
            tr_matrix_item(src, DEXP, DM, 128 * ct, 128, EW1 + (size_t)e * 512 * DM, 256 * ct + 128 * mat, scr, r2, F.lane); }
        else { const int r = it - N1, e = r / PER2, r2 = r % PER2;
            const float* src = (e < NE) ? F.in[I_EWD] + (size_t)e * DEXP * DM : F.in[I_SWD];
            tr_matrix_item(src, DM, DEXP, 0, DM, EW2 + (size_t)e * DM * DEXP, 0, scr, r2, F.lane); }
    }
}
__device__ __forceinline__ void p3_transpose(Frame& F) {
    const bf16* YT = (const bf16*)(F.ws + WS_YTHY); bf16* Y = (bf16*)(F.ws + WS_YHY);
    LAS bf16* scr = (LAS bf16*)(F.lds + F.wave * 9216);
    const int gw = F.vcu * NWAVES + F.wave, NGW = F.G * NWAVES, lane = F.lane;
    for (int tile = gw; tile < 16 * 512; tile += NGW) {
        const int c0 = (tile & 15) * 64, t0 = (tile >> 4) * 64;
#pragma unroll
        for (int p = 0; p < 8; ++p) { const int c = p * 8 + (lane >> 3), ch = lane & 7;
            const u32x4 g = *(const u32x4*)(YT + (size_t)(c0 + c) * MTOK + t0 + ch * 8);
            LAS bf16* d = scr + (ch * 8) * 72 + (c ^ (ch << 3));
            d[0 * 72] = (bf16)(g.x & 0xffff); d[1 * 72] = (bf16)(g.x >> 16); d[2 * 72] = (bf16)(g.y & 0xffff); d[3 * 72] = (bf16)(g.y >> 16);
            d[4 * 72] = (bf16)(g.z & 0xffff); d[5 * 72] = (bf16)(g.z >> 16); d[6 * 72] = (bf16)(g.w & 0xffff); d[7 * 72] = (bf16)(g.w >> 16); }
        LDS_WAIT(); asm volatile("" ::: "memory");
#pragma unroll
        for (int p = 0; p < 8; ++p) { const int tk = p * 8 + (lane >> 3), ch = lane & 7;
            const u32x4 v = *(const LAS u32x4*)(scr + tk * 72 + ((ch ^ ((tk >> 3) & 7)) << 3));
            *(u32x4*)(Y + (size_t)(t0 + tk) * DM + c0 + ch * 8) = v; }
        LDS_WAIT(); asm volatile("" ::: "memory");
    }
}

constexpr int HY_LDU = 2064, HY_KCS = 4128, HY_U_BYTES = 16 * HY_LDU * 2, HY_KC_BYTES = 8 * HY_KCS * 2;

struct HyKRow { u32x4 cur, prv; };
__device__ __forceinline__ void hy_load_kern(HyKRow& r, const bf16* kern, int tid) {
    r.cur = *(const u32x4*)(kern + 8 * tid);
    r.prv = (u32x4){0u, 0u, 0u, 0u};
    if (tid > 0) r.prv = *(const u32x4*)(kern + 8 * tid - 8);
}
__device__ __forceinline__ void hy_store_kc(LAS bf16* KC, const HyKRow& r, int tid) {
    const unsigned E[9] = {r.prv.x, r.prv.y, r.prv.z, r.prv.w, r.cur.x, r.cur.y, r.cur.z, r.cur.w, 0u};
#pragma unroll
    for (int fl = 0; fl < 8; ++fl) { const int sft = 8 - fl, k = sft >> 1;
        u32x4 o;
        if (sft & 1) { o.x = __builtin_amdgcn_alignbit(E[k + 1], E[k], 16); o.y = __builtin_amdgcn_alignbit(E[k + 2], E[k + 1], 16);
                       o.z = __builtin_amdgcn_alignbit(E[k + 3], E[k + 2], 16); o.w = __builtin_amdgcn_alignbit(E[k + 4], E[k + 3], 16); }
        else { o.x = E[k]; o.y = E[k + 1]; o.z = E[k + 2]; o.w = E[k + 3]; }
        *(LAS u32x4*)(KC + fl * HY_KCS + 8 * tid) = o; }
}
__device__ __forceinline__ f32x4 hy_short4(const bf16* prow, int t0, float w0, float w1, float w2, float cb) {
    const u32x2 g = *(const u32x2*)(prow + t0);
    const float p0 = bflo(g.x), p1 = bfhi(g.x), p2 = bflo(g.y), p3 = bfhi(g.y);
    const float pm = (t0 > 0) ? bf2f(prow[t0 - 1]) : 0.f, pp = (t0 + 4 < SEQ) ? bf2f(prow[t0 + 4]) : 0.f;
    f32x4 r; r[0] = cb + w0 * pm + w1 * p0 + w2 * p1; r[1] = cb + w0 * p0 + w1 * p1 + w2 * p2; r[2] = cb + w0 * p1 + w1 * p2 + w2 * p3; r[3] = cb + w0 * p2 + w1 * p3 + w2 * pp;
    return r;
}
__device__ __forceinline__ f32x4 hy_conv4(const u32x2 g, float pm, float pp, float w0, float w1, float w2, float cb) {
    const float p0 = bflo(g.x), p1 = bfhi(g.x), p2 = bflo(g.y), p3 = bfhi(g.y);
    f32x4 r; r[0] = cb + w0 * pm + w1 * p0 + w2 * p1; r[1] = cb + w0 * p0 + w1 * p1 + w2 * p2; r[2] = cb + w0 * p1 + w1 * p2 + w2 * p3; r[3] = cb + w0 * p2 + w1 * p3 + w2 * pp;
    return r;
}
__device__ __forceinline__ void hyena_phase(Frame& F) {
    LAS bf16* U = (LAS bf16*)(F.lds); LAS bf16* KC = (LAS bf16*)(F.lds + HY_U_BYTES);
    const bf16* PT = (const bf16*)(F.ws + WS_PTHY); const bf16* KERN = (const bf16*)(F.ws + WS_KERN); bf16* YT = (bf16*)(F.ws + WS_YTHY);
    const float* cw = F.in[I_HCW]; const float* cbv = F.in[I_HCB]; const float* hb = F.in[I_HBIAS];
    const int tid = F.tid, lane = F.lane, w = F.wave, fr = lane & 15, fq = lane >> 4;
    u32x4 um[8]; unsigned ee[8]; HyKRow kr;
    auto load_v = [&](int c) { int tl = tid; asm volatile("" : "+v"(tl));
        const bf16* prow = PT + (size_t)(2048 + c) * MTOK + (size_t)(tl >> 8) * SEQ + (tl & 255) * 8;
#pragma unroll
        for (int it = 0; it < 8; ++it) { um[it] = *(const u32x4*)(prow + (size_t)(2 * it) * SEQ); ee[it] = 0u; }
        if (lane == 0 || lane == 63) {
#pragma unroll
            for (int it = 0; it < 8; ++it) { const int t8 = (tl & 255) * 8; const bf16* pr = prow + (size_t)(2 * it) * SEQ - t8;
                if (lane == 0) { if (t8 > 0) ee[it] = pr[t8 - 1]; } else { if (t8 + 8 < SEQ) ee[it] = pr[t8 + 8]; } } } };
    if (F.vcu < DM) { hy_load_kern(kr, KERN + ((size_t)F.vcu * 2 + 0) * 4096, tid); load_v(F.vcu); }
    for (int c = F.vcu; c < DM; c += F.G) {
        const bool has_next = (c + F.G < DM);
        hy_store_kc(KC, kr, tid);
        { const int vc = 2048 + c; const float w0 = cw[0 * HYC + vc], w1 = cw[1 * HYC + vc], w2 = cw[2 * HYC + vc], cb = cbv[vc];
#pragma unroll
          for (int it = 0; it < 8; ++it) { const int idx = tid + 512 * it, b = idx >> 8, t8 = (idx & 255) * 8;
              const unsigned up = __shfl_up(um[it].w >> 16, 1), dn = __shfl_down(um[it].x & 0xffffu, 1);
              const float pm = bf2f(lane == 0 ? ee[it] : up), pp = bf2f(lane == 63 ? ee[it] : dn);
              u32x2 g0; g0.x = um[it].x; g0.y = um[it].y; u32x2 g1v; g1v.x = um[it].z; g1v.y = um[it].w;
              const f32x4 lo = hy_conv4(g0, pm, bflo(um[it].z), w0, w1, w2, cb), hi = hy_conv4(g1v, bfhi(um[it].y), pp, w0, w1, w2, cb);
              u32x4 o; o.x = pk2(lo[0], lo[1]); o.y = pk2(lo[2], lo[3]); o.z = pk2(hi[0], hi[1]); o.w = pk2(hi[2], hi[3]);
              *(LAS u32x4*)(U + b * HY_LDU + t8) = o; } }
        __syncthreads();
#pragma unroll
        for (int o = 0; o < 2; ++o) {
            const int gc = (o == 0) ? c : 1024 + c;
            int lz = lane; asm volatile("" : "+v"(lz));
            const bf16* grow = PT + (size_t)gc * MTOK + (size_t)(lz & 15) * SEQ;
            u32x2 gm[16];
#pragma unroll
            for (int tt = 0; tt < 16; ++tt) gm[tt] = *(const u32x2*)(grow + 256 * w + 16 * tt + 4 * fq);
            const unsigned edge_lo = (w > 0) ? (unsigned)grow[256 * w - 1] : 0u, edge_hi = (w < 7) ? (unsigned)grow[256 * w + 256] : 0u;
            if (o == 0) hy_load_kern(kr, KERN + ((size_t)c * 2 + 1) * 4096, tid);
            else if (has_next) hy_load_kern(kr, KERN + ((size_t)(c + F.G) * 2 + 0) * 4096, tid);
            f32x4 acc[16];
#pragma unroll
            for (int i = 0; i < 16; ++i) acc[i] = (f32x4){0.f, 0.f, 0.f, 0.f};
            const LAS bf16* kbase = KC + (fr & 7) * HY_KCS + 2048 + 8 * fq - 8 * (fr >> 3) - 256 * w;
            const LAS bf16* ubase = U + fr * HY_LDU + 8 * fq;
            bf16x8 win[16];
#pragma unroll
            for (int i = 0; i < 16; ++i) win[i] = *(const LAS bf16x8*)(kbase - 16 * i);
            bf16x8 bnx = *(const LAS bf16x8*)(ubase);
#define HY_TIE(a, b, c) asm volatile("s_waitcnt lgkmcnt(0)" : "+v"(a), "+v"(b), "+v"(c) :: "memory")
#pragma unroll 1
            for (int sj8 = 0; sj8 < 64; sj8 += 8) {
#pragma unroll
                for (int u = 0; u < 8; ++u) { const int sj = sj8 + u;
                    HY_TIE(bnx, win[(16 - 2 * u) & 15], win[(17 - 2 * u) & 15]);
                    const bf16x8 bfr = bnx;
#pragma unroll
                    for (int tt = 14; tt < 16; ++tt) acc[tt] = __builtin_amdgcn_mfma_f32_16x16x32_bf16(win[(tt - 2 * u) & 15], bfr, acc[tt], 0, 0, 0);
                    __builtin_amdgcn_sched_barrier(0);
                    bnx = *(const LAS bf16x8*)(ubase + 32 * ((sj + 1) & 63));
                    win[(14 - 2 * u) & 15] = *(const LAS bf16x8*)(kbase + 16 * (2 * sj + 2));
                    win[(15 - 2 * u) & 15] = *(const LAS bf16x8*)(kbase + 16 * (2 * sj + 1));
                    __builtin_amdgcn_sched_barrier(0);
#pragma unroll
                    for (int tt = 2; tt < 14; ++tt) acc[tt] = __builtin_amdgcn_mfma_f32_16x16x32_bf16(win[(tt - 2 * u) & 15], bfr, acc[tt], 0, 0, 0);
#pragma unroll
                    for (int tt = 0; tt < 2; ++tt) acc[tt] = __builtin_amdgcn_mfma_f32_16x16x32_bf16(win[(tt - 2 * u) & 15], bfr, acc[tt], 0, 0, 0);
                    __builtin_amdgcn_sched_barrier(0);
                } }
#undef HY_TIE
            if (o == 1 && has_next) load_v(c + F.G);
            const float hbias = hb[o * DM + c];
            const float w0 = cw[0 * HYC + gc], w1 = cw[1 * HYC + gc], w2 = cw[2 * HYC + gc], cb = cbv[gc];
            u32x2 zpk[16];
            unsigned pa[16], nb[16];
#pragma unroll
            for (int tt = 0; tt < 16; ++tt) { pa[tt] = __shfl(gm[tt].y >> 16, (lane + 48) & 63); nb[tt] = __shfl(gm[tt].x & 0xffffu, (lane + 16) & 63); }
#pragma unroll
            for (int tt = 0; tt < 16; ++tt) { const int t0 = 256 * w + 16 * tt + 4 * fq;
                const unsigned pmv = (fq > 0) ? pa[tt] : (tt > 0 ? pa[tt > 0 ? tt - 1 : 0] : edge_lo), ppv = (fq < 3) ? nb[tt] : (tt < 15 ? nb[tt < 15 ? tt + 1 : 15] : edge_hi);
                const u32x2 uu = *(const LAS u32x2*)(U + fr * HY_LDU + t0);
                const f32x4 g = hy_conv4(gm[tt], bf2f(pmv), bf2f(ppv), w0, w1, w2, cb);
                f32x4 y = acc[tt]; y[0] = g[0] * (y[0] + bflo(uu.x) * hbias); y[1] = g[1] * (y[1] + bfhi(uu.x) * hbias); y[2] = g[2] * (y[2] + bflo(uu.y) * hbias); y[3] = g[3] * (y[3] + bfhi(uu.y) * hbias);
                zpk[tt].x = pk2(y[0], y[1]); zpk[tt].y = pk2(y[2], y[3]); }
            __syncthreads();
            if (o == 0) {
#pragma unroll
                for (int tt = 0; tt < 16; ++tt) *(LAS u32x2*)(U + fr * HY_LDU + 256 * w + 16 * tt + 4 * fq) = zpk[tt];
                hy_store_kc(KC, kr, tid);
                __syncthreads();
            } else {
                int ly = lane; asm volatile("" : "+v"(ly));
                bf16* yrow = YT + (size_t)c * MTOK + (size_t)(ly & 15) * SEQ + 256 * w + 4 * (ly >> 4);
#pragma unroll
                for (int tt = 0; tt < 16; ++tt) *(u32x2*)(yrow + 16 * tt) = zpk[tt];
            }
        }
    }
}

__device__ __forceinline__ void ssd_conv_phase(Frame& F) {
    bf16* XBC = (bf16*)(F.ws + WS_XBC); const bf16* HALO = (const bf16*)(F.ws + WS_HALO);
    const float* scw = F.in[I_SCW]; const float* scb = F.in[I_SCB];
    const int gw = F.vcu * NWAVES + F.wave, NGW = F.G * NWAVES, lane = F.lane;
    for (int item = gw; item < BATCH * 32 * 8; item += NGW) {
        const int cb8 = item & 7, seg = (item >> 3) & 31, b = item >> 8, col = cb8 * 512 + lane * 8;
        float wk[5][8], cbv[8];
#pragma unroll
        for (int k = 0; k < 5; ++k) { const f32x4 a = *(const f32x4*)(scw + k * CONVD + col), c = *(const f32x4*)(scw + k * CONVD + col + 4);
#pragma unroll
            for (int e = 0; e < 4; ++e) { wk[k][e] = a[e]; wk[k][4 + e] = c[e]; } }
        { const f32x4 a = *(const f32x4*)(scb + col), c = *(const f32x4*)(scb + col + 4);
#pragma unroll
          for (int e = 0; e < 4; ++e) { cbv[e] = a[e]; cbv[4 + e] = c[e]; } }
        bf16* xrow0 = XBC + ((size_t)b * SEQ + seg * 64) * CONVD + col;
        const bf16* hlo = HALO + ((size_t)(b * 33 + seg) * 4) * CONVD + col;
        const bf16* hhi = HALO + ((size_t)(b * 33 + seg + 1) * 4 + 2) * CONVD + col;
        const u32x4 zero4 = {0u, 0u, 0u, 0u};
        u32x4 W[12];
        W[0] = seg > 0 ? *(const u32x4*)(hlo) : zero4; W[1] = seg > 0 ? *(const u32x4*)(hlo + CONVD) : zero4;
        W[2] = *(const u32x4*)(xrow0); W[3] = *(const u32x4*)(xrow0 + CONVD);
#pragma unroll 1
        for (int blk = 0; blk < 8; ++blk) { const int r0 = 8 * blk;
#pragma unroll
            for (int i = 4; i < 12; ++i) { const int rr = r0 - 2 + i;
                if (rr < 64) W[i] = *(const u32x4*)(xrow0 + (size_t)rr * CONVD);
                else W[i] = (seg < 31) ? *(const u32x4*)(hhi + (size_t)(rr - 64) * CONVD) : zero4; }
#pragma unroll
            for (int o = 0; o < 8; ++o) { float v[8];
#pragma unroll
                for (int e = 0; e < 8; ++e) v[e] = cbv[e];
#pragma unroll
                for (int k = 0; k < 5; ++k) { const u32x4 p = W[o + k];
                    v[0] += wk[k][0] * bflo(p.x); v[1] += wk[k][1] * bfhi(p.x); v[2] += wk[k][2] * bflo(p.y); v[3] += wk[k][3] * bfhi(p.y);
                    v[4] += wk[k][4] * bflo(p.z); v[5] += wk[k][5] * bfhi(p.z); v[6] += wk[k][6] * bflo(p.w); v[7] += wk[k][7] * bfhi(p.w); }
#pragma unroll
                for (int e = 0; e < 8; ++e) v[e] = siluf_(v[e]);
                u32x4 ov; ov.x = pk2(v[0], v[1]); ov.y = pk2(v[2], v[3]); ov.z = pk2(v[4], v[5]); ov.w = pk2(v[6], v[7]);
                *(u32x4*)(xrow0 + (size_t)(r0 + o) * CONVD) = ov; }
#pragma unroll
            for (int i = 0; i < 4; ++i) W[i] = W[8 + i];
        }
    }
}

constexpr int SS_LDC = 144, SS_LDM = 136;
constexpr int SS_C = 0, SS_B = 18432, SS_X = 36864, SS_XE = 55296, SS_M = 73728, SS_SB = 108544, SS_ACS = 145408, SS_DTV = 146432, SS_TOE = 147456, SS_END = 148480;
static_assert(SS_END <= MISC_OFF, "SSD LDS map");
typedef short s16x4 __attribute__((ext_vector_type(4)));
__device__ __forceinline__ bf16x8 ssd_trfrag(const LAS bf16* p) {
    const s16x4 a = __builtin_amdgcn_ds_read_tr16_b64_v4i16((LAS s16x4*)p), b = __builtin_amdgcn_ds_read_tr16_b64_v4i16((LAS s16x4*)(p + 16 * SS_LDC));
    return __builtin_shufflevector(a, b, 0, 1, 2, 3, 4, 5, 6, 7);
}

__device__ __forceinline__ void ssd_phase(Frame& F) {
    LAS unsigned char* L = F.lds;
    LAS bf16* Cl = (LAS bf16*)(L + SS_C); LAS bf16* Bl = (LAS bf16*)(L + SS_B); LAS bf16* Xr = (LAS bf16*)(L + SS_X); LAS bf16* XEr = (LAS bf16*)(L + SS_XE);
    LAS bf16* Ml = (LAS bf16*)(L + SS_M); LAS bf16* SB = (LAS bf16*)(L + SS_SB);
    LAS float* ACS = (LAS float*)(L + SS_ACS); LAS float* DTV = (LAS float*)(L + SS_DTV); LAS float* TOE = (LAS float*)(L + SS_TOE);
    const bf16* XBC = (const bf16*)(F.ws + WS_XBC); const float* DT = (const float*)(F.ws + WS_DT); const unsigned char* Z8 = (const unsigned char*)F.out; bf16* YS = (bf16*)(F.ws + WS_YSSD);
    const float* dtb = F.in[I_DTB]; const float* alog = F.in[I_ALOG]; const float* sd = F.in[I_SD];
    const int tid = F.tid, lane = F.lane, w = F.wave, fr = lane & 15, fq = lane >> 4;
    for (int unit = F.vcu; unit < BATCH * NGRP * 2; unit += F.G) {
        const int b = unit >> 4, g = (unit >> 1) & 7, hp = unit & 1, h0 = 4 * g + 2 * hp;
#pragma unroll 1
        for (int dir = 0; dir < 2; ++dir) {
            const float dtbias = (w < 2) ? dtb[dir * 32 + h0 + w] : 0.f, aexp = (w < 2) ? __expf(alog[dir * 32 + h0 + w]) : 0.f;
            auto scan = [&](int buf, float raw) {
                raw += dtbias; const float dtv = raw > 20.f ? raw : log1pf(__expf(raw)); float a = -dtv * aexp;
#pragma unroll
                for (int o = 1; o < 64; o <<= 1) { const float v = __shfl_up(a, o); if (lane >= o) a += v; }
                const float tot = __shfl(a, 63); const int ix = (buf * 2 + w) * 64 + lane;
                ACS[ix] = a; DTV[ix] = dtv; TOE[ix] = __expf(tot - a); };
            auto dtload = [&](int ci) -> float { const int ch = dir ? 31 - ci : ci, r = dir ? 63 - lane : lane;
                return DT[((size_t)b * SEQ + 64 * ch + r) * 64 + dir * 32 + h0 + w]; };
            auto rowload = [&](int ci, int it, int tl) -> u32x4 {
                const int l = (tl >> 4) + 32 * (it & 1), j = tl & 15, ch = dir ? 31 - ci : ci, r = dir ? 63 - l : l;
                const int col = (it < 2 ? 64 * h0 : (it < 4 ? 2048 + 128 * g : 3072 + 128 * g)) + 8 * j;
                return *(const u32x4*)(XBC + ((size_t)b * SEQ + 64 * ch + r) * CONVD + col); };
            f32x4 Sacc[8];
#pragma unroll
            for (int i = 0; i < 8; ++i) Sacc[i] = (f32x4){0.f, 0.f, 0.f, 0.f};
            const float dsk = sd[h0 + (w >> 2)];
            __syncthreads();
            for (int i = tid; i < 2 * 64 * SS_LDC / 2; i += NTHR) ((LAS unsigned*)SB)[i] = 0u;
            float dtn = 0.f;
            if (w < 2) { scan(0, dtload(0)); dtn = dtload(1); }
            u32x4 pf[6];
#pragma unroll
            for (int it = 0; it < 6; ++it) pf[it] = rowload(0, it, tid);
            __syncthreads();
#pragma unroll 1
            for (int ci = 0; ci < 32; ++ci) {
                const int ch = dir ? 31 - ci : ci, buf = ci & 1;
                const size_t tokbase = (size_t)b * SEQ + 64 * ch;
                int tl = tid; asm volatile("" : "+v"(tl));
                int frl = fr, fql = fq; asm volatile("" : "+v"(frl), "+v"(fql));
                const LAS float* acs = ACS + buf * 128; const LAS float* dtv = DTV + buf * 128; const LAS float* toe = TOE + buf * 128;
#pragma unroll
                for (int it = 0; it < 6; ++it) { const int l = (tl >> 4) + 32 * (it & 1), j = tl & 15; const u32x4 p = pf[it];
                    if (it < 2) { const int hh = j >> 3; const float de = dtv[hh * 64 + l] * toe[hh * 64 + l];
                        *(LAS u32x4*)(Xr + l * SS_LDC + j * 8) = p;
                        u32x4 q; q.x = pk2(bflo(p.x) * de, bfhi(p.x) * de); q.y = pk2(bflo(p.y) * de, bfhi(p.y) * de); q.z = pk2(bflo(p.z) * de, bfhi(p.z) * de); q.w = pk2(bflo(p.w) * de, bfhi(p.w) * de);
                        *(LAS u32x4*)(XEr + l * SS_LDC + j * 8) = q; }
                    else if (it < 4) { *(LAS u32x4*)(Bl + l * SS_LDC + j * 8) = p; }
                    else { *(LAS u32x4*)(Cl + l * SS_LDC + j * 8) = p; } }
                if (ci + 1 < 32) {
#pragma unroll
                    for (int it = 0; it < 6; ++it) pf[it] = rowload(ci + 1, it, tl); }
                __syncthreads();
                const int hh = w >> 2, li = w & 3, lrow = 16 * li + frl;
                const int rloc = dir ? 63 - lrow : lrow; const size_t tok = tokbase + rloc;
                u32x2 pv[4]; unsigned zv[4];
                if (dir) {
#pragma unroll
                    for (int pi = 0; pi < 4; ++pi) { const size_t o = tok * DSSM + 64 * (h0 + hh) + 16 * pi + 4 * fql; pv[pi] = *(const u32x2*)(YS + o); zv[pi] = *(const unsigned*)(Z8 + o); } }
#define SSD_FENCE() asm volatile("s_waitcnt lgkmcnt(0)" ::: "memory")
#define SSD_TIE8(a) asm volatile("s_waitcnt lgkmcnt(0)" : "+v"(a[0][0]), "+v"(a[0][1]), "+v"(a[1][0]), "+v"(a[1][1]), "+v"(a[2][0]), "+v"(a[2][1]), "+v"(a[3][0]), "+v"(a[3][1]) :: "memory")
#define SSD_TIE8K(a) asm volatile("s_waitcnt lgkmcnt(0)" : "+v"(a[0][0]), "+v"(a[0][1]), "+v"(a[0][2]), "+v"(a[0][3]), "+v"(a[1][0]), "+v"(a[1][1]), "+v"(a[1][2]), "+v"(a[1][3]) :: "memory")
                f32x4 Y[4];
                { bf16x8 cfr[4];
#pragma unroll
                  for (int kk = 0; kk < 4; ++kk) cfr[kk] = *(const LAS bf16x8*)(Cl + lrow * SS_LDC + 8 * fql + 32 * kk);
#pragma unroll
                  for (int ph = 0; ph < 2; ++ph) { bf16x8 sfr[2][4];
#pragma unroll
                      for (int pp = 0; pp < 2; ++pp)
#pragma unroll
                          for (int kk = 0; kk < 4; ++kk) sfr[pp][kk] = *(const LAS bf16x8*)(SB + (hh * 64 + 16 * (2 * ph + pp) + frl) * SS_LDC + 8 * fql + 32 * kk);
                      SSD_TIE8K(sfr);
#pragma unroll
                      for (int pp = 0; pp < 2; ++pp) { Y[2 * ph + pp] = (f32x4){0.f, 0.f, 0.f, 0.f};
#pragma unroll
                          for (int kk = 0; kk < 4; ++kk) Y[2 * ph + pp] = __builtin_amdgcn_mfma_f32_16x16x32_bf16(sfr[pp][kk], cfr[kk], Y[2 * ph + pp], 0, 0, 0); }
                      __builtin_amdgcn_sched_barrier(0); } }
                { bf16x8 cbA[2][4], cbB[2][4]; f32x4 tas[2], tdd[2]; float tal[2];
#pragma unroll
                  for (int q = 0; q < 2; ++q) { const int id = 2 * w + q, si = id >> 2, lj = id & 3;
                      if (si <= lj) {
#pragma unroll
                          for (int kk = 0; kk < 4; ++kk) { cbA[q][kk] = *(const LAS bf16x8*)(Bl + (16 * si + frl) * SS_LDC + 8 * fql + 32 * kk); cbB[q][kk] = *(const LAS bf16x8*)(Cl + (16 * lj + frl) * SS_LDC + 8 * fql + 32 * kk); } } }
                  auto tab_load = [&](int q) { const int id = 2 * w + q, si = id >> 2, lj = id & 3, l = 16 * lj + frl, s0 = 16 * si + 4 * fql;
#pragma unroll
                      for (int h = 0; h < 2; ++h) { tas[h] = *(const LAS f32x4*)(acs + 64 * h + s0); tdd[h] = *(const LAS f32x4*)(dtv + 64 * h + s0); tal[h] = acs[64 * h + l]; } };
                  tab_load(0);
                  SSD_FENCE();
#pragma unroll
                  for (int q = 0; q < 2; ++q) { const int id = 2 * w + q, si = id >> 2, lj = id & 3, l = 16 * lj + frl, s0 = 16 * si + 4 * fql;
                      u32x2 m0 = {0u, 0u}, m1 = {0u, 0u};
                      if (si <= lj) { f32x4 cb = (f32x4){0.f, 0.f, 0.f, 0.f};
#pragma unroll
                          for (int kk = 0; kk < 4; ++kk) cb = __builtin_amdgcn_mfma_f32_16x16x32_bf16(cbA[q][kk], cbB[q][kk], cb, 0, 0, 0);
                          float x0[4], x1[4];
#pragma unroll
                          for (int j = 0; j < 4; ++j) { const bool keep = (s0 + j <= l);
                              const float e0 = __expf(fminf(tal[0] - tas[0][j], 0.f)) * tdd[0][j], e1 = __expf(fminf(tal[1] - tas[1][j], 0.f)) * tdd[1][j];
                              const float c = keep ? cb[j] : 0.f; x0[j] = c * e0; x1[j] = c * e1; }
                          m0.x = pk2(x0[0], x0[1]); m0.y = pk2(x0[2], x0[3]); m1.x = pk2(x1[0], x1[1]); m1.y = pk2(x1[2], x1[3]); }
                      if (q == 0) tab_load(1);
                      *(LAS u32x2*)(Ml + (0 * 64 + l) * SS_LDM + s0) = m0; *(LAS u32x2*)(Ml + (1 * 64 + l) * SS_LDM + s0) = m1; } }
                __syncthreads();
                const int trb = (4 * fql + (frl >> 2)) * SS_LDC + 4 * (frl & 3);
                { bf16x8 mf[2], xdf[4][2];
#pragma unroll
                  for (int kk = 0; kk < 2; ++kk) { const LAS bf16* mp = Ml + (hh * 64 + lrow) * SS_LDM + 32 * kk + 4 * fql;
                      const s16x4 a = *(const LAS s16x4*)mp, b2 = *(const LAS s16x4*)(mp + 16); mf[kk] = __builtin_shufflevector(a, b2, 0, 1, 2, 3, 4, 5, 6, 7); }
#pragma unroll
                  for (int pi = 0; pi < 4; ++pi)
#pragma unroll
                      for (int kk = 0; kk < 2; ++kk) xdf[pi][kk] = ssd_trfrag(Xr + trb + 32 * kk * SS_LDC + hh * 64 + 16 * pi);
                  const float el = __expf(acs[hh * 64 + lrow]);
                  SSD_TIE8(xdf);
#pragma unroll
                  for (int pi = 0; pi < 4; ++pi) { Y[pi] = Y[pi] * el;
                      Y[pi] = __builtin_amdgcn_mfma_f32_16x16x32_bf16(xdf[pi][0], mf[0], Y[pi], 0, 0, 0);
                      Y[pi] = __builtin_amdgcn_mfma_f32_16x16x32_bf16(xdf[pi][1], mf[1], Y[pi], 0, 0, 0); }
                  __builtin_amdgcn_sched_barrier(0);
#pragma unroll
                  for (int pi = 0; pi < 4; ++pi) { const int p0 = 16 * pi + 4 * fql; bf16* yp = YS + tok * DSSM + 64 * (h0 + hh) + p0; f32x4 y = Y[pi];
                      if (dir == 0) { const u32x2 xv = *(const LAS u32x2*)(Xr + lrow * SS_LDC + hh * 64 + p0);
                          y[0] += dsk * bflo(xv.x); y[1] += dsk * bfhi(xv.x); y[2] += dsk * bflo(xv.y); y[3] += dsk * bfhi(xv.y);
                      } else { const u32x2 pvv = pv[pi]; const f32x2 z01 = __builtin_amdgcn_cvt_pk_f32_fp8((int)zv[pi], false), z23 = __builtin_amdgcn_cvt_pk_f32_fp8((int)zv[pi], true);
                          y[0] = (y[0] + bflo(pvv.x)) * siluf_(z01.x); y[1] = (y[1] + bfhi(pvv.x)) * siluf_(z01.y); y[2] = (y[2] + bflo(pvv.y)) * siluf_(z23.x); y[3] = (y[3] + bfhi(pvv.y)) * siluf_(z23.y); }
                      u32x2 o; o.x = pk2(y[0], y[1]); o.y = pk2(y[2], y[3]); *(u32x2*)yp = o; }
                  __builtin_amdgcn_sched_barrier(0); }
                { const int pi5 = w & 3; const float dec = __expf(acs[hh * 64 + 63]);
                  bf16x8 xef[2];
#pragma unroll
                  for (int kk = 0; kk < 2; ++kk) xef[kk] = ssd_trfrag(XEr + trb + 32 * kk * SS_LDC + hh * 64 + 16 * pi5);
#pragma unroll
                  for (int nh = 0; nh < 2; ++nh) { bf16x8 btf[4][2];
#pragma unroll
                      for (int nn = 0; nn < 4; ++nn)
#pragma unroll
                          for (int kk = 0; kk < 2; ++kk) btf[nn][kk] = ssd_trfrag(Bl + trb + 32 * kk * SS_LDC + 16 * (4 * nh + nn));
                      SSD_TIE8(btf);
#pragma unroll
                      for (int nn = 0; nn < 4; ++nn) { const int ni = 4 * nh + nn; Sacc[ni] = Sacc[ni] * dec;
                          Sacc[ni] = __builtin_amdgcn_mfma_f32_16x16x32_bf16(btf[nn][0], xef[0], Sacc[ni], 0, 0, 0);
                          Sacc[ni] = __builtin_amdgcn_mfma_f32_16x16x32_bf16(btf[nn][1], xef[1], Sacc[ni], 0, 0, 0); }
                      __builtin_amdgcn_sched_barrier(0); }
#pragma unroll
                  for (int ni = 0; ni < 8; ++ni) { u32x2 o; o.x = pk2(Sacc[ni][0], Sacc[ni][1]); o.y = pk2(Sacc[ni][2], Sacc[ni][3]);
                      *(LAS u32x2*)(SB + (hh * 64 + 16 * pi5 + frl) * SS_LDC + 16 * ni + 4 * fql) = o; } }
                if (w < 2 && ci + 1 < 32) { scan(buf ^ 1, dtn); if (ci + 2 < 32) dtn = dtload(ci + 2); }
                __syncthreads();
            }
        }
    }
}

__device__ __forceinline__ void ssd_norm_phase(Frame& F) {
    bf16* YS = (bf16*)(F.ws + WS_YSSD); const float* nw = F.in[I_SNW];
    const int gw = F.vcu * NWAVES + F.wave, NGW = F.G * NWAVES, lane = F.lane;
    f32x4 wv[8];
#pragma unroll
    for (int j = 0; j < 4; ++j) { wv[2 * j] = *(const f32x4*)(nw + 512 * j + 8 * lane); wv[2 * j + 1] = *(const f32x4*)(nw + 512 * j + 8 * lane + 4); }
    for (int m = gw; m < MTOK; m += 2 * NGW) {
        u32x4 v[2][4];
#pragma unroll
        for (int u = 0; u < 2; ++u)
#pragma unroll
            for (int j = 0; j < 4; ++j) v[u][j] = *(const u32x4*)(YS + (size_t)((m + u * NGW < MTOK) ? m + u * NGW : m) * DSSM + 512 * j + 8 * lane);
#pragma unroll
        for (int u = 0; u < 2; ++u) { if (m + u * NGW >= MTOK) break; bf16* row = YS + (size_t)(m + u * NGW) * DSSM + 8 * lane;
#pragma unroll
            for (int j = 0; j < 4; ++j) { const u32x4 q = v[u][j];
                const float a0 = bflo(q.x), a1 = bfhi(q.x), a2 = bflo(q.y), a3 = bfhi(q.y), a4 = bflo(q.z), a5 = bfhi(q.z), a6 = bflo(q.w), a7 = bfhi(q.w);
                float ss = (a0 * a0 + a1 * a1) + (a2 * a2 + a3 * a3) + (a4 * a4 + a5 * a5) + (a6 * a6 + a7 * a7);
                ss += __shfl_xor(ss, 1); ss += __shfl_xor(ss, 2); ss += __shfl_xor(ss, 4); ss += __shfl_xor(ss, 8); ss += __shfl_xor(ss, 16);
                const float rs = 1.0f / sqrtf(ss * (1.0f / 256.0f) + RMS_EPS); const f32x4 w0 = wv[2 * j], w1 = wv[2 * j + 1];
                u32x4 o; o.x = pk2(a0 * rs * w0[0], a1 * rs * w0[1]); o.y = pk2(a2 * rs * w0[2], a3 * rs * w0[3]);
                o.z = pk2(a4 * rs * w1[0], a5 * rs * w1[1]); o.w = pk2(a6 * rs * w1[2], a7 * rs * w1[3]);
                *(u32x4*)(row + 512 * j) = o; } } }
}

constexpr int RT_WC = 131072;
__device__ __forceinline__ void ln1_router_phase(Frame& F) {
    const bf16* H1P = (const bf16*)(F.ws + WS_H1P); bf16* H1B = (bf16*)F.out;
    int* TOK = (int*)(F.ws + WS_TOK); float* WGT = (float*)(F.ws + WS_WGT); int* ASG = (int*)(F.ws + WS_ASG);
    const float* g1 = F.in[I_LN1G]; const float* b1 = F.in[I_LN1B]; const float* rw = F.in[I_RW]; const float* rb = F.in[I_RB];
    LAS float* hrow = (LAS float*)(F.lds + F.wave * 16384);
    LAS float* wc = (LAS float*)(F.lds + RT_WC);
    LAS unsigned* cl = (LAS unsigned*)(F.lds + RT_WC + 16384);
    if (F.tid < 64) cl[F.tid] = 0u;
    __syncthreads();
    const int lane = F.lane, tid = F.tid;
    f32x4 gv[4], bv[4];
#pragma unroll
    for (int j = 0; j < 4; ++j) { gv[j] = *(const f32x4*)(g1 + 4 * lane + 256 * j); bv[j] = *(const f32x4*)(b1 + 4 * lane + 256 * j); }
    const float rbias = rb[lane];
    for (int step = F.vcu; step < MTOK / 32; step += F.G) {
        const int rg = step * 8 + F.wave;
        f32x4 nx0 = *(const f32x4*)(rw + tid * 4), nx1 = *(const f32x4*)(rw + 2048 + tid * 4);
#pragma unroll 1
        for (int r = 0; r < 4; ++r) { const size_t m = (size_t)rg * 4 + r; const bf16* xr = H1P + m * DM;
            f32x4 v[4]; float s = 0.f;
#pragma unroll
            for (int j = 0; j < 4; ++j) { const u32x2 q = *(const u32x2*)(xr + 4 * lane + 256 * j); v[j][0] = bflo(q.x); v[j][1] = bfhi(q.x); v[j][2] = bflo(q.y); v[j][3] = bfhi(q.y); s += (v[j][0] + v[j][1]) + (v[j][2] + v[j][3]); }
            const float mean = wave_sum(s) * (1.f / DM); float s2 = 0.f;
#pragma unroll
            for (int j = 0; j < 4; ++j) { v[j] = v[j] - mean; s2 += (v[j][0] * v[j][0] + v[j][1] * v[j][1]) + (v[j][2] * v[j][2] + v[j][3] * v[j][3]); }
            const float rstd = 1.f / sqrtf(wave_sum(s2) * (1.f / DM) + LN_EPS);
#pragma unroll
            for (int j = 0; j < 4; ++j) { const f32x4 h = v[j] * rstd * gv[j] + bv[j];
                u32x2 o; o.x = pk2(h[0], h[1]); o.y = pk2(h[2], h[3]); *(u32x2*)(H1B + m * H1B_PITCH + 4 * lane + 256 * j) = o;
                *(LAS f32x4*)(hrow + r * 1024 + 4 * lane + 256 * j) = h; } }
        float lg[4] = {0.f, 0.f, 0.f, 0.f};
#pragma unroll 1
        for (int kc = 0; kc < 16; ++kc) {
            __syncthreads();
            *(LAS f32x4*)(wc + tid * 4) = nx0; *(LAS f32x4*)(wc + 2048 + tid * 4) = nx1;
            if (kc + 1 < 16) { nx0 = *(const f32x4*)(rw + (kc + 1) * 4096 + tid * 4); nx1 = *(const f32x4*)(rw + (kc + 1) * 4096 + 2048 + tid * 4); }
            __syncthreads();
#pragma unroll 4
            for (int kk = 0; kk < 64; kk += 4) {
                const float w0 = wc[(kk + 0) * 64 + lane], w1 = wc[(kk + 1) * 64 + lane], w2 = wc[(kk + 2) * 64 + lane], w3 = wc[(kk + 3) * 64 + lane];
#pragma unroll
                for (int r = 0; r < 4; ++r) { const f32x4 h = *(const LAS f32x4*)(hrow + r * 1024 + kc * 64 + kk); lg[r] += h[0] * w0 + h[1] * w1 + h[2] * w2 + h[3] * w3; } }
        }
        bool selr[4]; float wgr[4]; int rkr[4];
#pragma unroll
        for (int r = 0; r < 4; ++r) {
            const float score = 1.0f / (1.0f + expf(-lg[r])), biased = score + rbias;
            float m1 = biased; m1 = fmaxf(m1, __shfl_xor(m1, 1)); m1 = fmaxf(m1, __shfl_xor(m1, 2)); m1 = fmaxf(m1, __shfl_xor(m1, 4));
            const unsigned long long eq = __ballot(biased == m1); const int gbase = lane & ~7; const int first = gbase + __ffs((unsigned)((eq >> gbase) & 0xffull)) - 1;
            float v2 = (lane == first) ? -INFINITY : biased; v2 = fmaxf(v2, __shfl_xor(v2, 1)); v2 = fmaxf(v2, __shfl_xor(v2, 2)); v2 = fmaxf(v2, __shfl_xor(v2, 4));
            const float gs = m1 + v2; const int g = lane >> 3; int better = 0;
#pragma unroll
            for (int d = 1; d < 8; ++d) { const int g2 = (g + d) & 7; const float og = __shfl(gs, g2 * 8); better += (og > gs || (og == gs && g2 < g)) ? 1 : 0; }
            float masked = (better < 4) ? biased : -INFINITY; bool sel = false;
#pragma unroll 1
            for (int it = 0; it < TOPK; ++it) { const float mx = wave_max(masked); const unsigned long long bm = __ballot(masked == mx); const int win = __ffsll((long long)bm) - 1;
                if (lane == win) { sel = true; masked = -INFINITY; } }
            const float sw = wave_sum(sel ? score : 0.f);
            const unsigned long long selm = __ballot(sel);
            selr[r] = sel; wgr[r] = score / sw * ROUTED_SCALE; rkr[r] = __popcll(selm & ((1ull << lane) - 1ull)); }
        unsigned lp[4];
#pragma unroll
        for (int r = 0; r < 4; ++r) lp[r] = selr[r] ? atomicAdd((unsigned*)(cl + lane), 1u) : 0u;
        __syncthreads();
        if (F.wave == 0) { const unsigned n = cl[lane]; unsigned bs = 0u;
            if (n) bs = __hip_atomic_fetch_add((unsigned*)(F.ctl + CW_CNT + 64 * lane), n, __ATOMIC_RELAXED, __HIP_MEMORY_SCOPE_AGENT);
            cl[64 + lane] = bs; cl[lane] = 0u; }
        __syncthreads();
        const unsigned bse = cl[64 + lane];
#pragma unroll
        for (int r = 0; r < 4; ++r) if (selr[r]) { const int m = rg * 4 + r; const unsigned pos = bse + lp[r];
            TOK[(size_t)lane * MTOK + pos] = m; WGT[(size_t)lane * MTOK + pos] = wgr[r]; ASG[(size_t)m * 8 + rkr[r]] = lane * MTOK + (int)pos; }
    }
}
constexpr int MOE_TP = 131072 + 1024, MOE_CNT = MOE_TP + 512, MOE_TE = 131072 + 4096;
__device__ __forceinline__ int moe_table(Frame& F) {
    LAS int* tp = (LAS int*)(F.lds + MOE_TP); LAS int* cnt = (LAS int*)(F.lds + MOE_CNT);
    __syncthreads();
    if (F.tid == 0) { int run = 0;
        for (int e = 0; e < NEX; ++e) { const int c = (e < NE) ? (int)__hip_atomic_load((unsigned*)(F.ctl + CW_CNT + 64 * e), __ATOMIC_RELAXED, __HIP_MEMORY_SCOPE_AGENT) : MTOK;
            cnt[e] = c; tp[e] = run; run += (c + 255) >> 8; }
        tp[NEX] = run; }
    __syncthreads();
    { LAS int* te = (LAS int*)(F.lds + MOE_TE); const int total = tp[NEX];
      for (int t = F.tid; t < total; t += NTHR) { int e = 0;
#pragma unroll 1
          for (int s = 64; s >= 1; s >>= 1) if (e + s <= NE && tp[e + s] <= t) e += s;
          te[t] = e; } }
    __syncthreads();
    return tp[NEX];
}
__device__ __forceinline__ void fp8x4_fma(f32x4& a, const unsigned v, const float w) {
    const f32x2 p0 = __builtin_amdgcn_cvt_pk_f32_fp8((int)v, false), p1 = __builtin_amdgcn_cvt_pk_f32_fp8((int)v, true);
    a[0] += w * p0.x; a[1] += w * p0.y; a[2] += w * p1.x; a[3] += w * p1.y;
}
__device__ __forceinline__ void moe_combine_phase(Frame& F) {
    const bf16* H1B = (const bf16*)F.out; const unsigned char* YQ = (const unsigned char*)(F.ws + WS_YQ); const int* ASG = (const int*)(F.ws + WS_ASG); const float* WGT = (const float*)(F.ws + WS_WGT);
    const LAS int* tp = (const LAS int*)(F.lds + MOE_TP);
    const float* g2 = F.in[I_LN2G]; const float* b2 = F.in[I_LN2B];
    const int gw = F.vcu * NWAVES + F.wave, NGW = F.G * NWAVES, lane = F.lane;
    const size_t shbase = (size_t)tp[NE] * 256;
    f32x4 gv[4], bv[4];
#pragma unroll
    for (int j = 0; j < 4; ++j) { gv[j] = *(const f32x4*)(g2 + 4 * lane + 256 * j); bv[j] = *(const f32x4*)(b2 + 4 * lane + 256 * j); }
    const int l8 = lane & 7;
    int li = ASG[(size_t)gw * 8 + l8];
    float wk = WGT[li];
    int li_n = (gw + NGW < MTOK) ? ASG[(size_t)(gw + NGW) * 8 + l8] : 0;
    for (int m = gw; m < MTOK; m += NGW) {
        const int e = li >> 15, pos = li & 32767; const int slot = 256 * tp[e] + pos; const float wcur = wk;
        unsigned vv[9][4]; f32x4 v[4];
        { const unsigned char* sp = YQ + (shbase + m) * 1024 + 4 * lane;
#pragma unroll
          for (int j = 0; j < 4; ++j) vv[8][j] = *(const unsigned*)(sp + 256 * j); }
#pragma unroll
        for (int k = 0; k < 8; ++k) { const int sk = __shfl(slot, k); const unsigned char* sp = YQ + (size_t)sk * 1024 + 4 * lane;
#pragma unroll
            for (int j = 0; j < 4; ++j) vv[k][j] = *(const unsigned*)(sp + 256 * j); }
        float* xr = F.out + (size_t)m * DM + 4 * lane; const bf16* hr = H1B + (size_t)m * H1B_PITCH + 4 * lane; u32x2 hq[4];
#pragma unroll
        for (int j = 0; j < 4; ++j) hq[j] = *(const u32x2*)(hr + 256 * j);
        li = li_n; wk = WGT[li];
        li_n = (m + 2 * NGW < MTOK) ? ASG[(size_t)(m + 2 * NGW) * 8 + l8] : 0;
#pragma unroll
        for (int j = 0; j < 4; ++j) { v[j][0] = DN_ALPHA * bflo(hq[j].x); v[j][1] = DN_ALPHA * bfhi(hq[j].x); v[j][2] = DN_ALPHA * bflo(hq[j].y); v[j][3] = DN_ALPHA * bfhi(hq[j].y); fp8x4_fma(v[j], vv[8][j], 1.0f); }
#pragma unroll
        for (int k = 0; k < 8; ++k) { const float w = __shfl(wcur, k);
#pragma unroll
            for (int j = 0; j < 4; ++j) fp8x4_fma(v[j], vv[k][j], w); }
        float s = 0.f;
#pragma unroll
        for (int j = 0; j < 4; ++j) s += (v[j][0] + v[j][1]) + (v[j][2] + v[j][3]);
        const float mean = wave_sum(s) * (1.f / DM); float s2 = 0.f;
#pragma unroll
        for (int j = 0; j < 4; ++j) { v[j] = v[j] - mean; s2 += (v[j][0] * v[j][0] + v[j][1] * v[j][1]) + (v[j][2] * v[j][2] + v[j][3] * v[j][3]); }
        const float rstd = 1.f / sqrtf(wave_sum(s2) * (1.f / DM) + LN_EPS);
#pragma unroll
        for (int j = 0; j < 4; ++j) *(f32x4*)(xr + 256 * j) = v[j] * rstd * gv[j] + bv[j];
    }
}

#ifndef MK_N_LAUNCHES
#define MK_N_LAUNCHES 1
#endif
constexpr int NPH = 15;
constexpr int N_LAUNCHES = MK_N_LAUNCHES;

__global__ void __launch_bounds__(NTHR, 2) fwd_kernel(Args args) {
    extern __shared__ __attribute__((aligned(16))) unsigned char lds_raw[];
    Frame F;
    F.lds = (LAS unsigned char*)lds_raw;
    F.MISC = (volatile LAS unsigned*)(F.lds + MISC_OFF);
    F.tid = threadIdx.x; F.lane = F.tid & 63; F.wave = __builtin_amdgcn_readfirstlane(F.tid >> 6);
    F.G = gridDim.x; { const int bx = blockIdx.x; F.vcu = (F.G % 8 == 0) ? (bx % 8) * (F.G / 8) + bx / 8 : bx; }
    F.ws = args.ws; F.ctl = (gu32*)(args.ws + WS_CTL); F.in = args.in; F.out = args.out;
    for (int u = F.tid; u < (LDS_BYTES - MISC_OFF) / 4; u += NTHR) ((LAS unsigned*)(F.lds + MISC_OFF))[u] = 0u;
    __syncthreads();
    XcdBarrier bar; bar.bar = (unsigned*)(F.ctl + CW_BAR); bar.x = 0; bar.st = nullptr;
    if (N_LAUNCHES != NPH) bar = xcd_barrier_post((unsigned*)(F.ctl + CW_BAR), F.MISC + 8);
    const int lo = args.ph_lo, hi = args.ph_hi;
#ifndef PH_MASK
#define PH_MASK 0x7fff
#endif
#define IN(k) ((((PH_MASK) >> (k)) & 1) && lo <= (k) && (k) < hi)
#ifdef STRESS_US
#define SKEW() do { if ((blockIdx.x * 2654435761u >> 28) & 1) { const unsigned long long t0_ = __builtin_amdgcn_s_memrealtime(); while (__builtin_amdgcn_s_memrealtime() - t0_ < (unsigned long long)(STRESS_US) * 100ull) __builtin_amdgcn_s_sleep(8); } __syncthreads(); } while (0)
#else
#define SKEW() do { } while (0)
#endif
#define SEAM(k) do { if (IN(k) && IN((k) + 1)) { xcd_barrier(bar); SKEW(); } } while (0)
#ifndef REP_MASK
#define REP_MASK 0
#endif
#define REPS(k) for (int rep_ = 0; rep_ < ((((REP_MASK) >> (k)) & 1) ? 2 : 1); ++rep_, ((((REP_MASK) >> (k)) & 1) && rep_ == 1 ? xcd_barrier(bar) : (void)0))
    const int G = F.G, bx = (int)blockIdx.x;

#ifdef START_BARS
    for (int xb_ = 0; xb_ < START_BARS; ++xb_) xcd_barrier(bar);
#endif
    if (IN(0)) REPS(0) { p0_prologue(F); } SEAM(0);
    if (IN(1)) REPS(1) {
        pg8::StaticOrder S; S.init((const bf16*)((unsigned char*)F.out + OUT_XB), (const bf16*)(F.ws + WS_WINT), MTOK, HYC, DM, G, bx);
        pg8::EpiHyT E{(bf16*)(F.ws + WS_PTHY), F.in[I_BIN], F.lds + pg8::STAGE_BYTES};
        pg8::gemm_phase<pg8::EpiHyT, pg8::StaticOrder, false>(F.lds, DM, S, E);
    } SEAM(1);
    if (IN(2)) REPS(2) { hyena_phase(F); } SEAM(2);
    if (IN(3)) REPS(3) { p3_transpose(F); } SEAM(3);
    if (IN(4)) REPS(4) {
        pg8::StaticOrder S; S.init((const bf16*)((unsigned char*)F.out + OUT_XB), (const bf16*)(F.ws + WS_WINT) + (size_t)3072 * DM, MTOK, 6400, DM, G, bx);
        pg8::EpiZXD E{(unsigned char*)F.out, (bf16*)(F.ws + WS_XBC), (float*)(F.ws + WS_DT), F.in[I_BIN], (bf16*)(F.ws + WS_HALO)};
        pg8::gemm_phase<pg8::EpiZXD, pg8::StaticOrder, false>(F.lds, DM, S, E);
    } SEAM(4);
    if (IN(5)) REPS(5) { ssd_conv_phase(F); } SEAM(5);
    if (IN(6)) REPS(6) { ssd_phase(F); } SEAM(6);
    if (IN(7)) REPS(7) { ssd_norm_phase(F); }
    if (IN(8)) REPS(8) {
        pg8::StaticOrder S; S.init((const bf16*)((unsigned char*)F.out + OUT_XB), (const bf16*)(F.ws + WS_WING), MTOK, 2048, DM, G, bx);
        pg8::EpiBf<0> E{(bf16*)(F.ws + WS_G), 2048, F.in[I_BIN] + 9280, nullptr, 0, nullptr};
        pg8::gemm_phase<pg8::EpiBf<0>, pg8::StaticOrder, false>(F.lds, DM, S, E);
    } SEAM(8);
    if (IN(9)) REPS(9) {
        pg8::StaticOrder S; S.init((const bf16*)(F.ws + WS_YHY), (const bf16*)(F.ws + WS_WHYB), MTOK, DM, DM, G, bx);
        pg8::EpiBf<1> E{(bf16*)(F.ws + WS_MIX), DM, nullptr, (const bf16*)(F.ws + WS_G), 2048, nullptr};
        pg8::gemm_phase<pg8::EpiBf<1>, pg8::StaticOrder, false>(F.lds, DM, S, E);
    }
    if (IN(10)) REPS(10) {
        pg8::StaticOrder S; S.init((const bf16*)(F.ws + WS_YSSD), (const bf16*)(F.ws + WS_WSSDB), MTOK, DM, DSSM, G, bx);
        pg8::EpiBf<2> E{(bf16*)(F.ws + WS_MIX), DM, nullptr, (const bf16*)(F.ws + WS_G) + 1024, 2048, (const bf16*)(F.ws + WS_MIX)};
        pg8::gemm_phase<pg8::EpiBf<2>, pg8::StaticOrder, false>(F.lds, DSSM, S, E);
    } SEAM(10);
    if (IN(11)) REPS(11) {
        pg8::StaticOrder S; S.init((const bf16*)(F.ws + WS_MIX), (const bf16*)(F.ws + WS_WOUT), MTOK, DM, DM, G, bx);
        pg8::EpiRes E{(bf16*)(F.ws + WS_H1P), F.in[I_BOUT], (const bf16*)((unsigned char*)F.out + OUT_XB), DN_ALPHA};
        pg8::gemm_phase<pg8::EpiRes, pg8::StaticOrder, false>(F.lds, DM, S, E);
        p10_expert_weights(F);
    } SEAM(11);
    if (IN(12)) REPS(12) { ln1_router_phase(F); } SEAM(12);
    if (IN(13)) REPS(13) {
        const int total = moe_table(F);
        pg8::MoeOrder<2, true> S{(const LAS int*)(F.lds + MOE_TP), (const LAS int*)(F.lds + MOE_CNT), (const LAS int*)(F.lds + MOE_TE), G, bx, total, (const char*)F.out, (const char*)(F.ws + WS_EW1), (const int*)(F.ws + WS_TOK)};
        pg8::EpiSwiGLU E{(bf16*)(F.ws + WS_HID)};
        pg8::gemm_phase<pg8::EpiSwiGLU, pg8::MoeOrder<2, true>, true>(F.lds, DM, S, E);
    } SEAM(13);
    if (IN(14)) {
        const int total = moe_table(F);
        { pg8::SlotOrder4 S{(const LAS int*)(F.lds + MOE_TP), (const LAS int*)(F.lds + MOE_TE), G, bx, total, (const char*)(F.ws + WS_HID), (const char*)(F.ws + WS_EW2)};
          pg8::EpiSlot8 E{(unsigned char*)(F.ws + WS_YQ)}; int kd = DEXP; asm volatile("" : "+s"(kd));
          pg8::gemm_phase<pg8::EpiSlot8, pg8::SlotOrder4, false>(F.lds, kd, S, E); }
        xcd_barrier(bar);
        moe_combine_phase(F);
    }
#ifdef EXTRA_BARS
    for (int xb_ = 0; xb_ < EXTRA_BARS; ++xb_) xcd_barrier(bar);
#endif
#undef IN
#undef SEAM
}

extern "C" void kernel_launch(void* const* d_in, const int* in_sizes, int n_in, void* d_out, int out_size, void* d_ws, size_t ws_size, hipStream_t stream) {
    static int grid = 0;
    if (grid == 0) {
        if (n_in != 38 || out_size != MTOK * DM || ws_size < WS_END) { fprintf(stderr, "kernel_launch: unexpected shapes (n_in %d out %d ws %zu)\n", n_in, out_size, ws_size); grid = -1; return; }
        int dev = 0, cus = 0, per_cu = 0;
        if (hipGetDevice(&dev) != hipSuccess || hipDeviceGetAttribute(&cus, hipDeviceAttributeMultiprocessorCount, dev) != hipSuccess) { grid = -1; return; }
        if (hipFuncSetAttribute((const void*)fwd_kernel, hipFuncAttributeMaxDynamicSharedMemorySize, LDS_BYTES) != hipSuccess) { fprintf(stderr, "kernel_launch: hipFuncSetAttribute failed\n"); grid = -1; return; }
        if (hipOccupancyMaxActiveBlocksPerMultiprocessor(&per_cu, (const void*)fwd_kernel, NTHR, LDS_BYTES) != hipSuccess || per_cu < 1) fprintf(stderr, "kernel_launch: occupancy query says %d\n", per_cu);
        (void)hipGetLastError();
        grid = cus;
    }
    if (grid < 0) return;
#ifdef EXTRA_PHASE
    {
        (void)hipMemsetAsync((char*)d_ws + WS_CTL, 0, CTL_ZERO_BYTES, stream);
        Args x{}; for (int i = 0; i < 38; ++i) x.in[i] = (const float*)d_in[i];
        x.out = (float*)d_out; x.ws = (unsigned char*)d_ws; x.ph_lo = EXTRA_PHASE; x.ph_hi = EXTRA_PHASE + 1; x.li = 0;
        hipLaunchKernelGGL(fwd_kernel, dim3(grid), dim3(NTHR), LDS_BYTES, stream, x);
    }
#endif
    (void)hipMemsetAsync((char*)d_ws + WS_CTL, 0, CTL_ZERO_BYTES, stream);
    Args a{};
    for (int i = 0; i < 38; ++i) a.in[i] = (const float*)d_in[i];
    a.out = (float*)d_out; a.ws = (unsigned char*)d_ws;
    for (int li = 0; li < N_LAUNCHES; ++li) {
        a.ph_lo = (N_LAUNCHES == NPH) ? li : 0; a.ph_hi = (N_LAUNCHES == NPH) ? li + 1 : NPH; a.li = li;
        hipLaunchKernelGGL(fwd_kernel, dim3(grid), dim3(NTHR), LDS_BYTES, stream, a);
    }
}
```

```cpp
#define MK_N_LAUNCHES 1
#include <hip/hip_runtime.h>
#include <cstdio>
#include <cstdint>

#define LAS __attribute__((address_space(3)))
#define GAS __attribute__((address_space(1)))
typedef unsigned short bf16;
typedef short bf16x8 __attribute__((ext_vector_type(8)));
typedef float f32x4 __attribute__((ext_vector_type(4)));
typedef float f32x2 __attribute__((ext_vector_type(2)));
typedef unsigned u32x4 __attribute__((ext_vector_type(4)));
typedef unsigned u32x2 __attribute__((ext_vector_type(2)));
typedef GAS unsigned gu32;

constexpr int BATCH = 16, SEQ = 2048, DM = 1024, MTOK = BATCH * SEQ;
constexpr int HYC = 3072, DSSM = 2048, CONVD = 4096, NHEAD = 32, NGRP = 8, NSTATE = 128, INC = 11328;
constexpr int NE = 64, TOPK = 8, DEXP = 256, NEX = NE + 1;
constexpr float DN_ALPHA = 1.189207115002721f;
constexpr float LN_EPS = 1e-5f, RMS_EPS = 1e-5f, ROUTED_SCALE = 2.5f;
constexpr int NWAVES = 8, NTHR = 512;
constexpr int WIN_ROWS = 11520;

constexpr size_t MiB = 1u << 20;
constexpr size_t WS_CTL = 0, CTL_ZERO_BYTES = 256 * 1024;
constexpr size_t WS_WHYB = 1 * MiB, WS_WSSDB = 3 * MiB, WS_WOUT = 7 * MiB;
constexpr size_t WS_XB = 9 * MiB;
constexpr size_t WS_WINT = 73 * MiB;
constexpr size_t WS_KERN = 96 * MiB;
constexpr size_t WS_PTHY = 112 * MiB;
constexpr size_t WS_YTHY = 304 * MiB;
constexpr size_t WS_YHY = 137 * MiB;
constexpr size_t WS_XBC = 201 * MiB;
constexpr size_t WS_DT = 457 * MiB;
constexpr size_t WS_HALO = 465 * MiB;
constexpr size_t WS_YSSD = 9 * MiB;
constexpr size_t WS_XB2 = 201 * MiB;
constexpr size_t WS_WING = 505 * MiB;
constexpr size_t WS_G = 269 * MiB;
constexpr size_t WS_MIX = 397 * MiB;
constexpr int H1B_PITCH = 2048;
constexpr size_t WS_EW1 = 9 * MiB;
constexpr size_t WS_EW2 = 477 * MiB;
constexpr size_t WS_YQ = 1 * MiB;
constexpr size_t WS_ASG = 510 * MiB;
constexpr size_t WS_H1P = 177 * MiB;
constexpr size_t WS_HID = 305 * MiB;
constexpr size_t WS_TOK = 461 * MiB;
constexpr size_t WS_WGT = 469 * MiB;
constexpr size_t WS_END = 511 * MiB;
constexpr size_t OUT_XB = 64 * MiB;
constexpr int CW_BAR = 4096;
constexpr int CW_CNT = 16384;
constexpr int CW_DBG = 32768;

constexpr int LDS_BYTES = 163840;
constexpr int MISC_OFF = 163840 - 512;

#define RLX_AGENT __ATOMIC_RELAXED, __HIP_MEMORY_SCOPE_AGENT
#define LDS_WAIT() asm volatile("s_waitcnt lgkmcnt(0)" ::: "memory")
#define VM_WAIT() asm volatile("s_waitcnt vmcnt(0)" ::: "memory")
typedef __bf16 bf16x2_t __attribute__((ext_vector_type(2)));
__device__ __forceinline__ unsigned pk2(float lo, float hi) { const f32x2 v = {lo, hi}; return __builtin_bit_cast(unsigned, __builtin_convertvector(v, bf16x2_t)); }
__device__ __forceinline__ unsigned f2bf(float f) { return pk2(f, 0.f) & 0xffffu; }
__device__ __forceinline__ float bf2f(unsigned b) { return __builtin_bit_cast(float, b << 16); }
__device__ __forceinline__ float bflo(unsigned w) { return __builtin_bit_cast(float, w << 16); }
__device__ __forceinline__ float bfhi(unsigned w) { return __builtin_bit_cast(float, w & 0xffff0000u); }
__device__ __forceinline__ float sigmoidf_(float v) { return __builtin_amdgcn_rcpf(1.0f + __expf(-v)); }
__device__ __forceinline__ float siluf_(float v) { return v * __builtin_amdgcn_rcpf(1.0f + __expf(-v)); }
__device__ __forceinline__ float wave_sum(float v) {
#pragma unroll
    for (int o = 1; o < 64; o <<= 1) v += __shfl_xor(v, o);
    return v;
}
__device__ __forceinline__ float wave_max(float v) {
#pragma unroll
    for (int o = 1; o < 64; o <<= 1) v = fmaxf(v, __shfl_xor(v, o));
    return v;
}

#ifndef PG8_WGM
#define PG8_WGM 8
#endif
namespace pg8 {
constexpr int BM = 256, BK = 64, HALF = 128, HTB = HALF * BK * 2, STAGE_BYTES = 8 * HTB, NXCD = 8, WGM = PG8_WGM;
__host__ __device__ __forceinline__ int lds_byte(int r, int c) { const int st = (r >> 4) * 2 + (c >> 5), rr = r & 15, cc = c & 31, ob = rr * 64 + cc * 2; return st * 1024 + (ob ^ (((ob >> 9) & 1) << 5)); }
__host__ __device__ __forceinline__ void stage_rc(int b, int& R, int& C) { const int st = b / 1024, sb = b % 1024, swz = sb ^ (((sb >> 9) & 1) << 5); R = (st >> 1) * 16 + swz / 64; C = (st & 1) * 32 + (swz % 64) / 2; }
__host__ __device__ __forceinline__ int perm32(int rho) { const int n = rho >> 4, i = rho & 15; return 8 * (i >> 2) + 4 * n + (i & 3); }

struct Unit { int pm, pn; const char* A; const char* B; int e, cnt; };

struct StaticOrder {
    int nM, nN, nwg, G, c, K; const char* A; const char* B;
    __device__ void init(const bf16* A_, const bf16* B_, int M, int N, int K_, int G_, int c_) { A = (const char*)A_; B = (const char*)B_; nM = M / BM; nN = N / BM; nwg = nM * nN; G = G_; c = c_; K = K_; }
    __device__ __forceinline__ bool next(int i, Unit& u) const {
        const long L = (long)i * G + c; if (L >= nwg) return false;
        int wgid = (int)L; { const int q = nwg / NXCD, r = nwg % NXCD, xcd = wgid % NXCD, off = wgid / NXCD; wgid = (xcd < r ? xcd * (q + 1) : r * (q + 1) + (xcd - r) * q) + off; }
        const int nig = WGM * nN, gid = wgid / nig, fm = gid * WGM, gsz = (nM - fm) < WGM ? (nM - fm) : WGM;
        u.pm = fm + ((wgid % nig) % gsz); u.pn = (wgid % nig) / gsz;
        u.A = A + (size_t)u.pm * BM * K * 2; u.B = B + (size_t)u.pn * BM * K * 2; u.e = 0; u.cnt = 0; return true;
    }
    __device__ __forceinline__ unsigned row_off(const Unit&, int) const { return 0u; }
};

__device__ __forceinline__ unsigned cvt_pk_bf16(float lo, float hi) { unsigned r; asm volatile("v_cvt_pk_bf16_f32 %0, %1, %2" : "=v"(r) : "v"(lo), "v"(hi)); return r; }

#ifndef PG8_SP2
#define PG8_SP2 true
#endif
#ifndef PG8_ALIGN
#define PG8_ALIGN true
#endif
template <class Epi, class Sched, bool GATHER, bool SP2 = PG8_SP2, bool ALIGN_EPI = PG8_ALIGN>
__device__ __forceinline__ void gemm_phase(LAS unsigned char* lds, const int K, const Sched& S, const Epi& E) {
    constexpr bool TA = Epi::TA;
    const int tid = threadIdx.x, wid = __builtin_amdgcn_readfirstlane(tid >> 6), lane = tid & 63, wr = wid >> 2, wc = wid & 3, fr = lane & 15, fq = lane >> 4;
    const int nt = K / BK;
    unsigned voffA[2][2], voffB[2]; int RA[2], CA[2];
#pragma unroll
    for (int i = 0; i < 2; ++i) { int R, C; stage_rc(tid * 16 + i * 8192, R, C);
        const int Rb = Epi::PERM == 3 ? (64 * (R >> 5) + 16 * ((R & 15) >> 2) + 4 * ((R >> 4) & 1) + (R & 3)) : (Epi::PERM ? ((R & ~31) + perm32(R & 31)) : R);
        RA[i] = R; CA[i] = C; voffA[0][i] = (unsigned)(R * K + C) * 2u; voffA[1][i] = voffA[0][i]; voffB[i] = (unsigned)(Rb * K + C) * 2u; }
    const size_t kstep = (size_t)(BK * 2);
    const size_t hstep = (size_t)HALF * K * 2;
    const size_t hstepA = GATHER ? 0 : hstep;
    const size_t hstepB = (Epi::PERM == 3) ? (size_t)8 * K * 2 : hstep;
    const unsigned ldsw = (unsigned)wid * 1024u;
    const int aoff = lds_byte(wr * 64 + fr, fq * 8), boff = lds_byte(wc * 32 + fr, fq * 8);
#define PG8_SA(b, h) (((b) * 2 + (h)) * HTB)
#define PG8_SB(b, h) ((4 + (b) * 2 + (h)) * HTB)
#define PG8_STAGE(bufoff, gbase, voff) do { _Pragma("unroll") for (int _i = 0; _i < 2; ++_i) \
        __builtin_amdgcn_global_load_lds((const unsigned*)((const char*)(gbase) + (voff)[_i]), (LAS unsigned*)(lds + (bufoff) + ldsw + _i * 8192), 16, 0, 0); } while (0)
#define PG8_STAGE_A(bufoff, gbase, h) PG8_STAGE(bufoff, (gbase) + (h) * hstepA, voffA[GATHER ? (h) : 0])
#define PG8_LDA(dst, b, h) do { _Pragma("unroll") for (int m = 0; m < 4; ++m) _Pragma("unroll") for (int k = 0; k < 2; ++k) dst[m][k] = *(const LAS bf16x8*)(lds + PG8_SA(b, h) + aoff + m * 2048 + k * 1024); } while (0)
#define PG8_LDB(dst, b, h) do { _Pragma("unroll") for (int n = 0; n < 2; ++n) _Pragma("unroll") for (int k = 0; k < 2; ++k) dst[n][k] = *(const LAS bf16x8*)(lds + PG8_SB(b, h) + boff + n * 2048 + k * 1024); } while (0)
#define PG8_MMA(ai, bj, At, Bt) do { __builtin_amdgcn_s_setprio(1); _Pragma("unroll") for (int m = 0; m < 4; ++m) _Pragma("unroll") for (int n = 0; n < 2; ++n) _Pragma("unroll") for (int k = 0; k < 2; ++k) \
        acc[ai][bj][m][n] = TA ? __builtin_amdgcn_mfma_f32_16x16x32_bf16(Bt[n][k], At[m][k], acc[ai][bj][m][n], 0, 0, 0) \
                               : __builtin_amdgcn_mfma_f32_16x16x32_bf16(At[m][k], Bt[n][k], acc[ai][bj][m][n], 0, 0, 0); __builtin_amdgcn_s_setprio(0); } while (0)
#define PG8_WAIT_V(n) asm volatile("s_waitcnt vmcnt(" #n ")" ::: "memory")
#define PG8_WAIT_L(n) asm volatile("s_waitcnt lgkmcnt(" #n ")" ::: "memory")
#define PG8_BAR __builtin_amdgcn_s_barrier()
#define PG8_SCHED __builtin_amdgcn_sched_barrier(0)
    Unit cur, nxt; int ui = 0;
    if (!S.next(0, cur)) return;
    if (GATHER) {
#pragma unroll
        for (int h = 0; h < 2; ++h)
#pragma unroll
            for (int i = 0; i < 2; ++i) voffA[h][i] = S.row_off(cur, h * HALF + RA[i]) + (unsigned)CA[i] * 2u;
    }
    f32x4 acc[2][2][4][2];
#pragma unroll
    for (int a = 0; a < 2; ++a)
#pragma unroll
        for (int b = 0; b < 2; ++b)
#pragma unroll
            for (int m = 0; m < 4; ++m)
#pragma unroll
                for (int n = 0; n < 2; ++n) acc[a][b][m][n] = (f32x4){0.f, 0.f, 0.f, 0.f};
    bf16x8 At[4][2], B0[2][2], B1[2][2];
    const char* cA = cur.A; const char* cB = cur.B;
    if constexpr (SP2) {
        PG8_STAGE(PG8_SB(0, 0), cB, voffB); PG8_STAGE(PG8_SB(0, 1), cB + hstepB, voffB); PG8_STAGE_A(PG8_SA(0, 0), cA, 0); PG8_STAGE_A(PG8_SA(0, 1), cA, 1);
        if (wr == 1) PG8_BAR;
        PG8_WAIT_V(2); PG8_BAR;
        PG8_STAGE(PG8_SB(1, 0), cB + kstep, voffB); PG8_STAGE_A(PG8_SA(1, 0), cA + kstep, 0); PG8_STAGE(PG8_SB(1, 1), cB + hstepB + kstep, voffB);
        PG8_WAIT_V(6); PG8_BAR;
    } else {
    PG8_STAGE(PG8_SB(0, 0), cB, voffB); PG8_STAGE_A(PG8_SA(0, 0), cA, 0); PG8_STAGE(PG8_SB(0, 1), cB + hstepB, voffB); PG8_STAGE_A(PG8_SA(0, 1), cA, 1);
    if (wr == 1) PG8_BAR;
    PG8_WAIT_V(4); PG8_BAR;
    PG8_STAGE(PG8_SB(1, 0), cB + kstep, voffB); PG8_STAGE_A(PG8_SA(1, 0), cA + kstep, 0); PG8_STAGE(PG8_SB(1, 1), cB + hstepB + kstep, voffB);
    PG8_WAIT_V(6); PG8_BAR;
    }
    for (;;) {
        const bool has_next = S.next(ui + 1, nxt);
        const char* nA = has_next ? nxt.A : cA; const char* nB = has_next ? nxt.B : cB;
        for (int t = 0; t < nt; t += 2) {
            const bool last = (t == nt - 2);
            const char* a1 = cA + (size_t)(t + 1) * kstep;
            const char* a2 = last ? nA : cA + (size_t)(t + 2) * kstep; const char* b2 = last ? nB : cB + (size_t)(t + 2) * kstep;
            const char* a3 = a2 + kstep; const char* b3 = b2 + kstep;
            if constexpr (SP2) {
            PG8_LDB(B0, 0, 0); PG8_LDB(B1, 0, 1); PG8_SCHED; PG8_LDA(At, 0, 0); PG8_STAGE_A(PG8_SA(1, 1), a1, 1);
            PG8_WAIT_V(8); PG8_WAIT_L(0); PG8_BAR; PG8_MMA(0, 0, At, B0); PG8_MMA(0, 1, At, B1); PG8_BAR; PG8_SCHED;
            if (GATHER) { if (last && has_next) {
#pragma unroll
                for (int h = 0; h < 2; ++h)
#pragma unroll
                    for (int i = 0; i < 2; ++i) voffA[h][i] = S.row_off(nxt, h * HALF + RA[i]) + (unsigned)CA[i] * 2u;
            } }
            PG8_LDA(At, 0, 1); PG8_STAGE(PG8_SB(0, 0), b2, voffB); PG8_STAGE(PG8_SB(0, 1), b2 + hstepB, voffB); PG8_STAGE_A(PG8_SA(0, 0), a2, 0);
            PG8_WAIT_V(8); PG8_WAIT_L(0); PG8_BAR; PG8_MMA(1, 0, At, B0); PG8_MMA(1, 1, At, B1); PG8_BAR; PG8_SCHED;
            PG8_LDB(B0, 1, 0); PG8_LDB(B1, 1, 1); PG8_SCHED; PG8_LDA(At, 1, 0); PG8_STAGE_A(PG8_SA(0, 1), a2, 1);
            PG8_WAIT_V(8); PG8_WAIT_L(0); PG8_BAR; PG8_MMA(0, 0, At, B0); PG8_MMA(0, 1, At, B1); PG8_BAR; PG8_SCHED;
            PG8_LDA(At, 1, 1); PG8_STAGE(PG8_SB(1, 0), b3, voffB); PG8_STAGE(PG8_SB(1, 1), b3 + hstepB, voffB); PG8_STAGE_A(PG8_SA(1, 0), a3, 0);
            PG8_WAIT_V(8); PG8_WAIT_L(0); PG8_BAR; PG8_MMA(1, 0, At, B0); PG8_MMA(1, 1, At, B1); PG8_BAR; PG8_SCHED;
            } else {
            PG8_LDB(B0, 0, 0); PG8_SCHED; PG8_LDA(At, 0, 0); PG8_STAGE_A(PG8_SA(1, 1), a1, 1);
            PG8_WAIT_L(8); PG8_BAR; PG8_WAIT_L(0); PG8_MMA(0, 0, At, B0); PG8_BAR; PG8_SCHED;
            if (GATHER) { if (last && has_next) {
#pragma unroll
                for (int h = 0; h < 2; ++h)
#pragma unroll
                    for (int i = 0; i < 2; ++i) voffA[h][i] = S.row_off(nxt, h * HALF + RA[i]) + (unsigned)CA[i] * 2u;
            } }
            PG8_LDB(B1, 0, 1); PG8_STAGE(PG8_SB(0, 0), b2, voffB);
            PG8_BAR; PG8_WAIT_L(0); PG8_MMA(0, 1, At, B1); PG8_BAR;
            PG8_LDA(At, 0, 1); PG8_STAGE_A(PG8_SA(0, 0), a2, 0);
            PG8_BAR; PG8_WAIT_L(0); PG8_MMA(1, 0, At, B0); PG8_BAR; PG8_SCHED;
            PG8_STAGE(PG8_SB(0, 1), b2 + hstepB, voffB);
            PG8_WAIT_V(6); PG8_BAR; PG8_MMA(1, 1, At, B1); PG8_BAR;
            PG8_LDB(B0, 1, 0); PG8_SCHED; PG8_LDA(At, 1, 0); PG8_STAGE_A(PG8_SA(0, 1), a2, 1);
            PG8_WAIT_L(8); PG8_BAR; PG8_WAIT_L(0); PG8_MMA(0, 0, At, B0); PG8_BAR; PG8_SCHED;
            PG8_LDB(B1, 1, 1); PG8_STAGE(PG8_SB(1, 0), b3, voffB);
            PG8_BAR; PG8_WAIT_L(0); PG8_MMA(0, 1, At, B1); PG8_BAR;
            PG8_LDA(At, 1, 1); PG8_STAGE_A(PG8_SA(1, 0), a3, 0);
            PG8_BAR; PG8_WAIT_L(0); PG8_MMA(1, 0, At, B0); PG8_BAR; PG8_SCHED;
            PG8_STAGE(PG8_SB(1, 1), b3 + hstepB, voffB);
            PG8_WAIT_V(6); PG8_BAR; PG8_MMA(1, 1, At, B1); PG8_BAR;
                    }
        }
        if constexpr (ALIGN_EPI) { if (wr == 0) PG8_BAR; }
        E(acc, cur, wr, wc, fr, fq);
        if (!has_next) break;
#pragma unroll
        for (int a = 0; a < 2; ++a)
#pragma unroll
            for (int b = 0; b < 2; ++b)
#pragma unroll
                for (int m = 0; m < 4; ++m)
#pragma unroll
                    for (int n = 0; n < 2; ++n) acc[a][b][m][n] = (f32x4){0.f, 0.f, 0.f, 0.f};
        cur = nxt; cA = nA; cB = nB; ++ui;
        if constexpr (ALIGN_EPI) { if (wr == 1) PG8_BAR; }
    }
    PG8_WAIT_V(0);
    if constexpr (!ALIGN_EPI) { if (wr == 0) PG8_BAR; }
    PG8_BAR;
#undef PG8_SA
#undef PG8_SB
#undef PG8_STAGE
#undef PG8_STAGE_A
#undef PG8_LDA
#undef PG8_LDB
#undef PG8_MMA
#undef PG8_WAIT_V
#undef PG8_WAIT_L
#undef PG8_BAR
#undef PG8_SCHED
}
}

namespace pg8 {
struct EpiHyT {
    static constexpr bool TA = false; static constexpr int PERM = 0;
    bf16* PT; const float* bias; LAS unsigned char* scr;
    __device__ __forceinline__ void operator()(const f32x4 (&acc)[2][2][4][2], const Unit& u, int wr, int wc, int fr, int fq) const {
        const int lane = fq * 16 + fr, lc = lane >> 3, lp = lane & 7;
        LAS unsigned char* s = scr + (wr * 4 + wc) * 2304;
        LAS unsigned char* wp = s + fr * 144 + 8 * fq;
        const LAS unsigned char* rp = s + lc * 144 + 16 * lp;
#pragma unroll
        for (int bj = 0; bj < 2; ++bj)
#pragma unroll
            for (int n = 0; n < 2; ++n) {
                const int col0 = u.pn * BM + bj * HALF + wc * 32 + n * 16; const float bv = bias[col0 + fr];
                bf16* gp = PT + (size_t)(col0 + lc) * MTOK + u.pm * BM + wr * 64 + 8 * lp;
#pragma unroll
                for (int ai = 0; ai < 2; ++ai) {
#pragma unroll
                    for (int m = 0; m < 4; ++m) { const f32x4 v = acc[ai][bj][m][n] + bv; u32x2 w; w.x = cvt_pk_bf16(v[0], v[1]); w.y = cvt_pk_bf16(v[2], v[3]);
                        *(LAS u32x2*)(wp + 32 * m) = w; }
                    const u32x4 r0 = *(const LAS u32x4*)rp, r1 = *(const LAS u32x4*)(rp + 8 * 144);
                    *(u32x4*)(gp + ai * HALF) = r0; *(u32x4*)(gp + ai * HALF + (size_t)8 * MTOK) = r1; }
            }
    }
};
struct EpiZXD {
    static constexpr bool TA = true; static constexpr int PERM = 1;
    unsigned char* Z8; bf16* XBC; float* DT; const float* b_in; bf16* HALO;
    __device__ __forceinline__ void operator()(const f32x4 (&acc)[2][2][4][2], const Unit& u, int wr, int wc, int fr, int fq) const {
        const int row0 = u.pm * BM + wr * 64 + fr;
        if (u.pn == 24) {
            if (wc < 2) {
                const int c0 = wc * 32 + 8 * fq;
#pragma unroll
                for (int n = 0; n < 2; ++n) { const f32x4 bv = *(const f32x4*)(b_in + 9216 + c0 + 4 * n);
#pragma unroll
                    for (int ai = 0; ai < 2; ++ai)
#pragma unroll
                        for (int m = 0; m < 4; ++m) *(f32x4*)(DT + (size_t)(row0 + ai * HALF + m * 16) * 64 + c0 + 4 * n) = acc[ai][0][m][n] + bv; }
            }
            return;
        }
        if (u.pn < 8) {
            const int col0z = u.pn * BM + wc * 32 + 8 * fq;
#pragma unroll
            for (int bj = 0; bj < 2; ++bj) { const f32x4 b0 = *(const f32x4*)(b_in + 3072 + col0z + bj * HALF), b1 = *(const f32x4*)(b_in + 3072 + col0z + bj * HALF + 4);
#pragma unroll
                for (int ai = 0; ai < 2; ++ai)
#pragma unroll
                    for (int m = 0; m < 4; ++m) { const f32x4 v0 = acc[ai][bj][m][0] + b0, v1 = acc[ai][bj][m][1] + b1;
                        int w0 = __builtin_amdgcn_cvt_pk_fp8_f32(v0[0], v0[1], 0, false); w0 = __builtin_amdgcn_cvt_pk_fp8_f32(v0[2], v0[3], w0, true);
                        int w1 = __builtin_amdgcn_cvt_pk_fp8_f32(v1[0], v1[1], 0, false); w1 = __builtin_amdgcn_cvt_pk_fp8_f32(v1[2], v1[3], w1, true);
                        u32x2 w; w.x = (unsigned)w0; w.y = (unsigned)w1;
                        *(u32x2*)(Z8 + (size_t)(row0 + ai * HALF + m * 16) * DSSM + col0z + bj * HALF) = w; } }
            return;
        }
        bf16* base = XBC; const int ldc = CONVD, colt = (u.pn - 8) * BM, bcol = 5120 + colt;
        const int col0 = colt + wc * 32 + 8 * fq, bcol0 = bcol + wc * 32 + 8 * fq;
        f32x4 bv[2][2];
#pragma unroll
        for (int bj = 0; bj < 2; ++bj)
#pragma unroll
            for (int n = 0; n < 2; ++n) bv[bj][n] = *(const f32x4*)(b_in + bcol0 + bj * HALF + 4 * n);
#pragma unroll
        for (int ai = 0; ai < 2; ++ai)
#pragma unroll
            for (int m = 0; m < 4; ++m) { bf16* rowp = base + (size_t)(row0 + ai * HALF + m * 16) * ldc + col0;
#pragma unroll
                for (int bj = 0; bj < 2; ++bj) { const f32x4 v0 = acc[ai][bj][m][0] + bv[bj][0], v1 = acc[ai][bj][m][1] + bv[bj][1];
                    u32x4 w; w.x = cvt_pk_bf16(v0[0], v0[1]); w.y = cvt_pk_bf16(v0[2], v0[3]); w.z = cvt_pk_bf16(v1[0], v1[1]); w.w = cvt_pk_bf16(v1[2], v1[3]);
                    *(u32x4*)(rowp + bj * HALF) = w;
                    if ((m == 3 && fr >= 14) || (m == 0 && fr < 2)) {
                        const int row = row0 + ai * HALF + m * 16, bb = row >> 11, t = row & 2047, tm = t & 63;
                        const int jb = (tm >= 62) ? (t >> 6) + 1 : (t >> 6), idx = (tm >= 62) ? tm - 62 : 2 + tm;
                        *(u32x4*)(HALO + ((size_t)(bb * 33 + jb) * 4 + idx) * CONVD + col0 + bj * HALF) = w; } } }
    }
};
template <int MODE> struct EpiBf {
    static constexpr bool TA = true; static constexpr int PERM = 1;
    bf16* O; int ldc; const float* bias; const bf16* G1; int ldg; const bf16* P;
    __device__ __forceinline__ void operator()(const f32x4 (&acc)[2][2][4][2], const Unit& u, int wr, int wc, int fr, int fq) const {
        const int row0 = u.pm * BM + wr * 64 + fr, col0 = u.pn * BM + wc * 32 + 8 * fq;
#pragma unroll
        for (int ai = 0; ai < 2; ++ai)
#pragma unroll
            for (int m = 0; m < 4; ++m) { const size_t r = (size_t)(row0 + ai * HALF + m * 16);
#pragma unroll
                for (int bj = 0; bj < 2; ++bj) { f32x4 v0 = acc[ai][bj][m][0], v1 = acc[ai][bj][m][1]; const int c = col0 + bj * HALF;
                    if (MODE == 0) { const f32x4 b0 = *(const f32x4*)(bias + c), b1 = *(const f32x4*)(bias + c + 4); v0 = v0 + b0; v1 = v1 + b1;
#pragma unroll
                        for (int j = 0; j < 4; ++j) { v0[j] = sigmoidf_(v0[j]); v1[j] = sigmoidf_(v1[j]); } }
                    else { const u32x4 g = *(const u32x4*)(G1 + r * ldg + c);
                        v0[0] *= bflo(g.x); v0[1] *= bfhi(g.x); v0[2] *= bflo(g.y); v0[3] *= bfhi(g.y); v1[0] *= bflo(g.z); v1[1] *= bfhi(g.z); v1[2] *= bflo(g.w); v1[3] *= bfhi(g.w);
                        if (MODE == 2) { const u32x4 p = *(const u32x4*)(P + r * ldc + c);
                            v0[0] += bflo(p.x); v0[1] += bfhi(p.x); v0[2] += bflo(p.y); v0[3] += bfhi(p.y); v1[0] += bflo(p.z); v1[1] += bfhi(p.z); v1[2] += bflo(p.w); v1[3] += bfhi(p.w); } }
                    u32x4 w; w.x = cvt_pk_bf16(v0[0], v0[1]); w.y = cvt_pk_bf16(v0[2], v0[3]); w.z = cvt_pk_bf16(v1[0], v1[1]); w.w = cvt_pk_bf16(v1[2], v1[3]);
                    *(u32x4*)(O + r * ldc + c) = w; } }
    }
};
struct EpiRes {
    static constexpr bool TA = true; static constexpr int PERM = 1;
    bf16* O; const float* bias; const bf16* X; float alpha;
    __device__ __forceinline__ void operator()(const f32x4 (&acc)[2][2][4][2], const Unit& u, int wr, int wc, int fr, int fq) const {
        const int row0 = u.pm * BM + wr * 64 + fr, col0 = u.pn * BM + wc * 32 + 8 * fq;
#pragma unroll
        for (int ai = 0; ai < 2; ++ai)
#pragma unroll
            for (int m = 0; m < 4; ++m) { const size_t off = (size_t)(row0 + ai * HALF + m * 16) * DM + col0;
#pragma unroll
                for (int bj = 0; bj < 2; ++bj) { const u32x4 xv = *(const u32x4*)(X + off + bj * HALF); const f32x4 b0 = *(const f32x4*)(bias + col0 + bj * HALF), b1 = *(const f32x4*)(bias + col0 + bj * HALF + 4);
                    f32x4 v0 = acc[ai][bj][m][0] + b0, v1 = acc[ai][bj][m][1] + b1;
                    v0[0] += alpha * bflo(xv.x); v0[1] += alpha * bfhi(xv.x); v0[2] += alpha * bflo(xv.y); v0[3] += alpha * bfhi(xv.y);
                    v1[0] += alpha * bflo(xv.z); v1[1] += alpha * bfhi(xv.z); v1[2] += alpha * bflo(xv.w); v1[3] += alpha * bfhi(xv.w);
                    u32x4 w; w.x = cvt_pk_bf16(v0[0], v0[1]); w.y = cvt_pk_bf16(v0[2], v0[3]); w.z = cvt_pk_bf16(v1[0], v1[1]); w.w = cvt_pk_bf16(v1[2], v1[3]);
                    *(u32x4*)(O + off + bj * HALF) = w; } }
    }
};
struct EpiSwiGLU {
    static constexpr bool TA = true; static constexpr int PERM = 1;
    bf16* HID;
    __device__ __forceinline__ void operator()(const f32x4 (&acc)[2][2][4][2], const Unit& u, int wr, int wc, int fr, int fq) const {
        const int row0 = u.pm * BM + wr * 64 + fr, col0 = u.pn * HALF + wc * 32 + 8 * fq;
#pragma unroll
        for (int ai = 0; ai < 2; ++ai)
#pragma unroll
            for (int m = 0; m < 4; ++m) { f32x4 v0, v1;
#pragma unroll
                for (int j = 0; j < 4; ++j) { v0[j] = siluf_(acc[ai][0][m][0][j]) * acc[ai][1][m][0][j]; v1[j] = siluf_(acc[ai][0][m][1][j]) * acc[ai][1][m][1][j]; }
                u32x4 w; w.x = cvt_pk_bf16(v0[0], v0[1]); w.y = cvt_pk_bf16(v0[2], v0[3]); w.z = cvt_pk_bf16(v1[0], v1[1]); w.w = cvt_pk_bf16(v1[2], v1[3]);
                *(u32x4*)(HID + (size_t)(row0 + ai * HALF + m * 16) * DEXP + col0) = w; }
    }
};
struct EpiScatter {
    static constexpr bool TA = false; static constexpr int PERM = 0;
    float* ACC; const int* tok; const float* wgt; int j0_unused;
    __device__ __forceinline__ void operator()(const f32x4 (&acc)[2][2][4][2], const Unit& u, int wr, int wc, int fr, int fq) const {
        asm volatile("" : "+v"(fr), "+v"(fq));
        const int jt = u.pn >> 2, ct = u.pn & 3;
#pragma unroll
        for (int ai = 0; ai < 2; ++ai)
#pragma unroll
            for (int m = 0; m < 4; ++m)
#pragma unroll
                for (int j = 0; j < 4; ++j) { const int r = ai * HALF + wr * 64 + m * 16 + 4 * fq + j;
                    if (r < u.cnt) { int token; float w;
                        if (u.e == NE) { token = jt * BM + r; w = 1.0f; } else { const size_t li = (size_t)u.e * MTOK + (size_t)jt * BM + r; token = tok[li]; w = wgt[li]; }
                        float* rowp = ACC + (size_t)token * DM + ct * BM + wc * 32 + fr;
#pragma unroll
                        for (int bj = 0; bj < 2; ++bj)
#pragma unroll
                            for (int n = 0; n < 2; ++n) unsafeAtomicAdd(rowp + bj * HALF + n * 16, w * acc[ai][bj][m][n][j]);
                    }
                    asm volatile("" ::: "memory"); }
    }
};

struct EpiSlot8 {
    static constexpr bool TA = true; static constexpr int PERM = 3;
    unsigned char* YQ;
    __device__ __forceinline__ void operator()(const f32x4 (&acc)[2][2][4][2], const Unit& u, int wr, int wc, int fr, int fq) const {
        asm volatile("" : "+v"(fr), "+v"(fq));
        const int row0 = u.pm * BM + wr * 64 + fr, col0 = u.pn * 256 + wc * 64 + 16 * fq;
#pragma unroll
        for (int ai = 0; ai < 2; ++ai)
#pragma unroll
            for (int m = 0; m < 4; ++m) { u32x4 w;
#pragma unroll
                for (int bj = 0; bj < 2; ++bj) { const f32x4 v0 = acc[ai][bj][m][0], v1 = acc[ai][bj][m][1];
                    int w0 = __builtin_amdgcn_cvt_pk_fp8_f32(v0[0], v0[1], 0, false); w0 = __builtin_amdgcn_cvt_pk_fp8_f32(v0[2], v0[3], w0, true);
                    int w1 = __builtin_amdgcn_cvt_pk_fp8_f32(v1[0], v1[1], 0, false); w1 = __builtin_amdgcn_cvt_pk_fp8_f32(v1[2], v1[3], w1, true);
                    if (bj == 0) { w.x = (unsigned)w0; w.y = (unsigned)w1; } else { w.z = (unsigned)w0; w.w = (unsigned)w1; } }
                *(u32x4*)(YQ + (size_t)(row0 + ai * HALF + m * 16) * 1024 + col0) = w; }
    }
};
struct SlotOrder4 {
    const LAS int* tp; const LAS int* te; int G, c, total; const char* A; const char* W;
    __device__ __forceinline__ bool next(int i, Unit& u) const {
        int tile, q;
        if (G == 256) { const int cx = c & 7, cj = c >> 3; q = cj & 3; tile = i * 64 + (cj >> 2) * 8 + cx; }
        else { const long L = (long)i * G + c; tile = (int)(L >> 2); q = (int)(L & 3); }
        if (tile >= total) return false;
        const int e = te[tile];
        u.e = e; u.cnt = 0; u.pm = tile; u.pn = q; u.A = A + (size_t)tile * BM * DEXP * 2; u.B = W + ((size_t)e * DM + (size_t)q * 256) * DEXP * 2;
        return true;
    }
    __device__ __forceinline__ unsigned row_off(const Unit&, int) const { return 0u; }
};
template <int NCT, bool FIRST> struct MoeOrder {
    const LAS int* tp; const LAS int* cnt; const LAS int* te; int G, c, total;
    const char* A; const char* W; const int* tok;
    __device__ __forceinline__ bool next(int i, Unit& u) const {
        const long L = (long)i * G + c; if (L >= (long)total * NCT) return false;
        const int tile = (int)(L / NCT), ct = (int)(L % NCT);
        const int e = te[tile];
        const int jt = tile - tp[e];
        u.e = e; const int left = cnt[e] - jt * BM; u.cnt = left < BM ? left : BM;
        if (FIRST) { u.pm = tile; u.pn = ct; u.A = A; u.B = W + ((size_t)e * 512 + (size_t)ct * 256) * DM * 2; }
        else { u.pm = tile; u.pn = jt * 4 + ct; u.A = A + (size_t)tile * BM * DEXP * 2; u.B = W + ((size_t)e * DM + (size_t)ct * 256) * DEXP * 2; }
        return true;
    }
    __device__ __forceinline__ unsigned row_off(const Unit& u, int r) const {
        const int jt = u.pm - tp[u.e]; int token;
        if (u.e == NE) token = jt * BM + r; else token = (r < u.cnt) ? tok[(size_t)u.e * MTOK + (size_t)jt * BM + r] : 0;
        return (unsigned)token * (unsigned)(H1B_PITCH * 2);
    }
};
}

#define XB_TMO      128
#define XB_XCNT(j)  (256  + 64 * (j))
#define XB_XSUB(j)  (1280 + 64 * (j))
#define XB_XGEN(j)  (2304 + 64 * (j))
#define XB_TOP      3328
#define XB_TOPGEN   3392
#define XCD_BAR_WORDS 3456
#define XB_SPIN_CAP (1u << 18)
__device__ __forceinline__ unsigned xb_ld(unsigned* p)              { return __hip_atomic_load(p, __ATOMIC_RELAXED, __HIP_MEMORY_SCOPE_AGENT); }
__device__ __forceinline__ unsigned xb_add(unsigned* p, unsigned v) { return __hip_atomic_fetch_add(p, v, __ATOMIC_RELAXED, __HIP_MEMORY_SCOPE_AGENT); }
__device__ __forceinline__ unsigned xb_xcc_id() { return (unsigned)__builtin_amdgcn_s_getreg((3 << 11) | 20) & 0xFu; }
#define XB_SPIN(cond, bar) do { unsigned _sp = 0; while (cond) { __builtin_amdgcn_s_sleep(1); \
    if ((++_sp & 255u) == 0u) { if (xb_ld(&(bar)[XB_TMO])) break; if (_sp > XB_SPIN_CAP) { atomicAdd(&(bar)[XB_TMO], 1u); break; } } } } while (0)
struct XcdBarrier { unsigned* bar; unsigned x; volatile LAS unsigned* st; };
__device__ __forceinline__ XcdBarrier xcd_barrier_post(unsigned* bar, volatile LAS unsigned* st) {
    XcdBarrier b; b.bar = bar; b.x = xb_xcc_id(); b.st = st;
    if (threadIdx.x == 0) (void)xb_add(&bar[XB_XCNT(b.x)], 1u);
    return b;
}
__device__ __forceinline__ void xcd_barrier_complete(unsigned* bar, unsigned x, unsigned& nloc, unsigned& nx) {
    const unsigned G = gridDim.x * gridDim.y * gridDim.z;
    unsigned sum, cnt, mine, sp = 0u;
    for (;;) {
        sum = 0u; cnt = 0u; mine = 0u;
#pragma unroll
        for (unsigned j = 0; j < 16; ++j) { const unsigned c = xb_ld(&bar[XB_XCNT(j)]); sum += c; cnt += (c > 0u) ? 1u : 0u; mine = (j == x) ? c : mine; }
        if (sum == G) break;
        __builtin_amdgcn_s_sleep(1);
        if ((++sp & 255u) == 0u) { if (xb_ld(&bar[XB_TMO])) break; if (sp > XB_SPIN_CAP) { atomicAdd(&bar[XB_TMO], 1u); break; } }
    }
    nloc = mine > 0u ? mine : 1u; nx = cnt > 0u ? cnt : 1u;
}
__device__ __forceinline__ void xcd_barrier(const XcdBarrier& b) {
    asm volatile("s_waitcnt vmcnt(0)" ::: "memory");
    __syncthreads();
    if (threadIdx.x == 0) {
        unsigned* bar = b.bar;
        __builtin_amdgcn_s_waitcnt(0);
        unsigned nloc = b.st[0], nx = b.st[1];
        if (nloc == 0u) { xcd_barrier_complete(bar, b.x, nloc, nx); b.st[0] = nloc; b.st[1] = nx; }
        const unsigned old = xb_add(&bar[XB_XSUB(b.x)], 1u);
        const unsigned gen = old / nloc;
        if (old + 1u == (gen + 1u) * nloc) {
            __builtin_amdgcn_fence(__ATOMIC_RELEASE, "agent");
            asm volatile("s_waitcnt vmcnt(0)" ::: "memory");
            const unsigned og = xb_add(&bar[XB_TOP], 1u);
            const unsigned tg = og / nx;
            if (og + 1u == (tg + 1u) * nx) xb_add(&bar[XB_TOPGEN], 1u);
            else XB_SPIN(xb_ld(&bar[XB_TOPGEN]) == tg, bar);
            __builtin_amdgcn_fence(__ATOMIC_ACQUIRE, "agent");
            xb_add(&bar[XB_XGEN(b.x)], 1u);
            asm volatile("s_waitcnt vmcnt(0)" ::: "memory");
        } else {
            XB_SPIN(xb_ld(&bar[XB_XGEN(b.x)]) == gen, bar);
            __builtin_amdgcn_fence(__ATOMIC_ACQUIRE, "agent");
            asm volatile("s_waitcnt vmcnt(0)" ::: "memory");
        }
    }
    __syncthreads();
}

struct Args {
    const float* in[38]; float* out; unsigned char* ws; int ph_lo, ph_hi, li, pad;
};
enum { I_X = 0, I_WIN, I_BIN, I_HCW, I_HCB, I_FW1, I_FB1, I_FF1, I_FW2, I_FB2, I_FF2, I_FW3, I_FB3, I_FF3, I_FW4, I_HBIAS,
       I_SCW, I_SCB, I_DTB, I_ALOG, I_SD, I_SNW, I_WHYB, I_WSSDB, I_WOUT, I_BOUT, I_LN1G, I_LN1B, I_RW, I_RB, I_EWG, I_EWU, I_EWD, I_SWG, I_SWU, I_SWD, I_LN2G, I_LN2B };
struct Frame {
    LAS unsigned char* lds; volatile LAS unsigned* MISC; gu32* ctl; unsigned char* ws;
    int tid, lane, wave, vcu, G;
    const float* const* in; float* out;
};

__device__ __forceinline__ void tr_item(const float* src, int ld_src, int k0, int c0, bf16* dst, int drow0, int ldd, LAS float* scr, int lane) {
    f32x4 ld[8];
#pragma unroll
    for (int i = 0; i < 8; ++i) ld[i] = *(const f32x4*)(src + (size_t)(k0 + 8 * i + (lane >> 3)) * ld_src + c0 + 4 * (lane & 7));
#pragma unroll
    for (int i = 0; i < 8; ++i) { LAS float* d = scr + (8 * i + (lane >> 3)) * 33 + 4 * (lane & 7); d[0] = ld[i][0]; d[1] = ld[i][1]; d[2] = ld[i][2]; d[3] = ld[i][3]; }
    LDS_WAIT(); asm volatile("" ::: "memory");
    const int c = lane & 7;
#pragma unroll
    for (int j = 0; j < 4; ++j) { const int n = (lane >> 3) + 8 * j; const LAS float* s = scr + (8 * c) * 33 + n;
        u32x4 o; o.x = pk2(s[0 * 33], s[1 * 33]); o.y = pk2(s[2 * 33], s[3 * 33]); o.z = pk2(s[4 * 33], s[5 * 33]); o.w = pk2(s[6 * 33], s[7 * 33]);
        *(u32x4*)(dst + (size_t)(drow0 + n) * ldd + k0 + 8 * c) = o; }
    LDS_WAIT(); asm volatile("" ::: "memory");
}
__device__ __forceinline__ void tr_matrix_item(const float* src, int ld_src, int K, int col_first, int ncols, bf16* dst, int drow_first, LAS float* scr, int it, int lane) {
    const int nblk = ncols / 32, kb = it / nblk, nb = it % nblk;
    tr_item(src, ld_src, kb * 64, col_first + nb * 32, dst, drow_first + nb * 32, K, scr, lane);
}
__device__ __forceinline__ void convert_x(Frame& F, const float* x, bf16* xb) {
    const size_t n8 = (size_t)MTOK * DM / 8; const size_t stride = (size_t)F.G * NTHR;
    for (size_t i = (size_t)F.vcu * NTHR + F.tid; i < n8; i += 4 * stride) {
        f32x4 a[4], b[4];
#pragma unroll
        for (int u = 0; u < 4; ++u) { const size_t k = (i + u * stride < n8) ? i + u * stride : i; a[u] = *(const f32x4*)(x + k * 8); b[u] = *(const f32x4*)(x + k * 8 + 4); }
#pragma unroll
        for (int u = 0; u < 4; ++u) { u32x4 o; o.x = pk2(a[u][0], a[u][1]); o.y = pk2(a[u][2], a[u][3]); o.z = pk2(b[u][0], b[u][1]); o.w = pk2(b[u][2], b[u][3]);
            if (i + u * stride < n8) *(u32x4*)(xb + (i + u * stride) * 8) = o; } }
}

__device__ __forceinline__ void hyena_filter(Frame& F) {
    const float* w1 = F.in[I_FW1]; const float* b1 = F.in[I_FB1]; const float* f1 = F.in[I_FF1];
    const float* w2 = F.in[I_FW2]; const float* b2 = F.in[I_FB2]; const float* f2 = F.in[I_FF2];
    const float* w3 = F.in[I_FW3]; const float* b3 = F.in[I_FB3]; const float* f3 = F.in[I_FF3];
    const float* w4 = F.in[I_FW4];
    bf16* KERN = (bf16*)(F.ws + WS_KERN);
    LAS float* hbuf = (LAS float*)(F.lds);
    const int lane = F.lane, wave = F.wave;
    for (int pg = F.vcu; pg < SEQ / 8; pg += F.G) {
        const int t = 8 * pg + wave;
        const float tn = (float)t / (float)(SEQ - 1), wv = 6.283185307179586f * (float)t / (float)SEQ;
        float zf = 0.f;
        if (lane == 0) zf = tn;
        else if (lane <= 16) { const float f = 1e-4f + (float)(lane - 1) * ((15.0f - 1e-4f) / 15.0f); zf = cosf(f * wv); }
        else if (lane <= 32) { const float f = 1e-4f + (float)(lane - 17) * ((15.0f - 1e-4f) / 15.0f); zf = -sinf(f * wv); }
        float s = b1[lane];
        for (int i = 0; i < 33; ++i) s += __shfl(zf, i) * w1[i * 64 + lane];
        float h = sinf(f1[lane] * s);
        s = b2[lane];
        for (int i = 0; i < 64; ++i) s += __shfl(h, i) * w2[i * 64 + lane];
        h = sinf(f2[lane] * s);
        s = b3[lane];
        for (int i = 0; i < 64; ++i) s += __shfl(h, i) * w3[i * 64 + lane];
        h = sinf(f3[lane] * s);
        hbuf[wave * 64 + lane] = h;
        __syncthreads();
        { float a[8][8];
#pragma unroll
          for (int q = 0; q < 8; ++q)
#pragma unroll
              for (int p = 0; p < 8; ++p) a[q][p] = 0.f;
          float a0b[4] = {0.f, 0.f, 0.f, 0.f};
#pragma unroll 2
          for (int i = 0; i < 64; ++i) { float wv[8], hv[8];
#pragma unroll
              for (int q = 0; q < 8; ++q) wv[q] = w4[(size_t)i * 4096 + F.tid + 512 * q];
#pragma unroll
              for (int p = 0; p < 8; ++p) hv[p] = hbuf[p * 64 + i];
#pragma unroll
              for (int q = 0; q < 8; ++q)
#pragma unroll
                  for (int p = 0; p < 8; ++p) a[q][p] += hv[p] * wv[q];
              if (pg == 0) { a0b[0] += hv[0] * wv[2]; a0b[1] += hv[0] * wv[3]; a0b[2] += hv[0] * wv[6]; a0b[3] += hv[0] * wv[7]; } }
#pragma unroll
          for (int q = 0; q < 8; ++q) { const int col = F.tid + 512 * q, c = col & 1023, dir = (q >> 1) & 1, o = q >> 2;
              const float adel = 3.0701134573253945f + (float)c * ((15.350567286626973f - 3.0701134573253945f) / 1023.0f);
              bf16* kc = KERN + ((size_t)c * 2 + o) * 4096;
#pragma unroll
              for (int p = 0; p < 8; ++p) { const int tp = 8 * pg + p; const float v = a[q][p] * __expf(-((float)tp / (float)(SEQ - 1)) * adel);
                  if (tp == 0) { if (dir == 0) { kc[2048] = (bf16)f2bf(v + a0b[(q & 1) + 2 * o]); kc[0] = 0; } }
                  else kc[dir == 0 ? 2048 - tp : 2048 + tp] = (bf16)f2bf(v); } } }
        __syncthreads();
    }
}

__device__ __forceinline__ void p0_prologue(Frame& F) {
    LAS float* scr = (LAS float*)(F.lds + 4096 + F.wave * 16384);
    const int gw = F.vcu * NWAVES + F.wave, NGW = F.G * NWAVES;
    const bool late_filter = (blockIdx.x & 1);
    bf16* WINT = (bf16*)(F.ws + WS_WINT);
    constexpr int I_A = 16 * (9216 / 32), I_B = 16 * (64 / 32), I_C = 16 * (2048 / 32);
    constexpr int I_HY = 16 * 32, I_SS = 32 * 32, I_OUT = 16 * 32;
    constexpr int NITEMS = I_A + I_B + I_C + I_HY + I_SS + I_OUT;
#pragma unroll 1
    for (int s_ = 0; s_ < 2; ++s_) {
    if ((s_ == 1) == late_filter) { hyena_filter(F); continue; }
    for (int it = gw; it < NITEMS; it += NGW) {
        int r = it;
        if (r < I_A) { tr_matrix_item(F.in[I_WIN], INC, DM, 0, 9216, WINT, 0, scr, r, F.lane); continue; } r -= I_A;
        if (r < I_B) { tr_matrix_item(F.in[I_WIN], INC, DM, 9216, 64, WINT, 9216, scr, r, F.lane); continue; } r -= I_B;
        if (r < I_C) { tr_matrix_item(F.in[I_WIN], INC, DM, 9280, 2048, (bf16*)(F.ws + WS_WING), 0, scr, r, F.lane); continue; } r -= I_C;
        if (r < I_HY) { tr_matrix_item(F.in[I_WHYB], DM, DM, 0, DM, (bf16*)(F.ws + WS_WHYB), 0, scr, r, F.lane); continue; } r -= I_HY;
        if (r < I_SS) { tr_matrix_item(F.in[I_WSSDB], DM, DSSM, 0, DM, (bf16*)(F.ws + WS_WSSDB), 0, scr, r, F.lane); continue; } r -= I_SS;
        tr_matrix_item(F.in[I_WOUT], DM, DM, 0, DM, (bf16*)(F.ws + WS_WOUT), 0, scr, r, F.lane);
    }
    convert_x(F, F.in[I_X], (bf16*)((unsigned char*)F.out + OUT_XB));
    __syncthreads();
    }
}
__device__ __forceinline__ void p6_reconvert(Frame& F) {
    LAS float* scr = (LAS float*)(F.lds + 4096 + F.wave * 16384);
    const int gw = F.vcu * NWAVES + F.wave, NGW = F.G * NWAVES;
    for (int it = gw; it < 16 * (2048 / 32); it += NGW) tr_matrix_item(F.in[I_WIN], INC, DM, 9280, 2048, (bf16*)(F.ws + WS_WING), 0, scr, it, F.lane);
    convert_x(F, F.in[I_X], (bf16*)(F.ws + WS_XB2));
}
__device__ __forceinline__ void p10_expert_weights(Frame& F) {
    LAS float* scr = (LAS float*)(F.lds + 4096 + F.wave * 16384);
    const int gw = F.vcu * NWAVES + F.wave, NGW = F.G * NWAVES;
    bf16* EW1 = (bf16*)(F.ws + WS_EW1); bf16* EW2 = (bf16*)(F.ws + WS_EW2);
    constexpr int PER1 = 16 * 4;
    constexpr int N1 = NEX * 2 * 2 * PER1, PER2 = 4 * 32, N2 = NEX * PER2;
    for (int it = gw; it < N1 + N2; it += NGW) {
        if (it < N1) { const int e = it / (4 * PER1), r0 = it % (4 * PER1), mat = r0 / (2 * PER1), r1 = r0 % (2 * PER1), ct = r1 / PER1, r2 = r1 % PER1;
            const float* src = (e < NE) ? F.in[mat ? I_EWU : I_EWG] + (size_t)e * DM * DEXP : F.in[mat ? I_SWU : I_SWG];
            tr_matrix_item(src, DEXP, DM, 128 * ct, 128, EW1 + (size_t)e * 512 * DM, 256 * ct + 128 * mat, scr, r2, F.lane); }
        else { const int r = it - N1, e = r / PER2, r2 = r % PER2;
            const float* src = (e < NE) ? F.in[I_EWD] + (size_t)e * DEXP * DM : F.in[I_SWD];
            tr_matrix_item(src, DM, DEXP, 0, DM, EW2 + (size_t)e * DM * DEXP, 0, scr, r2, F.lane); }
    }
}
__device__ __forceinline__ void p3_transpose(Frame& F) {
    const bf16* YT = (const bf16*)(F.ws + WS_YTHY); bf16* Y = (bf16*)(F.ws + WS_YHY);
    LAS bf16* scr = (LAS bf16*)(F.lds + F.wave * 9216);
    const int gw = F.vcu * NWAVES + F.wave, NGW = F.G * NWAVES, lane = F.lane;
    for (int tile = gw; tile < 16 * 512; tile += NGW) {
        const int c0 = (tile & 15) * 64, t0 = (tile >> 4) * 64;
#pragma unroll
        for (int p = 0; p < 8; ++p) { const int c = p * 8 + (lane >> 3), ch = lane & 7;
            const u32x4 g = *(const u32x4*)(YT + (size_t)(c0 + c) * MTOK + t0 + ch * 8);
            LAS bf16* d = scr + (ch * 8) * 72 + (c ^ (ch << 3));
            d[0 * 72] = (bf16)(g.x & 0xffff); d[1 * 72] = (bf16)(g.x >> 16); d[2 * 72] = (bf16)(g.y & 0xffff); d[3 * 72] = (bf16)(g.y >> 16);
            d[4 * 72] = (bf16)(g.z & 0xffff); d[5 * 72] = (bf16)(g.z >> 16); d[6 * 72] = (bf16)(g.w & 0xffff); d[7 * 72] = (bf16)(g.w >> 16); }
        LDS_WAIT(); asm volatile("" ::: "memory");
#pragma unroll
        for (int p = 0; p < 8; ++p) { const int tk = p * 8 + (lane >> 3), ch = lane & 7;
            const u32x4 v = *(const LAS u32x4*)(scr + tk * 72 + ((ch ^ ((tk >> 3) & 7)) << 3));
            *(u32x4*)(Y + (size_t)(t0 + tk) * DM + c0 + ch * 8) = v; }
        LDS_WAIT(); asm volatile("" ::: "memory");
    }
}

constexpr int HY_LDU = 2064, HY_KCS = 4128, HY_U_BYTES = 16 * HY_LDU * 2, HY_KC_BYTES = 8 * HY_KCS * 2;

struct HyKRow { u32x4 cur, prv; };
__device__ __forceinline__ void hy_load_kern(HyKRow& r, const bf16* kern, int tid) {
    r.cur = *(const u32x4*)(kern + 8 * tid);
    r.prv = (u32x4){0u, 0u, 0u, 0u};
    if (tid > 0) r.prv = *(const u32x4*)(kern + 8 * tid - 8);
}
__device__ __forceinline__ void hy_store_kc(LAS bf16* KC, const HyKRow& r, int tid) {
    const unsigned E[9] = {r.prv.x, r.prv.y, r.prv.z, r.prv.w, r.cur.x, r.cur.y, r.cur.z, r.cur.w, 0u};
#pragma unroll
    for (int fl = 0; fl < 8; ++fl) { const int sft = 8 - fl, k = sft >> 1;
        u32x4 o;
        if (sft & 1) { o.x = __builtin_amdgcn_alignbit(E[k + 1], E[k], 16); o.y = __builtin_amdgcn_alignbit(E[k + 2], E[k + 1], 16);
                       o.z = __builtin_amdgcn_alignbit(E[k + 3], E[k + 2], 16); o.w = __builtin_amdgcn_alignbit(E[k + 4], E[k + 3], 16); }
        else { o.x = E[k]; o.y = E[k + 1]; o.z = E[k + 2]; o.w = E[k + 3]; }
        *(LAS u32x4*)(KC + fl * HY_KCS + 8 * tid) = o; }
}
__device__ __forceinline__ f32x4 hy_short4(const bf16* prow, int t0, float w0, float w1, float w2, float cb) {
    const u32x2 g = *(const u32x2*)(prow + t0);
    const float p0 = bflo(g.x), p1 = bfhi(g.x), p2 = bflo(g.y), p3 = bfhi(g.y);
    const float pm = (t0 > 0) ? bf2f(prow[t0 - 1]) : 0.f, pp = (t0 + 4 < SEQ) ? bf2f(prow[t0 + 4]) : 0.f;
    f32x4 r; r[0] = cb + w0 * pm + w1 * p0 + w2 * p1; r[1] = cb + w0 * p0 + w1 * p1 + w2 * p2; r[2] = cb + w0 * p1 + w1 * p2 + w2 * p3; r[3] = cb + w0 * p2 + w1 * p3 + w2 * pp;
    return r;
}
__device__ __forceinline__ f32x4 hy_conv4(const u32x2 g, float pm, float pp, float w0, float w1, float w2, float cb) {
    const float p0 = bflo(g.x), p1 = bfhi(g.x), p2 = bflo(g.y), p3 = bfhi(g.y);
    f32x4 r; r[0] = cb + w0 * pm + w1 * p0 + w2 * p1; r[1] = cb + w0 * p0 + w1 * p1 + w2 * p2; r[2] = cb + w0 * p1 + w1 * p2 + w2 * p3; r[3] = cb + w0 * p2 + w1 * p3 + w2 * pp;
    return r;
}
__device__ __forceinline__ void hyena_phase(Frame& F) {
    LAS bf16* U = (LAS bf16*)(F.lds); LAS bf16* KC = (LAS bf16*)(F.lds + HY_U_BYTES);
    const bf16* PT = (const bf16*)(F.ws + WS_PTHY); const bf16* KERN = (const bf16*)(F.ws + WS_KERN); bf16* YT = (bf16*)(F.ws + WS_YTHY);
    const float* cw = F.in[I_HCW]; const float* cbv = F.in[I_HCB]; const float* hb = F.in[I_HBIAS];
    const int tid = F.tid, lane = F.lane, w = F.wave, fr = lane & 15, fq = lane >> 4;
    u32x4 um[8]; unsigned ee[8]; HyKRow kr;
    auto load_v = [&](int c) { int tl = tid; asm volatile("" : "+v"(tl));
        const bf16* prow = PT + (size_t)(2048 + c) * MTOK + (size_t)(tl >> 8) * SEQ + (tl & 255) * 8;
#pragma unroll
        for (int it = 0; it < 8; ++it) { um[it] = *(const u32x4*)(prow + (size_t)(2 * it) * SEQ); ee[it] = 0u; }
        if (lane == 0 || lane == 63) {
#pragma unroll
            for (int it = 0; it < 8; ++it) { const int t8 = (tl & 255) * 8; const bf16* pr = prow + (size_t)(2 * it) * SEQ - t8;
                if (lane == 0) { if (t8 > 0) ee[it] = pr[t8 - 1]; } else { if (t8 + 8 < SEQ) ee[it] = pr[t8 + 8]; } } } };
    if (F.vcu < DM) { hy_load_kern(kr, KERN + ((size_t)F.vcu * 2 + 0) * 4096, tid); load_v(F.vcu); }
    for (int c = F.vcu; c < DM; c += F.G) {
        const bool has_next = (c + F.G < DM);
        hy_store_kc(KC, kr, tid);
        { const int vc = 2048 + c; const float w0 = cw[0 * HYC + vc], w1 = cw[1 * HYC + vc], w2 = cw[2 * HYC + vc], cb = cbv[vc];
#pragma unroll
          for (int it = 0; it < 8; ++it) { const int idx = tid + 512 * it, b = idx >> 8, t8 = (idx & 255) * 8;
              const unsigned up = __shfl_up(um[it].w >> 16, 1), dn = __shfl_down(um[it].x & 0xffffu, 1);
              const float pm = bf2f(lane == 0 ? ee[it] : up), pp = bf2f(lane == 63 ? ee[it] : dn);
              u32x2 g0; g0.x = um[it].x; g0.y = um[it].y; u32x2 g1v; g1v.x = um[it].z; g1v.y = um[it].w;
              const f32x4 lo = hy_conv4(g0, pm, bflo(um[it].z), w0, w1, w2, cb), hi = hy_conv4(g1v, bfhi(um[it].y), pp, w0, w1, w2, cb);
              u32x4 o; o.x = pk2(lo[0], lo[1]); o.y = pk2(lo[2], lo[3]); o.z = pk2(hi[0], hi[1]); o.w = pk2(hi[2], hi[3]);
              *(LAS u32x4*)(U + b * HY_LDU + t8) = o; } }
        __syncthreads();
#pragma unroll
        for (int o = 0; o < 2; ++o) {
            const int gc = (o == 0) ? c : 1024 + c;
            int lz = lane; asm volatile("" : "+v"(lz));
            const bf16* grow = PT + (size_t)gc * MTOK + (size_t)(lz & 15) * SEQ;
            u32x2 gm[16];
#pragma unroll
            for (int tt = 0; tt < 16; ++tt) gm[tt] = *(const u32x2*)(grow + 256 * w + 16 * tt + 4 * fq);
            const unsigned edge_lo = (w > 0) ? (unsigned)grow[256 * w - 1] : 0u, edge_hi = (w < 7) ? (unsigned)grow[256 * w + 256] : 0u;
            if (o == 0) hy_load_kern(kr, KERN + ((size_t)c * 2 + 1) * 4096, tid);
            else if (has_next) hy_load_kern(kr, KERN + ((size_t)(c + F.G) * 2 + 0) * 4096, tid);
            f32x4 acc[16];
#pragma unroll
            for (int i = 0; i < 16; ++i) acc[i] = (f32x4){0.f, 0.f, 0.f, 0.f};
            const LAS bf16* kbase = KC + (fr & 7) * HY_KCS + 2048 + 8 * fq - 8 * (fr >> 3) - 256 * w;
            const LAS bf16* ubase = U + fr * HY_LDU + 8 * fq;
            bf16x8 win[16];
#pragma unroll
            for (int i = 0; i < 16; ++i) win[i] = *(const LAS bf16x8*)(kbase - 16 * i);
            bf16x8 bnx = *(const LAS bf16x8*)(ubase);
#define HY_TIE(a, b, c) asm volatile("s_waitcnt lgkmcnt(0)" : "+v"(a), "+v"(b), "+v"(c) :: "memory")
#pragma unroll 1
            for (int sj8 = 0; sj8 < 64; sj8 += 8) {
#pragma unroll
                for (int u = 0; u < 8; ++u) { const int sj = sj8 + u;
                    HY_TIE(bnx, win[(16 - 2 * u) & 15], win[(17 - 2 * u) & 15]);
                    const bf16x8 bfr = bnx;
#pragma unroll
                    for (int tt = 14; tt < 16; ++tt) acc[tt] = __builtin_amdgcn_mfma_f32_16x16x32_bf16(win[(tt - 2 * u) & 15], bfr, acc[tt], 0, 0, 0);
                    __builtin_amdgcn_sched_barrier(0);
                    bnx = *(const LAS bf16x8*)(ubase + 32 * ((sj + 1) & 63));
                    win[(14 - 2 * u) & 15] = *(const LAS bf16x8*)(kbase + 16 * (2 * sj + 2));
                    win[(15 - 2 * u) & 15] = *(const LAS bf16x8*)(kbase + 16 * (2 * sj + 1));
                    __builtin_amdgcn_sched_barrier(0);
#pragma unroll
                    for (int tt = 2; tt < 14; ++tt) acc[tt] = __builtin_amdgcn_mfma_f32_16x16x32_bf16(win[(tt - 2 * u) & 15], bfr, acc[tt], 0, 0, 0);
#pragma unroll
                    for (int tt = 0; tt < 2; ++tt) acc[tt] = __builtin_amdgcn_mfma_f32_16x16x32_bf16(win[(tt - 2 * u) & 15], bfr, acc[tt], 0, 0, 0);
                    __builtin_amdgcn_sched_barrier(0);
                } }
#undef HY_TIE
            if (o == 1 && has_next) load_v(c + F.G);
            const float hbias = hb[o * DM + c];
            const float w0 = cw[0 * HYC + gc], w1 = cw[1 * HYC + gc], w2 = cw[2 * HYC + gc], cb = cbv[gc];
            u32x2 zpk[16];
            unsigned pa[16], nb[16];
#pragma unroll
            for (int tt = 0; tt < 16; ++tt) { pa[tt] = __shfl(gm[tt].y >> 16, (lane + 48) & 63); nb[tt] = __shfl(gm[tt].x & 0xffffu, (lane + 16) & 63); }
#pragma unroll
            for (int tt = 0; tt < 16; ++tt) { const int t0 = 256 * w + 16 * tt + 4 * fq;
                const unsigned pmv = (fq > 0) ? pa[tt] : (tt > 0 ? pa[tt > 0 ? tt - 1 : 0] : edge_lo), ppv = (fq < 3) ? nb[tt] : (tt < 15 ? nb[tt < 15 ? tt + 1 : 15] : edge_hi);
                const u32x2 uu = *(const LAS u32x2*)(U + fr * HY_LDU + t0);
                const f32x4 g = hy_conv4(gm[tt], bf2f(pmv), bf2f(ppv), w0, w1, w2, cb);
                f32x4 y = acc[tt]; y[0] = g[0] * (y[0] + bflo(uu.x) * hbias); y[1] = g[1] * (y[1] + bfhi(uu.x) * hbias); y[2] = g[2] * (y[2] + bflo(uu.y) * hbias); y[3] = g[3] * (y[3] + bfhi(uu.y) * hbias);
                zpk[tt].x = pk2(y[0], y[1]); zpk[tt].y = pk2(y[2], y[3]); }
            __syncthreads();
            if (o == 0) {
#pragma unroll
                for (int tt = 0; tt < 16; ++tt) *(LAS u32x2*)(U + fr * HY_LDU + 256 * w + 16 * tt + 4 * fq) = zpk[tt];
                hy_store_kc(KC, kr, tid);
                __syncthreads();
            } else {
                int ly = lane; asm volatile("" : "+v"(ly));
                bf16* yrow = YT + (size_t)c * MTOK + (size_t)(ly & 15) * SEQ + 256 * w + 4 * (ly >> 4);
#pragma unroll
                for (int tt = 0; tt < 16; ++tt) *(u32x2*)(yrow + 16 * tt) = zpk[tt];
            }
        }
    }
}

__device__ __forceinline__ void ssd_conv_phase(Frame& F) {
    bf16* XBC = (bf16*)(F.ws + WS_XBC); const bf16* HALO = (const bf16*)(F.ws + WS_HALO);
    const float* scw = F.in[I_SCW]; const float* scb = F.in[I_SCB];
    const int gw = F.vcu * NWAVES + F.wave, NGW = F.G * NWAVES, lane = F.lane;
    for (int item = gw; item < BATCH * 32 * 8; item += NGW) {
        const int cb8 = item & 7, seg = (item >> 3) & 31, b = item >> 8, col = cb8 * 512 + lane * 8;
        float wk[5][8], cbv[8];
#pragma unroll
        for (int k = 0; k < 5; ++k) { const f32x4 a = *(const f32x4*)(scw + k * CONVD + col), c = *(const f32x4*)(scw + k * CONVD + col + 4);
#pragma unroll
            for (int e = 0; e < 4; ++e) { wk[k][e] = a[e]; wk[k][4 + e] = c[e]; } }
        { const f32x4 a = *(const f32x4*)(scb + col), c = *(const f32x4*)(scb + col + 4);
#pragma unroll
          for (int e = 0; e < 4; ++e) { cbv[e] = a[e]; cbv[4 + e] = c[e]; } }
        bf16* xrow0 = XBC + ((size_t)b * SEQ + seg * 64) * CONVD + col;
        const bf16* hlo = HALO + ((size_t)(b * 33 + seg) * 4) * CONVD + col;
        const bf16* hhi = HALO + ((size_t)(b * 33 + seg + 1) * 4 + 2) * CONVD + col;
        const u32x4 zero4 = {0u, 0u, 0u, 0u};
        u32x4 W[12];
        W[0] = seg > 0 ? *(const u32x4*)(hlo) : zero4; W[1] = seg > 0 ? *(const u32x4*)(hlo + CONVD) : zero4;
        W[2] = *(const u32x4*)(xrow0); W[3] = *(const u32x4*)(xrow0 + CONVD);
#pragma unroll 1
        for (int blk = 0; blk < 8; ++blk) { const int r0 = 8 * blk;
#pragma unroll
            for (int i = 4; i < 12; ++i) { const int rr = r0 - 2 + i;
                if (rr < 64) W[i] = *(const u32x4*)(xrow0 + (size_t)rr * CONVD);
                else W[i] = (seg < 31) ? *(const u32x4*)(hhi + (size_t)(rr - 64) * CONVD) : zero4; }
#pragma unroll
            for (int o = 0; o < 8; ++o) { float v[8];
#pragma unroll
                for (int e = 0; e < 8; ++e) v[e] = cbv[e];
#pragma unroll
                for (int k = 0; k < 5; ++k) { const u32x4 p = W[o + k];
                    v[0] += wk[k][0] * bflo(p.x); v[1] += wk[k][1] * bfhi(p.x); v[2] += wk[k][2] * bflo(p.y); v[3] += wk[k][3] * bfhi(p.y);
                    v[4] += wk[k][4] * bflo(p.z); v[5] += wk[k][5] * bfhi(p.z); v[6] += wk[k][6] * bflo(p.w); v[7] += wk[k][7] * bfhi(p.w); }
#pragma unroll
                for (int e = 0; e < 8; ++e) v[e] = siluf_(v[e]);
                u32x4 ov; ov.x = pk2(v[0], v[1]); ov.y = pk2(v[2], v[3]); ov.z = pk2(v[4], v[5]); ov.w = pk2(v[6], v[7]);
                *(u32x4*)(xrow0 + (size_t)(r0 + o) * CONVD) = ov; }
#pragma unroll
            for (int i = 0; i < 4; ++i) W[i] = W[8 + i];
        }
    }
}

constexpr int SS_LDC = 144, SS_LDM = 136;
constexpr int SS_C = 0, SS_B = 18432, SS_X = 36864, SS_XE = 55296, SS_M = 73728, SS_SB = 108544, SS_ACS = 145408, SS_DTV = 146432, SS_TOE = 147456, SS_END = 148480;
static_assert(SS_END <= MISC_OFF, "SSD LDS map");
typedef short s16x4 __attribute__((ext_vector_type(4)));
__device__ __forceinline__ bf16x8 ssd_trfrag(const LAS bf16* p) {
    const s16x4 a = __builtin_amdgcn_ds_read_tr16_b64_v4i16((LAS s16x4*)p), b = __builtin_amdgcn_ds_read_tr16_b64_v4i16((LAS s16x4*)(p + 16 * SS_LDC));
    return __builtin_shufflevector(a, b, 0, 1, 2, 3, 4, 5, 6, 7);
}

__device__ __forceinline__ void ssd_phase(Frame& F) {
    LAS unsigned char* L = F.lds;
    LAS bf16* Cl = (LAS bf16*)(L + SS_C); LAS bf16* Bl = (LAS bf16*)(L + SS_B); LAS bf16* Xr = (LAS bf16*)(L + SS_X); LAS bf16* XEr = (LAS bf16*)(L + SS_XE);
    LAS bf16* Ml = (LAS bf16*)(L + SS_M); LAS bf16* SB = (LAS bf16*)(L + SS_SB);
    LAS float* ACS = (LAS float*)(L + SS_ACS); LAS float* DTV = (LAS float*)(L + SS_DTV); LAS float* TOE = (LAS float*)(L + SS_TOE);
    const bf16* XBC = (const bf16*)(F.ws + WS_XBC); const float* DT = (const float*)(F.ws + WS_DT); const unsigned char* Z8 = (const unsigned char*)F.out; bf16* YS = (bf16*)(F.ws + WS_YSSD);
    const float* dtb = F.in[I_DTB]; const float* alog = F.in[I_ALOG]; const float* sd = F.in[I_SD];
    const int tid = F.tid, lane = F.lane, w = F.wave, fr = lane & 15, fq = lane >> 4;
    for (int unit = F.vcu; unit < BATCH * NGRP * 2; unit += F.G) {
        const int b = unit >> 4, g = (unit >> 1) & 7, hp = unit & 1, h0 = 4 * g + 2 * hp;
#pragma unroll 1
        for (int dir = 0; dir < 2; ++dir) {
            const float dtbias = (w < 2) ? dtb[dir * 32 + h0 + w] : 0.f, aexp = (w < 2) ? __expf(alog[dir * 32 + h0 + w]) : 0.f;
            auto scan = [&](int buf, float raw) {
                raw += dtbias; const float dtv = raw > 20.f ? raw : log1pf(__expf(raw)); float a = -dtv * aexp;
#pragma unroll
                for (int o = 1; o < 64; o <<= 1) { const float v = __shfl_up(a, o); if (lane >= o) a += v; }
                const float tot = __shfl(a, 63); const int ix = (buf * 2 + w) * 64 + lane;
                ACS[ix] = a; DTV[ix] = dtv; TOE[ix] = __expf(tot - a); };
            auto dtload = [&](int ci) -> float { const int ch = dir ? 31 - ci : ci, r = dir ? 63 - lane : lane;
                return DT[((size_t)b * SEQ + 64 * ch + r) * 64 + dir * 32 + h0 + w]; };
            auto rowload = [&](int ci, int it, int tl) -> u32x4 {
                const int l = (tl >> 4) + 32 * (it & 1), j = tl & 15, ch = dir ? 31 - ci : ci, r = dir ? 63 - l : l;
                const int col = (it < 2 ? 64 * h0 : (it < 4 ? 2048 + 128 * g : 3072 + 128 * g)) + 8 * j;
                return *(const u32x4*)(XBC + ((size_t)b * SEQ + 64 * ch + r) * CONVD + col); };
            f32x4 Sacc[8];
#pragma unroll
            for (int i = 0; i < 8; ++i) Sacc[i] = (f32x4){0.f, 0.f, 0.f, 0.f};
            const float dsk = sd[h0 + (w >> 2)];
            __syncthreads();
            for (int i = tid; i < 2 * 64 * SS_LDC / 2; i += NTHR) ((LAS unsigned*)SB)[i] = 0u;
            float dtn = 0.f;
            if (w < 2) { scan(0, dtload(0)); dtn = dtload(1); }
            u32x4 pf[6];
#pragma unroll
            for (int it = 0; it < 6; ++it) pf[it] = rowload(0, it, tid);
            __syncthreads();
#pragma unroll 1
            for (int ci = 0; ci < 32; ++ci) {
                const int ch = dir ? 31 - ci : ci, buf = ci & 1;
                const size_t tokbase = (size_t)b * SEQ + 64 * ch;
                int tl = tid; asm volatile("" : "+v"(tl));
                int frl = fr, fql = fq; asm volatile("" : "+v"(frl), "+v"(fql));
                const LAS float* acs = ACS + buf * 128; const LAS float* dtv = DTV + buf * 128; const LAS float* toe = TOE + buf * 128;
#pragma unroll
                for (int it = 0; it < 6; ++it) { const int l = (tl >> 4) + 32 * (it & 1), j = tl & 15; const u32x4 p = pf[it];
                    if (it < 2) { const int hh = j >> 3; const float de = dtv[hh * 64 + l] * toe[hh * 64 + l];
                        *(LAS u32x4*)(Xr + l * SS_LDC + j * 8) = p;
                        u32x4 q; q.x = pk2(bflo(p.x) * de, bfhi(p.x) * de); q.y = pk2(bflo(p.y) * de, bfhi(p.y) * de); q.z = pk2(bflo(p.z) * de, bfhi(p.z) * de); q.w = pk2(bflo(p.w) * de, bfhi(p.w) * de);
                        *(LAS u32x4*)(XEr + l * SS_LDC + j * 8) = q; }
                    else if (it < 4) { *(LAS u32x4*)(Bl + l * SS_LDC + j * 8) = p; }
                    else { *(LAS u32x4*)(Cl + l * SS_LDC + j * 8) = p; } }
                if (ci + 1 < 32) {
#pragma unroll
                    for (int it = 0; it < 6; ++it) pf[it] = rowload(ci + 1, it, tl); }
                __syncthreads();
                const int hh = w >> 2, li = w & 3, lrow = 16 * li + frl;
                const int rloc = dir ? 63 - lrow : lrow; const size_t tok = tokbase + rloc;
                u32x2 pv[4]; unsigned zv[4];
                if (dir) {
#pragma unroll
                    for (int pi = 0; pi < 4; ++pi) { const size_t o = tok * DSSM + 64 * (h0 + hh) + 16 * pi + 4 * fql; pv[pi] = *(const u32x2*)(YS + o); zv[pi] = *(const unsigned*)(Z8 + o); } }
#define SSD_FENCE() asm volatile("s_waitcnt lgkmcnt(0)" ::: "memory")
#define SSD_TIE8(a) asm volatile("s_waitcnt lgkmcnt(0)" : "+v"(a[0][0]), "+v"(a[0][1]), "+v"(a[1][0]), "+v"(a[1][1]), "+v"(a[2][0]), "+v"(a[2][1]), "+v"(a[3][0]), "+v"(a[3][1]) :: "memory")
#define SSD_TIE8K(a) asm volatile("s_waitcnt lgkmcnt(0)" : "+v"(a[0][0]), "+v"(a[0][1]), "+v"(a[0][2]), "+v"(a[0][3]), "+v"(a[1][0]), "+v"(a[1][1]), "+v"(a[1][2]), "+v"(a[1][3]) :: "memory")
                f32x4 Y[4];
                { bf16x8 cfr[4];
#pragma unroll
                  for (int kk = 0; kk < 4; ++kk) cfr[kk] = *(const LAS bf16x8*)(Cl + lrow * SS_LDC + 8 * fql + 32 * kk);
#pragma unroll
                  for (int ph = 0; ph < 2; ++ph) { bf16x8 sfr[2][4];
#pragma unroll
                      for (int pp = 0; pp < 2; ++pp)
#pragma unroll
                          for (int kk = 0; kk < 4; ++kk) sfr[pp][kk] = *(const LAS bf16x8*)(SB + (hh * 64 + 16 * (2 * ph + pp) + frl) * SS_LDC + 8 * fql + 32 * kk);
                      SSD_TIE8K(sfr);
#pragma unroll
                      for (int pp = 0; pp < 2; ++pp) { Y[2 * ph + pp] = (f32x4){0.f, 0.f, 0.f, 0.f};
#pragma unroll
                          for (int kk = 0; kk < 4; ++kk) Y[2 * ph + pp] = __builtin_amdgcn_mfma_f32_16x16x32_bf16(sfr[pp][kk], cfr[kk], Y[2 * ph + pp], 0, 0, 0); }
                      __builtin_amdgcn_sched_barrier(0); } }
                { bf16x8 cbA[2][4], cbB[2][4]; f32x4 tas[2], tdd[2]; float tal[2];
#pragma unroll
                  for (int q = 0; q < 2; ++q) { const int id = 2 * w + q, si = id >> 2, lj = id & 3;
                      if (si <= lj) {
#pragma unroll
                          for (int kk = 0; kk < 4; ++kk) { cbA[q][kk] = *(const LAS bf16x8*)(Bl + (16 * si + frl) * SS_LDC + 8 * fql + 32 * kk); cbB[q][kk] = *(const LAS bf16x8*)(Cl + (16 * lj + frl) * SS_LDC + 8 * fql + 32 * kk); } } }
                  auto tab_load = [&](int q) { const int id = 2 * w + q, si = id >> 2, lj = id & 3, l = 16 * lj + frl, s0 = 16 * si + 4 * fql;
#pragma unroll
                      for (int h = 0; h < 2; ++h) { tas[h] = *(const LAS f32x4*)(acs + 64 * h + s0); tdd[h] = *(const LAS f32x4*)(dtv + 64 * h + s0); tal[h] = acs[64 * h + l]; } };
                  tab_load(0);
                  SSD_FENCE();
#pragma unroll
                  for (int q = 0; q < 2; ++q) { const int id = 2 * w + q, si = id >> 2, lj = id & 3, l = 16 * lj + frl, s0 = 16 * si + 4 * fql;
                      u32x2 m0 = {0u, 0u}, m1 = {0u, 0u};
                      if (si <= lj) { f32x4 cb = (f32x4){0.f, 0.f, 0.f, 0.f};
#pragma unroll
                          for (int kk = 0; kk < 4; ++kk) cb = __builtin_amdgcn_mfma_f32_16x16x32_bf16(cbA[q][kk], cbB[q][kk], cb, 0, 0, 0);
                          float x0[4], x1[4];
#pragma unroll
                          for (int j = 0; j < 4; ++j) { const bool keep = (s0 + j <= l);
                              const float e0 = __expf(fminf(tal[0] - tas[0][j], 0.f)) * tdd[0][j], e1 = __expf(fminf(tal[1] - tas[1][j], 0.f)) * tdd[1][j];
                              const float c = keep ? cb[j] : 0.f; x0[j] = c * e0; x1[j] = c * e1; }
                          m0.x = pk2(x0[0], x0[1]); m0.y = pk2(x0[2], x0[3]); m1.x = pk2(x1[0], x1[1]); m1.y = pk2(x1[2], x1[3]); }
                      if (q == 0) tab_load(1);
                      *(LAS u32x2*)(Ml + (0 * 64 + l) * SS_LDM + s0) = m0; *(LAS u32x2*)(Ml + (1 * 64 + l) * SS_LDM + s0) = m1; } }
                __syncthreads();
                const int trb = (4 * fql + (frl >> 2)) * SS_LDC + 4 * (frl & 3);
                { bf16x8 mf[2], xdf[4][2];
#pragma unroll
                  for (int kk = 0; kk < 2; ++kk) { const LAS bf16* mp = Ml + (hh * 64 + lrow) * SS_LDM + 32 * kk + 4 * fql;
                      const s16x4 a = *(const LAS s16x4*)mp, b2 = *(const LAS s16x4*)(mp + 16); mf[kk] = __builtin_shufflevector(a, b2, 0, 1, 2, 3, 4, 5, 6, 7); }
#pragma unroll
                  for (int pi = 0; pi < 4; ++pi)
#pragma unroll
                      for (int kk = 0; kk < 2; ++kk) xdf[pi][kk] = ssd_trfrag(Xr + trb + 32 * kk * SS_LDC + hh * 64 + 16 * pi);
                  const float el = __expf(acs[hh * 64 + lrow]);
                  SSD_TIE8(xdf);
#pragma unroll
                  for (int pi = 0; pi < 4; ++pi) { Y[pi] = Y[pi] * el;
                      Y[pi] = __builtin_amdgcn_mfma_f32_16x16x32_bf16(xdf[pi][0], mf[0], Y[pi], 0, 0, 0);
                      Y[pi] = __builtin_amdgcn_mfma_f32_16x16x32_bf16(xdf[pi][1], mf[1], Y[pi], 0, 0, 0); }
                  __builtin_amdgcn_sched_barrier(0);
#pragma unroll
                  for (int pi = 0; pi < 4; ++pi) { const int p0 = 16 * pi + 4 * fql; bf16* yp = YS + tok * DSSM + 64 * (h0 + hh) + p0; f32x4 y = Y[pi];
                      if (dir == 0) { const u32x2 xv = *(const LAS u32x2*)(Xr + lrow * SS_LDC + hh * 64 + p0);
                          y[0] += dsk * bflo(xv.x); y[1] += dsk * bfhi(xv.x); y[2] += dsk * bflo(xv.y); y[3] += dsk * bfhi(xv.y);
                      } else { const u32x2 pvv = pv[pi]; const f32x2 z01 = __builtin_amdgcn_cvt_pk_f32_fp8((int)zv[pi], false), z23 = __builtin_amdgcn_cvt_pk_f32_fp8((int)zv[pi], true);
                          y[0] = (y[0] + bflo(pvv.x)) * siluf_(z01.x); y[1] = (y[1] + bfhi(pvv.x)) * siluf_(z01.y); y[2] = (y[2] + bflo(pvv.y)) * siluf_(z23.x); y[3] = (y[3] + bfhi(pvv.y)) * siluf_(z23.y); }
                      u32x2 o; o.x = pk2(y[0], y[1]); o.y = pk2(y[2], y[3]); *(u32x2*)yp = o; }
                  __builtin_amdgcn_sched_barrier(0); }
                { const int pi5 = w & 3; const float dec = __expf(acs[hh * 64 + 63]);
                  bf16x8 xef[2];
#pragma unroll
                  for (int kk = 0; kk < 2; ++kk) xef[kk] = ssd_trfrag(XEr + trb + 32 * kk * SS_LDC + hh * 64 + 16 * pi5);
#pragma unroll
                  for (int nh = 0; nh < 2; ++nh) { bf16x8 btf[4][2];
#pragma unroll
                      for (int nn = 0; nn < 4; ++nn)
#pragma unroll
                          for (int kk = 0; kk < 2; ++kk) btf[nn][kk] = ssd_trfrag(Bl + trb + 32 * kk * SS_LDC + 16 * (4 * nh + nn));
                      SSD_TIE8(btf);
#pragma unroll
                      for (int nn = 0; nn < 4; ++nn) { const int ni = 4 * nh + nn; Sacc[ni] = Sacc[ni] * dec;
                          Sacc[ni] = __builtin_amdgcn_mfma_f32_16x16x32_bf16(btf[nn][0], xef[0], Sacc[ni], 0, 0, 0);
                          Sacc[ni] = __builtin_amdgcn_mfma_f32_16x16x32_bf16(btf[nn][1], xef[1], Sacc[ni], 0, 0, 0); }
                      __builtin_amdgcn_sched_barrier(0); }
#pragma unroll
                  for (int ni = 0; ni < 8; ++ni) { u32x2 o; o.x = pk2(Sacc[ni][0], Sacc[ni][1]); o.y = pk2(Sacc[ni][2], Sacc[ni][3]);
                      *(LAS u32x2*)(SB + (hh * 64 + 16 * pi5 + frl) * SS_LDC + 16 * ni + 4 * fql) = o; } }
                if (w < 2 && ci + 1 < 32) { scan(buf ^ 1, dtn); if (ci + 2 < 32) dtn = dtload(ci + 2); }
                __syncthreads();
            }
        }
    }
}

__device__ __forceinline__ void ssd_norm_phase(Frame& F) {
    bf16* YS = (bf16*)(F.ws + WS_YSSD); const float* nw = F.in[I_SNW];
    const int gw = F.vcu * NWAVES + F.wave, NGW = F.G * NWAVES, lane = F.lane;
    f32x4 wv[8];
#pragma unroll
    for (int j = 0; j < 4; ++j) { wv[2 * j] = *(const f32x4*)(nw + 512 * j + 8 * lane); wv[2 * j + 1] = *(const f32x4*)(nw + 512 * j + 8 * lane + 4); }
    for (int m = gw; m < MTOK; m += 2 * NGW) {
        u32x4 v[2][4];
#pragma unroll
        for (int u = 0; u < 2; ++u)
#pragma unroll
            for (int j = 0; j < 4; ++j) v[u][j] = *(const u32x4*)(YS + (size_t)((m + u * NGW < MTOK) ? m + u * NGW : m) * DSSM + 512 * j + 8 * lane);
#pragma unroll
        for (int u = 0; u < 2; ++u) { if (m + u * NGW >= MTOK) break; bf16* row = YS + (size_t)(m + u * NGW) * DSSM + 8 * lane;
#pragma unroll
            for (int j = 0; j < 4; ++j) { const u32x4 q = v[u][j];
                const float a0 = bflo(q.x), a1 = bfhi(q.x), a2 = bflo(q.y), a3 = bfhi(q.y), a4 = bflo(q.z), a5 = bfhi(q.z), a6 = bflo(q.w), a7 = bfhi(q.w);
                float ss = (a0 * a0 + a1 * a1) + (a2 * a2 + a3 * a3) + (a4 * a4 + a5 * a5) + (a6 * a6 + a7 * a7);
                ss += __shfl_xor(ss, 1); ss += __shfl_xor(ss, 2); ss += __shfl_xor(ss, 4); ss += __shfl_xor(ss, 8); ss += __shfl_xor(ss, 16);
                const float rs = 1.0f / sqrtf(ss * (1.0f / 256.0f) + RMS_EPS); const f32x4 w0 = wv[2 * j], w1 = wv[2 * j + 1];
                u32x4 o; o.x = pk2(a0 * rs * w0[0], a1 * rs * w0[1]); o.y = pk2(a2 * rs * w0[2], a3 * rs * w0[3]);
                o.z = pk2(a4 * rs * w1[0], a5 * rs * w1[1]); o.w = pk2(a6 * rs * w1[2], a7 * rs * w1[3]);
                *(u32x4*)(row + 512 * j) = o; } } }
}

constexpr int RT_WC = 131072;
__device__ __forceinline__ void ln1_router_phase(Frame& F) {
    const bf16* H1P = (const bf16*)(F.ws + WS_H1P); bf16* H1B = (bf16*)F.out;
    int* TOK = (int*)(F.ws + WS_TOK); float* WGT = (float*)(F.ws + WS_WGT); int* ASG = (int*)(F.ws + WS_ASG);
    const float* g1 = F.in[I_LN1G]; const float* b1 = F.in[I_LN1B]; const float* rw = F.in[I_RW]; const float* rb = F.in[I_RB];
    LAS float* hrow = (LAS float*)(F.lds + F.wave * 16384);
    LAS float* wc = (LAS float*)(F.lds + RT_WC);
    LAS unsigned* cl = (LAS unsigned*)(F.lds + RT_WC + 16384);
    if (F.tid < 64) cl[F.tid] = 0u;
    __syncthreads();
    const int lane = F.lane, tid = F.tid;
    f32x4 gv[4], bv[4];
#pragma unroll
    for (int j = 0; j < 4; ++j) { gv[j] = *(const f32x4*)(g1 + 4 * lane + 256 * j); bv[j] = *(const f32x4*)(b1 + 4 * lane + 256 * j); }
    const float rbias = rb[lane];
    for (int step = F.vcu; step < MTOK / 32; step += F.G) {
        const int rg = step * 8 + F.wave;
        f32x4 nx0 = *(const f32x4*)(rw + tid * 4), nx1 = *(const f32x4*)(rw + 2048 + tid * 4);
#pragma unroll 1
        for (int r = 0; r < 4; ++r) { const size_t m = (size_t)rg * 4 + r; const bf16* xr = H1P + m * DM;
            f32x4 v[4]; float s = 0.f;
#pragma unroll
            for (int j = 0; j < 4; ++j) { const u32x2 q = *(const u32x2*)(xr + 4 * lane + 256 * j); v[j][0] = bflo(q.x); v[j][1] = bfhi(q.x); v[j][2] = bflo(q.y); v[j][3] = bfhi(q.y); s += (v[j][0] + v[j][1]) + (v[j][2] + v[j][3]); }
            const float mean = wave_sum(s) * (1.f / DM); float s2 = 0.f;
#pragma unroll
            for (int j = 0; j < 4; ++j) { v[j] = v[j] - mean; s2 += (v[j][0] * v[j][0] + v[j][1] * v[j][1]) + (v[j][2] * v[j][2] + v[j][3] * v[j][3]); }
            const float rstd = 1.f / sqrtf(wave_sum(s2) * (1.f / DM) + LN_EPS);
#pragma unroll
            for (int j = 0; j < 4; ++j) { const f32x4 h = v[j] * rstd * gv[j] + bv[j];
                u32x2 o; o.x = pk2(h[0], h[1]); o.y = pk2(h[2], h[3]); *(u32x2*)(H1B + m * H1B_PITCH + 4 * lane + 256 * j) = o;
                *(LAS f32x4*)(hrow + r * 1024 + 4 * lane + 256 * j) = h; } }
        float lg[4] = {0.f, 0.f, 0.f, 0.f};
#pragma unroll 1
        for (int kc = 0; kc < 16; ++kc) {
            __syncthreads();
            *(LAS f32x4*)(wc + tid * 4) = nx0; *(LAS f32x4*)(wc + 2048 + tid * 4) = nx1;
            if (kc + 1 < 16) { nx0 = *(const f32x4*)(rw + (kc + 1) * 4096 + tid * 4); nx1 = *(const f32x4*)(rw + (kc + 1) * 4096 + 2048 + tid * 4); }
            __syncthreads();
#pragma unroll 4
            for (int kk = 0; kk < 64; kk += 4) {
                const float w0 = wc[(kk + 0) * 64 + lane], w1 = wc[(kk + 1) * 64 + lane], w2 = wc[(kk + 2) * 64 + lane], w3 = wc[(kk + 3) * 64 + lane];
#pragma unroll
                for (int r = 0; r < 4; ++r) { const f32x4 h = *(const LAS f32x4*)(hrow + r * 1024 + kc * 64 + kk); lg[r] += h[0] * w0 + h[1] * w1 + h[2] * w2 + h[3] * w3; } }
        }
        bool selr[4]; float wgr[4]; int rkr[4];
#pragma unroll
        for (int r = 0; r < 4; ++r) {
            const float score = 1.0f / (1.0f + expf(-lg[r])), biased = score + rbias;
            float m1 = biased; m1 = fmaxf(m1, __shfl_xor(m1, 1)); m1 = fmaxf(m1, __shfl_xor(m1, 2)); m1 = fmaxf(m1, __shfl_xor(m1, 4));
            const unsigned long long eq = __ballot(biased == m1); const int gbase = lane & ~7; const int first = gbase + __ffs((unsigned)((eq >> gbase) & 0xffull)) - 1;
            float v2 = (lane == first) ? -INFINITY : biased; v2 = fmaxf(v2, __shfl_xor(v2, 1)); v2 = fmaxf(v2, __shfl_xor(v2, 2)); v2 = fmaxf(v2, __shfl_xor(v2, 4));
            const float gs = m1 + v2; const int g = lane >> 3; int better = 0;
#pragma unroll
            for (int d = 1; d < 8; ++d) { const int g2 = (g + d) & 7; const float og = __shfl(gs, g2 * 8); better += (og > gs || (og == gs && g2 < g)) ? 1 : 0; }
            float masked = (better < 4) ? biased : -INFINITY; bool sel = false;
#pragma unroll 1
            for (int it = 0; it < TOPK; ++it) { const float mx = wave_max(masked); const unsigned long long bm = __ballot(masked == mx); const int win = __ffsll((long long)bm) - 1;
                if (lane == win) { sel = true; masked = -INFINITY; } }
            const float sw = wave_sum(sel ? score : 0.f);
            const unsigned long long selm = __ballot(sel);
            selr[r] = sel; wgr[r] = score / sw * ROUTED_SCALE; rkr[r] = __popcll(selm & ((1ull << lane) - 1ull)); }
        unsigned lp[4];
#pragma unroll
        for (int r = 0; r < 4; ++r) lp[r] = selr[r] ? atomicAdd((unsigned*)(cl + lane), 1u) : 0u;
        __syncthreads();
        if (F.wave == 0) { const unsigned n = cl[lane]; unsigned bs = 0u;
            if (n) bs = __hip_atomic_fetch_add((unsigned*)(F.ctl + CW_CNT + 64 * lane), n, __ATOMIC_RELAXED, __HIP_MEMORY_SCOPE_AGENT);
            cl[64 + lane] = bs; cl[lane] = 0u; }
        __syncthreads();
        const unsigned bse = cl[64 + lane];
#pragma unroll
        for (int r = 0; r < 4; ++r) if (selr[r]) { const int m = rg * 4 + r; const unsigned pos = bse + lp[r];
            TOK[(size_t)lane * MTOK + pos] = m; WGT[(size_t)lane * MTOK + pos] = wgr[r]; ASG[(size_t)m * 8 + rkr[r]] = lane * MTOK + (int)pos; }
    }
}
constexpr int MOE_TP = 131072 + 1024, MOE_CNT = MOE_TP + 512, MOE_TE = 131072 + 4096;
__device__ __forceinline__ int moe_table(Frame& F) {
    LAS int* tp = (LAS int*)(F.lds + MOE_TP); LAS int* cnt = (LAS int*)(F.lds + MOE_CNT);
    __syncthreads();
    if (F.tid == 0) { int run = 0;
        for (int e = 0; e < NEX; ++e) { const int c = (e < NE) ? (int)__hip_atomic_load((unsigned*)(F.ctl + CW_CNT + 64 * e), __ATOMIC_RELAXED, __HIP_MEMORY_SCOPE_AGENT) : MTOK;
            cnt[e] = c; tp[e] = run; run += (c + 255) >> 8; }
        tp[NEX] = run; }
    __syncthreads();
    { LAS int* te = (LAS int*)(F.lds + MOE_TE); const int total = tp[NEX];
      for (int t = F.tid; t < total; t += NTHR) { int e = 0;
#pragma unroll 1
          for (int s = 64; s >= 1; s >>= 1) if (e + s <= NE && tp[e + s] <= t) e += s;
          te[t] = e; } }
    __syncthreads();
    return tp[NEX];
}
__device__ __forceinline__ void fp8x4_fma(f32x4& a, const unsigned v, const float w) {
    const f32x2 p0 = __builtin_amdgcn_cvt_pk_f32_fp8((int)v, false), p1 = __builtin_amdgcn_cvt_pk_f32_fp8((int)v, true);
    a[0] += w * p0.x; a[1] += w * p0.y; a[2] += w * p1.x; a[3] += w * p1.y;
}
__device__ __forceinline__ void moe_combine_phase(Frame& F) {
    const bf16* H1B = (const bf16*)F.out; const unsigned char* YQ = (const unsigned char*)(F.ws + WS_YQ); const int* ASG = (const int*)(F.ws + WS_ASG); const float* WGT = (const float*)(F.ws + WS_WGT);
    const LAS int* tp = (const LAS int*)(F.lds + MOE_TP);
    const float* g2 = F.in[I_LN2G]; const float* b2 = F.in[I_LN2B];
    const int gw = F.vcu * NWAVES + F.wave, NGW = F.G * NWAVES, lane = F.lane;
    const size_t shbase = (size_t)tp[NE] * 256;
    f32x4 gv[4], bv[4];
#pragma unroll
    for (int j = 0; j < 4; ++j) { gv[j] = *(const f32x4*)(g2 + 4 * lane + 256 * j); bv[j] = *(const f32x4*)(b2 + 4 * lane + 256 * j); }
    const int l8 = lane & 7;
    int li = ASG[(size_t)gw * 8 + l8];
    float wk = WGT[li];
    int li_n = (gw + NGW < MTOK) ? ASG[(size_t)(gw + NGW) * 8 + l8] : 0;
    for (int m = gw; m < MTOK; m += NGW) {
        const int e = li >> 15, pos = li & 32767; const int slot = 256 * tp[e] + pos; const float wcur = wk;
        unsigned vv[9][4]; f32x4 v[4];
        { const unsigned char* sp = YQ + (shbase + m) * 1024 + 4 * lane;
#pragma unroll
          for (int j = 0; j < 4; ++j) vv[8][j] = *(const unsigned*)(sp + 256 * j); }
#pragma unroll
        for (int k = 0; k < 8; ++k) { const int sk = __shfl(slot, k); const unsigned char* sp = YQ + (size_t)sk * 1024 + 4 * lane;
#pragma unroll
            for (int j = 0; j < 4; ++j) vv[k][j] = *(const unsigned*)(sp + 256 * j); }
        float* xr = F.out + (size_t)m * DM + 4 * lane; const bf16* hr = H1B + (size_t)m * H1B_PITCH + 4 * lane; u32x2 hq[4];
#pragma unroll
        for (int j = 0; j < 4; ++j) hq[j] = *(const u32x2*)(hr + 256 * j);
        li = li_n; wk = WGT[li];
        li_n = (m + 2 * NGW < MTOK) ? ASG[(size_t)(m + 2 * NGW) * 8 + l8] : 0;
#pragma unroll
        for (int j = 0; j < 4; ++j) { v[j][0] = DN_ALPHA * bflo(hq[j].x); v[j][1] = DN_ALPHA * bfhi(hq[j].x); v[j][2] = DN_ALPHA * bflo(hq[j].y); v[j][3] = DN_ALPHA * bfhi(hq[j].y); fp8x4_fma(v[j], vv[8][j], 1.0f); }
#pragma unroll
        for (int k = 0; k < 8; ++k) { const float w = __shfl(wcur, k);
#pragma unroll
            for (int j = 0; j < 4; ++j) fp8x4_fma(v[j], vv[k][j], w); }
        float s = 0.f;
#pragma unroll
        for (int j = 0; j < 4; ++j) s += (v[j][0] + v[j][1]) + (v[j][2] + v[j][3]);
        const float mean = wave_sum(s) * (1.f / DM); float s2 = 0.f;
#pragma unroll
        for (int j = 0; j < 4; ++j) { v[j] = v[j] - mean; s2 += (v[j][0] * v[j][0] + v[j][1] * v[j][1]) + (v[j][2] * v[j][2] + v[j][3] * v[j][3]); }
        const float rstd = 1.f / sqrtf(wave_sum(s2) * (1.f / DM) + LN_EPS);
#pragma unroll
        for (int j = 0; j < 4; ++j) *(f32x4*)(xr + 256 * j) = v[j] * rstd * gv[j] + bv[j];
    }
}

#ifndef MK_N_LAUNCHES
#define MK_N_LAUNCHES 1
#endif
constexpr int NPH = 15;
constexpr int N_LAUNCHES = MK_N_LAUNCHES;

__global__ void __launch_bounds__(NTHR, 2) fwd_kernel(Args args) {
    extern __shared__ __attribute__((aligned(16))) unsigned char lds_raw[];
    Frame F;
    F.lds = (LAS unsigned char*)lds_raw;
    F.MISC = (volatile LAS unsigned*)(F.lds + MISC_OFF);
    F.tid = threadIdx.x; F.lane = F.tid & 63; F.wave = __builtin_amdgcn_readfirstlane(F.tid >> 6);
    F.G = gridDim.x; { const int bx = blockIdx.x; F.vcu = (F.G % 8 == 0) ? (bx % 8) * (F.G / 8) + bx / 8 : bx; }
    F.ws = args.ws; F.ctl = (gu32*)(args.ws + WS_CTL); F.in = args.in; F.out = args.out;
    for (int u = F.tid; u < (LDS_BYTES - MISC_OFF) / 4; u += NTHR) ((LAS unsigned*)(F.lds + MISC_OFF))[u] = 0u;
    __syncthreads();
    XcdBarrier bar; bar.bar = (unsigned*)(F.ctl + CW_BAR); bar.x = 0; bar.st = nullptr;
    if (N_LAUNCHES != NPH) bar = xcd_barrier_post((unsigned*)(F.ctl + CW_BAR), F.MISC + 8);
    const int lo = args.ph_lo, hi = args.ph_hi;
#ifndef PH_MASK
#define PH_MASK 0x7fff
#endif
#define IN(k) ((((PH_MASK) >> (k)) & 1) && lo <= (k) && (k) < hi)
#ifdef STRESS_US
#define SKEW() do { if ((blockIdx.x * 2654435761u >> 28) & 1) { const unsigned long long t0_ = __builtin_amdgcn_s_memrealtime(); while (__builtin_amdgcn_s_memrealtime() - t0_ < (unsigned long long)(STRESS_US) * 100ull) __builtin_amdgcn_s_sleep(8); } __syncthreads(); } while (0)
#else
#define SKEW() do { } while (0)
#endif
#define SEAM(k) do { if (IN(k) && IN((k) + 1)) { xcd_barrier(bar); SKEW(); } } while (0)
#ifndef REP_MASK
#define REP_MASK 0
#endif
#define REPS(k) for (int rep_ = 0; rep_ < ((((REP_MASK) >> (k)) & 1) ? 2 : 1); ++rep_, ((((REP_MASK) >> (k)) & 1) && rep_ == 1 ? xcd_barrier(bar) : (void)0))
    const int G = F.G, bx = (int)blockIdx.x;

#ifdef START_BARS
    for (int xb_ = 0; xb_ < START_BARS; ++xb_) xcd_barrier(bar);
#endif
    if (IN(0)) REPS(0) { p0_prologue(F); } SEAM(0);
    if (IN(1)) REPS(1) {
        pg8::StaticOrder S; S.init((const bf16*)((unsigned char*)F.out + OUT_XB), (const bf16*)(F.ws + WS_WINT), MTOK, HYC, DM, G, bx);
        pg8::EpiHyT E{(bf16*)(F.ws + WS_PTHY), F.in[I_BIN], F.lds + pg8::STAGE_BYTES};
        pg8::gemm_phase<pg8::EpiHyT, pg8::StaticOrder, false>(F.lds, DM, S, E);
    } SEAM(1);
    if (IN(2)) REPS(2) { hyena_phase(F); } SEAM(2);
    if (IN(3)) REPS(3) { p3_transpose(F); } SEAM(3);
    if (IN(4)) REPS(4) {
        pg8::StaticOrder S; S.init((const bf16*)((unsigned char*)F.out + OUT_XB), (const bf16*)(F.ws + WS_WINT) + (size_t)3072 * DM, MTOK, 6400, DM, G, bx);
        pg8::EpiZXD E{(unsigned char*)F.out, (bf16*)(F.ws + WS_XBC), (float*)(F.ws + WS_DT), F.in[I_BIN], (bf16*)(F.ws + WS_HALO)};
        pg8::gemm_phase<pg8::EpiZXD, pg8::StaticOrder, false>(F.lds, DM, S, E);
    } SEAM(4);
    if (IN(5)) REPS(5) { ssd_conv_phase(F); } SEAM(5);
    if (IN(6)) REPS(6) { ssd_phase(F); } SEAM(6);
    if (IN(7)) REPS(7) { ssd_norm_phase(F); }
    if (IN(8)) REPS(8) {
        pg8::StaticOrder S; S.init((const bf16*)((unsigned char*)F.out + OUT_XB), (const bf16*)(F.ws + WS_WING), MTOK, 2048, DM, G, bx);
        pg8::EpiBf<0> E{(bf16*)(F.ws + WS_G), 2048, F.in[I_BIN] + 9280, nullptr, 0, nullptr};
        pg8::gemm_phase<pg8::EpiBf<0>, pg8::StaticOrder, false>(F.lds, DM, S, E);
    } SEAM(8);
    if (IN(9)) REPS(9) {
        pg8::StaticOrder S; S.init((const bf16*)(F.ws + WS_YHY), (const bf16*)(F.ws + WS_WHYB), MTOK, DM, DM, G, bx);
        pg8::EpiBf<1> E{(bf16*)(F.ws + WS_MIX), DM, nullptr, (const bf16*)(F.ws + WS_G), 2048, nullptr};
        pg8::gemm_phase<pg8::EpiBf<1>, pg8::StaticOrder, false>(F.lds, DM, S, E);
    }
    if (IN(10)) REPS(10) {
        pg8::StaticOrder S; S.init((const bf16*)(F.ws + WS_YSSD), (const bf16*)(F.ws + WS_WSSDB), MTOK, DM, DSSM, G, bx);
        pg8::EpiBf<2> E{(bf16*)(F.ws + WS_MIX), DM, nullptr, (const bf16*)(F.ws + WS_G) + 1024, 2048, (const bf16*)(F.ws + WS_MIX)};
        pg8::gemm_phase<pg8::EpiBf<2>, pg8::StaticOrder, false>(F.lds, DSSM, S, E);
    } SEAM(10);
    if (IN(11)) REPS(11) {
        pg8::StaticOrder S; S.init((const bf16*)(F.ws + WS_MIX), (const bf16*)(F.ws + WS_WOUT), MTOK, DM, DM, G, bx);
        pg8::EpiRes E{(bf16*)(F.ws + WS_H1P), F.in[I_BOUT], (const bf16*)((unsigned char*)F.out + OUT_XB), DN_ALPHA};
        pg8::gemm_phase<pg8::EpiRes, pg8::StaticOrder, false>(F.lds, DM, S, E);
        p10_expert_weights(F);
    } SEAM(11);
    if (IN(12)) REPS(12) { ln1_router_phase(F); } SEAM(12);
    if (IN(13)) REPS(13) {
        const int total = moe_table(F);
        pg8::MoeOrder<2, true> S{(const LAS int*)(F.lds + MOE_TP), (const LAS int*)(F.lds + MOE_CNT), (const LAS int*)(F.lds + MOE_TE), G, bx, total, (const char*)F.out, (const char*)(F.ws + WS_EW1), (const int*)(F.ws + WS_TOK)};
        pg8::EpiSwiGLU E{(bf16*)(F.ws + WS_HID)};
        pg8::gemm_phase<pg8::EpiSwiGLU, pg8::MoeOrder<2, true>, true>(F.lds, DM, S, E);
    } SEAM(13);
    if (IN(14)) {
        const int total = moe_table(F);
        { pg8::SlotOrder4 S{(const LAS int*)(F.lds + MOE_TP), (const LAS int*)(F.lds + MOE_TE), G, bx, total, (const char*)(F.ws + WS_HID), (const char*)(F.ws + WS_EW2)};
          pg8::EpiSlot8 E{(unsigned char*)(F.ws + WS_YQ)}; int kd = DEXP; asm volatile("" : "+s"(kd));
          pg8::gemm_phase<pg8::EpiSlot8, pg8::SlotOrder4, false>(F.lds, kd, S, E); }
        xcd_barrier(bar);
        moe_combine_phase(F);
    }
#ifdef EXTRA_BARS
    for (int xb_ = 0; xb_ < EXTRA_BARS; ++xb_) xcd_barrier(bar);
#endif
#undef IN
#undef SEAM
}

extern "C" void kernel_launch(void* const* d_in, const int* in_sizes, int n_in, void* d_out, int out_size, void* d_ws, size_t ws_size, hipStream_t stream) {
    static int grid = 0;
    if (grid == 0) {
        if (n_in != 38 || out_size != MTOK * DM || ws_size < WS_END) { fprintf(stderr, "kernel_launch: unexpected shapes (n_in %d out %d ws %zu)\n", n_in, out_size, ws_size); grid = -1; return; }
        int dev = 0, cus = 0, per_cu = 0;
        if (hipGetDevice(&dev) != hipSuccess || hipDeviceGetAttribute(&cus, hipDeviceAttributeMultiprocessorCount, dev) != hipSuccess) { grid = -1; return; }
        if (hipFuncSetAttribute((const void*)fwd_kernel, hipFuncAttributeMaxDynamicSharedMemorySize, LDS_BYTES) != hipSuccess) { fprintf(stderr, "kernel_launch: hipFuncSetAttribute failed\n"); grid = -1; return; }
        if (hipOccupancyMaxActiveBlocksPerMultiprocessor(&per_cu, (const void*)fwd_kernel, NTHR, LDS_BYTES) != hipSuccess || per_cu < 1) fprintf(stderr, "kernel_launch: occupancy query says %d\n", per_cu);
        (void)hipGetLastError();
        grid = cus;
    }
    if (grid < 0) return;
#ifdef EXTRA_PHASE
    {
        (void)hipMemsetAsync((char*)d_ws + WS_CTL, 0, CTL_ZERO_BYTES, stream);
        Args x{}; for (int i = 0; i < 38; ++i) x.in[i] = (const float*)d_in[i];
        x.out = (float*)d_out; x.ws = (unsigned char*)d_ws; x.ph_lo = EXTRA_PHASE; x.ph_hi = EXTRA_PHASE + 1; x.li = 0;
        hipLaunchKernelGGL(fwd_kernel, dim3(grid), dim3(NTHR), LDS_BYTES, stream, x);
    }
#endif
    (void)hipMemsetAsync((char*)d_ws + WS_CTL, 0, CTL_ZERO_BYTES, stream);
    Args a{};
    for (int i = 0; i < 38; ++i) a.in[i] = (const float*)d_in[i];
    a.out = (float*)d_out; a.ws = (unsigned char*)d_ws;
    for (int li = 0; li < N_LAUNCHES; ++li) {
        a.ph_lo = (N_LAUNCHES == NPH) ? li : 0; a.ph_hi = (N_LAUNCHES == NPH) ? li + 1 : NPH; a.li = li;
        hipLaunchKernelGGL(fwd_kernel, dim3(grid), dim3(NTHR), LDS_BYTES, stream, a);
    }
}
```

```cpp
#define MK_N_LAUNCHES 1
#include <hip/hip_runtime.h>
#include <cstdio>
#include <cstdint>

#define LAS __attribute__((address_space(3)))
#define GAS __attribute__((address_space(1)))
typedef unsigned short bf16;
typedef short bf16x8 __attribute__((ext_vector_type(8)));
typedef float f32x4 __attribute__((ext_vector_type(4)));
typedef float f32x2 __attribute__((ext_vector_type(2)));
typedef unsigned u32x4 __attribute__((ext_vector_type(4)));
typedef unsigned u32x2 __attribute__((ext_vector_type(2)));
typedef GAS unsigned gu32;

constexpr int BATCH = 16, SEQ = 2048, DM = 1024, MTOK = BATCH * SEQ;
constexpr int HYC = 3072, DSSM = 2048, CONVD = 4096, NHEAD = 32, NGRP = 8, NSTATE = 128, INC = 11328;
constexpr int NE = 64, TOPK = 8, DEXP = 256, NEX = NE + 1;
constexpr float DN_ALPHA = 1.189207115002721f;
constexpr float LN_EPS = 1e-5f, RMS_EPS = 1e-5f, ROUTED_SCALE = 2.5f;
constexpr int NWAVES = 8, NTHR = 512;
constexpr int WIN_ROWS = 11520;

constexpr size_t MiB = 1u << 20;
constexpr size_t WS_CTL = 0, CTL_ZERO_BYTES = 256 * 1024;
constexpr size_t WS_WHYB = 1 * MiB, WS_WSSDB = 3 * MiB, WS_WOUT = 7 * MiB;
constexpr size_t WS_XB = 9 * MiB;
constexpr size_t WS_WINT = 73 * MiB;
constexpr size_t WS_KERN = 96 * MiB;
constexpr size_t WS_PTHY = 112 * MiB;
constexpr size_t WS_YTHY = 304 * MiB;
constexpr size_t WS_YHY = 137 * MiB;
constexpr size_t WS_XBC = 201 * MiB;
constexpr size_t WS_DT = 457 * MiB;
constexpr size_t WS_HALO = 465 * MiB;
constexpr size_t WS_YSSD = 9 * MiB;
constexpr size_t WS_XB2 = 201 * MiB;
constexpr size_t WS_WING = 505 * MiB;
constexpr size_t WS_G = 269 * MiB;
constexpr size_t WS_MIX = 397 * MiB;
constexpr int H1B_PITCH = 2048;
constexpr size_t WS_EW1 = 9 * MiB;
constexpr size_t WS_EW2 = 477 * MiB;
constexpr size_t WS_YQ = 1 * MiB;
constexpr size_t WS_ASG = 510 * MiB;
constexpr size_t WS_H1P = 177 * MiB;
constexpr size_t WS_HID = 305 * MiB;
constexpr size_t WS_TOK = 461 * MiB;
constexpr size_t WS_WGT = 469 * MiB;
constexpr size_t WS_END = 511 * MiB;
constexpr size_t OUT_XB = 64 * MiB;
constexpr int CW_BAR = 4096;
constexpr int CW_CNT = 16384;
constexpr int CW_DBG = 32768;

constexpr int LDS_BYTES = 163840;
constexpr int MISC_OFF = 163840 - 512;

#define RLX_AGENT __ATOMIC_RELAXED, __HIP_MEMORY_SCOPE_AGENT
#define LDS_WAIT() asm volatile("s_waitcnt lgkmcnt(0)" ::: "memory")
#define VM_WAIT() asm volatile("s_waitcnt vmcnt(0)" ::: "memory")
typedef __bf16 bf16x2_t __attribute__((ext_vector_type(2)));
__device__ __forceinline__ unsigned pk2(float lo, float hi) { const f32x2 v = {lo, hi}; return __builtin_bit_cast(unsigned, __builtin_convertvector(v, bf16x2_t)); }
__device__ __forceinline__ unsigned f2bf(float f) { return pk2(f, 0.f) & 0xffffu; }
__device__ __forceinline__ float bf2f(unsigned b) { return __builtin_bit_cast(float, b << 16); }
__device__ __forceinline__ float bflo(unsigned w) { return __builtin_bit_cast(float, w << 16); }
__device__ __forceinline__ float bfhi(unsigned w) { return __builtin_bit_cast(float, w & 0xffff0000u); }
__device__ __forceinline__ float sigmoidf_(float v) { return __builtin_amdgcn_rcpf(1.0f + __expf(-v)); }
__device__ __forceinline__ float siluf_(float v) { return v * __builtin_amdgcn_rcpf(1.0f + __expf(-v)); }
__device__ __forceinline__ float wave_sum(float v) {
#pragma unroll
    for (int o = 1; o < 64; o <<= 1) v += __shfl_xor(v, o);
    return v;
}
__device__ __forceinline__ float wave_max(float v) {
#pragma unroll
    for (int o = 1; o < 64; o <<= 1) v = fmaxf(v, __shfl_xor(v, o));
    return v;
}

#ifndef PG8_WGM
#define PG8_WGM 8
#endif
namespace pg8 {
constexpr int BM = 256, BK = 64, HALF = 128, HTB = HALF * BK * 2, STAGE_BYTES = 8 * HTB, NXCD = 8, WGM = PG8_WGM;
__host__ __device__ __forceinline__ int lds_byte(int r, int c) { const int st = (r >> 4) * 2 + (c >> 5), rr = r & 15, cc = c & 31, ob = rr * 64 + cc * 2; return st * 1024 + (ob ^ (((ob >> 9) & 1) << 5)); }
__host__ __device__ __forceinline__ void stage_rc(int b, int& R, int& C) { const int st = b / 1024, sb = b % 1024, swz = sb ^ (((sb >> 9) & 1) << 5); R = (st >> 1) * 16 + swz / 64; C = (st & 1) * 32 + (swz % 64) / 2; }
__host__ __device__ __forceinline__ int perm32(int rho) { const int n = rho >> 4, i = rho & 15; return 8 * (i >> 2) + 4 * n + (i & 3); }

struct Unit { int pm, pn; const char* A; const char* B; int e, cnt; };

struct StaticOrder {
    int nM, nN, nwg, G, c, K; const char* A; const char* B;
    __device__ void init(const bf16* A_, const bf16* B_, int M, int N, int K_, int G_, int c_) { A = (const char*)A_; B = (const char*)B_; nM = M / BM; nN = N / BM; nwg = nM * nN; G = G_; c = c_; K = K_; }
    __device__ __forceinline__ bool next(int i, Unit& u) const {
        const long L = (long)i * G + c; if (L >= nwg) return false;
        int wgid = (int)L; { const int q = nwg / NXCD, r = nwg % NXCD, xcd = wgid % NXCD, off = wgid / NXCD; wgid = (xcd < r ? xcd * (q + 1) : r * (q + 1) + (xcd - r) * q) + off; }
        const int nig = WGM * nN, gid = wgid / nig, fm = gid * WGM, gsz = (nM - fm) < WGM ? (nM - fm) : WGM;
        u.pm = fm + ((wgid % nig) % gsz); u.pn = (wgid % nig) / gsz;
        u.A = A + (size_t)u.pm * BM * K * 2; u.B = B + (size_t)u.pn * BM * K * 2; u.e = 0; u.cnt = 0; return true;
    }
    __device__ __forceinline__ unsigned row_off(const Unit&, int) const { return 0u; }
};

__device__ __forceinline__ unsigned cvt_pk_bf16(float lo, float hi) { unsigned r; asm volatile("v_cvt_pk_bf16_f32 %0, %1, %2" : "=v"(r) : "v"(lo), "v"(hi)); return r; }

#ifndef PG8_SP2
#define PG8_SP2 true
#endif
#ifndef PG8_ALIGN
#define PG8_ALIGN true
#endif
template <class Epi, class Sched, bool GATHER, bool SP2 = PG8_SP2, bool ALIGN_EPI = PG8_ALIGN>
__device__ __forceinline__ void gemm_phase(LAS unsigned char* lds, const int K, const Sched& S, const Epi& E) {
    constexpr bool TA = Epi::TA;
    const int tid = threadIdx.x, wid = __builtin_amdgcn_readfirstlane(tid >> 6), lane = tid & 63, wr = wid >> 2, wc = wid & 3, fr = lane & 15, fq = lane >> 4;
    const int nt = K / BK;
    unsigned voffA[2][2], voffB[2]; int RA[2], CA[2];
#pragma unroll
    for (int i = 0; i < 2; ++i) { int R, C; stage_rc(tid * 16 + i * 8192, R, C);
        const int Rb = Epi::PERM == 3 ? (64 * (R >> 5) + 16 * ((R & 15) >> 2) + 4 * ((R >> 4) & 1) + (R & 3)) : (Epi::PERM == 2 ? (64 * (R >> 5) + perm32(R & 31)) : (Epi::PERM ? ((R & ~31) + perm32(R & 31)) : R));
        RA[i] = R; CA[i] = C; voffA[0][i] = (unsigned)(R * K + C) * 2u; voffA[1][i] = voffA[0][i]; voffB[i] = (unsigned)(Rb * K + C) * 2u; }
    const size_t kstep = (size_t)(BK * 2);
    const size_t hstep = (size_t)HALF * K * 2;
    const size_t hstepA = GATHER ? 0 : hstep;
    const size_t hstepB = (Epi::PERM == 3) ? (size_t)8 * K * 2 : ((Epi::PERM == 2) ? (size_t)32 * K * 2 : hstep);
    const unsigned ldsw = (unsigned)wid * 1024u;
    const int aoff = lds_byte(wr * 64 + fr, fq * 8), boff = lds_byte(wc * 32 + fr, fq * 8);
#define PG8_SA(b, h) (((b) * 2 + (h)) * HTB)
#define PG8_SB(b, h) ((4 + (b) * 2 + (h)) * HTB)
#define PG8_STAGE(bufoff, gbase, voff) do { _Pragma("unroll") for (int _i = 0; _i < 2; ++_i) \
        __builtin_amdgcn_global_load_lds((const unsigned*)((const char*)(gbase) + (voff)[_i]), (LAS unsigned*)(lds + (bufoff) + ldsw + _i * 8192), 16, 0, 0); } while (0)
#define PG8_STAGE_A(bufoff, gbase, h) PG8_STAGE(bufoff, (gbase) + (h) * hstepA, voffA[GATHER ? (h) : 0])
#define PG8_LDA(dst, b, h) do { _Pragma("unroll") for (int m = 0; m < 4; ++m) _Pragma("unroll") for (int k = 0; k < 2; ++k) dst[m][k] = *(const LAS bf16x8*)(lds + PG8_SA(b, h) + aoff + m * 2048 + k * 1024); } while (0)
#define PG8_LDB(dst, b, h) do { _Pragma("unroll") for (int n = 0; n < 2; ++n) _Pragma("unroll") for (int k = 0; k < 2; ++k) dst[n][k] = *(const LAS bf16x8*)(lds + PG8_SB(b, h) + boff + n * 2048 + k * 1024); } while (0)
#define PG8_MMA(ai, bj, At, Bt) do { __builtin_amdgcn_s_setprio(1); _Pragma("unroll") for (int m = 0; m < 4; ++m) _Pragma("unroll") for (int n = 0; n < 2; ++n) _Pragma("unroll") for (int k = 0; k < 2; ++k) \
        acc[ai][bj][m][n] = TA ? __builtin_amdgcn_mfma_f32_16x16x32_bf16(Bt[n][k], At[m][k], acc[ai][bj][m][n], 0, 0, 0) \
                               : __builtin_amdgcn_mfma_f32_16x16x32_bf16(At[m][k], Bt[n][k], acc[ai][bj][m][n], 0, 0, 0); __builtin_amdgcn_s_setprio(0); } while (0)
#define PG8_WAIT_V(n) asm volatile("s_waitcnt vmcnt(" #n ")" ::: "memory")
#define PG8_WAIT_L(n) asm volatile("s_waitcnt lgkmcnt(" #n ")" ::: "memory")
#define PG8_BAR __builtin_amdgcn_s_barrier()
#define PG8_SCHED __builtin_amdgcn_sched_barrier(0)
    Unit cur, nxt; int ui = 0;
    if (!S.next(0, cur)) return;
    if (GATHER) {
#pragma unroll
        for (int h = 0; h < 2; ++h)
#pragma unroll
            for (int i = 0; i < 2; ++i) voffA[h][i] = S.row_off(cur, h * HALF + RA[i]) + (unsigned)CA[i] * 2u;
    }
    f32x4 acc[2][2][4][2];
#pragma unroll
    for (int a = 0; a < 2; ++a)
#pragma unroll
        for (int b = 0; b < 2; ++b)
#pragma unroll
            for (int m = 0; m < 4; ++m)
#pragma unroll
                for (int n = 0; n < 2; ++n) acc[a][b][m][n] = (f32x4){0.f, 0.f, 0.f, 0.f};
    bf16x8 At[4][2], B0[2][2], B1[2][2];
    const char* cA = cur.A; const char* cB = cur.B;
    if constexpr (SP2) {
        PG8_STAGE(PG8_SB(0, 0), cB, voffB); PG8_STAGE(PG8_SB(0, 1), cB + hstepB, voffB); PG8_STAGE_A(PG8_SA(0, 0), cA, 0); PG8_STAGE_A(PG8_SA(0, 1), cA, 1);
        if (wr == 1) PG8_BAR;
        PG8_WAIT_V(2); PG8_BAR;
        PG8_STAGE(PG8_SB(1, 0), cB + kstep, voffB); PG8_STAGE_A(PG8_SA(1, 0), cA + kstep, 0); PG8_STAGE(PG8_SB(1, 1), cB + hstepB + kstep, voffB);
        PG8_WAIT_V(6); PG8_BAR;
    } else {
    PG8_STAGE(PG8_SB(0, 0), cB, voffB); PG8_STAGE_A(PG8_SA(0, 0), cA, 0); PG8_STAGE(PG8_SB(0, 1), cB + hstepB, voffB); PG8_STAGE_A(PG8_SA(0, 1), cA, 1);
    if (wr == 1) PG8_BAR;
    PG8_WAIT_V(4); PG8_BAR;
    PG8_STAGE(PG8_SB(1, 0), cB + kstep, voffB); PG8_STAGE_A(PG8_SA(1, 0), cA + kstep, 0); PG8_STAGE(PG8_SB(1, 1), cB + hstepB + kstep, voffB);
    PG8_WAIT_V(6); PG8_BAR;
    }
    for (;;) {
        const bool has_next = S.next(ui + 1, nxt);
        const char* nA = has_next ? nxt.A : cA; const char* nB = has_next ? nxt.B : cB;
        for (int t = 0; t < nt; t += 2) {
            const bool last = (t == nt - 2);
            const char* a1 = cA + (size_t)(t + 1) * kstep;
            const char* a2 = last ? nA : cA + (size_t)(t + 2) * kstep; const char* b2 = last ? nB : cB + (size_t)(t + 2) * kstep;
            const char* a3 = a2 + kstep; const char* b3 = b2 + kstep;
            if constexpr (SP2) {
            PG8_LDB(B0, 0, 0); PG8_LDB(B1, 0, 1); PG8_SCHED; PG8_LDA(At, 0, 0); PG8_STAGE_A(PG8_SA(1, 1), a1, 1);
            PG8_WAIT_V(8); PG8_WAIT_L(0); PG8_BAR; PG8_MMA(0, 0, At, B0); PG8_MMA(0, 1, At, B1); PG8_BAR; PG8_SCHED;
            if (GATHER) { if (last && has_next) {
#pragma unroll
                for (int h = 0; h < 2; ++h)
#pragma unroll
                    for (int i = 0; i < 2; ++i) voffA[h][i] = S.row_off(nxt, h * HALF + RA[i]) + (unsigned)CA[i] * 2u;
            } }
            PG8_LDA(At, 0, 1); PG8_STAGE(PG8_SB(0, 0), b2, voffB); PG8_STAGE(PG8_SB(0, 1), b2 + hstepB, voffB); PG8_STAGE_A(PG8_SA(0, 0), a2, 0);
            PG8_WAIT_V(8); PG8_WAIT_L(0); PG8_BAR; PG8_MMA(1, 0, At, B0); PG8_MMA(1, 1, At, B1); PG8_BAR; PG8_SCHED;
            PG8_LDB(B0, 1, 0); PG8_LDB(B1, 1, 1); PG8_SCHED; PG8_LDA(At, 1, 0); PG8_STAGE_A(PG8_SA(0, 1), a2, 1);
            PG8_WAIT_V(8); PG8_WAIT_L(0); PG8_BAR; PG8_MMA(0, 0, At, B0); PG8_MMA(0, 1, At, B1); PG8_BAR; PG8_SCHED;
            PG8_LDA(At, 1, 1); PG8_STAGE(PG8_SB(1, 0), b3, voffB); PG8_STAGE(PG8_SB(1, 1), b3 + hstepB, voffB); PG8_STAGE_A(PG8_SA(1, 0), a3, 0);
            PG8_WAIT_V(8); PG8_WAIT_L(0); PG8_BAR; PG8_MMA(1, 0, At, B0); PG8_MMA(1, 1, At, B1); PG8_BAR; PG8_SCHED;
            } else {
            PG8_LDB(B0, 0, 0); PG8_SCHED; PG8_LDA(At, 0, 0); PG8_STAGE_A(PG8_SA(1, 1), a1, 1);
            PG8_WAIT_L(8); PG8_BAR; PG8_WAIT_L(0); PG8_MMA(0, 0, At, B0); PG8_BAR; PG8_SCHED;
            if (GATHER) { if (last && has_next) {
#pragma unroll
                for (int h = 0; h < 2; ++h)
#pragma unroll
                    for (int i = 0; i < 2; ++i) voffA[h][i] = S.row_off(nxt, h * HALF + RA[i]) + (unsigned)CA[i] * 2u;
            } }
            PG8_LDB(B1, 0, 1); PG8_STAGE(PG8_SB(0, 0), b2, voffB);
            PG8_BAR; PG8_WAIT_L(0); PG8_MMA(0, 1, At, B1); PG8_BAR;
            PG8_LDA(At, 0, 1); PG8_STAGE_A(PG8_SA(0, 0), a2, 0);
            PG8_BAR; PG8_WAIT_L(0); PG8_MMA(1, 0, At, B0); PG8_BAR; PG8_SCHED;
            PG8_STAGE(PG8_SB(0, 1), b2 + hstepB, voffB);
            PG8_WAIT_V(6); PG8_BAR; PG8_MMA(1, 1, At, B1); PG8_BAR;
            PG8_LDB(B0, 1, 0); PG8_SCHED; PG8_LDA(At, 1, 0); PG8_STAGE_A(PG8_SA(0, 1), a2, 1);
            PG8_WAIT_L(8); PG8_BAR; PG8_WAIT_L(0); PG8_MMA(0, 0, At, B0); PG8_BAR; PG8_SCHED;
            PG8_LDB(B1, 1, 1); PG8_STAGE(PG8_SB(1, 0), b3, voffB);
            PG8_BAR; PG8_WAIT_L(0); PG8_MMA(0, 1, At, B1); PG8_BAR;
            PG8_LDA(At, 1, 1); PG8_STAGE_A(PG8_SA(1, 0), a3, 0);
            PG8_BAR; PG8_WAIT_L(0); PG8_MMA(1, 0, At, B0); PG8_BAR; PG8_SCHED;
            PG8_STAGE(PG8_SB(1, 1), b3 + hstepB, voffB);
            PG8_WAIT_V(6); PG8_BAR; PG8_MMA(1, 1, At, B1); PG8_BAR;
                    }
        }
        if constexpr (ALIGN_EPI) { if (wr == 0) PG8_BAR; }
        E(acc, cur, wr, wc, fr, fq);
        if (!has_next) break;
#pragma unroll
        for (int a = 0; a < 2; ++a)
#pragma unroll
            for (int b = 0; b < 2; ++b)
#pragma unroll
                for (int m = 0; m < 4; ++m)
#pragma unroll
                    for (int n = 0; n < 2; ++n) acc[a][b][m][n] = (f32x4){0.f, 0.f, 0.f, 0.f};
        cur = nxt; cA = nA; cB = nB; ++ui;
        if constexpr (ALIGN_EPI) { if (wr == 1) PG8_BAR; }
    }
    PG8_WAIT_V(0);
    if constexpr (!ALIGN_EPI) { if (wr == 0) PG8_BAR; }
    PG8_BAR;
#undef PG8_SA
#undef PG8_SB
#undef PG8_STAGE
#undef PG8_STAGE_A
#undef PG8_LDA
#undef PG8_LDB
#undef PG8_MMA
#undef PG8_WAIT_V
#undef PG8_WAIT_L
#undef PG8_BAR
#undef PG8_SCHED
}
}

namespace pg8 {
struct EpiHyT {
    static constexpr bool TA = false; static constexpr int PERM = 0;
    bf16* PT; const float* bias; LAS unsigned char* scr;
    __device__ __forceinline__ void operator()(const f32x4 (&acc)[2][2][4][2], const Unit& u, int wr, int wc, int fr, int fq) const {
        const int lane = fq * 16 + fr, lc = lane >> 3, lp = lane & 7;
        LAS unsigned char* s = scr + (wr * 4 + wc) * 2304;
        LAS unsigned char* wp = s + fr * 144 + 8 * fq;
        const LAS unsigned char* rp = s + lc * 144 + 16 * lp;
#pragma unroll
        for (int bj = 0; bj < 2; ++bj)
#pragma unroll
            for (int n = 0; n < 2; ++n) {
                const int col0 = u.pn * BM + bj * HALF + wc * 32 + n * 16; const float bv = bias[col0 + fr];
                bf16* gp = PT + (size_t)(col0 + lc) * MTOK + u.pm * BM + wr * 64 + 8 * lp;
#pragma unroll
                for (int ai = 0; ai < 2; ++ai) {
#pragma unroll
                    for (int m = 0; m < 4; ++m) { const f32x4 v = acc[ai][bj][m][n] + bv; u32x2 w; w.x = cvt_pk_bf16(v[0], v[1]); w.y = cvt_pk_bf16(v[2], v[3]);
                        *(LAS u32x2*)(wp + 32 * m) = w; }
                    const u32x4 r0 = *(const LAS u32x4*)rp, r1 = *(const LAS u32x4*)(rp + 8 * 144);
                    *(u32x4*)(gp + ai * HALF) = r0; *(u32x4*)(gp + ai * HALF + (size_t)8 * MTOK) = r1; }
            }
    }
};
__device__ __forceinline__ unsigned dpp_ror8(unsigned v) { return (unsigned)__builtin_amdgcn_update_dpp(0, (int)v, 0x128, 0xf, 0xf, false); }
__device__ __forceinline__ void xchg4(u32x4& u0, u32x4& u1, bool lo) { const u32x4 x = lo ? u1 : u0; u32x4 y; y.x = dpp_ror8(x.x); y.y = dpp_ror8(x.y); y.z = dpp_ror8(x.z); y.w = dpp_ror8(x.w); if (lo) u1 = y; else u0 = y; }
__device__ __forceinline__ void xchg2(u32x2& u0, u32x2& u1, bool lo) { const u32x2 x = lo ? u1 : u0; u32x2 y; y.x = dpp_ror8(x.x); y.y = dpp_ror8(x.y); if (lo) u1 = y; else u0 = y; }
struct EpiZXD {
    static constexpr bool TA = true; static constexpr int PERM = 2;
    unsigned char* Z8; bf16* XBC; float* DT; const float* b_in; bf16* HALO;
    __device__ __forceinline__ void operator()(const f32x4 (&acc)[2][2][4][2], const Unit& u, int wr, int wc, int fr, int fq) const {
        const bool lo = fr < 8; const int f7 = fr & 7;
        if (u.pn == 24) {
            if (wc == 0) { const int row0 = u.pm * BM + wr * 64 + fr;
#pragma unroll
                for (int bj = 0; bj < 2; ++bj)
#pragma unroll
                    for (int n = 0; n < 2; ++n) { const int c = 32 * bj + 8 * fq + 4 * n; const f32x4 bv = *(const f32x4*)(b_in + 9216 + c);
#pragma unroll
                        for (int ai = 0; ai < 2; ++ai)
#pragma unroll
                            for (int m = 0; m < 4; ++m) *(f32x4*)(DT + (size_t)(row0 + ai * HALF + m * 16) * 64 + c) = acc[ai][bj][m][n] + bv; } }
            return;
        }
        const int rowm = u.pm * BM + wr * 64 + f7;
        if (u.pn < 8) {
            const int cz = u.pn * BM + wc * 64 + 8 * fq;
            f32x4 bz[2][2];
#pragma unroll
            for (int bj = 0; bj < 2; ++bj) { bz[bj][0] = *(const f32x4*)(b_in + 3072 + cz + 32 * bj); bz[bj][1] = *(const f32x4*)(b_in + 3072 + cz + 32 * bj + 4); }
            unsigned char* zp = Z8 + (size_t)rowm * DSSM + cz + (lo ? 0 : 32);
#pragma unroll
            for (int ai = 0; ai < 2; ++ai)
#pragma unroll
                for (int m = 0; m < 4; ++m) { u32x2 p[2];
#pragma unroll
                    for (int bj = 0; bj < 2; ++bj) { const f32x4 v0 = acc[ai][bj][m][0] + bz[bj][0], v1 = acc[ai][bj][m][1] + bz[bj][1];
                        int w0 = __builtin_amdgcn_cvt_pk_fp8_f32(v0[0], v0[1], 0, false); w0 = __builtin_amdgcn_cvt_pk_fp8_f32(v0[2], v0[3], w0, true);
                        int w1 = __builtin_amdgcn_cvt_pk_fp8_f32(v1[0], v1[1], 0, false); w1 = __builtin_amdgcn_cvt_pk_fp8_f32(v1[2], v1[3], w1, true);
                        p[bj].x = (unsigned)w0; p[bj].y = (unsigned)w1; }
                    xchg2(p[0], p[1], lo);
                    unsigned char* q = zp + (size_t)(ai * HALF + m * 16) * DSSM;
                    *(u32x2*)q = p[0]; *(u32x2*)(q + (size_t)8 * DSSM) = p[1]; }
            return;
        }
        const int colt = (u.pn - 8) * BM, cx = colt + wc * 64 + 8 * fq;
        f32x4 bv[2][2];
#pragma unroll
        for (int bj = 0; bj < 2; ++bj)
#pragma unroll
            for (int n = 0; n < 2; ++n) bv[bj][n] = *(const f32x4*)(b_in + 5120 + cx + 32 * bj + 4 * n);
        const int cm = cx + (lo ? 0 : 32);
#pragma unroll
        for (int ai = 0; ai < 2; ++ai)
#pragma unroll
            for (int m = 0; m < 4; ++m) { u32x4 p[2];
#pragma unroll
                for (int bj = 0; bj < 2; ++bj) { const f32x4 v0 = acc[ai][bj][m][0] + bv[bj][0], v1 = acc[ai][bj][m][1] + bv[bj][1];
                    p[bj].x = cvt_pk_bf16(v0[0], v0[1]); p[bj].y = cvt_pk_bf16(v0[2], v0[3]); p[bj].z = cvt_pk_bf16(v1[0], v1[1]); p[bj].w = cvt_pk_bf16(v1[2], v1[3]); }
                xchg4(p[0], p[1], lo);
#pragma unroll
                for (int hb = 0; hb < 2; ++hb) { const int row = rowm + ai * HALF + m * 16 + 8 * hb;
                    *(u32x4*)(XBC + (size_t)row * CONVD + cm) = p[hb];
                    if ((m == 3 && hb == 1 && f7 >= 6) || (m == 0 && hb == 0 && f7 < 2)) {
                        const int bb = row >> 11, t = row & 2047, tm = t & 63;
                        const int jb = (tm >= 62) ? (t >> 6) + 1 : (t >> 6), idx = (tm >= 62) ? tm - 62 : 2 + tm;
                        *(u32x4*)(HALO + ((size_t)(bb * 33 + jb) * 4 + idx) * CONVD + cm) = p[hb]; } } }
    }
};
template <int MODE> struct EpiBf {
    static constexpr bool TA = true; static constexpr int PERM = 2;
    bf16* O; int ldc; const float* bias; const bf16* G1; int ldg; const bf16* P;
    __device__ __forceinline__ void operator()(const f32x4 (&acc)[2][2][4][2], const Unit& u, int wr, int wc, int fr, int fq) const {
        const bool lo = fr < 8; const int rowm = u.pm * BM + wr * 64 + (fr & 7), co = u.pn * BM + wc * 64 + 8 * fq, cm = co + (lo ? 0 : 32);
        f32x4 bb[2][2];
        if (MODE == 0) {
#pragma unroll
            for (int bj = 0; bj < 2; ++bj) { bb[bj][0] = *(const f32x4*)(bias + co + 32 * bj); bb[bj][1] = *(const f32x4*)(bias + co + 32 * bj + 4); } }
#pragma unroll
        for (int ai = 0; ai < 2; ++ai)
#pragma unroll
            for (int m = 0; m < 4; ++m) { const size_t r0 = (size_t)(rowm + ai * HALF + m * 16), r1 = r0 + 8; u32x4 g[2], pp[2], w[2];
                if (MODE != 0) { g[0] = *(const u32x4*)(G1 + r0 * ldg + cm); g[1] = *(const u32x4*)(G1 + r1 * ldg + cm);
                    if (MODE == 2) { pp[0] = *(const u32x4*)(P + r0 * ldc + cm); pp[1] = *(const u32x4*)(P + r1 * ldc + cm); }
                    xchg4(g[0], g[1], lo); if (MODE == 2) xchg4(pp[0], pp[1], lo); }
#pragma unroll
                for (int bj = 0; bj < 2; ++bj) { f32x4 v0 = acc[ai][bj][m][0], v1 = acc[ai][bj][m][1];
                    if (MODE == 0) { v0 = v0 + bb[bj][0]; v1 = v1 + bb[bj][1];
#pragma unroll
                        for (int j = 0; j < 4; ++j) { v0[j] = sigmoidf_(v0[j]); v1[j] = sigmoidf_(v1[j]); } }
                    else { const u32x4 gg = g[bj];
                        v0[0] *= bflo(gg.x); v0[1] *= bfhi(gg.x); v0[2] *= bflo(gg.y); v0[3] *= bfhi(gg.y); v1[0] *= bflo(gg.z); v1[1] *= bfhi(gg.z); v1[2] *= bflo(gg.w); v1[3] *= bfhi(gg.w);
                        if (MODE == 2) { const u32x4 p = pp[bj];
                            v0[0] += bflo(p.x); v0[1] += bfhi(p.x); v0[2] += bflo(p.y); v0[3] += bfhi(p.y); v1[0] += bflo(p.z); v1[1] += bfhi(p.z); v1[2] += bflo(p.w); v1[3] += bfhi(p.w); } }
                    w[bj].x = cvt_pk_bf16(v0[0], v0[1]); w[bj].y = cvt_pk_bf16(v0[2], v0[3]); w[bj].z = cvt_pk_bf16(v1[0], v1[1]); w[bj].w = cvt_pk_bf16(v1[2], v1[3]); }
                xchg4(w[0], w[1], lo);
                *(u32x4*)(O + r0 * ldc + cm) = w[0]; *(u32x4*)(O + r1 * ldc + cm) = w[1]; }
    }
};
struct EpiRes {
    static constexpr bool TA = true; static constexpr int PERM = 2;
    bf16* O; const float* bias; const bf16* X; float alpha;
    __device__ __forceinline__ void operator()(const f32x4 (&acc)[2][2][4][2], const Unit& u, int wr, int wc, int fr, int fq) const {
        const bool lo = fr < 8; const int rowm = u.pm * BM + wr * 64 + (fr & 7), co = u.pn * BM + wc * 64 + 8 * fq, cm = co + (lo ? 0 : 32);
        f32x4 bb[2][2];
#pragma unroll
        for (int bj = 0; bj < 2; ++bj) { bb[bj][0] = *(const f32x4*)(bias + co + 32 * bj); bb[bj][1] = *(const f32x4*)(bias + co + 32 * bj + 4); }
#pragma unroll
        for (int ai = 0; ai < 2; ++ai)
#pragma unroll
            for (int m = 0; m < 4; ++m) { const size_t o0 = (size_t)(rowm + ai * HALF + m * 16) * DM + cm, o1 = o0 + (size_t)8 * DM; u32x4 x[2], w[2];
                x[0] = *(const u32x4*)(X + o0); x[1] = *(const u32x4*)(X + o1); xchg4(x[0], x[1], lo);
#pragma unroll
                for (int bj = 0; bj < 2; ++bj) { const u32x4 xv = x[bj]; f32x4 v0 = acc[ai][bj][m][0] + bb[bj][0], v1 = acc[ai][bj][m][1] + bb[bj][1];
                    v0[0] += alpha * bflo(xv.x); v0[1] += alpha * bfhi(xv.x); v0[2] += alpha * bflo(xv.y); v0[3] += alpha * bfhi(xv.y);
                    v1[0] += alpha * bflo(xv.z); v1[1] += alpha * bfhi(xv.z); v1[2] += alpha * bflo(xv.w); v1[3] += alpha * bfhi(xv.w);
                    w[bj].x = cvt_pk_bf16(v0[0], v0[1]); w[bj].y = cvt_pk_bf16(v0[2], v0[3]); w[bj].z = cvt_pk_bf16(v1[0], v1[1]); w[bj].w = cvt_pk_bf16(v1[2], v1[3]); }
                xchg4(w[0], w[1], lo);
                *(u32x4*)(O + o0) = w[0]; *(u32x4*)(O + o1) = w[1]; }
    }
};
struct EpiSwiGLU {
    static constexpr bool TA = true; static constexpr int PERM = 1;
    bf16* HID;
    __device__ __forceinline__ void operator()(const f32x4 (&acc)[2][2][4][2], const Unit& u, int wr, int wc, int fr, int fq) const {
        const int row0 = u.pm * BM + wr * 64 + fr, col0 = u.pn * HALF + wc * 32 + 8 * fq;
#pragma unroll
        for (int ai = 0; ai < 2; ++ai)
#pragma unroll
            for (int m = 0; m < 4; ++m) { f32x4 v0, v1;
#pragma unroll
                for (int j = 0; j < 4; ++j) { v0[j] = siluf_(acc[ai][0][m][0][j]) * acc[ai][1][m][0][j]; v1[j] = siluf_(acc[ai][0][m][1][j]) * acc[ai][1][m][1][j]; }
                u32x4 w; w.x = cvt_pk_bf16(v0[0], v0[1]); w.y = cvt_pk_bf16(v0[2], v0[3]); w.z = cvt_pk_bf16(v1[0], v1[1]); w.w = cvt_pk_bf16(v1[2], v1[3]);
                *(u32x4*)(HID + (size_t)(row0 + ai * HALF + m * 16) * DEXP + col0) = w; }
    }
};
struct EpiScatter {
    static constexpr bool TA = false; static constexpr int PERM = 0;
    float* ACC; const int* tok; const float* wgt; int j0_unused;
    __device__ __forceinline__ void operator()(const f32x4 (&acc)[2][2][4][2], const Unit& u, int wr, int wc, int fr, int fq) const {
        asm volatile("" : "+v"(fr), "+v"(fq));
        const int jt = u.pn >> 2, ct = u.pn & 3;
#pragma unroll
        for (int ai = 0; ai < 2; ++ai)
#pragma unroll
            for (int m = 0; m < 4; ++m)
#pragma unroll
                for (int j = 0; j < 4; ++j) { const int r = ai * HALF + wr * 64 + m * 16 + 4 * fq + j;
                    if (r < u.cnt) { int token; float w;
                        if (u.e == NE) { token = jt * BM + r; w = 1.0f; } else { const size_t li = (size_t)u.e * MTOK + (size_t)jt * BM + r; token = tok[li]; w = wgt[li]; }
                        float* rowp = ACC + (size_t)token * DM + ct * BM + wc * 32 + fr;
#pragma unroll
                        for (int bj = 0; bj < 2; ++bj)
#pragma unroll
                            for (int n = 0; n < 2; ++n) unsafeAtomicAdd(rowp + bj * HALF + n * 16, w * acc[ai][bj][m][n][j]);
                    }
                    asm volatile("" ::: "memory"); }
    }
};

struct EpiSlot8 {
    static constexpr bool TA = true; static constexpr int PERM = 3;
    unsigned char* YQ;
    __device__ __forceinline__ void operator()(const f32x4 (&acc)[2][2][4][2], const Unit& u, int wr, int wc, int fr, int fq) const {
        asm volatile("" : "+v"(fr), "+v"(fq));
        const int row0 = u.pm * BM + wr * 64 + fr, col0 = u.pn * 256 + wc * 64 + 16 * fq;
#pragma unroll
        for (int ai = 0; ai < 2; ++ai)
#pragma unroll
            for (int m = 0; m < 4; ++m) { u32x4 w;
#pragma unroll
                for (int bj = 0; bj < 2; ++bj) { const f32x4 v0 = acc[ai][bj][m][0], v1 = acc[ai][bj][m][1];
                    int w0 = __builtin_amdgcn_cvt_pk_fp8_f32(v0[0], v0[1], 0, false); w0 = __builtin_amdgcn_cvt_pk_fp8_f32(v0[2], v0[3], w0, true);
                    int w1 = __builtin_amdgcn_cvt_pk_fp8_f32(v1[0], v1[1], 0, false); w1 = __builtin_amdgcn_cvt_pk_fp8_f32(v1[2], v1[3], w1, true);
                    if (bj == 0) { w.x = (unsigned)w0; w.y = (unsigned)w1; } else { w.z = (unsigned)w0; w.w = (unsigned)w1; } }
                *(u32x4*)(YQ + (size_t)(row0 + ai * HALF + m * 16) * 1024 + col0) = w; }
    }
};
struct SlotOrder4 {
    const LAS int* tp; const LAS int* te; int G, c, total; const char* A; const char* W;
    __device__ __forceinline__ bool next(int i, Unit& u) const {
        int tile, q;
        if (G == 256) { const int cx = c & 7, cj = c >> 3; q = cj & 3; tile = i * 64 + (cj >> 2) * 8 + cx; }
        else { const long L = (long)i * G + c; tile = (int)(L >> 2); q = (int)(L & 3); }
        if (tile >= total) return false;
        const int e = te[tile];
        u.e = e; u.cnt = 0; u.pm = tile; u.pn = q; u.A = A + (size_t)tile * BM * DEXP * 2; u.B = W + ((size_t)e * DM + (size_t)q * 256) * DEXP * 2;
        return true;
    }
    __device__ __forceinline__ unsigned row_off(const Unit&, int) const { return 0u; }
};
template <int NCT, bool FIRST> struct MoeOrder {
    const LAS int* tp; const LAS int* cnt; const LAS int* te; int G, c, total;
    const char* A; const char* W; const int* tok;
    __device__ __forceinline__ bool next(int i, Unit& u) const {
        const long L = (long)i * G + c; if (L >= (long)total * NCT) return false;
        const int tile = (int)(L / NCT), ct = (int)(L % NCT);
        const int e = te[tile];
        const int jt = tile - tp[e];
        u.e = e; const int left = cnt[e] - jt * BM; u.cnt = left < BM ? left : BM;
        if (FIRST) { u.pm = tile; u.pn = ct; u.A = A; u.B = W + ((size_t)e * 512 + (size_t)ct * 256) * DM * 2; }
        else { u.pm = tile; u.pn = jt * 4 + ct; u.A = A + (size_t)tile * BM * DEXP * 2; u.B = W + ((size_t)e * DM + (size_t)ct * 256) * DEXP * 2; }
        return true;
    }
    __device__ __forceinline__ unsigned row_off(const Unit& u, int r) const {
        const int jt = u.pm - tp[u.e]; int token;
        if (u.e == NE) token = jt * BM + r; else token = (r < u.cnt) ? tok[(size_t)u.e * MTOK + (size_t)jt * BM + r] : 0;
        return (unsigned)token * (unsigned)(H1B_PITCH * 2);
    }
};
}

#define XB_TMO      128
#define XB_XCNT(j)  (256  + 64 * (j))
#define XB_XSUB(j)  (1280 + 64 * (j))
#define XB_XGEN(j)  (2304 + 64 * (j))
#define XB_TOP      3328
#define XB_TOPGEN   3392
#define XCD_BAR_WORDS 3456
#define XB_SPIN_CAP (1u << 18)
__device__ __forceinline__ unsigned xb_ld(unsigned* p)              { return __hip_atomic_load(p, __ATOMIC_RELAXED, __HIP_MEMORY_SCOPE_AGENT); }
__device__ __forceinline__ unsigned xb_add(unsigned* p, unsigned v) { return __hip_atomic_fetch_add(p, v, __ATOMIC_RELAXED, __HIP_MEMORY_SCOPE_AGENT); }
__device__ __forceinline__ unsigned xb_xcc_id() { return (unsigned)__builtin_amdgcn_s_getreg((3 << 11) | 20) & 0xFu; }
#define XB_SPIN(cond, bar) do { unsigned _sp = 0; while (cond) { __builtin_amdgcn_s_sleep(1); \
    if ((++_sp & 255u) == 0u) { if (xb_ld(&(bar)[XB_TMO])) break; if (_sp > XB_SPIN_CAP) { atomicAdd(&(bar)[XB_TMO], 1u); break; } } } } while (0)
struct XcdBarrier { unsigned* bar; unsigned x; volatile LAS unsigned* st; };
__device__ __forceinline__ XcdBarrier xcd_barrier_post(unsigned* bar, volatile LAS unsigned* st) {
    XcdBarrier b; b.bar = bar; b.x = xb_xcc_id(); b.st = st;
    if (threadIdx.x == 0) (void)xb_add(&bar[XB_XCNT(b.x)], 1u);
    return b;
}
__device__ __forceinline__ void xcd_barrier_complete(unsigned* bar, unsigned x, unsigned& nloc, unsigned& nx) {
    const unsigned G = gridDim.x * gridDim.y * gridDim.z;
    unsigned sum, cnt, mine, sp = 0u;
    for (;;) {
        sum = 0u; cnt = 0u; mine = 0u;
#pragma unroll
        for (unsigned j = 0; j < 16; ++j) { const unsigned c = xb_ld(&bar[XB_XCNT(j)]); sum += c; cnt += (c > 0u) ? 1u : 0u; mine = (j == x) ? c : mine; }
        if (sum == G) break;
        __builtin_amdgcn_s_sleep(1);
        if ((++sp & 255u) == 0u) { if (xb_ld(&bar[XB_TMO])) break; if (sp > XB_SPIN_CAP) { atomicAdd(&bar[XB_TMO], 1u); break; } }
    }
    nloc = mine > 0u ? mine : 1u; nx = cnt > 0u ? cnt : 1u;
}
__device__ __forceinline__ void xcd_barrier(const XcdBarrier& b) {
    asm volatile("s_waitcnt vmcnt(0)" ::: "memory");
    __syncthreads();
    if (threadIdx.x == 0) {
        unsigned* bar = b.bar;
        __builtin_amdgcn_s_waitcnt(0);
        unsigned nloc = b.st[0], nx = b.st[1];
        if (nloc == 0u) { xcd_barrier_complete(bar, b.x, nloc, nx); b.st[0] = nloc; b.st[1] = nx; }
        const unsigned old = xb_add(&bar[XB_XSUB(b.x)], 1u);
        const unsigned gen = old / nloc;
        if (old + 1u == (gen + 1u) * nloc) {
            __builtin_amdgcn_fence(__ATOMIC_RELEASE, "agent");
            asm volatile("s_waitcnt vmcnt(0)" ::: "memory");
            const unsigned og = xb_add(&bar[XB_TOP], 1u);
            const unsigned tg = og / nx;
            if (og + 1u == (tg + 1u) * nx) xb_add(&bar[XB_TOPGEN], 1u);
            else XB_SPIN(xb_ld(&bar[XB_TOPGEN]) == tg, bar);
            __builtin_amdgcn_fence(__ATOMIC_ACQUIRE, "agent");
            xb_add(&bar[XB_XGEN(b.x)], 1u);
            asm volatile("s_waitcnt vmcnt(0)" ::: "memory");
        } else {
            XB_SPIN(xb_ld(&bar[XB_XGEN(b.x)]) == gen, bar);
            __builtin_amdgcn_fence(__ATOMIC_ACQUIRE, "agent");
            asm volatile("s_waitcnt vmcnt(0)" ::: "memory");
        }
    }
    __syncthreads();
}

struct Args {
    const float* in[38]; float* out; unsigned char* ws; int ph_lo, ph_hi, li, pad;
};
enum { I_X = 0, I_WIN, I_BIN, I_HCW, I_HCB, I_FW1, I_FB1, I_FF1, I_FW2, I_FB2, I_FF2, I_FW3, I_FB3, I_FF3, I_FW4, I_HBIAS,
       I_SCW, I_SCB, I_DTB, I_ALOG, I_SD, I_SNW, I_WHYB, I_WSSDB, I_WOUT, I_BOUT, I_LN1G, I_LN1B, I_RW, I_RB, I_EWG, I_EWU, I_EWD, I_SWG, I_SWU, I_SWD, I_LN2G, I_LN2B };
struct Frame {
    LAS unsigned char* lds; volatile LAS unsigned* MISC; gu32* ctl; unsigned char* ws;
    int tid, lane, wave, vcu, G;
    const float* const* in; float* out;
};

__device__ __forceinline__ void tr_item(const float* src, int ld_src, int k0, int c0, bf16* dst, int drow0, int ldd, LAS float* scr, int lane) {
    f32x4 ld[8];
#pragma unroll
    for (int i = 0; i < 8; ++i) ld[i] = *(const f32x4*)(src + (size_t)(k0 + 8 * i + (lane >> 3)) * ld_src + c0 + 4 * (lane & 7));
#pragma unroll
    for (int i = 0; i < 8; ++i) { LAS float* d = scr + (8 * i + (lane >> 3)) * 33 + 4 * (lane & 7); d[0] = ld[i][0]; d[1] = ld[i][1]; d[2] = ld[i][2]; d[3] = ld[i][3]; }
    LDS_WAIT(); asm volatile("" ::: "memory");
    const int c = lane & 7;
#pragma unroll
    for (int j = 0; j < 4; ++j) { const int n = (lane >> 3) + 8 * j; const LAS float* s = scr + (8 * c) * 33 + n;
        u32x4 o; o.x = pk2(s[0 * 33], s[1 * 33]); o.y = pk2(s[2 * 33], s[3 * 33]); o.z = pk2(s[4 * 33], s[5 * 33]); o.w = pk2(s[6 * 33], s[7 * 33]);
        *(u32x4*)(dst + (size_t)(drow0 + n) * ldd + k0 + 8 * c) = o; }
    LDS_WAIT(); asm volatile("" ::: "memory");
}
__device__ __forceinline__ void tr_matrix_item(const float* src, int ld_src, int K, int col_first, int ncols, bf16* dst, int drow_first, LAS float* scr, int it, int lane) {
    const int nblk = ncols / 32, kb = it / nblk, nb = it % nblk;
    tr_item(src, ld_src, kb * 64, col_first + nb * 32, dst, drow_first + nb * 32, K, scr, lane);
}
__device__ __forceinline__ void convert_x(Frame& F, const float* x, bf16* xb) {
    const size_t n8 = (size_t)MTOK * DM / 8; const size_t stride = (size_t)F.G * NTHR;
    for (size_t i = (size_t)F.vcu * NTHR + F.tid; i < n8; i += 4 * stride) {
        f32x4 a[4], b[4];
#pragma unroll
        for (int u = 0; u < 4; ++u) { const size_t k = (i + u * stride < n8) ? i + u * stride : i; a[u] = *(const f32x4*)(x + k * 8); b[u] = *(const f32x4*)(x + k * 8 + 4); }
#pragma unroll
        for (int u = 0; u < 4; ++u) { u32x4 o; o.x = pk2(a[u][0], a[u][1]); o.y = pk2(a[u][2], a[u][3]); o.z = pk2(b[u][0], b[u][1]); o.w = pk2(b[u][2], b[u][3]);
            if (i + u * stride < n8) *(u32x4*)(xb + (i + u * stride) * 8) = o; } }
}

__device__ __forceinline__ void hyena_filter(Frame& F) {
    const float* w1 = F.in[I_FW1]; const float* b1 = F.in[I_FB1]; const float* f1 = F.in[I_FF1];
    const float* w2 = F.in[I_FW2]; const float* b2 = F.in[I_FB2]; const float* f2 = F.in[I_FF2];
    const float* w3 = F.in[I_FW3]; const float* b3 = F.in[I_FB3]; const float* f3 = F.in[I_FF3];
    const float* w4 = F.in[I_FW4];
    bf16* KERN = (bf16*)(F.ws + WS_KERN);
    LAS float* hbuf = (LAS float*)(F.lds);
    const int lane = F.lane, wave = F.wave;
    for (int pg = F.vcu; pg < SEQ / 8; pg += F.G) {
        const int t = 8 * pg + wave;
        const float tn = (float)t / (float)(SEQ - 1), wv = 6.283185307179586f * (float)t / (float)SEQ;
        float zf = 0.f;
        if (lane == 0) zf = tn;
        else if (lane <= 16) { const float f = 1e-4f + (float)(lane - 1) * ((15.0f - 1e-4f) / 15.0f); zf = cosf(f * wv); }
        else if (lane <= 32) { const float f = 1e-4f + (float)(lane - 17) * ((15.0f - 1e-4f) / 15.0f); zf = -sinf(f * wv); }
        float s = b1[lane];
        for (int i = 0; i < 33; ++i) s += __shfl(zf, i) * w1[i * 64 + lane];
        float h = sinf(f1[lane] * s);
        s = b2[lane];
        for (int i = 0; i < 64; ++i) s += __shfl(h, i) * w2[i * 64 + lane];
        h = sinf(f2[lane] * s);
        s = b3[lane];
        for (int i = 0; i < 64; ++i) s += __shfl(h, i) * w3[i * 64 + lane];
        h = sinf(f3[lane] * s);
        hbuf[wave * 64 + lane] = h;
        __syncthreads();
        { float a[8][8];
#pragma unroll
          for (int q = 0; q < 8; ++q)
#pragma unroll
              for (int p = 0; p < 8; ++p) a[q][p] = 0.f;
          float a0b[4] = {0.f, 0.f, 0.f, 0.f};
#pragma unroll 2
          for (int i = 0; i < 64; ++i) { float wv[8], hv[8];
#pragma unroll
              for (int q = 0; q < 8; ++q) wv[q] = w4[(size_t)i * 4096 + F.tid + 512 * q];
#pragma unroll
              for (int p = 0; p < 8; ++p) hv[p] = hbuf[p * 64 + i];
#pragma unroll
              for (int q = 0; q < 8; ++q)
#pragma unroll
                  for (int p = 0; p < 8; ++p) a[q][p] += hv[p] * wv[q];
              if (pg == 0) { a0b[0] += hv[0] * wv[2]; a0b[1] += hv[0] * wv[3]; a0b[2] += hv[0] * wv[6]; a0b[3] += hv[0] * wv[7]; } }
#pragma unroll
          for (int q = 0; q < 8; ++q) { const int col = F.tid + 512 * q, c = col & 1023, dir = (q >> 1) & 1, o = q >> 2;
              const float adel = 3.0701134573253945f + (float)c * ((15.350567286626973f - 3.0701134573253945f) / 1023.0f);
              bf16* kc = KERN + ((size_t)c * 2 + o) * 4096;
#pragma unroll
              for (int p = 0; p < 8; ++p) { const int tp = 8 * pg + p; const float v = a[q][p] * __expf(-((float)tp / (float)(SEQ - 1)) * adel);
                  if (tp == 0) { if (dir == 0) { kc[2048] = (bf16)f2bf(v + a0b[(q & 1) + 2 * o]); kc[0] = 0; } }
                  else kc[dir == 0 ? 2048 - tp : 2048 + tp] = (bf16)f2bf(v); } } }
        __syncthreads();
    }
}

__device__ __forceinline__ void p0_prologue(Frame& F) {
    LAS float* scr = (LAS float*)(F.lds + 4096 + F.wave * 16384);
    const int gw = F.vcu * NWAVES + F.wave, NGW = F.G * NWAVES;
    const bool late_filter = (blockIdx.x & 1);
    bf16* WINT = (bf16*)(F.ws + WS_WINT);
    constexpr int I_A = 16 * (9216 / 32), I_B = 16 * (64 / 32), I_C = 16 * (2048 / 32);
    constexpr int I_HY = 16 * 32, I_SS = 32 * 32, I_OUT = 16 * 32;
    constexpr int NITEMS = I_A + I_B + I_C + I_HY + I_SS + I_OUT;
#pragma unroll 1
    for (int s_ = 0; s_ < 2; ++s_) {
    if ((s_ == 1) == late_filter) { hyena_filter(F); continue; }
    for (int it = gw; it < NITEMS; it += NGW) {
        int r = it;
        if (r < I_A) { tr_matrix_item(F.in[I_WIN], INC, DM, 0, 9216, WINT, 0, scr, r, F.lane); continue; } r -= I_A;
        if (r < I_B) { tr_matrix_item(F.in[I_WIN], INC, DM, 9216, 64, WINT, 9216, scr, r, F.lane); continue; } r -= I_B;
        if (r < I_C) { tr_matrix_item(F.in[I_WIN], INC, DM, 9280, 2048, (bf16*)(F.ws + WS_WING), 0, scr, r, F.lane); continue; } r -= I_C;
        if (r < I_HY) { tr_matrix_item(F.in[I_WHYB], DM, DM, 0, DM, (bf16*)(F.ws + WS_WHYB), 0, scr, r, F.lane); continue; } r -= I_HY;
        if (r < I_SS) { tr_matrix_item(F.in[I_WSSDB], DM, DSSM, 0, DM, (bf16*)(F.ws + WS_WSSDB), 0, scr, r, F.lane); continue; } r -= I_SS;
        tr_matrix_item(F.in[I_WOUT], DM, DM, 0, DM, (bf16*)(F.ws + WS_WOUT), 0, scr, r, F.lane);
    }
    convert_x(F, F.in[I_X], (bf16*)((unsigned char*)F.out + OUT_XB));
    __syncthreads();
    }
}
__device__ __forceinline__ void p6_reconvert(Frame& F) {
    LAS float* scr = (LAS float*)(F.lds + 4096 + F.wave * 16384);
    const int gw = F.vcu * NWAVES + F.wave, NGW = F.G * NWAVES;
    for (int it = gw; it < 16 * (2048 / 32); it += NGW) tr_matrix_item(F.in[I_WIN], INC, DM, 9280, 2048, (bf16*)(F.ws + WS_WING), 0, scr, it, F.lane);
    convert_x(F, F.in[I_X], (bf16*)(F.ws + WS_XB2));
}
__device__ __forceinline__ void p10_expert_weights(Frame& F) {
    LAS float* scr = (LAS float*)(F.lds + 4096 + F.wave * 16384);
    const int gw = F.vcu * NWAVES + F.wave, NGW = F.G * NWAVES;
    bf16* EW1 = (bf16*)(F.ws + WS_EW1); bf16* EW2 = (bf16*)(F.ws + WS_EW2);
    constexpr int PER1 = 16 * 4;
    constexpr int N1 = NEX * 2 * 2 * PER1, PER2 = 4 * 32, N2 = NEX * PER2;
    for (int it = gw; it < N1 + N2; it += NGW) {
        if (it < N1) { const int e = it / (4 * PER1), r0 = it % (4 * PER1), mat = r0 / (2 * PER1), r1 = r0 % (2 * PER1), ct = r1 / PER1, r2 = r1 % PER1;
            const float* src = (e < NE) ? F.in[mat ? I_EWU : I_EWG] + (size_t)e * DM * DEXP : F.in[mat ? I_SWU : I_SWG];
            tr_matrix_item(src, DEXP, DM, 128 * ct, 128, EW1 + (size_t)e * 512 * DM, 256 * ct + 128 * mat, scr, r2, F.lane); }
        else { const int r = it - N1, e = r / PER2, r2 = r % PER2;
            const float* src = (e < NE) ? F.in[I_EWD] + (size_t)e * DEXP * DM : F.in[I_SWD];
            tr_matrix_item(src, DM, DEXP, 0, DM, EW2 + (size_t)e * DM * DEXP, 0, scr, r2, F.lane); }
    }
}
__device__ __forceinline__ void p3_transpose(Frame& F) {
    const bf16* YT = (const bf16*)(F.ws + WS_YTHY); bf16* Y = (bf16*)(F.ws + WS_YHY);
    LAS bf16* scr = (LAS bf16*)(F.lds + F.wave * 9216);
    const int gw = F.vcu * NWAVES + F.wave, NGW = F.G * NWAVES, lane = F.lane;
    for (int tile = gw; tile < 16 * 512; tile += NGW) {
        const int c0 = (tile & 15) * 64, t0 = (tile >> 4) * 64;
#pragma unroll
        for (int p = 0; p < 8; ++p) { const int c = p * 8 + (lane >> 3), ch = lane & 7;
            const u32x4 g = *(const u32x4*)(YT + (size_t)(c0 + c) * MTOK + t0 + ch * 8);
            LAS bf16* d = scr + (ch * 8) * 72 + (c ^ (ch << 3));
            d[0 * 72] = (bf16)(g.x & 0xffff); d[1 * 72] = (bf16)(g.x >> 16); d[2 * 72] = (bf16)(g.y & 0xffff); d[3 * 72] = (bf16)(g.y >> 16);
            d[4 * 72] = (bf16)(g.z & 0xffff); d[5 * 72] = (bf16)(g.z >> 16); d[6 * 72] = (bf16)(g.w & 0xffff); d[7 * 72] = (bf16)(g.w >> 16); }
        LDS_WAIT(); asm volatile("" ::: "memory");
#pragma unroll
        for (int p = 0; p < 8; ++p) { const int tk = p * 8 + (lane >> 3), ch = lane & 7;
            const u32x4 v = *(const LAS u32x4*)(scr + tk * 72 + ((ch ^ ((tk >> 3) & 7)) << 3));
            *(u32x4*)(Y + (size_t)(t0 + tk) * DM + c0 + ch * 8) = v; }
        LDS_WAIT(); asm volatile("" ::: "memory");
    }
}

constexpr int HY_LDU = 2064, HY_KCS = 4128, HY_U_BYTES = 16 * HY_LDU * 2, HY_KC_BYTES = 8 * HY_KCS * 2;

struct HyKRow { u32x4 cur, prv; };
__device__ __forceinline__ void hy_load_kern(HyKRow& r, const bf16* kern, int tid) {
    r.cur = *(const u32x4*)(kern + 8 * tid);
    r.prv = (u32x4){0u, 0u, 0u, 0u};
    if (tid > 0) r.prv = *(const u32x4*)(kern + 8 * tid - 8);
}
__device__ __forceinline__ void hy_store_kc(LAS bf16* KC, const HyKRow& r, int tid) {
    const unsigned E[9] = {r.prv.x, r.prv.y, r.prv.z, r.prv.w, r.cur.x, r.cur.y, r.cur.z, r.cur.w, 0u};
#pragma unroll
    for (int fl = 0; fl < 8; ++fl) { const int sft = 8 - fl, k = sft >> 1;
        u32x4 o;
        if (sft & 1) { o.x = __builtin_amdgcn_alignbit(E[k + 1], E[k], 16); o.y = __builtin_amdgcn_alignbit(E[k + 2], E[k + 1], 16);
                       o.z = __builtin_amdgcn_alignbit(E[k + 3], E[k + 2], 16); o.w = __builtin_amdgcn_alignbit(E[k + 4], E[k + 3], 16); }
        else { o.x = E[k]; o.y = E[k + 1]; o.z = E[k + 2]; o.w = E[k + 3]; }
        *(LAS u32x4*)(KC + fl * HY_KCS + 8 * tid) = o; }
}
__device__ __forceinline__ f32x4 hy_short4(const bf16* prow, int t0, float w0, float w1, float w2, float cb) {
    const u32x2 g = *(const u32x2*)(prow + t0);
    const float p0 = bflo(g.x), p1 = bfhi(g.x), p2 = bflo(g.y), p3 = bfhi(g.y);
    const float pm = (t0 > 0) ? bf2f(prow[t0 - 1]) : 0.f, pp = (t0 + 4 < SEQ) ? bf2f(prow[t0 + 4]) : 0.f;
    f32x4 r; r[0] = cb + w0 * pm + w1 * p0 + w2 * p1; r[1] = cb + w0 * p0 + w1 * p1 + w2 * p2; r[2] = cb + w0 * p1 + w1 * p2 + w2 * p3; r[3] = cb + w0 * p2 + w1 * p3 + w2 * pp;
    return r;
}
__device__ __forceinline__ f32x4 hy_conv4(const u32x2 g, float pm, float pp, float w0, float w1, float w2, float cb) {
    const float p0 = bflo(g.x), p1 = bfhi(g.x), p2 = bflo(g.y), p3 = bfhi(g.y);
    f32x4 r; r[0] = cb + w0 * pm + w1 * p0 + w2 * p1; r[1] = cb + w0 * p0 + w1 * p1 + w2 * p2; r[2] = cb + w0 * p1 + w1 * p2 + w2 * p3; r[3] = cb + w0 * p2 + w1 * p3 + w2 * pp;
    return r;
}
__device__ __forceinline__ void hyena_phase(Frame& F) {
    LAS bf16* U = (LAS bf16*)(F.lds); LAS bf16* KC = (LAS bf16*)(F.lds + HY_U_BYTES);
    const bf16* PT = (const bf16*)(F.ws + WS_PTHY); const bf16* KERN = (const bf16*)(F.ws + WS_KERN); bf16* YT = (bf16*)(F.ws + WS_YTHY);
    const float* cw = F.in[I_HCW]; const float* cbv = F.in[I_HCB]; const float* hb = F.in[I_HBIAS];
    const int tid = F.tid, lane = F.lane, w = F.wave, fr = lane & 15, fq = lane >> 4;
    u32x4 um[8]; unsigned ee[8]; HyKRow kr;
    auto load_v = [&](int c) { int tl = tid; asm volatile("" : "+v"(tl));
        const bf16* prow = PT + (size_t)(2048 + c) * MTOK + (size_t)(tl >> 8) * SEQ + (tl & 255) * 8;
#pragma unroll
        for (int it = 0; it < 8; ++it) { um[it] = *(const u32x4*)(prow + (size_t)(2 * it) * SEQ); ee[it] = 0u; }
        if (lane == 0 || lane == 63) {
#pragma unroll
            for (int it = 0; it < 8; ++it) { const int t8 = (tl & 255) * 8; const bf16* pr = prow + (size_t)(2 * it) * SEQ - t8;
                if (lane == 0) { if (t8 > 0) ee[it] = pr[t8 - 1]; } else { if (t8 + 8 < SEQ) ee[it] = pr[t8 + 8]; } } } };
    if (F.vcu < DM) { hy_load_kern(kr, KERN + ((size_t)F.vcu * 2 + 0) * 4096, tid); load_v(F.vcu); }
    for (int c = F.vcu; c < DM; c += F.G) {
        const bool has_next = (c + F.G < DM);
        hy_store_kc(KC, kr, tid);
        { const int vc = 2048 + c; const float w0 = cw[0 * HYC + vc], w1 = cw[1 * HYC + vc], w2 = cw[2 * HYC + vc], cb = cbv[vc];
#pragma unroll
          for (int it = 0; it < 8; ++it) { const int idx = tid + 512 * it, b = idx >> 8, t8 = (idx & 255) * 8;
              const unsigned up = __shfl_up(um[it].w >> 16, 1), dn = __shfl_down(um[it].x & 0xffffu, 1);
              const float pm = bf2f(lane == 0 ? ee[it] : up), pp = bf2f(lane == 63 ? ee[it] : dn);
              u32x2 g0; g0.x = um[it].x; g0.y = um[it].y; u32x2 g1v; g1v.x = um[it].z; g1v.y = um[it].w;
              const f32x4 lo = hy_conv4(g0, pm, bflo(um[it].z), w0, w1, w2, cb), hi = hy_conv4(g1v, bfhi(um[it].y), pp, w0, w1, w2, cb);
              u32x4 o; o.x = pk2(lo[0], lo[1]); o.y = pk2(lo[2], lo[3]); o.z = pk2(hi[0], hi[1]); o.w = pk2(hi[2], hi[3]);
              *(LAS u32x4*)(U + b * HY_LDU + t8) = o; } }
        __syncthreads();
#pragma unroll
        for (int o = 0; o < 2; ++o) {
            const int gc = (o == 0) ? c : 1024 + c;
            int lz = lane; asm volatile("" : "+v"(lz));
            const bf16* grow = PT + (size_t)gc * MTOK + (size_t)(lz & 15) * SEQ;
            u32x2 gm[16];
#pragma unroll
            for (int tt = 0; tt < 16; ++tt) gm[tt] = *(const u32x2*)(grow + 256 * w + 16 * tt + 4 * fq);
            const unsigned edge_lo = (w > 0) ? (unsigned)grow[256 * w - 1] : 0u, edge_hi = (w < 7) ? (unsigned)grow[256 * w + 256] : 0u;
            if (o == 0) hy_load_kern(kr, KERN + ((size_t)c * 2 + 1) * 4096, tid);
            else if (has_next) hy_load_kern(kr, KERN + ((size_t)(c + F.G) * 2 + 0) * 4096, tid);
            f32x4 acc[16];
#pragma unroll
            for (int i = 0; i < 16; ++i) acc[i] = (f32x4){0.f, 0.f, 0.f, 0.f};
            const LAS bf16* kbase = KC + (fr & 7) * HY_KCS + 2048 + 8 * fq - 8 * (fr >> 3) - 256 * w;
            const LAS bf16* ubase = U + fr * HY_LDU + 8 * fq;
            bf16x8 win[16];
#pragma unroll
            for (int i = 0; i < 16; ++i) win[i] = *(const LAS bf16x8*)(kbase - 16 * i);
            bf16x8 bnx = *(const LAS bf16x8*)(ubase);
#define HY_TIE(a, b, c) asm volatile("s_waitcnt lgkmcnt(0)" : "+v"(a), "+v"(b), "+v"(c) :: "memory")
#pragma unroll 1
            for (int sj8 = 0; sj8 < 64; sj8 += 8) {
#pragma unroll
                for (int u = 0; u < 8; ++u) { const int sj = sj8 + u;
                    HY_TIE(bnx, win[(16 - 2 * u) & 15], win[(17 - 2 * u) & 15]);
                    const bf16x8 bfr = bnx;
#pragma unroll
                    for (int tt = 14; tt < 16; ++tt) acc[tt] = __builtin_amdgcn_mfma_f32_16x16x32_bf16(win[(tt - 2 * u) & 15], bfr, acc[tt], 0, 0, 0);
                    __builtin_amdgcn_sched_barrier(0);
                    bnx = *(const LAS bf16x8*)(ubase + 32 * ((sj + 1) & 63));
                    win[(14 - 2 * u) & 15] = *(const LAS bf16x8*)(kbase + 16 * (2 * sj + 2));
                    win[(15 - 2 * u) & 15] = *(const LAS bf16x8*)(kbase + 16 * (2 * sj + 1));
                    __builtin_amdgcn_sched_barrier(0);
#pragma unroll
                    for (int tt = 2; tt < 14; ++tt) acc[tt] = __builtin_amdgcn_mfma_f32_16x16x32_bf16(win[(tt - 2 * u) & 15], bfr, acc[tt], 0, 0, 0);
#pragma unroll
                    for (int tt = 0; tt < 2; ++tt) acc[tt] = __builtin_amdgcn_mfma_f32_16x16x32_bf16(win[(tt - 2 * u) & 15], bfr, acc[tt], 0, 0, 0);
                    __builtin_amdgcn_sched_barrier(0);
                } }
#undef HY_TIE
            if (o == 1 && has_next) load_v(c + F.G);
            const float hbias = hb[o * DM + c];
            const float w0 = cw[0 * HYC + gc], w1 = cw[1 * HYC + gc], w2 = cw[2 * HYC + gc], cb = cbv[gc];
            u32x2 zpk[16];
            unsigned pa[16], nb[16];
#pragma unroll
            for (int tt = 0; tt < 16; ++tt) { pa[tt] = __shfl(gm[tt].y >> 16, (lane + 48) & 63); nb[tt] = __shfl(gm[tt].x & 0xffffu, (lane + 16) & 63); }
#pragma unroll
            for (int tt = 0; tt < 16; ++tt) { const int t0 = 256 * w + 16 * tt + 4 * fq;
                const unsigned pmv = (fq > 0) ? pa[tt] : (tt > 0 ? pa[tt > 0 ? tt - 1 : 0] : edge_lo), ppv = (fq < 3) ? nb[tt] : (tt < 15 ? nb[tt < 15 ? tt + 1 : 15] : edge_hi);
                const u32x2 uu = *(const LAS u32x2*)(U + fr * HY_LDU + t0);
                const f32x4 g = hy_conv4(gm[tt], bf2f(pmv), bf2f(ppv), w0, w1, w2, cb);
                f32x4 y = acc[tt]; y[0] = g[0] * (y[0] + bflo(uu.x) * hbias); y[1] = g[1] * (y[1] + bfhi(uu.x) * hbias); y[2] = g[2] * (y[2] + bflo(uu.y) * hbias); y[3] = g[3] * (y[3] + bfhi(uu.y) * hbias);
                zpk[tt].x = pk2(y[0], y[1]); zpk[tt].y = pk2(y[2], y[3]); }
            __syncthreads();
            if (o == 0) {
#pragma unroll
                for (int tt = 0; tt < 16; ++tt) *(LAS u32x2*)(U + fr * HY_LDU + 256 * w + 16 * tt + 4 * fq) = zpk[tt];
                hy_store_kc(KC, kr, tid);
                __syncthreads();
            } else {
                int ly = lane; asm volatile("" : "+v"(ly));
                bf16* yrow = YT + (size_t)c * MTOK + (size_t)(ly & 15) * SEQ + 256 * w + 4 * (ly >> 4);
#pragma unroll
                for (int tt = 0; tt < 16; ++tt) *(u32x2*)(yrow + 16 * tt) = zpk[tt];
            }
        }
    }
}

__device__ __forceinline__ void ssd_conv_phase(Frame& F) {
    bf16* XBC = (bf16*)(F.ws + WS_XBC); const bf16* HALO = (const bf16*)(F.ws + WS_HALO);
    const float* scw = F.in[I_SCW]; const float* scb = F.in[I_SCB];
    const int gw = F.vcu * NWAVES + F.wave, NGW = F.G * NWAVES, lane = F.lane;
    for (int item = gw; item < BATCH * 32 * 8; item += NGW) {
        const int cb8 = item & 7, seg = (item >> 3) & 31, b = item >> 8, col = cb8 * 512 + lane * 8;
        float wk[5][8], cbv[8];
#pragma unroll
        for (int k = 0; k < 5; ++k) { const f32x4 a = *(const f32x4*)(scw + k * CONVD + col), c = *(const f32x4*)(scw + k * CONVD + col + 4);
#pragma unroll
            for (int e = 0; e < 4; ++e) { wk[k][e] = a[e]; wk[k][4 + e] = c[e]; } }
        { const f32x4 a = *(const f32x4*)(scb + col), c = *(const f32x4*)(scb + col + 4);
#pragma unroll
          for (int e = 0; e < 4; ++e) { cbv[e] = a[e]; cbv[4 + e] = c[e]; } }
        bf16* xrow0 = XBC + ((size_t)b * SEQ + seg * 64) * CONVD + col;
        const bf16* hlo = HALO + ((size_t)(b * 33 + seg) * 4) * CONVD + col;
        const bf16* hhi = HALO + ((size_t)(b * 33 + seg + 1) * 4 + 2) * CONVD + col;
        const u32x4 zero4 = {0u, 0u, 0u, 0u};
        u32x4 W[12];
        W[0] = seg > 0 ? *(const u32x4*)(hlo) : zero4; W[1] = seg > 0 ? *(const u32x4*)(hlo + CONVD) : zero4;
        W[2] = *(const u32x4*)(xrow0); W[3] = *(const u32x4*)(xrow0 + CONVD);
#pragma unroll 1
        for (int blk = 0; blk < 8; ++blk) { const int r0 = 8 * blk;
#pragma unroll
            for (int i = 4; i < 12; ++i) { const int rr = r0 - 2 + i;
                if (rr < 64) W[i] = *(const u32x4*)(xrow0 + (size_t)rr * CONVD);
                else W[i] = (seg < 31) ? *(const u32x4*)(hhi + (size_t)(rr - 64) * CONVD) : zero4; }
#pragma unroll
            for (int o = 0; o < 8; ++o) { float v[8];
#pragma unroll
                for (int e = 0; e < 8; ++e) v[e] = cbv[e];
#pragma unroll
                for (int k = 0; k < 5; ++k) { const u32x4 p = W[o + k];
                    v[0] += wk[k][0] * bflo(p.x); v[1] += wk[k][1] * bfhi(p.x); v[2] += wk[k][2] * bflo(p.y); v[3] += wk[k][3] * bfhi(p.y);
                    v[4] += wk[k][4] * bflo(p.z); v[5] += wk[k][5] * bfhi(p.z); v[6] += wk[k][6] * bflo(p.w); v[7] += wk[k][7] * bfhi(p.w); }
#pragma unroll
                for (int e = 0; e < 8; ++e) v[e] = siluf_(v[e]);
                u32x4 ov; ov.x = pk2(v[0], v[1]); ov.y = pk2(v[2], v[3]); ov.z = pk2(v[4], v[5]); ov.w = pk2(v[6], v[7]);
                *(u32x4*)(xrow0 + (size_t)(r0 + o) * CONVD) = ov; }
#pragma unroll
            for (int i = 0; i < 4; ++i) W[i] = W[8 + i];
        }
    }
}

constexpr int SS_LDC = 144, SS_LDM = 136;
constexpr int SS_C = 0, SS_B = 18432, SS_X = 36864, SS_XE = 55296, SS_M = 73728, SS_SB = 108544, SS_ACS = 145408, SS_DTV = 146432, SS_TOE = 147456, SS_END = 148480;
static_assert(SS_END <= MISC_OFF, "SSD LDS map");
typedef short s16x4 __attribute__((ext_vector_type(4)));
__device__ __forceinline__ bf16x8 ssd_trfrag(const LAS bf16* p) {
    const s16x4 a = __builtin_amdgcn_ds_read_tr16_b64_v4i16((LAS s16x4*)p), b = __builtin_amdgcn_ds_read_tr16_b64_v4i16((LAS s16x4*)(p + 16 * SS_LDC));
    return __builtin_shufflevector(a, b, 0, 1, 2, 3, 4, 5, 6, 7);
}

__device__ __forceinline__ void ssd_phase(Frame& F) {
    LAS unsigned char* L = F.lds;
    LAS bf16* Cl = (LAS bf16*)(L + SS_C); LAS bf16* Bl = (LAS bf16*)(L + SS_B); LAS bf16* Xr = (LAS bf16*)(L + SS_X); LAS bf16* XEr = (LAS bf16*)(L + SS_XE);
    LAS bf16* Ml = (LAS bf16*)(L + SS_M); LAS bf16* SB = (LAS bf16*)(L + SS_SB);
    LAS float* ACS = (LAS float*)(L + SS_ACS); LAS float* DTV = (LAS float*)(L + SS_DTV); LAS float* TOE = (LAS float*)(L + SS_TOE);
    const bf16* XBC = (const bf16*)(F.ws + WS_XBC); const float* DT = (const float*)(F.ws + WS_DT); const unsigned char* Z8 = (const unsigned char*)F.out; bf16* YS = (bf16*)(F.ws + WS_YSSD);
    const float* dtb = F.in[I_DTB]; const float* alog = F.in[I_ALOG]; const float* sd = F.in[I_SD];
    const int tid = F.tid, lane = F.lane, w = F.wave, fr = lane & 15, fq = lane >> 4;
    for (int unit = F.vcu; unit < BATCH * NGRP * 2; unit += F.G) {
        const int b = unit >> 4, g = (unit >> 1) & 7, hp = unit & 1, h0 = 4 * g + 2 * hp;
#pragma unroll 1
        for (int dir = 0; dir < 2; ++dir) {
            const float dtbias = (w < 2) ? dtb[dir * 32 + h0 + w] : 0.f, aexp = (w < 2) ? __expf(alog[dir * 32 + h0 + w]) : 0.f;
            auto scan = [&](int buf, float raw) {
                raw += dtbias; const float dtv = raw > 20.f ? raw : log1pf(__expf(raw)); float a = -dtv * aexp;
#pragma unroll
                for (int o = 1; o < 64; o <<= 1) { const float v = __shfl_up(a, o); if (lane >= o) a += v; }
                const float tot = __shfl(a, 63); const int ix = (buf * 2 + w) * 64 + lane;
                ACS[ix] = a; DTV[ix] = dtv; TOE[ix] = __expf(tot - a); };
            auto dtload = [&](int ci) -> float { const int ch = dir ? 31 - ci : ci, r = dir ? 63 - lane : lane;
                return DT[((size_t)b * SEQ + 64 * ch + r) * 64 + dir * 32 + h0 + w]; };
            auto rowload = [&](int ci, int it, int tl) -> u32x4 {
                const int l = (tl >> 4) + 32 * (it & 1), j = tl & 15, ch = dir ? 31 - ci : ci, r = dir ? 63 - l : l;
                const int col = (it < 2 ? 64 * h0 : (it < 4 ? 2048 + 128 * g : 3072 + 128 * g)) + 8 * j;
                return *(const u32x4*)(XBC + ((size_t)b * SEQ + 64 * ch + r) * CONVD + col); };
            f32x4 Sacc[8];
#pragma unroll
            for (int i = 0; i < 8; ++i) Sacc[i] = (f32x4){0.f, 0.f, 0.f, 0.f};
            const float dsk = sd[h0 + (w >> 2)];
            __syncthreads();
            for (int i = tid; i < 2 * 64 * SS_LDC / 2; i += NTHR) ((LAS unsigned*)SB)[i] = 0u;
            float dtn = 0.f;
            if (w < 2) { scan(0, dtload(0)); dtn = dtload(1); }
            u32x4 pf[6];
#pragma unroll
            for (int it = 0; it < 6; ++it) pf[it] = rowload(0, it, tid);
            __syncthreads();
#pragma unroll 1
            for (int ci = 0; ci < 32; ++ci) {
                const int ch = dir ? 31 - ci : ci, buf = ci & 1;
                const size_t tokbase = (size_t)b * SEQ + 64 * ch;
                int tl = tid; asm volatile("" : "+v"(tl));
                int frl = fr, fql = fq; asm volatile("" : "+v"(frl), "+v"(fql));
                const LAS float* acs = ACS + buf * 128; const LAS float* dtv = DTV + buf * 128; const LAS float* toe = TOE + buf * 128;
#pragma unroll
                for (int it = 0; it < 6; ++it) { const int l = (tl >> 4) + 32 * (it & 1), j = tl & 15; const u32x4 p = pf[it];
                    if (it < 2) { const int hh = j >> 3; const float de = dtv[hh * 64 + l] * toe[hh * 64 + l];
                        *(LAS u32x4*)(Xr + l * SS_LDC + j * 8) = p;
                        u32x4 q; q.x = pk2(bflo(p.x) * de, bfhi(p.x) * de); q.y = pk2(bflo(p.y) * de, bfhi(p.y) * de); q.z = pk2(bflo(p.z) * de, bfhi(p.z) * de); q.w = pk2(bflo(p.w) * de, bfhi(p.w) * de);
                        *(LAS u32x4*)(XEr + l * SS_LDC + j * 8) = q; }
                    else if (it < 4) { *(LAS u32x4*)(Bl + l * SS_LDC + j * 8) = p; }
                    else { *(LAS u32x4*)(Cl + l * SS_LDC + j * 8) = p; } }
                if (ci + 1 < 32) {
#pragma unroll
                    for (int it = 0; it < 6; ++it) pf[it] = rowload(ci + 1, it, tl); }
                __syncthreads();
                const int hh = w >> 2, li = w & 3, lrow = 16 * li + frl;
                const int rloc = dir ? 63 - lrow : lrow; const size_t tok = tokbase + rloc;
                u32x2 pv[4]; unsigned zv[4];
                if (dir) {
#pragma unroll
                    for (int pi = 0; pi < 4; ++pi) { const size_t o = tok * DSSM + 64 * (h0 + hh) + 16 * pi + 4 * fql; pv[pi] = *(const u32x2*)(YS + o); zv[pi] = *(const unsigned*)(Z8 + o); } }
#define SSD_FENCE() asm volatile("s_waitcnt lgkmcnt(0)" ::: "memory")
#define SSD_TIE8(a) asm volatile("s_waitcnt lgkmcnt(0)" : "+v"(a[0][0]), "+v"(a[0][1]), "+v"(a[1][0]), "+v"(a[1][1]), "+v"(a[2][0]), "+v"(a[2][1]), "+v"(a[3][0]), "+v"(a[3][1]) :: "memory")
#define SSD_TIE8K(a) asm volatile("s_waitcnt lgkmcnt(0)" : "+v"(a[0][0]), "+v"(a[0][1]), "+v"(a[0][2]), "+v"(a[0][3]), "+v"(a[1][0]), "+v"(a[1][1]), "+v"(a[1][2]), "+v"(a[1][3]) :: "memory")
                f32x4 Y[4];
                { bf16x8 cfr[4];
#pragma unroll
                  for (int kk = 0; kk < 4; ++kk) cfr[kk] = *(const LAS bf16x8*)(Cl + lrow * SS_LDC + 8 * fql + 32 * kk);
#pragma unroll
                  for (int ph = 0; ph < 2; ++ph) { bf16x8 sfr[2][4];
#pragma unroll
                      for (int pp = 0; pp < 2; ++pp)
#pragma unroll
                          for (int kk = 0; kk < 4; ++kk) sfr[pp][kk] = *(const LAS bf16x8*)(SB + (hh * 64 + 16 * (2 * ph + pp) + frl) * SS_LDC + 8 * fql + 32 * kk);
                      SSD_TIE8K(sfr);
#pragma unroll
                      for (int pp = 0; pp < 2; ++pp) { Y[2 * ph + pp] = (f32x4){0.f, 0.f, 0.f, 0.f};
#pragma unroll
                          for (int kk = 0; kk < 4; ++kk) Y[2 * ph + pp] = __builtin_amdgcn_mfma_f32_16x16x32_bf16(sfr[pp][kk], cfr[kk], Y[2 * ph + pp], 0, 0, 0); }
                      __builtin_amdgcn_sched_barrier(0); } }
                { bf16x8 cbA[2][4], cbB[2][4]; f32x4 tas[2], tdd[2]; float tal[2];
#pragma unroll
                  for (int q = 0; q < 2; ++q) { const int id = 2 * w + q, si = id >> 2, lj = id & 3;
                      if (si <= lj) {
#pragma unroll
                          for (int kk = 0; kk < 4; ++kk) { cbA[q][kk] = *(const LAS bf16x8*)(Bl + (16 * si + frl) * SS_LDC + 8 * fql + 32 * kk); cbB[q][kk] = *(const LAS bf16x8*)(Cl + (16 * lj + frl) * SS_LDC + 8 * fql + 32 * kk); } } }
                  auto tab_load = [&](int q) { const int id = 2 * w + q, si = id >> 2, lj = id & 3, l = 16 * lj + frl, s0 = 16 * si + 4 * fql;
#pragma unroll
                      for (int h = 0; h < 2; ++h) { tas[h] = *(const LAS f32x4*)(acs + 64 * h + s0); tdd[h] = *(const LAS f32x4*)(dtv + 64 * h + s0); tal[h] = acs[64 * h + l]; } };
                  tab_load(0);
                  SSD_FENCE();
#pragma unroll
                  for (int q = 0; q < 2; ++q) { const int id = 2 * w + q, si = id >> 2, lj = id & 3, l = 16 * lj + frl, s0 = 16 * si + 4 * fql;
                      u32x2 m0 = {0u, 0u}, m1 = {0u, 0u};
                      if (si <= lj) { f32x4 cb = (f32x4){0.f, 0.f, 0.f, 0.f};
#pragma unroll
                          for (int kk = 0; kk < 4; ++kk) cb = __builtin_amdgcn_mfma_f32_16x16x32_bf16(cbA[q][kk], cbB[q][kk], cb, 0, 0, 0);
                          float x0[4], x1[4];
#pragma unroll
                          for (int j = 0; j < 4; ++j) { const bool keep = (s0 + j <= l);
                              const float e0 = __expf(fminf(tal[0] - tas[0][j], 0.f)) * tdd[0][j], e1 = __expf(fminf(tal[1] - tas[1][j], 0.f)) * tdd[1][j];
                              const float c = keep ? cb[j] : 0.f; x0[j] = c * e0; x1[j] = c * e1; }
                          m0.x = pk2(x0[0], x0[1]); m0.y = pk2(x0[2], x0[3]); m1.x = pk2(x1[0], x1[1]); m1.y = pk2(x1[2], x1[3]); }
                      if (q == 0) tab_load(1);
                      *(LAS u32x2*)(Ml + (0 * 64 + l) * SS_LDM + s0) = m0; *(LAS u32x2*)(Ml + (1 * 64 + l) * SS_LDM + s0) = m1; } }
                __syncthreads();
                const int trb = (4 * fql + (frl >> 2)) * SS_LDC + 4 * (frl & 3);
                { bf16x8 mf[2], xdf[4][2];
#pragma unroll
                  for (int kk = 0; kk < 2; ++kk) { const LAS bf16* mp = Ml + (hh * 64 + lrow) * SS_LDM + 32 * kk + 4 * fql;
                      const s16x4 a = *(const LAS s16x4*)mp, b2 = *(const LAS s16x4*)(mp + 16); mf[kk] = __builtin_shufflevector(a, b2, 0, 1, 2, 3, 4, 5, 6, 7); }
#pragma unroll
                  for (int pi = 0; pi < 4; ++pi)
#pragma unroll
                      for (int kk = 0; kk < 2; ++kk) xdf[pi][kk] = ssd_trfrag(Xr + trb + 32 * kk * SS_LDC + hh * 64 + 16 * pi);
                  const float el = __expf(acs[hh * 64 + lrow]);
                  SSD_TIE8(xdf);
#pragma unroll
                  for (int pi = 0; pi < 4; ++pi) { Y[pi] = Y[pi] * el;
                      Y[pi] = __builtin_amdgcn_mfma_f32_16x16x32_bf16(xdf[pi][0], mf[0], Y[pi], 0, 0, 0);
                      Y[pi] = __builtin_amdgcn_mfma_f32_16x16x32_bf16(xdf[pi][1], mf[1], Y[pi], 0, 0, 0); }
                  __builtin_amdgcn_sched_barrier(0);
#pragma unroll
                  for (int pi = 0; pi < 4; ++pi) { const int p0 = 16 * pi + 4 * fql; bf16* yp = YS + tok * DSSM + 64 * (h0 + hh) + p0; f32x4 y = Y[pi];
                      if (dir == 0) { const u32x2 xv = *(const LAS u32x2*)(Xr + lrow * SS_LDC + hh * 64 + p0);
                          y[0] += dsk * bflo(xv.x); y[1] += dsk * bfhi(xv.x); y[2] += dsk * bflo(xv.y); y[3] += dsk * bfhi(xv.y);
                      } else { const u32x2 pvv = pv[pi]; const f32x2 z01 = __builtin_amdgcn_cvt_pk_f32_fp8((int)zv[pi], false), z23 = __builtin_amdgcn_cvt_pk_f32_fp8((int)zv[pi], true);
                          y[0] = (y[0] + bflo(pvv.x)) * siluf_(z01.x); y[1] = (y[1] + bfhi(pvv.x)) * siluf_(z01.y); y[2] = (y[2] + bflo(pvv.y)) * siluf_(z23.x); y[3] = (y[3] + bfhi(pvv.y)) * siluf_(z23.y); }
                      u32x2 o; o.x = pk2(y[0], y[1]); o.y = pk2(y[2], y[3]); *(u32x2*)yp = o; }
                  __builtin_amdgcn_sched_barrier(0); }
                { const int pi5 = w & 3; const float dec = __expf(acs[hh * 64 + 63]);
                  bf16x8 xef[2];
#pragma unroll
                  for (int kk = 0; kk < 2; ++kk) xef[kk] = ssd_trfrag(XEr + trb + 32 * kk * SS_LDC + hh * 64 + 16 * pi5);
#pragma unroll
                  for (int nh = 0; nh < 2; ++nh) { bf16x8 btf[4][2];
#pragma unroll
                      for (int nn = 0; nn < 4; ++nn)
#pragma unroll
                          for (int kk = 0; kk < 2; ++kk) btf[nn][kk] = ssd_trfrag(Bl + trb + 32 * kk * SS_LDC + 16 * (4 * nh + nn));
                      SSD_TIE8(btf);
#pragma unroll
                      for (int nn = 0; nn < 4; ++nn) { const int ni = 4 * nh + nn; Sacc[ni] = Sacc[ni] * dec;
                          Sacc[ni] = __builtin_amdgcn_mfma_f32_16x16x32_bf16(btf[nn][0], xef[0], Sacc[ni], 0, 0, 0);
                          Sacc[ni] = __builtin_amdgcn_mfma_f32_16x16x32_bf16(btf[nn][1], xef[1], Sacc[ni], 0, 0, 0); }
                      __builtin_amdgcn_sched_barrier(0); }
#pragma unroll
                  for (int ni = 0; ni < 8; ++ni) { u32x2 o; o.x = pk2(Sacc[ni][0], Sacc[ni][1]); o.y = pk2(Sacc[ni][2], Sacc[ni][3]);
                      *(LAS u32x2*)(SB + (hh * 64 + 16 * pi5 + frl) * SS_LDC + 16 * ni + 4 * fql) = o; } }
                if (w < 2 && ci + 1 < 32) { scan(buf ^ 1, dtn); if (ci + 2 < 32) dtn = dtload(ci + 2); }
                __syncthreads();
            }
        }
    }
}

__device__ __forceinline__ void ssd_norm_phase(Frame& F) {
    bf16* YS = (bf16*)(F.ws + WS_YSSD); const float* nw = F.in[I_SNW];
    const int gw = F.vcu * NWAVES + F.wave, NGW = F.G * NWAVES, lane = F.lane;
    f32x4 wv[8];
#pragma unroll
    for (int j = 0; j < 4; ++j) { wv[2 * j] = *(const f32x4*)(nw + 512 * j + 8 * lane); wv[2 * j + 1] = *(const f32x4*)(nw + 512 * j + 8 * lane + 4); }
    for (int m = gw; m < MTOK; m += 2 * NGW) {
        u32x4 v[2][4];
#pragma unroll
        for (int u = 0; u < 2; ++u)
#pragma unroll
            for (int j = 0; j < 4; ++j) v[u][j] = *(const u32x4*)(YS + (size_t)((m + u * NGW < MTOK) ? m + u * NGW : m) * DSSM + 512 * j + 8 * lane);
#pragma unroll
        for (int u = 0; u < 2; ++u) { if (m + u * NGW >= MTOK) break; bf16* row = YS + (size_t)(m + u * NGW) * DSSM + 8 * lane;
#pragma unroll
            for (int j = 0; j < 4; ++j) { const u32x4 q = v[u][j];
                const float a0 = bflo(q.x), a1 = bfhi(q.x), a2 = bflo(q.y), a3 = bfhi(q.y), a4 = bflo(q.z), a5 = bfhi(q.z), a6 = bflo(q.w), a7 = bfhi(q.w);
                float ss = (a0 * a0 + a1 * a1) + (a2 * a2 + a3 * a3) + (a4 * a4 + a5 * a5) + (a6 * a6 + a7 * a7);
                ss += __shfl_xor(ss, 1); ss += __shfl_xor(ss, 2); ss += __shfl_xor(ss, 4); ss += __shfl_xor(ss, 8); ss += __shfl_xor(ss, 16);
                const float rs = 1.0f / sqrtf(ss * (1.0f / 256.0f) + RMS_EPS); const f32x4 w0 = wv[2 * j], w1 = wv[2 * j + 1];
                u32x4 o; o.x = pk2(a0 * rs * w0[0], a1 * rs * w0[1]); o.y = pk2(a2 * rs * w0[2], a3 * rs * w0[3]);
                o.z = pk2(a4 * rs * w1[0], a5 * rs * w1[1]); o.w = pk2(a6 * rs * w1[2], a7 * rs * w1[3]);
                *(u32x4*)(row + 512 * j) = o; } } }
}

constexpr int RT_WC = 131072;
__device__ __forceinline__ void ln1_router_phase(Frame& F) {
    const bf16* H1P = (const bf16*)(F.ws + WS_H1P); bf16* H1B = (bf16*)F.out;
    int* TOK = (int*)(F.ws + WS_TOK); float* WGT = (float*)(F.ws + WS_WGT); int* ASG = (int*)(F.ws + WS_ASG);
    const float* g1 = F.in[I_LN1G]; const float* b1 = F.in[I_LN1B]; const float* rw = F.in[I_RW]; const float* rb = F.in[I_RB];
    LAS float* hrow = (LAS float*)(F.lds + F.wave * 16384);
    LAS float* wc = (LAS float*)(F.lds + RT_WC);
    LAS unsigned* cl = (LAS unsigned*)(F.lds + RT_WC + 16384);
    if (F.tid < 64) cl[F.tid] = 0u;
    __syncthreads();
    const int lane = F.lane, tid = F.tid;
    f32x4 gv[4], bv[4];
#pragma unroll
    for (int j = 0; j < 4; ++j) { gv[j] = *(const f32x4*)(g1 + 4 * lane + 256 * j); bv[j] = *(const f32x4*)(b1 + 4 * lane + 256 * j); }
    const float rbias = rb[lane];
    for (int step = F.vcu; step < MTOK / 32; step += F.G) {
        const int rg = step * 8 + F.wave;
        f32x4 nx0 = *(const f32x4*)(rw + tid * 4), nx1 = *(const f32x4*)(rw + 2048 + tid * 4);
#pragma unroll 1
        for (int r = 0; r < 4; ++r) { const size_t m = (size_t)rg * 4 + r; const bf16* xr = H1P + m * DM;
            f32x4 v[4]; float s = 0.f;
#pragma unroll
            for (int j = 0; j < 4; ++j) { const u32x2 q = *(const u32x2*)(xr + 4 * lane + 256 * j); v[j][0] = bflo(q.x); v[j][1] = bfhi(q.x); v[j][2] = bflo(q.y); v[j][3] = bfhi(q.y); s += (v[j][0] + v[j][1]) + (v[j][2] + v[j][3]); }
            const float mean = wave_sum(s) * (1.f / DM); float s2 = 0.f;
#pragma unroll
            for (int j = 0; j < 4; ++j) { v[j] = v[j] - mean; s2 += (v[j][0] * v[j][0] + v[j][1] * v[j][1]) + (v[j][2] * v[j][2] + v[j][3] * v[j][3]); }
            const float rstd = 1.f / sqrtf(wave_sum(s2) * (1.f / DM) + LN_EPS);
#pragma unroll
            for (int j = 0; j < 4; ++j) { const f32x4 h = v[j] * rstd * gv[j] + bv[j];
                u32x2 o; o.x = pk2(h[0], h[1]); o.y = pk2(h[2], h[3]); *(u32x2*)(H1B + m * H1B_PITCH + 4 * lane + 256 * j) = o;
                *(LAS f32x4*)(hrow + r * 1024 + 4 * lane + 256 * j) = h; } }
        float lg[4] = {0.f, 0.f, 0.f, 0.f};
#pragma unroll 1
        for (int kc = 0; kc < 16; ++kc) {
            __syncthreads();
            *(LAS f32x4*)(wc + tid * 4) = nx0; *(LAS f32x4*)(wc + 2048 + tid * 4) = nx1;
            if (kc + 1 < 16) { nx0 = *(const f32x4*)(rw + (kc + 1) * 4096 + tid * 4); nx1 = *(const f32x4*)(rw + (kc + 1) * 4096 + 2048 + tid * 4); }
            __syncthreads();
#pragma unroll 4
            for (int kk = 0; kk < 64; kk += 4) {
                const float w0 = wc[(kk + 0) * 64 + lane], w1 = wc[(kk + 1) * 64 + lane], w2 = wc[(kk + 2) * 64 + lane], w3 = wc[(kk + 3) * 64 + lane];
#pragma unroll
                for (int r = 0; r < 4; ++r) { const f32x4 h = *(const LAS f32x4*)(hrow + r * 1024 + kc * 64 + kk); lg[r] += h[0] * w0 + h[1] * w1 + h[2] * w2 + h[3] * w3; } }
        }
        bool selr[4]; float wgr[4]; int rkr[4];
#pragma unroll
        for (int r = 0; r < 4; ++r) {
            const float score = 1.0f / (1.0f + expf(-lg[r])), biased = score + rbias;
            float m1 = biased; m1 = fmaxf(m1, __shfl_xor(m1, 1)); m1 = fmaxf(m1, __shfl_xor(m1, 2)); m1 = fmaxf(m1, __shfl_xor(m1, 4));
            const unsigned long long eq = __ballot(biased == m1); const int gbase = lane & ~7; const int first = gbase + __ffs((unsigned)((eq >> gbase) & 0xffull)) - 1;
            float v2 = (lane == first) ? -INFINITY : biased; v2 = fmaxf(v2, __shfl_xor(v2, 1)); v2 = fmaxf(v2, __shfl_xor(v2, 2)); v2 = fmaxf(v2, __shfl_xor(v2, 4));
            const float gs = m1 + v2; const int g = lane >> 3; int better = 0;
#pragma unroll
            for (int d = 1; d < 8; ++d) { const int g2 = (g + d) & 7; const float og = __shfl(gs, g2 * 8); better += (og > gs || (og == gs && g2 < g)) ? 1 : 0; }
            float masked = (better < 4) ? biased : -INFINITY; bool sel = false;
#pragma unroll 1
            for (int it = 0; it < TOPK; ++it) { const float mx = wave_max(masked); const unsigned long long bm = __ballot(masked == mx); const int win = __ffsll((long long)bm) - 1;
                if (lane == win) { sel = true; masked = -INFINITY; } }
            const float sw = wave_sum(sel ? score : 0.f);
            const unsigned long long selm = __ballot(sel);
            selr[r] = sel; wgr[r] = score / sw * ROUTED_SCALE; rkr[r] = __popcll(selm & ((1ull << lane) - 1ull)); }
        unsigned lp[4];
#pragma unroll
        for (int r = 0; r < 4; ++r) lp[r] = selr[r] ? atomicAdd((unsigned*)(cl + lane), 1u) : 0u;
        __syncthreads();
        if (F.wave == 0) { const unsigned n = cl[lane]; unsigned bs = 0u;
            if (n) bs = __hip_atomic_fetch_add((unsigned*)(F.ctl + CW_CNT + 64 * lane), n, __ATOMIC_RELAXED, __HIP_MEMORY_SCOPE_AGENT);
            cl[64 + lane] = bs; cl[lane] = 0u; }
        __syncthreads();
        const unsigned bse = cl[64 + lane];
#pragma unroll
        for (int r = 0; r < 4; ++r) if (selr[r]) { const int m = rg * 4 + r; const unsigned pos = bse + lp[r];
            TOK[(size_t)lane * MTOK + pos] = m; WGT[(size_t)lane * MTOK + pos] = wgr[r]; ASG[(size_t)m * 8 + rkr[r]] = lane * MTOK + (int)pos; }
    }
}
constexpr int MOE_TP = 131072 + 1024, MOE_CNT = MOE_TP + 512, MOE_TE = 131072 + 4096;
__device__ __forceinline__ int moe_table(Frame& F) {
    LAS int* tp = (LAS int*)(F.lds + MOE_TP); LAS int* cnt = (LAS int*)(F.lds + MOE_CNT);
    __syncthreads();
    if (F.tid == 0) { int run = 0;
        for (int e = 0; e < NEX; ++e) { const int c = (e < NE) ? (int)__hip_atomic_load((unsigned*)(F.ctl + CW_CNT + 64 * e), __ATOMIC_RELAXED, __HIP_MEMORY_SCOPE_AGENT) : MTOK;
            cnt[e] = c; tp[e] = run; run += (c + 255) >> 8; }
        tp[NEX] = run; }
    __syncthreads();
    { LAS int* te = (LAS int*)(F.lds + MOE_TE); const int total = tp[NEX];
      for (int t = F.tid; t < total; t += NTHR) { int e = 0;
#pragma unroll 1
          for (int s = 64; s >= 1; s >>= 1) if (e + s <= NE && tp[e + s] <= t) e += s;
          te[t] = e; } }
    __syncthreads();
    return tp[NEX];
}
__device__ __forceinline__ void fp8x4_fma(f32x4& a, const unsigned v, const float w) {
    const f32x2 p0 = __builtin_amdgcn_cvt_pk_f32_fp8((int)v, false), p1 = __builtin_amdgcn_cvt_pk_f32_fp8((int)v, true);
    a[0] += w * p0.x; a[1] += w * p0.y; a[2] += w * p1.x; a[3] += w * p1.y;
}
__device__ __forceinline__ void moe_combine_phase(Frame& F) {
    const bf16* H1B = (const bf16*)F.out; const unsigned char* YQ = (const unsigned char*)(F.ws + WS_YQ); const int* ASG = (const int*)(F.ws + WS_ASG); const float* WGT = (const float*)(F.ws + WS_WGT);
    const LAS int* tp = (const LAS int*)(F.lds + MOE_TP);
    const float* g2 = F.in[I_LN2G]; const float* b2 = F.in[I_LN2B];
    const int gw = F.vcu * NWAVES + F.wave, NGW = F.G * NWAVES, lane = F.lane;
    const size_t shbase = (size_t)tp[NE] * 256;
    f32x4 gv[4], bv[4];
#pragma unroll
    for (int j = 0; j < 4; ++j) { gv[j] = *(const f32x4*)(g2 + 4 * lane + 256 * j); bv[j] = *(const f32x4*)(b2 + 4 * lane + 256 * j); }
    const int l8 = lane & 7;
    int li = ASG[(size_t)gw * 8 + l8];
    float wk = WGT[li];
    int li_n = (gw + NGW < MTOK) ? ASG[(size_t)(gw + NGW) * 8 + l8] : 0;
    for (int m = gw; m < MTOK; m += NGW) {
        const int e = li >> 15, pos = li & 32767; const int slot = 256 * tp[e] + pos; const float wcur = wk;
        unsigned vv[9][4]; f32x4 v[4];
        { const unsigned char* sp = YQ + (shbase + m) * 1024 + 4 * lane;
#pragma unroll
          for (int j = 0; j < 4; ++j) vv[8][j] = *(const unsigned*)(sp + 256 * j); }
#pragma unroll
        for (int k = 0; k < 8; ++k) { const int sk = __shfl(slot, k); const unsigned char* sp = YQ + (size_t)sk * 1024 + 4 * lane;
#pragma unroll
            for (int j = 0; j < 4; ++j) vv[k][j] = *(const unsigned*)(sp + 256 * j); }
        float* xr = F.out + (size_t)m * DM + 4 * lane; const bf16* hr = H1B + (size_t)m * H1B_PITCH + 4 * lane; u32x2 hq[4];
#pragma unroll
        for (int j = 0; j < 4; ++j) hq[j] = *(const u32x2*)(hr + 256 * j);
        li = li_n; wk = WGT[li];
        li_n = (m + 2 * NGW < MTOK) ? ASG[(size_t)(m + 2 * NGW) * 8 + l8] : 0;
#pragma unroll
        for (int j = 0; j < 4; ++j) { v[j][0] = DN_ALPHA * bflo(hq[j].x); v[j][1] = DN_ALPHA * bfhi(hq[j].x); v[j][2] = DN_ALPHA * bflo(hq[j].y); v[j][3] = DN_ALPHA * bfhi(hq[j].y); fp8x4_fma(v[j], vv[8][j], 1.0f); }
#pragma unroll
        for (int k = 0; k < 8; ++k) { const float w = __shfl(wcur, k);
#pragma unroll
            for (int j = 0; j < 4; ++j) fp8x4_fma(v[j], vv[k][j], w); }
        float s = 0.f;
#pragma unroll
        for (int j = 0; j < 4; ++j) s += (v[j][0] + v[j][1]) + (v[j][2] + v[j][3]);
        const float mean = wave_sum(s) * (1.f / DM); float s2 = 0.f;
#pragma unroll
        for (int j = 0; j < 4; ++j) { v[j] = v[j] - mean; s2 += (v[j][0] * v[j][0] + v[j][1] * v[j][1]) + (v[j][2] * v[j][2] + v[j][3] * v[j][3]); }
        const float rstd = 1.f / sqrtf(wave_sum(s2) * (1.f / DM) + LN_EPS);
#pragma unroll
        for (int j = 0; j < 4; ++j) *(f32x4*)(xr + 256 * j) = v[j] * rstd * gv[j] + bv[j];
    }
}

#ifndef MK_N_LAUNCHES
#define MK_N_LAUNCHES 1
#endif
constexpr int NPH = 15;
constexpr int N_LAUNCHES = MK_N_LAUNCHES;

__global__ void __launch_bounds__(NTHR, 2) fwd_kernel(Args args) {
    extern __shared__ __attribute__((aligned(16))) unsigned char lds_raw[];
    Frame F;
    F.lds = (LAS unsigned char*)lds_raw;
    F.MISC = (volatile LAS unsigned*)(F.lds + MISC_OFF);
    F.tid = threadIdx.x; F.lane = F.tid & 63; F.wave = __builtin_amdgcn_readfirstlane(F.tid >> 6);
    F.G = gridDim.x; { const int bx = blockIdx.x; F.vcu = (F.G % 8 == 0) ? (bx % 8) * (F.G / 8) + bx / 8 : bx; }
    F.ws = args.ws; F.ctl = (gu32*)(args.ws + WS_CTL); F.in = args.in; F.out = args.out;
    for (int u = F.tid; u < (LDS_BYTES - MISC_OFF) / 4; u += NTHR) ((LAS unsigned*)(F.lds + MISC_OFF))[u] = 0u;
    __syncthreads();
    XcdBarrier bar; bar.bar = (unsigned*)(F.ctl + CW_BAR); bar.x = 0; bar.st = nullptr;
    if (N_LAUNCHES != NPH) bar = xcd_barrier_post((unsigned*)(F.ctl + CW_BAR), F.MISC + 8);
    const int lo = args.ph_lo, hi = args.ph_hi;
#ifndef PH_MASK
#define PH_MASK 0x7fff
#endif
#define IN(k) ((((PH_MASK) >> (k)) & 1) && lo <= (k) && (k) < hi)
#ifdef STRESS_US
#define SKEW() do { if ((blockIdx.x * 2654435761u >> 28) & 1) { const unsigned long long t0_ = __builtin_amdgcn_s_memrealtime(); while (__builtin_amdgcn_s_memrealtime() - t0_ < (unsigned long long)(STRESS_US) * 100ull) __builtin_amdgcn_s_sleep(8); } __syncthreads(); } while (0)
#else
#define SKEW() do { } while (0)
#endif
#define SEAM(k) do { if (IN(k) && IN((k) + 1)) { xcd_barrier(bar); SKEW(); } } while (0)
#ifndef REP_MASK
#define REP_MASK 0
#endif
#define REPS(k) for (int rep_ = 0; rep_ < ((((REP_MASK) >> (k)) & 1) ? 2 : 1); ++rep_, ((((REP_MASK) >> (k)) & 1) && rep_ == 1 ? xcd_barrier(bar) : (void)0))
    const int G = F.G, bx = (int)blockIdx.x;

#ifdef START_BARS
    for (int xb_ = 0; xb_ < START_BARS; ++xb_) xcd_barrier(bar);
#endif
    if (IN(0)) REPS(0) { p0_prologue(F); } SEAM(0);
    if (IN(1)) REPS(1) {
        pg8::StaticOrder S; S.init((const bf16*)((unsigned char*)F.out + OUT_XB), (const bf16*)(F.ws + WS_WINT), MTOK, HYC, DM, G, bx);
        pg8::EpiHyT E{(bf16*)(F.ws + WS_PTHY), F.in[I_BIN], F.lds + pg8::STAGE_BYTES};
        pg8::gemm_phase<pg8::EpiHyT, pg8::StaticOrder, false>(F.lds, DM, S, E);
    } SEAM(1);
    if (IN(2)) REPS(2) { hyena_phase(F); } SEAM(2);
    if (IN(3)) REPS(3) { p3_transpose(F); } SEAM(3);
    if (IN(4)) REPS(4) {
        pg8::StaticOrder S; S.init((const bf16*)((unsigned char*)F.out + OUT_XB), (const bf16*)(F.ws + WS_WINT) + (size_t)3072 * DM, MTOK, 6400, DM, G, bx);
        pg8::EpiZXD E{(unsigned char*)F.out, (bf16*)(F.ws + WS_XBC), (float*)(F.ws + WS_DT), F.in[I_BIN], (bf16*)(F.ws + WS_HALO)};
        pg8::gemm_phase<pg8::EpiZXD, pg8::StaticOrder, false>(F.lds, DM, S, E);
    } SEAM(4);
    if (IN(5)) REPS(5) { ssd_conv_phase(F); } SEAM(5);
    if (IN(6)) REPS(6) { ssd_phase(F); } SEAM(6);
    if (IN(7)) REPS(7) { ssd_norm_phase(F); }
    if (IN(8)) REPS(8) {
        pg8::StaticOrder S; S.init((const bf16*)((unsigned char*)F.out + OUT_XB), (const bf16*)(F.ws + WS_WING), MTOK, 2048, DM, G, bx);
        pg8::EpiBf<0> E{(bf16*)(F.ws + WS_G), 2048, F.in[I_BIN] + 9280, nullptr, 0, nullptr};
        pg8::gemm_phase<pg8::EpiBf<0>, pg8::StaticOrder, false>(F.lds, DM, S, E);
    } SEAM(8);
    if (IN(9)) REPS(9) {
        pg8::StaticOrder S; S.init((const bf16*)(F.ws + WS_YHY), (const bf16*)(F.ws + WS_WHYB), MTOK, DM, DM, G, bx);
        pg8::EpiBf<1> E{(bf16*)(F.ws + WS_MIX), DM, nullptr, (const bf16*)(F.ws + WS_G), 2048, nullptr};
        pg8::gemm_phase<pg8::EpiBf<1>, pg8::StaticOrder, false>(F.lds, DM, S, E);
    }
    if (IN(10)) REPS(10) {
        pg8::StaticOrder S; S.init((const bf16*)(F.ws + WS_YSSD), (const bf16*)(F.ws + WS_WSSDB), MTOK, DM, DSSM, G, bx);
        pg8::EpiBf<2> E{(bf16*)(F.ws + WS_MIX), DM, nullptr, (const bf16*)(F.ws + WS_G) + 1024, 2048, (const bf16*)(F.ws + WS_MIX)};
        pg8::gemm_phase<pg8::EpiBf<2>, pg8::StaticOrder, false>(F.lds, DSSM, S, E);
    } SEAM(10);
    if (IN(11)) REPS(11) {
        pg8::StaticOrder S; S.init((const bf16*)(F.ws + WS_MIX), (const bf16*)(F.ws + WS_WOUT), MTOK, DM, DM, G, bx);
        pg8::EpiRes E{(bf16*)(F.ws + WS_H1P), F.in[I_BOUT], (const bf16*)((unsigned char*)F.out + OUT_XB), DN_ALPHA};
        pg8::gemm_phase<pg8::EpiRes, pg8::StaticOrder, false>(F.lds, DM, S, E);
        p10_expert_weights(F);
    } SEAM(11);
    if (IN(12)) REPS(12) { ln1_router_phase(F); } SEAM(12);
    if (IN(13)) REPS(13) {
        const int total = moe_table(F);
        pg8::MoeOrder<2, true> S{(const LAS int*)(F.lds + MOE_TP), (const LAS int*)(F.lds + MOE_CNT), (const LAS int*)(F.lds + MOE_TE), G, bx, total, (const char*)F.out, (const char*)(F.ws + WS_EW1), (const int*)(F.ws + WS_TOK)};
        pg8::EpiSwiGLU E{(bf16*)(F.ws + WS_HID)};
        pg8::gemm_phase<pg8::EpiSwiGLU, pg8::MoeOrder<2, true>, true>(F.lds, DM, S, E);
    } SEAM(13);
    if (IN(14)) {
        const int total = moe_table(F);
        { pg8::SlotOrder4 S{(const LAS int*)(F.lds + MOE_TP), (const LAS int*)(F.lds + MOE_TE), G, bx, total, (const char*)(F.ws + WS_HID), (const char*)(F.ws + WS_EW2)};
          pg8::EpiSlot8 E{(unsigned char*)(F.ws + WS_YQ)}; int kd = DEXP; asm volatile("" : "+s"(kd));
          pg8::gemm_phase<pg8::EpiSlot8, pg8::SlotOrder4, false>(F.lds, kd, S, E); }
        xcd_barrier(bar);
        moe_combine_phase(F);
    }
#ifdef EXTRA_BARS
    for (int xb_ = 0; xb_ < EXTRA_BARS; ++xb_) xcd_barrier(bar);
#endif
#undef IN
#undef SEAM
}

extern "C" void kernel_launch(void* const* d_in, const int* in_sizes, int n_in, void* d_out, int out_size, void* d_ws, size_t ws_size, hipStream_t stream) {
    static int grid = 0;
    if (grid == 0) {
        if (n_in != 38 || out_size != MTOK * DM || ws_size < WS_END) { fprintf(stderr, "kernel_launch: unexpected shapes (n_in %d out %d ws %zu)\n", n_in, out_size, ws_size); grid = -1; return; }
        int dev = 0, cus = 0, per_cu = 0;
        if (hipGetDevice(&dev) != hipSuccess || hipDeviceGetAttribute(&cus, hipDeviceAttributeMultiprocessorCount, dev) != hipSuccess) { grid = -1; return; }
        if (hipFuncSetAttribute((const void*)fwd_kernel, hipFuncAttributeMaxDynamicSharedMemorySize, LDS_BYTES) != hipSuccess) { fprintf(stderr, "kernel_launch: hipFuncSetAttribute failed\n"); grid = -1; return; }
        if (hipOccupancyMaxActiveBlocksPerMultiprocessor(&per_cu, (const void*)fwd_kernel, NTHR, LDS_BYTES) != hipSuccess || per_cu < 1) fprintf(stderr, "kernel_launch: occupancy query says %d\n", per_cu);
        (void)hipGetLastError();
        grid = cus;
    }
    if (grid < 0) return;
#ifdef EXTRA_PHASE
    {
        (void)hipMemsetAsync((char*)d_ws + WS_CTL, 0, CTL_ZERO_BYTES, stream);
        Args x{}; for (int i = 0; i < 38; ++i) x.in[i] = (const float*)d_in[i];
        x.out = (float*)d_out; x.ws = (unsigned char*)d_ws; x.ph_lo = EXTRA_PHASE; x.ph_hi = EXTRA_PHASE + 1; x.li = 0;
        hipLaunchKernelGGL(fwd_kernel, dim3(grid), dim3(NTHR), LDS_BYTES, stream, x);
    }
#endif
    (void)hipMemsetAsync((char*)d_ws + WS_CTL, 0, CTL_ZERO_BYTES, stream);
    Args a{};
    for (int i = 0; i < 38; ++i) a.in[i] = (const float*)d_in[i];
    a.out = (float*)d_out; a.ws = (unsigned char*)d_ws;
    for (int li = 0; li < N_LAUNCHES; ++li) {
        a.ph_lo = (N_LAUNCHES == NPH) ? li : 0; a.ph_hi = (N_LAUNCHES == NPH) ? li + 1 : NPH; a.li = li;
        hipLaunchKernelGGL(fwd_kernel, dim3(grid), dim3(NTHR), LDS_BYTES, stream, a);
    }
}
```

```cpp
#define MK_N_LAUNCHES 1
#include <hip/hip_runtime.h>
#include <cstdio>
#include <cstdint>

#define LAS __attribute__((address_space(3)))
#define GAS __attribute__((address_space(1)))
typedef unsigned short bf16;
typedef short bf16x8 __attribute__((ext_vector_type(8)));
typedef float f32x4 __attribute__((ext_vector_type(4)));
typedef float f32x2 __attribute__((ext_vector_type(2)));
typedef unsigned u32x4 __attribute__((ext_vector_type(4)));
typedef unsigned u32x2 __attribute__((ext_vector_type(2)));
typedef GAS unsigned gu32;

constexpr int BATCH = 16, SEQ = 2048, DM = 1024, MTOK = BATCH * SEQ;
constexpr int HYC = 3072, DSSM = 2048, CONVD = 4096, NHEAD = 32, NGRP = 8, NSTATE = 128, INC = 11328;
constexpr int NE = 64, TOPK = 8, DEXP = 256, NEX = NE + 1;
constexpr float DN_ALPHA = 1.189207115002721f;
constexpr float LN_EPS = 1e-5f, RMS_EPS = 1e-5f, ROUTED_SCALE = 2.5f;
constexpr int NWAVES = 8, NTHR = 512;
constexpr int WIN_ROWS = 11520;

constexpr size_t MiB = 1u << 20;
constexpr size_t WS_CTL = 0, CTL_ZERO_BYTES = 256 * 1024;
constexpr size_t WS_WHYB = 1 * MiB, WS_WSSDB = 3 * MiB, WS_WOUT = 7 * MiB;
constexpr size_t WS_XB = 9 * MiB;
constexpr size_t WS_WINT = 73 * MiB;
constexpr size_t WS_KERN = 96 * MiB;
constexpr size_t WS_PTHY = 112 * MiB;
constexpr size_t WS_YTHY = 304 * MiB;
constexpr size_t WS_YHY = 137 * MiB;
constexpr size_t WS_XBC = 201 * MiB;
constexpr size_t WS_DT = 457 * MiB;
constexpr size_t WS_HALO = 465 * MiB;
constexpr size_t WS_YSSD = 9 * MiB;
constexpr size_t WS_XB2 = 201 * MiB;
constexpr size_t WS_WING = 505 * MiB;
constexpr size_t WS_G = 269 * MiB;
constexpr size_t WS_MIX = 397 * MiB;
constexpr int H1B_PITCH = 2048;
constexpr size_t WS_EW1 = 9 * MiB;
constexpr size_t WS_EW2 = 477 * MiB;
constexpr size_t WS_YQ = 1 * MiB;
constexpr size_t WS_ASG = 510 * MiB;
constexpr size_t WS_H1P = 177 * MiB;
constexpr size_t WS_HID = 305 * MiB;
constexpr size_t WS_TOK = 461 * MiB;
constexpr size_t WS_WGT = 469 * MiB;
constexpr size_t WS_END = 511 * MiB;
constexpr size_t OUT_XB = 64 * MiB;
constexpr int CW_BAR = 4096;
constexpr int CW_CNT = 16384;
constexpr int CW_DBG = 32768;

constexpr int LDS_BYTES = 163840;
constexpr int MISC_OFF = 163840 - 512;

#define RLX_AGENT __ATOMIC_RELAXED, __HIP_MEMORY_SCOPE_AGENT
#define LDS_WAIT() asm volatile("s_waitcnt lgkmcnt(0)" ::: "memory")
#define VM_WAIT() asm volatile("s_waitcnt vmcnt(0)" ::: "memory")
typedef __bf16 bf16x2_t __attribute__((ext_vector_type(2)));
__device__ __forceinline__ unsigned pk2(float lo, float hi) { const f32x2 v = {lo, hi}; return __builtin_bit_cast(unsigned, __builtin_convertvector(v, bf16x2_t)); }
__device__ __forceinline__ unsigned f2bf(float f) { return pk2(f, 0.f) & 0xffffu; }
__device__ __forceinline__ float bf2f(unsigned b) { return __builtin_bit_cast(float, b << 16); }
__device__ __forceinline__ float bflo(unsigned w) { return __builtin_bit_cast(float, w << 16); }
__device__ __forceinline__ float bfhi(unsigned w) { return __builtin_bit_cast(float, w & 0xffff0000u); }
__device__ __forceinline__ float sigmoidf_(float v) { return __builtin_amdgcn_rcpf(1.0f + __expf(-v)); }
__device__ __forceinline__ float siluf_(float v) { return v * __builtin_amdgcn_rcpf(1.0f + __expf(-v)); }
__device__ __forceinline__ float wave_sum(float v) {
#pragma unroll
    for (int o = 1; o < 64; o <<= 1) v += __shfl_xor(v, o);
    return v;
}
__device__ __forceinline__ float wave_max(float v) {
#pragma unroll
    for (int o = 1; o < 64; o <<= 1) v = fmaxf(v, __shfl_xor(v, o));
    return v;
}

#ifndef PG8_WGM
#define PG8_WGM 8
#endif
namespace pg8 {
constexpr int BM = 256, BK = 64, HALF = 128, HTB = HALF * BK * 2, STAGE_BYTES = 8 * HTB, NXCD = 8, WGM = PG8_WGM;
__host__ __device__ __forceinline__ int lds_byte(int r, int c) { const int st = (r >> 4) * 2 + (c >> 5), rr = r & 15, cc = c & 31, ob = rr * 64 + cc * 2; return st * 1024 + (ob ^ (((ob >> 9) & 1) << 5)); }
__host__ __device__ __forceinline__ void stage_rc(int b, int& R, int& C) { const int st = b / 1024, sb = b % 1024, swz = sb ^ (((sb >> 9) & 1) << 5); R = (st >> 1) * 16 + swz / 64; C = (st & 1) * 32 + (swz % 64) / 2; }
__host__ __device__ __forceinline__ int perm32(int rho) { const int n = rho >> 4, i = rho & 15; return 8 * (i >> 2) + 4 * n + (i & 3); }

struct Unit { int pm, pn; const char* A; const char* B; int e, cnt; };

struct StaticOrder {
    int nM, nN, nwg, G, c, K; const char* A; const char* B;
    __device__ void init(const bf16* A_, const bf16* B_, int M, int N, int K_, int G_, int c_) { A = (const char*)A_; B = (const char*)B_; nM = M / BM; nN = N / BM; nwg = nM * nN; G = G_; c = c_; K = K_; }
    __device__ __forceinline__ bool next(int i, Unit& u) const {
        const long L = (long)i * G + c; if (L >= nwg) return false;
        int wgid = (int)L; { const int q = nwg / NXCD, r = nwg % NXCD, xcd = wgid % NXCD, off = wgid / NXCD; wgid = (xcd < r ? xcd * (q + 1) : r * (q + 1) + (xcd - r) * q) + off; }
        const int nig = WGM * nN, gid = wgid / nig, fm = gid * WGM, gsz = (nM - fm) < WGM ? (nM - fm) : WGM;
        u.pm = fm + ((wgid % nig) % gsz); u.pn = (wgid % nig) / gsz;
        u.A = A + (size_t)u.pm * BM * K * 2; u.B = B + (size_t)u.pn * BM * K * 2; u.e = 0; u.cnt = 0; return true;
    }
    __device__ __forceinline__ unsigned row_off(const Unit&, int) const { return 0u; }
};

__device__ __forceinline__ unsigned cvt_pk_bf16(float lo, float hi) { unsigned r; asm volatile("v_cvt_pk_bf16_f32 %0, %1, %2" : "=v"(r) : "v"(lo), "v"(hi)); return r; }

#ifndef PG8_SP2
#define PG8_SP2 true
#endif
#ifndef PG8_ALIGN
#define PG8_ALIGN true
#endif
template <class Epi, class Sched, bool GATHER, bool SP2 = PG8_SP2, bool ALIGN_EPI = PG8_ALIGN>
__device__ __forceinline__ void gemm_phase(LAS unsigned char* lds, const int K, const Sched& S, const Epi& E) {
    constexpr bool TA = Epi::TA;
    const int tid = threadIdx.x, wid = __builtin_amdgcn_readfirstlane(tid >> 6), lane = tid & 63, wr = wid >> 2, wc = wid & 3, fr = lane & 15, fq = lane >> 4;
    const int nt = K / BK;
    unsigned voffA[2][2], voffB[2]; int RA[2], CA[2];
#pragma unroll
    for (int i = 0; i < 2; ++i) { int R, C; stage_rc(tid * 16 + i * 8192, R, C);
        const int Rb = Epi::PERM == 3 ? (64 * (R >> 5) + 16 * ((R & 15) >> 2) + 4 * ((R >> 4) & 1) + (R & 3)) : (Epi::PERM == 2 ? (64 * (R >> 5) + perm32(R & 31)) : (Epi::PERM ? ((R & ~31) + perm32(R & 31)) : R));
        RA[i] = R; CA[i] = C; voffA[0][i] = (unsigned)(R * K + C) * 2u; voffA[1][i] = voffA[0][i]; voffB[i] = (unsigned)(Rb * K + C) * 2u; }
    const size_t kstep = (size_t)(BK * 2);
    const size_t hstep = (size_t)HALF * K * 2;
    const size_t hstepA = GATHER ? 0 : hstep;
    const size_t hstepB = (Epi::PERM == 3) ? (size_t)8 * K * 2 : ((Epi::PERM == 2) ? (size_t)32 * K * 2 : hstep);
    const unsigned ldsw = (unsigned)wid * 1024u;
    const int aoff = lds_byte(wr * 64 + fr, fq * 8), boff = lds_byte(wc * 32 + fr, fq * 8);
#define PG8_SA(b, h) (((b) * 2 + (h)) * HTB)
#define PG8_SB(b, h) ((4 + (b) * 2 + (h)) * HTB)
#define PG8_STAGE(bufoff, gbase, voff) do { _Pragma("unroll") for (int _i = 0; _i < 2; ++_i) \
        __builtin_amdgcn_global_load_lds((const unsigned*)((const char*)(gbase) + (voff)[_i]), (LAS unsigned*)(lds + (bufoff) + ldsw + _i * 8192), 16, 0, 0); } while (0)
#define PG8_STAGE_A(bufoff, gbase, h) PG8_STAGE(bufoff, (gbase) + (h) * hstepA, voffA[GATHER ? (h) : 0])
#define PG8_LDA(dst, b, h) do { _Pragma("unroll") for (int m = 0; m < 4; ++m) _Pragma("unroll") for (int k = 0; k < 2; ++k) dst[m][k] = *(const LAS bf16x8*)(lds + PG8_SA(b, h) + aoff + m * 2048 + k * 1024); } while (0)
#define PG8_LDB(dst, b, h) do { _Pragma("unroll") for (int n = 0; n < 2; ++n) _Pragma("unroll") for (int k = 0; k < 2; ++k) dst[n][k] = *(const LAS bf16x8*)(lds + PG8_SB(b, h) + boff + n * 2048 + k * 1024); } while (0)
#define PG8_MMA(ai, bj, At, Bt) do { __builtin_amdgcn_s_setprio(1); _Pragma("unroll") for (int m = 0; m < 4; ++m) _Pragma("unroll") for (int n = 0; n < 2; ++n) _Pragma("unroll") for (int k = 0; k < 2; ++k) \
        acc[ai][bj][m][n] = TA ? __builtin_amdgcn_mfma_f32_16x16x32_bf16(Bt[n][k], At[m][k], acc[ai][bj][m][n], 0, 0, 0) \
                               : __builtin_amdgcn_mfma_f32_16x16x32_bf16(At[m][k], Bt[n][k], acc[ai][bj][m][n], 0, 0, 0); __builtin_amdgcn_s_setprio(0); } while (0)
#define PG8_WAIT_V(n) asm volatile("s_waitcnt vmcnt(" #n ")" ::: "memory")
#define PG8_WAIT_L(n) asm volatile("s_waitcnt lgkmcnt(" #n ")" ::: "memory")
#define PG8_BAR __builtin_amdgcn_s_barrier()
#define PG8_SCHED __builtin_amdgcn_sched_barrier(0)
    Unit cur, nxt; int ui = 0;
    if (!S.next(0, cur)) return;
    if (GATHER) {
#pragma unroll
        for (int h = 0; h < 2; ++h)
#pragma unroll
            for (int i = 0; i < 2; ++i) voffA[h][i] = S.row_off(cur, h * HALF + RA[i]) + (unsigned)CA[i] * 2u;
    }
    f32x4 acc[2][2][4][2];
#pragma unroll
    for (int a = 0; a < 2; ++a)
#pragma unroll
        for (int b = 0; b < 2; ++b)
#pragma unroll
            for (int m = 0; m < 4; ++m)
#pragma unroll
                for (int n = 0; n < 2; ++n) acc[a][b][m][n] = (f32x4){0.f, 0.f, 0.f, 0.f};
    bf16x8 At[4][2], B0[2][2], B1[2][2];
    const char* cA = cur.A; const char* cB = cur.B;
    if constexpr (SP2) {
        PG8_STAGE(PG8_SB(0, 0), cB, voffB); PG8_STAGE(PG8_SB(0, 1), cB + hstepB, voffB); PG8_STAGE_A(PG8_SA(0, 0), cA, 0); PG8_STAGE_A(PG8_SA(0, 1), cA, 1);
        if (wr == 1) PG8_BAR;
        PG8_WAIT_V(2); PG8_BAR;
        PG8_STAGE(PG8_SB(1, 0), cB + kstep, voffB); PG8_STAGE_A(PG8_SA(1, 0), cA + kstep, 0); PG8_STAGE(PG8_SB(1, 1), cB + hstepB + kstep, voffB);
        PG8_WAIT_V(6); PG8_BAR;
    } else {
    PG8_STAGE(PG8_SB(0, 0), cB, voffB); PG8_STAGE_A(PG8_SA(0, 0), cA, 0); PG8_STAGE(PG8_SB(0, 1), cB + hstepB, voffB); PG8_STAGE_A(PG8_SA(0, 1), cA, 1);
    if (wr == 1) PG8_BAR;
    PG8_WAIT_V(4); PG8_BAR;
    PG8_STAGE(PG8_SB(1, 0), cB + kstep, voffB); PG8_STAGE_A(PG8_SA(1, 0), cA + kstep, 0); PG8_STAGE(PG8_SB(1, 1), cB + hstepB + kstep, voffB);
    PG8_WAIT_V(6); PG8_BAR;
    }
    for (;;) {
        const bool has_next = S.next(ui + 1, nxt);
        const char* nA = has_next ? nxt.A : cA; const char* nB = has_next ? nxt.B : cB;
        for (int t = 0; t < nt; t += 2) {
            const bool last = (t == nt - 2);
            const char* a1 = cA + (size_t)(t + 1) * kstep;
            const char* a2 = last ? nA : cA + (size_t)(t + 2) * kstep; const char* b2 = last ? nB : cB + (size_t)(t + 2) * kstep;
            const char* a3 = a2 + kstep; const char* b3 = b2 + kstep;
            if constexpr (SP2) {
            PG8_LDB(B0, 0, 0); PG8_LDB(B1, 0, 1); PG8_SCHED; PG8_LDA(At, 0, 0); PG8_STAGE_A(PG8_SA(1, 1), a1, 1);
            PG8_WAIT_V(8); PG8_WAIT_L(0); PG8_BAR; PG8_MMA(0, 0, At, B0); PG8_MMA(0, 1, At, B1); PG8_BAR; PG8_SCHED;
            if (GATHER) { if (last && has_next) {
#pragma unroll
                for (int h = 0; h < 2; ++h)
#pragma unroll
                    for (int i = 0; i < 2; ++i) voffA[h][i] = S.row_off(nxt, h * HALF + RA[i]) + (unsigned)CA[i] * 2u;
            } }
            PG8_LDA(At, 0, 1); PG8_STAGE(PG8_SB(0, 0), b2, voffB); PG8_STAGE(PG8_SB(0, 1), b2 + hstepB, voffB); PG8_STAGE_A(PG8_SA(0, 0), a2, 0);
            PG8_WAIT_V(8); PG8_WAIT_L(0); PG8_BAR; PG8_MMA(1, 0, At, B0); PG8_MMA(1, 1, At, B1); PG8_BAR; PG8_SCHED;
            PG8_LDB(B0, 1, 0); PG8_LDB(B1, 1, 1); PG8_SCHED; PG8_LDA(At, 1, 0); PG8_STAGE_A(PG8_SA(0, 1), a2, 1);
            PG8_WAIT_V(8); PG8_WAIT_L(0); PG8_BAR; PG8_MMA(0, 0, At, B0); PG8_MMA(0, 1, At, B1); PG8_BAR; PG8_SCHED;
            PG8_LDA(At, 1, 1); PG8_STAGE(PG8_SB(1, 0), b3, voffB); PG8_STAGE(PG8_SB(1, 1), b3 + hstepB, voffB); PG8_STAGE_A(PG8_SA(1, 0), a3, 0);
            PG8_WAIT_V(8); PG8_WAIT_L(0); PG8_BAR; PG8_MMA(1, 0, At, B0); PG8_MMA(1, 1, At, B1); PG8_BAR; PG8_SCHED;
            } else {
            PG8_LDB(B0, 0, 0); PG8_SCHED; PG8_LDA(At, 0, 0); PG8_STAGE_A(PG8_SA(1, 1), a1, 1);
            PG8_WAIT_L(8); PG8_BAR; PG8_WAIT_L(0); PG8_MMA(0, 0, At, B0); PG8_BAR; PG8_SCHED;
            if (GATHER) { if (last && has_next) {
#pragma unroll
                for (int h = 0; h < 2; ++h)
#pragma unroll
                    for (int i = 0; i < 2; ++i) voffA[h][i] = S.row_off(nxt, h * HALF + RA[i]) + (unsigned)CA[i] * 2u;
            } }
            PG8_LDB(B1, 0, 1); PG8_STAGE(PG8_SB(0, 0), b2, voffB);
            PG8_BAR; PG8_WAIT_L(0); PG8_MMA(0, 1, At, B1); PG8_BAR;
            PG8_LDA(At, 0, 1); PG8_STAGE_A(PG8_SA(0, 0), a2, 0);
            PG8_BAR; PG8_WAIT_L(0); PG8_MMA(1, 0, At, B0); PG8_BAR; PG8_SCHED;
            PG8_STAGE(PG8_SB(0, 1), b2 + hstepB, voffB);
            PG8_WAIT_V(6); PG8_BAR; PG8_MMA(1, 1, At, B1); PG8_BAR;
            PG8_LDB(B0, 1, 0); PG8_SCHED; PG8_LDA(At, 1, 0); PG8_STAGE_A(PG8_SA(0, 1), a2, 1);
            PG8_WAIT_L(8); PG8_BAR; PG8_WAIT_L(0); PG8_MMA(0, 0, At, B0); PG8_BAR; PG8_SCHED;
            PG8_LDB(B1, 1, 1); PG8_STAGE(PG8_SB(1, 0), b3, voffB);
            PG8_BAR; PG8_WAIT_L(0); PG8_MMA(0, 1, At, B1); PG8_BAR;
            PG8_LDA(At, 1, 1); PG8_STAGE_A(PG8_SA(1, 0), a3, 0);
            PG8_BAR; PG8_WAIT_L(0); PG8_MMA(1, 0, At, B0); PG8_BAR; PG8_SCHED;
            PG8_STAGE(PG8_SB(1, 1), b3 + hstepB, voffB);
            PG8_WAIT_V(6); PG8_BAR; PG8_MMA(1, 1, At, B1); PG8_BAR;
                    }
        }
        if constexpr (ALIGN_EPI) { if (wr == 0) PG8_BAR; }
        E(acc, cur, wr, wc, fr, fq);
        if (!has_next) break;
#pragma unroll
        for (int a = 0; a < 2; ++a)
#pragma unroll
            for (int b = 0; b < 2; ++b)
#pragma unroll
                for (int m = 0; m < 4; ++m)
#pragma unroll
                    for (int n = 0; n < 2; ++n) acc[a][b][m][n] = (f32x4){0.f, 0.f, 0.f, 0.f};
        cur = nxt; cA = nA; cB = nB; ++ui;
        if constexpr (ALIGN_EPI) { if (wr == 1) PG8_BAR; }
    }
    PG8_WAIT_V(0);
    if constexpr (!ALIGN_EPI) { if (wr == 0) PG8_BAR; }
    PG8_BAR;
#undef PG8_SA
#undef PG8_SB
#undef PG8_STAGE
#undef PG8_STAGE_A
#undef PG8_LDA
#undef PG8_LDB
#undef PG8_MMA
#undef PG8_WAIT_V
#undef PG8_WAIT_L
#undef PG8_BAR
#undef PG8_SCHED
}
}

namespace pg8 {
struct EpiHyT {
    static constexpr bool TA = false; static constexpr int PERM = 0;
    bf16* PT; const float* bias; LAS unsigned char* scr;
    __device__ __forceinline__ void operator()(const f32x4 (&acc)[2][2][4][2], const Unit& u, int wr, int wc, int fr, int fq) const {
        const int lane = fq * 16 + fr, lc = lane >> 3, lp = lane & 7;
        LAS unsigned char* s = scr + (wr * 4 + wc) * 2304;
        LAS unsigned char* wp = s + fr * 144 + 8 * fq;
        const LAS unsigned char* rp = s + lc * 144 + 16 * lp;
#pragma unroll
        for (int bj = 0; bj < 2; ++bj)
#pragma unroll
            for (int n = 0; n < 2; ++n) {
                const int col0 = u.pn * BM + bj * HALF + wc * 32 + n * 16; const float bv = bias[col0 + fr];
                bf16* gp = PT + (size_t)(col0 + lc) * MTOK + u.pm * BM + wr * 64 + 8 * lp;
#pragma unroll
                for (int ai = 0; ai < 2; ++ai) {
#pragma unroll
                    for (int m = 0; m < 4; ++m) { const f32x4 v = acc[ai][bj][m][n] + bv; u32x2 w; w.x = cvt_pk_bf16(v[0], v[1]); w.y = cvt_pk_bf16(v[2], v[3]);
                        *(LAS u32x2*)(wp + 32 * m) = w; }
                    const u32x4 r0 = *(const LAS u32x4*)rp, r1 = *(const LAS u32x4*)(rp + 8 * 144);
                    *(u32x4*)(gp + ai * HALF) = r0; *(u32x4*)(gp + ai * HALF + (size_t)8 * MTOK) = r1; }
            }
    }
};
__device__ __forceinline__ unsigned dpp_ror8(unsigned v) { return (unsigned)__builtin_amdgcn_update_dpp(0, (int)v, 0x128, 0xf, 0xf, false); }
__device__ __forceinline__ void xchg4(u32x4& u0, u32x4& u1, bool lo) { const u32x4 x = lo ? u1 : u0; u32x4 y; y.x = dpp_ror8(x.x); y.y = dpp_ror8(x.y); y.z = dpp_ror8(x.z); y.w = dpp_ror8(x.w); if (lo) u1 = y; else u0 = y; }
__device__ __forceinline__ void xchg2(u32x2& u0, u32x2& u1, bool lo) { const u32x2 x = lo ? u1 : u0; u32x2 y; y.x = dpp_ror8(x.x); y.y = dpp_ror8(x.y); if (lo) u1 = y; else u0 = y; }
struct EpiZXD {
    static constexpr bool TA = true; static constexpr int PERM = 2;
    unsigned char* Z8; bf16* XBC; float* DT; const float* b_in; bf16* HALO;
    __device__ __forceinline__ void operator()(const f32x4 (&acc)[2][2][4][2], const Unit& u, int wr, int wc, int fr, int fq) const {
        const bool lo = fr < 8; const int f7 = fr & 7;
        if (u.pn == 24) {
            if (wc == 0) { const int row0 = u.pm * BM + wr * 64 + fr;
#pragma unroll
                for (int bj = 0; bj < 2; ++bj)
#pragma unroll
                    for (int n = 0; n < 2; ++n) { const int c = 32 * bj + 8 * fq + 4 * n; const f32x4 bv = *(const f32x4*)(b_in + 9216 + c);
#pragma unroll
                        for (int ai = 0; ai < 2; ++ai)
#pragma unroll
                            for (int m = 0; m < 4; ++m) *(f32x4*)(DT + (size_t)(row0 + ai * HALF + m * 16) * 64 + c) = acc[ai][bj][m][n] + bv; } }
            return;
        }
        const int rowm = u.pm * BM + wr * 64 + f7;
        if (u.pn < 8) {
            const int cz = u.pn * BM + wc * 64 + 8 * fq;
            f32x4 bz[2][2];
#pragma unroll
            for (int bj = 0; bj < 2; ++bj) { bz[bj][0] = *(const f32x4*)(b_in + 3072 + cz + 32 * bj); bz[bj][1] = *(const f32x4*)(b_in + 3072 + cz + 32 * bj + 4); }
            unsigned char* zp = Z8 + (size_t)rowm * DSSM + cz + (lo ? 0 : 32);
#pragma unroll
            for (int ai = 0; ai < 2; ++ai)
#pragma unroll
                for (int m = 0; m < 4; ++m) { u32x2 p[2];
#pragma unroll
                    for (int bj = 0; bj < 2; ++bj) { const f32x4 v0 = acc[ai][bj][m][0] + bz[bj][0], v1 = acc[ai][bj][m][1] + bz[bj][1];
                        int w0 = __builtin_amdgcn_cvt_pk_fp8_f32(v0[0], v0[1], 0, false); w0 = __builtin_amdgcn_cvt_pk_fp8_f32(v0[2], v0[3], w0, true);
                        int w1 = __builtin_amdgcn_cvt_pk_fp8_f32(v1[0], v1[1], 0, false); w1 = __builtin_amdgcn_cvt_pk_fp8_f32(v1[2], v1[3], w1, true);
                        p[bj].x = (unsigned)w0; p[bj].y = (unsigned)w1; }
                    xchg2(p[0], p[1], lo);
                    unsigned char* q = zp + (size_t)(ai * HALF + m * 16) * DSSM;
                    *(u32x2*)q = p[0]; *(u32x2*)(q + (size_t)8 * DSSM) = p[1]; }
            return;
        }
        const int colt = (u.pn - 8) * BM, cx = colt + wc * 64 + 8 * fq;
        f32x4 bv[2][2];
#pragma unroll
        for (int bj = 0; bj < 2; ++bj)
#pragma unroll
            for (int n = 0; n < 2; ++n) bv[bj][n] = *(const f32x4*)(b_in + 5120 + cx + 32 * bj + 4 * n);
        const int cm = cx + (lo ? 0 : 32);
#pragma unroll
        for (int ai = 0; ai < 2; ++ai)
#pragma unroll
            for (int m = 0; m < 4; ++m) { u32x4 p[2];
#pragma unroll
                for (int bj = 0; bj < 2; ++bj) { const f32x4 v0 = acc[ai][bj][m][0] + bv[bj][0], v1 = acc[ai][bj][m][1] + bv[bj][1];
                    p[bj].x = cvt_pk_bf16(v0[0], v0[1]); p[bj].y = cvt_pk_bf16(v0[2], v0[3]); p[bj].z = cvt_pk_bf16(v1[0], v1[1]); p[bj].w = cvt_pk_bf16(v1[2], v1[3]); }
                xchg4(p[0], p[1], lo);
#pragma unroll
                for (int hb = 0; hb < 2; ++hb) { const int row = rowm + ai * HALF + m * 16 + 8 * hb;
                    *(u32x4*)(XBC + (size_t)row * CONVD + cm) = p[hb];
                    if ((m == 3 && hb == 1 && f7 >= 6) || (m == 0 && hb == 0 && f7 < 2)) {
                        const int bb = row >> 11, t = row & 2047, tm = t & 63;
                        const int jb = (tm >= 62) ? (t >> 6) + 1 : (t >> 6), idx = (tm >= 62) ? tm - 62 : 2 + tm;
                        *(u32x4*)(HALO + ((size_t)(bb * 33 + jb) * 4 + idx) * CONVD + cm) = p[hb]; } } }
    }
};
template <int MODE> struct EpiBf {
    static constexpr bool TA = true; static constexpr int PERM = 2;
    bf16* O; int ldc; const float* bias; const bf16* G1; int ldg; const bf16* P;
    __device__ __forceinline__ void operator()(const f32x4 (&acc)[2][2][4][2], const Unit& u, int wr, int wc, int fr, int fq) const {
        const bool lo = fr < 8; const int rowm = u.pm * BM + wr * 64 + (fr & 7), co = u.pn * BM + wc * 64 + 8 * fq, cm = co + (lo ? 0 : 32);
        f32x4 bb[2][2];
        if (MODE == 0) {
#pragma unroll
            for (int bj = 0; bj < 2; ++bj) { bb[bj][0] = *(const f32x4*)(bias + co + 32 * bj); bb[bj][1] = *(const f32x4*)(bias + co + 32 * bj + 4); } }
#pragma unroll
        for (int ai = 0; ai < 2; ++ai)
#pragma unroll
            for (int m = 0; m < 4; ++m) { const size_t r0 = (size_t)(rowm + ai * HALF + m * 16), r1 = r0 + 8; u32x4 g[2], pp[2], w[2];
                if (MODE != 0) { g[0] = *(const u32x4*)(G1 + r0 * ldg + cm); g[1] = *(const u32x4*)(G1 + r1 * ldg + cm);
                    if (MODE == 2) { pp[0] = *(const u32x4*)(P + r0 * ldc + cm); pp[1] = *(const u32x4*)(P + r1 * ldc + cm); }
                    xchg4(g[0], g[1], lo); if (MODE == 2) xchg4(pp[0], pp[1], lo); }
#pragma unroll
                for (int bj = 0; bj < 2; ++bj) { f32x4 v0 = acc[ai][bj][m][0], v1 = acc[ai][bj][m][1];
                    if (MODE == 0) { v0 = v0 + bb[bj][0]; v1 = v1 + bb[bj][1];
#pragma unroll
                        for (int j = 0; j < 4; ++j) { v0[j] = sigmoidf_(v0[j]); v1[j] = sigmoidf_(v1[j]); } }
                    else { const u32x4 gg = g[bj];
                        v0[0] *= bflo(gg.x); v0[1] *= bfhi(gg.x); v0[2] *= bflo(gg.y); v0[3] *= bfhi(gg.y); v1[0] *= bflo(gg.z); v1[1] *= bfhi(gg.z); v1[2] *= bflo(gg.w); v1[3] *= bfhi(gg.w);
                        if (MODE == 2) { const u32x4 p = pp[bj];
                            v0[0] += bflo(p.x); v0[1] += bfhi(p.x); v0[2] += bflo(p.y); v0[3] += bfhi(p.y); v1[0] += bflo(p.z); v1[1] += bfhi(p.z); v1[2] += bflo(p.w); v1[3] += bfhi(p.w); } }
                    w[bj].x = cvt_pk_bf16(v0[0], v0[1]); w[bj].y = cvt_pk_bf16(v0[2], v0[3]); w[bj].z = cvt_pk_bf16(v1[0], v1[1]); w[bj].w = cvt_pk_bf16(v1[2], v1[3]); }
                xchg4(w[0], w[1], lo);
                *(u32x4*)(O + r0 * ldc + cm) = w[0]; *(u32x4*)(O + r1 * ldc + cm) = w[1]; }
    }
};
struct EpiRes {
    static constexpr bool TA = true; static constexpr int PERM = 2;
    bf16* O; const float* bias; const bf16* X; float alpha;
    __device__ __forceinline__ void operator()(const f32x4 (&acc)[2][2][4][2], const Unit& u, int wr, int wc, int fr, int fq) const {
        const bool lo = fr < 8; const int rowm = u.pm * BM + wr * 64 + (fr & 7), co = u.pn * BM + wc * 64 + 8 * fq, cm = co + (lo ? 0 : 32);
        f32x4 bb[2][2];
#pragma unroll
        for (int bj = 0; bj < 2; ++bj) { bb[bj][0] = *(const f32x4*)(bias + co + 32 * bj); bb[bj][1] = *(const f32x4*)(bias + co + 32 * bj + 4); }
#pragma unroll
        for (int ai = 0; ai < 2; ++ai)
#pragma unroll
            for (int m = 0; m < 4; ++m) { const size_t o0 = (size_t)(rowm + ai * HALF + m * 16) * DM + cm, o1 = o0 + (size_t)8 * DM; u32x4 x[2], w[2];
                x[0] = *(const u32x4*)(X + o0); x[1] = *(const u32x4*)(X + o1); xchg4(x[0], x[1], lo);
#pragma unroll
                for (int bj = 0; bj < 2; ++bj) { const u32x4 xv = x[bj]; f32x4 v0 = acc[ai][bj][m][0] + bb[bj][0], v1 = acc[ai][bj][m][1] + bb[bj][1];
                    v0[0] += alpha * bflo(xv.x); v0[1] += alpha * bfhi(xv.x); v0[2] += alpha * bflo(xv.y); v0[3] += alpha * bfhi(xv.y);
                    v1[0] += alpha * bflo(xv.z); v1[1] += alpha * bfhi(xv.z); v1[2] += alpha * bflo(xv.w); v1[3] += alpha * bfhi(xv.w);
                    w[bj].x = cvt_pk_bf16(v0[0], v0[1]); w[bj].y = cvt_pk_bf16(v0[2], v0[3]); w[bj].z = cvt_pk_bf16(v1[0], v1[1]); w[bj].w = cvt_pk_bf16(v1[2], v1[3]); }
                xchg4(w[0], w[1], lo);
                *(u32x4*)(O + o0) = w[0]; *(u32x4*)(O + o1) = w[1]; }
    }
};
struct EpiSwiGLU {
    static constexpr bool TA = true; static constexpr int PERM = 1;
    bf16* HID;
    __device__ __forceinline__ void operator()(const f32x4 (&acc)[2][2][4][2], const Unit& u, int wr, int wc, int fr, int fq) const {
        const int row0 = u.pm * BM + wr * 64 + fr, col0 = u.pn * HALF + wc * 32 + 8 * fq;
#pragma unroll
        for (int ai = 0; ai < 2; ++ai)
#pragma unroll
            for (int m = 0; m < 4; ++m) { f32x4 v0, v1;
#pragma unroll
                for (int j = 0; j < 4; ++j) { v0[j] = siluf_(acc[ai][0][m][0][j]) * acc[ai][1][m][0][j]; v1[j] = siluf_(acc[ai][0][m][1][j]) * acc[ai][1][m][1][j]; }
                u32x4 w; w.x = cvt_pk_bf16(v0[0], v0[1]); w.y = cvt_pk_bf16(v0[2], v0[3]); w.z = cvt_pk_bf16(v1[0], v1[1]); w.w = cvt_pk_bf16(v1[2], v1[3]);
                *(u32x4*)(HID + (size_t)(row0 + ai * HALF + m * 16) * DEXP + col0) = w; }
    }
};
struct EpiScatter {
    static constexpr bool TA = false; static constexpr int PERM = 0;
    float* ACC; const int* tok; const float* wgt; int j0_unused;
    __device__ __forceinline__ void operator()(const f32x4 (&acc)[2][2][4][2], const Unit& u, int wr, int wc, int fr, int fq) const {
        asm volatile("" : "+v"(fr), "+v"(fq));
        const int jt = u.pn >> 2, ct = u.pn & 3;
#pragma unroll
        for (int ai = 0; ai < 2; ++ai)
#pragma unroll
            for (int m = 0; m < 4; ++m)
#pragma unroll
                for (int j = 0; j < 4; ++j) { const int r = ai * HALF + wr * 64 + m * 16 + 4 * fq + j;
                    if (r < u.cnt) { int token; float w;
                        if (u.e == NE) { token = jt * BM + r; w = 1.0f; } else { const size_t li = (size_t)u.e * MTOK + (size_t)jt * BM + r; token = tok[li]; w = wgt[li]; }
                        float* rowp = ACC + (size_t)token * DM + ct * BM + wc * 32 + fr;
#pragma unroll
                        for (int bj = 0; bj < 2; ++bj)
#pragma unroll
                            for (int n = 0; n < 2; ++n) unsafeAtomicAdd(rowp + bj * HALF + n * 16, w * acc[ai][bj][m][n][j]);
                    }
                    asm volatile("" ::: "memory"); }
    }
};

struct EpiSlot8 {
    static constexpr bool TA = true; static constexpr int PERM = 3;
    unsigned char* YQ;
    __device__ __forceinline__ void operator()(const f32x4 (&acc)[2][2][4][2], const Unit& u, int wr, int wc, int fr, int fq) const {
        asm volatile("" : "+v"(fr), "+v"(fq));
        const int row0 = u.pm * BM + wr * 64 + fr, col0 = u.pn * 256 + wc * 64 + 16 * fq;
#pragma unroll
        for (int ai = 0; ai < 2; ++ai)
#pragma unroll
            for (int m = 0; m < 4; ++m) { u32x4 w;
#pragma unroll
                for (int bj = 0; bj < 2; ++bj) { const f32x4 v0 = acc[ai][bj][m][0], v1 = acc[ai][bj][m][1];
                    int w0 = __builtin_amdgcn_cvt_pk_fp8_f32(v0[0], v0[1], 0, false); w0 = __builtin_amdgcn_cvt_pk_fp8_f32(v0[2], v0[3], w0, true);
                    int w1 = __builtin_amdgcn_cvt_pk_fp8_f32(v1[0], v1[1], 0, false); w1 = __builtin_amdgcn_cvt_pk_fp8_f32(v1[2], v1[3], w1, true);
                    if (bj == 0) { w.x = (unsigned)w0; w.y = (unsigned)w1; } else { w.z = (unsigned)w0; w.w = (unsigned)w1; } }
                *(u32x4*)(YQ + (size_t)(row0 + ai * HALF + m * 16) * 1024 + col0) = w; }
    }
};
struct SlotOrder4 {
    const LAS int* tp; const LAS int* te; int G, c, total; const char* A; const char* W;
    __device__ __forceinline__ bool next(int i, Unit& u) const {
        int tile, q;
        if (G == 256) { const int cx = c & 7, cj = c >> 3; q = cj & 3; tile = i * 64 + (cj >> 2) * 8 + cx; }
        else { const long L = (long)i * G + c; tile = (int)(L >> 2); q = (int)(L & 3); }
        if (tile >= total) return false;
        const int e = te[tile];
        u.e = e; u.cnt = 0; u.pm = tile; u.pn = q; u.A = A + (size_t)tile * BM * DEXP * 2; u.B = W + ((size_t)e * DM + (size_t)q * 256) * DEXP * 2;
        return true;
    }
    __device__ __forceinline__ unsigned row_off(const Unit&, int) const { return 0u; }
};
template <int NCT, bool FIRST> struct MoeOrder {
    const LAS int* tp; const LAS int* cnt; const LAS int* te; int G, c, total;
    const char* A; const char* W; const int* tok;
    __device__ __forceinline__ bool next(int i, Unit& u) const {
        const long L = (long)i * G + c; if (L >= (long)total * NCT) return false;
        const int tile = (int)(L / NCT), ct = (int)(L % NCT);
        const int e = te[tile];
        const int jt = tile - tp[e];
        u.e = e; const int left = cnt[e] - jt * BM; u.cnt = left < BM ? left : BM;
        if (FIRST) { u.pm = tile; u.pn = ct; u.A = A; u.B = W + ((size_t)e * 512 + (size_t)ct * 256) * DM * 2; }
        else { u.pm = tile; u.pn = jt * 4 + ct; u.A = A + (size_t)tile * BM * DEXP * 2; u.B = W + ((size_t)e * DM + (size_t)ct * 256) * DEXP * 2; }
        return true;
    }
    __device__ __forceinline__ unsigned row_off(const Unit& u, int r) const {
        const int jt = u.pm - tp[u.e]; int token;
        if (u.e == NE) token = jt * BM + r; else token = (r < u.cnt) ? tok[(size_t)u.e * MTOK + (size_t)jt * BM + r] : 0;
        return (unsigned)token * (unsigned)(H1B_PITCH * 2);
    }
};
}

#define XB_TMO      128
#define XB_XCNT(j)  (256  + 64 * (j))
#define XB_XSUB(j)  (1280 + 64 * (j))
#define XB_XGEN(j)  (2304 + 64 * (j))
#define XB_TOP      3328
#define XB_TOPGEN   3392
#define XCD_BAR_WORDS 3456
#define XB_SPIN_CAP (1u << 18)
__device__ __forceinline__ unsigned xb_ld(unsigned* p)              { return __hip_atomic_load(p, __ATOMIC_RELAXED, __HIP_MEMORY_SCOPE_AGENT); }
__device__ __forceinline__ unsigned xb_add(unsigned* p, unsigned v) { return __hip_atomic_fetch_add(p, v, __ATOMIC_RELAXED, __HIP_MEMORY_SCOPE_AGENT); }
__device__ __forceinline__ unsigned xb_xcc_id() { return (unsigned)__builtin_amdgcn_s_getreg((3 << 11) | 20) & 0xFu; }
#define XB_SPIN(cond, bar) do { unsigned _sp = 0; while (cond) { __builtin_amdgcn_s_sleep(1); \
    if ((++_sp & 255u) == 0u) { if (xb_ld(&(bar)[XB_TMO])) break; if (_sp > XB_SPIN_CAP) { atomicAdd(&(bar)[XB_TMO], 1u); break; } } } } while (0)
struct XcdBarrier { unsigned* bar; unsigned x; volatile LAS unsigned* st; };
__device__ __forceinline__ XcdBarrier xcd_barrier_post(unsigned* bar, volatile LAS unsigned* st) {
    XcdBarrier b; b.bar = bar; b.x = xb_xcc_id(); b.st = st;
    if (threadIdx.x == 0) (void)xb_add(&bar[XB_XCNT(b.x)], 1u);
    return b;
}
__device__ __forceinline__ void xcd_barrier_complete(unsigned* bar, unsigned x, unsigned& nloc, unsigned& nx) {
    const unsigned G = gridDim.x * gridDim.y * gridDim.z;
    unsigned sum, cnt, mine, sp = 0u;
    for (;;) {
        sum = 0u; cnt = 0u; mine = 0u;
#pragma unroll
        for (unsigned j = 0; j < 16; ++j) { const unsigned c = xb_ld(&bar[XB_XCNT(j)]); sum += c; cnt += (c > 0u) ? 1u : 0u; mine = (j == x) ? c : mine; }
        if (sum == G) break;
        __builtin_amdgcn_s_sleep(1);
        if ((++sp & 255u) == 0u) { if (xb_ld(&bar[XB_TMO])) break; if (sp > XB_SPIN_CAP) { atomicAdd(&bar[XB_TMO], 1u); break; } }
    }
    nloc = mine > 0u ? mine : 1u; nx = cnt > 0u ? cnt : 1u;
}
__device__ __forceinline__ void xcd_barrier(const XcdBarrier& b) {
    asm volatile("s_waitcnt vmcnt(0)" ::: "memory");
    __syncthreads();
    if (threadIdx.x == 0) {
        unsigned* bar = b.bar;
        __builtin_amdgcn_s_waitcnt(0);
        unsigned nloc = b.st[0], nx = b.st[1];
        if (nloc == 0u) { xcd_barrier_complete(bar, b.x, nloc, nx); b.st[0] = nloc; b.st[1] = nx; }
        const unsigned old = xb_add(&bar[XB_XSUB(b.x)], 1u);
        const unsigned gen = old / nloc;
        if (old + 1u == (gen + 1u) * nloc) {
            __builtin_amdgcn_fence(__ATOMIC_RELEASE, "agent");
            asm volatile("s_waitcnt vmcnt(0)" ::: "memory");
            const unsigned og = xb_add(&bar[XB_TOP], 1u);
            const unsigned tg = og / nx;
            if (og + 1u == (tg + 1u) * nx) xb_add(&bar[XB_TOPGEN], 1u);
            else XB_SPIN(xb_ld(&bar[XB_TOPGEN]) == tg, bar);
            __builtin_amdgcn_fence(__ATOMIC_ACQUIRE, "agent");
            xb_add(&bar[XB_XGEN(b.x)], 1u);
            asm volatile("s_waitcnt vmcnt(0)" ::: "memory");
        } else {
            XB_SPIN(xb_ld(&bar[XB_XGEN(b.x)]) == gen, bar);
            __builtin_amdgcn_fence(__ATOMIC_ACQUIRE, "agent");
            asm volatile("s_waitcnt vmcnt(0)" ::: "memory");
        }
    }
    __syncthreads();
}

struct Args {
    const float* in[38]; float* out; unsigned char* ws; int ph_lo, ph_hi, li, pad;
};
enum { I_X = 0, I_WIN, I_BIN, I_HCW, I_HCB, I_FW1, I_FB1, I_FF1, I_FW2, I_FB2, I_FF2, I_FW3, I_FB3, I_FF3, I_FW4, I_HBIAS,
       I_SCW, I_SCB, I_DTB, I_ALOG, I_SD, I_SNW, I_WHYB, I_WSSDB, I_WOUT, I_BOUT, I_LN1G, I_LN1B, I_RW, I_RB, I_EWG, I_EWU, I_EWD, I_SWG, I_SWU, I_SWD, I_LN2G, I_LN2B };
struct Frame {
    LAS unsigned char* lds; volatile LAS unsigned* MISC; gu32* ctl; unsigned char* ws;
    int tid, lane, wave, vcu, G;
    const float* const* in; float* out;
};

__device__ __forceinline__ void tr_item(const float* src, int ld_src, int k0, int c0, bf16* dst, int drow0, int ldd, LAS float* scr, int lane) {
    f32x4 ld[8];
#pragma unroll
    for (int i = 0; i < 8; ++i) ld[i] = *(const f32x4*)(src + (size_t)(k0 + 8 * i + (lane >> 3)) * ld_src + c0 + 4 * (lane & 7));
#pragma unroll
    for (int i = 0; i < 8; ++i) { LAS float* d = scr + (8 * i + (lane >> 3)) * 33 + 4 * (lane & 7); d[0] = ld[i][0]; d[1] = ld[i][1]; d[2] = ld[i][2]; d[3] = ld[i][3]; }
    LDS_WAIT(); asm volatile("" ::: "memory");
    const int c = lane & 7;
#pragma unroll
    for (int j = 0; j < 4; ++j) { const int n = (lane >> 3) + 8 * j; const LAS float* s = scr + (8 * c) * 33 + n;
        u32x4 o; o.x = pk2(s[0 * 33], s[1 * 33]); o.y = pk2(s[2 * 33], s[3 * 33]); o.z = pk2(s[4 * 33], s[5 * 33]); o.w = pk2(s[6 * 33], s[7 * 33]);
        *(u32x4*)(dst + (size_t)(drow0 + n) * ldd + k0 + 8 * c) = o; }
    LDS_WAIT(); asm volatile("" ::: "memory");
}
__device__ __forceinline__ void tr_matrix_item(const float* src, int ld_src, int K, int col_first, int ncols, bf16* dst, int drow_first, LAS float* scr, int it, int lane) {
    const int nblk = ncols / 32, kb = it / nblk, nb = it % nblk;
    tr_item(src, ld_src, kb * 64, col_first + nb * 32, dst, drow_first + nb * 32, K, scr, lane);
}
__device__ __forceinline__ void convert_x(Frame& F, const float* x, bf16* xb) {
    const size_t n8 = (size_t)MTOK * DM / 8; const size_t stride = (size_t)F.G * NTHR;
    for (size_t i = (size_t)F.vcu * NTHR + F.tid; i < n8; i += 4 * stride) {
        f32x4 a[4], b[4];
#pragma unroll
        for (int u = 0; u < 4; ++u) { const size_t k = (i + u * stride < n8) ? i + u * stride : i; a[u] = *(const f32x4*)(x + k * 8); b[u] = *(const f32x4*)(x + k * 8 + 4); }
#pragma unroll
        for (int u = 0; u < 4; ++u) { u32x4 o; o.x = pk2(a[u][0], a[u][1]); o.y = pk2(a[u][2], a[u][3]); o.z = pk2(b[u][0], b[u][1]); o.w = pk2(b[u][2], b[u][3]);
            if (i + u * stride < n8) *(u32x4*)(xb + (i + u * stride) * 8) = o; } }
}

__device__ __forceinline__ void hyena_filter(Frame& F) {
    const float* w1 = F.in[I_FW1]; const float* b1 = F.in[I_FB1]; const float* f1 = F.in[I_FF1];
    const float* w2 = F.in[I_FW2]; const float* b2 = F.in[I_FB2]; const float* f2 = F.in[I_FF2];
    const float* w3 = F.in[I_FW3]; const float* b3 = F.in[I_FB3]; const float* f3 = F.in[I_FF3];
    const float* w4 = F.in[I_FW4];
    bf16* KERN = (bf16*)(F.ws + WS_KERN);
    LAS float* hbuf = (LAS float*)(F.lds);
    const int lane = F.lane, wave = F.wave;
    for (int pg = F.vcu; pg < SEQ / 8; pg += F.G) {
        const int t = 8 * pg + wave;
        const float tn = (float)t / (float)(SEQ - 1), wv = 6.283185307179586f * (float)t / (float)SEQ;
        float zf = 0.f;
        if (lane == 0) zf = tn;
        else if (lane <= 16) { const float f = 1e-4f + (float)(lane - 1) * ((15.0f - 1e-4f) / 15.0f); zf = cosf(f * wv); }
        else if (lane <= 32) { const float f = 1e-4f + (float)(lane - 17) * ((15.0f - 1e-4f) / 15.0f); zf = -sinf(f * wv); }
        float s = b1[lane];
        for (int i = 0; i < 33; ++i) s += __shfl(zf, i) * w1[i * 64 + lane];
        float h = sinf(f1[lane] * s);
        s = b2[lane];
        for (int i = 0; i < 64; ++i) s += __shfl(h, i) * w2[i * 64 + lane];
        h = sinf(f2[lane] * s);
        s = b3[lane];
        for (int i = 0; i < 64; ++i) s += __shfl(h, i) * w3[i * 64 + lane];
        h = sinf(f3[lane] * s);
        hbuf[wave * 64 + lane] = h;
        __syncthreads();
        { float a[8][8];
#pragma unroll
          for (int q = 0; q < 8; ++q)
#pragma unroll
              for (int p = 0; p < 8; ++p) a[q][p] = 0.f;
          float a0b[4] = {0.f, 0.f, 0.f, 0.f};
#pragma unroll 2
          for (int i = 0; i < 64; ++i) { float wv[8], hv[8];
#pragma unroll
              for (int q = 0; q < 8; ++q) wv[q] = w4[(size_t)i * 4096 + F.tid + 512 * q];
#pragma unroll
              for (int p = 0; p < 8; ++p) hv[p] = hbuf[p * 64 + i];
#pragma unroll
              for (int q = 0; q < 8; ++q)
#pragma unroll
                  for (int p = 0; p < 8; ++p) a[q][p] += hv[p] * wv[q];
              if (pg == 0) { a0b[0] += hv[0] * wv[2]; a0b[1] += hv[0] * wv[3]; a0b[2] += hv[0] * wv[6]; a0b[3] += hv[0] * wv[7]; } }
#pragma unroll
          for (int q = 0; q < 8; ++q) { const int col = F.tid + 512 * q, c = col & 1023, dir = (q >> 1) & 1, o = q >> 2;
              const float adel = 3.0701134573253945f + (float)c * ((15.350567286626973f - 3.0701134573253945f) / 1023.0f);
              bf16* kc = KERN + ((size_t)c * 2 + o) * 4096;
#pragma unroll
              for (int p = 0; p < 8; ++p) { const int tp = 8 * pg + p; const float v = a[q][p] * __expf(-((float)tp / (float)(SEQ - 1)) * adel);
                  if (tp == 0) { if (dir == 0) { kc[2048] = (bf16)f2bf(v + a0b[(q & 1) + 2 * o]); kc[0] = 0; } }
                  else kc[dir == 0 ? 2048 - tp : 2048 + tp] = (bf16)f2bf(v); } } }
        __syncthreads();
    }
}

__device__ __forceinline__ void p0_prologue(Frame& F) {
    LAS float* scr = (LAS float*)(F.lds + 4096 + F.wave * 16384);
    const int gw = F.vcu * NWAVES + F.wave, NGW = F.G * NWAVES;
    const bool late_filter = (blockIdx.x & 1);
    bf16* WINT = (bf16*)(F.ws + WS_WINT);
    constexpr int I_A = 16 * (9216 / 32), I_B = 16 * (64 / 32), I_C = 16 * (2048 / 32);
    constexpr int I_HY = 16 * 32, I_SS = 32 * 32, I_OUT = 16 * 32;
    constexpr int NITEMS = I_A + I_B + I_C + I_HY + I_SS + I_OUT;
#pragma unroll 1
    for (int s_ = 0; s_ < 2; ++s_) {
    if ((s_ == 1) == late_filter) { hyena_filter(F); continue; }
    for (int it = gw; it < NITEMS; it += NGW) {
        int r = it;
        if (r < I_A) { tr_matrix_item(F.in[I_WIN], INC, DM, 0, 9216, WINT, 0, scr, r, F.lane); continue; } r -= I_A;
        if (r < I_B) { tr_matrix_item(F.in[I_WIN], INC, DM, 9216, 64, WINT, 9216, scr, r, F.lane); continue; } r -= I_B;
        if (r < I_C) { tr_matrix_item(F.in[I_WIN], INC, DM, 9280, 2048, (bf16*)(F.ws + WS_WING), 0, scr, r, F.lane); continue; } r -= I_C;
        if (r < I_HY) { tr_matrix_item(F.in[I_WHYB], DM, DM, 0, DM, (bf16*)(F.ws + WS_WHYB), 0, scr, r, F.lane); continue; } r -= I_HY;
        if (r < I_SS) { tr_matrix_item(F.in[I_WSSDB], DM, DSSM, 0, DM, (bf16*)(F.ws + WS_WSSDB), 0, scr, r, F.lane); continue; } r -= I_SS;
        tr_matrix_item(F.in[I_WOUT], DM, DM, 0, DM, (bf16*)(F.ws + WS_WOUT), 0, scr, r, F.lane);
    }
    convert_x(F, F.in[I_X], (bf16*)((unsigned char*)F.out + OUT_XB));
    __syncthreads();
    }
}
__device__ __forceinline__ void p6_reconvert(Frame& F) {
    LAS float* scr = (LAS float*)(F.lds + 4096 + F.wave * 16384);
    const int gw = F.vcu * NWAVES + F.wave, NGW = F.G * NWAVES;
    for (int it = gw; it < 16 * (2048 / 32); it += NGW) tr_matrix_item(F.in[I_WIN], INC, DM, 9280, 2048, (bf16*)(F.ws + WS_WING), 0, scr, it, F.lane);
    convert_x(F, F.in[I_X], (bf16*)(F.ws + WS_XB2));
}
__device__ __forceinline__ void p10_expert_weights(Frame& F) {
    LAS float* scr = (LAS float*)(F.lds + 4096 + F.wave * 16384);
    const int gw = F.vcu * NWAVES + F.wave, NGW = F.G * NWAVES;
    bf16* EW1 = (bf16*)(F.ws + WS_EW1); bf16* EW2 = (bf16*)(F.ws + WS_EW2);
    constexpr int PER1 = 16 * 4;
    constexpr int N1 = NEX * 2 * 2 * PER1, PER2 = 4 * 32, N2 = NEX * PER2;
    for (int it = gw; it < N1 + N2; it += NGW) {
        if (it < N1) { const int e = it / (4 * PER1), r0 = it % (4 * PER1), mat = r0 / (2 * PER1), r1 = r0 % (2 * PER1), ct = r1 / PER1, r2 = r1 % PER1;
            const float* src = (e < NE) ? F.in[mat ? I_EWU : I_EWG] + (size_t)e * DM * DEXP : F.in[mat ? I_SWU : I_SWG];
            tr_matrix_item(src, DEXP, DM, 128 * ct, 128, EW1 + (size_t)e * 512 * DM, 256 * ct + 128 * mat, scr, r2, F.lane); }
        else { const int r = it - N1, e = r / PER2, r2 = r % PER2;
            const float* src = (e < NE) ? F.in[I_EWD] + (size_t)e * DEXP * DM : F.in[I_SWD];
            tr_matrix_item(src, DM, DEXP, 0, DM, EW2 + (size_t)e * DM * DEXP, 0, scr, r2, F.lane); }
    }
}
__device__ __forceinline__ void p3_transpose(Frame& F) {
    const bf16* YT = (const bf16*)(F.ws + WS_YTHY); bf16* Y = (bf16*)(F.ws + WS_YHY);
    LAS bf16* scr = (LAS bf16*)(F.lds + F.wave * 9216);
    const int gw = F.vcu * NWAVES + F.wave, NGW = F.G * NWAVES, lane = F.lane;
    for (int tile = gw; tile < 16 * 512; tile += NGW) {
        const int c0 = (tile & 15) * 64, t0 = (tile >> 4) * 64;
#pragma unroll
        for (int p = 0; p < 8; ++p) { const int c = p * 8 + (lane >> 3), ch = lane & 7;
            const u32x4 g = *(const u32x4*)(YT + (size_t)(c0 + c) * MTOK + t0 + ch * 8);
            LAS bf16* d = scr + (ch * 8) * 72 + (c ^ (ch << 3));
            d[0 * 72] = (bf16)(g.x & 0xffff); d[1 * 72] = (bf16)(g.x >> 16); d[2 * 72] = (bf16)(g.y & 0xffff); d[3 * 72] = (bf16)(g.y >> 16);
            d[4 * 72] = (bf16)(g.z & 0xffff); d[5 * 72] = (bf16)(g.z >> 16); d[6 * 72] = (bf16)(g.w & 0xffff); d[7 * 72] = (bf16)(g.w >> 16); }
        LDS_WAIT(); asm volatile("" ::: "memory");
#pragma unroll
        for (int p = 0; p < 8; ++p) { const int tk = p * 8 + (lane >> 3), ch = lane & 7;
            const u32x4 v = *(const LAS u32x4*)(scr + tk * 72 + ((ch ^ ((tk >> 3) & 7)) << 3));
            *(u32x4*)(Y + (size_t)(t0 + tk) * DM + c0 + ch * 8) = v; }
        LDS_WAIT(); asm volatile("" ::: "memory");
    }
}

constexpr int HY_LDU = 2064, HY_KCS = 4128, HY_U_BYTES = 16 * HY_LDU * 2, HY_KC_BYTES = 8 * HY_KCS * 2;

struct HyKRow { u32x4 cur, prv; };
__device__ __forceinline__ void hy_load_kern(HyKRow& r, const bf16* kern, int tid) {
    r.cur = *(const u32x4*)(kern + 8 * tid);
    r.prv = (u32x4){0u, 0u, 0u, 0u};
    if (tid > 0) r.prv = *(const u32x4*)(kern + 8 * tid - 8);
}
__device__ __forceinline__ void hy_store_kc(LAS bf16* KC, const HyKRow& r, int tid) {
    const unsigned E[9] = {r.prv.x, r.prv.y, r.prv.z, r.prv.w, r.cur.x, r.cur.y, r.cur.z, r.cur.w, 0u};
#pragma unroll
    for (int fl = 0; fl < 8; ++fl) { const int sft = 8 - fl, k = sft >> 1;
        u32x4 o;
        if (sft & 1) { o.x = __builtin_amdgcn_alignbit(E[k + 1], E[k], 16); o.y = __builtin_amdgcn_alignbit(E[k + 2], E[k + 1], 16);
                       o.z = __builtin_amdgcn_alignbit(E[k + 3], E[k + 2], 16); o.w = __builtin_amdgcn_alignbit(E[k + 4], E[k + 3], 16); }
        else { o.x = E[k]; o.y = E[k + 1]; o.z = E[k + 2]; o.w = E[k + 3]; }
        *(LAS u32x4*)(KC + fl * HY_KCS + 8 * tid) = o; }
}
__device__ __forceinline__ f32x4 hy_short4(const bf16* prow, int t0, float w0, float w1, float w2, float cb) {
    const u32x2 g = *(const u32x2*)(prow + t0);
    const float p0 = bflo(g.x), p1 = bfhi(g.x), p2 = bflo(g.y), p3 = bfhi(g.y);
    const float pm = (t0 > 0) ? bf2f(prow[t0 - 1]) : 0.f, pp = (t0 + 4 < SEQ) ? bf2f(prow[t0 + 4]) : 0.f;
    f32x4 r; r[0] = cb + w0 * pm + w1 * p0 + w2 * p1; r[1] = cb + w0 * p0 + w1 * p1 + w2 * p2; r[2] = cb + w0 * p1 + w1 * p2 + w2 * p3; r[3] = cb + w0 * p2 + w1 * p3 + w2 * pp;
    return r;
}
__device__ __forceinline__ f32x4 hy_conv4(const u32x2 g, float pm, float pp, float w0, float w1, float w2, float cb) {
    const float p0 = bflo(g.x), p1 = bfhi(g.x), p2 = bflo(g.y), p3 = bfhi(g.y);
    f32x4 r; r[0] = cb + w0 * pm + w1 * p0 + w2 * p1; r[1] = cb + w0 * p0 + w1 * p1 + w2 * p2; r[2] = cb + w0 * p1 + w1 * p2 + w2 * p3; r[3] = cb + w0 * p2 + w1 * p3 + w2 * pp;
    return r;
}
__device__ __forceinline__ void hyena_phase(Frame& F) {
    LAS bf16* U = (LAS bf16*)(F.lds); LAS bf16* KC = (LAS bf16*)(F.lds + HY_U_BYTES);
    const bf16* PT = (const bf16*)(F.ws + WS_PTHY); const bf16* KERN = (const bf16*)(F.ws + WS_KERN); bf16* YT = (bf16*)(F.ws + WS_YTHY);
    const float* cw = F.in[I_HCW]; const float* cbv = F.in[I_HCB]; const float* hb = F.in[I_HBIAS];
    const int tid = F.tid, lane = F.lane, w = F.wave, fr = lane & 15, fq = lane >> 4;
    u32x4 um[8]; unsigned ee[8]; HyKRow kr;
    auto load_v = [&](int c) { int tl = tid; asm volatile("" : "+v"(tl));
        const bf16* prow = PT + (size_t)(2048 + c) * MTOK + (size_t)(tl >> 8) * SEQ + (tl & 255) * 8;
#pragma unroll
        for (int it = 0; it < 8; ++it) { um[it] = *(const u32x4*)(prow + (size_t)(2 * it) * SEQ); ee[it] = 0u; }
        if (lane == 0 || lane == 63) {
#pragma unroll
            for (int it = 0; it < 8; ++it) { const int t8 = (tl & 255) * 8; const bf16* pr = prow + (size_t)(2 * it) * SEQ - t8;
                if (lane == 0) { if (t8 > 0) ee[it] = pr[t8 - 1]; } else { if (t8 + 8 < SEQ) ee[it] = pr[t8 + 8]; } } } };
    if (F.vcu < DM) { hy_load_kern(kr, KERN + ((size_t)F.vcu * 2 + 0) * 4096, tid); load_v(F.vcu); }
    for (int c = F.vcu; c < DM; c += F.G) {
        const bool has_next = (c + F.G < DM);
        hy_store_kc(KC, kr, tid);
        { const int vc = 2048 + c; const float w0 = cw[0 * HYC + vc], w1 = cw[1 * HYC + vc], w2 = cw[2 * HYC + vc], cb = cbv[vc];
#pragma unroll
          for (int it = 0; it < 8; ++it) { const int idx = tid + 512 * it, b = idx >> 8, t8 = (idx & 255) * 8;
              const unsigned up = __shfl_up(um[it].w >> 16, 1), dn = __shfl_down(um[it].x & 0xffffu, 1);
              const float pm = bf2f(lane == 0 ? ee[it] : up), pp = bf2f(lane == 63 ? ee[it] : dn);
              u32x2 g0; g0.x = um[it].x; g0.y = um[it].y; u32x2 g1v; g1v.x = um[it].z; g1v.y = um[it].w;
              const f32x4 lo = hy_conv4(g0, pm, bflo(um[it].z), w0, w1, w2, cb), hi = hy_conv4(g1v, bfhi(um[it].y), pp, w0, w1, w2, cb);
              u32x4 o; o.x = pk2(lo[0], lo[1]); o.y = pk2(lo[2], lo[3]); o.z = pk2(hi[0], hi[1]); o.w = pk2(hi[2], hi[3]);
              *(LAS u32x4*)(U + b * HY_LDU + t8) = o; } }
        __syncthreads();
#pragma unroll
        for (int o = 0; o < 2; ++o) {
            const int gc = (o == 0) ? c : 1024 + c;
            int lz = lane; asm volatile("" : "+v"(lz));
            const bf16* grow = PT + (size_t)gc * MTOK + (size_t)(lz & 15) * SEQ;
            u32x2 gm[16];
#pragma unroll
            for (int tt = 0; tt < 16; ++tt) gm[tt] = *(const u32x2*)(grow + 256 * w + 16 * tt + 4 * fq);
            const unsigned edge_lo = (w > 0) ? (unsigned)grow[256 * w - 1] : 0u, edge_hi = (w < 7) ? (unsigned)grow[256 * w + 256] : 0u;
            if (o == 0) hy_load_kern(kr, KERN + ((size_t)c * 2 + 1) * 4096, tid);
            else if (has_next) hy_load_kern(kr, KERN + ((size_t)(c + F.G) * 2 + 0) * 4096, tid);
            f32x4 acc[16];
#pragma unroll
            for (int i = 0; i < 16; ++i) acc[i] = (f32x4){0.f, 0.f, 0.f, 0.f};
            const LAS bf16* kbase = KC + (fr & 7) * HY_KCS + 2048 + 8 * fq - 8 * (fr >> 3) - 256 * w;
            const LAS bf16* ubase = U + fr * HY_LDU + 8 * fq;
            bf16x8 win[16];
#pragma unroll
            for (int i = 0; i < 16; ++i) win[i] = *(const LAS bf16x8*)(kbase - 16 * i);
            bf16x8 bnx = *(const LAS bf16x8*)(ubase);
#define HY_TIE(a, b, c) asm volatile("s_waitcnt lgkmcnt(0)" : "+v"(a), "+v"(b), "+v"(c) :: "memory")
#pragma unroll 1
            for (int sj8 = 0; sj8 < 64; sj8 += 8) {
#pragma unroll
                for (int u = 0; u < 8; ++u) { const int sj = sj8 + u;
                    HY_TIE(bnx, win[(16 - 2 * u) & 15], win[(17 - 2 * u) & 15]);
                    const bf16x8 bfr = bnx;
#pragma unroll
                    for (int tt = 14; tt < 16; ++tt) acc[tt] = __builtin_amdgcn_mfma_f32_16x16x32_bf16(win[(tt - 2 * u) & 15], bfr, acc[tt], 0, 0, 0);
                    __builtin_amdgcn_sched_barrier(0);
                    bnx = *(const LAS bf16x8*)(ubase + 32 * ((sj + 1) & 63));
                    win[(14 - 2 * u) & 15] = *(const LAS bf16x8*)(kbase + 16 * (2 * sj + 2));
                    win[(15 - 2 * u) & 15] = *(const LAS bf16x8*)(kbase + 16 * (2 * sj + 1));
                    __builtin_amdgcn_sched_barrier(0);
#pragma unroll
                    for (int tt = 2; tt < 14; ++tt) acc[tt] = __builtin_amdgcn_mfma_f32_16x16x32_bf16(win[(tt - 2 * u) & 15], bfr, acc[tt], 0, 0, 0);
#pragma unroll
                    for (int tt = 0; tt < 2; ++tt) acc[tt] = __builtin_amdgcn_mfma_f32_16x16x32_bf16(win[(tt - 2 * u) & 15], bfr, acc[tt], 0, 0, 0);
                    __builtin_amdgcn_sched_barrier(0);
                } }
#undef HY_TIE
            if (o == 1 && has_next) load_v(c + F.G);
            const float hbias = hb[o * DM + c];
            const float w0 = cw[0 * HYC + gc], w1 = cw[1 * HYC + gc], w2 = cw[2 * HYC + gc], cb = cbv[gc];
            u32x2 zpk[16];
            unsigned pa[16], nb[16];
#pragma unroll
            for (int tt = 0; tt < 16; ++tt) { pa[tt] = __shfl(gm[tt].y >> 16, (lane + 48) & 63); nb[tt] = __shfl(gm[tt].x & 0xffffu, (lane + 16) & 63); }
#pragma unroll
            for (int tt = 0; tt < 16; ++tt) { const int t0 = 256 * w + 16 * tt + 4 * fq;
                const unsigned pmv = (fq > 0) ? pa[tt] : (tt > 0 ? pa[tt > 0 ? tt - 1 : 0] : edge_lo), ppv = (fq < 3) ? nb[tt] : (tt < 15 ? nb[tt < 15 ? tt + 1 : 15] : edge_hi);
                const u32x2 uu = *(const LAS u32x2*)(U + fr * HY_LDU + t0);
                const f32x4 g = hy_conv4(gm[tt], bf2f(pmv), bf2f(ppv), w0, w1, w2, cb);
                f32x4 y = acc[tt]; y[0] = g[0] * (y[0] + bflo(uu.x) * hbias); y[1] = g[1] * (y[1] + bfhi(uu.x) * hbias); y[2] = g[2] * (y[2] + bflo(uu.y) * hbias); y[3] = g[3] * (y[3] + bfhi(uu.y) * hbias);
                zpk[tt].x = pk2(y[0], y[1]); zpk[tt].y = pk2(y[2], y[3]); }
            __syncthreads();
            if (o == 0) {
#pragma unroll
                for (int tt = 0; tt < 16; ++tt) *(LAS u32x2*)(U + fr * HY_LDU + 256 * w + 16 * tt + 4 * fq) = zpk[tt];
                hy_store_kc(KC, kr, tid);
                __syncthreads();
            } else {
                int ly = lane; asm volatile("" : "+v"(ly));
                bf16* yrow = YT + (size_t)c * MTOK + (size_t)(ly & 15) * SEQ + 256 * w + 4 * (ly >> 4);
#pragma unroll
                for (int tt = 0; tt < 16; ++tt) *(u32x2*)(yrow + 16 * tt) = zpk[tt];
            }
        }
    }
}

__device__ __forceinline__ void ssd_conv_phase(Frame& F) {
    bf16* XBC = (bf16*)(F.ws + WS_XBC); const bf16* HALO = (const bf16*)(F.ws + WS_HALO);
    const float* scw = F.in[I_SCW]; const float* scb = F.in[I_SCB];
    const int gw = F.vcu * NWAVES + F.wave, NGW = F.G * NWAVES, lane = F.lane;
    for (int item = gw; item < BATCH * 32 * 8; item += NGW) {
        const int cb8 = item & 7, seg = (item >> 3) & 31, b = item >> 8, col = cb8 * 512 + lane * 8;
        float wk[5][8], cbv[8];
#pragma unroll
        for (int k = 0; k < 5; ++k) { const f32x4 a = *(const f32x4*)(scw + k * CONVD + col), c = *(const f32x4*)(scw + k * CONVD + col + 4);
#pragma unroll
            for (int e = 0; e < 4; ++e) { wk[k][e] = a[e]; wk[k][4 + e] = c[e]; } }
        { const f32x4 a = *(const f32x4*)(scb + col), c = *(const f32x4*)(scb + col + 4);
#pragma unroll
          for (int e = 0; e < 4; ++e) { cbv[e] = a[e]; cbv[4 + e] = c[e]; } }
        bf16* xrow0 = XBC + ((size_t)b * SEQ + seg * 64) * CONVD + col;
        const bf16* hlo = HALO + ((size_t)(b * 33 + seg) * 4) * CONVD + col;
        const bf16* hhi = HALO + ((size_t)(b * 33 + seg + 1) * 4 + 2) * CONVD + col;
        const u32x4 zero4 = {0u, 0u, 0u, 0u};
        u32x4 W[12];
        W[0] = seg > 0 ? *(const u32x4*)(hlo) : zero4; W[1] = seg > 0 ? *(const u32x4*)(hlo + CONVD) : zero4;
        W[2] = *(const u32x4*)(xrow0); W[3] = *(const u32x4*)(xrow0 + CONVD);
#pragma unroll 1
        for (int blk = 0; blk < 8; ++blk) { const int r0 = 8 * blk;
#pragma unroll
            for (int i = 4; i < 12; ++i) { const int rr = r0 - 2 + i;
                if (rr < 64) W[i] = *(const u32x4*)(xrow0 + (size_t)rr * CONVD);
                else W[i] = (seg < 31) ? *(const u32x4*)(hhi + (size_t)(rr - 64) * CONVD) : zero4; }
#pragma unroll
            for (int o = 0; o < 8; ++o) { float v[8];
#pragma unroll
                for (int e = 0; e < 8; ++e) v[e] = cbv[e];
#pragma unroll
                for (int k = 0; k < 5; ++k) { const u32x4 p = W[o + k];
                    v[0] += wk[k][0] * bflo(p.x); v[1] += wk[k][1] * bfhi(p.x); v[2] += wk[k][2] * bflo(p.y); v[3] += wk[k][3] * bfhi(p.y);
                    v[4] += wk[k][4] * bflo(p.z); v[5] += wk[k][5] * bfhi(p.z); v[6] += wk[k][6] * bflo(p.w); v[7] += wk[k][7] * bfhi(p.w); }
#pragma unroll
                for (int e = 0; e < 8; ++e) v[e] = siluf_(v[e]);
                u32x4 ov; ov.x = pk2(v[0], v[1]); ov.y = pk2(v[2], v[3]); ov.z = pk2(v[4], v[5]); ov.w = pk2(v[6], v[7]);
                *(u32x4*)(xrow0 + (size_t)(r0 + o) * CONVD) = ov; }
#pragma unroll
            for (int i = 0; i < 4; ++i) W[i] = W[8 + i];
        }
    }
}

constexpr int SS_LDC = 144, SS_LDM = 136;
constexpr int SS_C = 0, SS_B = 18432, SS_X = 36864, SS_XE = 55296, SS_M = 73728, SS_SB = 108544, SS_ACS = 145408, SS_DTV = 146432, SS_TOE = 147456, SS_END = 148480;
static_assert(SS_END <= MISC_OFF, "SSD LDS map");
typedef short s16x4 __attribute__((ext_vector_type(4)));
__device__ __forceinline__ bf16x8 ssd_trfrag(const LAS bf16* p) {
    const s16x4 a = __builtin_amdgcn_ds_read_tr16_b64_v4i16((LAS s16x4*)p), b = __builtin_amdgcn_ds_read_tr16_b64_v4i16((LAS s16x4*)(p + 16 * SS_LDC));
    return __builtin_shufflevector(a, b, 0, 1, 2, 3, 4, 5, 6, 7);
}

__device__ __forceinline__ void ssd_phase(Frame& F) {
    LAS unsigned char* L = F.lds;
    LAS bf16* Cl = (LAS bf16*)(L + SS_C); LAS bf16* Bl = (LAS bf16*)(L + SS_B); LAS bf16* Xr = (LAS bf16*)(L + SS_X); LAS bf16* XEr = (LAS bf16*)(L + SS_XE);
    LAS bf16* Ml = (LAS bf16*)(L + SS_M); LAS bf16* SB = (LAS bf16*)(L + SS_SB);
    LAS float* ACS = (LAS float*)(L + SS_ACS); LAS float* DTV = (LAS float*)(L + SS_DTV); LAS float* TOE = (LAS float*)(L + SS_TOE);
    const bf16* XBC = (const bf16*)(F.ws + WS_XBC); const float* DT = (const float*)(F.ws + WS_DT); const unsigned char* Z8 = (const unsigned char*)F.out; bf16* YS = (bf16*)(F.ws + WS_YSSD);
    const float* dtb = F.in[I_DTB]; const float* alog = F.in[I_ALOG]; const float* sd = F.in[I_SD];
    const int tid = F.tid, lane = F.lane, w = F.wave, fr = lane & 15, fq = lane >> 4;
    for (int unit = F.vcu; unit < BATCH * NGRP * 2; unit += F.G) {
        const int b = unit >> 4, g = (unit >> 1) & 7, hp = unit & 1, h0 = 4 * g + 2 * hp;
#pragma unroll 1
        for (int dir = 0; dir < 2; ++dir) {
            const float dtbias = (w < 2) ? dtb[dir * 32 + h0 + w] : 0.f, aexp = (w < 2) ? __expf(alog[dir * 32 + h0 + w]) : 0.f;
            auto scan = [&](int buf, float raw) {
                raw += dtbias; const float dtv = raw > 20.f ? raw : log1pf(__expf(raw)); float a = -dtv * aexp;
#pragma unroll
                for (int o = 1; o < 64; o <<= 1) { const float v = __shfl_up(a, o); if (lane >= o) a += v; }
                const float tot = __shfl(a, 63); const int ix = (buf * 2 + w) * 64 + lane;
                ACS[ix] = a; DTV[ix] = dtv; TOE[ix] = __expf(tot - a); };
            auto dtload = [&](int ci) -> float { const int ch = dir ? 31 - ci : ci, r = dir ? 63 - lane : lane;
                return DT[((size_t)b * SEQ + 64 * ch + r) * 64 + dir * 32 + h0 + w]; };
            auto rowload = [&](int ci, int it, int tl) -> u32x4 {
                const int l = (tl >> 4) + 32 * (it & 1), j = tl & 15, ch = dir ? 31 - ci : ci, r = dir ? 63 - l : l;
                const int col = (it < 2 ? 64 * h0 : (it < 4 ? 2048 + 128 * g : 3072 + 128 * g)) + 8 * j;
                return *(const u32x4*)(XBC + ((size_t)b * SEQ + 64 * ch + r) * CONVD + col); };
            f32x4 Sacc[8];
#pragma unroll
            for (int i = 0; i < 8; ++i) Sacc[i] = (f32x4){0.f, 0.f, 0.f, 0.f};
            const float dsk = sd[h0 + (w >> 2)];
            __syncthreads();
            for (int i = tid; i < 2 * 64 * SS_LDC / 2; i += NTHR) ((LAS unsigned*)SB)[i] = 0u;
            float dtn = 0.f;
            if (w < 2) { scan(0, dtload(0)); dtn = dtload(1); }
            u32x4 pf[6];
#pragma unroll
            for (int it = 0; it < 6; ++it) pf[it] = rowload(0, it, tid);
            __syncthreads();
#pragma unroll 1
            for (int ci = 0; ci < 32; ++ci) {
                const int ch = dir ? 31 - ci : ci, buf = ci & 1;
                const size_t tokbase = (size_t)b * SEQ + 64 * ch;
                int tl = tid; asm volatile("" : "+v"(tl));
                int frl = fr, fql = fq; asm volatile("" : "+v"(frl), "+v"(fql));
                const LAS float* acs = ACS + buf * 128; const LAS float* dtv = DTV + buf * 128; const LAS float* toe = TOE + buf * 128;
#pragma unroll
                for (int it = 0; it < 6; ++it) { const int l = (tl >> 4) + 32 * (it & 1), j = tl & 15; const u32x4 p = pf[it];
                    if (it < 2) { const int hh = j >> 3; const float de = dtv[hh * 64 + l] * toe[hh * 64 + l];
                        *(LAS u32x4*)(Xr + l * SS_LDC + j * 8) = p;
                        u32x4 q; q.x = pk2(bflo(p.x) * de, bfhi(p.x) * de); q.y = pk2(bflo(p.y) * de, bfhi(p.y) * de); q.z = pk2(bflo(p.z) * de, bfhi(p.z) * de); q.w = pk2(bflo(p.w) * de, bfhi(p.w) * de);
                        *(LAS u32x4*)(XEr + l * SS_LDC + j * 8) = q; }
                    else if (it < 4) { *(LAS u32x4*)(Bl + l * SS_LDC + j * 8) = p; }
                    else { *(LAS u32x4*)(Cl + l * SS_LDC + j * 8) = p; } }
                if (ci + 1 < 32) {
#pragma unroll
                    for (int it = 0; it < 6; ++it) pf[it] = rowload(ci + 1, it, tl); }
                __syncthreads();
                const int hh = w >> 2, li = w & 3, lrow = 16 * li + frl;
                const int rloc = dir ? 63 - lrow : lrow; const size_t tok = tokbase + rloc;
                u32x4 pv[2]; u32x2 zv[2];
                if (dir) {
#pragma unroll
                    for (int t = 0; t < 2; ++t) { const size_t o = tok * DSSM + 64 * (h0 + hh) + 32 * t + 8 * fql; pv[t] = *(const u32x4*)(YS + o); zv[t] = *(const u32x2*)(Z8 + o); } }
#define SSD_FENCE() asm volatile("s_waitcnt lgkmcnt(0)" ::: "memory")
#define SSD_TIE8(a) asm volatile("s_waitcnt lgkmcnt(0)" : "+v"(a[0][0]), "+v"(a[0][1]), "+v"(a[1][0]), "+v"(a[1][1]), "+v"(a[2][0]), "+v"(a[2][1]), "+v"(a[3][0]), "+v"(a[3][1]) :: "memory")
#define SSD_TIE8K(a) asm volatile("s_waitcnt lgkmcnt(0)" : "+v"(a[0][0]), "+v"(a[0][1]), "+v"(a[0][2]), "+v"(a[0][3]), "+v"(a[1][0]), "+v"(a[1][1]), "+v"(a[1][2]), "+v"(a[1][3]) :: "memory")
                f32x4 Y[4];
                { bf16x8 cfr[4];
#pragma unroll
                  for (int kk = 0; kk < 4; ++kk) cfr[kk] = *(const LAS bf16x8*)(Cl + lrow * SS_LDC + 8 * fql + 32 * kk);
#pragma unroll
                  for (int ph = 0; ph < 2; ++ph) { bf16x8 sfr[2][4];
#pragma unroll
                      for (int pp = 0; pp < 2; ++pp)
#pragma unroll
                          for (int kk = 0; kk < 4; ++kk) sfr[pp][kk] = *(const LAS bf16x8*)(SB + (hh * 64 + 32 * ph + 8 * (frl >> 2) + 4 * pp + (frl & 3)) * SS_LDC + 8 * fql + 32 * kk);
                      SSD_TIE8K(sfr);
#pragma unroll
                      for (int pp = 0; pp < 2; ++pp) { Y[2 * ph + pp] = (f32x4){0.f, 0.f, 0.f, 0.f};
#pragma unroll
                          for (int kk = 0; kk < 4; ++kk) Y[2 * ph + pp] = __builtin_amdgcn_mfma_f32_16x16x32_bf16(sfr[pp][kk], cfr[kk], Y[2 * ph + pp], 0, 0, 0); }
                      __builtin_amdgcn_sched_barrier(0); } }
                { bf16x8 cbA[2][4], cbB[2][4]; f32x4 tas[2], tdd[2]; float tal[2];
#pragma unroll
                  for (int q = 0; q < 2; ++q) { const int id = 2 * w + q, si = id >> 2, lj = id & 3;
                      if (si <= lj) {
#pragma unroll
                          for (int kk = 0; kk < 4; ++kk) { cbA[q][kk] = *(const LAS bf16x8*)(Bl + (16 * si + frl) * SS_LDC + 8 * fql + 32 * kk); cbB[q][kk] = *(const LAS bf16x8*)(Cl + (16 * lj + frl) * SS_LDC + 8 * fql + 32 * kk); } } }
                  auto tab_load = [&](int q) { const int id = 2 * w + q, si = id >> 2, lj = id & 3, l = 16 * lj + frl, s0 = 16 * si + 4 * fql;
#pragma unroll
                      for (int h = 0; h < 2; ++h) { tas[h] = *(const LAS f32x4*)(acs + 64 * h + s0); tdd[h] = *(const LAS f32x4*)(dtv + 64 * h + s0); tal[h] = acs[64 * h + l]; } };
                  tab_load(0);
                  SSD_FENCE();
#pragma unroll
                  for (int q = 0; q < 2; ++q) { const int id = 2 * w + q, si = id >> 2, lj = id & 3, l = 16 * lj + frl, s0 = 16 * si + 4 * fql;
                      u32x2 m0 = {0u, 0u}, m1 = {0u, 0u};
                      if (si <= lj) { f32x4 cb = (f32x4){0.f, 0.f, 0.f, 0.f};
#pragma unroll
                          for (int kk = 0; kk < 4; ++kk) cb = __builtin_amdgcn_mfma_f32_16x16x32_bf16(cbA[q][kk], cbB[q][kk], cb, 0, 0, 0);
                          float x0[4], x1[4];
#pragma unroll
                          for (int j = 0; j < 4; ++j) { const bool keep = (s0 + j <= l);
                              const float e0 = __expf(fminf(tal[0] - tas[0][j], 0.f)) * tdd[0][j], e1 = __expf(fminf(tal[1] - tas[1][j], 0.f)) * tdd[1][j];
                              const float c = keep ? cb[j] : 0.f; x0[j] = c * e0; x1[j] = c * e1; }
                          m0.x = pk2(x0[0], x0[1]); m0.y = pk2(x0[2], x0[3]); m1.x = pk2(x1[0], x1[1]); m1.y = pk2(x1[2], x1[3]); }
                      if (q == 0) tab_load(1);
                      *(LAS u32x2*)(Ml + (0 * 64 + l) * SS_LDM + s0) = m0; *(LAS u32x2*)(Ml + (1 * 64 + l) * SS_LDM + s0) = m1; } }
                __syncthreads();
                const int trb = (4 * fql + (frl >> 2)) * SS_LDC + 4 * (frl & 3);
                const int trbx = (4 * fql + (frl >> 2)) * SS_LDC + 8 * (frl & 3);
                { bf16x8 mf[2], xdf[4][2];
#pragma unroll
                  for (int kk = 0; kk < 2; ++kk) { const LAS bf16* mp = Ml + (hh * 64 + lrow) * SS_LDM + 32 * kk + 4 * fql;
                      const s16x4 a = *(const LAS s16x4*)mp, b2 = *(const LAS s16x4*)(mp + 16); mf[kk] = __builtin_shufflevector(a, b2, 0, 1, 2, 3, 4, 5, 6, 7); }
#pragma unroll
                  for (int pi = 0; pi < 4; ++pi)
#pragma unroll
                      for (int kk = 0; kk < 2; ++kk) xdf[pi][kk] = ssd_trfrag(Xr + trbx + 32 * kk * SS_LDC + hh * 64 + 32 * (pi >> 1) + 4 * (pi & 1));
                  const float el = __expf(acs[hh * 64 + lrow]);
                  SSD_TIE8(xdf);
#pragma unroll
                  for (int pi = 0; pi < 4; ++pi) { Y[pi] = Y[pi] * el;
                      Y[pi] = __builtin_amdgcn_mfma_f32_16x16x32_bf16(xdf[pi][0], mf[0], Y[pi], 0, 0, 0);
                      Y[pi] = __builtin_amdgcn_mfma_f32_16x16x32_bf16(xdf[pi][1], mf[1], Y[pi], 0, 0, 0); }
                  __builtin_amdgcn_sched_barrier(0);
#pragma unroll
                  for (int t = 0; t < 2; ++t) { const int p0 = 32 * t + 8 * fql; bf16* yp = YS + tok * DSSM + 64 * (h0 + hh) + p0; f32x4 y0 = Y[2 * t], y1 = Y[2 * t + 1];
                      if (dir == 0) { const u32x4 xv = *(const LAS u32x4*)(Xr + lrow * SS_LDC + hh * 64 + p0);
                          y0[0] += dsk * bflo(xv.x); y0[1] += dsk * bfhi(xv.x); y0[2] += dsk * bflo(xv.y); y0[3] += dsk * bfhi(xv.y);
                          y1[0] += dsk * bflo(xv.z); y1[1] += dsk * bfhi(xv.z); y1[2] += dsk * bflo(xv.w); y1[3] += dsk * bfhi(xv.w);
                      } else { const u32x4 pvv = pv[t];
                          const f32x2 z01 = __builtin_amdgcn_cvt_pk_f32_fp8((int)zv[t].x, false), z23 = __builtin_amdgcn_cvt_pk_f32_fp8((int)zv[t].x, true);
                          const f32x2 z45 = __builtin_amdgcn_cvt_pk_f32_fp8((int)zv[t].y, false), z67 = __builtin_amdgcn_cvt_pk_f32_fp8((int)zv[t].y, true);
                          y0[0] = (y0[0] + bflo(pvv.x)) * siluf_(z01.x); y0[1] = (y0[1] + bfhi(pvv.x)) * siluf_(z01.y); y0[2] = (y0[2] + bflo(pvv.y)) * siluf_(z23.x); y0[3] = (y0[3] + bfhi(pvv.y)) * siluf_(z23.y);
                          y1[0] = (y1[0] + bflo(pvv.z)) * siluf_(z45.x); y1[1] = (y1[1] + bfhi(pvv.z)) * siluf_(z45.y); y1[2] = (y1[2] + bflo(pvv.w)) * siluf_(z67.x); y1[3] = (y1[3] + bfhi(pvv.w)) * siluf_(z67.y); }
                      u32x4 o; o.x = pk2(y0[0], y0[1]); o.y = pk2(y0[2], y0[3]); o.z = pk2(y1[0], y1[1]); o.w = pk2(y1[2], y1[3]); *(u32x4*)yp = o; }
                  __builtin_amdgcn_sched_barrier(0); }
                { const int pi5 = w & 3; const float dec = __expf(acs[hh * 64 + 63]);
                  bf16x8 xef[2];
#pragma unroll
                  for (int kk = 0; kk < 2; ++kk) xef[kk] = ssd_trfrag(XEr + trb + 32 * kk * SS_LDC + hh * 64 + 16 * pi5);
#pragma unroll
                  for (int nh = 0; nh < 2; ++nh) { bf16x8 btf[4][2];
#pragma unroll
                      for (int nn = 0; nn < 4; ++nn)
#pragma unroll
                          for (int kk = 0; kk < 2; ++kk) btf[nn][kk] = ssd_trfrag(Bl + trb + 32 * kk * SS_LDC + 16 * (4 * nh + nn));
                      SSD_TIE8(btf);
#pragma unroll
                      for (int nn = 0; nn < 4; ++nn) { const int ni = 4 * nh + nn; Sacc[ni] = Sacc[ni] * dec;
                          Sacc[ni] = __builtin_amdgcn_mfma_f32_16x16x32_bf16(btf[nn][0], xef[0], Sacc[ni], 0, 0, 0);
                          Sacc[ni] = __builtin_amdgcn_mfma_f32_16x16x32_bf16(btf[nn][1], xef[1], Sacc[ni], 0, 0, 0); }
                      __builtin_amdgcn_sched_barrier(0); }
#pragma unroll
                  for (int ni = 0; ni < 8; ++ni) { u32x2 o; o.x = pk2(Sacc[ni][0], Sacc[ni][1]); o.y = pk2(Sacc[ni][2], Sacc[ni][3]);
                      *(LAS u32x2*)(SB + (hh * 64 + 16 * pi5 + frl) * SS_LDC + 16 * ni + 4 * fql) = o; } }
                if (w < 2 && ci + 1 < 32) { scan(buf ^ 1, dtn); if (ci + 2 < 32) dtn = dtload(ci + 2); }
                __syncthreads();
            }
        }
    }
}

__device__ __forceinline__ void ssd_norm_phase(Frame& F) {
    bf16* YS = (bf16*)(F.ws + WS_YSSD); const float* nw = F.in[I_SNW];
    const int gw = F.vcu * NWAVES + F.wave, NGW = F.G * NWAVES, lane = F.lane;
    f32x4 wv[8];
#pragma unroll
    for (int j = 0; j < 4; ++j) { wv[2 * j] = *(const f32x4*)(nw + 512 * j + 8 * lane); wv[2 * j + 1] = *(const f32x4*)(nw + 512 * j + 8 * lane + 4); }
    for (int m = gw; m < MTOK; m += 2 * NGW) {
        u32x4 v[2][4];
#pragma unroll
        for (int u = 0; u < 2; ++u)
#pragma unroll
            for (int j = 0; j < 4; ++j) v[u][j] = *(const u32x4*)(YS + (size_t)((m + u * NGW < MTOK) ? m + u * NGW : m) * DSSM + 512 * j + 8 * lane);
#pragma unroll
        for (int u = 0; u < 2; ++u) { if (m + u * NGW >= MTOK) break; bf16* row = YS + (size_t)(m + u * NGW) * DSSM + 8 * lane;
#pragma unroll
            for (int j = 0; j < 4; ++j) { const u32x4 q = v[u][j];
                const float a0 = bflo(q.x), a1 = bfhi(q.x), a2 = bflo(q.y), a3 = bfhi(q.y), a4 = bflo(q.z), a5 = bfhi(q.z), a6 = bflo(q.w), a7 = bfhi(q.w);
                float ss = (a0 * a0 + a1 * a1) + (a2 * a2 + a3 * a3) + (a4 * a4 + a5 * a5) + (a6 * a6 + a7 * a7);
                ss += __shfl_xor(ss, 1); ss += __shfl_xor(ss, 2); ss += __shfl_xor(ss, 4); ss += __shfl_xor(ss, 8); ss += __shfl_xor(ss, 16);
                const float rs = 1.0f / sqrtf(ss * (1.0f / 256.0f) + RMS_EPS); const f32x4 w0 = wv[2 * j], w1 = wv[2 * j + 1];
                u32x4 o; o.x = pk2(a0 * rs * w0[0], a1 * rs * w0[1]); o.y = pk2(a2 * rs * w0[2], a3 * rs * w0[3]);
                o.z = pk2(a4 * rs * w1[0], a5 * rs * w1[1]); o.w = pk2(a6 * rs * w1[2], a7 * rs * w1[3]);
                *(u32x4*)(row + 512 * j) = o; } } }
}

constexpr int RT_WC = 131072;
__device__ __forceinline__ void ln1_router_phase(Frame& F) {
    const bf16* H1P = (const bf16*)(F.ws + WS_H1P); bf16* H1B = (bf16*)F.out;
    int* TOK = (int*)(F.ws + WS_TOK); float* WGT = (float*)(F.ws + WS_WGT); int* ASG = (int*)(F.ws + WS_ASG);
    const float* g1 = F.in[I_LN1G]; const float* b1 = F.in[I_LN1B]; const float* rw = F.in[I_RW]; const float* rb = F.in[I_RB];
    LAS float* hrow = (LAS float*)(F.lds + F.wave * 16384);
    LAS float* wc = (LAS float*)(F.lds + RT_WC);
    LAS unsigned* cl = (LAS unsigned*)(F.lds + RT_WC + 16384);
    if (F.tid < 64) cl[F.tid] = 0u;
    __syncthreads();
    const int lane = F.lane, tid = F.tid;
    f32x4 gv[4], bv[4];
#pragma unroll
    for (int j = 0; j < 4; ++j) { gv[j] = *(const f32x4*)(g1 + 4 * lane + 256 * j); bv[j] = *(const f32x4*)(b1 + 4 * lane + 256 * j); }
    const float rbias = rb[lane];
    for (int step = F.vcu; step < MTOK / 32; step += F.G) {
        const int rg = step * 8 + F.wave;
        f32x4 nx0 = *(const f32x4*)(rw + tid * 4), nx1 = *(const f32x4*)(rw + 2048 + tid * 4);
#pragma unroll 1
        for (int r = 0; r < 4; ++r) { const size_t m = (size_t)rg * 4 + r; const bf16* xr = H1P + m * DM;
            f32x4 v[4]; float s = 0.f;
#pragma unroll
            for (int j = 0; j < 4; ++j) { const u32x2 q = *(const u32x2*)(xr + 4 * lane + 256 * j); v[j][0] = bflo(q.x); v[j][1] = bfhi(q.x); v[j][2] = bflo(q.y); v[j][3] = bfhi(q.y); s += (v[j][0] + v[j][1]) + (v[j][2] + v[j][3]); }
            const float mean = wave_sum(s) * (1.f / DM); float s2 = 0.f;
#pragma unroll
            for (int j = 0; j < 4; ++j) { v[j] = v[j] - mean; s2 += (v[j][0] * v[j][0] + v[j][1] * v[j][1]) + (v[j][2] * v[j][2] + v[j][3] * v[j][3]); }
            const float rstd = 1.f / sqrtf(wave_sum(s2) * (1.f / DM) + LN_EPS);
#pragma unroll
            for (int j = 0; j < 4; ++j) { const f32x4 h = v[j] * rstd * gv[j] + bv[j];
                u32x2 o; o.x = pk2(h[0], h[1]); o.y = pk2(h[2], h[3]); *(u32x2*)(H1B + m * H1B_PITCH + 4 * lane + 256 * j) = o;
                *(LAS f32x4*)(hrow + r * 1024 + 4 * lane + 256 * j) = h; } }
        float lg[4] = {0.f, 0.f, 0.f, 0.f};
#pragma unroll 1
        for (int kc = 0; kc < 16; ++kc) {
            __syncthreads();
            *(LAS f32x4*)(wc + tid * 4) = nx0; *(LAS f32x4*)(wc + 2048 + tid * 4) = nx1;
            if (kc + 1 < 16) { nx0 = *(const f32x4*)(rw + (kc + 1) * 4096 + tid * 4); nx1 = *(const f32x4*)(rw + (kc + 1) * 4096 + 2048 + tid * 4); }
            __syncthreads();
#pragma unroll 4
            for (int kk = 0; kk < 64; kk += 4) {
                const float w0 = wc[(kk + 0) * 64 + lane], w1 = wc[(kk + 1) * 64 + lane], w2 = wc[(kk + 2) * 64 + lane], w3 = wc[(kk + 3) * 64 + lane];
#pragma unroll
                for (int r = 0; r < 4; ++r) { const f32x4 h = *(const LAS f32x4*)(hrow + r * 1024 + kc * 64 + kk); lg[r] += h[0] * w0 + h[1] * w1 + h[2] * w2 + h[3] * w3; } }
        }
        bool selr[4]; float wgr[4]; int rkr[4];
#pragma unroll
        for (int r = 0; r < 4; ++r) {
            const float score = 1.0f / (1.0f + expf(-lg[r])), biased = score + rbias;
            float m1 = biased; m1 = fmaxf(m1, __shfl_xor(m1, 1)); m1 = fmaxf(m1, __shfl_xor(m1, 2)); m1 = fmaxf(m1, __shfl_xor(m1, 4));
            const unsigned long long eq = __ballot(biased == m1); const int gbase = lane & ~7; const int first = gbase + __ffs((unsigned)((eq >> gbase) & 0xffull)) - 1;
            float v2 = (lane == first) ? -INFINITY : biased; v2 = fmaxf(v2, __shfl_xor(v2, 1)); v2 = fmaxf(v2, __shfl_xor(v2, 2)); v2 = fmaxf(v2, __shfl_xor(v2, 4));
            const float gs = m1 + v2; const int g = lane >> 3; int better = 0;
#pragma unroll
            for (int d = 1; d < 8; ++d) { const int g2 = (g + d) & 7; const float og = __shfl(gs, g2 * 8); better += (og > gs || (og == gs && g2 < g)) ? 1 : 0; }
            float masked = (better < 4) ? biased : -INFINITY; bool sel = false;
#pragma unroll 1
            for (int it = 0; it < TOPK; ++it) { const float mx = wave_max(masked); const unsigned long long bm = __ballot(masked == mx); const int win = __ffsll((long long)bm) - 1;
                if (lane == win) { sel = true; masked = -INFINITY; } }
            const float sw = wave_sum(sel ? score : 0.f);
            const unsigned long long selm = __ballot(sel);
            selr[r] = sel; wgr[r] = score / sw * ROUTED_SCALE; rkr[r] = __popcll(selm & ((1ull << lane) - 1ull)); }
        unsigned lp[4];
#pragma unroll
        for (int r = 0; r < 4; ++r) lp[r] = selr[r] ? atomicAdd((unsigned*)(cl + lane), 1u) : 0u;
        __syncthreads();
        if (F.wave == 0) { const unsigned n = cl[lane]; unsigned bs = 0u;
            if (n) bs = __hip_atomic_fetch_add((unsigned*)(F.ctl + CW_CNT + 64 * lane), n, __ATOMIC_RELAXED, __HIP_MEMORY_SCOPE_AGENT);
            cl[64 + lane] = bs; cl[lane] = 0u; }
        __syncthreads();
        const unsigned bse = cl[64 + lane];
#pragma unroll
        for (int r = 0; r < 4; ++r) if (selr[r]) { const int m = rg * 4 + r; const unsigned pos = bse + lp[r];
            TOK[(size_t)lane * MTOK + pos] = m; WGT[(size_t)lane * MTOK + pos] = wgr[r]; ASG[(size_t)m * 8 + rkr[r]] = lane * MTOK + (int)pos; }
    }
}
constexpr int MOE_TP = 131072 + 1024, MOE_CNT = MOE_TP + 512, MOE_TE = 131072 + 4096;
__device__ __forceinline__ int moe_table(Frame& F) {
    LAS int* tp = (LAS int*)(F.lds + MOE_TP); LAS int* cnt = (LAS int*)(F.lds + MOE_CNT);
    __syncthreads();
    if (F.tid == 0) { int run = 0;
        for (int e = 0; e < NEX; ++e) { const int c = (e < NE) ? (int)__hip_atomic_load((unsigned*)(F.ctl + CW_CNT + 64 * e), __ATOMIC_RELAXED, __HIP_MEMORY_SCOPE_AGENT) : MTOK;
            cnt[e] = c; tp[e] = run; run += (c + 255) >> 8; }
        tp[NEX] = run; }
    __syncthreads();
    { LAS int* te = (LAS int*)(F.lds + MOE_TE); const int total = tp[NEX];
      for (int t = F.tid; t < total; t += NTHR) { int e = 0;
#pragma unroll 1
          for (int s = 64; s >= 1; s >>= 1) if (e + s <= NE && tp[e + s] <= t) e += s;
          te[t] = e; } }
    __syncthreads();
    return tp[NEX];
}
__device__ __forceinline__ void fp8x4_fma(f32x4& a, const unsigned v, const float w) {
    const f32x2 p0 = __builtin_amdgcn_cvt_pk_f32_fp8((int)v, false), p1 = __builtin_amdgcn_cvt_pk_f32_fp8((int)v, true);
    a[0] += w * p0.x; a[1] += w * p0.y; a[2] += w * p1.x; a[3] += w * p1.y;
}
__device__ __forceinline__ void moe_combine_phase(Frame& F) {
    const bf16* H1B = (const bf16*)F.out; const unsigned char* YQ = (const unsigned char*)(F.ws + WS_YQ); const int* ASG = (const int*)(F.ws + WS_ASG); const float* WGT = (const float*)(F.ws + WS_WGT);
    const LAS int* tp = (const LAS int*)(F.lds + MOE_TP);
    const float* g2 = F.in[I_LN2G]; const float* b2 = F.in[I_LN2B];
    const int gw = F.vcu * NWAVES + F.wave, NGW = F.G * NWAVES, lane = F.lane;
    const size_t shbase = (size_t)tp[NE] * 256;
    f32x4 gv[4], bv[4];
#pragma unroll
    for (int j = 0; j < 4; ++j) { gv[j] = *(const f32x4*)(g2 + 4 * lane + 256 * j); bv[j] = *(const f32x4*)(b2 + 4 * lane + 256 * j); }
    const int l8 = lane & 7;
    int li = ASG[(size_t)gw * 8 + l8];
    float wk = WGT[li];
    int li_n = (gw + NGW < MTOK) ? ASG[(size_t)(gw + NGW) * 8 + l8] : 0;
    for (int m = gw; m < MTOK; m += NGW) {
        const int e = li >> 15, pos = li & 32767; const int slot = 256 * tp[e] + pos; const float wcur = wk;
        unsigned vv[9][4]; f32x4 v[4];
        { const unsigned char* sp = YQ + (shbase + m) * 1024 + 4 * lane;
#pragma unroll
          for (int j = 0; j < 4; ++j) vv[8][j] = *(const unsigned*)(sp + 256 * j); }
#pragma unroll
        for (int k = 0; k < 8; ++k) { const int sk = __shfl(slot, k); const unsigned char* sp = YQ + (size_t)sk * 1024 + 4 * lane;
#pragma unroll
            for (int j = 0; j < 4; ++j) vv[k][j] = *(const unsigned*)(sp + 256 * j); }
        float* xr = F.out + (size_t)m * DM + 4 * lane; const bf16* hr = H1B + (size_t)m * H1B_PITCH + 4 * lane; u32x2 hq[4];
#pragma unroll
        for (int j = 0; j < 4; ++j) hq[j] = *(const u32x2*)(hr + 256 * j);
        li = li_n; wk = WGT[li];
        li_n = (m + 2 * NGW < MTOK) ? ASG[(size_t)(m + 2 * NGW) * 8 + l8] : 0;
#pragma unroll
        for (int j = 0; j < 4; ++j) { v[j][0] = DN_ALPHA * bflo(hq[j].x); v[j][1] = DN_ALPHA * bfhi(hq[j].x); v[j][2] = DN_ALPHA * bflo(hq[j].y); v[j][3] = DN_ALPHA * bfhi(hq[j].y); fp8x4_fma(v[j], vv[8][j], 1.0f); }
#pragma unroll
        for (int k = 0; k < 8; ++k) { const float w = __shfl(wcur, k);
#pragma unroll
            for (int j = 0; j < 4; ++j) fp8x4_fma(v[j], vv[k][j], w); }
        float s = 0.f;
#pragma unroll
        for (int j = 0; j < 4; ++j) s += (v[j][0] + v[j][1]) + (v[j][2] + v[j][3]);
        const float mean = wave_sum(s) * (1.f / DM); float s2 = 0.f;
#pragma unroll
        for (int j = 0; j < 4; ++j) { v[j] = v[j] - mean; s2 += (v[j][0] * v[j][0] + v[j][1] * v[j][1]) + (v[j][2] * v[j][2] + v[j][3] * v[j][3]); }
        const float rstd = 1.f / sqrtf(wave_sum(s2) * (1.f / DM) + LN_EPS);
#pragma unroll
        for (int j = 0; j < 4; ++j) *(f32x4*)(xr + 256 * j) = v[j] * rstd * gv[j] + bv[j];
    }
}

#ifndef MK_N_LAUNCHES
#define MK_N_LAUNCHES 1
#endif
constexpr int NPH = 15;
constexpr int N_LAUNCHES = MK_N_LAUNCHES;

__global__ void __launch_bounds__(NTHR, 2) fwd_kernel(Args args) {
    extern __shared__ __attribute__((aligned(16))) unsigned char lds_raw[];
    Frame F;
    F.lds = (LAS unsigned char*)lds_raw;
    F.MISC = (volatile LAS unsigned*)(F.lds + MISC_OFF);
    F.tid = threadIdx.x; F.lane = F.tid & 63; F.wave = __builtin_amdgcn_readfirstlane(F.tid >> 6);
    F.G = gridDim.x; { const int bx = blockIdx.x; F.vcu = (F.G % 8 == 0) ? (bx % 8) * (F.G / 8) + bx / 8 : bx; }
    F.ws = args.ws; F.ctl = (gu32*)(args.ws + WS_CTL); F.in = args.in; F.out = args.out;
    for (int u = F.tid; u < (LDS_BYTES - MISC_OFF) / 4; u += NTHR) ((LAS unsigned*)(F.lds + MISC_OFF))[u] = 0u;
    __syncthreads();
    XcdBarrier bar; bar.bar = (unsigned*)(F.ctl + CW_BAR); bar.x = 0; bar.st = nullptr;
    if (N_LAUNCHES != NPH) bar = xcd_barrier_post((unsigned*)(F.ctl + CW_BAR), F.MISC + 8);
    const int lo = args.ph_lo, hi = args.ph_hi;
#ifndef PH_MASK
#define PH_MASK 0x7fff
#endif
#define IN(k) ((((PH_MASK) >> (k)) & 1) && lo <= (k) && (k) < hi)
#ifdef STRESS_US
#define SKEW() do { if ((blockIdx.x * 2654435761u >> 28) & 1) { const unsigned long long t0_ = __builtin_amdgcn_s_memrealtime(); while (__builtin_amdgcn_s_memrealtime() - t0_ < (unsigned long long)(STRESS_US) * 100ull) __builtin_amdgcn_s_sleep(8); } __syncthreads(); } while (0)
#else
#define SKEW() do { } while (0)
#endif
#define SEAM(k) do { if (IN(k) && IN((k) + 1)) { xcd_barrier(bar); SKEW(); } } while (0)
#ifndef REP_MASK
#define REP_MASK 0
#endif
#define REPS(k) for (int rep_ = 0; rep_ < ((((REP_MASK) >> (k)) & 1) ? 2 : 1); ++rep_, ((((REP_MASK) >> (k)) & 1) && rep_ == 1 ? xcd_barrier(bar) : (void)0))
    const int G = F.G, bx = (int)blockIdx.x;

#ifdef START_BARS
    for (int xb_ = 0; xb_ < START_BARS; ++xb_) xcd_barrier(bar);
#endif
    if (IN(0)) REPS(0) { p0_prologue(F); } SEAM(0);
    if (IN(1)) REPS(1) {
        pg8::StaticOrder S; S.init((const bf16*)((unsigned char*)F.out + OUT_XB), (const bf16*)(F.ws + WS_WINT), MTOK, HYC, DM, G, bx);
        pg8::EpiHyT E{(bf16*)(F.ws + WS_PTHY), F.in[I_BIN], F.lds + pg8::STAGE_BYTES};
        pg8::gemm_phase<pg8::EpiHyT, pg8::StaticOrder, false>(F.lds, DM, S, E);
    } SEAM(1);
    if (IN(2)) REPS(2) { hyena_phase(F); } SEAM(2);
    if (IN(3)) REPS(3) { p3_transpose(F); } SEAM(3);
    if (IN(4)) REPS(4) {
        pg8::StaticOrder S; S.init((const bf16*)((unsigned char*)F.out + OUT_XB), (const bf16*)(F.ws + WS_WINT) + (size_t)3072 * DM, MTOK, 6400, DM, G, bx);
        pg8::EpiZXD E{(unsigned char*)F.out, (bf16*)(F.ws + WS_XBC), (float*)(F.ws + WS_DT), F.in[I_BIN], (bf16*)(F.ws + WS_HALO)};
        pg8::gemm_phase<pg8::EpiZXD, pg8::StaticOrder, false>(F.lds, DM, S, E);
    } SEAM(4);
    if (IN(5)) REPS(5) { ssd_conv_phase(F); } SEAM(5);
    if (IN(6)) REPS(6) { ssd_phase(F); } SEAM(6);
    if (IN(7)) REPS(7) { ssd_norm_phase(F); }
    if (IN(8)) REPS(8) {
        pg8::StaticOrder S; S.init((const bf16*)((unsigned char*)F.out + OUT_XB), (const bf16*)(F.ws + WS_WING), MTOK, 2048, DM, G, bx);
        pg8::EpiBf<0> E{(bf16*)(F.ws + WS_G), 2048, F.in[I_BIN] + 9280, nullptr, 0, nullptr};
        pg8::gemm_phase<pg8::EpiBf<0>, pg8::StaticOrder, false>(F.lds, DM, S, E);
    } SEAM(8);
    if (IN(9)) REPS(9) {
        pg8::StaticOrder S; S.init((const bf16*)(F.ws + WS_YHY), (const bf16*)(F.ws + WS_WHYB), MTOK, DM, DM, G, bx);
        pg8::EpiBf<1> E{(bf16*)(F.ws + WS_MIX), DM, nullptr, (const bf16*)(F.ws + WS_G), 2048, nullptr};
        pg8::gemm_phase<pg8::EpiBf<1>, pg8::StaticOrder, false>(F.lds, DM, S, E);
    }
    if (IN(10)) REPS(10) {
        pg8::StaticOrder S; S.init((const bf16*)(F.ws + WS_YSSD), (const bf16*)(F.ws + WS_WSSDB), MTOK, DM, DSSM, G, bx);
        pg8::EpiBf<2> E{(bf16*)(F.ws + WS_MIX), DM, nullptr, (const bf16*)(F.ws + WS_G) + 1024, 2048, (const bf16*)(F.ws + WS_MIX)};
        pg8::gemm_phase<pg8::EpiBf<2>, pg8::StaticOrder, false>(F.lds, DSSM, S, E);
    } SEAM(10);
    if (IN(11)) REPS(11) {
        pg8::StaticOrder S; S.init((const bf16*)(F.ws + WS_MIX), (const bf16*)(F.ws + WS_WOUT), MTOK, DM, DM, G, bx);
        pg8::EpiRes E{(bf16*)(F.ws + WS_H1P), F.in[I_BOUT], (const bf16*)((unsigned char*)F.out + OUT_XB), DN_ALPHA};
        pg8::gemm_phase<pg8::EpiRes, pg8::StaticOrder, false>(F.lds, DM, S, E);
        p10_expert_weights(F);
    } SEAM(11);
    if (IN(12)) REPS(12) { ln1_router_phase(F); } SEAM(12);
    if (IN(13)) REPS(13) {
        const int total = moe_table(F);
        pg8::MoeOrder<2, true> S{(const LAS int*)(F.lds + MOE_TP), (const LAS int*)(F.lds + MOE_CNT), (const LAS int*)(F.lds + MOE_TE), G, bx, total, (const char*)F.out, (const char*)(F.ws + WS_EW1), (const int*)(F.ws + WS_TOK)};
        pg8::EpiSwiGLU E{(bf16*)(F.ws + WS_HID)};
        pg8::gemm_phase<pg8::EpiSwiGLU, pg8::MoeOrder<2, true>, true>(F.lds, DM, S, E);
    } SEAM(13);
    if (IN(14)) {
        const int total = moe_table(F);
        { pg8::SlotOrder4 S{(const LAS int*)(F.lds + MOE_TP), (const LAS int*)(F.lds + MOE_TE), G, bx, total, (const char*)(F.ws + WS_HID), (const char*)(F.ws + WS_EW2)};
          pg8::EpiSlot8 E{(unsigned char*)(F.ws + WS_YQ)}; int kd = DEXP; asm volatile("" : "+s"(kd));
          pg8::gemm_phase<pg8::EpiSlot8, pg8::SlotOrder4, false>(F.lds, kd, S, E); }
        xcd_barrier(bar);
        moe_combine_phase(F);
    }
#ifdef EXTRA_BARS
    for (int xb_ = 0; xb_ < EXTRA_BARS; ++xb_) xcd_barrier(bar);
#endif
#undef IN
#undef SEAM
}

extern "C" void kernel_launch(void* const* d_in, const int* in_sizes, int n_in, void* d_out, int out_size, void* d_ws, size_t ws_size, hipStream_t stream) {
    static int grid = 0;
    if (grid == 0) {
        if (n_in != 38 || out_size != MTOK * DM || ws_size < WS_END) { fprintf(stderr, "kernel_launch: unexpected shapes (n_in %d out %d ws %zu)\n", n_in, out_size, ws_size); grid = -1; return; }
        int dev = 0, cus = 0, per_cu = 0;
        if (hipGetDevice(&dev) != hipSuccess || hipDeviceGetAttribute(&cus, hipDeviceAttributeMultiprocessorCount, dev) != hipSuccess) { grid = -1; return; }
        if (hipFuncSetAttribute((const void*)fwd_kernel, hipFuncAttributeMaxDynamicSharedMemorySize, LDS_BYTES) != hipSuccess) { fprintf(stderr, "kernel_launch: hipFuncSetAttribute failed\n"); grid = -1; return; }
        if (hipOccupancyMaxActiveBlocksPerMultiprocessor(&per_cu, (const void*)fwd_kernel, NTHR, LDS_BYTES) != hipSuccess || per_cu < 1) fprintf(stderr, "kernel_launch: occupancy query says %d\n", per_cu);
        (void)hipGetLastError();
        grid = cus;
    }
    if (grid < 0) return;
#ifdef EXTRA_PHASE
    {
        (void)hipMemsetAsync((char*)d_ws + WS_CTL, 0, CTL_ZERO_BYTES, stream);
        Args x{}; for (int i = 0; i < 38; ++i) x.in[i] = (const float*)d_in[i];
        x.out = (float*)d_out; x.ws = (unsigned char*)d_ws; x.ph_lo = EXTRA_PHASE; x.ph_hi = EXTRA_PHASE + 1; x.li = 0;
        hipLaunchKernelGGL(fwd_kernel, dim3(grid), dim3(NTHR), LDS_BYTES, stream, x);
    }
#endif
    (void)hipMemsetAsync((char*)d_ws + WS_CTL, 0, CTL_ZERO_BYTES, stream);
    Args a{};
    for (int i = 0; i < 38; ++i) a.in[i] = (const float*)d_in[i];
    a.out = (float*)d_out; a.ws = (unsigned char*)d_ws;
    for (int li = 0; li < N_LAUNCHES; ++li) {
        a.ph_lo = (N_LAUNCHES == NPH) ? li : 0; a.ph_hi = (N_LAUNCHES == NPH) ? li + 1 : NPH; a.li = li;
        hipLaunchKernelGGL(fwd_kernel, dim3(grid), dim3(NTHR), LDS_BYTES, stream, a);
    }
}
```

```cpp
#define MK_N_LAUNCHES 1
#include <hip/hip_runtime.h>
#include <cstdio>
#include <cstdint>

#define LAS __attribute__((address_space(3)))
#define GAS __attribute__((address_space(1)))
typedef unsigned short bf16;
typedef short bf16x8 __attribute__((ext_vector_type(8)));
typedef float f32x4 __attribute__((ext_vector_type(4)));
typedef float f32x2 __attribute__((ext_vector_type(2)));
typedef unsigned u32x4 __attribute__((ext_vector_type(4)));
typedef unsigned u32x2 __attribute__((ext_vector_type(2)));
typedef GAS unsigned gu32;

constexpr int BATCH = 16, SEQ = 2048, DM = 1024, MTOK = BATCH * SEQ;
constexpr int HYC = 3072, DSSM = 2048, CONVD = 4096, NHEAD = 32, NGRP = 8, NSTATE = 128, INC = 11328;
constexpr int NE = 64, TOPK = 8, DEXP = 256, NEX = NE + 1;
constexpr float DN_ALPHA = 1.189207115002721f;
constexpr float LN_EPS = 1e-5f, RMS_EPS = 1e-5f, ROUTED_SCALE = 2.5f;
constexpr int NWAVES = 8, NTHR = 512;
constexpr int WIN_ROWS = 11520;

constexpr size_t MiB = 1u << 20;
constexpr size_t WS_CTL = 0, CTL_ZERO_BYTES = 256 * 1024;
constexpr size_t WS_RWT = 256 * 1024;
constexpr size_t WS_WHYB = 1 * MiB, WS_WSSDB = 3 * MiB, WS_WOUT = 7 * MiB;
constexpr size_t WS_XB = 9 * MiB;
constexpr size_t WS_WINT = 73 * MiB;
constexpr size_t WS_KERN = 96 * MiB;
constexpr size_t WS_PTHY = 112 * MiB;
constexpr size_t WS_YTHY = 304 * MiB;
constexpr size_t WS_YHY = 137 * MiB;
constexpr size_t WS_XBC = 201 * MiB;
constexpr size_t WS_DT = 457 * MiB;
constexpr size_t WS_HALO = 465 * MiB;
constexpr size_t WS_YSSD = 9 * MiB;
constexpr size_t WS_XB2 = 201 * MiB;
constexpr size_t WS_WING = 505 * MiB;
constexpr size_t WS_G = 269 * MiB;
constexpr size_t WS_MIX = 397 * MiB;
constexpr int H1B_PITCH = 2048;
constexpr size_t WS_EW1 = 9 * MiB;
constexpr size_t WS_EW2 = 477 * MiB;
constexpr size_t WS_YQ = 1 * MiB;
constexpr size_t WS_ASG = 510 * MiB;
constexpr size_t WS_H1P = 177 * MiB;
constexpr size_t WS_HID = 305 * MiB;
constexpr size_t WS_TOK = 461 * MiB;
constexpr size_t WS_WGT = 469 * MiB;
constexpr size_t WS_END = 511 * MiB;
constexpr size_t OUT_XB = 64 * MiB;
constexpr int CW_BAR = 4096;
constexpr int CW_CNT = 16384;
constexpr int CW_DBG = 32768;

constexpr int LDS_BYTES = 163840;
constexpr int MISC_OFF = 163840 - 512;

#define RLX_AGENT __ATOMIC_RELAXED, __HIP_MEMORY_SCOPE_AGENT
#define LDS_WAIT() asm volatile("s_waitcnt lgkmcnt(0)" ::: "memory")
#define VM_WAIT() asm volatile("s_waitcnt vmcnt(0)" ::: "memory")
typedef __bf16 bf16x2_t __attribute__((ext_vector_type(2)));
__device__ __forceinline__ unsigned pk2(float lo, float hi) { const f32x2 v = {lo, hi}; return __builtin_bit_cast(unsigned, __builtin_convertvector(v, bf16x2_t)); }
__device__ __forceinline__ unsigned f2bf(float f) { return pk2(f, 0.f) & 0xffffu; }
__device__ __forceinline__ float bf2f(unsigned b) { return __builtin_bit_cast(float, b << 16); }
__device__ __forceinline__ float bflo(unsigned w) { return __builtin_bit_cast(float, w << 16); }
__device__ __forceinline__ float bfhi(unsigned w) { return __builtin_bit_cast(float, w & 0xffff0000u); }
__device__ __forceinline__ float sigmoidf_(float v) { return __builtin_amdgcn_rcpf(1.0f + __expf(-v)); }
__device__ __forceinline__ float siluf_(float v) { return v * __builtin_amdgcn_rcpf(1.0f + __expf(-v)); }
#define DPPF(old, src, ctrl, rmask) __builtin_bit_cast(float, __builtin_amdgcn_update_dpp(__builtin_bit_cast(int, (float)(old)), __builtin_bit_cast(int, (float)(src)), (ctrl), (rmask), 0xf, false))
__device__ __forceinline__ float wave_sum(float v) {
    v += DPPF(0.f, v, 0xB1, 0xf);
    v += DPPF(0.f, v, 0x4E, 0xf);
    v += DPPF(0.f, v, 0x141, 0xf);
    v += DPPF(0.f, v, 0x140, 0xf);
    v += DPPF(0.f, v, 0x142, 0xa);
    v += DPPF(0.f, v, 0x143, 0xc);
    return __builtin_bit_cast(float, __builtin_amdgcn_readlane(__builtin_bit_cast(int, v), 63));
}
__device__ __forceinline__ float wave_max(float v) {
    v = fmaxf(v, DPPF(v, v, 0xB1, 0xf));
    v = fmaxf(v, DPPF(v, v, 0x4E, 0xf));
    v = fmaxf(v, DPPF(v, v, 0x141, 0xf));
    v = fmaxf(v, DPPF(v, v, 0x140, 0xf));
    v = fmaxf(v, DPPF(v, v, 0x142, 0xa));
    v = fmaxf(v, DPPF(v, v, 0x143, 0xc));
    return __builtin_bit_cast(float, __builtin_amdgcn_readlane(__builtin_bit_cast(int, v), 63));
}

#ifndef PG8_WGM
#define PG8_WGM 8
#endif
namespace pg8 {
constexpr int BM = 256, BK = 64, HALF = 128, HTB = HALF * BK * 2, STAGE_BYTES = 8 * HTB, NXCD = 8, WGM = PG8_WGM;
__host__ __device__ __forceinline__ int lds_byte(int r, int c) { const int st = (r >> 4) * 2 + (c >> 5), rr = r & 15, cc = c & 31, ob = rr * 64 + cc * 2; return st * 1024 + (ob ^ (((ob >> 9) & 1) << 5)); }
__host__ __device__ __forceinline__ void stage_rc(int b, int& R, int& C) { const int st = b / 1024, sb = b % 1024, swz = sb ^ (((sb >> 9) & 1) << 5); R = (st >> 1) * 16 + swz / 64; C = (st & 1) * 32 + (swz % 64) / 2; }
__host__ __device__ __forceinline__ int perm32(int rho) { const int n = rho >> 4, i = rho & 15; return 8 * (i >> 2) + 4 * n + (i & 3); }

struct Unit { int pm, pn; const char* A; const char* B; int e, cnt; };

struct StaticOrder {
    int nM, nN, nwg, G, c, K; const char* A; const char* B;
    __device__ void init(const bf16* A_, const bf16* B_, int M, int N, int K_, int G_, int c_) { A = (const char*)A_; B = (const char*)B_; nM = M / BM; nN = N / BM; nwg = nM * nN; G = G_; c = c_; K = K_; }
    __device__ __forceinline__ bool next(int i, Unit& u) const {
        const long L = (long)i * G + c; if (L >= nwg) return false;
        int wgid = (int)L; { const int q = nwg / NXCD, r = nwg % NXCD, xcd = wgid % NXCD, off = wgid / NXCD; wgid = (xcd < r ? xcd * (q + 1) : r * (q + 1) + (xcd - r) * q) + off; }
        const int nig = WGM * nN, gid = wgid / nig, fm = gid * WGM, gsz = (nM - fm) < WGM ? (nM - fm) : WGM;
        u.pm = fm + ((wgid % nig) % gsz); u.pn = (wgid % nig) / gsz;
        u.A = A + (size_t)u.pm * BM * K * 2; u.B = B + (size_t)u.pn * BM * K * 2; u.e = 0; u.cnt = 0; return true;
    }
    __device__ __forceinline__ unsigned row_off(const Unit&, int) const { return 0u; }
};

__device__ __forceinline__ unsigned cvt_pk_bf16(float lo, float hi) { unsigned r; asm volatile("v_cvt_pk_bf16_f32 %0, %1, %2" : "=v"(r) : "v"(lo), "v"(hi)); return r; }

#ifndef PG8_SP2
#define PG8_SP2 true
#endif
#ifndef PG8_ALIGN
#define PG8_ALIGN true
#endif
template <class Epi, class Sched, bool GATHER, bool SP2 = PG8_SP2, bool ALIGN_EPI = PG8_ALIGN>
__device__ __forceinline__ void gemm_phase(LAS unsigned char* lds, const int K, const Sched& S, const Epi& E) {
    constexpr bool TA = Epi::TA;
    const int tid = threadIdx.x, wid = __builtin_amdgcn_readfirstlane(tid >> 6), lane = tid & 63, wr = wid >> 2, wc = wid & 3, fr = lane & 15, fq = lane >> 4;
    const int nt = K / BK;
    unsigned voffA[2][2], voffB[2]; int RA[2], CA[2];
#pragma unroll
    for (int i = 0; i < 2; ++i) { int R, C; stage_rc(tid * 16 + i * 8192, R, C);
        const int Rb = Epi::PERM == 3 ? (64 * (R >> 5) + 16 * ((R & 15) >> 2) + 4 * ((R >> 4) & 1) + (R & 3)) : (Epi::PERM == 2 ? (64 * (R >> 5) + perm32(R & 31)) : (Epi::PERM ? ((R & ~31) + perm32(R & 31)) : R));
        RA[i] = R; CA[i] = C; voffA[0][i] = (unsigned)(R * K + C) * 2u; voffA[1][i] = voffA[0][i]; voffB[i] = (unsigned)(Rb * K + C) * 2u; }
    const size_t kstep = (size_t)(BK * 2);
    const size_t hstep = (size_t)HALF * K * 2;
    const size_t hstepA = GATHER ? 0 : hstep;
    const size_t hstepB = (Epi::PERM == 3) ? (size_t)8 * K * 2 : ((Epi::PERM == 2) ? (size_t)32 * K * 2 : hstep);
    const unsigned ldsw = (unsigned)wid * 1024u;
    const int aoff = lds_byte(wr * 64 + fr, fq * 8), boff = lds_byte(wc * 32 + fr, fq * 8);
#define PG8_SA(b, h) (((b) * 2 + (h)) * HTB)
#define PG8_SB(b, h) ((4 + (b) * 2 + (h)) * HTB)
#define PG8_STAGE(bufoff, gbase, voff) do { _Pragma("unroll") for (int _i = 0; _i < 2; ++_i) \
        __builtin_amdgcn_global_load_lds((const unsigned*)((const char*)(gbase) + (voff)[_i]), (LAS unsigned*)(lds + (bufoff) + ldsw + _i * 8192), 16, 0, 0); } while (0)
#define PG8_STAGE_A(bufoff, gbase, h) PG8_STAGE(bufoff, (gbase) + (h) * hstepA, voffA[GATHER ? (h) : 0])
#define PG8_LDA(dst, b, h) do { _Pragma("unroll") for (int m = 0; m < 4; ++m) _Pragma("unroll") for (int k = 0; k < 2; ++k) dst[m][k] = *(const LAS bf16x8*)(lds + PG8_SA(b, h) + aoff + m * 2048 + k * 1024); } while (0)
#define PG8_LDB(dst, b, h) do { _Pragma("unroll") for (int n = 0; n < 2; ++n) _Pragma("unroll") for (int k = 0; k < 2; ++k) dst[n][k] = *(const LAS bf16x8*)(lds + PG8_SB(b, h) + boff + n * 2048 + k * 1024); } while (0)
#define PG8_MMA(ai, bj, At, Bt) do { __builtin_amdgcn_s_setprio(1); _Pragma("unroll") for (int m = 0; m < 4; ++m) _Pragma("unroll") for (int n = 0; n < 2; ++n) _Pragma("unroll") for (int k = 0; k < 2; ++k) \
        acc[ai][bj][m][n] = TA ? __builtin_amdgcn_mfma_f32_16x16x32_bf16(Bt[n][k], At[m][k], acc[ai][bj][m][n], 0, 0, 0) \
                               : __builtin_amdgcn_mfma_f32_16x16x32_bf16(At[m][k], Bt[n][k], acc[ai][bj][m][n], 0, 0, 0); __builtin_amdgcn_s_setprio(0); } while (0)
#define PG8_WAIT_V(n) asm volatile("s_waitcnt vmcnt(" #n ")" ::: "memory")
#define PG8_WAIT_L(n) asm volatile("s_waitcnt lgkmcnt(" #n ")" ::: "memory")
#define PG8_BAR __builtin_amdgcn_s_barrier()
#define PG8_SCHED __builtin_amdgcn_sched_barrier(0)
    Unit cur, nxt; int ui = 0;
    if (!S.next(0, cur)) return;
    if (GATHER) {
#pragma unroll
        for (int h = 0; h < 2; ++h)
#pragma unroll
            for (int i = 0; i < 2; ++i) voffA[h][i] = S.row_off(cur, h * HALF + RA[i]) + (unsigned)CA[i] * 2u;
    }
    f32x4 acc[2][2][4][2];
#pragma unroll
    for (int a = 0; a < 2; ++a)
#pragma unroll
        for (int b = 0; b < 2; ++b)
#pragma unroll
            for (int m = 0; m < 4; ++m)
#pragma unroll
                for (int n = 0; n < 2; ++n) acc[a][b][m][n] = (f32x4){0.f, 0.f, 0.f, 0.f};
    bf16x8 At[4][2], B0[2][2], B1[2][2];
    const char* cA = cur.A; const char* cB = cur.B;
    if constexpr (SP2) {
        PG8_STAGE(PG8_SB(0, 0), cB, voffB); PG8_STAGE(PG8_SB(0, 1), cB + hstepB, voffB); PG8_STAGE_A(PG8_SA(0, 0), cA, 0); PG8_STAGE_A(PG8_SA(0, 1), cA, 1);
        if (wr == 1) PG8_BAR;
        PG8_WAIT_V(2); PG8_BAR;
        PG8_STAGE(PG8_SB(1, 0), cB + kstep, voffB); PG8_STAGE_A(PG8_SA(1, 0), cA + kstep, 0); PG8_STAGE(PG8_SB(1, 1), cB + hstepB + kstep, voffB);
        PG8_WAIT_V(6); PG8_BAR;
    } else {
    PG8_STAGE(PG8_SB(0, 0), cB, voffB); PG8_STAGE_A(PG8_SA(0, 0), cA, 0); PG8_STAGE(PG8_SB(0, 1), cB + hstepB, voffB); PG8_STAGE_A(PG8_SA(0, 1), cA, 1);
    if (wr == 1) PG8_BAR;
    PG8_WAIT_V(4); PG8_BAR;
    PG8_STAGE(PG8_SB(1, 0), cB + kstep, voffB); PG8_STAGE_A(PG8_SA(1, 0), cA + kstep, 0); PG8_STAGE(PG8_SB(1, 1), cB + hstepB + kstep, voffB);
    PG8_WAIT_V(6); PG8_BAR;
    }
    for (;;) {
        const bool has_next = S.next(ui + 1, nxt);
        const char* nA = has_next ? nxt.A : cA; const char* nB = has_next ? nxt.B : cB;
        for (int t = 0; t < nt; t += 2) {
            const bool last = (t == nt - 2);
            const char* a1 = cA + (size_t)(t + 1) * kstep;
            const char* a2 = last ? nA : cA + (size_t)(t + 2) * kstep; const char* b2 = last ? nB : cB + (size_t)(t + 2) * kstep;
            const char* a3 = a2 + kstep; const char* b3 = b2 + kstep;
            if constexpr (SP2) {
            PG8_LDB(B0, 0, 0); PG8_LDB(B1, 0, 1); PG8_SCHED; PG8_LDA(At, 0, 0); PG8_STAGE_A(PG8_SA(1, 1), a1, 1);
            PG8_WAIT_V(8); PG8_WAIT_L(0); PG8_BAR; PG8_MMA(0, 0, At, B0); PG8_MMA(0, 1, At, B1); PG8_BAR; PG8_SCHED;
            if (GATHER) { if (last && has_next) {
#pragma unroll
                for (int h = 0; h < 2; ++h)
#pragma unroll
                    for (int i = 0; i < 2; ++i) voffA[h][i] = S.row_off(nxt, h * HALF + RA[i]) + (unsigned)CA[i] * 2u;
            } }
            PG8_LDA(At, 0, 1); PG8_STAGE(PG8_SB(0, 0), b2, voffB); PG8_STAGE(PG8_SB(0, 1), b2 + hstepB, voffB); PG8_STAGE_A(PG8_SA(0, 0), a2, 0);
            PG8_WAIT_V(8); PG8_WAIT_L(0); PG8_BAR; PG8_MMA(1, 0, At, B0); PG8_MMA(1, 1, At, B1); PG8_BAR; PG8_SCHED;
            PG8_LDB(B0, 1, 0); PG8_LDB(B1, 1, 1); PG8_SCHED; PG8_LDA(At, 1, 0); PG8_STAGE_A(PG8_SA(0, 1), a2, 1);
            PG8_WAIT_V(8); PG8_WAIT_L(0); PG8_BAR; PG8_MMA(0, 0, At, B0); PG8_MMA(0, 1, At, B1); PG8_BAR; PG8_SCHED;
            PG8_LDA(At, 1, 1); PG8_STAGE(PG8_SB(1, 0), b3, voffB); PG8_STAGE(PG8_SB(1, 1), b3 + hstepB, voffB); PG8_STAGE_A(PG8_SA(1, 0), a3, 0);
            PG8_WAIT_V(8); PG8_WAIT_L(0); PG8_BAR; PG8_MMA(1, 0, At, B0); PG8_MMA(1, 1, At, B1); PG8_BAR; PG8_SCHED;
            } else {
            PG8_LDB(B0, 0, 0); PG8_SCHED; PG8_LDA(At, 0, 0); PG8_STAGE_A(PG8_SA(1, 1), a1, 1);
            PG8_WAIT_L(8); PG8_BAR; PG8_WAIT_L(0); PG8_MMA(0, 0, At, B0); PG8_BAR; PG8_SCHED;
            if (GATHER) { if (last && has_next) {
#pragma unroll
                for (int h = 0; h < 2; ++h)
#pragma unroll
                    for (int i = 0; i < 2; ++i) voffA[h][i] = S.row_off(nxt, h * HALF + RA[i]) + (unsigned)CA[i] * 2u;
            } }
            PG8_LDB(B1, 0, 1); PG8_STAGE(PG8_SB(0, 0), b2, voffB);
            PG8_BAR; PG8_WAIT_L(0); PG8_MMA(0, 1, At, B1); PG8_BAR;
            PG8_LDA(At, 0, 1); PG8_STAGE_A(PG8_SA(0, 0), a2, 0);
            PG8_BAR; PG8_WAIT_L(0); PG8_MMA(1, 0, At, B0); PG8_BAR; PG8_SCHED;
            PG8_STAGE(PG8_SB(0, 1), b2 + hstepB, voffB);
            PG8_WAIT_V(6); PG8_BAR; PG8_MMA(1, 1, At, B1); PG8_BAR;
            PG8_LDB(B0, 1, 0); PG8_SCHED; PG8_LDA(At, 1, 0); PG8_STAGE_A(PG8_SA(0, 1), a2, 1);
            PG8_WAIT_L(8); PG8_BAR; PG8_WAIT_L(0); PG8_MMA(0, 0, At, B0); PG8_BAR; PG8_SCHED;
            PG8_LDB(B1, 1, 1); PG8_STAGE(PG8_SB(1, 0), b3, voffB);
            PG8_BAR; PG8_WAIT_L(0); PG8_MMA(0, 1, At, B1); PG8_BAR;
            PG8_LDA(At, 1, 1); PG8_STAGE_A(PG8_SA(1, 0), a3, 0);
            PG8_BAR; PG8_WAIT_L(0); PG8_MMA(1, 0, At, B0); PG8_BAR; PG8_SCHED;
            PG8_STAGE(PG8_SB(1, 1), b3 + hstepB, voffB);
            PG8_WAIT_V(6); PG8_BAR; PG8_MMA(1, 1, At, B1); PG8_BAR;
                    }
        }
        if constexpr (ALIGN_EPI) { if (wr == 0) PG8_BAR; }
        E(acc, cur, wr, wc, fr, fq);
        if (!has_next) break;
#pragma unroll
        for (int a = 0; a < 2; ++a)
#pragma unroll
            for (int b = 0; b < 2; ++b)
#pragma unroll
                for (int m = 0; m < 4; ++m)
#pragma unroll
                    for (int n = 0; n < 2; ++n) acc[a][b][m][n] = (f32x4){0.f, 0.f, 0.f, 0.f};
        cur = nxt; cA = nA; cB = nB; ++ui;
        if constexpr (ALIGN_EPI) { if (wr == 1) PG8_BAR; }
    }
    PG8_WAIT_V(0);
    if constexpr (!ALIGN_EPI) { if (wr == 0) PG8_BAR; }
    PG8_BAR;
#undef PG8_SA
#undef PG8_SB
#undef PG8_STAGE
#undef PG8_STAGE_A
#undef PG8_LDA
#undef PG8_LDB
#undef PG8_MMA
#undef PG8_WAIT_V
#undef PG8_WAIT_L
#undef PG8_BAR
#undef PG8_SCHED
}
}

namespace pg8 {
struct EpiHyT {
    static constexpr bool TA = false; static constexpr int PERM = 0;
    bf16* PT; const float* bias; LAS unsigned char* scr;
    __device__ __forceinline__ void operator()(const f32x4 (&acc)[2][2][4][2], const Unit& u, int wr, int wc, int fr, int fq) const {
        const int lane = fq * 16 + fr, lc = lane >> 3, lp = lane & 7;
        LAS unsigned char* s = scr + (wr * 4 + wc) * 2304;
        LAS unsigned char* wp = s + fr * 144 + 8 * fq;
        const LAS unsigned char* rp = s + lc * 144 + 16 * lp;
#pragma unroll
        for (int bj = 0; bj < 2; ++bj)
#pragma unroll
            for (int n = 0; n < 2; ++n) {
                const int col0 = u.pn * BM + bj * HALF + wc * 32 + n * 16; const float bv = bias[col0 + fr];
                bf16* gp = PT + (size_t)(col0 + lc) * MTOK + u.pm * BM + wr * 64 + 8 * lp;
#pragma unroll
                for (int ai = 0; ai < 2; ++ai) {
#pragma unroll
                    for (int m = 0; m < 4; ++m) { const f32x4 v = acc[ai][bj][m][n] + bv; u32x2 w; w.x = cvt_pk_bf16(v[0], v[1]); w.y = cvt_pk_bf16(v[2], v[3]);
                        *(LAS u32x2*)(wp + 32 * m) = w; }
                    const u32x4 r0 = *(const LAS u32x4*)rp, r1 = *(const LAS u32x4*)(rp + 8 * 144);
                    *(u32x4*)(gp + ai * HALF) = r0; *(u32x4*)(gp + ai * HALF + (size_t)8 * MTOK) = r1; }
            }
    }
};
__device__ __forceinline__ unsigned dpp_ror8(unsigned v) { return (unsigned)__builtin_amdgcn_update_dpp(0, (int)v, 0x128, 0xf, 0xf, false); }
__device__ __forceinline__ void xchg4(u32x4& u0, u32x4& u1, bool lo) { const u32x4 x = lo ? u1 : u0; u32x4 y; y.x = dpp_ror8(x.x); y.y = dpp_ror8(x.y); y.z = dpp_ror8(x.z); y.w = dpp_ror8(x.w); if (lo) u1 = y; else u0 = y; }
__device__ __forceinline__ void xchg2(u32x2& u0, u32x2& u1, bool lo) { const u32x2 x = lo ? u1 : u0; u32x2 y; y.x = dpp_ror8(x.x); y.y = dpp_ror8(x.y); if (lo) u1 = y; else u0 = y; }
struct EpiZXD {
    static constexpr bool TA = true; static constexpr int PERM = 2;
    unsigned char* Z8; bf16* XBC; float* DT; const float* b_in; bf16* HALO;
    __device__ __forceinline__ void operator()(const f32x4 (&acc)[2][2][4][2], const Unit& u, int wr, int wc, int fr, int fq) const {
        const bool lo = fr < 8; const int f7 = fr & 7;
        if (u.pn == 24) {
            if (wc == 0) { const int row0 = u.pm * BM + wr * 64 + fr;
#pragma unroll
                for (int bj = 0; bj < 2; ++bj)
#pragma unroll
                    for (int n = 0; n < 2; ++n) { const int c = 32 * bj + 8 * fq + 4 * n; const f32x4 bv = *(const f32x4*)(b_in + 9216 + c);
#pragma unroll
                        for (int ai = 0; ai < 2; ++ai)
#pragma unroll
                            for (int m = 0; m < 4; ++m) *(f32x4*)(DT + (size_t)(row0 + ai * HALF + m * 16) * 64 + c) = acc[ai][bj][m][n] + bv; } }
            return;
        }
        const int rowm = u.pm * BM + wr * 64 + f7;
        if (u.pn < 8) {
            const int cz = u.pn * BM + wc * 64 + 8 * fq;
            f32x4 bz[2][2];
#pragma unroll
            for (int bj = 0; bj < 2; ++bj) { bz[bj][0] = *(const f32x4*)(b_in + 3072 + cz + 32 * bj); bz[bj][1] = *(const f32x4*)(b_in + 3072 + cz + 32 * bj + 4); }
            unsigned char* zp = Z8 + (size_t)rowm * DSSM + cz + (lo ? 0 : 32);
#pragma unroll
            for (int ai = 0; ai < 2; ++ai)
#pragma unroll
                for (int m = 0; m < 4; ++m) { u32x2 p[2];
#pragma unroll
                    for (int bj = 0; bj < 2; ++bj) { const f32x4 v0 = acc[ai][bj][m][0] + bz[bj][0], v1 = acc[ai][bj][m][1] + bz[bj][1];
                        int w0 = __builtin_amdgcn_cvt_pk_fp8_f32(v0[0], v0[1], 0, false); w0 = __builtin_amdgcn_cvt_pk_fp8_f32(v0[2], v0[3], w0, true);
                        int w1 = __builtin_amdgcn_cvt_pk_fp8_f32(v1[0], v1[1], 0, false); w1 = __builtin_amdgcn_cvt_pk_fp8_f32(v1[2], v1[3], w1, true);
                        p[bj].x = (unsigned)w0; p[bj].y = (unsigned)w1; }
                    xchg2(p[0], p[1], lo);
                    unsigned char* q = zp + (size_t)(ai * HALF + m * 16) * DSSM;
                    *(u32x2*)q = p[0]; *(u32x2*)(q + (size_t)8 * DSSM) = p[1]; }
            return;
        }
        const int colt = (u.pn - 8) * BM, cx = colt + wc * 64 + 8 * fq;
        f32x4 bv[2][2];
#pragma unroll
        for (int bj = 0; bj < 2; ++bj)
#pragma unroll
            for (int n = 0; n < 2; ++n) bv[bj][n] = *(const f32x4*)(b_in + 5120 + cx + 32 * bj + 4 * n);
        const int cm = cx + (lo ? 0 : 32);
#pragma unroll
        for (int ai = 0; ai < 2; ++ai)
#pragma unroll
            for (int m = 0; m < 4; ++m) { u32x4 p[2];
#pragma unroll
                for (int bj = 0; bj < 2; ++bj) { const f32x4 v0 = acc[ai][bj][m][0] + bv[bj][0], v1 = acc[ai][bj][m][1] + bv[bj][1];
                    p[bj].x = cvt_pk_bf16(v0[0], v0[1]); p[bj].y = cvt_pk_bf16(v0[2], v0[3]); p[bj].z = cvt_pk_bf16(v1[0], v1[1]); p[bj].w = cvt_pk_bf16(v1[2], v1[3]); }
                xchg4(p[0], p[1], lo);
#pragma unroll
                for (int hb = 0; hb < 2; ++hb) { const int row = rowm + ai * HALF + m * 16 + 8 * hb;
                    *(u32x4*)(XBC + (size_t)row * CONVD + cm) = p[hb];
                    if ((m == 3 && hb == 1 && f7 >= 6) || (m == 0 && hb == 0 && f7 < 2)) {
                        const int bb = row >> 11, t = row & 2047, tm = t & 63;
                        const int jb = (tm >= 62) ? (t >> 6) + 1 : (t >> 6), idx = (tm >= 62) ? tm - 62 : 2 + tm;
                        *(u32x4*)(HALO + ((size_t)(bb * 33 + jb) * 4 + idx) * CONVD + cm) = p[hb]; } } }
    }
};
template <int MODE> struct EpiBf {
    static constexpr bool TA = true; static constexpr int PERM = 2;
    bf16* O; int ldc; const float* bias; const bf16* G1; int ldg; const bf16* P;
    __device__ __forceinline__ void operator()(const f32x4 (&acc)[2][2][4][2], const Unit& u, int wr, int wc, int fr, int fq) const {
        const bool lo = fr < 8; const int rowm = u.pm * BM + wr * 64 + (fr & 7), co = u.pn * BM + wc * 64 + 8 * fq, cm = co + (lo ? 0 : 32);
        f32x4 bb[2][2];
        if (MODE == 0) {
#pragma unroll
            for (int bj = 0; bj < 2; ++bj) { bb[bj][0] = *(const f32x4*)(bias + co + 32 * bj); bb[bj][1] = *(const f32x4*)(bias + co + 32 * bj + 4); } }
#pragma unroll
        for (int ai = 0; ai < 2; ++ai)
#pragma unroll
            for (int m = 0; m < 4; ++m) { const size_t r0 = (size_t)(rowm + ai * HALF + m * 16), r1 = r0 + 8; u32x4 g[2], pp[2], w[2];
                if (MODE != 0) { g[0] = *(const u32x4*)(G1 + r0 * ldg + cm); g[1] = *(const u32x4*)(G1 + r1 * ldg + cm);
                    if (MODE == 2) { pp[0] = *(const u32x4*)(P + r0 * ldc + cm); pp[1] = *(const u32x4*)(P + r1 * ldc + cm); }
                    xchg4(g[0], g[1], lo); if (MODE == 2) xchg4(pp[0], pp[1], lo); }
#pragma unroll
                for (int bj = 0; bj < 2; ++bj) { f32x4 v0 = acc[ai][bj][m][0], v1 = acc[ai][bj][m][1];
                    if (MODE == 0) { v0 = v0 + bb[bj][0]; v1 = v1 + bb[bj][1];
#pragma unroll
                        for (int j = 0; j < 4; ++j) { v0[j] = sigmoidf_(v0[j]); v1[j] = sigmoidf_(v1[j]); } }
                    else { const u32x4 gg = g[bj];
                        v0[0] *= bflo(gg.x); v0[1] *= bfhi(gg.x); v0[2] *= bflo(gg.y); v0[3] *= bfhi(gg.y); v1[0] *= bflo(gg.z); v1[1] *= bfhi(gg.z); v1[2] *= bflo(gg.w); v1[3] *= bfhi(gg.w);
                        if (MODE == 2) { const u32x4 p = pp[bj];
                            v0[0] += bflo(p.x); v0[1] += bfhi(p.x); v0[2] += bflo(p.y); v0[3] += bfhi(p.y); v1[0] += bflo(p.z); v1[1] += bfhi(p.z); v1[2] += bflo(p.w); v1[3] += bfhi(p.w); } }
                    w[bj].x = cvt_pk_bf16(v0[0], v0[1]); w[bj].y = cvt_pk_bf16(v0[2], v0[3]); w[bj].z = cvt_pk_bf16(v1[0], v1[1]); w[bj].w = cvt_pk_bf16(v1[2], v1[3]); }
                xchg4(w[0], w[1], lo);
                *(u32x4*)(O + r0 * ldc + cm) = w[0]; *(u32x4*)(O + r1 * ldc + cm) = w[1]; }
    }
};
struct EpiRes {
    static constexpr bool TA = true; static constexpr int PERM = 2;
    bf16* O; const float* bias; const bf16* X; float alpha;
    __device__ __forceinline__ void operator()(const f32x4 (&acc)[2][2][4][2], const Unit& u, int wr, int wc, int fr, int fq) const {
        const bool lo = fr < 8; const int rowm = u.pm * BM + wr * 64 + (fr & 7), co = u.pn * BM + wc * 64 + 8 * fq, cm = co + (lo ? 0 : 32);
        f32x4 bb[2][2];
#pragma unroll
        for (int bj = 0; bj < 2; ++bj) { bb[bj][0] = *(const f32x4*)(bias + co + 32 * bj); bb[bj][1] = *(const f32x4*)(bias + co + 32 * bj + 4); }
#pragma unroll
        for (int ai = 0; ai < 2; ++ai)
#pragma unroll
            for (int m = 0; m < 4; ++m) { const size_t o0 = (size_t)(rowm + ai * HALF + m * 16) * DM + cm, o1 = o0 + (size_t)8 * DM; u32x4 x[2], w[2];
                x[0] = *(const u32x4*)(X + o0); x[1] = *(const u32x4*)(X + o1); xchg4(x[0], x[1], lo);
#pragma unroll
                for (int bj = 0; bj < 2; ++bj) { const u32x4 xv = x[bj]; f32x4 v0 = acc[ai][bj][m][0] + bb[bj][0], v1 = acc[ai][bj][m][1] + bb[bj][1];
                    v0[0] += alpha * bflo(xv.x); v0[1] += alpha * bfhi(xv.x); v0[2] += alpha * bflo(xv.y); v0[3] += alpha * bfhi(xv.y);
                    v1[0] += alpha * bflo(xv.z); v1[1] += alpha * bfhi(xv.z); v1[2] += alpha * bflo(xv.w); v1[3] += alpha * bfhi(xv.w);
                    w[bj].x = cvt_pk_bf16(v0[0], v0[1]); w[bj].y = cvt_pk_bf16(v0[2], v0[3]); w[bj].z = cvt_pk_bf16(v1[0], v1[1]); w[bj].w = cvt_pk_bf16(v1[2], v1[3]); }
                xchg4(w[0], w[1], lo);
                *(u32x4*)(O + o0) = w[0]; *(u32x4*)(O + o1) = w[1]; }
    }
};
struct EpiSwiGLU {
    static constexpr bool TA = true; static constexpr int PERM = 1;
    bf16* HID;
    __device__ __forceinline__ void operator()(const f32x4 (&acc)[2][2][4][2], const Unit& u, int wr, int wc, int fr, int fq) const {
        const int row0 = u.pm * BM + wr * 64 + fr, col0 = u.pn * HALF + wc * 32 + 8 * fq;
#pragma unroll
        for (int ai = 0; ai < 2; ++ai)
#pragma unroll
            for (int m = 0; m < 4; ++m) { f32x4 v0, v1;
#pragma unroll
                for (int j = 0; j < 4; ++j) { v0[j] = siluf_(acc[ai][0][m][0][j]) * acc[ai][1][m][0][j]; v1[j] = siluf_(acc[ai][0][m][1][j]) * acc[ai][1][m][1][j]; }
                u32x4 w; w.x = cvt_pk_bf16(v0[0], v0[1]); w.y = cvt_pk_bf16(v0[2], v0[3]); w.z = cvt_pk_bf16(v1[0], v1[1]); w.w = cvt_pk_bf16(v1[2], v1[3]);
                *(u32x4*)(HID + (size_t)(row0 + ai * HALF + m * 16) * DEXP + col0) = w; }
    }
};
struct EpiScatter {
    static constexpr bool TA = false; static constexpr int PERM = 0;
    float* ACC; const int* tok; const float* wgt; int j0_unused;
    __device__ __forceinline__ void operator()(const f32x4 (&acc)[2][2][4][2], const Unit& u, int wr, int wc, int fr, int fq) const {
        asm volatile("" : "+v"(fr), "+v"(fq));
        const int jt = u.pn >> 2, ct = u.pn & 3;
#pragma unroll
        for (int ai = 0; ai < 2; ++ai)
#pragma unroll
            for (int m = 0; m < 4; ++m)
#pragma unroll
                for (int j = 0; j < 4; ++j) { const int r = ai * HALF + wr * 64 + m * 16 + 4 * fq + j;
                    if (r < u.cnt) { int token; float w;
                        if (u.e == NE) { token = jt * BM + r; w = 1.0f; } else { const size_t li = (size_t)u.e * MTOK + (size_t)jt * BM + r; token = tok[li]; w = wgt[li]; }
                        float* rowp = ACC + (size_t)token * DM + ct * BM + wc * 32 + fr;
#pragma unroll
                        for (int bj = 0; bj < 2; ++bj)
#pragma unroll
                            for (int n = 0; n < 2; ++n) unsafeAtomicAdd(rowp + bj * HALF + n * 16, w * acc[ai][bj][m][n][j]);
                    }
                    asm volatile("" ::: "memory"); }
    }
};

struct EpiSlot8 {
    static constexpr bool TA = true; static constexpr int PERM = 3;
    unsigned char* YQ;
    __device__ __forceinline__ void operator()(const f32x4 (&acc)[2][2][4][2], const Unit& u, int wr, int wc, int fr, int fq) const {
        asm volatile("" : "+v"(fr), "+v"(fq));
        const int row0 = u.pm * BM + wr * 64 + fr, col0 = u.pn * 256 + wc * 64 + 16 * fq;
#pragma unroll
        for (int ai = 0; ai < 2; ++ai)
#pragma unroll
            for (int m = 0; m < 4; ++m) { u32x4 w;
#pragma unroll
                for (int bj = 0; bj < 2; ++bj) { const f32x4 v0 = acc[ai][bj][m][0], v1 = acc[ai][bj][m][1];
                    int w0 = __builtin_amdgcn_cvt_pk_fp8_f32(v0[0], v0[1], 0, false); w0 = __builtin_amdgcn_cvt_pk_fp8_f32(v0[2], v0[3], w0, true);
                    int w1 = __builtin_amdgcn_cvt_pk_fp8_f32(v1[0], v1[1], 0, false); w1 = __builtin_amdgcn_cvt_pk_fp8_f32(v1[2], v1[3], w1, true);
                    if (bj == 0) { w.x = (unsigned)w0; w.y = (unsigned)w1; } else { w.z = (unsigned)w0; w.w = (unsigned)w1; } }
                *(u32x4*)(YQ + (size_t)(row0 + ai * HALF + m * 16) * 1024 + col0) = w; }
    }
};
struct SlotOrder4 {
    const LAS int* tp; const LAS int* te; int G, c, total; const char* A; const char* W;
    __device__ __forceinline__ bool next(int i, Unit& u) const {
        int tile, q;
        if (G == 256) { const int cx = c & 7, cj = c >> 3; q = cj & 3; tile = i * 64 + (cj >> 2) * 8 + cx; }
        else { const long L = (long)i * G + c; tile = (int)(L >> 2); q = (int)(L & 3); }
        if (tile >= total) return false;
        const int e = te[tile];
        u.e = e; u.cnt = 0; u.pm = tile; u.pn = q; u.A = A + (size_t)tile * BM * DEXP * 2; u.B = W + ((size_t)e * DM + (size_t)q * 256) * DEXP * 2;
        return true;
    }
    __device__ __forceinline__ unsigned row_off(const Unit&, int) const { return 0u; }
};
template <int NCT, bool FIRST> struct MoeOrder {
    const LAS int* tp; const LAS int* cnt; const LAS int* te; int G, c, total;
    const char* A; const char* W; const int* tok;
    __device__ __forceinline__ bool next(int i, Unit& u) const {
        const long L = (long)i * G + c; if (L >= (long)total * NCT) return false;
        const int tile = (int)(L / NCT), ct = (int)(L % NCT);
        const int e = te[tile];
        const int jt = tile - tp[e];
        u.e = e; const int left = cnt[e] - jt * BM; u.cnt = left < BM ? left : BM;
        if (FIRST) { u.pm = tile; u.pn = ct; u.A = A; u.B = W + ((size_t)e * 512 + (size_t)ct * 256) * DM * 2; }
        else { u.pm = tile; u.pn = jt * 4 + ct; u.A = A + (size_t)tile * BM * DEXP * 2; u.B = W + ((size_t)e * DM + (size_t)ct * 256) * DEXP * 2; }
        return true;
    }
    __device__ __forceinline__ unsigned row_off(const Unit& u, int r) const {
        const int jt = u.pm - tp[u.e]; int token;
        if (u.e == NE) token = jt * BM + r; else token = (r < u.cnt) ? tok[(size_t)u.e * MTOK + (size_t)jt * BM + r] : 0;
        return (unsigned)token * (unsigned)(H1B_PITCH * 2);
    }
};
}

#define XB_TMO      128
#define XB_XCNT(j)  (256  + 64 * (j))
#define XB_XSUB(j)  (1280 + 64 * (j))
#define XB_XGEN(j)  (2304 + 64 * (j))
#define XB_TOP      3328
#define XB_TOPGEN   3392
#define XCD_BAR_WORDS 3456
#define XB_SPIN_CAP (1u << 18)
__device__ __forceinline__ unsigned xb_ld(unsigned* p)              { return __hip_atomic_load(p, __ATOMIC_RELAXED, __HIP_MEMORY_SCOPE_AGENT); }
__device__ __forceinline__ unsigned xb_add(unsigned* p, unsigned v) { return __hip_atomic_fetch_add(p, v, __ATOMIC_RELAXED, __HIP_MEMORY_SCOPE_AGENT); }
__device__ __forceinline__ unsigned xb_xcc_id() { return (unsigned)__builtin_amdgcn_s_getreg((3 << 11) | 20) & 0xFu; }
#define XB_SPIN(cond, bar) do { unsigned _sp = 0; while (cond) { __builtin_amdgcn_s_sleep(1); \
    if ((++_sp & 255u) == 0u) { if (xb_ld(&(bar)[XB_TMO])) break; if (_sp > XB_SPIN_CAP) { atomicAdd(&(bar)[XB_TMO], 1u); break; } } } } while (0)
struct XcdBarrier { unsigned* bar; unsigned x; volatile LAS unsigned* st; };
__device__ __forceinline__ XcdBarrier xcd_barrier_post(unsigned* bar, volatile LAS unsigned* st) {
    XcdBarrier b; b.bar = bar; b.x = xb_xcc_id(); b.st = st;
    if (threadIdx.x == 0) (void)xb_add(&bar[XB_XCNT(b.x)], 1u);
    return b;
}
__device__ __forceinline__ void xcd_barrier_complete(unsigned* bar, unsigned x, unsigned& nloc, unsigned& nx) {
    const unsigned G = gridDim.x * gridDim.y * gridDim.z;
    unsigned sum, cnt, mine, sp = 0u;
    for (;;) {
        sum = 0u; cnt = 0u; mine = 0u;
#pragma unroll
        for (unsigned j = 0; j < 16; ++j) { const unsigned c = xb_ld(&bar[XB_XCNT(j)]); sum += c; cnt += (c > 0u) ? 1u : 0u; mine = (j == x) ? c : mine; }
        if (sum == G) break;
        __builtin_amdgcn_s_sleep(1);
        if ((++sp & 255u) == 0u) { if (xb_ld(&bar[XB_TMO])) break; if (sp > XB_SPIN_CAP) { atomicAdd(&bar[XB_TMO], 1u); break; } }
    }
    nloc = mine > 0u ? mine : 1u; nx = cnt > 0u ? cnt : 1u;
}
__device__ __forceinline__ void xcd_barrier(const XcdBarrier& b) {
    asm volatile("s_waitcnt vmcnt(0)" ::: "memory");
    __syncthreads();
    if (threadIdx.x == 0) {
        unsigned* bar = b.bar;
        __builtin_amdgcn_s_waitcnt(0);
        unsigned nloc = b.st[0], nx = b.st[1];
        if (nloc == 0u) { xcd_barrier_complete(bar, b.x, nloc, nx); b.st[0] = nloc; b.st[1] = nx; }
        const unsigned old = xb_add(&bar[XB_XSUB(b.x)], 1u);
        const unsigned gen = old / nloc;
        if (old + 1u == (gen + 1u) * nloc) {
            __builtin_amdgcn_fence(__ATOMIC_RELEASE, "agent");
            asm volatile("s_waitcnt vmcnt(0)" ::: "memory");
            const unsigned og = xb_add(&bar[XB_TOP], 1u);
            const unsigned tg = og / nx;
            if (og + 1u == (tg + 1u) * nx) xb_add(&bar[XB_TOPGEN], 1u);
            else XB_SPIN(xb_ld(&bar[XB_TOPGEN]) == tg, bar);
            __builtin_amdgcn_fence(__ATOMIC_ACQUIRE, "agent");
            xb_add(&bar[XB_XGEN(b.x)], 1u);
            asm volatile("s_waitcnt vmcnt(0)" ::: "memory");
        } else {
            XB_SPIN(xb_ld(&bar[XB_XGEN(b.x)]) == gen, bar);
            __builtin_amdgcn_fence(__ATOMIC_ACQUIRE, "agent");
            asm volatile("s_waitcnt vmcnt(0)" ::: "memory");
        }
    }
    __syncthreads();
}

struct Args {
    const float* in[38]; float* out; unsigned char* ws; int ph_lo, ph_hi, li, pad;
};
enum { I_X = 0, I_WIN, I_BIN, I_HCW, I_HCB, I_FW1, I_FB1, I_FF1, I_FW2, I_FB2, I_FF2, I_FW3, I_FB3, I_FF3, I_FW4, I_HBIAS,
       I_SCW, I_SCB, I_DTB, I_ALOG, I_SD, I_SNW, I_WHYB, I_WSSDB, I_WOUT, I_BOUT, I_LN1G, I_LN1B, I_RW, I_RB, I_EWG, I_EWU, I_EWD, I_SWG, I_SWU, I_SWD, I_LN2G, I_LN2B };
struct Frame {
    LAS unsigned char* lds; volatile LAS unsigned* MISC; gu32* ctl; unsigned char* ws;
    int tid, lane, wave, vcu, G;
    const float* const* in; float* out;
};

__device__ __forceinline__ void tr_item(const float* src, int ld_src, int k0, int c0, bf16* dst, int drow0, int ldd, LAS float* scr, int lane) {
    f32x4 ld[8];
#pragma unroll
    for (int i = 0; i < 8; ++i) ld[i] = *(const f32x4*)(src + (size_t)(k0 + 8 * i + (lane >> 3)) * ld_src + c0 + 4 * (lane & 7));
#pragma unroll
    for (int i = 0; i < 8; ++i) { LAS float* d = scr + (8 * i + (lane >> 3)) * 33 + 4 * (lane & 7); d[0] = ld[i][0]; d[1] = ld[i][1]; d[2] = ld[i][2]; d[3] = ld[i][3]; }
    LDS_WAIT(); asm volatile("" ::: "memory");
    const int c = lane & 7;
#pragma unroll
    for (int j = 0; j < 4; ++j) { const int n = (lane >> 3) + 8 * j; const LAS float* s = scr + (8 * c) * 33 + n;
        u32x4 o; o.x = pk2(s[0 * 33], s[1 * 33]); o.y = pk2(s[2 * 33], s[3 * 33]); o.z = pk2(s[4 * 33], s[5 * 33]); o.w = pk2(s[6 * 33], s[7 * 33]);
        *(u32x4*)(dst + (size_t)(drow0 + n) * ldd + k0 + 8 * c) = o; }
    LDS_WAIT(); asm volatile("" ::: "memory");
}
__device__ __forceinline__ void tr_matrix_item(const float* src, int ld_src, int K, int col_first, int ncols, bf16* dst, int drow_first, LAS float* scr, int it, int lane) {
    const int nblk = ncols / 32, kb = it / nblk, nb = it % nblk;
    tr_item(src, ld_src, kb * 64, col_first + nb * 32, dst, drow_first + nb * 32, K, scr, lane);
}
__device__ __forceinline__ void convert_x(Frame& F, const float* x, bf16* xb) {
    const size_t n8 = (size_t)MTOK * DM / 8; const size_t stride = (size_t)F.G * NTHR;
    for (size_t i = (size_t)F.vcu * NTHR + F.tid; i < n8; i += 4 * stride) {
        f32x4 a[4], b[4];
#pragma unroll
        for (int u = 0; u < 4; ++u) { const size_t k = (i + u * stride < n8) ? i + u * stride : i; a[u] = *(const f32x4*)(x + k * 8); b[u] = *(const f32x4*)(x + k * 8 + 4); }
#pragma unroll
        for (int u = 0; u < 4; ++u) { u32x4 o; o.x = pk2(a[u][0], a[u][1]); o.y = pk2(a[u][2], a[u][3]); o.z = pk2(b[u][0], b[u][1]); o.w = pk2(b[u][2], b[u][3]);
            if (i + u * stride < n8) *(u32x4*)(xb + (i + u * stride) * 8) = o; } }
}

__device__ __forceinline__ void hyena_filter(Frame& F) {
    const float* w1 = F.in[I_FW1]; const float* b1 = F.in[I_FB1]; const float* f1 = F.in[I_FF1];
    const float* w2 = F.in[I_FW2]; const float* b2 = F.in[I_FB2]; const float* f2 = F.in[I_FF2];
    const float* w3 = F.in[I_FW3]; const float* b3 = F.in[I_FB3]; const float* f3 = F.in[I_FF3];
    const float* w4 = F.in[I_FW4];
    bf16* KERN = (bf16*)(F.ws + WS_KERN);
    LAS float* hbuf = (LAS float*)(F.lds);
    const int lane = F.lane, wave = F.wave;
    for (int pg = F.vcu; pg < SEQ / 8; pg += F.G) {
        const int t = 8 * pg + wave;
        const float tn = (float)t / (float)(SEQ - 1), wv = 6.283185307179586f * (float)t / (float)SEQ;
        float zf = 0.f;
        if (lane == 0) zf = tn;
        else if (lane <= 16) { const float f = 1e-4f + (float)(lane - 1) * ((15.0f - 1e-4f) / 15.0f); zf = cosf(f * wv); }
        else if (lane <= 32) { const float f = 1e-4f + (float)(lane - 17) * ((15.0f - 1e-4f) / 15.0f); zf = -sinf(f * wv); }
        float s = b1[lane];
        for (int i = 0; i < 33; ++i) s += __shfl(zf, i) * w1[i * 64 + lane];
        float h = sinf(f1[lane] * s);
        s = b2[lane];
        for (int i = 0; i < 64; ++i) s += __shfl(h, i) * w2[i * 64 + lane];
        h = sinf(f2[lane] * s);
        s = b3[lane];
        for (int i = 0; i < 64; ++i) s += __shfl(h, i) * w3[i * 64 + lane];
        h = sinf(f3[lane] * s);
        hbuf[wave * 64 + lane] = h;
        __syncthreads();
        { float a[8][8];
#pragma unroll
          for (int q = 0; q < 8; ++q)
#pragma unroll
              for (int p = 0; p < 8; ++p) a[q][p] = 0.f;
          float a0b[4] = {0.f, 0.f, 0.f, 0.f};
#pragma unroll 2
          for (int i = 0; i < 64; ++i) { float wv[8], hv[8];
#pragma unroll
              for (int q = 0; q < 8; ++q) wv[q] = w4[(size_t)i * 4096 + F.tid + 512 * q];
#pragma unroll
              for (int p = 0; p < 8; ++p) hv[p] = hbuf[p * 64 + i];
#pragma unroll
              for (int q = 0; q < 8; ++q)
#pragma unroll
                  for (int p = 0; p < 8; ++p) a[q][p] += hv[p] * wv[q];
              if (pg == 0) { a0b[0] += hv[0] * wv[2]; a0b[1] += hv[0] * wv[3]; a0b[2] += hv[0] * wv[6]; a0b[3] += hv[0] * wv[7]; } }
#pragma unroll
          for (int q = 0; q < 8; ++q) { const int col = F.tid + 512 * q, c = col & 1023, dir = (q >> 1) & 1, o = q >> 2;
              const float adel = 3.0701134573253945f + (float)c * ((15.350567286626973f - 3.0701134573253945f) / 1023.0f);
              bf16* kc = KERN + ((size_t)c * 2 + o) * 4096;
#pragma unroll
              for (int p = 0; p < 8; ++p) { const int tp = 8 * pg + p; const float v = a[q][p] * __expf(-((float)tp / (float)(SEQ - 1)) * adel);
                  if (tp == 0) { if (dir == 0) { kc[2048] = (bf16)f2bf(v + a0b[(q & 1) + 2 * o]); kc[0] = 0; } }
                  else kc[dir == 0 ? 2048 - tp : 2048 + tp] = (bf16)f2bf(v); } } }
        __syncthreads();
    }
}

__device__ __forceinline__ void p0_prologue(Frame& F) {
    LAS float* scr = (LAS float*)(F.lds + 4096 + F.wave * 16384);
    const int gw = F.vcu * NWAVES + F.wave, NGW = F.G * NWAVES;
    const bool late_filter = (blockIdx.x & 1);
    bf16* WINT = (bf16*)(F.ws + WS_WINT);
    constexpr int I_A = 16 * (9216 / 32), I_B = 16 * (64 / 32), I_C = 16 * (2048 / 32);
    constexpr int I_HY = 16 * 32, I_SS = 32 * 32, I_OUT = 16 * 32;
    constexpr int NITEMS = I_A + I_B + I_C + I_HY + I_SS + I_OUT;
#pragma unroll 1
    for (int s_ = 0; s_ < 2; ++s_) {
    if ((s_ == 1) == late_filter) { hyena_filter(F); continue; }
    for (int it = gw; it < NITEMS; it += NGW) {
        int r = it;
        if (r < I_A) { tr_matrix_item(F.in[I_WIN], INC, DM, 0, 9216, WINT, 0, scr, r, F.lane); continue; } r -= I_A;
        if (r < I_B) { tr_matrix_item(F.in[I_WIN], INC, DM, 9216, 64, WINT, 9216, scr, r, F.lane); continue; } r -= I_B;
        if (r < I_C) { tr_matrix_item(F.in[I_WIN], INC, DM, 9280, 2048, (bf16*)(F.ws + WS_WING), 0, scr, r, F.lane); continue; } r -= I_C;
        if (r < I_HY) { tr_matrix_item(F.in[I_WHYB], DM, DM, 0, DM, (bf16*)(F.ws + WS_WHYB), 0, scr, r, F.lane); continue; } r -= I_HY;
        if (r < I_SS) { tr_matrix_item(F.in[I_WSSDB], DM, DSSM, 0, DM, (bf16*)(F.ws + WS_WSSDB), 0, scr, r, F.lane); continue; } r -= I_SS;
        tr_matrix_item(F.in[I_WOUT], DM, DM, 0, DM, (bf16*)(F.ws + WS_WOUT), 0, scr, r, F.lane);
    }
    convert_x(F, F.in[I_X], (bf16*)((unsigned char*)F.out + OUT_XB));
    { const int gid = F.vcu * NTHR + F.tid;
      if (gid < DM * NE) { const int kk = gid >> 6, e = gid & 63; const float w = F.in[I_RW][gid]; const unsigned hi = f2bf(w), lo = f2bf(w - bf2f(hi));
          bf16* RWT = (bf16*)(F.ws + WS_RWT); RWT[e * DM + kk] = (bf16)hi; RWT[DM * NE + e * DM + kk] = (bf16)lo; } }
    __syncthreads();
    }
}
__device__ __forceinline__ void p6_reconvert(Frame& F) {
    LAS float* scr = (LAS float*)(F.lds + 4096 + F.wave * 16384);
    const int gw = F.vcu * NWAVES + F.wave, NGW = F.G * NWAVES;
    for (int it = gw; it < 16 * (2048 / 32); it += NGW) tr_matrix_item(F.in[I_WIN], INC, DM, 9280, 2048, (bf16*)(F.ws + WS_WING), 0, scr, it, F.lane);
    convert_x(F, F.in[I_X], (bf16*)(F.ws + WS_XB2));
}
struct TrDesc { const float* src; int ld_src, k0, c0; bf16* dst; int drow0, ldd; };
__device__ __forceinline__ void tr_ld(const TrDesc& d, f32x4 (&ld)[8], int lane) {
#pragma unroll
    for (int i = 0; i < 8; ++i) ld[i] = *(const f32x4*)(d.src + (size_t)(d.k0 + 8 * i + (lane >> 3)) * d.ld_src + d.c0 + 4 * (lane & 7));
}
__device__ __forceinline__ void tr_st(const TrDesc& d, const f32x4 (&ld)[8], LAS float* scr, int lane) {
#pragma unroll
    for (int i = 0; i < 8; ++i) { LAS float* q = scr + (8 * i + (lane >> 3)) * 33 + 4 * (lane & 7); q[0] = ld[i][0]; q[1] = ld[i][1]; q[2] = ld[i][2]; q[3] = ld[i][3]; }
    LDS_WAIT(); asm volatile("" ::: "memory");
    const int c = lane & 7;
#pragma unroll
    for (int j = 0; j < 4; ++j) { const int n = (lane >> 3) + 8 * j; const LAS float* s = scr + (8 * c) * 33 + n;
        u32x4 o; o.x = pk2(s[0 * 33], s[1 * 33]); o.y = pk2(s[2 * 33], s[3 * 33]); o.z = pk2(s[4 * 33], s[5 * 33]); o.w = pk2(s[6 * 33], s[7 * 33]);
        *(u32x4*)(d.dst + (size_t)(d.drow0 + n) * d.ldd + d.k0 + 8 * c) = o; }
    LDS_WAIT(); asm volatile("" ::: "memory");
}
__device__ __forceinline__ void p10_expert_weights(Frame& F) {
    LAS float* scr = (LAS float*)(F.lds + 4096 + F.wave * 16384);
    const int gw = F.vcu * NWAVES + F.wave, NGW = F.G * NWAVES;
    bf16* EW1 = (bf16*)(F.ws + WS_EW1); bf16* EW2 = (bf16*)(F.ws + WS_EW2);
    constexpr int PER1 = 16 * 4;
    constexpr int N1 = NEX * 2 * 2 * PER1, PER2 = 4 * 32, N2 = NEX * PER2, NT = N1 + N2;
    auto desc = [&](int it) -> TrDesc { TrDesc d;
        if (it < N1) { const int e = it / (4 * PER1), r0 = it % (4 * PER1), mat = r0 / (2 * PER1), r1 = r0 % (2 * PER1), ct = r1 / PER1, r2 = r1 % PER1;
            d.src = (e < NE) ? F.in[mat ? I_EWU : I_EWG] + (size_t)e * DM * DEXP : F.in[mat ? I_SWU : I_SWG];
            d.ld_src = DEXP; d.k0 = (r2 / 4) * 64; d.c0 = 128 * ct + (r2 % 4) * 32; d.dst = EW1 + (size_t)e * 512 * DM; d.drow0 = 256 * ct + 128 * mat + (r2 % 4) * 32; d.ldd = DM; }
        else { const int r = it - N1, e = r / PER2, r2 = r % PER2;
            d.src = (e < NE) ? F.in[I_EWD] + (size_t)e * DEXP * DM : F.in[I_SWD];
            d.ld_src = DM; d.k0 = (r2 / 32) * 64; d.c0 = (r2 % 32) * 32; d.dst = EW2 + (size_t)e * DM * DEXP; d.drow0 = (r2 % 32) * 32; d.ldd = DEXP; }
        return d; };
    f32x4 la[8], lb[8]; TrDesc da, db;
    int it = gw;
    if (it < NT) { da = desc(it); tr_ld(da, la, F.lane); }
    for (; it < NT; it += 2 * NGW) {
        const bool hb = it + NGW < NT, ha = it + 2 * NGW < NT;
        if (hb) { db = desc(it + NGW); tr_ld(db, lb, F.lane); }
        tr_st(da, la, scr, F.lane);
        if (ha) { da = desc(it + 2 * NGW); tr_ld(da, la, F.lane); }
        if (hb) tr_st(db, lb, scr, F.lane);
    }
}
__device__ __forceinline__ void p3_transpose(Frame& F) {
    const bf16* YT = (const bf16*)(F.ws + WS_YTHY); bf16* Y = (bf16*)(F.ws + WS_YHY);
    LAS bf16* scr = (LAS bf16*)(F.lds + F.wave * 9216);
    const int gw = F.vcu * NWAVES + F.wave, NGW = F.G * NWAVES, lane = F.lane;
    for (int tile = gw; tile < 16 * 512; tile += NGW) {
        const int c0 = (tile & 15) * 64, t0 = (tile >> 4) * 64;
#pragma unroll
        for (int p = 0; p < 8; ++p) { const int c = p * 8 + (lane >> 3), ch = lane & 7;
            const u32x4 g = *(const u32x4*)(YT + (size_t)(c0 + c) * MTOK + t0 + ch * 8);
            LAS bf16* d = scr + (ch * 8) * 72 + (c ^ (ch << 3));
            d[0 * 72] = (bf16)(g.x & 0xffff); d[1 * 72] = (bf16)(g.x >> 16); d[2 * 72] = (bf16)(g.y & 0xffff); d[3 * 72] = (bf16)(g.y >> 16);
            d[4 * 72] = (bf16)(g.z & 0xffff); d[5 * 72] = (bf16)(g.z >> 16); d[6 * 72] = (bf16)(g.w & 0xffff); d[7 * 72] = (bf16)(g.w >> 16); }
        LDS_WAIT(); asm volatile("" ::: "memory");
#pragma unroll
        for (int p = 0; p < 8; ++p) { const int tk = p * 8 + (lane >> 3), ch = lane & 7;
            const u32x4 v = *(const LAS u32x4*)(scr + tk * 72 + ((ch ^ ((tk >> 3) & 7)) << 3));
            *(u32x4*)(Y + (size_t)(t0 + tk) * DM + c0 + ch * 8) = v; }
        LDS_WAIT(); asm volatile("" ::: "memory");
    }
}

constexpr int HY_LDU = 2064, HY_KCS = 4128, HY_U_BYTES = 16 * HY_LDU * 2, HY_KC_BYTES = 8 * HY_KCS * 2;

struct HyKRow { u32x4 cur, prv; };
__device__ __forceinline__ void hy_load_kern(HyKRow& r, const bf16* kern, int tid) {
    r.cur = *(const u32x4*)(kern + 8 * tid);
    r.prv = (u32x4){0u, 0u, 0u, 0u};
    if (tid > 0) r.prv = *(const u32x4*)(kern + 8 * tid - 8);
}
__device__ __forceinline__ void hy_store_kc(LAS bf16* KC, const HyKRow& r, int tid) {
    const unsigned E[9] = {r.prv.x, r.prv.y, r.prv.z, r.prv.w, r.cur.x, r.cur.y, r.cur.z, r.cur.w, 0u};
#pragma unroll
    for (int fl = 0; fl < 8; ++fl) { const int sft = 8 - fl, k = sft >> 1;
        u32x4 o;
        if (sft & 1) { o.x = __builtin_amdgcn_alignbit(E[k + 1], E[k], 16); o.y = __builtin_amdgcn_alignbit(E[k + 2], E[k + 1], 16);
                       o.z = __builtin_amdgcn_alignbit(E[k + 3], E[k + 2], 16); o.w = __builtin_amdgcn_alignbit(E[k + 4], E[k + 3], 16); }
        else { o.x = E[k]; o.y = E[k + 1]; o.z = E[k + 2]; o.w = E[k + 3]; }
        *(LAS u32x4*)(KC + fl * HY_KCS + 8 * tid) = o; }
}
__device__ __forceinline__ f32x4 hy_short4(const bf16* prow, int t0, float w0, float w1, float w2, float cb) {
    const u32x2 g = *(const u32x2*)(prow + t0);
    const float p0 = bflo(g.x), p1 = bfhi(g.x), p2 = bflo(g.y), p3 = bfhi(g.y);
    const float pm = (t0 > 0) ? bf2f(prow[t0 - 1]) : 0.f, pp = (t0 + 4 < SEQ) ? bf2f(prow[t0 + 4]) : 0.f;
    f32x4 r; r[0] = cb + w0 * pm + w1 * p0 + w2 * p1; r[1] = cb + w0 * p0 + w1 * p1 + w2 * p2; r[2] = cb + w0 * p1 + w1 * p2 + w2 * p3; r[3] = cb + w0 * p2 + w1 * p3 + w2 * pp;
    return r;
}
__device__ __forceinline__ f32x4 hy_conv4(const u32x2 g, float pm, float pp, float w0, float w1, float w2, float cb) {
    const float p0 = bflo(g.x), p1 = bfhi(g.x), p2 = bflo(g.y), p3 = bfhi(g.y);
    f32x4 r; r[0] = cb + w0 * pm + w1 * p0 + w2 * p1; r[1] = cb + w0 * p0 + w1 * p1 + w2 * p2; r[2] = cb + w0 * p1 + w1 * p2 + w2 * p3; r[3] = cb + w0 * p2 + w1 * p3 + w2 * pp;
    return r;
}
__device__ __forceinline__ void hyena_phase(Frame& F) {
    LAS bf16* U = (LAS bf16*)(F.lds); LAS bf16* KC = (LAS bf16*)(F.lds + HY_U_BYTES);
    const bf16* PT = (const bf16*)(F.ws + WS_PTHY); const bf16* KERN = (const bf16*)(F.ws + WS_KERN); bf16* YT = (bf16*)(F.ws + WS_YTHY);
    const float* cw = F.in[I_HCW]; const float* cbv = F.in[I_HCB]; const float* hb = F.in[I_HBIAS];
    const int tid = F.tid, lane = F.lane, w = F.wave, fr = lane & 15, fq = lane >> 4;
    u32x4 um[8]; unsigned ee[8]; HyKRow kr;
    auto load_v = [&](int c) { int tl = tid; asm volatile("" : "+v"(tl));
        const bf16* prow = PT + (size_t)(2048 + c) * MTOK + (size_t)(tl >> 8) * SEQ + (tl & 255) * 8;
#pragma unroll
        for (int it = 0; it < 8; ++it) { um[it] = *(const u32x4*)(prow + (size_t)(2 * it) * SEQ); ee[it] = 0u; }
        if (lane == 0 || lane == 63) {
#pragma unroll
            for (int it = 0; it < 8; ++it) { const int t8 = (tl & 255) * 8; const bf16* pr = prow + (size_t)(2 * it) * SEQ - t8;
                if (lane == 0) { if (t8 > 0) ee[it] = pr[t8 - 1]; } else { if (t8 + 8 < SEQ) ee[it] = pr[t8 + 8]; } } } };
    if (F.vcu < DM) { hy_load_kern(kr, KERN + ((size_t)F.vcu * 2 + 0) * 4096, tid); load_v(F.vcu); }
    for (int c = F.vcu; c < DM; c += F.G) {
        const bool has_next = (c + F.G < DM);
        hy_store_kc(KC, kr, tid);
        { const int vc = 2048 + c; const float w0 = cw[0 * HYC + vc], w1 = cw[1 * HYC + vc], w2 = cw[2 * HYC + vc], cb = cbv[vc];
#pragma unroll
          for (int it = 0; it < 8; ++it) { const int idx = tid + 512 * it, b = idx >> 8, t8 = (idx & 255) * 8;
              const unsigned up = __shfl_up(um[it].w >> 16, 1), dn = __shfl_down(um[it].x & 0xffffu, 1);
              const float pm = bf2f(lane == 0 ? ee[it] : up), pp = bf2f(lane == 63 ? ee[it] : dn);
              u32x2 g0; g0.x = um[it].x; g0.y = um[it].y; u32x2 g1v; g1v.x = um[it].z; g1v.y = um[it].w;
              const f32x4 lo = hy_conv4(g0, pm, bflo(um[it].z), w0, w1, w2, cb), hi = hy_conv4(g1v, bfhi(um[it].y), pp, w0, w1, w2, cb);
              u32x4 o; o.x = pk2(lo[0], lo[1]); o.y = pk2(lo[2], lo[3]); o.z = pk2(hi[0], hi[1]); o.w = pk2(hi[2], hi[3]);
              *(LAS u32x4*)(U + b * HY_LDU + t8) = o; } }
        __syncthreads();
#pragma unroll
        for (int o = 0; o < 2; ++o) {
            const int gc = (o == 0) ? c : 1024 + c;
            int lz = lane; asm volatile("" : "+v"(lz));
            const bf16* grow = PT + (size_t)gc * MTOK + (size_t)(lz & 15) * SEQ;
            u32x2 gm[16];
#pragma unroll
            for (int tt = 0; tt < 16; ++tt) gm[tt] = *(const u32x2*)(grow + 256 * w + 16 * tt + 4 * fq);
            const unsigned edge_lo = (w > 0) ? (unsigned)grow[256 * w - 1] : 0u, edge_hi = (w < 7) ? (unsigned)grow[256 * w + 256] : 0u;
            if (o == 0) hy_load_kern(kr, KERN + ((size_t)c * 2 + 1) * 4096, tid);
            else if (has_next) hy_load_kern(kr, KERN + ((size_t)(c + F.G) * 2 + 0) * 4096, tid);
            f32x4 acc[16];
#pragma unroll
            for (int i = 0; i < 16; ++i) acc[i] = (f32x4){0.f, 0.f, 0.f, 0.f};
            const LAS bf16* kbase = KC + (fr & 7) * HY_KCS + 2048 + 8 * fq - 8 * (fr >> 3) - 256 * w;
            const LAS bf16* ubase = U + fr * HY_LDU + 8 * fq;
            bf16x8 win[16];
#pragma unroll
            for (int i = 0; i < 16; ++i) win[i] = *(const LAS bf16x8*)(kbase - 16 * i);
            bf16x8 bnx = *(const LAS bf16x8*)(ubase);
#define HY_TIE(a, b, c) asm volatile("s_waitcnt lgkmcnt(0)" : "+v"(a), "+v"(b), "+v"(c) :: "memory")
#pragma unroll 1
            for (int sj8 = 0; sj8 < 64; sj8 += 8) {
#pragma unroll
                for (int u = 0; u < 8; ++u) { const int sj = sj8 + u;
                    HY_TIE(bnx, win[(16 - 2 * u) & 15], win[(17 - 2 * u) & 15]);
                    const bf16x8 bfr = bnx;
#pragma unroll
                    for (int tt = 14; tt < 16; ++tt) acc[tt] = __builtin_amdgcn_mfma_f32_16x16x32_bf16(win[(tt - 2 * u) & 15], bfr, acc[tt], 0, 0, 0);
                    __builtin_amdgcn_sched_barrier(0);
                    bnx = *(const LAS bf16x8*)(ubase + 32 * ((sj + 1) & 63));
                    win[(14 - 2 * u) & 15] = *(const LAS bf16x8*)(kbase + 16 * (2 * sj + 2));
                    win[(15 - 2 * u) & 15] = *(const LAS bf16x8*)(kbase + 16 * (2 * sj + 1));
                    __builtin_amdgcn_sched_barrier(0);
#pragma unroll
                    for (int tt = 2; tt < 14; ++tt) acc[tt] = __builtin_amdgcn_mfma_f32_16x16x32_bf16(win[(tt - 2 * u) & 15], bfr, acc[tt], 0, 0, 0);
#pragma unroll
                    for (int tt = 0; tt < 2; ++tt) acc[tt] = __builtin_amdgcn_mfma_f32_16x16x32_bf16(win[(tt - 2 * u) & 15], bfr, acc[tt], 0, 0, 0);
                    __builtin_amdgcn_sched_barrier(0);
                } }
#undef HY_TIE
            if (o == 1 && has_next) load_v(c + F.G);
            const float hbias = hb[o * DM + c];
            const float w0 = cw[0 * HYC + gc], w1 = cw[1 * HYC + gc], w2 = cw[2 * HYC + gc], cb = cbv[gc];
            u32x2 zpk[16];
            unsigned pa[16], nb[16];
#pragma unroll
            for (int tt = 0; tt < 16; ++tt) { pa[tt] = __shfl(gm[tt].y >> 16, (lane + 48) & 63); nb[tt] = __shfl(gm[tt].x & 0xffffu, (lane + 16) & 63); }
#pragma unroll
            for (int tt = 0; tt < 16; ++tt) { const int t0 = 256 * w + 16 * tt + 4 * fq;
                const unsigned pmv = (fq > 0) ? pa[tt] : (tt > 0 ? pa[tt > 0 ? tt - 1 : 0] : edge_lo), ppv = (fq < 3) ? nb[tt] : (tt < 15 ? nb[tt < 15 ? tt + 1 : 15] : edge_hi);
                const u32x2 uu = *(const LAS u32x2*)(U + fr * HY_LDU + t0);
                const f32x4 g = hy_conv4(gm[tt], bf2f(pmv), bf2f(ppv), w0, w1, w2, cb);
                f32x4 y = acc[tt]; y[0] = g[0] * (y[0] + bflo(uu.x) * hbias); y[1] = g[1] * (y[1] + bfhi(uu.x) * hbias); y[2] = g[2] * (y[2] + bflo(uu.y) * hbias); y[3] = g[3] * (y[3] + bfhi(uu.y) * hbias);
                zpk[tt].x = pk2(y[0], y[1]); zpk[tt].y = pk2(y[2], y[3]); }
            __syncthreads();
            if (o == 0) {
#pragma unroll
                for (int tt = 0; tt < 16; ++tt) *(LAS u32x2*)(U + fr * HY_LDU + 256 * w + 16 * tt + 4 * fq) = zpk[tt];
                hy_store_kc(KC, kr, tid);
                __syncthreads();
            } else {
                int ly = lane; asm volatile("" : "+v"(ly));
                bf16* yrow = YT + (size_t)c * MTOK + (size_t)(ly & 15) * SEQ + 256 * w + 4 * (ly >> 4);
#pragma unroll
                for (int tt = 0; tt < 16; ++tt) *(u32x2*)(yrow + 16 * tt) = zpk[tt];
            }
        }
    }
}

__device__ __forceinline__ void ssd_conv_phase(Frame& F) {
    bf16* XBC = (bf16*)(F.ws + WS_XBC); const bf16* HALO = (const bf16*)(F.ws + WS_HALO);
    const float* scw = F.in[I_SCW]; const float* scb = F.in[I_SCB];
    const int gw = F.vcu * NWAVES + F.wave, NGW = F.G * NWAVES, lane = F.lane;
    for (int item = gw; item < BATCH * 32 * 8; item += NGW) {
        const int cb8 = item & 7, seg = (item >> 3) & 31, b = item >> 8, col = cb8 * 512 + lane * 8;
        float wk[5][8], cbv[8];
#pragma unroll
        for (int k = 0; k < 5; ++k) { const f32x4 a = *(const f32x4*)(scw + k * CONVD + col), c = *(const f32x4*)(scw + k * CONVD + col + 4);
#pragma unroll
            for (int e = 0; e < 4; ++e) { wk[k][e] = a[e]; wk[k][4 + e] = c[e]; } }
        { const f32x4 a = *(const f32x4*)(scb + col), c = *(const f32x4*)(scb + col + 4);
#pragma unroll
          for (int e = 0; e < 4; ++e) { cbv[e] = a[e]; cbv[4 + e] = c[e]; } }
        bf16* xrow0 = XBC + ((size_t)b * SEQ + seg * 64) * CONVD + col;
        const bf16* hlo = HALO + ((size_t)(b * 33 + seg) * 4) * CONVD + col;
        const bf16* hhi = HALO + ((size_t)(b * 33 + seg + 1) * 4 + 2) * CONVD + col;
        const u32x4 zero4 = {0u, 0u, 0u, 0u};
        u32x4 W[12];
        W[0] = seg > 0 ? *(const u32x4*)(hlo) : zero4; W[1] = seg > 0 ? *(const u32x4*)(hlo + CONVD) : zero4;
        W[2] = *(const u32x4*)(xrow0); W[3] = *(const u32x4*)(xrow0 + CONVD);
#pragma unroll 1
        for (int blk = 0; blk < 8; ++blk) { const int r0 = 8 * blk;
#pragma unroll
            for (int i = 4; i < 12; ++i) { const int rr = r0 - 2 + i;
                if (rr < 64) W[i] = *(const u32x4*)(xrow0 + (size_t)rr * CONVD);
                else W[i] = (seg < 31) ? *(const u32x4*)(hhi + (size_t)(rr - 64) * CONVD) : zero4; }
#pragma unroll
            for (int o = 0; o < 8; ++o) { float v[8];
#pragma unroll
                for (int e = 0; e < 8; ++e) v[e] = cbv[e];
#pragma unroll
                for (int k = 0; k < 5; ++k) { const u32x4 p = W[o + k];
                    v[0] += wk[k][0] * bflo(p.x); v[1] += wk[k][1] * bfhi(p.x); v[2] += wk[k][2] * bflo(p.y); v[3] += wk[k][3] * bfhi(p.y);
                    v[4] += wk[k][4] * bflo(p.z); v[5] += wk[k][5] * bfhi(p.z); v[6] += wk[k][6] * bflo(p.w); v[7] += wk[k][7] * bfhi(p.w); }
#pragma unroll
                for (int e = 0; e < 8; ++e) v[e] = siluf_(v[e]);
                u32x4 ov; ov.x = pk2(v[0], v[1]); ov.y = pk2(v[2], v[3]); ov.z = pk2(v[4], v[5]); ov.w = pk2(v[6], v[7]);
                *(u32x4*)(xrow0 + (size_t)(r0 + o) * CONVD) = ov; }
#pragma unroll
            for (int i = 0; i < 4; ++i) W[i] = W[8 + i];
        }
    }
}

constexpr int SS_LDC = 144, SS_LDM = 136;
constexpr int SS_C = 0, SS_B = 18432, SS_X = 36864, SS_XE = 55296, SS_M = 73728, SS_SB = 108544, SS_ACS = 145408, SS_DTV = 146432, SS_TOE = 147456, SS_END = 148480;
static_assert(SS_END <= MISC_OFF, "SSD LDS map");
typedef short s16x4 __attribute__((ext_vector_type(4)));
__device__ __forceinline__ bf16x8 ssd_trfrag(const LAS bf16* p) {
    const s16x4 a = __builtin_amdgcn_ds_read_tr16_b64_v4i16((LAS s16x4*)p), b = __builtin_amdgcn_ds_read_tr16_b64_v4i16((LAS s16x4*)(p + 16 * SS_LDC));
    return __builtin_shufflevector(a, b, 0, 1, 2, 3, 4, 5, 6, 7);
}

__device__ __forceinline__ void ssd_phase(Frame& F) {
    LAS unsigned char* L = F.lds;
    LAS bf16* Cl = (LAS bf16*)(L + SS_C); LAS bf16* Bl = (LAS bf16*)(L + SS_B); LAS bf16* Xr = (LAS bf16*)(L + SS_X); LAS bf16* XEr = (LAS bf16*)(L + SS_XE);
    LAS bf16* Ml = (LAS bf16*)(L + SS_M); LAS bf16* SB = (LAS bf16*)(L + SS_SB);
    LAS float* ACS = (LAS float*)(L + SS_ACS); LAS float* DTV = (LAS float*)(L + SS_DTV); LAS float* TOE = (LAS float*)(L + SS_TOE);
    const bf16* XBC = (const bf16*)(F.ws + WS_XBC); const float* DT = (const float*)(F.ws + WS_DT); const unsigned char* Z8 = (const unsigned char*)F.out; bf16* YS = (bf16*)(F.ws + WS_YSSD);
    const float* dtb = F.in[I_DTB]; const float* alog = F.in[I_ALOG]; const float* sd = F.in[I_SD];
    const int tid = F.tid, lane = F.lane, w = F.wave, fr = lane & 15, fq = lane >> 4;
    for (int unit = F.vcu; unit < BATCH * NGRP * 2; unit += F.G) {
        const int b = unit >> 4, g = (unit >> 1) & 7, hp = unit & 1, h0 = 4 * g + 2 * hp;
#pragma unroll 1
        for (int dir = 0; dir < 2; ++dir) {
            const float dtbias = (w < 2) ? dtb[dir * 32 + h0 + w] : 0.f, aexp = (w < 2) ? __expf(alog[dir * 32 + h0 + w]) : 0.f;
            auto scan = [&](int buf, float raw) {
                raw += dtbias; const float dtv = raw > 20.f ? raw : log1pf(__expf(raw)); float a = -dtv * aexp;
#pragma unroll
                for (int o = 1; o < 64; o <<= 1) { const float v = __shfl_up(a, o); if (lane >= o) a += v; }
                const float tot = __shfl(a, 63); const int ix = (buf * 2 + w) * 64 + lane;
                ACS[ix] = a; DTV[ix] = dtv; TOE[ix] = __expf(tot - a); };
            auto dtload = [&](int ci) -> float { const int ch = dir ? 31 - ci : ci, r = dir ? 63 - lane : lane;
                return DT[((size_t)b * SEQ + 64 * ch + r) * 64 + dir * 32 + h0 + w]; };
            auto rowload = [&](int ci, int it, int tl) -> u32x4 {
                const int l = (tl >> 4) + 32 * (it & 1), j = tl & 15, ch = dir ? 31 - ci : ci, r = dir ? 63 - l : l;
                const int col = (it < 2 ? 64 * h0 : (it < 4 ? 2048 + 128 * g : 3072 + 128 * g)) + 8 * j;
                return *(const u32x4*)(XBC + ((size_t)b * SEQ + 64 * ch + r) * CONVD + col); };
            f32x4 Sacc[8];
#pragma unroll
            for (int i = 0; i < 8; ++i) Sacc[i] = (f32x4){0.f, 0.f, 0.f, 0.f};
            const float dsk = sd[h0 + (w >> 2)];
            __syncthreads();
            for (int i = tid; i < 2 * 64 * SS_LDC / 2; i += NTHR) ((LAS unsigned*)SB)[i] = 0u;
            float dtn = 0.f;
            if (w < 2) { scan(0, dtload(0)); dtn = dtload(1); }
            u32x4 pf[6];
#pragma unroll
            for (int it = 0; it < 6; ++it) pf[it] = rowload(0, it, tid);
            __syncthreads();
#pragma unroll 1
            for (int ci = 0; ci < 32; ++ci) {
                const int ch = dir ? 31 - ci : ci, buf = ci & 1;
                const size_t tokbase = (size_t)b * SEQ + 64 * ch;
                int tl = tid; asm volatile("" : "+v"(tl));
                int frl = fr, fql = fq; asm volatile("" : "+v"(frl), "+v"(fql));
                const LAS float* acs = ACS + buf * 128; const LAS float* dtv = DTV + buf * 128; const LAS float* toe = TOE + buf * 128;
#pragma unroll
                for (int it = 0; it < 6; ++it) { const int l = (tl >> 4) + 32 * (it & 1), j = tl & 15; const u32x4 p = pf[it];
                    if (it < 2) { const int hh = j >> 3; const float de = dtv[hh * 64 + l] * toe[hh * 64 + l];
                        *(LAS u32x4*)(Xr + l * SS_LDC + j * 8) = p;
                        u32x4 q; q.x = pk2(bflo(p.x) * de, bfhi(p.x) * de); q.y = pk2(bflo(p.y) * de, bfhi(p.y) * de); q.z = pk2(bflo(p.z) * de, bfhi(p.z) * de); q.w = pk2(bflo(p.w) * de, bfhi(p.w) * de);
                        *(LAS u32x4*)(XEr + l * SS_LDC + j * 8) = q; }
                    else if (it < 4) { *(LAS u32x4*)(Bl + l * SS_LDC + j * 8) = p; }
                    else { *(LAS u32x4*)(Cl + l * SS_LDC + j * 8) = p; } }
                if (ci + 1 < 32) {
#pragma unroll
                    for (int it = 0; it < 6; ++it) pf[it] = rowload(ci + 1, it, tl); }
                __syncthreads();
                const int hh = w >> 2, li = w & 3, lrow = 16 * li + frl;
                const int rloc = dir ? 63 - lrow : lrow; const size_t tok = tokbase + rloc;
                u32x4 pv[2]; u32x2 zv[2];
                if (dir) {
#pragma unroll
                    for (int t = 0; t < 2; ++t) { const size_t o = tok * DSSM + 64 * (h0 + hh) + 32 * t + 8 * fql; pv[t] = *(const u32x4*)(YS + o); zv[t] = *(const u32x2*)(Z8 + o); } }
#define SSD_FENCE() asm volatile("s_waitcnt lgkmcnt(0)" ::: "memory")
#define SSD_TIE8(a) asm volatile("s_waitcnt lgkmcnt(0)" : "+v"(a[0][0]), "+v"(a[0][1]), "+v"(a[1][0]), "+v"(a[1][1]), "+v"(a[2][0]), "+v"(a[2][1]), "+v"(a[3][0]), "+v"(a[3][1]) :: "memory")
#define SSD_TIE8K(a) asm volatile("s_waitcnt lgkmcnt(0)" : "+v"(a[0][0]), "+v"(a[0][1]), "+v"(a[0][2]), "+v"(a[0][3]), "+v"(a[1][0]), "+v"(a[1][1]), "+v"(a[1][2]), "+v"(a[1][3]) :: "memory")
                f32x4 Y[4];
                { bf16x8 cfr[4];
#pragma unroll
                  for (int kk = 0; kk < 4; ++kk) cfr[kk] = *(const LAS bf16x8*)(Cl + lrow * SS_LDC + 8 * fql + 32 * kk);
#pragma unroll
                  for (int ph = 0; ph < 2; ++ph) { bf16x8 sfr[2][4];
#pragma unroll
                      for (int pp = 0; pp < 2; ++pp)
#pragma unroll
                          for (int kk = 0; kk < 4; ++kk) sfr[pp][kk] = *(const LAS bf16x8*)(SB + (hh * 64 + 32 * ph + 8 * (frl >> 2) + 4 * pp + (frl & 3)) * SS_LDC + 8 * fql + 32 * kk);
                      SSD_TIE8K(sfr);
#pragma unroll
                      for (int pp = 0; pp < 2; ++pp) { Y[2 * ph + pp] = (f32x4){0.f, 0.f, 0.f, 0.f};
#pragma unroll
                          for (int kk = 0; kk < 4; ++kk) Y[2 * ph + pp] = __builtin_amdgcn_mfma_f32_16x16x32_bf16(sfr[pp][kk], cfr[kk], Y[2 * ph + pp], 0, 0, 0); }
                      __builtin_amdgcn_sched_barrier(0); } }
                { bf16x8 cbA[2][4], cbB[2][4]; f32x4 tas[2], tdd[2]; float tal[2];
#pragma unroll
                  for (int q = 0; q < 2; ++q) { const int id = 2 * w + q, si = id >> 2, lj = id & 3;
                      if (si <= lj) {
#pragma unroll
                          for (int kk = 0; kk < 4; ++kk) { cbA[q][kk] = *(const LAS bf16x8*)(Bl + (16 * si + frl) * SS_LDC + 8 * fql + 32 * kk); cbB[q][kk] = *(const LAS bf16x8*)(Cl + (16 * lj + frl) * SS_LDC + 8 * fql + 32 * kk); } } }
                  auto tab_load = [&](int q) { const int id = 2 * w + q, si = id >> 2, lj = id & 3, l = 16 * lj + frl, s0 = 16 * si + 4 * fql;
#pragma unroll
                      for (int h = 0; h < 2; ++h) { tas[h] = *(const LAS f32x4*)(acs + 64 * h + s0); tdd[h] = *(const LAS f32x4*)(dtv + 64 * h + s0); tal[h] = acs[64 * h + l]; } };
                  tab_load(0);
                  SSD_FENCE();
#pragma unroll
                  for (int q = 0; q < 2; ++q) { const int id = 2 * w + q, si = id >> 2, lj = id & 3, l = 16 * lj + frl, s0 = 16 * si + 4 * fql;
                      u32x2 m0 = {0u, 0u}, m1 = {0u, 0u};
                      if (si <= lj) { f32x4 cb = (f32x4){0.f, 0.f, 0.f, 0.f};
#pragma unroll
                          for (int kk = 0; kk < 4; ++kk) cb = __builtin_amdgcn_mfma_f32_16x16x32_bf16(cbA[q][kk], cbB[q][kk], cb, 0, 0, 0);
                          float x0[4], x1[4];
#pragma unroll
                          for (int j = 0; j < 4; ++j) { const bool keep = (s0 + j <= l);
                              const float e0 = __expf(fminf(tal[0] - tas[0][j], 0.f)) * tdd[0][j], e1 = __expf(fminf(tal[1] - tas[1][j], 0.f)) * tdd[1][j];
                              const float c = keep ? cb[j] : 0.f; x0[j] = c * e0; x1[j] = c * e1; }
                          m0.x = pk2(x0[0], x0[1]); m0.y = pk2(x0[2], x0[3]); m1.x = pk2(x1[0], x1[1]); m1.y = pk2(x1[2], x1[3]); }
                      if (q == 0) tab_load(1);
                      *(LAS u32x2*)(Ml + (0 * 64 + l) * SS_LDM + s0) = m0; *(LAS u32x2*)(Ml + (1 * 64 + l) * SS_LDM + s0) = m1; } }
                __syncthreads();
                const int trb = (4 * fql + (frl >> 2)) * SS_LDC + 4 * (frl & 3);
                const int trbx = (4 * fql + (frl >> 2)) * SS_LDC + 8 * (frl & 3);
                { bf16x8 mf[2], xdf[4][2];
#pragma unroll
                  for (int kk = 0; kk < 2; ++kk) { const LAS bf16* mp = Ml + (hh * 64 + lrow) * SS_LDM + 32 * kk + 4 * fql;
                      const s16x4 a = *(const LAS s16x4*)mp, b2 = *(const LAS s16x4*)(mp + 16); mf[kk] = __builtin_shufflevector(a, b2, 0, 1, 2, 3, 4, 5, 6, 7); }
#pragma unroll
                  for (int pi = 0; pi < 4; ++pi)
#pragma unroll
                      for (int kk = 0; kk < 2; ++kk) xdf[pi][kk] = ssd_trfrag(Xr + trbx + 32 * kk * SS_LDC + hh * 64 + 32 * (pi >> 1) + 4 * (pi & 1));
                  const float el = __expf(acs[hh * 64 + lrow]);
                  SSD_TIE8(xdf);
#pragma unroll
                  for (int pi = 0; pi < 4; ++pi) { Y[pi] = Y[pi] * el;
                      Y[pi] = __builtin_amdgcn_mfma_f32_16x16x32_bf16(xdf[pi][0], mf[0], Y[pi], 0, 0, 0);
                      Y[pi] = __builtin_amdgcn_mfma_f32_16x16x32_bf16(xdf[pi][1], mf[1], Y[pi], 0, 0, 0); }
                  __builtin_amdgcn_sched_barrier(0);
#pragma unroll
                  for (int t = 0; t < 2; ++t) { const int p0 = 32 * t + 8 * fql; bf16* yp = YS + tok * DSSM + 64 * (h0 + hh) + p0; f32x4 y0 = Y[2 * t], y1 = Y[2 * t + 1];
                      if (dir == 0) { const u32x4 xv = *(const LAS u32x4*)(Xr + lrow * SS_LDC + hh * 64 + p0);
                          y0[0] += dsk * bflo(xv.x); y0[1] += dsk * bfhi(xv.x); y0[2] += dsk * bflo(xv.y); y0[3] += dsk * bfhi(xv.y);
                          y1[0] += dsk * bflo(xv.z); y1[1] += dsk * bfhi(xv.z); y1[2] += dsk * bflo(xv.w); y1[3] += dsk * bfhi(xv.w);
                      } else { const u32x4 pvv = pv[t];
                          const f32x2 z01 = __builtin_amdgcn_cvt_pk_f32_fp8((int)zv[t].x, false), z23 = __builtin_amdgcn_cvt_pk_f32_fp8((int)zv[t].x, true);
                          const f32x2 z45 = __builtin_amdgcn_cvt_pk_f32_fp8((int)zv[t].y, false), z67 = __builtin_amdgcn_cvt_pk_f32_fp8((int)zv[t].y, true);
                          y0[0] = (y0[0] + bflo(pvv.x)) * siluf_(z01.x); y0[1] = (y0[1] + bfhi(pvv.x)) * siluf_(z01.y); y0[2] = (y0[2] + bflo(pvv.y)) * siluf_(z23.x); y0[3] = (y0[3] + bfhi(pvv.y)) * siluf_(z23.y);
                          y1[0] = (y1[0] + bflo(pvv.z)) * siluf_(z45.x); y1[1] = (y1[1] + bfhi(pvv.z)) * siluf_(z45.y); y1[2] = (y1[2] + bflo(pvv.w)) * siluf_(z67.x); y1[3] = (y1[3] + bfhi(pvv.w)) * siluf_(z67.y); }
                      u32x4 o; o.x = pk2(y0[0], y0[1]); o.y = pk2(y0[2], y0[3]); o.z = pk2(y1[0], y1[1]); o.w = pk2(y1[2], y1[3]); *(u32x4*)yp = o; }
                  __builtin_amdgcn_sched_barrier(0); }
                { const int pi5 = w & 3; const float dec = __expf(acs[hh * 64 + 63]);
                  bf16x8 xef[2];
#pragma unroll
                  for (int kk = 0; kk < 2; ++kk) xef[kk] = ssd_trfrag(XEr + trb + 32 * kk * SS_LDC + hh * 64 + 16 * pi5);
#pragma unroll
                  for (int nh = 0; nh < 2; ++nh) { bf16x8 btf[4][2];
#pragma unroll
                      for (int nn = 0; nn < 4; ++nn)
#pragma unroll
                          for (int kk = 0; kk < 2; ++kk) btf[nn][kk] = ssd_trfrag(Bl + trb + 32 * kk * SS_LDC + 16 * (4 * nh + nn));
                      SSD_TIE8(btf);
#pragma unroll
                      for (int nn = 0; nn < 4; ++nn) { const int ni = 4 * nh + nn; Sacc[ni] = Sacc[ni] * dec;
                          Sacc[ni] = __builtin_amdgcn_mfma_f32_16x16x32_bf16(btf[nn][0], xef[0], Sacc[ni], 0, 0, 0);
                          Sacc[ni] = __builtin_amdgcn_mfma_f32_16x16x32_bf16(btf[nn][1], xef[1], Sacc[ni], 0, 0, 0); }
                      __builtin_amdgcn_sched_barrier(0); }
#pragma unroll
                  for (int ni = 0; ni < 8; ++ni) { u32x2 o; o.x = pk2(Sacc[ni][0], Sacc[ni][1]); o.y = pk2(Sacc[ni][2], Sacc[ni][3]);
                      *(LAS u32x2*)(SB + (hh * 64 + 16 * pi5 + frl) * SS_LDC + 16 * ni + 4 * fql) = o; } }
                if (w < 2 && ci + 1 < 32) { scan(buf ^ 1, dtn); if (ci + 2 < 32) dtn = dtload(ci + 2); }
                __syncthreads();
            }
        }
    }
}

__device__ __forceinline__ void ssd_norm_phase(Frame& F) {
    bf16* YS = (bf16*)(F.ws + WS_YSSD); const float* nw = F.in[I_SNW];
    const int gw = F.vcu * NWAVES + F.wave, NGW = F.G * NWAVES, lane = F.lane;
    f32x4 wv[8];
#pragma unroll
    for (int j = 0; j < 4; ++j) { wv[2 * j] = *(const f32x4*)(nw + 512 * j + 8 * lane); wv[2 * j + 1] = *(const f32x4*)(nw + 512 * j + 8 * lane + 4); }
    for (int m = gw; m < MTOK; m += 2 * NGW) {
        u32x4 v[2][4];
#pragma unroll
        for (int u = 0; u < 2; ++u)
#pragma unroll
            for (int j = 0; j < 4; ++j) v[u][j] = *(const u32x4*)(YS + (size_t)((m + u * NGW < MTOK) ? m + u * NGW : m) * DSSM + 512 * j + 8 * lane);
#pragma unroll
        for (int u = 0; u < 2; ++u) { if (m + u * NGW >= MTOK) break; bf16* row = YS + (size_t)(m + u * NGW) * DSSM + 8 * lane;
#pragma unroll
            for (int j = 0; j < 4; ++j) { const u32x4 q = v[u][j];
                const float a0 = bflo(q.x), a1 = bfhi(q.x), a2 = bflo(q.y), a3 = bfhi(q.y), a4 = bflo(q.z), a5 = bfhi(q.z), a6 = bflo(q.w), a7 = bfhi(q.w);
                float ss = (a0 * a0 + a1 * a1) + (a2 * a2 + a3 * a3) + (a4 * a4 + a5 * a5) + (a6 * a6 + a7 * a7);
                ss += __shfl_xor(ss, 1); ss += __shfl_xor(ss, 2); ss += __shfl_xor(ss, 4); ss += __shfl_xor(ss, 8); ss += __shfl_xor(ss, 16);
                const float rs = 1.0f / sqrtf(ss * (1.0f / 256.0f) + RMS_EPS); const f32x4 w0 = wv[2 * j], w1 = wv[2 * j + 1];
                u32x4 o; o.x = pk2(a0 * rs * w0[0], a1 * rs * w0[1]); o.y = pk2(a2 * rs * w0[2], a3 * rs * w0[3]);
                o.z = pk2(a4 * rs * w1[0], a5 * rs * w1[1]); o.w = pk2(a6 * rs * w1[2], a7 * rs * w1[3]);
                *(u32x4*)(row + 512 * j) = o; } } }
}

constexpr int RT_WB = 131072, RT_WBP = 40, RT_WBSZ = 2 * 16 * RT_WBP * 2;
constexpr int RT_LG = RT_WB + 8 * RT_WBSZ;
__device__ __forceinline__ void ln1_router_phase(Frame& F) {
    const bf16* H1P = (const bf16*)(F.ws + WS_H1P); bf16* H1B = (bf16*)F.out;
    int* TOK = (int*)(F.ws + WS_TOK); float* WGT = (float*)(F.ws + WS_WGT); int* ASG = (int*)(F.ws + WS_ASG);
    const float* g1 = F.in[I_LN1G]; const float* b1 = F.in[I_LN1B]; const float* rb = F.in[I_RB];
    const bf16* RWT = (const bf16*)(F.ws + WS_RWT);
    LAS float* hrow = (LAS float*)(F.lds + F.wave * 16384);
    LAS bf16* wbuf = (LAS bf16*)(F.lds + RT_WB + F.wave * RT_WBSZ);
    LAS float* LG = (LAS float*)(F.lds + RT_LG);
    LAS unsigned* cl = (LAS unsigned*)(F.lds + RT_LG + 8192);
    if (F.tid < 64) cl[F.tid] = 0u;
    __syncthreads();
    const int lane = F.lane, tid = F.tid, fr = lane & 15, fq = lane >> 4;
    f32x4 gv[4], bv[4];
#pragma unroll
    for (int j = 0; j < 4; ++j) { gv[j] = *(const f32x4*)(g1 + 4 * lane + 256 * j); bv[j] = *(const f32x4*)(b1 + 4 * lane + 256 * j); }
    const float rbias = rb[lane];
    const int et = F.wave & 3, rt = F.wave >> 2;
    const int hl = lane >> 5, se = (lane >> 1) & 15, sq = lane & 1;
    const bf16* wsrc = RWT + (size_t)hl * DM * NE + (size_t)(16 * et + se) * DM + 16 * sq;
    LAS bf16* wdst = wbuf + hl * (16 * RT_WBP) + se * RT_WBP + 16 * sq;
    const LAS float* hsrc = (const LAS float*)(F.lds + (4 * rt + (fr >> 2)) * 16384) + (fr & 3) * 1024 + 8 * fq;
    const LAS bf16* asrc = wbuf + fr * RT_WBP + 8 * fq;
    u32x2 qin[4][4];
    auto rows_load = [&](int step) { const int rg_ = step * 8 + F.wave;
#pragma unroll
        for (int r = 0; r < 4; ++r)
#pragma unroll
            for (int j = 0; j < 4; ++j) qin[r][j] = *(const u32x2*)(H1P + ((size_t)rg_ * 4 + r) * DM + 4 * lane + 256 * j); };
    if (F.vcu < MTOK / 32) rows_load(F.vcu);
    for (int step = F.vcu; step < MTOK / 32; step += F.G) {
        const int rg = step * 8 + F.wave;
        u32x4 nx0 = *(const u32x4*)(wsrc), nx1 = *(const u32x4*)(wsrc + 8);
#pragma unroll
        for (int r = 0; r < 4; ++r) { const size_t m = (size_t)rg * 4 + r;
            f32x4 v[4]; float s = 0.f;
#pragma unroll
            for (int j = 0; j < 4; ++j) { const u32x2 q = qin[r][j]; v[j][0] = bflo(q.x); v[j][1] = bfhi(q.x); v[j][2] = bflo(q.y); v[j][3] = bfhi(q.y); s += (v[j][0] + v[j][1]) + (v[j][2] + v[j][3]); }
            const float mean = wave_sum(s) * (1.f / DM); float s2 = 0.f;
#pragma unroll
            for (int j = 0; j < 4; ++j) { v[j] = v[j] - mean; s2 += (v[j][0] * v[j][0] + v[j][1] * v[j][1]) + (v[j][2] * v[j][2] + v[j][3] * v[j][3]); }
            const float rstd = 1.f / sqrtf(wave_sum(s2) * (1.f / DM) + LN_EPS);
#pragma unroll
            for (int j = 0; j < 4; ++j) { const f32x4 h = v[j] * rstd * gv[j] + bv[j];
                u32x2 o; o.x = pk2(h[0], h[1]); o.y = pk2(h[2], h[3]); *(u32x2*)(H1B + m * H1B_PITCH + 4 * lane + 256 * j) = o;
                *(LAS f32x4*)(hrow + r * 1024 + 4 * lane + 256 * j) = h; } }
        __syncthreads();
        if (step + F.G < MTOK / 32) rows_load(step + F.G);
        f32x4 acc = (f32x4){0.f, 0.f, 0.f, 0.f};
#pragma unroll 4
        for (int ks = 0; ks < 32; ++ks) {
            *(LAS u32x4*)(wdst) = nx0; *(LAS u32x4*)(wdst + 8) = nx1;
            if (ks + 1 < 32) { nx0 = *(const u32x4*)(wsrc + 32 * (ks + 1)); nx1 = *(const u32x4*)(wsrc + 32 * (ks + 1) + 8); }
            const f32x4 x0 = *(const LAS f32x4*)(hsrc + 32 * ks), x1 = *(const LAS f32x4*)(hsrc + 32 * ks + 4);
            u32x4 hh, hlw;
            hh.x = pk2(x0[0], x0[1]); hh.y = pk2(x0[2], x0[3]); hh.z = pk2(x1[0], x1[1]); hh.w = pk2(x1[2], x1[3]);
            hlw.x = pk2(x0[0] - bflo(hh.x), x0[1] - bfhi(hh.x)); hlw.y = pk2(x0[2] - bflo(hh.y), x0[3] - bfhi(hh.y));
            hlw.z = pk2(x1[0] - bflo(hh.z), x1[1] - bfhi(hh.z)); hlw.w = pk2(x1[2] - bflo(hh.w), x1[3] - bfhi(hh.w));
            const bf16x8 bh = __builtin_bit_cast(bf16x8, hh), bl = __builtin_bit_cast(bf16x8, hlw);
            const bf16x8 ah = *(const LAS bf16x8*)asrc, al = *(const LAS bf16x8*)(asrc + 16 * RT_WBP);
            acc = __builtin_amdgcn_mfma_f32_16x16x32_bf16(ah, bh, acc, 0, 0, 0);
            acc = __builtin_amdgcn_mfma_f32_16x16x32_bf16(ah, bl, acc, 0, 0, 0);
            acc = __builtin_amdgcn_mfma_f32_16x16x32_bf16(al, bh, acc, 0, 0, 0);
        }
        *(LAS f32x4*)(LG + (16 * rt + fr) * 64 + 16 * et + 4 * fq) = acc;
        __syncthreads();
        float lg[4];
#pragma unroll
        for (int r = 0; r < 4; ++r) lg[r] = LG[(4 * F.wave + r) * 64 + lane];
        bool selr[4]; float wgr[4]; int rkr[4];
        float scr_[4], msk_[4];
#pragma unroll
        for (int r = 0; r < 4; ++r) {
            const float score = 1.0f / (1.0f + expf(-lg[r])), biased = score + rbias;
            float m1 = biased; m1 = fmaxf(m1, DPPF(m1, m1, 0xB1, 0xf)); m1 = fmaxf(m1, DPPF(m1, m1, 0x4E, 0xf)); m1 = fmaxf(m1, DPPF(m1, m1, 0x141, 0xf));
            const unsigned long long eq = __ballot(biased == m1); const int gbase = lane & ~7; const int first = gbase + __ffs((unsigned)((eq >> gbase) & 0xffull)) - 1;
            float v2 = (lane == first) ? -INFINITY : biased; v2 = fmaxf(v2, DPPF(v2, v2, 0xB1, 0xf)); v2 = fmaxf(v2, DPPF(v2, v2, 0x4E, 0xf)); v2 = fmaxf(v2, DPPF(v2, v2, 0x141, 0xf));
            const float gs = m1 + v2; const int g = lane >> 3; int better = 0;
#pragma unroll
            for (int d = 1; d < 8; ++d) { const int g2 = (g + d) & 7; const float og = __shfl(gs, g2 * 8); better += (og > gs || (og == gs && g2 < g)) ? 1 : 0; }
            scr_[r] = score; msk_[r] = (better < 4) ? biased : -INFINITY; }
        unsigned key_[4]; int thr_[4] = {0, 0, 0, 0};
#pragma unroll
        for (int r = 0; r < 4; ++r) { const unsigned u = __builtin_bit_cast(unsigned, msk_[r]); const unsigned s_ = (u & 0x80000000u) ? ~u : (u | 0x80000000u); key_[r] = (s_ & ~63u) | (unsigned)(63 - lane); }
#pragma unroll 1
        for (int bit = 31; bit >= 0; --bit) {
#pragma unroll
            for (int r = 0; r < 4; ++r) { const int cand = __builtin_amdgcn_readfirstlane(thr_[r] | (int)(1u << bit)); const int cnt = __popcll(__ballot(key_[r] >= (unsigned)cand)); thr_[r] = (cnt >= TOPK) ? cand : thr_[r]; } }
#pragma unroll
        for (int r = 0; r < 4; ++r) selr[r] = key_[r] >= (unsigned)thr_[r];
#pragma unroll
        for (int r = 0; r < 4; ++r) {
            const float sw = wave_sum(selr[r] ? scr_[r] : 0.f);
            const unsigned long long selm = __ballot(selr[r]);
            wgr[r] = scr_[r] / sw * ROUTED_SCALE; rkr[r] = __popcll(selm & ((1ull << lane) - 1ull)); }
        unsigned lp[4];
#pragma unroll
        for (int r = 0; r < 4; ++r) lp[r] = selr[r] ? atomicAdd((unsigned*)(cl + lane), 1u) : 0u;
        __syncthreads();
        if (F.wave == 0) { const unsigned n = cl[lane]; unsigned bs = 0u;
            if (n) bs = __hip_atomic_fetch_add((unsigned*)(F.ctl + CW_CNT + 64 * lane), n, __ATOMIC_RELAXED, __HIP_MEMORY_SCOPE_AGENT);
            cl[64 + lane] = bs; cl[lane] = 0u; }
        __syncthreads();
        const unsigned bse = cl[64 + lane];
#pragma unroll
        for (int r = 0; r < 4; ++r) if (selr[r]) { const int m = rg * 4 + r; const unsigned pos = bse + lp[r];
            TOK[(size_t)lane * MTOK + pos] = m; WGT[(size_t)lane * MTOK + pos] = wgr[r]; ASG[(size_t)m * 8 + rkr[r]] = lane * MTOK + (int)pos; }
    }
}
constexpr int MOE_TP = 131072 + 1024, MOE_CNT = MOE_TP + 512, MOE_TE = 131072 + 4096;
__device__ __forceinline__ int moe_table(Frame& F) {
    LAS int* tp = (LAS int*)(F.lds + MOE_TP); LAS int* cnt = (LAS int*)(F.lds + MOE_CNT);
    __syncthreads();
    if (F.tid < NEX) cnt[F.tid] = (F.tid < NE) ? (int)__hip_atomic_load((unsigned*)(F.ctl + CW_CNT + 64 * F.tid), __ATOMIC_RELAXED, __HIP_MEMORY_SCOPE_AGENT) : MTOK;
    __syncthreads();
    if (F.tid == 0) { int run = 0;
        for (int e = 0; e < NEX; ++e) { tp[e] = run; run += (cnt[e] + 255) >> 8; }
        tp[NEX] = run; }
    __syncthreads();
    { LAS int* te = (LAS int*)(F.lds + MOE_TE); const int total = tp[NEX];
      for (int t = F.tid; t < total; t += NTHR) { int e = 0;
#pragma unroll 1
          for (int s = 64; s >= 1; s >>= 1) if (e + s <= NE && tp[e + s] <= t) e += s;
          te[t] = e; } }
    __syncthreads();
    return tp[NEX];
}
__device__ __forceinline__ void fp8x4_fma(f32x4& a, const unsigned v, const float w) {
    const f32x2 p0 = __builtin_amdgcn_cvt_pk_f32_fp8((int)v, false), p1 = __builtin_amdgcn_cvt_pk_f32_fp8((int)v, true);
    a[0] += w * p0.x; a[1] += w * p0.y; a[2] += w * p1.x; a[3] += w * p1.y;
}
__device__ __forceinline__ void moe_combine_phase(Frame& F) {
    const bf16* H1B = (const bf16*)F.out; const unsigned char* YQ = (const unsigned char*)(F.ws + WS_YQ); const int* ASG = (const int*)(F.ws + WS_ASG); const float* WGT = (const float*)(F.ws + WS_WGT);
    const LAS int* tp = (const LAS int*)(F.lds + MOE_TP);
    const float* g2 = F.in[I_LN2G]; const float* b2 = F.in[I_LN2B];
    const int gw = F.vcu * NWAVES + F.wave, NGW = F.G * NWAVES, lane = F.lane;
    const size_t shbase = (size_t)tp[NE] * 256;
    f32x4 gv[4], bv[4];
#pragma unroll
    for (int j = 0; j < 4; ++j) { gv[j] = *(const f32x4*)(g2 + 4 * lane + 256 * j); bv[j] = *(const f32x4*)(b2 + 4 * lane + 256 * j); }
    const int l8 = lane & 7;
    int li = ASG[(size_t)gw * 8 + l8];
    float wk = WGT[li];
    int li_n = (gw + NGW < MTOK) ? ASG[(size_t)(gw + NGW) * 8 + l8] : 0;
    for (int m = gw; m < MTOK; m += NGW) {
        const int e = li >> 15, pos = li & 32767; const int slot = 256 * tp[e] + pos; const float wcur = wk;
        unsigned vv[9][4]; f32x4 v[4];
        { const unsigned char* sp = YQ + (shbase + m) * 1024 + 4 * lane;
#pragma unroll
          for (int j = 0; j < 4; ++j) vv[8][j] = *(const unsigned*)(sp + 256 * j); }
#pragma unroll
        for (int k = 0; k < 8; ++k) { const int sk = __shfl(slot, k); const unsigned char* sp = YQ + (size_t)sk * 1024 + 4 * lane;
#pragma unroll
            for (int j = 0; j < 4; ++j) vv[k][j] = *(const unsigned*)(sp + 256 * j); }
        float* xr = F.out + (size_t)m * DM + 4 * lane; const bf16* hr = H1B + (size_t)m * H1B_PITCH + 4 * lane; u32x2 hq[4];
#pragma unroll
        for (int j = 0; j < 4; ++j) hq[j] = *(const u32x2*)(hr + 256 * j);
        li = li_n; wk = WGT[li];
        li_n = (m + 2 * NGW < MTOK) ? ASG[(size_t)(m + 2 * NGW) * 8 + l8] : 0;
#pragma unroll
        for (int j = 0; j < 4; ++j) { v[j][0] = DN_ALPHA * bflo(hq[j].x); v[j][1] = DN_ALPHA * bfhi(hq[j].x); v[j][2] = DN_ALPHA * bflo(hq[j].y); v[j][3] = DN_ALPHA * bfhi(hq[j].y); fp8x4_fma(v[j], vv[8][j], 1.0f); }
#pragma unroll
        for (int k = 0; k < 8; ++k) { const float w = __shfl(wcur, k);
#pragma unroll
            for (int j = 0; j < 4; ++j) fp8x4_fma(v[j], vv[k][j], w); }
        float s = 0.f;
#pragma unroll
        for (int j = 0; j < 4; ++j) s += (v[j][0] + v[j][1]) + (v[j][2] + v[j][3]);
        const float mean = wave_sum(s) * (1.f / DM); float s2 = 0.f;
#pragma unroll
        for (int j = 0; j < 4; ++j) { v[j] = v[j] - mean; s2 += (v[j][0] * v[j][0] + v[j][1] * v[j][1]) + (v[j][2] * v[j][2] + v[j][3] * v[j][3]); }
        const float rstd = 1.f / sqrtf(wave_sum(s2) * (1.f / DM) + LN_EPS);
#pragma unroll
        for (int j = 0; j < 4; ++j) *(f32x4*)(xr + 256 * j) = v[j] * rstd * gv[j] + bv[j];
    }
}

#ifndef MK_N_LAUNCHES
#define MK_N_LAUNCHES 1
#endif
constexpr int NPH = 15;
constexpr int N_LAUNCHES = MK_N_LAUNCHES;

__global__ void __launch_bounds__(NTHR, 2) fwd_kernel(Args args) {
    extern __shared__ __attribute__((aligned(16))) unsigned char lds_raw[];
    Frame F;
    F.lds = (LAS unsigned char*)lds_raw;
    F.MISC = (volatile LAS unsigned*)(F.lds + MISC_OFF);
    F.tid = threadIdx.x; F.lane = F.tid & 63; F.wave = __builtin_amdgcn_readfirstlane(F.tid >> 6);
    F.G = gridDim.x; { const int bx = blockIdx.x; F.vcu = (F.G % 8 == 0) ? (bx % 8) * (F.G / 8) + bx / 8 : bx; }
    F.ws = args.ws; F.ctl = (gu32*)(args.ws + WS_CTL); F.in = args.in; F.out = args.out;
    for (int u = F.tid; u < (LDS_BYTES - MISC_OFF) / 4; u += NTHR) ((LAS unsigned*)(F.lds + MISC_OFF))[u] = 0u;
    __syncthreads();
    XcdBarrier bar; bar.bar = (unsigned*)(F.ctl + CW_BAR); bar.x = 0; bar.st = nullptr;
    if (N_LAUNCHES != NPH) bar = xcd_barrier_post((unsigned*)(F.ctl + CW_BAR), F.MISC + 8);
    const int lo = args.ph_lo, hi = args.ph_hi;
#ifndef PH_MASK
#define PH_MASK 0x7fff
#endif
#define IN(k) ((((PH_MASK) >> (k)) & 1) && lo <= (k) && (k) < hi)
#ifdef STRESS_US
#define SKEW() do { if ((blockIdx.x * 2654435761u >> 28) & 1) { const unsigned long long t0_ = __builtin_amdgcn_s_memrealtime(); while (__builtin_amdgcn_s_memrealtime() - t0_ < (unsigned long long)(STRESS_US) * 100ull) __builtin_amdgcn_s_sleep(8); } __syncthreads(); } while (0)
#else
#define SKEW() do { } while (0)
#endif
#define SEAM(k) do { if (IN(k) && IN((k) + 1)) { xcd_barrier(bar); SKEW(); } } while (0)
#ifndef REP_MASK
#define REP_MASK 0
#endif
#define REPS(k) for (int rep_ = 0; rep_ < ((((REP_MASK) >> (k)) & 1) ? 2 : 1); ++rep_, ((((REP_MASK) >> (k)) & 1) && rep_ == 1 ? xcd_barrier(bar) : (void)0))
    const int G = F.G, bx = (int)blockIdx.x;

#ifdef START_BARS
    for (int xb_ = 0; xb_ < START_BARS; ++xb_) xcd_barrier(bar);
#endif
    if (IN(0)) REPS(0) { p0_prologue(F); } SEAM(0);
    if (IN(1)) REPS(1) {
        pg8::StaticOrder S; S.init((const bf16*)((unsigned char*)F.out + OUT_XB), (const bf16*)(F.ws + WS_WINT), MTOK, HYC, DM, G, bx);
        pg8::EpiHyT E{(bf16*)(F.ws + WS_PTHY), F.in[I_BIN], F.lds + pg8::STAGE_BYTES};
        pg8::gemm_phase<pg8::EpiHyT, pg8::StaticOrder, false>(F.lds, DM, S, E);
    } SEAM(1);
    if (IN(2)) REPS(2) { hyena_phase(F); } SEAM(2);
    if (IN(3)) REPS(3) { p3_transpose(F); } SEAM(3);
    if (IN(4)) REPS(4) {
        pg8::StaticOrder S; S.init((const bf16*)((unsigned char*)F.out + OUT_XB), (const bf16*)(F.ws + WS_WINT) + (size_t)3072 * DM, MTOK, 6400, DM, G, bx);
        pg8::EpiZXD E{(unsigned char*)F.out, (bf16*)(F.ws + WS_XBC), (float*)(F.ws + WS_DT), F.in[I_BIN], (bf16*)(F.ws + WS_HALO)};
        pg8::gemm_phase<pg8::EpiZXD, pg8::StaticOrder, false>(F.lds, DM, S, E);
    } SEAM(4);
    if (IN(5)) REPS(5) { ssd_conv_phase(F); } SEAM(5);
    if (IN(6)) REPS(6) { ssd_phase(F); } SEAM(6);
    if (IN(7)) REPS(7) { ssd_norm_phase(F); }
    if (IN(8)) REPS(8) {
        pg8::StaticOrder S; S.init((const bf16*)((unsigned char*)F.out + OUT_XB), (const bf16*)(F.ws + WS_WING), MTOK, 2048, DM, G, bx);
        pg8::EpiBf<0> E{(bf16*)(F.ws + WS_G), 2048, F.in[I_BIN] + 9280, nullptr, 0, nullptr};
        pg8::gemm_phase<pg8::EpiBf<0>, pg8::StaticOrder, false>(F.lds, DM, S, E);
    } SEAM(8);
    if (IN(9)) REPS(9) {
        pg8::StaticOrder S; S.init((const bf16*)(F.ws + WS_YHY), (const bf16*)(F.ws + WS_WHYB), MTOK, DM, DM, G, bx);
        pg8::EpiBf<1> E{(bf16*)(F.ws + WS_MIX), DM, nullptr, (const bf16*)(F.ws + WS_G), 2048, nullptr};
        pg8::gemm_phase<pg8::EpiBf<1>, pg8::StaticOrder, false>(F.lds, DM, S, E);
    }
    if (IN(10)) REPS(10) {
        pg8::StaticOrder S; S.init((const bf16*)(F.ws + WS_YSSD), (const bf16*)(F.ws + WS_WSSDB), MTOK, DM, DSSM, G, bx);
        pg8::EpiBf<2> E{(bf16*)(F.ws + WS_MIX), DM, nullptr, (const bf16*)(F.ws + WS_G) + 1024, 2048, (const bf16*)(F.ws + WS_MIX)};
        pg8::gemm_phase<pg8::EpiBf<2>, pg8::StaticOrder, false>(F.lds, DSSM, S, E);
    } SEAM(10);
    if (IN(11)) REPS(11) {
        pg8::StaticOrder S; S.init((const bf16*)(F.ws + WS_MIX), (const bf16*)(F.ws + WS_WOUT), MTOK, DM, DM, G, bx);
        pg8::EpiRes E{(bf16*)(F.ws + WS_H1P), F.in[I_BOUT], (const bf16*)((unsigned char*)F.out + OUT_XB), DN_ALPHA};
        if (bx & 1) { p10_expert_weights(F); __syncthreads(); }
        pg8::gemm_phase<pg8::EpiRes, pg8::StaticOrder, false>(F.lds, DM, S, E);
        if (!(bx & 1)) p10_expert_weights(F);
    } SEAM(11);
    if (IN(12)) REPS(12) { ln1_router_phase(F); } SEAM(12);
    if (IN(13)) REPS(13) {
        const int total = moe_table(F);
        pg8::MoeOrder<2, true> S{(const LAS int*)(F.lds + MOE_TP), (const LAS int*)(F.lds + MOE_CNT), (const LAS int*)(F.lds + MOE_TE), G, bx, total, (const char*)F.out, (const char*)(F.ws + WS_EW1), (const int*)(F.ws + WS_TOK)};
        pg8::EpiSwiGLU E{(bf16*)(F.ws + WS_HID)};
        pg8::gemm_phase<pg8::EpiSwiGLU, pg8::MoeOrder<2, true>, true>(F.lds, DM, S, E);
    } SEAM(13);
    if (IN(14)) {
        const int total = moe_table(F);
        { pg8::SlotOrder4 S{(const LAS int*)(F.lds + MOE_TP), (const LAS int*)(F.lds + MOE_TE), G, bx, total, (const char*)(F.ws + WS_HID), (const char*)(F.ws + WS_EW2)};
          pg8::EpiSlot8 E{(unsigned char*)(F.ws + WS_YQ)}; int kd = DEXP; asm volatile("" : "+s"(kd));
          pg8::gemm_phase<pg8::EpiSlot8, pg8::SlotOrder4, false>(F.lds, kd, S, E); }
        xcd_barrier(bar);
        moe_combine_phase(F);
    }
#ifdef EXTRA_BARS
    for (int xb_ = 0; xb_ < EXTRA_BARS; ++xb_) xcd_barrier(bar);
#endif
#undef IN
#undef SEAM
}

extern "C" void kernel_launch(void* const* d_in, const int* in_sizes, int n_in, void* d_out, int out_size, void* d_ws, size_t ws_size, hipStream_t stream) {
    static int grid = 0;
    if (grid == 0) {
        if (n_in != 38 || out_size != MTOK * DM || ws_size < WS_END) { fprintf(stderr, "kernel_launch: unexpected shapes (n_in %d out %d ws %zu)\n", n_in, out_size, ws_size); grid = -1; return; }
        int dev = 0, cus = 0, per_cu = 0;
        if (hipGetDevice(&dev) != hipSuccess || hipDeviceGetAttribute(&cus, hipDeviceAttributeMultiprocessorCount, dev) != hipSuccess) { grid = -1; return; }
        if (hipFuncSetAttribute((const void*)fwd_kernel, hipFuncAttributeMaxDynamicSharedMemorySize, LDS_BYTES) != hipSuccess) { fprintf(stderr, "kernel_launch: hipFuncSetAttribute failed\n"); grid = -1; return; }
        if (hipOccupancyMaxActiveBlocksPerMultiprocessor(&per_cu, (const void*)fwd_kernel, NTHR, LDS_BYTES) != hipSuccess || per_cu < 1) fprintf(stderr, "kernel_launch: occupancy query says %d\n", per_cu);
        (void)hipGetLastError();
        grid = cus;
    }
    if (grid < 0) return;
#ifdef EXTRA_PHASE
    {
        (void)hipMemsetAsync((char*)d_ws + WS_CTL, 0, CTL_ZERO_BYTES, stream);
        Args x{}; for (int i = 0; i < 38; ++i) x.in[i] = (const float*)d_in[i];
        x.out = (float*)d_out; x.ws = (unsigned char*)d_ws; x.ph_lo = EXTRA_PHASE; x.ph_hi = EXTRA_PHASE + 1; x.li = 0;
        hipLaunchKernelGGL(fwd_kernel, dim3(grid), dim3(NTHR), LDS_BYTES, stream, x);
#ifdef EXTRA_REPEAT
        for (int rr = 0; rr < EXTRA_REPEAT; ++rr) hipLaunchKernelGGL(fwd_kernel, dim3(grid), dim3(NTHR), LDS_BYTES, stream, x);
#endif
    }
#endif
    (void)hipMemsetAsync((char*)d_ws + WS_CTL, 0, CTL_ZERO_BYTES, stream);
    Args a{};
    for (int i = 0; i < 38; ++i) a.in[i] = (const float*)d_in[i];
    a.out = (float*)d_out; a.ws = (unsigned char*)d_ws;
    for (int li = 0; li < N_LAUNCHES; ++li) {
        a.ph_lo = (N_LAUNCHES == NPH) ? li : 0; a.ph_hi = (N_LAUNCHES == NPH) ? li + 1 : NPH; a.li = li;
        hipLaunchKernelGGL(fwd_kernel, dim3(grid), dim3(NTHR), LDS_BYTES, stream, a);
    }
}
```
